# Optimizing an MI355X kernel written in HIP

```python
import math
import jax, jax.numpy as jnp
from jax import lax
import numpy as np

D_MODEL = 1024
BATCH = 2
SEQ = 8192
DEPTH = 1

MEM_LEN = 256
EPS = 1e-6
CONV_WIDTH = 4
SSD_EXPAND = 2
SSD_WIDTH = SSD_EXPAND * D_MODEL
SSD_HEAD_DIM = 64
SSD_HEADS = SSD_WIDTH // SSD_HEAD_DIM
SSD_GROUPS = 4
SSD_STATE = 128
SSD_CHUNK = 128
SSD_CONV_CH = SSD_WIDTH + 2 * SSD_GROUPS * SSD_STATE
LRU_WIDTH = 3 * D_MODEL // 2
LRU_BLOCKS = 16
LRU_BLOCK = LRU_WIDTH // LRU_BLOCKS
LRU_C = 8.0
MEM_HEADS = 4
MEM_HEAD_DIM = D_MODEL // MEM_HEADS
N_BRANCH = 3
SPLIT_POINTS = (
    SSD_WIDTH,
    SSD_WIDTH + SSD_CONV_CH,
    SSD_WIDTH + SSD_CONV_CH + SSD_HEADS,
    SSD_WIDTH + SSD_CONV_CH + SSD_HEADS + LRU_WIDTH,
    SSD_WIDTH + SSD_CONV_CH + SSD_HEADS + 2 * LRU_WIDTH,
    SSD_WIDTH + SSD_CONV_CH + SSD_HEADS + 2 * LRU_WIDTH + D_MODEL,
)
IN_WIDTH = SSD_WIDTH + SSD_CONV_CH + SSD_HEADS + 2 * LRU_WIDTH + D_MODEL + N_BRANCH * D_MODEL

kernel_name = "hybrid_ssd_rglru_memxattn_gated_block"


def rms_norm(x, g):
    xf = x.astype(jnp.float32)
    y = xf * lax.rsqrt(jnp.mean(xf * xf, axis=-1, keepdims=True) + EPS)
    return (y * g.astype(jnp.float32)).astype(x.dtype)


def causal_dwconv(x, w, b):
    k = w.shape[0]
    y = lax.conv_general_dilated(
        x, w[:, None, :].astype(x.dtype), window_strides=(1,), padding=[(k - 1, 0)],
        dimension_numbers=('NWC', 'WIO', 'NWC'), feature_group_count=x.shape[-1])
    return y + b


def ssd_scan(x, dt, a_neg, b_in, c_in):
    f32 = jnp.float32
    bsz, s, h, p = x.shape
    g, n = b_in.shape[2], b_in.shape[3]
    k = h // g
    l = SSD_CHUNK
    nc = s // l
    x = x.astype(f32).reshape(bsz, nc, l, g, k, p)
    dt = dt.astype(f32).reshape(bsz, nc, l, g, k)
    bm = b_in.astype(f32).reshape(bsz, nc, l, g, n)
    cm = c_in.astype(f32).reshape(bsz, nc, l, g, n)
    xdt = x * dt[..., None]
    a_cs = jnp.cumsum(dt * a_neg.astype(f32).reshape(g, k), axis=2)
    causal = jnp.tril(jnp.ones((l, l), dtype=bool))
    seg = a_cs[:, :, :, None] - a_cs[:, :, None, :]
    decay = jnp.exp(jnp.where(causal[:, :, None, None], seg, -jnp.inf))
    cb = jnp.einsum('bclgn,bcsgn->bclsg', cm, bm)
    y_diag = jnp.einsum('bclsgk,bcsgkp->bclgkp', decay * cb[..., None], xdt)
    decay_to_end = jnp.exp(a_cs[:, :, -1:] - a_cs)
    states = jnp.einsum('bclgn,bclgkp->bcgkpn', bm, xdt * decay_to_end[..., None])
    chunk_decay = jnp.exp(a_cs[:, :, -1])

    def step(carry, inp):
        st, dec = inp
        return carry * dec[..., None, None] + st, carry

    init = jnp.zeros((bsz, g, k, p, n), f32)
    _, prev = lax.scan(step, init, (jnp.moveaxis(states, 1, 0), jnp.moveaxis(chunk_decay, 1, 0)))
    prev = jnp.moveaxis(prev, 0, 1)
    y_off = jnp.einsum('bclgn,bcgkpn->bclgkp', cm, prev) * jnp.exp(a_cs)[..., None]
    return (y_diag + y_off).reshape(bsz, s, h, p)


def rg_lru(x, w_a, b_a, w_x, b_x, lam):
    f32 = jnp.float32
    bsz, s, w = x.shape
    xb = x.reshape(bsz, s, LRU_BLOCKS, LRU_BLOCK)
    r = jax.nn.sigmoid(jnp.einsum('bsni,nij->bsnj', xb, w_a) + b_a).reshape(bsz, s, w)
    i = jax.nn.sigmoid(jnp.einsum('bsni,nij->bsnj', xb, w_x) + b_x).reshape(bsz, s, w)
    log_a = (-LRU_C * r.astype(f32)) * jax.nn.softplus(-lam.astype(f32))
    a = jnp.exp(log_a)
    mult = jnp.sqrt(-jnp.expm1(2.0 * log_a))
    u = mult * (i * x).astype(f32)

    def combine(left, right):
        a1, b1 = left
        a2, b2 = right
        return a1 * a2, a2 * b1 + b2

    _, hs = lax.associative_scan(combine, (a, u), axis=1)
    return hs.astype(x.dtype)


def memory_attention(q, mem_n, w_kv):
    bsz, s, _ = q.shape
    m = mem_n.shape[1]
    kv = mem_n @ w_kv
    k, v = jnp.split(kv, 2, axis=-1)
    q = q.reshape(bsz, s, MEM_HEADS, MEM_HEAD_DIM)
    k = k.reshape(bsz, m, MEM_HEADS, MEM_HEAD_DIM)
    v = v.reshape(bsz, m, MEM_HEADS, MEM_HEAD_DIM)
    scores = jnp.einsum('bshd,bmhd->bhsm', q, k).astype(jnp.float32) * (MEM_HEAD_DIM ** -0.5)
    probs = jax.nn.softmax(scores, axis=-1).astype(v.dtype)
    return jnp.einsum('bhsm,bmhd->bshd', probs, v).reshape(bsz, s, D_MODEL)


def setup_inputs(seed: int = 0) -> dict:
    key = jax.random.key(seed)
    ks = jax.random.split(key, 24)
    f32 = jnp.float32
    nrm = lambda k, shape, scale: jax.random.normal(k, shape, f32) * scale
    x = jax.random.normal(ks[0], (BATCH, SEQ, D_MODEL), f32)
    mem = jax.random.normal(ks[1], (BATCH, MEM_LEN, D_MODEL), f32)
    norm_g = 1.0 + nrm(ks[2], (DEPTH, D_MODEL), 0.02)
    w_in = nrm(ks[3], (DEPTH, D_MODEL, IN_WIDTH), D_MODEL ** -0.5)
    ssd_conv_w = nrm(ks[4], (DEPTH, CONV_WIDTH, SSD_CONV_CH), CONV_WIDTH ** -0.5)
    ssd_conv_b = nrm(ks[5], (DEPTH, SSD_CONV_CH), 0.02)
    dt0 = jnp.exp(jax.random.uniform(ks[6], (DEPTH, SSD_HEADS), f32, math.log(1e-3), math.log(1e-1)))
    ssd_dt_bias = dt0 + jnp.log(-jnp.expm1(-dt0))
    ssd_a_log = jnp.log(jax.random.uniform(ks[7], (DEPTH, SSD_HEADS), f32, 1.0, 16.0))
    ssd_d = 1.0 + nrm(ks[8], (DEPTH, SSD_HEADS), 0.02)
    ssd_norm_g = 1.0 + nrm(ks[9], (DEPTH, SSD_GROUPS, SSD_WIDTH // SSD_GROUPS), 0.02)
    lru_conv_w = nrm(ks[10], (DEPTH, CONV_WIDTH, LRU_WIDTH), CONV_WIDTH ** -0.5)
    lru_conv_b = nrm(ks[11], (DEPTH, LRU_WIDTH), 0.02)
    lru_w_a = nrm(ks[12], (DEPTH, LRU_BLOCKS, LRU_BLOCK, LRU_BLOCK), LRU_BLOCK ** -0.5)
    lru_b_a = nrm(ks[13], (DEPTH, LRU_BLOCKS, LRU_BLOCK), 0.02)
    lru_w_x = nrm(ks[14], (DEPTH, LRU_BLOCKS, LRU_BLOCK, LRU_BLOCK), LRU_BLOCK ** -0.5)
    lru_b_x = nrm(ks[15], (DEPTH, LRU_BLOCKS, LRU_BLOCK), 0.02)
    a8 = jax.random.uniform(ks[16], (DEPTH, LRU_WIDTH), f32, 0.9, 0.999)
    sig = a8 ** (1.0 / LRU_C)
    lru_lambda = jnp.log(sig) - jnp.log1p(-sig)
    mem_norm_g = 1.0 + nrm(ks[17], (DEPTH, D_MODEL), 0.02)
    w_kv = nrm(ks[18], (DEPTH, D_MODEL, 2 * D_MODEL), D_MODEL ** -0.5)
    w_br_ssd = nrm(ks[19], (DEPTH, SSD_WIDTH, D_MODEL), SSD_WIDTH ** -0.5)
    w_br_lru = nrm(ks[20], (DEPTH, LRU_WIDTH, D_MODEL), LRU_WIDTH ** -0.5)
    w_br_mem = nrm(ks[21], (DEPTH, D_MODEL, D_MODEL), D_MODEL ** -0.5)
    w_out = nrm(ks[22], (DEPTH, D_MODEL, D_MODEL), D_MODEL ** -0.5)
    final_g = 1.0 + nrm(ks[23], (D_MODEL,), 0.02)
    return {"x": x, "mem": mem, "norm_g": norm_g, "w_in": w_in,
            "ssd_conv_w": ssd_conv_w, "ssd_conv_b": ssd_conv_b, "ssd_dt_bias": ssd_dt_bias,
            "ssd_a_log": ssd_a_log, "ssd_d": ssd_d, "ssd_norm_g": ssd_norm_g,
            "lru_conv_w": lru_conv_w, "lru_conv_b": lru_conv_b, "lru_w_a": lru_w_a,
            "lru_b_a": lru_b_a, "lru_w_x": lru_w_x, "lru_b_x": lru_b_x, "lru_lambda": lru_lambda,
            "mem_norm_g": mem_norm_g, "w_kv": w_kv, "w_br_ssd": w_br_ssd, "w_br_lru": w_br_lru,
            "w_br_mem": w_br_mem, "w_out": w_out, "final_g": final_g}


def reference(x, mem, norm_g, w_in, ssd_conv_w, ssd_conv_b, ssd_dt_bias, ssd_a_log, ssd_d,
              ssd_norm_g, lru_conv_w, lru_conv_b, lru_w_a, lru_b_a, lru_w_x, lru_b_x, lru_lambda,
              mem_norm_g, w_kv, w_br_ssd, w_br_lru, w_br_mem, w_out, final_g):
    bsz, s, _ = x.shape
    for l in range(DEPTH):
        h = rms_norm(x, norm_g[l])
        proj = h @ w_in[l]
        z, xbc, dt_raw, lru_gate, lru_x, q, gate_logits = jnp.split(proj, SPLIT_POINTS, axis=-1)

        xbc = jax.nn.silu(causal_dwconv(xbc, ssd_conv_w[l], ssd_conv_b[l]))
        xs, bs, cs = jnp.split(xbc, [SSD_WIDTH, SSD_WIDTH + SSD_GROUPS * SSD_STATE], axis=-1)
        xs = xs.reshape(bsz, s, SSD_HEADS, SSD_HEAD_DIM)
        dt = jax.nn.softplus((dt_raw + ssd_dt_bias[l]).astype(jnp.float32))
        y = ssd_scan(xs, dt, -jnp.exp(ssd_a_log[l].astype(jnp.float32)),
                     bs.reshape(bsz, s, SSD_GROUPS, SSD_STATE), cs.reshape(bsz, s, SSD_GROUPS, SSD_STATE))
        y = (y + xs.astype(jnp.float32) * ssd_d[l][:, None].astype(jnp.float32)).astype(x.dtype)
        y = y.reshape(bsz, s, SSD_WIDTH) * jax.nn.silu(z)
        y_ssd = rms_norm(y.reshape(bsz, s, SSD_GROUPS, SSD_WIDTH // SSD_GROUPS),
                         ssd_norm_g[l]).reshape(bsz, s, SSD_WIDTH)

        xl = causal_dwconv(lru_x, lru_conv_w[l], lru_conv_b[l])
        y_lru = rg_lru(xl, lru_w_a[l], lru_b_a[l], lru_w_x[l], lru_b_x[l], lru_lambda[l]) * jax.nn.silu(lru_gate)

        mem_n = rms_norm(mem, mem_norm_g[l])
        y_mem = memory_attention(q, mem_n, w_kv[l])

        gates = jax.nn.sigmoid(gate_logits).reshape(bsz, s, N_BRANCH, D_MODEL)
        merged = (gates[:, :, 0] * (y_ssd @ w_br_ssd[l])
                  + gates[:, :, 1] * (y_lru @ w_br_lru[l])
                  + gates[:, :, 2] * (y_mem @ w_br_mem[l]))
        x = x + merged @ w_out[l]
    return rms_norm(x, final_g)
```

```cpp
#define NAIVE_GEMM 0
#define NAIVE_ATT 0
#define NAIVE_LRU 0
#define NAIVE_SSD 0
#define ONE_LAUNCH 1
#include <hip/hip_runtime.h>
#include <hip/hip_cooperative_groups.h>
#include <cstdio>
#include <cstdint>
namespace cg = cooperative_groups;

#ifndef NAIVE_GEMM
#define NAIVE_GEMM 1
#endif
#ifndef NAIVE_SSD
#define NAIVE_SSD 1
#endif
#ifndef NAIVE_LRU
#define NAIVE_LRU 1
#endif
#ifndef NAIVE_ATT
#define NAIVE_ATT 1
#endif
#ifndef ONE_LAUNCH
#define ONE_LAUNCH 0
#endif

namespace pg8 {
#define PG8_LAS __attribute__((address_space(3)))
typedef unsigned short bf16_t;
typedef short bf16x8 __attribute__((ext_vector_type(8)));
typedef float f32x4 __attribute__((ext_vector_type(4)));
typedef unsigned u32x4 __attribute__((ext_vector_type(4)));
constexpr int BM = 256, BK = 64, HALF = 128, HTB = HALF * BK * 2  , STAGE_BYTES = 8 * HTB, NXCD = 8, WGM = 8;

__host__ __device__ __forceinline__ int lds_byte(int r, int c) { const int st = (r >> 4) * 2 + (c >> 5), rr = r & 15, cc = c & 31, ob = rr * 64 + cc * 2; return st * 1024 + (ob ^ (((ob >> 9) & 1) << 5)); }
__host__ __device__ __forceinline__ void stage_rc(int b, int& R, int& C) { const int st = b / 1024, sb = b % 1024, swz = sb ^ (((sb >> 9) & 1) << 5); R = (st >> 1) * 16 + swz / 64; C = (st & 1) * 32 + (swz % 64) / 2; }
__host__ __device__ __forceinline__ int perm32(int rho) { const int n = rho >> 4, i = rho & 15; return 8 * (i >> 2) + 4 * n + (i & 3); }

struct Unit { int pm, pn; };
struct Gemm { const bf16_t* A; const bf16_t* Bt; int M, N, K, lda, ldb; };

struct StaticOrder {
    int nM, nN, nwg, G, c;
    __host__ __device__ void init(int M, int N, int G_, int c_) { nM = M / BM; nN = N / BM; nwg = nM * nN; G = G_; c = c_; }
    __host__ __device__ bool next(int i, Unit& u) const {
        const long L = (long)i * G + c; if (L >= nwg) return false;
        int wgid = (int)L; { const int q = nwg / NXCD, r = nwg % NXCD, xcd = wgid % NXCD, off = wgid / NXCD; wgid = (xcd < r ? xcd * (q + 1) : r * (q + 1) + (xcd - r) * q) + off; }
        const int nig = WGM * nN, gid = wgid / nig, fm = gid * WGM, gsz = (nM - fm) < WGM ? (nM - fm) : WGM;
        u.pm = fm + ((wgid % nig) % gsz); u.pn = (wgid % nig) / gsz; return true;
    }
    __device__ __forceinline__ void a_ready(const Unit&) const {}
    __device__ __forceinline__ void done(const Unit&) const {}
};

__device__ __forceinline__ unsigned cvt_pk_bf16(float lo, float hi) { unsigned r; asm volatile("v_cvt_pk_bf16_f32 %0, %1, %2" : "=v"(r) : "v"(lo), "v"(hi)); return r; }
typedef float f32x2 __attribute__((ext_vector_type(2)));
__device__ __forceinline__ f32x2 gelu_pk(f32x2 v) {
    const f32x2 av = __builtin_elementwise_abs(v), d = av * 0.2316418882f + 1.0f;
    f32x2 t; t.x = __builtin_amdgcn_rcpf(d.x); t.y = __builtin_amdgcn_rcpf(d.y);
    f32x2 q = t * 0.5307027145f + (-0.7265760135f); q = q * t + 0.7107068705f; q = q * t + (-0.142248368f); q = q * t + 0.127414796f; q = q * t;
    const f32x2 s = (v * v) * (-0.72134752044f);
    f32x2 e; e.x = __builtin_amdgcn_exp2f(s.x); e.y = __builtin_amdgcn_exp2f(s.y);
    const f32x2 m = v * (q * e), r = v - m;
    f32x2 o; o.x = v.x < 0.f ? m.x : r.x; o.y = v.y < 0.f ? m.y : r.y; return o;
}

template <int ACT  > struct EpiBf16 {
    static constexpr bool PERM = true, AFTER_DRAIN = false; static_assert(ACT == 0 || ACT == 1, "EpiBf16: ACT is 0 (none) or 1 (gelu_pk)");
    bf16_t* O; int ldc; const float* bias; int split_cols; size_t split_stride; float scale0;
    __device__ __forceinline__ void operator()(const f32x4 (&acc)[2][2][4][2], const Unit& u, int wr, int wc, int fr, int fq) const {
        const int row0 = u.pm * BM + wr * 64 + fr; int colt = u.pn * BM; bf16_t* base = O;
        float sc = 1.f; if (split_cols) { const int t = colt / split_cols; base += (size_t)t * split_stride; colt -= t * split_cols; if (t == 0) sc = scale0; }
        const int col0 = colt + wc * 32 + 8 * fq, bcol0 = u.pn * BM + wc * 32 + 8 * fq;
        f32x4 bv[2][2];
#pragma unroll
        for (int bj = 0; bj < 2; ++bj)
#pragma unroll
            for (int n = 0; n < 2; ++n) bv[bj][n] = bias ? *(const f32x4*)(bias + bcol0 + bj * HALF + 4 * n) : (f32x4){0.f, 0.f, 0.f, 0.f};
#pragma unroll
        for (int ai = 0; ai < 2; ++ai)
#pragma unroll
            for (int m = 0; m < 4; ++m) { bf16_t* rowp = base + (size_t)(row0 + ai * HALF + m * 16) * ldc + col0;
#pragma unroll
                for (int bj = 0; bj < 2; ++bj) { f32x4 v0 = acc[ai][bj][m][0] + bv[bj][0], v1 = acc[ai][bj][m][1] + bv[bj][1];
                    if (ACT == 1) { f32x2 a = gelu_pk((f32x2){v0[0], v0[1]}), b = gelu_pk((f32x2){v0[2], v0[3]}), c = gelu_pk((f32x2){v1[0], v1[1]}), d = gelu_pk((f32x2){v1[2], v1[3]});
                        v0 = (f32x4){a.x, a.y, b.x, b.y}; v1 = (f32x4){c.x, c.y, d.x, d.y}; }
                    v0 = v0 * sc; v1 = v1 * sc; u32x4 w; w.x = cvt_pk_bf16(v0[0], v0[1]); w.y = cvt_pk_bf16(v0[2], v0[3]); w.z = cvt_pk_bf16(v1[0], v1[1]); w.w = cvt_pk_bf16(v1[2], v1[3]);
                    *(u32x4*)(rowp + bj * HALF) = w; } }
    }
};
template <class Epi, class Sched, bool ALIGN_EPI = false, bool SP2 = false>
__device__ __forceinline__ void gemm_phase(PG8_LAS unsigned char* lds, const Gemm g, const Sched& S, const Epi& E) {
    int tid_ = threadIdx.x; asm volatile("" : "+v"(tid_));
    const int tid = tid_, wid = __builtin_amdgcn_readfirstlane(tid >> 6), lane = tid & 63, wr = wid >> 2, wc = wid & 3, fr = lane & 15, fq = lane >> 4;
    const int K = g.K, nt = K / BK;
    unsigned voffA[2], voffB[2];
#pragma unroll
    for (int i = 0; i < 2; ++i) { int R, C; stage_rc(tid * 16 + i * 8192, R, C); const int Rb = Epi::PERM ? ((R & ~31) + perm32(R & 31)) : R;
        voffA[i] = (unsigned)(R * g.lda + C) * 2u; voffB[i] = (unsigned)(Rb * g.ldb + C) * 2u; }
    const size_t kstep = (size_t)(BK * 2);
    const size_t hstepA = (size_t)HALF * g.lda * 2, hstepB = (size_t)HALF * g.ldb * 2;
    const size_t tstepA = 2 * hstepA, tstepB = 2 * hstepB;
    const unsigned ldsw = (unsigned)wid * 1024u;
    const int aoff = lds_byte(wr * 64 + fr, fq * 8), boff = lds_byte(wc * 32 + fr, fq * 8);
#define PG8_SA(b, h) (((b) * 2 + (h)) * HTB)
#define PG8_SB(b, h) ((4 + (b) * 2 + (h)) * HTB)
#define PG8_STAGE(bufoff, gbase, voff) do { _Pragma("unroll") for (int _i = 0; _i < 2; ++_i) \
        __builtin_amdgcn_global_load_lds((const unsigned*)((const char*)(gbase) + (voff)[_i]), (PG8_LAS unsigned*)(lds + (bufoff) + ldsw + _i * 8192), 16, 0, 0); } while (0)
#define PG8_LDA(dst, b, h) do { _Pragma("unroll") for (int m = 0; m < 4; ++m) _Pragma("unroll") for (int k = 0; k < 2; ++k) dst[m][k] = *(const PG8_LAS bf16x8*)(lds + PG8_SA(b, h) + aoff + m * 2048 + k * 1024); } while (0)
#define PG8_LDB(dst, b, h) do { _Pragma("unroll") for (int n = 0; n < 2; ++n) _Pragma("unroll") for (int k = 0; k < 2; ++k) dst[n][k] = *(const PG8_LAS bf16x8*)(lds + PG8_SB(b, h) + boff + n * 2048 + k * 1024); } while (0)
#define PG8_MMA(ai, bj, At, Bt) do { __builtin_amdgcn_s_setprio(1); _Pragma("unroll") for (int m = 0; m < 4; ++m) _Pragma("unroll") for (int n = 0; n < 2; ++n) _Pragma("unroll") for (int k = 0; k < 2; ++k) \
        acc[ai][bj][m][n] = __builtin_amdgcn_mfma_f32_16x16x32_bf16(Bt[n][k], At[m][k], acc[ai][bj][m][n], 0, 0, 0); __builtin_amdgcn_s_setprio(0); } while (0)
#define PG8_WAIT_V(n) asm volatile("s_waitcnt vmcnt(" #n ")" ::: "memory")
#define PG8_WAIT_L(n) asm volatile("s_waitcnt lgkmcnt(" #n ")" ::: "memory")
#define PG8_BAR __builtin_amdgcn_s_barrier()
#define PG8_SCHED __builtin_amdgcn_sched_barrier(0)
    Unit cur, nxt; int ui = 0;
    if (!S.next(0, cur)) return;
    f32x4 acc[2][2][4][2];
#pragma unroll
    for (int a = 0; a < 2; ++a)
#pragma unroll
        for (int b = 0; b < 2; ++b)
#pragma unroll
            for (int m = 0; m < 4; ++m)
#pragma unroll
                for (int n = 0; n < 2; ++n) acc[a][b][m][n] = (f32x4){0.f, 0.f, 0.f, 0.f};
    bf16x8 At[4][2], B0[2][2], B1[2][2];
    const char* cA = (const char*)g.A + (size_t)cur.pm * tstepA; const char* cB = (const char*)g.Bt + (size_t)cur.pn * tstepB;
    S.a_ready(cur);
    if constexpr (SP2) {
        PG8_STAGE(PG8_SB(0, 0), cB, voffB); PG8_STAGE(PG8_SB(0, 1), cB + hstepB, voffB); PG8_STAGE(PG8_SA(0, 0), cA, voffA); PG8_STAGE(PG8_SA(0, 1), cA + hstepA, voffA);
        if (wr == 1) PG8_BAR;
        PG8_WAIT_V(2); PG8_BAR;
        PG8_STAGE(PG8_SB(1, 0), cB + kstep, voffB); PG8_STAGE(PG8_SA(1, 0), cA + kstep, voffA); PG8_STAGE(PG8_SB(1, 1), cB + hstepB + kstep, voffB);
        PG8_WAIT_V(6); PG8_BAR;
    } else {
        PG8_STAGE(PG8_SB(0, 0), cB, voffB); PG8_STAGE(PG8_SA(0, 0), cA, voffA); PG8_STAGE(PG8_SB(0, 1), cB + hstepB, voffB); PG8_STAGE(PG8_SA(0, 1), cA + hstepA, voffA);
        if (wr == 1) PG8_BAR;
        PG8_WAIT_V(4); PG8_BAR;
        PG8_STAGE(PG8_SB(1, 0), cB + kstep, voffB); PG8_STAGE(PG8_SA(1, 0), cA + kstep, voffA); PG8_STAGE(PG8_SB(1, 1), cB + hstepB + kstep, voffB);
        PG8_WAIT_V(6); PG8_BAR;
    }
    for (;;) {
        const bool has_next = S.next(ui + 1, nxt);
        const char* nA = has_next ? (const char*)g.A + (size_t)nxt.pm * tstepA : cA; const char* nB = has_next ? (const char*)g.Bt + (size_t)nxt.pn * tstepB : cB;
        for (int t = 0; t < nt; t += 2) {
            const bool last = (t == nt - 2);
            const char* a1 = cA + (size_t)(t + 1) * kstep;
            const char* a2 = last ? nA : cA + (size_t)(t + 2) * kstep; const char* b2 = last ? nB : cB + (size_t)(t + 2) * kstep;
            const char* a3 = a2 + kstep; const char* b3 = b2 + kstep;
            if (last && has_next) S.a_ready(nxt);
            if constexpr (SP2) {
            PG8_LDB(B0, 0, 0); PG8_LDB(B1, 0, 1); PG8_SCHED; PG8_LDA(At, 0, 0); PG8_STAGE(PG8_SA(1, 1), a1 + hstepA, voffA);
            PG8_WAIT_V(8); PG8_WAIT_L(0); PG8_BAR; PG8_MMA(0, 0, At, B0); PG8_MMA(0, 1, At, B1); PG8_BAR; PG8_SCHED;
            PG8_LDA(At, 0, 1); PG8_STAGE(PG8_SB(0, 0), b2, voffB); PG8_STAGE(PG8_SB(0, 1), b2 + hstepB, voffB); PG8_STAGE(PG8_SA(0, 0), a2, voffA);
            PG8_WAIT_V(8); PG8_WAIT_L(0); PG8_BAR; PG8_MMA(1, 0, At, B0); PG8_MMA(1, 1, At, B1); PG8_BAR; PG8_SCHED;
            PG8_LDB(B0, 1, 0); PG8_LDB(B1, 1, 1); PG8_SCHED; PG8_LDA(At, 1, 0); PG8_STAGE(PG8_SA(0, 1), a2 + hstepA, voffA);
            PG8_WAIT_V(8); PG8_WAIT_L(0); PG8_BAR; PG8_MMA(0, 0, At, B0); PG8_MMA(0, 1, At, B1); PG8_BAR; PG8_SCHED;
            PG8_LDA(At, 1, 1); PG8_STAGE(PG8_SB(1, 0), b3, voffB); PG8_STAGE(PG8_SB(1, 1), b3 + hstepB, voffB); PG8_STAGE(PG8_SA(1, 0), a3, voffA);
            PG8_WAIT_V(8); PG8_WAIT_L(0); PG8_BAR; PG8_MMA(1, 0, At, B0); PG8_MMA(1, 1, At, B1); PG8_BAR; PG8_SCHED;
            } else {
            PG8_LDB(B0, 0, 0); PG8_SCHED; PG8_LDA(At, 0, 0); PG8_STAGE(PG8_SA(1, 1), a1 + hstepA, voffA);
            PG8_WAIT_L(8); PG8_BAR; PG8_WAIT_L(0); PG8_MMA(0, 0, At, B0); PG8_BAR; PG8_SCHED;
            PG8_LDB(B1, 0, 1); PG8_STAGE(PG8_SB(0, 0), b2, voffB);
            PG8_BAR; PG8_WAIT_L(0); PG8_MMA(0, 1, At, B1); PG8_BAR;
            PG8_LDA(At, 0, 1); PG8_STAGE(PG8_SA(0, 0), a2, voffA);
            PG8_BAR; PG8_WAIT_L(0); PG8_MMA(1, 0, At, B0); PG8_BAR; PG8_SCHED;
            PG8_STAGE(PG8_SB(0, 1), b2 + hstepB, voffB);
            PG8_WAIT_V(6); PG8_BAR; PG8_MMA(1, 1, At, B1); PG8_BAR;
            PG8_LDB(B0, 1, 0); PG8_SCHED; PG8_LDA(At, 1, 0); PG8_STAGE(PG8_SA(0, 1), a2 + hstepA, voffA);
            PG8_WAIT_L(8); PG8_BAR; PG8_WAIT_L(0); PG8_MMA(0, 0, At, B0); PG8_BAR; PG8_SCHED;
            PG8_LDB(B1, 1, 1); PG8_STAGE(PG8_SB(1, 0), b3, voffB);
            PG8_BAR; PG8_WAIT_L(0); PG8_MMA(0, 1, At, B1); PG8_BAR;
            PG8_LDA(At, 1, 1); PG8_STAGE(PG8_SA(1, 0), a3, voffA);
            PG8_BAR; PG8_WAIT_L(0); PG8_MMA(1, 0, At, B0); PG8_BAR; PG8_SCHED;
            PG8_STAGE(PG8_SB(1, 1), b3 + hstepB, voffB);
            PG8_WAIT_V(6); PG8_BAR; PG8_MMA(1, 1, At, B1); PG8_BAR;
            }
        }
        if constexpr (ALIGN_EPI) { if (wr == 0) PG8_BAR; }
        if constexpr (!Epi::AFTER_DRAIN) { E(acc, cur, wr, wc, fr, fq); S.done(cur); }
        if (!has_next) break;
#pragma unroll
        for (int a = 0; a < 2; ++a)
#pragma unroll
            for (int b = 0; b < 2; ++b)
#pragma unroll
                for (int m = 0; m < 4; ++m)
#pragma unroll
                    for (int n = 0; n < 2; ++n) acc[a][b][m][n] = (f32x4){0.f, 0.f, 0.f, 0.f};
        cur = nxt; cA = nA; cB = nB; ++ui;
        if constexpr (ALIGN_EPI) { if (wr == 1) PG8_BAR; }
    }
    PG8_WAIT_V(0);
    if constexpr (!ALIGN_EPI) { if (wr == 0) PG8_BAR; }
    PG8_BAR;
    if constexpr (Epi::AFTER_DRAIN) { E.fused(acc, cur, wr, wc, fr, fq, lds, wid, lane); S.done(cur); }
#undef PG8_SA
#undef PG8_SB
#undef PG8_STAGE
#undef PG8_LDA
#undef PG8_LDB
#undef PG8_MMA
#undef PG8_WAIT_V
#undef PG8_WAIT_L
#undef PG8_BAR
#undef PG8_SCHED
}
}

#define GAS __attribute__((address_space(1)))
#define LAS __attribute__((address_space(3)))
typedef unsigned short bf16_t;
typedef short bf16x8 __attribute__((ext_vector_type(8)));
typedef float f32x4 __attribute__((ext_vector_type(4)));
typedef unsigned u32x4 __attribute__((ext_vector_type(4)));
typedef unsigned u32x2 __attribute__((ext_vector_type(2)));

constexpr int DM = 1024, NBATCH = 2, SEQ = 8192, MEML = 256, MTOK = NBATCH * SEQ;
constexpr int INW = 12320, LD = 12544;
constexpr int C_Z = 0, C_X = 2048, C_B = 4096, C_C = 4608, C_LG = 5120, C_LX = 6656, C_Q = 8192, C_G = 9216, C_DT = 12288;
constexpr int C_MRG = 2048;
constexpr int NHEAD = 32, HDIM = 64, NGRP = 4, NSTATE = 128, CHUNK = 128, NCHUNK = SEQ / CHUNK;
constexpr int LRUW = 1536, LRUB = 96, NLB = 16, LSEG = 512, NSEG = SEQ / LSEG;
constexpr float EPS = 1e-6f;
constexpr size_t MiB = 1u << 20;
constexpr size_t WS_WIN = 0, WS_WKV = 25 * MiB, WS_WSSD = 29 * MiB, WS_WLRU = 33 * MiB, WS_WMEM = 36 * MiB, WS_WOUT = 38 * MiB;
constexpr size_t WS_PROJ = 40 * MiB;
constexpr size_t WS_MEMN = 236 * MiB, WS_KVK = 237 * MiB, WS_KVVT = 238 * MiB, WS_LRUWA = 239 * MiB, WS_LRUWX = 239 * MiB + 512 * 1024;
constexpr size_t WS_DASUM = 240 * MiB;
constexpr size_t WS_LAGG = 241 * MiB;
constexpr size_t WS_LCAR = 242 * MiB;
constexpr size_t WS_END = 256 * MiB;
static_assert(WS_PROJ + (size_t)SEQ * LD * 2 <= WS_MEMN, "ws map");
constexpr int LDS_BYTES = 147456;

struct Params {
    const float *x, *mem, *norm_g, *w_in, *ssd_conv_w, *ssd_conv_b, *ssd_dt_bias, *ssd_a_log, *ssd_d, *ssd_norm_g,
        *lru_conv_w, *lru_conv_b, *lru_w_a, *lru_b_a, *lru_w_x, *lru_b_x, *lru_lambda, *mem_norm_g, *w_kv,
        *w_br_ssd, *w_br_lru, *w_br_mem, *w_out, *final_g;
    float* out; unsigned char* ws;
    int lo, hi;
};

__device__ __forceinline__ float bf2f(bf16_t v) { return __uint_as_float((unsigned)v << 16); }
__device__ __forceinline__ unsigned f2bf(float f) { unsigned u = __float_as_uint(f); return (u + 0x7fffu + ((u >> 16) & 1u)) >> 16; }
__device__ __forceinline__ unsigned pk2(float lo, float hi) { return f2bf(lo) | (f2bf(hi) << 16); }
__device__ __forceinline__ float sigmoidf_(float v) { return 1.f / (1.f + __expf(-v)); }
__device__ __forceinline__ float siluf_(float v) { return v / (1.f + __expf(-v)); }
__device__ __forceinline__ float softplusf_(float v) { return v > 20.f ? v : log1pf(__expf(v)); }
__device__ __forceinline__ float wave_sum(float v) {
#pragma unroll
    for (int o = 1; o < 64; o <<= 1) v += __shfl_xor(v, o);
    return v;
}
template <class T> __device__ __forceinline__ T* opq(T* q) { asm volatile("" : "+s"(q)); return q; }
__device__ __forceinline__ int opq_tid() { int t = threadIdx.x; asm volatile("" : "+v"(t)); return t; }
__device__ __forceinline__ int opq_bid() { int t = blockIdx.x; asm volatile("" : "+s"(t)); return t; }
__device__ __forceinline__ unsigned char* wsb(const Params& p) { return opq(p.ws); }
__device__ __forceinline__ bf16_t* proj_ptr(const Params& p) { return (bf16_t*)(wsb(p) + WS_PROJ); }
__device__ __forceinline__ bf16_t* xn_ptr(const Params& p) { return (bf16_t*)((unsigned char*)opq(p.out) + 32 * MiB); }
__device__ __forceinline__ bf16_t* states_ptr(const Params& p, int b) { return (bf16_t*)((unsigned char*)opq(p.out) + (size_t)b * 32 * MiB); }
__device__ __forceinline__ float* scr_ptr(const Params& p, int b) { return (float*)((unsigned char*)opq(p.out) + (size_t)b * 32 * MiB); }

__device__ __forceinline__ void transpose_item(const float* W, int K, int Ns, int srccol0, bf16_t* WT, int dstrow0, LAS float* scr, int k0, int lane) {
#pragma unroll 8
    for (int i = 0; i < 32; ++i) { const int kk = 2 * i + (lane >> 5); scr[kk * 33 + (lane & 31)] = W[(size_t)(k0 + kk) * Ns + srccol0 + (lane & 31)]; }
    asm volatile("s_waitcnt lgkmcnt(0)" ::: "memory");
    const int c = lane & 7;
#pragma unroll
    for (int j = 0; j < 4; ++j) { const int n = (lane >> 3) + 8 * j; const LAS float* s = scr + (8 * c) * 33 + n;
        u32x4 o; o.x = pk2(s[0 * 33], s[1 * 33]); o.y = pk2(s[2 * 33], s[3 * 33]); o.z = pk2(s[4 * 33], s[5 * 33]); o.w = pk2(s[6 * 33], s[7 * 33]);
        *(u32x4*)(WT + (size_t)(dstrow0 + n) * K + k0 + 8 * c) = o; }
    asm volatile("s_waitcnt lgkmcnt(0)" ::: "memory");
}
__device__ __forceinline__ void rms_row_to_bf16(const float* xrow, const float* g, bf16_t* orow, int lane) {
    const f32x4* xr = (const f32x4*)xrow + lane; const f32x4* gr = (const f32x4*)g + lane;
    f32x4 v[4]; float s = 0.f;
#pragma unroll
    for (int j = 0; j < 4; ++j) { v[j] = xr[64 * j]; s += (v[j].x * v[j].x + v[j].y * v[j].y) + (v[j].z * v[j].z + v[j].w * v[j].w); }
    const float rs = 1.f / sqrtf(wave_sum(s) * (1.f / DM) + EPS);
    unsigned long long* o8 = (unsigned long long*)orow + lane;
#pragma unroll
    for (int j = 0; j < 4; ++j) { const f32x4 gg = gr[64 * j];
        o8[64 * j] = (unsigned long long)pk2(v[j].x * rs * gg.x, v[j].y * rs * gg.y) | ((unsigned long long)pk2(v[j].z * rs * gg.z, v[j].w * rs * gg.w) << 32); }
}
__device__ __forceinline__ void phase0(const Params& p, LAS unsigned char* lds) {
    const int tid = opq_tid(), lane = tid & 63, wave = tid >> 6, bid = opq_bid();
    const int gw = bid * 8 + wave, NGW = gridDim.x * 8;
    LAS float* scr = (LAS float*)(lds + wave * 8704);
    bf16_t* Win = (bf16_t*)(wsb(p) + WS_WIN); bf16_t* Wkv = (bf16_t*)(wsb(p) + WS_WKV); bf16_t* Wssd = (bf16_t*)(wsb(p) + WS_WSSD);
    bf16_t* Wlru = (bf16_t*)(wsb(p) + WS_WLRU); bf16_t* Wmem = (bf16_t*)(wsb(p) + WS_WMEM); bf16_t* Wout = (bf16_t*)(wsb(p) + WS_WOUT);
    constexpr int I_IN = 16 * 385, I_KV = 16 * 64, I_SSD = 32 * 32, I_LRU = 24 * 32, I_MEM = 16 * 32, I_OUT = 16 * 32;
    constexpr int NITEMS = I_IN + I_KV + I_SSD + I_LRU + I_MEM + I_OUT;
    for (int it = gw; it < NITEMS; it += NGW) {
        int r = it;
        if (r < I_IN) { const int nb = r % 385, kb = r / 385; const int sc = 32 * nb; int dr;
            if (sc < 5120) dr = sc; else if (sc < 5152) dr = sc - 5120 + C_DT; else dr = sc - 32;
            transpose_item(opq(p.w_in), 1024, INW, sc, Win, dr, scr, 64 * kb, lane); continue; } r -= I_IN;
        if (r < I_KV) { transpose_item(opq(p.w_kv), 1024, 2048, 32 * (r % 64), Wkv, 32 * (r % 64), scr, 64 * (r / 64), lane); continue; } r -= I_KV;
        if (r < I_SSD) { transpose_item(opq(p.w_br_ssd), 2048, 1024, 32 * (r % 32), Wssd, 32 * (r % 32), scr, 64 * (r / 32), lane); continue; } r -= I_SSD;
        if (r < I_LRU) { transpose_item(opq(p.w_br_lru), 1536, 1024, 32 * (r % 32), Wlru, 32 * (r % 32), scr, 64 * (r / 32), lane); continue; } r -= I_LRU;
        if (r < I_MEM) { transpose_item(opq(p.w_br_mem), 1024, 1024, 32 * (r % 32), Wmem, 32 * (r % 32), scr, 64 * (r / 32), lane); continue; } r -= I_MEM;
        transpose_item(opq(p.w_out), 1024, 1024, 32 * (r % 32), Wout, 32 * (r % 32), scr, 64 * (r / 32), lane);
    }
    { const int gt = bid * 512 + tid, NT = gridDim.x * 512; u32x4* z = (u32x4*)(Win + (size_t)INW * 1024);
      for (int i = gt; i < (LD - INW) * 1024 / 8; i += NT) z[i] = (u32x4){0u, 0u, 0u, 0u}; }
    { const int gt = bid * 512 + tid, NT = gridDim.x * 512; bf16_t* wa = (bf16_t*)(wsb(p) + WS_LRUWA); bf16_t* wx = (bf16_t*)(wsb(p) + WS_LRUWX);
      for (int e = gt; e < NLB * LRUB * LRUB; e += NT) { const int n = e / (LRUB * LRUB), r2 = e % (LRUB * LRUB), j = r2 / LRUB, i = r2 % LRUB;
          wa[e] = (bf16_t)f2bf(opq(p.lru_w_a)[(n * LRUB + i) * LRUB + j]); wx[e] = (bf16_t)f2bf(opq(p.lru_w_x)[(n * LRUB + i) * LRUB + j]); } }
    bf16_t* XN = xn_ptr(p); bf16_t* MN = (bf16_t*)(wsb(p) + WS_MEMN);
    for (int m = gw; m < MTOK; m += NGW) rms_row_to_bf16(opq(p.x) + (size_t)m * DM, opq(p.norm_g), XN + (size_t)m * DM, lane);
    for (int m = gw; m < NBATCH * MEML; m += NGW) rms_row_to_bf16(opq(p.mem) + (size_t)m * DM, opq(p.mem_norm_g), MN + (size_t)m * DM, lane);
}
__device__ __forceinline__ void phase7(const Params& p) {
    const int tid = opq_tid(), lane = tid & 63, wave = tid >> 6; const int gw = opq_bid() * 8 + wave, NGW = gridDim.x * 8; float* outb = opq(p.out); const float* fg = opq(p.final_g);
    for (int m = gw; m < MTOK; m += NGW) {
        f32x4* xr = (f32x4*)(outb + (size_t)m * DM) + lane; const f32x4* gr = (const f32x4*)fg + lane;
        f32x4 v[4]; float s = 0.f;
#pragma unroll
        for (int j = 0; j < 4; ++j) { v[j] = xr[64 * j]; s += (v[j].x * v[j].x + v[j].y * v[j].y) + (v[j].z * v[j].z + v[j].w * v[j].w); }
        const float rs = 1.f / sqrtf(wave_sum(s) * (1.f / DM) + EPS);
#pragma unroll
        for (int j = 0; j < 4; ++j) { const f32x4 gg = gr[64 * j]; xr[64 * j] = v[j] * rs * gg; }
    }
}
__device__ __forceinline__ float dot8(u32x4 a, u32x4 b) {
    float s = 0.f;
#pragma unroll
    for (int i = 0; i < 4; ++i) { s += __uint_as_float(a[i] << 16) * __uint_as_float(b[i] << 16); s += __uint_as_float(a[i] & 0xffff0000u) * __uint_as_float(b[i] & 0xffff0000u); }
    return s;
}
template <int MODE> __global__ void __launch_bounds__(256) n_gemm(const bf16_t* A, int lda, const bf16_t* Bt, int ldb, int K, int N, bf16_t* C, int ldc,
                                                               const bf16_t* gate, int ldg, float* scr, int first, int last, const float* xres, float* outp) {
    const int n = blockIdx.x * 256 + threadIdx.x, m = blockIdx.y; if (n >= N) return;
    const u32x4* a = (const u32x4*)(A + (size_t)m * lda); const u32x4* b = (const u32x4*)(Bt + (size_t)n * ldb);
    float acc = 0.f;
    for (int k8 = 0; k8 < K / 8; ++k8) acc += dot8(a[k8], b[k8]);
    if (MODE == 0) C[(size_t)m * ldc + n] = (bf16_t)f2bf(acc);
    if (MODE == 1) { float v = sigmoidf_(bf2f(gate[(size_t)m * ldg + n])) * acc; if (!first) v += scr[(size_t)m * 1024 + n];
        if (last) C[(size_t)m * ldc + n] = (bf16_t)f2bf(v); else scr[(size_t)m * 1024 + n] = v; }
    if (MODE == 2) outp[(size_t)m * 1024 + n] = xres[(size_t)m * 1024 + n] + acc;
}
__global__ void __launch_bounds__(512) n_ssd(Params p, int b) {
    __shared__ float sB[128], sC[128], sred[8];
    bf16_t* P = proj_ptr(p); const int g = blockIdx.x, tid = threadIdx.x, hh = tid >> 6, pp = tid & 63, h = g * 8 + hh, lane = tid & 63;
    float st[128];
#pragma unroll
    for (int n = 0; n < 128; ++n) st[n] = 0.f;
    const int xc = h * 64 + pp;
    const float xw0 = p.ssd_conv_w[0 * 3072 + xc], xw1 = p.ssd_conv_w[1 * 3072 + xc], xw2 = p.ssd_conv_w[2 * 3072 + xc], xw3 = p.ssd_conv_w[3 * 3072 + xc], xb = p.ssd_conv_b[xc];
    const int bc = 2048 + (tid < 128 ? g * 128 + tid : 512 + g * 128 + (tid - 128));
    float bw0 = 0, bw1 = 0, bw2 = 0, bw3 = 0, bb = 0;
    if (tid < 256) { bw0 = p.ssd_conv_w[bc]; bw1 = p.ssd_conv_w[3072 + bc]; bw2 = p.ssd_conv_w[2 * 3072 + bc]; bw3 = p.ssd_conv_w[3 * 3072 + bc]; bb = p.ssd_conv_b[bc]; }
    float x1 = 0, x2 = 0, x3 = 0, c1 = 0, c2 = 0, c3 = 0;
    const float dtb = p.ssd_dt_bias[h], an = -__expf(p.ssd_a_log[h]), Dh = p.ssd_d[h], ng = p.ssd_norm_g[g * 512 + hh * 64 + pp];
    for (int t = 0; t < SEQ; ++t) {
        const bf16_t* row = P + (size_t)t * LD;
        const float xr = bf2f(row[C_X + xc]);
        const float xv = siluf_(xb + xw0 * x3 + xw1 * x2 + xw2 * x1 + xw3 * xr); x3 = x2; x2 = x1; x1 = xr;
        if (tid < 256) { const float cr = bf2f(row[C_X + bc]); const float v = siluf_(bb + bw0 * c3 + bw1 * c2 + bw2 * c1 + bw3 * cr); c3 = c2; c2 = c1; c1 = cr;
            if (tid < 128) sB[tid] = v; else sC[tid - 128] = v; }
        const float dt = softplusf_(bf2f(row[C_DT + h]) + dtb), dA = __expf(dt * an), zv = bf2f(row[C_Z + xc]);
        __syncthreads();
        float y = 0.f; const float dx = dt * xv;
#pragma unroll
        for (int n = 0; n < 128; ++n) { st[n] = st[n] * dA + sB[n] * dx; y += sC[n] * st[n]; }
        y = (y + Dh * xv) * siluf_(zv);
        float s = wave_sum(y * y);
        if (lane == 0) sred[hh] = s;
        __syncthreads();
        float tot = 0.f;
#pragma unroll
        for (int i = 0; i < 8; ++i) tot += sred[i];
        ((bf16_t*)row)[C_Z + xc] = (bf16_t)f2bf(y * (1.f / sqrtf(tot * (1.f / 512.f) + EPS)) * ng);
        __syncthreads();
    }
}
__global__ void __launch_bounds__(96) n_lru(Params p, int b) {
    __shared__ float sx[96];
    bf16_t* P = proj_ptr(p); const int n = blockIdx.x, j = threadIdx.x, ch = n * 96 + j;
    const float w0 = p.lru_conv_w[ch], w1 = p.lru_conv_w[1536 + ch], w2 = p.lru_conv_w[2 * 1536 + ch], w3 = p.lru_conv_w[3 * 1536 + ch], cb = p.lru_conv_b[ch];
    const float ba = p.lru_b_a[ch], bx = p.lru_b_x[ch], sp = softplusf_(-p.lru_lambda[ch]);
    const float* wa = p.lru_w_a + (size_t)n * 96 * 96 + j; const float* wx = p.lru_w_x + (size_t)n * 96 * 96 + j;
    float x1 = 0, x2 = 0, x3 = 0, h = 0.f;
    for (int t = 0; t < SEQ; ++t) {
        bf16_t* row = P + (size_t)t * LD;
        const float xr = bf2f(row[C_LX + ch]); const float xl = cb + w0 * x3 + w1 * x2 + w2 * x1 + w3 * xr; x3 = x2; x2 = x1; x1 = xr;
        sx[j] = xl; __syncthreads();
        float ra = ba, ri = bx;
        for (int i = 0; i < 96; ++i) { const float xi = sx[i]; ra += xi * wa[i * 96]; ri += xi * wx[i * 96]; }
        const float r = sigmoidf_(ra), ig = sigmoidf_(ri), la = -8.f * r * sp, a = __expf(la), mult = sqrtf(fmaxf(0.f, 1.f - __expf(2.f * la)));
        h = a * h + mult * ig * xl;
        row[C_LG + ch] = (bf16_t)f2bf(h * siluf_(bf2f(row[C_LG + ch])));
        __syncthreads();
    }
}
__global__ void __launch_bounds__(256) n_attn(Params p, int b) {
    __shared__ float sq[256], sp[256], sred[4];
    bf16_t* P = proj_ptr(p); const bf16_t* KK = (const bf16_t*)(p.ws + WS_KVK); const bf16_t* VT = (const bf16_t*)(p.ws + WS_KVVT);
    const int t = blockIdx.x >> 2, hd = blockIdx.x & 3, tid = threadIdx.x, lane = tid & 63, w = tid >> 6;
    bf16_t* qrow = P + (size_t)t * LD + C_Q + hd * 256;
    sq[tid] = bf2f(qrow[tid]); __syncthreads();
    const bf16_t* kr = KK + (size_t)(b * 256 + tid) * 1024 + hd * 256; float s = 0.f;
    for (int d = 0; d < 256; ++d) s += sq[d] * bf2f(kr[d]);
    s *= 0.0625f;
    float m = s;
#pragma unroll
    for (int o = 1; o < 64; o <<= 1) m = fmaxf(m, __shfl_xor(m, o));
    if (lane == 0) sred[w] = m; __syncthreads();
    m = fmaxf(fmaxf(sred[0], sred[1]), fmaxf(sred[2], sred[3])); __syncthreads();
    const float e = __expf(s - m); sp[tid] = e; const float es = wave_sum(e);
    if (lane == 0) sred[w] = es; __syncthreads();
    const float tot = sred[0] + sred[1] + sred[2] + sred[3];
    const bf16_t* vr = VT + (size_t)(hd * 256 + tid) * 512 + b * 256; float o = 0.f;
    for (int mm = 0; mm < 256; ++mm) o += sp[mm] * bf2f(vr[mm]);
    qrow[tid] = (bf16_t)f2bf(o / tot);
}
namespace pg8 {
template <int BR> struct EpiMerge {
    static constexpr bool PERM = true, AFTER_DRAIN = false;
    bf16_t* P; float* scr;
    __device__ __forceinline__ void operator()(const f32x4 (&acc)[2][2][4][2], const Unit& u, int wr, int wc, int fr, int fq) const {
        const int row0 = u.pm * BM + wr * 64 + fr, col0 = u.pn * BM + wc * 32 + 8 * fq;
#pragma unroll
        for (int ai = 0; ai < 2; ++ai)
#pragma unroll
            for (int m = 0; m < 4; ++m) { const size_t r = (size_t)(row0 + ai * HALF + m * 16);
#pragma unroll
                for (int bj = 0; bj < 2; ++bj) { const int c = col0 + bj * HALF;
                    const u32x4 gw = *(const u32x4*)(P + r * 12544 + 9216 + BR * 1024 + c);
                    float g[8];
#pragma unroll
                    for (int i = 0; i < 4; ++i) { g[2 * i] = __uint_as_float(gw[i] << 16); g[2 * i + 1] = __uint_as_float(gw[i] & 0xffff0000u); }
                    f32x4 v0 = acc[ai][bj][m][0], v1 = acc[ai][bj][m][1];
#pragma unroll
                    for (int i = 0; i < 4; ++i) { v0[i] *= 1.f / (1.f + __expf(-g[i])); v1[i] *= 1.f / (1.f + __expf(-g[4 + i])); }
                    float* sp = scr + r * 1024 + c;
                    if (BR > 0) { v0 += *(const f32x4*)sp; v1 += *(const f32x4*)(sp + 4); }
                    if (BR < 2) { *(f32x4*)sp = v0; *(f32x4*)(sp + 4) = v1; }
                    else { u32x4 w; w.x = cvt_pk_bf16(v0[0], v0[1]); w.y = cvt_pk_bf16(v0[2], v0[3]); w.z = cvt_pk_bf16(v1[0], v1[1]); w.w = cvt_pk_bf16(v1[2], v1[3]);
                        *(u32x4*)(P + r * 12544 + 2048 + c) = w; } } }
    }
};
struct EpiOut {
    static constexpr bool PERM = false, AFTER_DRAIN = false;
    const float* xres; float* out;
    __device__ __forceinline__ void operator()(const f32x4 (&acc)[2][2][4][2], const Unit& u, int wr, int wc, int fr, int fq) const {
        const int row0 = u.pm * BM + wr * 64 + fr, col0 = u.pn * BM + wc * 32 + 4 * fq;
#pragma unroll
        for (int ai = 0; ai < 2; ++ai)
#pragma unroll
            for (int m = 0; m < 4; ++m) { const size_t off = (size_t)(row0 + ai * HALF + m * 16) * 1024 + col0;
#pragma unroll
                for (int bj = 0; bj < 2; ++bj)
#pragma unroll
                    for (int n = 0; n < 2; ++n) *(f32x4*)(out + off + bj * HALF + n * 16) = *(const f32x4*)(xres + off + bj * HALF + n * 16) + acc[ai][bj][m][n]; }
    }
};
}
#define PG8_SP2 true
#define PG8_ALIGN true

__device__ __forceinline__ void phase1_gemm(const Params& p, int b, LAS unsigned char* lds) {
    const int G = gridDim.x, c = opq_bid();
    { pg8::Gemm g{xn_ptr(p) + (size_t)b * SEQ * DM, (const bf16_t*)(wsb(p) + WS_WIN), SEQ, LD, DM, DM, DM}; pg8::StaticOrder S; S.init(SEQ, LD, G, c);
      pg8::EpiBf16<0> E{proj_ptr(p), LD, nullptr, 0, 0, 1.f};
      pg8::gemm_phase<pg8::EpiBf16<0>, pg8::StaticOrder, PG8_ALIGN, PG8_SP2>(lds, g, S, E); }
    if (b == 0) {
        { pg8::Gemm g{(const bf16_t*)(wsb(p) + WS_MEMN), (const bf16_t*)(wsb(p) + WS_WKV), 512, 1024, DM, DM, DM}; pg8::StaticOrder S; S.init(512, 1024, G, (c + 16) % G);
          pg8::EpiBf16<0> E{(bf16_t*)(wsb(p) + WS_KVK), 1024, nullptr, 0, 0, 1.f};
          pg8::gemm_phase<pg8::EpiBf16<0>, pg8::StaticOrder, PG8_ALIGN, PG8_SP2>(lds, g, S, E); }
        { pg8::Gemm g{(const bf16_t*)(wsb(p) + WS_WKV) + (size_t)1024 * DM, (const bf16_t*)(wsb(p) + WS_MEMN), 1024, 512, DM, DM, DM}; pg8::StaticOrder S; S.init(1024, 512, G, (c + 8) % G);
          pg8::EpiBf16<0> E{(bf16_t*)(wsb(p) + WS_KVVT), 512, nullptr, 0, 0, 1.f};
          pg8::gemm_phase<pg8::EpiBf16<0>, pg8::StaticOrder, PG8_ALIGN, PG8_SP2>(lds, g, S, E); }
    }
}
__device__ __forceinline__ void phase5_gemm(const Params& p, int b, LAS unsigned char* lds) {
    const int G = gridDim.x, c = opq_bid(); bf16_t* P = proj_ptr(p); float* scr = scr_ptr(p, b);
    { pg8::Gemm g{P + C_Z, (const bf16_t*)(wsb(p) + WS_WSSD), SEQ, DM, 2048, LD, 2048}; pg8::StaticOrder S; S.init(SEQ, DM, G, c); pg8::EpiMerge<0> E{P, scr};
      pg8::gemm_phase<pg8::EpiMerge<0>, pg8::StaticOrder, false, PG8_SP2>(lds, g, S, E); }
    { pg8::Gemm g{P + C_LG, (const bf16_t*)(wsb(p) + WS_WLRU), SEQ, DM, 1536, LD, 1536}; pg8::StaticOrder S; S.init(SEQ, DM, G, c); pg8::EpiMerge<1> E{P, scr};
      pg8::gemm_phase<pg8::EpiMerge<1>, pg8::StaticOrder, false, PG8_SP2>(lds, g, S, E); }
    { pg8::Gemm g{P + C_Q, (const bf16_t*)(wsb(p) + WS_WMEM), SEQ, DM, 1024, LD, 1024}; pg8::StaticOrder S; S.init(SEQ, DM, G, c); pg8::EpiMerge<2> E{P, scr};
      pg8::gemm_phase<pg8::EpiMerge<2>, pg8::StaticOrder, false, PG8_SP2>(lds, g, S, E); }
}
__device__ __forceinline__ void phase6_gemm(const Params& p, int b, LAS unsigned char* lds) {
    const int G = gridDim.x, c = opq_bid(); bf16_t* P = proj_ptr(p);
    pg8::Gemm g{P + C_MRG, (const bf16_t*)(wsb(p) + WS_WOUT), SEQ, DM, DM, LD, DM}; pg8::StaticOrder S; S.init(SEQ, DM, G, c);
    pg8::EpiOut E{opq(p.x) + (size_t)b * SEQ * DM, opq(p.out) + (size_t)b * SEQ * DM};
    pg8::gemm_phase<pg8::EpiOut, pg8::StaticOrder, false, PG8_SP2>(lds, g, S, E);
}
#define MFMA16(a, b, c) __builtin_amdgcn_mfma_f32_16x16x32_bf16((a), (b), (c), 0, 0, 0)
__device__ __forceinline__ bf16x8 pack8(const float (&v)[8]) {
    u32x4 w; w.x = pk2(v[0], v[1]); w.y = pk2(v[2], v[3]); w.z = pk2(v[4], v[5]); w.w = pk2(v[6], v[7]); return __builtin_bit_cast(bf16x8, w);
}
__device__ __forceinline__ void unpack8(u32x4 w, float (&v)[8]) {
#pragma unroll
    for (int i = 0; i < 4; ++i) { v[2 * i] = __uint_as_float(w[i] << 16); v[2 * i + 1] = __uint_as_float(w[i] & 0xffff0000u); }
}
__device__ __forceinline__ void attn_phase(const Params& p, int b) {
    const int tid = opq_tid(), lane = tid & 63, wave = tid >> 6, fr = lane & 15, kg = lane >> 4;
    bf16_t* P = proj_ptr(p); const bf16_t* KK = (const bf16_t*)(wsb(p) + WS_KVK) + (size_t)b * 256 * 1024; const bf16_t* VT = (const bf16_t*)(wsb(p) + WS_KVVT) + b * 256;
    for (int u = opq_bid(); u < 256; u += gridDim.x) {
        const int hd = u & 3, rt = u >> 2, q0 = rt * 128 + wave * 16;
        bf16_t* qrow = P + (size_t)(q0 + fr) * LD + C_Q + hd * 256;
        bf16x8 qf[8];
#pragma unroll
        for (int s = 0; s < 8; ++s) qf[s] = *(const bf16x8*)(qrow + 32 * s + 8 * kg);
        f32x4 sacc[16];
#pragma unroll
        for (int mt = 0; mt < 16; ++mt) { sacc[mt] = (f32x4){0.f, 0.f, 0.f, 0.f}; const bf16_t* kr = KK + (size_t)(16 * mt + fr) * 1024 + hd * 256 + 8 * kg;
#pragma unroll
            for (int s = 0; s < 8; ++s) { const bf16x8 kf = *(const bf16x8*)(kr + 32 * s); sacc[mt] = MFMA16(kf, qf[s], sacc[mt]); } }
        float mx = -INFINITY;
#pragma unroll
        for (int mt = 0; mt < 16; ++mt)
#pragma unroll
            for (int j = 0; j < 4; ++j) mx = fmaxf(mx, sacc[mt][j]);
        mx = fmaxf(mx, __shfl_xor(mx, 16)); mx = fmaxf(mx, __shfl_xor(mx, 32));
        float sum = 0.f;
#pragma unroll
        for (int mt = 0; mt < 16; ++mt)
#pragma unroll
            for (int j = 0; j < 4; ++j) { const float e = __expf((sacc[mt][j] - mx) * 0.0625f); sacc[mt][j] = e; sum += e; }
        sum += __shfl_xor(sum, 16); sum += __shfl_xor(sum, 32);
        const float inv = 1.f / sum;
        bf16x8 pf[8];
#pragma unroll
        for (int s2 = 0; s2 < 8; ++s2) { u32x4 w; w.x = pk2(sacc[2 * s2][0], sacc[2 * s2][1]); w.y = pk2(sacc[2 * s2][2], sacc[2 * s2][3]);
            w.z = pk2(sacc[2 * s2 + 1][0], sacc[2 * s2 + 1][1]); w.w = pk2(sacc[2 * s2 + 1][2], sacc[2 * s2 + 1][3]); pf[s2] = __builtin_bit_cast(bf16x8, w); }
#pragma unroll 4
        for (int mt2 = 0; mt2 < 16; ++mt2) { f32x4 o = (f32x4){0.f, 0.f, 0.f, 0.f}; const bf16_t* vr = VT + (size_t)(hd * 256 + 16 * mt2 + fr) * 512 + 4 * kg;
#pragma unroll
            for (int s2 = 0; s2 < 8; ++s2) { const u32x2 lo = *(const u32x2*)(vr + 32 * s2), hi = *(const u32x2*)(vr + 32 * s2 + 16);
                u32x4 w; w.x = lo.x; w.y = lo.y; w.z = hi.x; w.w = hi.y; o = MFMA16(__builtin_bit_cast(bf16x8, w), pf[s2], o); }
            u32x2 ow; ow.x = pk2(o[0] * inv, o[1] * inv); ow.y = pk2(o[2] * inv, o[3] * inv);
            *(u32x2*)(qrow + 16 * mt2 + 4 * kg) = ow; }
    }
}
template <bool FINAL> __device__ __forceinline__ void lru_phase(const Params& p, int b, LAS unsigned char* lds) {
    const int tid = opq_tid(), lane = tid & 63, wave = tid >> 6, fr = lane & 15, kg = lane >> 4;
    bf16_t* P = proj_ptr(p);
    LAS bf16_t* sWA = (LAS bf16_t*)lds; LAS bf16_t* sWX = (LAS bf16_t*)(lds + 19968);
    LAS float* sCW = (LAS float*)(lds + 39936); LAS float* sCB = sCW + 384; LAS float* sBA = sCB + 96; LAS float* sBX = sBA + 96; LAS float* sSP = sBX + 96;
    LAS float* sXL = (LAS float*)(lds + 43008) + wave * 1600;
    LAS float* sAG = (LAS float*)(lds + 94208);
    float* agg = (float*)(wsb(p) + WS_LAGG) + (size_t)b * NSEG * LRUW * 2;
    const float* car = (const float*)(wsb(p) + WS_LCAR) + (size_t)b * NSEG * LRUW;
    const float* lcw = opq(p.lru_conv_w); const float* lcb = opq(p.lru_conv_b); const float* lba = opq(p.lru_b_a); const float* lbx = opq(p.lru_b_x); const float* lam = opq(p.lru_lambda);
    for (int u = opq_bid(); u < NLB * NSEG; u += gridDim.x) {
        const int n = u % NLB, sg = u / NLB;
        __syncthreads();
        { const bf16_t* gwa = (const bf16_t*)(wsb(p) + WS_LRUWA) + n * 9216; const bf16_t* gwx = (const bf16_t*)(wsb(p) + WS_LRUWX) + n * 9216;
          for (int e = tid; e < 96 * 12; e += 512) { const int j = e / 12, c8 = e % 12;
              *(LAS u32x4*)(sWA + j * 104 + 8 * c8) = *(const u32x4*)(gwa + j * 96 + 8 * c8); *(LAS u32x4*)(sWX + j * 104 + 8 * c8) = *(const u32x4*)(gwx + j * 96 + 8 * c8); }
          if (tid < 384) sCW[tid] = lcw[(tid / 96) * 1536 + n * 96 + tid % 96];
          if (tid < 96) { sCB[tid] = lcb[n * 96 + tid]; sBA[tid] = lba[n * 96 + tid]; sBX[tid] = lbx[n * 96 + tid]; sSP[tid] = softplusf_(-lam[n * 96 + tid]); } }
        __syncthreads();
        float runA[6], runH[6];
#pragma unroll
        for (int nt = 0; nt < 6; ++nt) { runA[nt] = 1.f; runH[nt] = FINAL ? car[sg * LRUW + n * 96 + 16 * nt + fr] : 0.f; }
        int par = 0;
        for (int step = 0; step < 4; ++step) {
            const int tb = sg * LSEG + step * 128 + wave * 16;
            bf16x8 af[3];
#pragma unroll
            for (int ks = 0; ks < 3; ++ks) { const int ch0 = 32 * ks + 8 * kg; float xl[8];
#pragma unroll
                for (int i = 0; i < 8; ++i) xl[i] = sCB[ch0 + i];
#pragma unroll
                for (int k = 0; k < 4; ++k) { const int t = tb + fr - 3 + k; const int tc = t < 0 ? 0 : t;
                    u32x4 raw = *(const u32x4*)(P + (size_t)tc * LD + C_LX + n * 96 + ch0); if (t < 0) raw = (u32x4){0u, 0u, 0u, 0u};
                    float rv[8]; unpack8(raw, rv);
#pragma unroll
                    for (int i = 0; i < 8; ++i) xl[i] += sCW[k * 96 + ch0 + i] * rv[i]; }
                *(LAS f32x4*)(sXL + fr * 100 + ch0) = (f32x4){xl[0], xl[1], xl[2], xl[3]}; *(LAS f32x4*)(sXL + fr * 100 + ch0 + 4) = (f32x4){xl[4], xl[5], xl[6], xl[7]};
                af[ks] = pack8(xl); }
            f32x4 aR[6], aI[6];
#pragma unroll
            for (int nt = 0; nt < 6; ++nt) { aR[nt] = (f32x4){0.f, 0.f, 0.f, 0.f}; aI[nt] = (f32x4){0.f, 0.f, 0.f, 0.f};
#pragma unroll
                for (int ks = 0; ks < 3; ++ks) { const bf16x8 wa = *(const LAS bf16x8*)(sWA + (16 * nt + fr) * 104 + 32 * ks + 8 * kg), wx = *(const LAS bf16x8*)(sWX + (16 * nt + fr) * 104 + 32 * ks + 8 * kg);
                    aR[nt] = MFMA16(af[ks], wa, aR[nt]); aI[nt] = MFMA16(af[ks], wx, aI[nt]); } }
            float Ainc[6][4], Hinc[6][4], Ap[6], Hp[6];
#pragma unroll
            for (int nt = 0; nt < 6; ++nt) { const int j = 16 * nt + fr; const float ba = sBA[j], bx = sBX[j], sp = sSP[j];
                float A = 1.f, H = 0.f;
#pragma unroll
                for (int r = 0; r < 4; ++r) { const float xlv = sXL[(4 * kg + r) * 100 + j];
                    const float rr = sigmoidf_(aR[nt][r] + ba), ii = sigmoidf_(aI[nt][r] + bx), la = -8.f * rr * sp, a = __expf(la), mult = sqrtf(fmaxf(0.f, 1.f - __expf(2.f * la)));
                    H = a * H + mult * ii * xlv; A *= a; Ainc[nt][r] = A; Hinc[nt][r] = H; }
                float ap = 1.f, hp = 0.f, at = 1.f, ht = 0.f;
#pragma unroll
                for (int k = 0; k < 4; ++k) { const float ab = __shfl(A, fr + 16 * k), hb = __shfl(H, fr + 16 * k);
                    if (k < kg) { hp = ab * hp + hb; ap *= ab; } ht = ab * ht + hb; at *= ab; }
                Ap[nt] = ap; Hp[nt] = hp;
                if (kg == 0) { sAG[((par * 8 + wave) * 96 + j) * 2] = at; sAG[((par * 8 + wave) * 96 + j) * 2 + 1] = ht; } }
            __syncthreads();
#pragma unroll
            for (int nt = 0; nt < 6; ++nt) { const int j = 16 * nt + fr; float cA = runA[nt], cH = runH[nt], rA = runA[nt], rH = runH[nt];
#pragma unroll
                for (int w2 = 0; w2 < 8; ++w2) { const float a2 = sAG[((par * 8 + w2) * 96 + j) * 2], h2 = sAG[((par * 8 + w2) * 96 + j) * 2 + 1];
                    if (w2 < wave) { cH = a2 * cH + h2; cA *= a2; } rH = a2 * rH + h2; rA *= a2; }
                runA[nt] = rA; runH[nt] = rH;
                if (FINAL) { const float hin = Ap[nt] * cH + Hp[nt];
#pragma unroll
                    for (int r = 0; r < 4; ++r) { const float hv = Ainc[nt][r] * hin + Hinc[nt][r]; bf16_t* gp = P + (size_t)(tb + 4 * kg + r) * LD + C_LG + n * 96 + j;
                        *gp = (bf16_t)f2bf(hv * siluf_(bf2f(*gp))); } } }
            par ^= 1;
        }
        if (!FINAL && wave == 0 && kg == 0) {
#pragma unroll
            for (int nt = 0; nt < 6; ++nt) { const int ch = n * 96 + 16 * nt + fr; agg[((size_t)sg * LRUW + ch) * 2] = runA[nt]; agg[((size_t)sg * LRUW + ch) * 2 + 1] = runH[nt]; } }
    }
}
__device__ __forceinline__ void lru_carry_phase(const Params& p, int b) {
    const int gt = opq_bid() * 512 + opq_tid();
    const float* agg = (const float*)(wsb(p) + WS_LAGG) + (size_t)b * NSEG * LRUW * 2; float* car = (float*)(wsb(p) + WS_LCAR) + (size_t)b * NSEG * LRUW;
    for (int ch = gt; ch < LRUW; ch += gridDim.x * 512) { float h = 0.f;
        for (int sg = 0; sg < NSEG; ++sg) { car[sg * LRUW + ch] = h; h = agg[((size_t)sg * LRUW + ch) * 2] * h + agg[((size_t)sg * LRUW + ch) * 2 + 1]; } }
}
__device__ __forceinline__ void conv8_silu(const bf16_t* P, int t, int col, const float* cw, const float* cb, int ch, float (&o)[8]) {
    float r[11];
    unsigned off0 = (unsigned)((t < 3 ? 0 : t - 3) * LD + col); asm volatile("" : "+v"(off0));
    if (t >= 3) {
#pragma unroll
        for (int i = 0; i < 11; ++i) r[i] = bf2f(P[off0 + (unsigned)(i * LD)]);
    } else {
#pragma unroll
        for (int i = 0; i < 11; ++i) { const int tt = t - 3 + i; const float v = bf2f(P[off0 + (unsigned)((tt < 0 ? 0 : tt) * LD)]); r[i] = tt < 0 ? 0.f : v; }
    }
    const float w0 = cw[ch], w1 = cw[3072 + ch], w2 = cw[6144 + ch], w3 = cw[9216 + ch], bb = cb[ch];
#pragma unroll
    for (int j = 0; j < 8; ++j) o[j] = siluf_(bb + w0 * r[j] + w1 * r[j + 1] + w2 * r[j + 2] + w3 * r[j + 3]);
}
__device__ __forceinline__ float ssd_dt_setup(const Params& p, const bf16_t* P, int t0, int h, int lane, LAS float* sACS, LAS float* sDT) {
    const float dtb = opq(p.ssd_dt_bias)[h], an = -__expf(opq(p.ssd_a_log)[h]);
    const float dt0 = softplusf_(bf2f(P[(size_t)(t0 + 2 * lane) * LD + C_DT + h]) + dtb), dt1 = softplusf_(bf2f(P[(size_t)(t0 + 2 * lane + 1) * LD + C_DT + h]) + dtb);
    const float dA1 = dt1 * an; float s = dt0 * an + dA1;
#pragma unroll
    for (int o = 1; o < 64; o <<= 1) { const float t = __shfl_up(s, o); if (lane >= o) s += t; }
    sACS[2 * lane] = s - dA1; sACS[2 * lane + 1] = s; sDT[2 * lane] = dt0; sDT[2 * lane + 1] = dt1;
    return __shfl(s, 63);
}
__device__ __forceinline__ void ssd_states_phase(const Params& p, int b, LAS unsigned char* lds) {
    const int tid = opq_tid(), lane = tid & 63, wave = tid >> 6, fr = lane & 15, kg = lane >> 4;
    const bf16_t* P = proj_ptr(p); bf16_t* ST = states_ptr(p, b); float* dasum = (float*)(wsb(p) + WS_DASUM) + b * NCHUNK * NHEAD;
    const float* cw = opq(p.ssd_conv_w); const float* cb = opq(p.ssd_conv_b);
    LAS bf16_t* sBT = (LAS bf16_t*)lds; LAS float* sACS = (LAS float*)(lds + 34816) + wave * 128; LAS float* sW = (LAS float*)(lds + 34816 + 4096) + wave * 128;
    for (int u = opq_bid(); u < NCHUNK * NGRP; u += gridDim.x) {
        const int c = u >> 2, g = u & 3, t0 = c * CHUNK, h = 8 * g + wave;
        __syncthreads();
        { const float tot = ssd_dt_setup(p, P, t0, h, lane, sACS, sW);
          if (lane == 0) dasum[c * NHEAD + h] = tot;
          sW[2 * lane] = sW[2 * lane] * __expf(tot - sACS[2 * lane]); sW[2 * lane + 1] = sW[2 * lane + 1] * __expf(tot - sACS[2 * lane + 1]); }
#pragma unroll
        for (int it = 0; it < 4; ++it) { const int item = tid + 512 * it, n = item & 127, lb = item >> 7; float v[8];
            conv8_silu(P, t0 + 8 * lb, C_B + g * 128 + n, cw, cb, 2048 + g * 128 + n, v);
            *(LAS bf16x8*)(sBT + n * 136 + 8 * lb) = pack8(v); }
        __syncthreads();
        for (int nt = 0; nt < 4; ++nt) {
            const int pp = 16 * nt + fr;
            bf16x8 xf[4];
#pragma unroll
            for (int s = 0; s < 4; ++s) { const int l0 = 32 * s + 8 * kg; float v[8];
                conv8_silu(P, t0 + l0, C_X + h * 64 + pp, cw, cb, h * 64 + pp, v);
                const f32x4 w0 = *(const LAS f32x4*)(sW + l0), w1 = *(const LAS f32x4*)(sW + l0 + 4);
                v[0] *= w0[0]; v[1] *= w0[1]; v[2] *= w0[2]; v[3] *= w0[3]; v[4] *= w1[0]; v[5] *= w1[1]; v[6] *= w1[2]; v[7] *= w1[3];
                xf[s] = pack8(v); }
            f32x4 acc[8];
#pragma unroll
            for (int mt = 0; mt < 8; ++mt) { acc[mt] = (f32x4){0.f, 0.f, 0.f, 0.f};
#pragma unroll
                for (int s = 0; s < 4; ++s) { const bf16x8 a = *(const LAS bf16x8*)(sBT + (16 * mt + fr) * 136 + 32 * s + 8 * kg); acc[mt] = MFMA16(a, xf[s], acc[mt]); } }
#pragma unroll
            for (int mt = 0; mt < 8; ++mt) { const int n0 = 16 * mt + 4 * kg;
                u32x2 w; w.x = pk2(acc[mt][0], acc[mt][1]); w.y = pk2(acc[mt][2], acc[mt][3]);
                *(u32x2*)(ST + ((size_t)(c * NHEAD + h) * 64 + pp) * 128 + n0) = w; }
        }
    }
}
__device__ __forceinline__ void ssd_scan_phase(const Params& p, int b) {
    unsigned* st = (unsigned*)states_ptr(p, b); const float* dasum = (const float*)(wsb(p) + WS_DASUM) + b * NCHUNK * NHEAD;
    for (int e2 = opq_bid() * 512 + opq_tid(); e2 < 131072; e2 += gridDim.x * 512) {
        const int h = e2 >> 12; float r0 = 0.f, r1 = 0.f;
        for (int c0 = 0; c0 < NCHUNK; c0 += 16) { unsigned v[16];
#pragma unroll
            for (int i = 0; i < 16; ++i) v[i] = st[(size_t)(c0 + i) * 131072 + e2];
#pragma unroll
            for (int i = 0; i < 16; ++i) { const float d = __expf(dasum[(c0 + i) * NHEAD + h]); st[(size_t)(c0 + i) * 131072 + e2] = pk2(r0, r1);
                r0 = r0 * d + __uint_as_float(v[i] << 16); r1 = r1 * d + __uint_as_float(v[i] & 0xffff0000u); } }
    }
}
__device__ __forceinline__ void ssd_out_phase(const Params& p, int b, LAS unsigned char* lds) {
    const int tid = opq_tid(), lane = tid & 63, wave = tid >> 6, fr = lane & 15, kg = lane >> 4;
    bf16_t* P = proj_ptr(p); const bf16_t* ST = states_ptr(p, b);
    const float* cw = opq(p.ssd_conv_w); const float* cb = opq(p.ssd_conv_b);
    LAS bf16_t* sB = (LAS bf16_t*)lds; LAS bf16_t* sC = (LAS bf16_t*)(lds + 34816); LAS bf16_t* sCB = (LAS bf16_t*)(lds + 69632);
    LAS float* sACS = (LAS float*)(lds + 104448) + wave * 128; LAS float* sDT = (LAS float*)(lds + 108544) + wave * 128; LAS float* sSSQ = (LAS float*)(lds + 112640);
    for (int u = opq_bid(); u < NCHUNK * NGRP; u += gridDim.x) {
        const int c = u >> 2, g = u & 3, t0 = c * CHUNK, h = 8 * g + wave;
        __syncthreads();
        (void)ssd_dt_setup(p, P, t0, h, lane, sACS, sDT);
#pragma unroll 1
        for (int it = 0; it < 8; ++it) { const int item = tid + 512 * it, isC = item >> 11, r = item & 2047, l = r >> 4, c8 = r & 15;
            const int ch = 2048 + isC * 512 + g * 128 + 8 * c8;
            float v[8];
            { const f32x4 b0 = *(const f32x4*)(cb + ch), b1 = *(const f32x4*)(cb + ch + 4); v[0] = b0[0]; v[1] = b0[1]; v[2] = b0[2]; v[3] = b0[3]; v[4] = b1[0]; v[5] = b1[1]; v[6] = b1[2]; v[7] = b1[3]; }
#pragma unroll
            for (int k = 0; k < 4; ++k) { const int t = t0 + l - 3 + k; u32x4 raw = *(const u32x4*)(P + (size_t)(t < 0 ? 0 : t) * LD + C_X + ch); if (t < 0) raw = (u32x4){0u, 0u, 0u, 0u};
                float rv[8]; unpack8(raw, rv); const f32x4 w0 = *(const f32x4*)(cw + k * 3072 + ch), w1 = *(const f32x4*)(cw + k * 3072 + ch + 4);
                v[0] += w0[0] * rv[0]; v[1] += w0[1] * rv[1]; v[2] += w0[2] * rv[2]; v[3] += w0[3] * rv[3]; v[4] += w1[0] * rv[4]; v[5] += w1[1] * rv[5]; v[6] += w1[2] * rv[6]; v[7] += w1[3] * rv[7]; }
#pragma unroll
            for (int i = 0; i < 8; ++i) v[i] = siluf_(v[i]);
            *(LAS bf16x8*)((isC ? sC : sB) + l * 136 + 8 * c8) = pack8(v); }
        __syncthreads();
#pragma unroll
        for (int ms = 0; ms < 8; ++ms) if (ms <= wave) { f32x4 a4 = (f32x4){0.f, 0.f, 0.f, 0.f};
#pragma unroll
            for (int kn = 0; kn < 4; ++kn) { const bf16x8 a = *(const LAS bf16x8*)(sB + (16 * ms + fr) * 136 + 32 * kn + 8 * kg), bb = *(const LAS bf16x8*)(sC + (16 * wave + fr) * 136 + 32 * kn + 8 * kg);
                a4 = MFMA16(a, bb, a4); }
            u32x2 w; w.x = pk2(a4[0], a4[1]); w.y = pk2(a4[2], a4[3]);
            *(LAS u32x2*)(sCB + (16 * wave + fr) * 136 + 16 * ms + 4 * kg) = w; }
        __syncthreads();
        const float Dh = opq(p.ssd_d)[h];
        const unsigned zbase0 = (unsigned)((t0 + 4 * kg) * LD + C_Z + h * 64 + fr);
        float ssq[8][4];
#pragma unroll
        for (int mt = 0; mt < 8; ++mt)
#pragma unroll
            for (int j = 0; j < 4; ++j) ssq[mt][j] = 0.f;
        for (int ph = 0; ph < 2; ++ph) {
            unsigned zb = zbase0 + 32u * ph; asm volatile("" : "+v"(zb));
            unsigned pfo = (unsigned)(((c * NHEAD + h) * 64 + 32 * ph + fr) * 128 + 8 * kg); asm volatile("" : "+v"(pfo));
            f32x4 acc[8][2];
#pragma unroll
            for (int mt = 0; mt < 8; ++mt) { acc[mt][0] = (f32x4){0.f, 0.f, 0.f, 0.f}; acc[mt][1] = (f32x4){0.f, 0.f, 0.f, 0.f}; }
            { bf16x8 pf[4][2];
#pragma unroll
              for (int sn = 0; sn < 4; ++sn)
#pragma unroll
                  for (int nt = 0; nt < 2; ++nt) pf[sn][nt] = *(const bf16x8*)(ST + (pfo + (unsigned)(16 * nt * 128 + 32 * sn)));
#pragma unroll
              for (int mt = 0; mt < 8; ++mt)
#pragma unroll
                  for (int sn = 0; sn < 4; ++sn) { const bf16x8 a = *(const LAS bf16x8*)(sC + (16 * mt + fr) * 136 + 32 * sn + 8 * kg);
                      acc[mt][0] = MFMA16(a, pf[sn][0], acc[mt][0]); acc[mt][1] = MFMA16(a, pf[sn][1], acc[mt][1]); } }
#pragma unroll
            for (int mt = 0; mt < 8; ++mt) { const f32x4 al = *(const LAS f32x4*)(sACS + 16 * mt + 4 * kg);
#pragma unroll
                for (int j = 0; j < 4; ++j) { const float sc = __expf(al[j]); acc[mt][0][j] *= sc; acc[mt][1][j] *= sc; } }
#pragma unroll
            for (int sk = 0; sk < 4; ++sk) {
                bf16x8 xf0, xf1;
                { float v[8]; conv8_silu(P, t0 + 32 * sk + 8 * kg, C_X + h * 64 + 32 * ph + fr, cw, cb, h * 64 + 32 * ph + fr, v); xf0 = pack8(v); }
                { float v[8]; conv8_silu(P, t0 + 32 * sk + 8 * kg, C_X + h * 64 + 32 * ph + 16 + fr, cw, cb, h * 64 + 32 * ph + 16 + fr, v); xf1 = pack8(v); }
                const int s0 = 32 * sk + 8 * kg;
                const f32x4 as0 = *(const LAS f32x4*)(sACS + s0), as1 = *(const LAS f32x4*)(sACS + s0 + 4), d0 = *(const LAS f32x4*)(sDT + s0), d1 = *(const LAS f32x4*)(sDT + s0 + 4);
#pragma unroll
                for (int mt = 0; mt < 8; ++mt) if (mt >= 2 * sk) { const int l = 16 * mt + fr; const float acsl = sACS[l];
                    float cbv[8]; unpack8(*(const LAS u32x4*)(sCB + l * 136 + s0), cbv);
                    float m[8];
#pragma unroll
                    for (int i = 0; i < 8; ++i) { const int s = s0 + i; const float as = i < 4 ? as0[i & 3] : as1[i & 3], ds = i < 4 ? d0[i & 3] : d1[i & 3];
                        float mv = (s <= l) ? cbv[i] * __expf(acsl - as) * ds : 0.f; if (s == l) mv += Dh; m[i] = mv; }
                    const bf16x8 a = pack8(m);
                    acc[mt][0] = MFMA16(a, xf0, acc[mt][0]); acc[mt][1] = MFMA16(a, xf1, acc[mt][1]);
                    asm volatile("" ::: "memory"); }
            }
#pragma unroll
            for (int mt = 0; mt < 8; ++mt)
#pragma unroll
                for (int nt = 0; nt < 2; ++nt) {
#pragma unroll
                    for (int j = 0; j < 4; ++j) { bf16_t* zp = P + (zb + (unsigned)((16 * mt + j) * LD + 16 * nt));
                        const float y = acc[mt][nt][j] * siluf_(bf2f(*zp)); ssq[mt][j] += y * y; *zp = (bf16_t)f2bf(y); } }
        }
#pragma unroll
        for (int mt = 0; mt < 8; ++mt)
#pragma unroll
            for (int j = 0; j < 4; ++j) { float v = ssq[mt][j]; v += __shfl_xor(v, 1); v += __shfl_xor(v, 2); v += __shfl_xor(v, 4); v += __shfl_xor(v, 8);
                if (fr == 0) sSSQ[wave * 128 + 16 * mt + 4 * kg + j] = v; }
        __syncthreads();
        float ngv[4];
#pragma unroll
        for (int q = 0; q < 4; ++q) ngv[q] = opq(p.ssd_norm_g)[g * 512 + wave * 64 + 16 * q + fr];
#pragma unroll
        for (int mt = 0; mt < 8; ++mt)
#pragma unroll
            for (int j = 0; j < 4; ++j) { const int l = 16 * mt + 4 * kg + j; float tot = 0.f;
#pragma unroll
                for (int w2 = 0; w2 < 8; ++w2) tot += sSSQ[w2 * 128 + l];
                const float rs = 1.f / sqrtf(tot * (1.f / 512.f) + EPS);
                unsigned zb2 = zbase0 + (unsigned)((16 * mt + j) * LD); asm volatile("" : "+v"(zb2));
#pragma unroll
                for (int q = 0; q < 4; ++q) { bf16_t* zp = P + (zb2 + 16u * q);
                    *zp = (bf16_t)f2bf(bf2f(*zp) * rs * ngv[q]); } }
    }
}
__global__ void __launch_bounds__(512) mk(Params p) {
    extern __shared__ __attribute__((aligned(16))) unsigned char lds_raw[];
    LAS unsigned char* lds = (LAS unsigned char*)lds_raw;
    cg::grid_group grid = cg::this_grid();
    for (int s = p.lo; s < p.hi; ++s) {
        if (s > p.lo) grid.sync();
        if (s == 0) { phase0(p, lds); continue; }
        if (s == 13) { phase7(p); continue; }
        const int b = (s - 1) / 6, ph = (s - 1) % 6 + 1;
        if (ph == 1) {
#if !NAIVE_GEMM
            phase1_gemm(p, b, lds);
#endif
        } else if (ph == 2) {
#if !NAIVE_SSD
#ifndef SKIP_ST
            ssd_states_phase(p, b, lds);
#endif
#endif
#if !NAIVE_LRU
            lru_phase<false>(p, b, lds);
#endif
#if !NAIVE_ATT
            attn_phase(p, b);
#endif
        } else if (ph == 3) {
#if !NAIVE_SSD
            ssd_scan_phase(p, b);
#endif
#if !NAIVE_LRU
            lru_carry_phase(p, b);
#endif
        } else if (ph == 4) {
#if !NAIVE_SSD
#ifndef SKIP_OUT
            ssd_out_phase(p, b, lds);
#endif
#endif
#if !NAIVE_LRU
            lru_phase<true>(p, b, lds);
#endif
        } else if (ph == 5) {
#if !NAIVE_GEMM
            phase5_gemm(p, b, lds);
#endif
        } else {
#if !NAIVE_GEMM
            phase6_gemm(p, b, lds);
#endif
        }
    }
}

static void launch_mk(Params& p, int lo, int hi, int grid, hipStream_t stream) {
    p.lo = lo; p.hi = hi; void* args[] = {&p};
    hipError_t e = hipLaunchCooperativeKernel((const void*)mk, dim3(grid), dim3(512), args, LDS_BYTES, stream);
    if (e != hipSuccess) fprintf(stderr, "cooperative launch failed: %s (grid %d)\n", hipGetErrorString(e), grid);
}
extern "C" void kernel_launch(void* const* d_in, const int* in_sizes, int n_in, void* d_out, int out_size, void* d_ws, size_t ws_size, hipStream_t stream) {
    static int grid = 0;
    if (grid == 0) {
        if (n_in != 24 || out_size != MTOK * DM || ws_size < WS_END) { fprintf(stderr, "kernel_launch: unexpected shapes (n_in %d out %d ws %zu)\n", n_in, out_size, ws_size); grid = -1; return; }
        int dev = 0, cus = 0, per_cu = 0;
        hipGetDevice(&dev); hipDeviceGetAttribute(&cus, hipDeviceAttributeMultiprocessorCount, dev);
        hipFuncSetAttribute((const void*)mk, hipFuncAttributeMaxDynamicSharedMemorySize, LDS_BYTES);
        hipOccupancyMaxActiveBlocksPerMultiprocessor(&per_cu, (const void*)mk, 512, LDS_BYTES);
        if (per_cu < 1) { fprintf(stderr, "kernel_launch: occupancy query says %d blocks/CU\n", per_cu); per_cu = 1; }
        grid = cus * 1;
        (void)hipGetLastError();
    }
    if (grid < 0) return;
    Params p{};
    const float** f = (const float**)&p;
    for (int i = 0; i < 24; ++i) f[i] = (const float*)d_in[i];
    p.out = (float*)d_out; p.ws = (unsigned char*)d_ws;
#if ONE_LAUNCH
    launch_mk(p, 0, 14, grid, stream);
#else
    bf16_t* P = (bf16_t*)(p.ws + WS_PROJ); (void)P;
    for (int s = 0; s < 14; ++s) {
        const int b = (s - 1) / 6, ph = (s == 0 || s == 13) ? 0 : (s - 1) % 6 + 1;
        launch_mk(p, s, s + 1, grid, stream);
#if NAIVE_GEMM
        if (ph == 1) {
            n_gemm<0><<<dim3(LD / 256, SEQ), 256, 0, stream>>>((const bf16_t*)((unsigned char*)d_out + 32 * MiB) + (size_t)b * SEQ * DM, DM, (const bf16_t*)(p.ws + WS_WIN), DM, DM, LD, P, LD, nullptr, 0, nullptr, 0, 0, nullptr, nullptr);
            if (b == 0) {
                n_gemm<0><<<dim3(4, 512), 256, 0, stream>>>((const bf16_t*)(p.ws + WS_MEMN), DM, (const bf16_t*)(p.ws + WS_WKV), DM, DM, 1024, (bf16_t*)(p.ws + WS_KVK), 1024, nullptr, 0, nullptr, 0, 0, nullptr, nullptr);
                n_gemm<0><<<dim3(2, 1024), 256, 0, stream>>>((const bf16_t*)(p.ws + WS_WKV) + (size_t)1024 * DM, DM, (const bf16_t*)(p.ws + WS_MEMN), DM, DM, 512, (bf16_t*)(p.ws + WS_KVVT), 512, nullptr, 0, nullptr, 0, 0, nullptr, nullptr);
            }
        }
        if (ph == 5) {
            float* scr = (float*)((unsigned char*)d_out + (size_t)b * 32 * MiB);
            n_gemm<1><<<dim3(4, SEQ), 256, 0, stream>>>(P + C_Z, LD, (const bf16_t*)(p.ws + WS_WSSD), 2048, 2048, 1024, P + C_MRG, LD, P + C_G, LD, scr, 1, 0, nullptr, nullptr);
            n_gemm<1><<<dim3(4, SEQ), 256, 0, stream>>>(P + C_LG, LD, (const bf16_t*)(p.ws + WS_WLRU), 1536, 1536, 1024, P + C_MRG, LD, P + C_G + 1024, LD, scr, 0, 0, nullptr, nullptr);
            n_gemm<1><<<dim3(4, SEQ), 256, 0, stream>>>(P + C_Q, LD, (const bf16_t*)(p.ws + WS_WMEM), 1024, 1024, 1024, P + C_MRG, LD, P + C_G + 2048, LD, scr, 0, 1, nullptr, nullptr);
        }
        if (ph == 6) n_gemm<2><<<dim3(4, SEQ), 256, 0, stream>>>(P + C_MRG, LD, (const bf16_t*)(p.ws + WS_WOUT), DM, DM, 1024, nullptr, 0, nullptr, 0, nullptr, 0, 0, (const float*)d_in[0] + (size_t)b * SEQ * DM, (float*)d_out + (size_t)b * SEQ * DM);
#endif
        if (ph == 2) {
#if NAIVE_SSD
            n_ssd<<<4, 512, 0, stream>>>(p, b);
#endif
#if NAIVE_LRU
            n_lru<<<16, 96, 0, stream>>>(p, b);
#endif
#if NAIVE_ATT
            n_attn<<<SEQ * 4, 256, 0, stream>>>(p, b);
#endif
        }
    }
#endif
}
```

```cpp
#define NAIVE_GEMM 0
#define NAIVE_ATT 0
#define NAIVE_LRU 0
#define NAIVE_SSD 0
#define ONE_LAUNCH 1

#include <hip/hip_runtime.h>
#include <hip/hip_cooperative_groups.h>
#include <cstdio>
#include <cstdint>
namespace cg = cooperative_groups;

#ifndef NAIVE_GEMM
#define NAIVE_GEMM 1
#endif
#ifndef NAIVE_SSD
#define NAIVE_SSD 1
#endif
#ifndef NAIVE_LRU
#define NAIVE_LRU 1
#endif
#ifndef NAIVE_ATT
#define NAIVE_ATT 1
#endif
#ifndef ONE_LAUNCH
#define ONE_LAUNCH 0
#endif

namespace pg8 {
#define PG8_LAS __attribute__((address_space(3)))
typedef unsigned short bf16_t;
typedef short bf16x8 __attribute__((ext_vector_type(8)));
typedef float f32x4 __attribute__((ext_vector_type(4)));
typedef unsigned u32x4 __attribute__((ext_vector_type(4)));
constexpr int BM = 256, BK = 64, HALF = 128, HTB = HALF * BK * 2  , STAGE_BYTES = 8 * HTB, NXCD = 8, WGM = 8;

__host__ __device__ __forceinline__ int lds_byte(int r, int c) { const int st = (r >> 4) * 2 + (c >> 5), rr = r & 15, cc = c & 31, ob = rr * 64 + cc * 2; return st * 1024 + (ob ^ (((ob >> 9) & 1) << 5)); }
__host__ __device__ __forceinline__ void stage_rc(int b, int& R, int& C) { const int st = b / 1024, sb = b % 1024, swz = sb ^ (((sb >> 9) & 1) << 5); R = (st >> 1) * 16 + swz / 64; C = (st & 1) * 32 + (swz % 64) / 2; }
__host__ __device__ __forceinline__ int perm32(int rho) { const int n = rho >> 4, i = rho & 15; return 8 * (i >> 2) + 4 * n + (i & 3); }

struct Unit { int pm, pn; };
struct Gemm { const bf16_t* A; const bf16_t* Bt; int M, N, K, lda, ldb; };

struct StaticOrder {
    int nM, nN, nwg, G, c;
    __host__ __device__ void init(int M, int N, int G_, int c_) { nM = M / BM; nN = N / BM; nwg = nM * nN; G = G_; c = c_; }
    __host__ __device__ bool next(int i, Unit& u) const {
        const long L = (long)i * G + c; if (L >= nwg) return false;
        int wgid = (int)L; { const int q = nwg / NXCD, r = nwg % NXCD, xcd = wgid % NXCD, off = wgid / NXCD; wgid = (xcd < r ? xcd * (q + 1) : r * (q + 1) + (xcd - r) * q) + off; }
        const int nig = WGM * nN, gid = wgid / nig, fm = gid * WGM, gsz = (nM - fm) < WGM ? (nM - fm) : WGM;
        u.pm = fm + ((wgid % nig) % gsz); u.pn = (wgid % nig) / gsz; return true;
    }
    __device__ __forceinline__ void a_ready(const Unit&) const {}
    __device__ __forceinline__ void done(const Unit&) const {}
};

__device__ __forceinline__ unsigned cvt_pk_bf16(float lo, float hi) { unsigned r; asm volatile("v_cvt_pk_bf16_f32 %0, %1, %2" : "=v"(r) : "v"(lo), "v"(hi)); return r; }
typedef float f32x2 __attribute__((ext_vector_type(2)));
__device__ __forceinline__ f32x2 gelu_pk(f32x2 v) {
    const f32x2 av = __builtin_elementwise_abs(v), d = av * 0.2316418882f + 1.0f;
    f32x2 t; t.x = __builtin_amdgcn_rcpf(d.x); t.y = __builtin_amdgcn_rcpf(d.y);
    f32x2 q = t * 0.5307027145f + (-0.7265760135f); q = q * t + 0.7107068705f; q = q * t + (-0.142248368f); q = q * t + 0.127414796f; q = q * t;
    const f32x2 s = (v * v) * (-0.72134752044f);
    f32x2 e; e.x = __builtin_amdgcn_exp2f(s.x); e.y = __builtin_amdgcn_exp2f(s.y);
    const f32x2 m = v * (q * e), r = v - m;
    f32x2 o; o.x = v.x < 0.f ? m.x : r.x; o.y = v.y < 0.f ? m.y : r.y; return o;
}

template <int ACT  > struct EpiBf16 {
    static constexpr bool PERM = true, AFTER_DRAIN = false; static_assert(ACT == 0 || ACT == 1, "EpiBf16: ACT is 0 (none) or 1 (gelu_pk)");
    bf16_t* O; int ldc; const float* bias; int split_cols; size_t split_stride; float scale0;
    __device__ __forceinline__ void operator()(const f32x4 (&acc)[2][2][4][2], const Unit& u, int wr, int wc, int fr, int fq) const {
        const int row0 = u.pm * BM + wr * 64 + fr; int colt = u.pn * BM; bf16_t* base = O;
        float sc = 1.f; if (split_cols) { const int t = colt / split_cols; base += (size_t)t * split_stride; colt -= t * split_cols; if (t == 0) sc = scale0; }
        const int col0 = colt + wc * 32 + 8 * fq, bcol0 = u.pn * BM + wc * 32 + 8 * fq;
        f32x4 bv[2][2];
#pragma unroll
        for (int bj = 0; bj < 2; ++bj)
#pragma unroll
            for (int n = 0; n < 2; ++n) bv[bj][n] = bias ? *(const f32x4*)(bias + bcol0 + bj * HALF + 4 * n) : (f32x4){0.f, 0.f, 0.f, 0.f};
#pragma unroll
        for (int ai = 0; ai < 2; ++ai)
#pragma unroll
            for (int m = 0; m < 4; ++m) { bf16_t* rowp = base + (size_t)(row0 + ai * HALF + m * 16) * ldc + col0;
#pragma unroll
                for (int bj = 0; bj < 2; ++bj) { f32x4 v0 = acc[ai][bj][m][0] + bv[bj][0], v1 = acc[ai][bj][m][1] + bv[bj][1];
                    if (ACT == 1) { f32x2 a = gelu_pk((f32x2){v0[0], v0[1]}), b = gelu_pk((f32x2){v0[2], v0[3]}), c = gelu_pk((f32x2){v1[0], v1[1]}), d = gelu_pk((f32x2){v1[2], v1[3]});
                        v0 = (f32x4){a.x, a.y, b.x, b.y}; v1 = (f32x4){c.x, c.y, d.x, d.y}; }
                    v0 = v0 * sc; v1 = v1 * sc; u32x4 w; w.x = cvt_pk_bf16(v0[0], v0[1]); w.y = cvt_pk_bf16(v0[2], v0[3]); w.z = cvt_pk_bf16(v1[0], v1[1]); w.w = cvt_pk_bf16(v1[2], v1[3]);
                    *(u32x4*)(rowp + bj * HALF) = w; } }
    }
};
template <class Epi, class Sched, bool ALIGN_EPI = false, bool SP2 = false>
__device__ __forceinline__ void gemm_phase(PG8_LAS unsigned char* lds, const Gemm g, const Sched& S, const Epi& E) {
    int tid_ = threadIdx.x; asm volatile("" : "+v"(tid_));
    const int tid = tid_, wid = __builtin_amdgcn_readfirstlane(tid >> 6), lane = tid & 63, wr = wid >> 2, wc = wid & 3, fr = lane & 15, fq = lane >> 4;
    const int K = g.K, nt = K / BK;
    unsigned voffA[2], voffB[2];
#pragma unroll
    for (int i = 0; i < 2; ++i) { int R, C; stage_rc(tid * 16 + i * 8192, R, C); const int Rb = Epi::PERM ? ((R & ~31) + perm32(R & 31)) : R;
        voffA[i] = (unsigned)(R * g.lda + C) * 2u; voffB[i] = (unsigned)(Rb * g.ldb + C) * 2u; }
    const size_t kstep = (size_t)(BK * 2);
    const size_t hstepA = (size_t)HALF * g.lda * 2, hstepB = (size_t)HALF * g.ldb * 2;
    const size_t tstepA = 2 * hstepA, tstepB = 2 * hstepB;
    const unsigned ldsw = (unsigned)wid * 1024u;
    const int aoff = lds_byte(wr * 64 + fr, fq * 8), boff = lds_byte(wc * 32 + fr, fq * 8);
#define PG8_SA(b, h) (((b) * 2 + (h)) * HTB)
#define PG8_SB(b, h) ((4 + (b) * 2 + (h)) * HTB)
#define PG8_STAGE(bufoff, gbase, voff) do { _Pragma("unroll") for (int _i = 0; _i < 2; ++_i) \
        __builtin_amdgcn_global_load_lds((const unsigned*)((const char*)(gbase) + (voff)[_i]), (PG8_LAS unsigned*)(lds + (bufoff) + ldsw + _i * 8192), 16, 0, 0); } while (0)
#define PG8_LDA(dst, b, h) do { _Pragma("unroll") for (int m = 0; m < 4; ++m) _Pragma("unroll") for (int k = 0; k < 2; ++k) dst[m][k] = *(const PG8_LAS bf16x8*)(lds + PG8_SA(b, h) + aoff + m * 2048 + k * 1024); } while (0)
#define PG8_LDB(dst, b, h) do { _Pragma("unroll") for (int n = 0; n < 2; ++n) _Pragma("unroll") for (int k = 0; k < 2; ++k) dst[n][k] = *(const PG8_LAS bf16x8*)(lds + PG8_SB(b, h) + boff + n * 2048 + k * 1024); } while (0)
#define PG8_MMA(ai, bj, At, Bt) do { __builtin_amdgcn_s_setprio(1); _Pragma("unroll") for (int m = 0; m < 4; ++m) _Pragma("unroll") for (int n = 0; n < 2; ++n) _Pragma("unroll") for (int k = 0; k < 2; ++k) \
        acc[ai][bj][m][n] = __builtin_amdgcn_mfma_f32_16x16x32_bf16(Bt[n][k], At[m][k], acc[ai][bj][m][n], 0, 0, 0); __builtin_amdgcn_s_setprio(0); } while (0)
#define PG8_WAIT_V(n) asm volatile("s_waitcnt vmcnt(" #n ")" ::: "memory")
#define PG8_WAIT_L(n) asm volatile("s_waitcnt lgkmcnt(" #n ")" ::: "memory")
#define PG8_BAR __builtin_amdgcn_s_barrier()
#define PG8_SCHED __builtin_amdgcn_sched_barrier(0)
    Unit cur, nxt; int ui = 0;
    if (!S.next(0, cur)) return;
    f32x4 acc[2][2][4][2];
#pragma unroll
    for (int a = 0; a < 2; ++a)
#pragma unroll
        for (int b = 0; b < 2; ++b)
#pragma unroll
            for (int m = 0; m < 4; ++m)
#pragma unroll
                for (int n = 0; n < 2; ++n) acc[a][b][m][n] = (f32x4){0.f, 0.f, 0.f, 0.f};
    bf16x8 At[4][2], B0[2][2], B1[2][2];
    const char* cA = (const char*)g.A + (size_t)cur.pm * tstepA; const char* cB = (const char*)g.Bt + (size_t)cur.pn * tstepB;
    S.a_ready(cur);
    if constexpr (SP2) {
        PG8_STAGE(PG8_SB(0, 0), cB, voffB); PG8_STAGE(PG8_SB(0, 1), cB + hstepB, voffB); PG8_STAGE(PG8_SA(0, 0), cA, voffA); PG8_STAGE(PG8_SA(0, 1), cA + hstepA, voffA);
        if (wr == 1) PG8_BAR;
        PG8_WAIT_V(2); PG8_BAR;
        PG8_STAGE(PG8_SB(1, 0), cB + kstep, voffB); PG8_STAGE(PG8_SA(1, 0), cA + kstep, voffA); PG8_STAGE(PG8_SB(1, 1), cB + hstepB + kstep, voffB);
        PG8_WAIT_V(6); PG8_BAR;
    } else {
        PG8_STAGE(PG8_SB(0, 0), cB, voffB); PG8_STAGE(PG8_SA(0, 0), cA, voffA); PG8_STAGE(PG8_SB(0, 1), cB + hstepB, voffB); PG8_STAGE(PG8_SA(0, 1), cA + hstepA, voffA);
        if (wr == 1) PG8_BAR;
        PG8_WAIT_V(4); PG8_BAR;
        PG8_STAGE(PG8_SB(1, 0), cB + kstep, voffB); PG8_STAGE(PG8_SA(1, 0), cA + kstep, voffA); PG8_STAGE(PG8_SB(1, 1), cB + hstepB + kstep, voffB);
        PG8_WAIT_V(6); PG8_BAR;
    }
    for (;;) {
        const bool has_next = S.next(ui + 1, nxt);
        const char* nA = has_next ? (const char*)g.A + (size_t)nxt.pm * tstepA : cA; const char* nB = has_next ? (const char*)g.Bt + (size_t)nxt.pn * tstepB : cB;
        for (int t = 0; t < nt; t += 2) {
            const bool last = (t == nt - 2);
            const char* a1 = cA + (size_t)(t + 1) * kstep;
            const char* a2 = last ? nA : cA + (size_t)(t + 2) * kstep; const char* b2 = last ? nB : cB + (size_t)(t + 2) * kstep;
            const char* a3 = a2 + kstep; const char* b3 = b2 + kstep;
            if (last && has_next) S.a_ready(nxt);
            if constexpr (SP2) {
            PG8_LDB(B0, 0, 0); PG8_LDB(B1, 0, 1); PG8_SCHED; PG8_LDA(At, 0, 0); PG8_STAGE(PG8_SA(1, 1), a1 + hstepA, voffA);
            PG8_WAIT_V(8); PG8_WAIT_L(0); PG8_BAR; PG8_MMA(0, 0, At, B0); PG8_MMA(0, 1, At, B1); PG8_BAR; PG8_SCHED;
            PG8_LDA(At, 0, 1); PG8_STAGE(PG8_SB(0, 0), b2, voffB); PG8_STAGE(PG8_SB(0, 1), b2 + hstepB, voffB); PG8_STAGE(PG8_SA(0, 0), a2, voffA);
            PG8_WAIT_V(8); PG8_WAIT_L(0); PG8_BAR; PG8_MMA(1, 0, At, B0); PG8_MMA(1, 1, At, B1); PG8_BAR; PG8_SCHED;
            PG8_LDB(B0, 1, 0); PG8_LDB(B1, 1, 1); PG8_SCHED; PG8_LDA(At, 1, 0); PG8_STAGE(PG8_SA(0, 1), a2 + hstepA, voffA);
            PG8_WAIT_V(8); PG8_WAIT_L(0); PG8_BAR; PG8_MMA(0, 0, At, B0); PG8_MMA(0, 1, At, B1); PG8_BAR; PG8_SCHED;
            PG8_LDA(At, 1, 1); PG8_STAGE(PG8_SB(1, 0), b3, voffB); PG8_STAGE(PG8_SB(1, 1), b3 + hstepB, voffB); PG8_STAGE(PG8_SA(1, 0), a3, voffA);
            PG8_WAIT_V(8); PG8_WAIT_L(0); PG8_BAR; PG8_MMA(1, 0, At, B0); PG8_MMA(1, 1, At, B1); PG8_BAR; PG8_SCHED;
            } else {
            PG8_LDB(B0, 0, 0); PG8_SCHED; PG8_LDA(At, 0, 0); PG8_STAGE(PG8_SA(1, 1), a1 + hstepA, voffA);
            PG8_WAIT_L(8); PG8_BAR; PG8_WAIT_L(0); PG8_MMA(0, 0, At, B0); PG8_BAR; PG8_SCHED;
            PG8_LDB(B1, 0, 1); PG8_STAGE(PG8_SB(0, 0), b2, voffB);
            PG8_BAR; PG8_WAIT_L(0); PG8_MMA(0, 1, At, B1); PG8_BAR;
            PG8_LDA(At, 0, 1); PG8_STAGE(PG8_SA(0, 0), a2, voffA);
            PG8_BAR; PG8_WAIT_L(0); PG8_MMA(1, 0, At, B0); PG8_BAR; PG8_SCHED;
            PG8_STAGE(PG8_SB(0, 1), b2 + hstepB, voffB);
            PG8_WAIT_V(6); PG8_BAR; PG8_MMA(1, 1, At, B1); PG8_BAR;
            PG8_LDB(B0, 1, 0); PG8_SCHED; PG8_LDA(At, 1, 0); PG8_STAGE(PG8_SA(0, 1), a2 + hstepA, voffA);
            PG8_WAIT_L(8); PG8_BAR; PG8_WAIT_L(0); PG8_MMA(0, 0, At, B0); PG8_BAR; PG8_SCHED;
            PG8_LDB(B1, 1, 1); PG8_STAGE(PG8_SB(1, 0), b3, voffB);
            PG8_BAR; PG8_WAIT_L(0); PG8_MMA(0, 1, At, B1); PG8_BAR;
            PG8_LDA(At, 1, 1); PG8_STAGE(PG8_SA(1, 0), a3, voffA);
            PG8_BAR; PG8_WAIT_L(0); PG8_MMA(1, 0, At, B0); PG8_BAR; PG8_SCHED;
            PG8_STAGE(PG8_SB(1, 1), b3 + hstepB, voffB);
            PG8_WAIT_V(6); PG8_BAR; PG8_MMA(1, 1, At, B1); PG8_BAR;
            }
        }
        if constexpr (ALIGN_EPI) { if (wr == 0) PG8_BAR; }
        if constexpr (!Epi::AFTER_DRAIN) { E(acc, cur, wr, wc, fr, fq); S.done(cur); }
        if (!has_next) break;
#pragma unroll
        for (int a = 0; a < 2; ++a)
#pragma unroll
            for (int b = 0; b < 2; ++b)
#pragma unroll
                for (int m = 0; m < 4; ++m)
#pragma unroll
                    for (int n = 0; n < 2; ++n) acc[a][b][m][n] = (f32x4){0.f, 0.f, 0.f, 0.f};
        cur = nxt; cA = nA; cB = nB; ++ui;
        if constexpr (ALIGN_EPI) { if (wr == 1) PG8_BAR; }
    }
    PG8_WAIT_V(0);
    if constexpr (!ALIGN_EPI) { if (wr == 0) PG8_BAR; }
    PG8_BAR;
    if constexpr (Epi::AFTER_DRAIN) { E.fused(acc, cur, wr, wc, fr, fq, lds, wid, lane); S.done(cur); }
#undef PG8_SA
#undef PG8_SB
#undef PG8_STAGE
#undef PG8_LDA
#undef PG8_LDB
#undef PG8_MMA
#undef PG8_WAIT_V
#undef PG8_WAIT_L
#undef PG8_BAR
#undef PG8_SCHED
}
}

#define GAS __attribute__((address_space(1)))
#define LAS __attribute__((address_space(3)))
typedef unsigned short bf16_t;
typedef short bf16x8 __attribute__((ext_vector_type(8)));
typedef float f32x4 __attribute__((ext_vector_type(4)));
typedef unsigned u32x4 __attribute__((ext_vector_type(4)));
typedef unsigned u32x2 __attribute__((ext_vector_type(2)));

constexpr int DM = 1024, NBATCH = 2, SEQ = 8192, MEML = 256, MTOK = NBATCH * SEQ;
constexpr int INW = 12320, LD = 12544;
constexpr int C_Z = 0, C_X = 2048, C_B = 4096, C_C = 4608, C_LG = 5120, C_LX = 6656, C_Q = 8192, C_G = 9216, C_DT = 12288;
constexpr int C_MRG = 2048;
constexpr int NHEAD = 32, HDIM = 64, NGRP = 4, NSTATE = 128, CHUNK = 128, NCHUNK = SEQ / CHUNK;
constexpr int LRUW = 1536, LRUB = 96, NLB = 16, LSEG = 512, NSEG = SEQ / LSEG;
constexpr float EPS = 1e-6f;
constexpr size_t MiB = 1u << 20;
constexpr size_t WS_WIN = 0, WS_WKV = 25 * MiB, WS_WSSD = 29 * MiB, WS_WLRU = 33 * MiB, WS_WMEM = 36 * MiB, WS_WOUT = 38 * MiB;
constexpr size_t WS_PROJ = 40 * MiB;
constexpr size_t WS_MEMN = 236 * MiB, WS_KVK = 237 * MiB, WS_KVVT = 238 * MiB, WS_LRUWA = 239 * MiB, WS_LRUWX = 239 * MiB + 512 * 1024;
constexpr size_t WS_DASUM = 240 * MiB;
constexpr size_t WS_LAGG = 241 * MiB;
constexpr size_t WS_LCAR = 242 * MiB;
constexpr size_t WS_CTL = 244 * MiB;
constexpr size_t WS_XBUF = 245 * MiB;
constexpr size_t WS_END = 256 * MiB;
static_assert(WS_PROJ + (size_t)SEQ * LD * 2 <= WS_MEMN, "ws map");
constexpr int LDS_BYTES = 155648;

struct Params {
    const float *x, *mem, *norm_g, *w_in, *ssd_conv_w, *ssd_conv_b, *ssd_dt_bias, *ssd_a_log, *ssd_d, *ssd_norm_g,
        *lru_conv_w, *lru_conv_b, *lru_w_a, *lru_b_a, *lru_w_x, *lru_b_x, *lru_lambda, *mem_norm_g, *w_kv,
        *w_br_ssd, *w_br_lru, *w_br_mem, *w_out, *final_g;
    float* out; unsigned char* ws;
    int lo, hi;
};

__device__ __forceinline__ float bf2f(bf16_t v) { return __uint_as_float((unsigned)v << 16); }
__device__ __forceinline__ unsigned f2bf(float f) { unsigned u = __float_as_uint(f); return (u + 0x7fffu + ((u >> 16) & 1u)) >> 16; }
__device__ __forceinline__ unsigned pk2(float lo, float hi) { return f2bf(lo) | (f2bf(hi) << 16); }
__device__ __forceinline__ float sigmoidf_(float v) { return 1.f / (1.f + __expf(-v)); }
__device__ __forceinline__ float siluf_(float v) { return v / (1.f + __expf(-v)); }
__device__ __forceinline__ float softplusf_(float v) { return v > 20.f ? v : log1pf(__expf(v)); }
__device__ __forceinline__ float wave_sum(float v) {
#pragma unroll
    for (int o = 1; o < 64; o <<= 1) v += __shfl_xor(v, o);
    return v;
}
template <class T> __device__ __forceinline__ T* opq(T* q) { asm volatile("" : "+s"(q)); return q; }
__device__ __forceinline__ int opq_tid() { int t = threadIdx.x; asm volatile("" : "+v"(t)); return t; }
__device__ __forceinline__ int opq_bid() { int t = blockIdx.x; asm volatile("" : "+s"(t)); return t; }
__device__ __forceinline__ unsigned char* wsb(const Params& p) { return opq(p.ws); }
__device__ __forceinline__ bf16_t* proj_ptr(const Params& p) { return (bf16_t*)(wsb(p) + WS_PROJ); }
__device__ __forceinline__ bf16_t* xn_ptr(const Params& p) { return (bf16_t*)((unsigned char*)opq(p.out) + 32 * MiB); }
__device__ __forceinline__ bf16_t* states_ptr(const Params& p, int b) { return (bf16_t*)((unsigned char*)opq(p.out) + (size_t)b * 32 * MiB); }
__device__ __forceinline__ float* scr_ptr(const Params& p, int b) { return (float*)((unsigned char*)opq(p.out) + (size_t)b * 32 * MiB); }

__device__ __forceinline__ void transpose_item(const float* W, int K, int Ns, int srccol0, bf16_t* WT, int dstrow0, LAS float* scr, int k0, int lane) {
#pragma unroll 8
    for (int i = 0; i < 32; ++i) { const int kk = 2 * i + (lane >> 5); scr[kk * 33 + (lane & 31)] = W[(size_t)(k0 + kk) * Ns + srccol0 + (lane & 31)]; }
    asm volatile("s_waitcnt lgkmcnt(0)" ::: "memory");
    const int c = lane & 7;
#pragma unroll
    for (int j = 0; j < 4; ++j) { const int n = (lane >> 3) + 8 * j; const LAS float* s = scr + (8 * c) * 33 + n;
        u32x4 o; o.x = pk2(s[0 * 33], s[1 * 33]); o.y = pk2(s[2 * 33], s[3 * 33]); o.z = pk2(s[4 * 33], s[5 * 33]); o.w = pk2(s[6 * 33], s[7 * 33]);
        *(u32x4*)(WT + (size_t)(dstrow0 + n) * K + k0 + 8 * c) = o; }
    asm volatile("s_waitcnt lgkmcnt(0)" ::: "memory");
}
__device__ __forceinline__ void rms_row_to_bf16(const float* xrow, const float* g, bf16_t* orow, int lane) {
    const f32x4* xr = (const f32x4*)xrow + lane; const f32x4* gr = (const f32x4*)g + lane;
    f32x4 v[4]; float s = 0.f;
#pragma unroll
    for (int j = 0; j < 4; ++j) { v[j] = xr[64 * j]; s += (v[j].x * v[j].x + v[j].y * v[j].y) + (v[j].z * v[j].z + v[j].w * v[j].w); }
    const float rs = 1.f / sqrtf(wave_sum(s) * (1.f / DM) + EPS);
    unsigned long long* o8 = (unsigned long long*)orow + lane;
#pragma unroll
    for (int j = 0; j < 4; ++j) { const f32x4 gg = gr[64 * j];
        o8[64 * j] = (unsigned long long)pk2(v[j].x * rs * gg.x, v[j].y * rs * gg.y) | ((unsigned long long)pk2(v[j].z * rs * gg.z, v[j].w * rs * gg.w) << 32); }
}
__device__ __forceinline__ void phase0(const Params& p, LAS unsigned char* lds) {
    const int tid = opq_tid(), lane = tid & 63, wave = tid >> 6, bid = opq_bid();
    const int gw = bid * 8 + wave, NGW = gridDim.x * 8;
    LAS float* scr = (LAS float*)(lds + wave * 8704);
    bf16_t* Win = (bf16_t*)(wsb(p) + WS_WIN); bf16_t* Wkv = (bf16_t*)(wsb(p) + WS_WKV); bf16_t* Wssd = (bf16_t*)(wsb(p) + WS_WSSD);
    bf16_t* Wlru = (bf16_t*)(wsb(p) + WS_WLRU); bf16_t* Wmem = (bf16_t*)(wsb(p) + WS_WMEM); bf16_t* Wout = (bf16_t*)(wsb(p) + WS_WOUT);
    constexpr int I_IN = 16 * 385, I_KV = 16 * 64, I_SSD = 32 * 32, I_LRU = 24 * 32, I_MEM = 16 * 32, I_OUT = 16 * 32;
    constexpr int NITEMS = I_IN + I_KV + I_SSD + I_LRU + I_MEM + I_OUT;
    for (int it = gw; it < NITEMS; it += NGW) {
        int r = it;
        if (r < I_IN) { const int nb = r % 385, kb = r / 385; const int sc = 32 * nb; int dr;
            if (sc < 5120) dr = sc; else if (sc < 5152) dr = sc - 5120 + C_DT; else dr = sc - 32;
            transpose_item(opq(p.w_in), 1024, INW, sc, Win, dr, scr, 64 * kb, lane); continue; } r -= I_IN;
        if (r < I_KV) { transpose_item(opq(p.w_kv), 1024, 2048, 32 * (r % 64), Wkv, 32 * (r % 64), scr, 64 * (r / 64), lane); continue; } r -= I_KV;
        if (r < I_SSD) { transpose_item(opq(p.w_br_ssd), 2048, 1024, 32 * (r % 32), Wssd, 32 * (r % 32), scr, 64 * (r / 32), lane); continue; } r -= I_SSD;
        if (r < I_LRU) { transpose_item(opq(p.w_br_lru), 1536, 1024, 32 * (r % 32), Wlru, 32 * (r % 32), scr, 64 * (r / 32), lane); continue; } r -= I_LRU;
        if (r < I_MEM) { transpose_item(opq(p.w_br_mem), 1024, 1024, 32 * (r % 32), Wmem, 32 * (r % 32), scr, 64 * (r / 32), lane); continue; } r -= I_MEM;
        transpose_item(opq(p.w_out), 1024, 1024, 32 * (r % 32), Wout, 32 * (r % 32), scr, 64 * (r / 32), lane);
    }
    { const int gt = bid * 512 + tid, NT = gridDim.x * 512; u32x4* z = (u32x4*)(Win + (size_t)INW * 1024);
      for (int i = gt; i < (LD - INW) * 1024 / 8; i += NT) z[i] = (u32x4){0u, 0u, 0u, 0u}; }
    { const int gt = bid * 512 + tid, NT = gridDim.x * 512; bf16_t* wa = (bf16_t*)(wsb(p) + WS_LRUWA); bf16_t* wx = (bf16_t*)(wsb(p) + WS_LRUWX);
      for (int e = gt; e < NLB * LRUB * LRUB; e += NT) { const int n = e / (LRUB * LRUB), r2 = e % (LRUB * LRUB), j = r2 / LRUB, i = r2 % LRUB;
          wa[e] = (bf16_t)f2bf(opq(p.lru_w_a)[(n * LRUB + i) * LRUB + j]); wx[e] = (bf16_t)f2bf(opq(p.lru_w_x)[(n * LRUB + i) * LRUB + j]); } }
    bf16_t* XN = xn_ptr(p); bf16_t* MN = (bf16_t*)(wsb(p) + WS_MEMN);
    for (int m = gw; m < MTOK; m += NGW) rms_row_to_bf16(opq(p.x) + (size_t)m * DM, opq(p.norm_g), XN + (size_t)m * DM, lane);
    for (int m = gw; m < NBATCH * MEML; m += NGW) rms_row_to_bf16(opq(p.mem) + (size_t)m * DM, opq(p.mem_norm_g), MN + (size_t)m * DM, lane);
}
__device__ __forceinline__ void phase7(const Params& p) {
    const int tid = opq_tid(), lane = tid & 63, wave = tid >> 6; const int gw = opq_bid() * 8 + wave, NGW = gridDim.x * 8; float* outb = opq(p.out); const float* fg = opq(p.final_g);
    for (int m = gw; m < MTOK; m += NGW) {
        f32x4* xr = (f32x4*)(outb + (size_t)m * DM) + lane; const f32x4* gr = (const f32x4*)fg + lane;
        f32x4 v[4]; float s = 0.f;
#pragma unroll
        for (int j = 0; j < 4; ++j) { v[j] = xr[64 * j]; s += (v[j].x * v[j].x + v[j].y * v[j].y) + (v[j].z * v[j].z + v[j].w * v[j].w); }
        const float rs = 1.f / sqrtf(wave_sum(s) * (1.f / DM) + EPS);
#pragma unroll
        for (int j = 0; j < 4; ++j) { const f32x4 gg = gr[64 * j]; xr[64 * j] = v[j] * rs * gg; }
    }
}

namespace pg8 {
template <int BR> struct EpiMerge {
    static constexpr bool PERM = true, AFTER_DRAIN = false;
    bf16_t* P; float* scr;
    __device__ __forceinline__ void operator()(const f32x4 (&acc)[2][2][4][2], const Unit& u, int wr, int wc, int fr, int fq) const {
        const int row0 = u.pm * BM + wr * 64 + fr, col0 = u.pn * BM + wc * 32 + 8 * fq;
#pragma unroll
        for (int ai = 0; ai < 2; ++ai)
#pragma unroll
            for (int m = 0; m < 4; ++m) { const size_t r = (size_t)(row0 + ai * HALF + m * 16);
#pragma unroll
                for (int bj = 0; bj < 2; ++bj) { const int c = col0 + bj * HALF;
                    const u32x4 gw = *(const u32x4*)(P + r * 12544 + 9216 + BR * 1024 + c);
                    float g[8];
#pragma unroll
                    for (int i = 0; i < 4; ++i) { g[2 * i] = __uint_as_float(gw[i] << 16); g[2 * i + 1] = __uint_as_float(gw[i] & 0xffff0000u); }
                    f32x4 v0 = acc[ai][bj][m][0], v1 = acc[ai][bj][m][1];
#pragma unroll
                    for (int i = 0; i < 4; ++i) { v0[i] *= 1.f / (1.f + __expf(-g[i])); v1[i] *= 1.f / (1.f + __expf(-g[4 + i])); }
                    float* sp = scr + r * 1024 + c;
                    if (BR > 0) { v0 += *(const f32x4*)sp; v1 += *(const f32x4*)(sp + 4); }
                    if (BR < 2) { *(f32x4*)sp = v0; *(f32x4*)(sp + 4) = v1; }
                    else { u32x4 w; w.x = cvt_pk_bf16(v0[0], v0[1]); w.y = cvt_pk_bf16(v0[2], v0[3]); w.z = cvt_pk_bf16(v1[0], v1[1]); w.w = cvt_pk_bf16(v1[2], v1[3]);
                        *(u32x4*)(P + r * 12544 + 2048 + c) = w; } } }
    }
};
template <int BR, bool FINAL> struct EpiMerge2 {
    static constexpr bool PERM = true, AFTER_DRAIN = false;
    bf16_t* P; float* s0; int ld0; const float* s1; int ld1;
    __device__ __forceinline__ void operator()(const f32x4 (&acc)[2][2][4][2], const Unit& u, int wr, int wc, int fr, int fq) const {
        const int row0 = u.pm * BM + wr * 64 + fr, col0 = u.pn * BM + wc * 32 + 8 * fq;
#pragma unroll
        for (int ai = 0; ai < 2; ++ai)
#pragma unroll
            for (int m = 0; m < 4; ++m) { const size_t r = (size_t)(row0 + ai * HALF + m * 16);
#pragma unroll
                for (int bj = 0; bj < 2; ++bj) { const int c = col0 + bj * HALF;
                    const u32x4 gw = *(const u32x4*)(P + r * 12544 + 9216 + BR * 1024 + c);
                    float g[8];
#pragma unroll
                    for (int i = 0; i < 4; ++i) { g[2 * i] = __uint_as_float(gw[i] << 16); g[2 * i + 1] = __uint_as_float(gw[i] & 0xffff0000u); }
                    f32x4 v0 = acc[ai][bj][m][0], v1 = acc[ai][bj][m][1];
#pragma unroll
                    for (int i = 0; i < 4; ++i) { v0[i] *= 1.f / (1.f + __expf(-g[i])); v1[i] *= 1.f / (1.f + __expf(-g[4 + i])); }
                    float* sp = s0 + r * ld0 + c;
                    if (!FINAL) { *(f32x4*)sp = v0; *(f32x4*)(sp + 4) = v1; }
                    else { const float* sq = s1 + r * ld1 + c;
                        v0 += *(const f32x4*)sp + *(const f32x4*)sq; v1 += *(const f32x4*)(sp + 4) + *(const f32x4*)(sq + 4);
                        u32x4 w; w.x = cvt_pk_bf16(v0[0], v0[1]); w.y = cvt_pk_bf16(v0[2], v0[3]); w.z = cvt_pk_bf16(v1[0], v1[1]); w.w = cvt_pk_bf16(v1[2], v1[3]);
                        *(u32x4*)(P + r * 12544 + 4096 + c) = w; } } }
    }
};
struct EpiOut {
    static constexpr bool PERM = false, AFTER_DRAIN = false;
    const float* xres; float* out;
    __device__ __forceinline__ void operator()(const f32x4 (&acc)[2][2][4][2], const Unit& u, int wr, int wc, int fr, int fq) const {
        const int row0 = u.pm * BM + wr * 64 + fr, col0 = u.pn * BM + wc * 32 + 4 * fq;
#pragma unroll
        for (int ai = 0; ai < 2; ++ai)
#pragma unroll
            for (int m = 0; m < 4; ++m) { const size_t off = (size_t)(row0 + ai * HALF + m * 16) * 1024 + col0;
#pragma unroll
                for (int bj = 0; bj < 2; ++bj)
#pragma unroll
                    for (int n = 0; n < 2; ++n) *(f32x4*)(out + off + bj * HALF + n * 16) = *(const f32x4*)(xres + off + bj * HALF + n * 16) + acc[ai][bj][m][n]; }
    }
};
struct EpiOutNorm {
    static constexpr bool PERM = false, AFTER_DRAIN = true;
    const float* xres; float* out; const float* fg; float* xbuf; unsigned* cnt;
    __device__ __forceinline__ void fused(f32x4 (&acc)[2][2][4][2], const Unit& u, int wr, int wc, int fr, int fq, PG8_LAS unsigned char* lds, int wid, int lane) const {
        PG8_LAS float* Pp = (PG8_LAS float*)lds; PG8_LAS float* Sr = (PG8_LAS float*)(lds + 4096);
        const int row0 = u.pm * BM + wr * 64 + fr, col0 = u.pn * BM + wc * 32 + 4 * fq;
#pragma unroll
        for (int ai = 0; ai < 2; ++ai)
#pragma unroll
            for (int m = 0; m < 4; ++m) { const size_t off = (size_t)(row0 + ai * HALF + m * 16) * 1024 + col0; float s = 0.f;
#pragma unroll
                for (int bj = 0; bj < 2; ++bj)
#pragma unroll
                    for (int n = 0; n < 2; ++n) { const f32x4 v = acc[ai][bj][m][n] + *(const f32x4*)(xres + off + bj * HALF + n * 16); acc[ai][bj][m][n] = v; s += (v[0] * v[0] + v[1] * v[1]) + (v[2] * v[2] + v[3] * v[3]); }
                s += __shfl_xor(s, 16); s += __shfl_xor(s, 32);
                if (fq == 0) Pp[(ai * HALF + wr * 64 + m * 16 + fr) * 4 + wc] = s;
                if (m & 1) asm volatile("" ::: "memory"); }
        asm volatile("s_waitcnt lgkmcnt(0)" ::: "memory"); __builtin_amdgcn_s_barrier(); asm volatile("" ::: "memory");
        const int tid = wid * 64 + lane;
        if (tid < 256) { const float s = (Pp[tid * 4 + 0] + Pp[tid * 4 + 1]) + (Pp[tid * 4 + 2] + Pp[tid * 4 + 3]);
            __hip_atomic_store(xbuf + (size_t)(u.pm * BM + tid) * 4 + u.pn, s, __ATOMIC_RELAXED, __HIP_MEMORY_SCOPE_AGENT); }
        asm volatile("s_waitcnt vmcnt(0)" ::: "memory");
        if (wid < 4 && lane == 0) __hip_atomic_fetch_add(cnt + 64 * u.pm, 1u, __ATOMIC_RELAXED, __HIP_MEMORY_SCOPE_AGENT);
        if (wid == 0) { unsigned spins = 0;
            while ((unsigned)__builtin_amdgcn_readfirstlane(__hip_atomic_load(cnt + 64 * u.pm, __ATOMIC_RELAXED, __HIP_MEMORY_SCOPE_AGENT)) < 16u && ++spins < (1u << 22)) __builtin_amdgcn_s_sleep(2);
            __builtin_amdgcn_fence(__ATOMIC_ACQUIRE, "agent"); }
        asm volatile("s_waitcnt vmcnt(0) lgkmcnt(0)" ::: "memory"); __builtin_amdgcn_s_barrier(); asm volatile("" ::: "memory");
        if (tid < 256) { const float* slot = xbuf + (size_t)(u.pm * BM + tid) * 4; float s = 0.f;
#pragma unroll
            for (int q = 0; q < 4; ++q) s += __hip_atomic_load(slot + q, __ATOMIC_RELAXED, __HIP_MEMORY_SCOPE_AGENT);
            Sr[tid] = 1.0f / sqrtf(s * (1.f / 1024.f) + 1e-6f); }
        asm volatile("s_waitcnt lgkmcnt(0)" ::: "memory"); __builtin_amdgcn_s_barrier(); asm volatile("" ::: "memory");
#pragma unroll
        for (int ai = 0; ai < 2; ++ai)
#pragma unroll
            for (int m = 0; m < 4; ++m) { const int r = ai * HALF + wr * 64 + m * 16 + fr; const float rs = Sr[r]; const size_t off = (size_t)(u.pm * BM + r) * 1024 + col0;
#pragma unroll
                for (int bj = 0; bj < 2; ++bj)
#pragma unroll
                    for (int n = 0; n < 2; ++n) { const f32x4 gg = *(const f32x4*)(fg + col0 + bj * HALF + n * 16); *(f32x4*)(out + off + bj * HALF + n * 16) = acc[ai][bj][m][n] * rs * gg; } }
    }
};
}
#define PG8_SP2 true
#define PG8_ALIGN true

__device__ __forceinline__ void phase1_gemm(const Params& p, int b, LAS unsigned char* lds) {
    const int G = gridDim.x, c = opq_bid();
    { pg8::Gemm g{xn_ptr(p) + (size_t)b * SEQ * DM, (const bf16_t*)(wsb(p) + WS_WIN), SEQ, LD, DM, DM, DM}; pg8::StaticOrder S; S.init(SEQ, LD, G, c);
      pg8::EpiBf16<0> E{proj_ptr(p), LD, nullptr, 0, 0, 1.f};
      pg8::gemm_phase<pg8::EpiBf16<0>, pg8::StaticOrder, PG8_ALIGN, PG8_SP2>(lds, g, S, E); }
    if (b == 0) {
        { pg8::Gemm g{(const bf16_t*)(wsb(p) + WS_MEMN), (const bf16_t*)(wsb(p) + WS_WKV), 512, 1024, DM, DM, DM}; pg8::StaticOrder S; S.init(512, 1024, G, (c + 16) % G);
          pg8::EpiBf16<0> E{(bf16_t*)(wsb(p) + WS_KVK), 1024, nullptr, 0, 0, 1.f};
          pg8::gemm_phase<pg8::EpiBf16<0>, pg8::StaticOrder, PG8_ALIGN, PG8_SP2>(lds, g, S, E); }
        { pg8::Gemm g{(const bf16_t*)(wsb(p) + WS_WKV) + (size_t)1024 * DM, (const bf16_t*)(wsb(p) + WS_MEMN), 1024, 512, DM, DM, DM}; pg8::StaticOrder S; S.init(1024, 512, G, (c + 8) % G);
          pg8::EpiBf16<0> E{(bf16_t*)(wsb(p) + WS_KVVT), 512, nullptr, 0, 0, 1.f};
          pg8::gemm_phase<pg8::EpiBf16<0>, pg8::StaticOrder, PG8_ALIGN, PG8_SP2>(lds, g, S, E); }
    }
}
__device__ __forceinline__ void phase5_gemm(const Params& p, int b, LAS unsigned char* lds) {
    const int G = gridDim.x, c = opq_bid(); bf16_t* P = proj_ptr(p); float* scr = scr_ptr(p, b);
    float* scrB = (float*)P + 1024;
    unsigned* flag = (unsigned*)(wsb(p) + WS_CTL) + 4096 + (b * 128 + (c & 127)) * 16;
    if (c < 128) {
        pg8::Gemm g{P + C_Z, (const bf16_t*)(wsb(p) + WS_WSSD), SEQ, DM, 2048, LD, 2048}; pg8::StaticOrder S; S.init(SEQ, DM, 128, c); pg8::EpiMerge2<0, false> E{P, scr, 1024, nullptr, 0};
        pg8::gemm_phase<pg8::EpiMerge2<0, false>, pg8::StaticOrder, false, PG8_SP2>(lds, g, S, E);
        asm volatile("s_waitcnt vmcnt(0)" ::: "memory"); __threadfence(); __syncthreads();
        if (threadIdx.x == 0) __hip_atomic_store(flag, 1u, __ATOMIC_RELAXED, __HIP_MEMORY_SCOPE_AGENT);
    } else {
        { pg8::Gemm g{P + C_LG, (const bf16_t*)(wsb(p) + WS_WLRU), SEQ, DM, 1536, LD, 1536}; pg8::StaticOrder S; S.init(SEQ, DM, 128, c - 128); pg8::EpiMerge2<1, false> E{P, scrB, LD / 2, nullptr, 0};
          pg8::gemm_phase<pg8::EpiMerge2<1, false>, pg8::StaticOrder, false, PG8_SP2>(lds, g, S, E); }
        if (threadIdx.x == 0) { unsigned spins = 0; while (__hip_atomic_load(flag, __ATOMIC_RELAXED, __HIP_MEMORY_SCOPE_AGENT) == 0u && ++spins < (1u << 22)) __builtin_amdgcn_s_sleep(2); }
        __syncthreads(); __builtin_amdgcn_fence(__ATOMIC_ACQUIRE, "agent"); asm volatile("s_waitcnt vmcnt(0)" ::: "memory");
        { pg8::Gemm g{P + C_Q, (const bf16_t*)(wsb(p) + WS_WMEM), SEQ, DM, 1024, LD, 1024}; pg8::StaticOrder S; S.init(SEQ, DM, 128, c - 128); pg8::EpiMerge2<2, true> E{P, scrB, LD / 2, scr, 1024};
          pg8::gemm_phase<pg8::EpiMerge2<2, true>, pg8::StaticOrder, false, PG8_SP2>(lds, g, S, E); }
    }
    (void)G;
}
__device__ __forceinline__ void phase6_gemm(const Params& p, int b, LAS unsigned char* lds) {
    const int G = gridDim.x, c = opq_bid(); bf16_t* P = proj_ptr(p);
    pg8::Gemm g{P + 4096, (const bf16_t*)(wsb(p) + WS_WOUT), SEQ, DM, DM, LD, DM}; pg8::StaticOrder S; S.init(SEQ, DM, G, c);
    pg8::EpiOutNorm E{opq(p.x) + (size_t)b * SEQ * DM, opq(p.out) + (size_t)b * SEQ * DM, opq(p.final_g), (float*)(wsb(p) + WS_XBUF) + (size_t)b * SEQ * 4, (unsigned*)(wsb(p) + WS_CTL) + 8192 + b * 2048};
    pg8::gemm_phase<pg8::EpiOutNorm, pg8::StaticOrder, false, PG8_SP2>(lds, g, S, E);
}
#define MFMA16(a, b, c) __builtin_amdgcn_mfma_f32_16x16x32_bf16((a), (b), (c), 0, 0, 0)
__device__ __forceinline__ bf16x8 pack8(const float (&v)[8]) {
    u32x4 w; w.x = pk2(v[0], v[1]); w.y = pk2(v[2], v[3]); w.z = pk2(v[4], v[5]); w.w = pk2(v[6], v[7]); return __builtin_bit_cast(bf16x8, w);
}
__device__ __forceinline__ void unpack8(u32x4 w, float (&v)[8]) {
#pragma unroll
    for (int i = 0; i < 4; ++i) { v[2 * i] = __uint_as_float(w[i] << 16); v[2 * i + 1] = __uint_as_float(w[i] & 0xffff0000u); }
}
__device__ __forceinline__ void attn_phase(const Params& p, int b, LAS unsigned char* lds, int dry = 0) {
    const int tid = opq_tid(), lane = tid & 63, wave = tid >> 6, fr = lane & 15, kg = lane >> 4;
    bf16_t* P = proj_ptr(p); const bf16_t* KK = (const bf16_t*)(wsb(p) + WS_KVK) + (size_t)b * 256 * 1024; const bf16_t* VT = (const bf16_t*)(wsb(p) + WS_KVVT) + b * 256;
    LAS bf16_t* sKV = (LAS bf16_t*)lds;
    for (int u = opq_bid(); u < 256; u += gridDim.x) {
        const int hd = u & 3, rt = u >> 2, q0 = rt * 128 + wave * 16;
        bf16_t* qrow = P + (size_t)(q0 + fr) * LD + C_Q + hd * 256;
        __syncthreads();
        { unsigned ko = (unsigned)((tid >> 5) * 1024 + hd * 256 + 8 * (tid & 31)); asm volatile("" : "+v"(ko));
          u32x4 st[16];
#pragma unroll
          for (int i = 0; i < 16; ++i) st[i] = *(const u32x4*)(KK + (ko + (unsigned)(i * 16 * 1024)));
#pragma unroll
          for (int i = 0; i < 16; ++i) *(LAS u32x4*)(sKV + ((tid >> 5) + 16 * i) * 264 + 8 * (tid & 31)) = st[i]; }
        bf16x8 qf[8];
#pragma unroll
        for (int s = 0; s < 8; ++s) qf[s] = *(const bf16x8*)(qrow + 32 * s + 8 * kg);
        __syncthreads();
        u32x4 vst[16];
        { unsigned vo = (unsigned)((hd * 256 + (tid >> 5)) * 512 + 8 * (tid & 31)); asm volatile("" : "+v"(vo));
#pragma unroll
          for (int i = 0; i < 16; ++i) vst[i] = *(const u32x4*)(VT + (vo + (unsigned)(i * 16 * 512))); }
        f32x4 sacc[16];
#pragma unroll
        for (int mt = 0; mt < 16; ++mt) { sacc[mt] = (f32x4){0.f, 0.f, 0.f, 0.f};
#pragma unroll
            for (int s = 0; s < 8; ++s) { const bf16x8 kf = *(const LAS bf16x8*)(sKV + (16 * mt + fr) * 264 + 32 * s + 8 * kg); sacc[mt] = MFMA16(kf, qf[s], sacc[mt]); } }
        float mx = -INFINITY;
#pragma unroll
        for (int mt = 0; mt < 16; ++mt)
#pragma unroll
            for (int j = 0; j < 4; ++j) mx = fmaxf(mx, sacc[mt][j]);
        mx = fmaxf(mx, __shfl_xor(mx, 16)); mx = fmaxf(mx, __shfl_xor(mx, 32));
        float sum = 0.f;
#pragma unroll
        for (int mt = 0; mt < 16; ++mt)
#pragma unroll
            for (int j = 0; j < 4; ++j) { const float e = __expf((sacc[mt][j] - mx) * 0.0625f); sacc[mt][j] = e; sum += e; }
        sum += __shfl_xor(sum, 16); sum += __shfl_xor(sum, 32);
        const float inv = 1.f / sum;
        bf16x8 pf[8];
#pragma unroll
        for (int s2 = 0; s2 < 8; ++s2) { u32x4 w; w.x = pk2(sacc[2 * s2][0], sacc[2 * s2][1]); w.y = pk2(sacc[2 * s2][2], sacc[2 * s2][3]);
            w.z = pk2(sacc[2 * s2 + 1][0], sacc[2 * s2 + 1][1]); w.w = pk2(sacc[2 * s2 + 1][2], sacc[2 * s2 + 1][3]); pf[s2] = __builtin_bit_cast(bf16x8, w); }
        __syncthreads();
#pragma unroll
        for (int i = 0; i < 16; ++i) *(LAS u32x4*)(sKV + ((tid >> 5) + 16 * i) * 264 + 8 * (tid & 31)) = vst[i];
        __syncthreads();
#pragma unroll 4
        for (int mt2 = 0; mt2 < 16; ++mt2) { f32x4 o = (f32x4){0.f, 0.f, 0.f, 0.f}; const LAS bf16_t* vr = sKV + (16 * mt2 + fr) * 264 + 4 * kg;
#pragma unroll
            for (int s2 = 0; s2 < 8; ++s2) { const u32x2 lo = *(const LAS u32x2*)(vr + 32 * s2), hi = *(const LAS u32x2*)(vr + 32 * s2 + 16);
                u32x4 w; w.x = lo.x; w.y = lo.y; w.z = hi.x; w.w = hi.y; o = MFMA16(__builtin_bit_cast(bf16x8, w), pf[s2], o); }
            u32x2 ow; ow.x = pk2(o[0] * inv, o[1] * inv); ow.y = pk2(o[2] * inv, o[3] * inv);
            if (!dry) *(u32x2*)(qrow + 16 * mt2 + 4 * kg) = ow; }
    }
}
template <bool FINAL> __device__ __forceinline__ void lru_phase(const Params& p, int b, LAS unsigned char* lds, int dry = 0) {
    const int tid = opq_tid(), lane = tid & 63, wave = tid >> 6, fr = lane & 15, kg = lane >> 4;
    bf16_t* P = proj_ptr(p);
    LAS bf16_t* sWA = (LAS bf16_t*)lds; LAS bf16_t* sWX = (LAS bf16_t*)(lds + 19968);
    LAS float* sCW = (LAS float*)(lds + 39936); LAS float* sCB = sCW + 384; LAS float* sBA = sCB + 96; LAS float* sBX = sBA + 96; LAS float* sSP = sBX + 96;
    LAS float* sXL = (LAS float*)(lds + 43008) + wave * 1600;
    LAS float* sAG = (LAS float*)(lds + 94208);
    float* agg = (float*)(wsb(p) + WS_LAGG) + (size_t)b * NSEG * LRUW * 2;
    const float* car = (const float*)(wsb(p) + WS_LCAR) + (size_t)b * NSEG * LRUW;
    const float* lcw = opq(p.lru_conv_w); const float* lcb = opq(p.lru_conv_b); const float* lba = opq(p.lru_b_a); const float* lbx = opq(p.lru_b_x); const float* lam = opq(p.lru_lambda);
    for (int u = opq_bid(); u < NLB * NSEG; u += gridDim.x) {
        const int n = u % NLB, sg = u / NLB;
        __syncthreads();
        { const bf16_t* gwa = (const bf16_t*)(wsb(p) + WS_LRUWA) + n * 9216; const bf16_t* gwx = (const bf16_t*)(wsb(p) + WS_LRUWX) + n * 9216;
          for (int e = tid; e < 96 * 12; e += 512) { const int j = e / 12, c8 = e % 12;
              *(LAS u32x4*)(sWA + j * 104 + 8 * c8) = *(const u32x4*)(gwa + j * 96 + 8 * c8); *(LAS u32x4*)(sWX + j * 104 + 8 * c8) = *(const u32x4*)(gwx + j * 96 + 8 * c8); }
          if (tid < 384) sCW[tid] = lcw[(tid / 96) * 1536 + n * 96 + tid % 96];
          if (tid < 96) { sCB[tid] = lcb[n * 96 + tid]; sBA[tid] = lba[n * 96 + tid]; sBX[tid] = lbx[n * 96 + tid]; sSP[tid] = softplusf_(-lam[n * 96 + tid]); } }
        __syncthreads();
        float runA[6], runH[6];
#pragma unroll
        for (int nt = 0; nt < 6; ++nt) { runA[nt] = 1.f; runH[nt] = FINAL ? car[sg * LRUW + n * 96 + 16 * nt + fr] : 0.f; }
        int par = 0;
        for (int step = 0; step < 4; ++step) {
            const int tb = sg * LSEG + step * 128 + wave * 16;
            bf16x8 af[3];
#pragma unroll
            for (int ks = 0; ks < 3; ++ks) { const int ch0 = 32 * ks + 8 * kg; float xl[8];
#pragma unroll
                for (int i = 0; i < 8; ++i) xl[i] = sCB[ch0 + i];
#pragma unroll
                for (int k = 0; k < 4; ++k) { const int t = tb + fr - 3 + k; const int tc = t < 0 ? 0 : t;
                    u32x4 raw = *(const u32x4*)(P + (size_t)tc * LD + C_LX + n * 96 + ch0); if (t < 0) raw = (u32x4){0u, 0u, 0u, 0u};
                    float rv[8]; unpack8(raw, rv);
#pragma unroll
                    for (int i = 0; i < 8; ++i) xl[i] += sCW[k * 96 + ch0 + i] * rv[i]; }
                *(LAS f32x4*)(sXL + fr * 100 + ch0) = (f32x4){xl[0], xl[1], xl[2], xl[3]}; *(LAS f32x4*)(sXL + fr * 100 + ch0 + 4) = (f32x4){xl[4], xl[5], xl[6], xl[7]};
                af[ks] = pack8(xl); }
            f32x4 aR[6], aI[6];
#pragma unroll
            for (int nt = 0; nt < 6; ++nt) { aR[nt] = (f32x4){0.f, 0.f, 0.f, 0.f}; aI[nt] = (f32x4){0.f, 0.f, 0.f, 0.f};
#pragma unroll
                for (int ks = 0; ks < 3; ++ks) { const bf16x8 wa = *(const LAS bf16x8*)(sWA + (16 * nt + fr) * 104 + 32 * ks + 8 * kg), wx = *(const LAS bf16x8*)(sWX + (16 * nt + fr) * 104 + 32 * ks + 8 * kg);
                    aR[nt] = MFMA16(af[ks], wa, aR[nt]); aI[nt] = MFMA16(af[ks], wx, aI[nt]); } }
            float Ainc[6][4], Hinc[6][4], Ap[6], Hp[6];
#pragma unroll
            for (int nt = 0; nt < 6; ++nt) { const int j = 16 * nt + fr; const float ba = sBA[j], bx = sBX[j], sp = sSP[j];
                float A = 1.f, H = 0.f;
#pragma unroll
                for (int r = 0; r < 4; ++r) { const float xlv = sXL[(4 * kg + r) * 100 + j];
                    const float rr = sigmoidf_(aR[nt][r] + ba), ii = sigmoidf_(aI[nt][r] + bx), la = -8.f * rr * sp, a = __expf(la), mult = sqrtf(fmaxf(0.f, 1.f - __expf(2.f * la)));
                    H = a * H + mult * ii * xlv; A *= a; Ainc[nt][r] = A; Hinc[nt][r] = H; }
                float ap = 1.f, hp = 0.f, at = 1.f, ht = 0.f;
#pragma unroll
                for (int k = 0; k < 4; ++k) { const float ab = __shfl(A, fr + 16 * k), hb = __shfl(H, fr + 16 * k);
                    if (k < kg) { hp = ab * hp + hb; ap *= ab; } ht = ab * ht + hb; at *= ab; }
                Ap[nt] = ap; Hp[nt] = hp;
                if (kg == 0) { sAG[((par * 8 + wave) * 96 + j) * 2] = at; sAG[((par * 8 + wave) * 96 + j) * 2 + 1] = ht; } }
            __syncthreads();
#pragma unroll
            for (int nt = 0; nt < 6; ++nt) { const int j = 16 * nt + fr; float cA = runA[nt], cH = runH[nt], rA = runA[nt], rH = runH[nt];
#pragma unroll
                for (int w2 = 0; w2 < 8; ++w2) { const float a2 = sAG[((par * 8 + w2) * 96 + j) * 2], h2 = sAG[((par * 8 + w2) * 96 + j) * 2 + 1];
                    if (w2 < wave) { cH = a2 * cH + h2; cA *= a2; } rH = a2 * rH + h2; rA *= a2; }
                runA[nt] = rA; runH[nt] = rH;
                if (FINAL) { const float hin = Ap[nt] * cH + Hp[nt];
#pragma unroll
                    for (int r = 0; r < 4; ++r) { const float hv = Ainc[nt][r] * hin + Hinc[nt][r]; bf16_t* gp = P + (size_t)(tb + 4 * kg + r) * LD + C_LG + n * 96 + j;
                        const float yv = hv * siluf_(bf2f(*gp)); if (!dry) *gp = (bf16_t)f2bf(yv); } } }
            par ^= 1;
        }
        if (!FINAL && wave == 0 && kg == 0) {
#pragma unroll
            for (int nt = 0; nt < 6; ++nt) { const int ch = n * 96 + 16 * nt + fr; agg[((size_t)sg * LRUW + ch) * 2] = runA[nt]; agg[((size_t)sg * LRUW + ch) * 2 + 1] = runH[nt]; } }
    }
}
__device__ __forceinline__ void lru_carry_phase(const Params& p, int b) {
    const int gt = opq_bid() * 512 + opq_tid();
    const float* agg = (const float*)(wsb(p) + WS_LAGG) + (size_t)b * NSEG * LRUW * 2; float* car = (float*)(wsb(p) + WS_LCAR) + (size_t)b * NSEG * LRUW;
    for (int ch = gt; ch < LRUW; ch += gridDim.x * 512) { float h = 0.f;
        for (int sg = 0; sg < NSEG; ++sg) { car[sg * LRUW + ch] = h; h = agg[((size_t)sg * LRUW + ch) * 2] * h + agg[((size_t)sg * LRUW + ch) * 2 + 1]; } }
}
__device__ __forceinline__ void conv8_silu(const bf16_t* P, int t, int col, const float* cw, const float* cb, int ch, float (&o)[8]) {
    float r[11];
    unsigned off0 = (unsigned)((t < 3 ? 0 : t - 3) * LD + col); asm volatile("" : "+v"(off0));
    if (t >= 3) {
#pragma unroll
        for (int i = 0; i < 11; ++i) r[i] = bf2f(P[off0 + (unsigned)(i * LD)]);
    } else {
#pragma unroll
        for (int i = 0; i < 11; ++i) { const int tt = t - 3 + i; const float v = bf2f(P[off0 + (unsigned)((tt < 0 ? 0 : tt) * LD)]); r[i] = tt < 0 ? 0.f : v; }
    }
    const float w0 = cw[ch], w1 = cw[3072 + ch], w2 = cw[6144 + ch], w3 = cw[9216 + ch], bb = cb[ch];
#pragma unroll
    for (int j = 0; j < 8; ++j) o[j] = siluf_(bb + w0 * r[j] + w1 * r[j + 1] + w2 * r[j + 2] + w3 * r[j + 3]);
}
__device__ __forceinline__ float ssd_dt_setup(const Params& p, const bf16_t* P, int t0, int h, int lane, LAS float* sACS, LAS float* sDT) {
    const float dtb = opq(p.ssd_dt_bias)[h], an = -__expf(opq(p.ssd_a_log)[h]);
    const float dt0 = softplusf_(bf2f(P[(size_t)(t0 + 2 * lane) * LD + C_DT + h]) + dtb), dt1 = softplusf_(bf2f(P[(size_t)(t0 + 2 * lane + 1) * LD + C_DT + h]) + dtb);
    const float dA1 = dt1 * an; float s = dt0 * an + dA1;
#pragma unroll
    for (int o = 1; o < 64; o <<= 1) { const float t = __shfl_up(s, o); if (lane >= o) s += t; }
    sACS[2 * lane] = s - dA1; sACS[2 * lane + 1] = s; sDT[2 * lane] = dt0; sDT[2 * lane + 1] = dt1;
    return __shfl(s, 63);
}
template <int R> __device__ __forceinline__ void conv_rows(const bf16_t* P, int t, int col, const float* cw, const float* cb, int ch, float (&o)[R][8]) {
    unsigned off0 = (unsigned)((t < 3 ? 0 : t - 3) * LD + col); asm volatile("" : "+v"(off0));
    u32x4 raw[R + 3];
    if (t >= 3) {
#pragma unroll
        for (int i = 0; i < R + 3; ++i) raw[i] = *(const u32x4*)(P + (off0 + (unsigned)(i * LD)));
    } else {
#pragma unroll
        for (int i = 0; i < R + 3; ++i) { const int tt = t - 3 + i; raw[i] = *(const u32x4*)(P + (off0 + (unsigned)((tt < 0 ? 0 : tt) * LD))); if (tt < 0) raw[i] = (u32x4){0u, 0u, 0u, 0u}; }
    }
    float w[4][8], bb[8];
#pragma unroll
    for (int k = 0; k < 4; ++k) { const f32x4 w0 = *(const f32x4*)(cw + k * 3072 + ch), w1 = *(const f32x4*)(cw + k * 3072 + ch + 4);
        w[k][0] = w0[0]; w[k][1] = w0[1]; w[k][2] = w0[2]; w[k][3] = w0[3]; w[k][4] = w1[0]; w[k][5] = w1[1]; w[k][6] = w1[2]; w[k][7] = w1[3]; }
    { const f32x4 b0 = *(const f32x4*)(cb + ch), b1 = *(const f32x4*)(cb + ch + 4); bb[0] = b0[0]; bb[1] = b0[1]; bb[2] = b0[2]; bb[3] = b0[3]; bb[4] = b1[0]; bb[5] = b1[1]; bb[6] = b1[2]; bb[7] = b1[3]; }
#pragma unroll
    for (int r = 0; r < R; ++r)
#pragma unroll
        for (int q = 0; q < 8; ++q) o[r][q] = bb[q];
#pragma unroll
    for (int i = 0; i < R + 3; ++i) { float v[8]; unpack8(raw[i], v);
#pragma unroll
        for (int k = 0; k < 4; ++k) { const int r = i - k; if (r >= 0 && r < R) {
#pragma unroll
                for (int q = 0; q < 8; ++q) o[r][q] += w[k][q] * v[q]; } } }
#pragma unroll
    for (int r = 0; r < R; ++r)
#pragma unroll
        for (int q = 0; q < 8; ++q) o[r][q] = siluf_(o[r][q]);
}
__device__ __forceinline__ void ssd_states_phase(const Params& p, int b, LAS unsigned char* lds) {
    const int tid = opq_tid(), lane = tid & 63, wave = tid >> 6, fr = lane & 15, kg = lane >> 4;
    const bf16_t* P = proj_ptr(p); bf16_t* ST = states_ptr(p, b); float* dasum = (float*)(wsb(p) + WS_DASUM) + b * NCHUNK * NHEAD;
    const float* cw = opq(p.ssd_conv_w); const float* cb = opq(p.ssd_conv_b);
    LAS bf16_t* sBT = (LAS bf16_t*)lds; LAS bf16_t* sXT = (LAS bf16_t*)(lds + 34816 + wave * 8704);
    LAS float* sACS = (LAS float*)(lds + 104448) + wave * 128; LAS float* sW = (LAS float*)(lds + 108544) + wave * 128;
    for (int u = opq_bid(); u < NCHUNK * NGRP; u += gridDim.x) {
        const int c = u >> 2, g = u & 3, t0 = c * CHUNK, h = 8 * g + wave;
        __syncthreads();
        { const float tot = ssd_dt_setup(p, P, t0, h, lane, sACS, sW);
          if (lane == 0) dasum[c * NHEAD + h] = tot;
          sW[2 * lane] = sW[2 * lane] * __expf(tot - sACS[2 * lane]); sW[2 * lane + 1] = sW[2 * lane + 1] * __expf(tot - sACS[2 * lane + 1]); }
        { const int cg = tid & 15, rs = tid >> 4; float o[4][8];
          conv_rows<4>(P, t0 + 4 * rs, C_B + g * 128 + 8 * cg, cw, cb, 2048 + g * 128 + 8 * cg, o);
#pragma unroll
          for (int q = 0; q < 8; ++q) { u32x2 w; w.x = pk2(o[0][q], o[1][q]); w.y = pk2(o[2][q], o[3][q]); *(LAS u32x2*)(sBT + (8 * cg + q) * 136 + 4 * rs) = w; } }
        __syncthreads();
        for (int ph = 0; ph < 2; ++ph) {
            { const int cg = lane & 3, rs = lane >> 2; float o[8][8];
              conv_rows<8>(P, t0 + 8 * rs, C_X + h * 64 + 32 * ph + 8 * cg, cw, cb, h * 64 + 32 * ph + 8 * cg, o);
              const f32x4 w0 = *(const LAS f32x4*)(sW + 8 * rs), w1 = *(const LAS f32x4*)(sW + 8 * rs + 4);
#pragma unroll
              for (int q = 0; q < 8; ++q) { float v[8] = {o[0][q] * w0[0], o[1][q] * w0[1], o[2][q] * w0[2], o[3][q] * w0[3], o[4][q] * w1[0], o[5][q] * w1[1], o[6][q] * w1[2], o[7][q] * w1[3]};
                  *(LAS bf16x8*)(sXT + (8 * cg + q) * 136 + 8 * rs) = pack8(v); } }
            asm volatile("s_waitcnt lgkmcnt(0)" ::: "memory");
            f32x4 acc[8][2];
#pragma unroll
            for (int mt = 0; mt < 8; ++mt) { acc[mt][0] = (f32x4){0.f, 0.f, 0.f, 0.f}; acc[mt][1] = (f32x4){0.f, 0.f, 0.f, 0.f}; }
#pragma unroll
            for (int s = 0; s < 4; ++s) { const bf16x8 x0 = *(const LAS bf16x8*)(sXT + fr * 136 + 32 * s + 8 * kg), x1 = *(const LAS bf16x8*)(sXT + (16 + fr) * 136 + 32 * s + 8 * kg);
#pragma unroll
                for (int mt = 0; mt < 8; ++mt) { const bf16x8 a = *(const LAS bf16x8*)(sBT + (16 * mt + fr) * 136 + 32 * s + 8 * kg);
                    acc[mt][0] = MFMA16(a, x0, acc[mt][0]); acc[mt][1] = MFMA16(a, x1, acc[mt][1]); } }
            asm volatile("s_waitcnt lgkmcnt(0)" ::: "memory");
#pragma unroll
            for (int mt = 0; mt < 8; ++mt)
#pragma unroll
                for (int nt = 0; nt < 2; ++nt) { const int n0 = 16 * mt + 4 * kg, pp = 32 * ph + 16 * nt + fr;
                    u32x2 w; w.x = pk2(acc[mt][nt][0], acc[mt][nt][1]); w.y = pk2(acc[mt][nt][2], acc[mt][nt][3]);
                    *(u32x2*)(ST + ((size_t)(c * NHEAD + h) * 64 + pp) * 128 + n0) = w; }
        }
    }
}
__device__ __forceinline__ void ssd_scan_phase(const Params& p, int b, int dry = 0) {
    unsigned* st = (unsigned*)states_ptr(p, b); const float* dasum = (const float*)(wsb(p) + WS_DASUM) + b * NCHUNK * NHEAD;
    for (int e2 = opq_bid() * 512 + opq_tid(); e2 < 131072; e2 += gridDim.x * 512) {
        const int h = e2 >> 12; float r0 = 0.f, r1 = 0.f;
        for (int c0 = 0; c0 < NCHUNK; c0 += 16) { unsigned v[16];
#pragma unroll
            for (int i = 0; i < 16; ++i) v[i] = st[(size_t)(c0 + i) * 131072 + e2];
#pragma unroll
            for (int i = 0; i < 16; ++i) { const float d = __expf(dasum[(c0 + i) * NHEAD + h]); if (!dry) st[(size_t)(c0 + i) * 131072 + e2] = pk2(r0, r1);
                r0 = r0 * d + __uint_as_float(v[i] << 16); r1 = r1 * d + __uint_as_float(v[i] & 0xffff0000u); } }
    }
}
__device__ __forceinline__ void ssd_out_phase(const Params& p, int b, LAS unsigned char* lds, int dry = 0) {
    const int tid = opq_tid(), lane = tid & 63, wave = tid >> 6, fr = lane & 15, kg = lane >> 4;
    bf16_t* P = proj_ptr(p); const bf16_t* ST = states_ptr(p, b);
    const float* cw = opq(p.ssd_conv_w); const float* cb = opq(p.ssd_conv_b);
    LAS bf16_t* sC = (LAS bf16_t*)lds; LAS bf16_t* sCB = (LAS bf16_t*)(lds + 34816); LAS bf16_t* sB = (LAS bf16_t*)(lds + 69632); LAS bf16_t* sXT = (LAS bf16_t*)(lds + 69632 + wave * 8704);
    LAS float* sACS = (LAS float*)(lds + 139264) + wave * 128; LAS float* sDT = (LAS float*)(lds + 143360) + wave * 128; LAS float* sSSQ = (LAS float*)(lds + 147456);
    for (int u = opq_bid(); u < NCHUNK * NGRP; u += gridDim.x) {
        const int c = u >> 2, g = u & 3, t0 = c * CHUNK, h = 8 * g + wave;
        __syncthreads();
        (void)ssd_dt_setup(p, P, t0, h, lane, sACS, sDT);
        { const int cg = tid & 15, rs = (tid >> 4) & 15, isC = tid >> 8; float o[8][8];
          conv_rows<8>(P, t0 + 8 * rs, C_B + isC * 512 + g * 128 + 8 * cg, cw, cb, 2048 + isC * 512 + g * 128 + 8 * cg, o);
          LAS bf16_t* dst = (isC ? sC : sB) + (8 * rs) * 136 + 8 * cg;
#pragma unroll
          for (int r = 0; r < 8; ++r) *(LAS bf16x8*)(dst + r * 136) = pack8(o[r]); }
        __syncthreads();
#pragma unroll
        for (int ms = 0; ms < 8; ++ms) if (ms <= wave) { f32x4 a4 = (f32x4){0.f, 0.f, 0.f, 0.f};
#pragma unroll
            for (int kn = 0; kn < 4; ++kn) { const bf16x8 a = *(const LAS bf16x8*)(sB + (16 * ms + fr) * 136 + 32 * kn + 8 * kg), bb = *(const LAS bf16x8*)(sC + (16 * wave + fr) * 136 + 32 * kn + 8 * kg);
                a4 = MFMA16(a, bb, a4); }
            u32x2 w; w.x = pk2(a4[0], a4[1]); w.y = pk2(a4[2], a4[3]);
            *(LAS u32x2*)(sCB + (16 * wave + fr) * 136 + 16 * ms + 4 * kg) = w; }
        __syncthreads();
        const float Dh = opq(p.ssd_d)[h];
        const unsigned zbase0 = (unsigned)((t0 + fr) * LD + C_Z + h * 64 + 4 * kg);
        float ssq[8];
#pragma unroll
        for (int nt = 0; nt < 8; ++nt) ssq[nt] = 0.f;
        for (int ph = 0; ph < 2; ++ph) {
            unsigned zb = zbase0 + 32u * ph; asm volatile("" : "+v"(zb));
            unsigned pfo = (unsigned)(((c * NHEAD + h) * 64 + 32 * ph + fr) * 128 + 8 * kg); asm volatile("" : "+v"(pfo));
            bf16x8 pf[4][2];
#pragma unroll
            for (int sn = 0; sn < 4; ++sn) { pf[sn][0] = *(const bf16x8*)(ST + (pfo + (unsigned)(32 * sn))); pf[sn][1] = *(const bf16x8*)(ST + (pfo + (unsigned)(16 * 128 + 32 * sn))); }
            { const int cg = lane & 3, rs = lane >> 2; float o[8][8];
              conv_rows<8>(P, t0 + 8 * rs, C_X + h * 64 + 32 * ph + 8 * cg, cw, cb, h * 64 + 32 * ph + 8 * cg, o);
#pragma unroll
              for (int q = 0; q < 8; ++q) { float v[8] = {o[0][q], o[1][q], o[2][q], o[3][q], o[4][q], o[5][q], o[6][q], o[7][q]};
                  *(LAS bf16x8*)(sXT + (8 * cg + q) * 136 + 8 * rs) = pack8(v); } }
            asm volatile("s_waitcnt lgkmcnt(0)" ::: "memory");
            f32x4 acc[2][8];
#pragma unroll
            for (int nt = 0; nt < 8; ++nt) { acc[0][nt] = (f32x4){0.f, 0.f, 0.f, 0.f}; acc[1][nt] = (f32x4){0.f, 0.f, 0.f, 0.f}; }
#pragma unroll
            for (int nt = 0; nt < 8; ++nt) {
#pragma unroll
                for (int sn = 0; sn < 4; ++sn) { const bf16x8 cf = *(const LAS bf16x8*)(sC + (16 * nt + fr) * 136 + 32 * sn + 8 * kg);
                    acc[0][nt] = MFMA16(pf[sn][0], cf, acc[0][nt]); acc[1][nt] = MFMA16(pf[sn][1], cf, acc[1][nt]); }
                const float sc = __expf(sACS[16 * nt + fr]);
                acc[0][nt] *= sc; acc[1][nt] *= sc; }
#pragma unroll
            for (int sk = 0; sk < 4; ++sk) {
                const int s0 = 32 * sk + 8 * kg;
                const bf16x8 xa0 = *(const LAS bf16x8*)(sXT + fr * 136 + s0), xa1 = *(const LAS bf16x8*)(sXT + (16 + fr) * 136 + s0);
                const f32x4 as0 = *(const LAS f32x4*)(sACS + s0), as1 = *(const LAS f32x4*)(sACS + s0 + 4), d0 = *(const LAS f32x4*)(sDT + s0), d1 = *(const LAS f32x4*)(sDT + s0 + 4);
#pragma unroll
                for (int nt = 0; nt < 8; ++nt) if (nt >= 2 * sk) { const int l = 16 * nt + fr; const float acsl = sACS[l];
                    float cbv[8]; unpack8(*(const LAS u32x4*)(sCB + l * 136 + s0), cbv);
                    float m[8];
#pragma unroll
                    for (int i = 0; i < 8; ++i) { const int s = s0 + i; const float as = i < 4 ? as0[i & 3] : as1[i & 3], ds = i < 4 ? d0[i & 3] : d1[i & 3];
                        float mv = (s <= l) ? cbv[i] * __expf(acsl - as) * ds : 0.f; if (s == l) mv += Dh; m[i] = mv; }
                    const bf16x8 mb = pack8(m);
                    acc[0][nt] = MFMA16(xa0, mb, acc[0][nt]); acc[1][nt] = MFMA16(xa1, mb, acc[1][nt]);
                    asm volatile("" ::: "memory"); }
            }
#pragma unroll
            for (int nt = 0; nt < 8; ++nt)
#pragma unroll
                for (int mt = 0; mt < 2; ++mt) { u32x2* zp = (u32x2*)(P + (zb + (unsigned)(16 * nt * LD + 16 * mt)));
                    const u32x2 zw = *zp; float y[4];
                    y[0] = acc[mt][nt][0] * siluf_(__uint_as_float(zw.x << 16)); y[1] = acc[mt][nt][1] * siluf_(__uint_as_float(zw.x & 0xffff0000u));
                    y[2] = acc[mt][nt][2] * siluf_(__uint_as_float(zw.y << 16)); y[3] = acc[mt][nt][3] * siluf_(__uint_as_float(zw.y & 0xffff0000u));
                    ssq[nt] += (y[0] * y[0] + y[1] * y[1]) + (y[2] * y[2] + y[3] * y[3]);
                    u32x2 yw; yw.x = pk2(y[0], y[1]); yw.y = pk2(y[2], y[3]); if (!dry) *zp = yw; }
        }
#pragma unroll
        for (int nt = 0; nt < 8; ++nt) { float v = ssq[nt]; v += __shfl_xor(v, 16); v += __shfl_xor(v, 32); if (kg == 0) sSSQ[wave * 128 + 16 * nt + fr] = v; }
        __syncthreads();
        const float* ng = opq(p.ssd_norm_g) + g * 512 + wave * 64 + 4 * kg;
#pragma unroll
        for (int nt = 0; nt < 8; ++nt) { const int l = 16 * nt + fr; float tot = 0.f;
#pragma unroll
            for (int w2 = 0; w2 < 8; ++w2) tot += sSSQ[w2 * 128 + l];
            const float rs = 1.f / sqrtf(tot * (1.f / 512.f) + EPS);
            unsigned zb2 = zbase0 + (unsigned)(16 * nt * LD); asm volatile("" : "+v"(zb2));
#pragma unroll
            for (int q = 0; q < 4; ++q) { u32x2* zp = (u32x2*)(P + (zb2 + 16u * q)); const u32x2 zw = *zp; const f32x4 gg = *(const f32x4*)(ng + 16 * q);
                u32x2 yw; yw.x = pk2(__uint_as_float(zw.x << 16) * rs * gg[0], __uint_as_float(zw.x & 0xffff0000u) * rs * gg[1]);
                yw.y = pk2(__uint_as_float(zw.y << 16) * rs * gg[2], __uint_as_float(zw.y & 0xffff0000u) * rs * gg[3]); if (!dry) *zp = yw; } }
    }
}
#define XB_TMO      128
#define XB_XCNT(j)  (256  + 64 * (j))
#define XB_XSUB(j)  (1280 + 64 * (j))
#define XB_XGEN(j)  (2304 + 64 * (j))
#define XB_TOP      3328
#define XB_TOPGEN   3392
#define XCD_BAR_WORDS 3456
#define XB_SPIN_CAP (1u << 18)

__device__ __forceinline__ unsigned xb_ld(unsigned* p)              { return __hip_atomic_load(p, __ATOMIC_RELAXED, __HIP_MEMORY_SCOPE_AGENT); }
__device__ __forceinline__ unsigned xb_add(unsigned* p, unsigned v) { return __hip_atomic_fetch_add(p, v, __ATOMIC_RELAXED, __HIP_MEMORY_SCOPE_AGENT); }
__device__ __forceinline__ unsigned xb_xcc_id() { return (unsigned)__builtin_amdgcn_s_getreg((3 << 11) | 20) & 0xFu; }
#define XB_SPIN(cond, bar) do { unsigned _sp = 0; while (cond) { __builtin_amdgcn_s_sleep(1); \
    if ((++_sp & 255u) == 0u) { if (xb_ld(&(bar)[XB_TMO])) break; if (_sp > XB_SPIN_CAP) { atomicAdd(&(bar)[XB_TMO], 1u); break; } } } } while (0)

struct XcdBarrier {
    unsigned* bar; unsigned x;
    volatile LAS unsigned* st;
};

__device__ __forceinline__ XcdBarrier xcd_barrier_post(unsigned* bar, volatile LAS unsigned* st) {
    XcdBarrier b; b.bar = bar; b.x = xb_xcc_id(); b.st = st;
    if (threadIdx.x == 0) (void)xb_add(&bar[XB_XCNT(b.x)], 1u);
    return b;
}
__device__ __forceinline__ void xcd_barrier_complete(unsigned* bar, unsigned x, unsigned& nloc, unsigned& nx) {
    const unsigned G = gridDim.x * gridDim.y * gridDim.z;
    unsigned sum, cnt, mine, sp = 0u;
    for (;;) {
        sum = 0u; cnt = 0u; mine = 0u;
#pragma unroll
        for (unsigned j = 0; j < 16; ++j) { const unsigned c = xb_ld(&bar[XB_XCNT(j)]); sum += c; cnt += (c > 0u) ? 1u : 0u; mine = (j == x) ? c : mine; }
        if (sum == G) break;
        __builtin_amdgcn_s_sleep(1);
        if ((++sp & 255u) == 0u) { if (xb_ld(&bar[XB_TMO])) break; if (sp > XB_SPIN_CAP) { atomicAdd(&bar[XB_TMO], 1u); break; } }
    }
    nloc = mine > 0u ? mine : 1u; nx = cnt > 0u ? cnt : 1u;
}

__device__ __forceinline__ void xcd_barrier(const XcdBarrier& b) {
    asm volatile("s_waitcnt vmcnt(0)" ::: "memory");
    __syncthreads();
    if (threadIdx.x == 0) {
        unsigned* bar = b.bar; asm volatile("" : "+s"(bar));
        unsigned bx = b.x; asm volatile("" : "+s"(bx));
        __builtin_amdgcn_s_waitcnt(0);
        unsigned nloc = b.st[0], nx = b.st[1];
        if (nloc == 0u) { xcd_barrier_complete(bar, bx, nloc, nx); b.st[0] = nloc; b.st[1] = nx; }
        const unsigned old = xb_add(&bar[XB_XSUB(bx)], 1u);
        const unsigned gen = old / nloc;
        if (old + 1u == (gen + 1u) * nloc) {
            __builtin_amdgcn_fence(__ATOMIC_RELEASE, "agent");
            asm volatile("s_waitcnt vmcnt(0)" ::: "memory");
            const unsigned og = xb_add(&bar[XB_TOP], 1u);
            const unsigned tg = og / nx;
            if (og + 1u == (tg + 1u) * nx) xb_add(&bar[XB_TOPGEN], 1u);
            else XB_SPIN(xb_ld(&bar[XB_TOPGEN]) == tg, bar);
            __builtin_amdgcn_fence(__ATOMIC_ACQUIRE, "agent");
            xb_add(&bar[XB_XGEN(bx)], 1u);
            asm volatile("s_waitcnt vmcnt(0)" ::: "memory");
        } else {
            XB_SPIN(xb_ld(&bar[XB_XGEN(bx)]) == gen, bar);
            __builtin_amdgcn_fence(__ATOMIC_ACQUIRE, "agent");
            asm volatile("s_waitcnt vmcnt(0)" ::: "memory");
        }
    }
    __syncthreads();
}

#define RUNP(n, ...) do { if ((n) > 1) { for (int r_ = nrep(n) - 1; r_ > 0; --r_) { const int dry_ = 1; (void)dry_; __VA_ARGS__; __syncthreads(); } } { const int dry_ = 0; (void)dry_; __VA_ARGS__; } } while (0)
#ifndef REP_SYNC
#define REP_SYNC 1
#endif
#ifndef REP_P0
#define REP_P0 1
#endif
#ifndef REP_P1
#define REP_P1 1
#endif
#ifndef REP_P5
#define REP_P5 1
#endif
#ifndef REP_P6
#define REP_P6 1
#endif
#ifndef REP_ST
#define REP_ST 1
#endif
#ifndef REP_LA
#define REP_LA 1
#endif
#ifndef REP_AT
#define REP_AT 1
#endif
#ifndef REP_SC
#define REP_SC 1
#endif
#ifndef REP_SO
#define REP_SO 1
#endif
#ifndef REP_LF
#define REP_LF 1
#endif
__device__ __forceinline__ int nrep(int n) { asm volatile("" : "+s"(n)); return n; }
__device__ __forceinline__ LAS unsigned char* opl(LAS unsigned char* q) { asm volatile("" : "+s"(q)); return q; }
__global__ void __launch_bounds__(512) mk(Params p) {
    extern __shared__ __attribute__((aligned(16))) unsigned char lds_raw[];
    LAS unsigned char* lds = (LAS unsigned char*)lds_raw;
    if (threadIdx.x < 4) ((volatile LAS unsigned*)(lds + LDS_BYTES - 16))[threadIdx.x] = 0u;
    __syncthreads();
    const XcdBarrier bar = xcd_barrier_post((unsigned*)(p.ws + WS_CTL), (volatile LAS unsigned*)(lds + LDS_BYTES - 16));
    if (p.hi > 1000) cg::this_grid().sync();
    RUNP(REP_P0, phase0(p, opl(lds)));
    xcd_barrier(bar);
    for (int b = 0; b < NBATCH; ++b) {
        RUNP(REP_P1, phase1_gemm(p, b, opl(lds)));
        for (int r = 0; r < nrep(REP_SYNC); ++r) xcd_barrier(bar);
        RUNP(REP_ST, ssd_states_phase(p, b, opl(lds)));
        __syncthreads();
        RUNP(REP_LA, lru_phase<false>(p, b, opl(lds), 0));
        __syncthreads();
        RUNP(REP_AT, attn_phase(p, b, opl(lds), dry_));
        xcd_barrier(bar);
        RUNP(REP_SC, ssd_scan_phase(p, b, dry_));
        lru_carry_phase(p, b);
        xcd_barrier(bar);
        RUNP(REP_SO, ssd_out_phase(p, b, opl(lds), dry_));
        __syncthreads();
        RUNP(REP_LF, lru_phase<true>(p, b, opl(lds), dry_));
        xcd_barrier(bar);
        RUNP(REP_P5, phase5_gemm(p, b, opl(lds)));
        xcd_barrier(bar);
        RUNP(REP_P6, phase6_gemm(p, b, opl(lds)));
        if (b + 1 < NBATCH) xcd_barrier(bar);
    }
}

static void launch_mk(Params& p, int lo, int hi, int grid, hipStream_t stream) {
    p.lo = lo; p.hi = hi; void* args[] = {&p};
    (void)hipMemsetAsync(p.ws + WS_CTL, 0, 65536, stream);
    hipError_t e = hipLaunchCooperativeKernel((const void*)mk, dim3(grid), dim3(512), args, LDS_BYTES, stream);
    if (e != hipSuccess) fprintf(stderr, "cooperative launch failed: %s (grid %d)\n", hipGetErrorString(e), grid);
}
extern "C" void kernel_launch(void* const* d_in, const int* in_sizes, int n_in, void* d_out, int out_size, void* d_ws, size_t ws_size, hipStream_t stream) {
    static int grid = 0;
    if (grid == 0) {
        if (n_in != 24 || out_size != MTOK * DM || ws_size < WS_END) { fprintf(stderr, "kernel_launch: unexpected shapes (n_in %d out %d ws %zu)\n", n_in, out_size, ws_size); grid = -1; return; }
        int dev = 0, cus = 0, per_cu = 0;
        hipGetDevice(&dev); hipDeviceGetAttribute(&cus, hipDeviceAttributeMultiprocessorCount, dev);
        hipFuncSetAttribute((const void*)mk, hipFuncAttributeMaxDynamicSharedMemorySize, LDS_BYTES);
        hipOccupancyMaxActiveBlocksPerMultiprocessor(&per_cu, (const void*)mk, 512, LDS_BYTES);
        if (per_cu < 1) { fprintf(stderr, "kernel_launch: occupancy query says %d blocks/CU\n", per_cu); per_cu = 1; }
        grid = cus * 1;
        (void)hipGetLastError();
    }
    if (grid < 0) return;
    Params p{};
    const float** f = (const float**)&p;
    for (int i = 0; i < 24; ++i) f[i] = (const float*)d_in[i];
    p.out = (float*)d_out; p.ws = (unsigned char*)d_ws;
    launch_mk(p, 0, 14, grid, stream);
}
```

```cpp
#define NAIVE_GEMM 0
#define NAIVE_ATT 0
#define NAIVE_LRU 0
#define NAIVE_SSD 0
#define ONE_LAUNCH 1

#include <hip/hip_runtime.h>
#include <hip/hip_cooperative_groups.h>
#include <cstdio>
#include <cstdint>
namespace cg = cooperative_groups;

#ifndef NAIVE_GEMM
#define NAIVE_GEMM 1
#endif
#ifndef NAIVE_SSD
#define NAIVE_SSD 1
#endif
#ifndef NAIVE_LRU
#define NAIVE_LRU 1
#endif
#ifndef NAIVE_ATT
#define NAIVE_ATT 1
#endif
#ifndef ONE_LAUNCH
#define ONE_LAUNCH 0
#endif

namespace pg8 {
#define PG8_LAS __attribute__((address_space(3)))
typedef unsigned short bf16_t;
typedef short bf16x8 __attribute__((ext_vector_type(8)));
typedef float f32x4 __attribute__((ext_vector_type(4)));
typedef unsigned u32x4 __attribute__((ext_vector_type(4)));
constexpr int BM = 256, BK = 64, HALF = 128, HTB = HALF * BK * 2  , STAGE_BYTES = 8 * HTB, NXCD = 8, WGM = 8;

__host__ __device__ __forceinline__ int lds_byte(int r, int c) { const int st = (r >> 4) * 2 + (c >> 5), rr = r & 15, cc = c & 31, ob = rr * 64 + cc * 2; return st * 1024 + (ob ^ (((ob >> 9) & 1) << 5)); }
__host__ __device__ __forceinline__ void stage_rc(int b, int& R, int& C) { const int st = b / 1024, sb = b % 1024, swz = sb ^ (((sb >> 9) & 1) << 5); R = (st >> 1) * 16 + swz / 64; C = (st & 1) * 32 + (swz % 64) / 2; }
__host__ __device__ __forceinline__ int perm32(int rho) { const int n = rho >> 4, i = rho & 15; return 8 * (i >> 2) + 4 * n + (i & 3); }

struct Unit { int pm, pn; };
struct Gemm { const bf16_t* A; const bf16_t* Bt; int M, N, K, lda, ldb; };

struct StaticOrder {
    int nM, nN, nwg, G, c;
    __host__ __device__ void init(int M, int N, int G_, int c_) { nM = M / BM; nN = N / BM; nwg = nM * nN; G = G_; c = c_; }
    __host__ __device__ bool next(int i, Unit& u) const {
        const long L = (long)i * G + c; if (L >= nwg) return false;
        int wgid = (int)L; { const int q = nwg / NXCD, r = nwg % NXCD, xcd = wgid % NXCD, off = wgid / NXCD; wgid = (xcd < r ? xcd * (q + 1) : r * (q + 1) + (xcd - r) * q) + off; }
        const int nig = WGM * nN, gid = wgid / nig, fm = gid * WGM, gsz = (nM - fm) < WGM ? (nM - fm) : WGM;
        u.pm = fm + ((wgid % nig) % gsz); u.pn = (wgid % nig) / gsz; return true;
    }
    __device__ __forceinline__ void a_ready(const Unit&) const {}
    __device__ __forceinline__ void done(const Unit&) const {}
};

__device__ __forceinline__ unsigned cvt_pk_bf16(float lo, float hi) { unsigned r; asm volatile("v_cvt_pk_bf16_f32 %0, %1, %2" : "=v"(r) : "v"(lo), "v"(hi)); return r; }
typedef float f32x2 __attribute__((ext_vector_type(2)));
__device__ __forceinline__ f32x2 gelu_pk(f32x2 v) {
    const f32x2 av = __builtin_elementwise_abs(v), d = av * 0.2316418882f + 1.0f;
    f32x2 t; t.x = __builtin_amdgcn_rcpf(d.x); t.y = __builtin_amdgcn_rcpf(d.y);
    f32x2 q = t * 0.5307027145f + (-0.7265760135f); q = q * t + 0.7107068705f; q = q * t + (-0.142248368f); q = q * t + 0.127414796f; q = q * t;
    const f32x2 s = (v * v) * (-0.72134752044f);
    f32x2 e; e.x = __builtin_amdgcn_exp2f(s.x); e.y = __builtin_amdgcn_exp2f(s.y);
    const f32x2 m = v * (q * e), r = v - m;
    f32x2 o; o.x = v.x < 0.f ? m.x : r.x; o.y = v.y < 0.f ? m.y : r.y; return o;
}

template <int ACT  > struct EpiBf16 {
    static constexpr bool PERM = true, AFTER_DRAIN = false; static_assert(ACT == 0 || ACT == 1, "EpiBf16: ACT is 0 (none) or 1 (gelu_pk)");
    bf16_t* O; int ldc; const float* bias; int split_cols; size_t split_stride; float scale0;
    __device__ __forceinline__ void operator()(const f32x4 (&acc)[2][2][4][2], const Unit& u, int wr, int wc, int fr, int fq) const {
        const int row0 = u.pm * BM + wr * 64 + fr; int colt = u.pn * BM; bf16_t* base = O;
        float sc = 1.f; if (split_cols) { const int t = colt / split_cols; base += (size_t)t * split_stride; colt -= t * split_cols; if (t == 0) sc = scale0; }
        const int col0 = colt + wc * 32 + 8 * fq, bcol0 = u.pn * BM + wc * 32 + 8 * fq;
        f32x4 bv[2][2];
#pragma unroll
        for (int bj = 0; bj < 2; ++bj)
#pragma unroll
            for (int n = 0; n < 2; ++n) bv[bj][n] = bias ? *(const f32x4*)(bias + bcol0 + bj * HALF + 4 * n) : (f32x4){0.f, 0.f, 0.f, 0.f};
#pragma unroll
        for (int ai = 0; ai < 2; ++ai)
#pragma unroll
            for (int m = 0; m < 4; ++m) { bf16_t* rowp = base + (size_t)(row0 + ai * HALF + m * 16) * ldc + col0;
#pragma unroll
                for (int bj = 0; bj < 2; ++bj) { f32x4 v0 = acc[ai][bj][m][0] + bv[bj][0], v1 = acc[ai][bj][m][1] + bv[bj][1];
                    if (ACT == 1) { f32x2 a = gelu_pk((f32x2){v0[0], v0[1]}), b = gelu_pk((f32x2){v0[2], v0[3]}), c = gelu_pk((f32x2){v1[0], v1[1]}), d = gelu_pk((f32x2){v1[2], v1[3]});
                        v0 = (f32x4){a.x, a.y, b.x, b.y}; v1 = (f32x4){c.x, c.y, d.x, d.y}; }
                    v0 = v0 * sc; v1 = v1 * sc; u32x4 w; w.x = cvt_pk_bf16(v0[0], v0[1]); w.y = cvt_pk_bf16(v0[2], v0[3]); w.z = cvt_pk_bf16(v1[0], v1[1]); w.w = cvt_pk_bf16(v1[2], v1[3]);
                    *(u32x4*)(rowp + bj * HALF) = w; } }
    }
};
template <class Epi, class Sched, bool ALIGN_EPI = false, bool SP2 = false>
__device__ __forceinline__ void gemm_phase(PG8_LAS unsigned char* lds, const Gemm g, const Sched& S, const Epi& E) {
    int tid_ = threadIdx.x; asm volatile("" : "+v"(tid_));
    const int tid = tid_, wid = __builtin_amdgcn_readfirstlane(tid >> 6), lane = tid & 63, wr = wid >> 2, wc = wid & 3, fr = lane & 15, fq = lane >> 4;
    const int K = g.K, nt = K / BK;
    unsigned voffA[2], voffB[2];
#pragma unroll
    for (int i = 0; i < 2; ++i) { int R, C; stage_rc(tid * 16 + i * 8192, R, C); const int Rb = Epi::PERM ? ((R & ~31) + perm32(R & 31)) : R;
        voffA[i] = (unsigned)(R * g.lda + C) * 2u; voffB[i] = (unsigned)(Rb * g.ldb + C) * 2u; }
    const size_t kstep = (size_t)(BK * 2);
    const size_t hstepA = (size_t)HALF * g.lda * 2, hstepB = (size_t)HALF * g.ldb * 2;
    const size_t tstepA = 2 * hstepA, tstepB = 2 * hstepB;
    const unsigned ldsw = (unsigned)wid * 1024u;
    const int aoff = lds_byte(wr * 64 + fr, fq * 8), boff = lds_byte(wc * 32 + fr, fq * 8);
#define PG8_SA(b, h) (((b) * 2 + (h)) * HTB)
#define PG8_SB(b, h) ((4 + (b) * 2 + (h)) * HTB)
#define PG8_STAGE(bufoff, gbase, voff) do { _Pragma("unroll") for (int _i = 0; _i < 2; ++_i) \
        __builtin_amdgcn_global_load_lds((const unsigned*)((const char*)(gbase) + (voff)[_i]), (PG8_LAS unsigned*)(lds + (bufoff) + ldsw + _i * 8192), 16, 0, 0); } while (0)
#define PG8_LDA(dst, b, h) do { _Pragma("unroll") for (int m = 0; m < 4; ++m) _Pragma("unroll") for (int k = 0; k < 2; ++k) dst[m][k] = *(const PG8_LAS bf16x8*)(lds + PG8_SA(b, h) + aoff + m * 2048 + k * 1024); } while (0)
#define PG8_LDB(dst, b, h) do { _Pragma("unroll") for (int n = 0; n < 2; ++n) _Pragma("unroll") for (int k = 0; k < 2; ++k) dst[n][k] = *(const PG8_LAS bf16x8*)(lds + PG8_SB(b, h) + boff + n * 2048 + k * 1024); } while (0)
#define PG8_MMA(ai, bj, At, Bt) do { __builtin_amdgcn_s_setprio(1); _Pragma("unroll") for (int m = 0; m < 4; ++m) _Pragma("unroll") for (int n = 0; n < 2; ++n) _Pragma("unroll") for (int k = 0; k < 2; ++k) \
        acc[ai][bj][m][n] = __builtin_amdgcn_mfma_f32_16x16x32_bf16(Bt[n][k], At[m][k], acc[ai][bj][m][n], 0, 0, 0); __builtin_amdgcn_s_setprio(0); } while (0)
#define PG8_WAIT_V(n) asm volatile("s_waitcnt vmcnt(" #n ")" ::: "memory")
#define PG8_WAIT_L(n) asm volatile("s_waitcnt lgkmcnt(" #n ")" ::: "memory")
#define PG8_BAR __builtin_amdgcn_s_barrier()
#define PG8_SCHED __builtin_amdgcn_sched_barrier(0)
    Unit cur, nxt; int ui = 0;
    if (!S.next(0, cur)) return;
    f32x4 acc[2][2][4][2];
#pragma unroll
    for (int a = 0; a < 2; ++a)
#pragma unroll
        for (int b = 0; b < 2; ++b)
#pragma unroll
            for (int m = 0; m < 4; ++m)
#pragma unroll
                for (int n = 0; n < 2; ++n) acc[a][b][m][n] = (f32x4){0.f, 0.f, 0.f, 0.f};
    bf16x8 At[4][2], B0[2][2], B1[2][2];
    const char* cA = (const char*)g.A + (size_t)cur.pm * tstepA; const char* cB = (const char*)g.Bt + (size_t)cur.pn * tstepB;
    S.a_ready(cur);
    if constexpr (SP2) {
        PG8_STAGE(PG8_SB(0, 0), cB, voffB); PG8_STAGE(PG8_SB(0, 1), cB + hstepB, voffB); PG8_STAGE(PG8_SA(0, 0), cA, voffA); PG8_STAGE(PG8_SA(0, 1), cA + hstepA, voffA);
        if (wr == 1) PG8_BAR;
        PG8_WAIT_V(2); PG8_BAR;
        PG8_STAGE(PG8_SB(1, 0), cB + kstep, voffB); PG8_STAGE(PG8_SA(1, 0), cA + kstep, voffA); PG8_STAGE(PG8_SB(1, 1), cB + hstepB + kstep, voffB);
        PG8_WAIT_V(6); PG8_BAR;
    } else {
        PG8_STAGE(PG8_SB(0, 0), cB, voffB); PG8_STAGE(PG8_SA(0, 0), cA, voffA); PG8_STAGE(PG8_SB(0, 1), cB + hstepB, voffB); PG8_STAGE(PG8_SA(0, 1), cA + hstepA, voffA);
        if (wr == 1) PG8_BAR;
        PG8_WAIT_V(4); PG8_BAR;
        PG8_STAGE(PG8_SB(1, 0), cB + kstep, voffB); PG8_STAGE(PG8_SA(1, 0), cA + kstep, voffA); PG8_STAGE(PG8_SB(1, 1), cB + hstepB + kstep, voffB);
        PG8_WAIT_V(6); PG8_BAR;
    }
    for (;;) {
        const bool has_next = S.next(ui + 1, nxt);
        const char* nA = has_next ? (const char*)g.A + (size_t)nxt.pm * tstepA : cA; const char* nB = has_next ? (const char*)g.Bt + (size_t)nxt.pn * tstepB : cB;
        for (int t = 0; t < nt; t += 2) {
            const bool last = (t == nt - 2);
            const char* a1 = cA + (size_t)(t + 1) * kstep;
            const char* a2 = last ? nA : cA + (size_t)(t + 2) * kstep; const char* b2 = last ? nB : cB + (size_t)(t + 2) * kstep;
            const char* a3 = a2 + kstep; const char* b3 = b2 + kstep;
            if (last && has_next) S.a_ready(nxt);
            if constexpr (SP2) {
            PG8_LDB(B0, 0, 0); PG8_LDB(B1, 0, 1); PG8_SCHED; PG8_LDA(At, 0, 0); PG8_STAGE(PG8_SA(1, 1), a1 + hstepA, voffA);
            PG8_WAIT_V(8); PG8_WAIT_L(0); PG8_BAR; PG8_MMA(0, 0, At, B0); PG8_MMA(0, 1, At, B1); PG8_BAR; PG8_SCHED;
            PG8_LDA(At, 0, 1); PG8_STAGE(PG8_SB(0, 0), b2, voffB); PG8_STAGE(PG8_SB(0, 1), b2 + hstepB, voffB); PG8_STAGE(PG8_SA(0, 0), a2, voffA);
            PG8_WAIT_V(8); PG8_WAIT_L(0); PG8_BAR; PG8_MMA(1, 0, At, B0); PG8_MMA(1, 1, At, B1); PG8_BAR; PG8_SCHED;
            PG8_LDB(B0, 1, 0); PG8_LDB(B1, 1, 1); PG8_SCHED; PG8_LDA(At, 1, 0); PG8_STAGE(PG8_SA(0, 1), a2 + hstepA, voffA);
            PG8_WAIT_V(8); PG8_WAIT_L(0); PG8_BAR; PG8_MMA(0, 0, At, B0); PG8_MMA(0, 1, At, B1); PG8_BAR; PG8_SCHED;
            PG8_LDA(At, 1, 1); PG8_STAGE(PG8_SB(1, 0), b3, voffB); PG8_STAGE(PG8_SB(1, 1), b3 + hstepB, voffB); PG8_STAGE(PG8_SA(1, 0), a3, voffA);
            PG8_WAIT_V(8); PG8_WAIT_L(0); PG8_BAR; PG8_MMA(1, 0, At, B0); PG8_MMA(1, 1, At, B1); PG8_BAR; PG8_SCHED;
            } else {
            PG8_LDB(B0, 0, 0); PG8_SCHED; PG8_LDA(At, 0, 0); PG8_STAGE(PG8_SA(1, 1), a1 + hstepA, voffA);
            PG8_WAIT_L(8); PG8_BAR; PG8_WAIT_L(0); PG8_MMA(0, 0, At, B0); PG8_BAR; PG8_SCHED;
            PG8_LDB(B1, 0, 1); PG8_STAGE(PG8_SB(0, 0), b2, voffB);
            PG8_BAR; PG8_WAIT_L(0); PG8_MMA(0, 1, At, B1); PG8_BAR;
            PG8_LDA(At, 0, 1); PG8_STAGE(PG8_SA(0, 0), a2, voffA);
            PG8_BAR; PG8_WAIT_L(0); PG8_MMA(1, 0, At, B0); PG8_BAR; PG8_SCHED;
            PG8_STAGE(PG8_SB(0, 1), b2 + hstepB, voffB);
            PG8_WAIT_V(6); PG8_BAR; PG8_MMA(1, 1, At, B1); PG8_BAR;
            PG8_LDB(B0, 1, 0); PG8_SCHED; PG8_LDA(At, 1, 0); PG8_STAGE(PG8_SA(0, 1), a2 + hstepA, voffA);
            PG8_WAIT_L(8); PG8_BAR; PG8_WAIT_L(0); PG8_MMA(0, 0, At, B0); PG8_BAR; PG8_SCHED;
            PG8_LDB(B1, 1, 1); PG8_STAGE(PG8_SB(1, 0), b3, voffB);
            PG8_BAR; PG8_WAIT_L(0); PG8_MMA(0, 1, At, B1); PG8_BAR;
            PG8_LDA(At, 1, 1); PG8_STAGE(PG8_SA(1, 0), a3, voffA);
            PG8_BAR; PG8_WAIT_L(0); PG8_MMA(1, 0, At, B0); PG8_BAR; PG8_SCHED;
            PG8_STAGE(PG8_SB(1, 1), b3 + hstepB, voffB);
            PG8_WAIT_V(6); PG8_BAR; PG8_MMA(1, 1, At, B1); PG8_BAR;
            }
        }
        if constexpr (ALIGN_EPI) { if (wr == 0) PG8_BAR; }
        if constexpr (!Epi::AFTER_DRAIN) { E(acc, cur, wr, wc, fr, fq); S.done(cur); }
        if (!has_next) break;
#pragma unroll
        for (int a = 0; a < 2; ++a)
#pragma unroll
            for (int b = 0; b < 2; ++b)
#pragma unroll
                for (int m = 0; m < 4; ++m)
#pragma unroll
                    for (int n = 0; n < 2; ++n) acc[a][b][m][n] = (f32x4){0.f, 0.f, 0.f, 0.f};
        cur = nxt; cA = nA; cB = nB; ++ui;
        if constexpr (ALIGN_EPI) { if (wr == 1) PG8_BAR; }
    }
    PG8_WAIT_V(0);
    if constexpr (!ALIGN_EPI) { if (wr == 0) PG8_BAR; }
    PG8_BAR;
    if constexpr (Epi::AFTER_DRAIN) { E.fused(acc, cur, wr, wc, fr, fq, lds, wid, lane); S.done(cur); }
#undef PG8_SA
#undef PG8_SB
#undef PG8_STAGE
#undef PG8_LDA
#undef PG8_LDB
#undef PG8_MMA
#undef PG8_WAIT_V
#undef PG8_WAIT_L
#undef PG8_BAR
#undef PG8_SCHED
}
}

#define GAS __attribute__((address_space(1)))
#define LAS __attribute__((address_space(3)))
typedef unsigned short bf16_t;
typedef short bf16x8 __attribute__((ext_vector_type(8)));
typedef float f32x4 __attribute__((ext_vector_type(4)));
typedef unsigned u32x4 __attribute__((ext_vector_type(4)));
typedef unsigned u32x2 __attribute__((ext_vector_type(2)));

constexpr int DM = 1024, NBATCH = 2, SEQ = 8192, MEML = 256, MTOK = NBATCH * SEQ;
constexpr int INW = 12320, LD = 12544;
constexpr int C_Z = 0, C_X = 2048, C_B = 4096, C_C = 4608, C_LG = 5120, C_LX = 6656, C_Q = 8192, C_G = 9216, C_DT = 12288;
constexpr int C_MRG = 2048;
constexpr int NHEAD = 32, HDIM = 64, NGRP = 4, NSTATE = 128, CHUNK = 128, NCHUNK = SEQ / CHUNK;
constexpr int LRUW = 1536, LRUB = 96, NLB = 16, LSEG = 512, NSEG = SEQ / LSEG, NBLK64 = SEQ / 64;
constexpr float EPS = 1e-6f;
constexpr size_t MiB = 1u << 20;
constexpr size_t WS_WIN = 0, WS_WKV = 25 * MiB, WS_WSSD = 29 * MiB, WS_WLRU = 33 * MiB, WS_WMEM = 36 * MiB, WS_WOUT = 38 * MiB;
constexpr size_t WS_PROJ = 40 * MiB;
constexpr size_t WS_MEMN = 236 * MiB, WS_KVK = 237 * MiB, WS_KVVT = 238 * MiB, WS_LRUWA = 239 * MiB, WS_LRUWX = 239 * MiB + 512 * 1024;
constexpr size_t WS_DASUM = 240 * MiB;
constexpr size_t WS_LAGG = 246 * MiB;
constexpr size_t WS_LCAR = 250 * MiB;
constexpr size_t WS_CTL = 244 * MiB;
constexpr size_t WS_XBUF = 245 * MiB;
constexpr size_t WS_END = 256 * MiB;
static_assert(WS_PROJ + (size_t)SEQ * LD * 2 <= WS_MEMN, "ws map");
constexpr int LDS_BYTES = 155648;

struct Params {
    const float *x, *mem, *norm_g, *w_in, *ssd_conv_w, *ssd_conv_b, *ssd_dt_bias, *ssd_a_log, *ssd_d, *ssd_norm_g,
        *lru_conv_w, *lru_conv_b, *lru_w_a, *lru_b_a, *lru_w_x, *lru_b_x, *lru_lambda, *mem_norm_g, *w_kv,
        *w_br_ssd, *w_br_lru, *w_br_mem, *w_out, *final_g;
    float* out; unsigned char* ws;
    int lo, hi;
};

__device__ __forceinline__ float bf2f(bf16_t v) { return __uint_as_float((unsigned)v << 16); }
__device__ __forceinline__ unsigned f2bf(float f) { unsigned u = __float_as_uint(f); return (u + 0x7fffu + ((u >> 16) & 1u)) >> 16; }
__device__ __forceinline__ unsigned pk2(float lo, float hi) { return f2bf(lo) | (f2bf(hi) << 16); }
__device__ __forceinline__ float sigmoidf_(float v) { return __builtin_amdgcn_rcpf(1.f + __expf(-v)); }
__device__ __forceinline__ float siluf_(float v) { return v * __builtin_amdgcn_rcpf(1.f + __expf(-v)); }
__device__ __forceinline__ float softplusf_(float v) { const float e = __expf(v); const float sm = e * (1.f - e * (0.5f - e * 0.33333334f)); return v > 20.f ? v : (e < 1e-3f ? sm : __logf(1.f + e)); }
__device__ __forceinline__ float wave_sum(float v) {
#pragma unroll
    for (int o = 1; o < 64; o <<= 1) v += __shfl_xor(v, o);
    return v;
}
template <class T> __device__ __forceinline__ T* opq(T* q) { asm volatile("" : "+s"(q)); return q; }
__device__ __forceinline__ int opq_tid() { int t = threadIdx.x; asm volatile("" : "+v"(t)); return t; }
__device__ __forceinline__ int opq_bid() { int t = blockIdx.x; asm volatile("" : "+s"(t)); return t; }
__device__ __forceinline__ unsigned char* wsb(const Params& p) { return opq(p.ws); }
__device__ __forceinline__ bf16_t* proj_ptr(const Params& p) { return (bf16_t*)(wsb(p) + WS_PROJ); }
__device__ __forceinline__ bf16_t* xn_ptr(const Params& p) { return (bf16_t*)((unsigned char*)opq(p.out) + 32 * MiB); }
__device__ __forceinline__ bf16_t* states_ptr(const Params& p, int b) { return (bf16_t*)((unsigned char*)opq(p.out) + (size_t)b * 32 * MiB); }
__device__ __forceinline__ float* scr_ptr(const Params& p, int b) { return (float*)((unsigned char*)opq(p.out) + (size_t)b * 32 * MiB); }

#ifdef PROBE_MA
#define MSTAMP(p, i) do { if (blockIdx.x == 0 && threadIdx.x == 0) ((unsigned long long*)(wsb(p) + 255 * MiB))[i] = __builtin_amdgcn_s_memrealtime(); } while (0)
#else
#define MSTAMP(p, i) do { } while (0)
#endif
__device__ __forceinline__ void transpose_item(const float* W, int K, int Ns, int srccol0, bf16_t* WT, int dstrow0, LAS float* scr, int k0, int lane) {
    float wv[32];
#pragma unroll
    for (int i = 0; i < 32; ++i) wv[i] = W[(size_t)(k0 + 2 * i + (lane >> 5)) * Ns + srccol0 + (lane & 31)];
#pragma unroll
    for (int i = 0; i < 32; ++i) scr[(2 * i + (lane >> 5)) * 33 + (lane & 31)] = wv[i];
    asm volatile("s_waitcnt lgkmcnt(0)" ::: "memory");
    const int c = lane & 7;
#pragma unroll
    for (int j = 0; j < 4; ++j) { const int n = (lane >> 3) + 8 * j; const LAS float* s = scr + (8 * c) * 33 + n;
        u32x4 o; o.x = pk2(s[0 * 33], s[1 * 33]); o.y = pk2(s[2 * 33], s[3 * 33]); o.z = pk2(s[4 * 33], s[5 * 33]); o.w = pk2(s[6 * 33], s[7 * 33]);
        *(u32x4*)(WT + (size_t)(dstrow0 + n) * K + k0 + 8 * c) = o; }
    asm volatile("s_waitcnt lgkmcnt(0)" ::: "memory");
}
__device__ __forceinline__ void rms_row_to_bf16(const float* xrow, const float* g, bf16_t* orow, int lane) {
    const f32x4* xr = (const f32x4*)xrow + lane; const f32x4* gr = (const f32x4*)g + lane;
    f32x4 v[4]; float s = 0.f;
#pragma unroll
    for (int j = 0; j < 4; ++j) { v[j] = xr[64 * j]; s += (v[j].x * v[j].x + v[j].y * v[j].y) + (v[j].z * v[j].z + v[j].w * v[j].w); }
    const float rs = 1.f / sqrtf(wave_sum(s) * (1.f / DM) + EPS);
    unsigned long long* o8 = (unsigned long long*)orow + lane;
#pragma unroll
    for (int j = 0; j < 4; ++j) { const f32x4 gg = gr[64 * j];
        o8[64 * j] = (unsigned long long)pk2(v[j].x * rs * gg.x, v[j].y * rs * gg.y) | ((unsigned long long)pk2(v[j].z * rs * gg.z, v[j].w * rs * gg.w) << 32); }
}
__device__ __forceinline__ void phase0(const Params& p, LAS unsigned char* lds) {
    const int tid = opq_tid(), lane = tid & 63, wave = tid >> 6, bid = opq_bid();
    const int gw = bid * 8 + wave, NGW = gridDim.x * 8;
    LAS float* scr = (LAS float*)(lds + wave * 8704);
    bf16_t* Win = (bf16_t*)(wsb(p) + WS_WIN); bf16_t* Wkv = (bf16_t*)(wsb(p) + WS_WKV); bf16_t* Wssd = (bf16_t*)(wsb(p) + WS_WSSD);
    bf16_t* Wlru = (bf16_t*)(wsb(p) + WS_WLRU); bf16_t* Wmem = (bf16_t*)(wsb(p) + WS_WMEM); bf16_t* Wout = (bf16_t*)(wsb(p) + WS_WOUT);
    constexpr int I_IN = 16 * 385, I_KV = 16 * 64, I_SSD = 32 * 32, I_LRU = 24 * 32, I_MEM = 16 * 32, I_OUT = 16 * 32;
    constexpr int NITEMS = I_IN + I_KV + I_SSD + I_LRU + I_MEM + I_OUT;
    for (int it = gw; it < NITEMS; it += NGW) {
        int r = it;
        if (r < I_IN) { const int nb = r % 385, kb = r / 385; const int sc = 32 * nb; int dr;
            if (sc < 5120) dr = sc; else if (sc < 5152) dr = sc - 5120 + C_DT; else dr = sc - 32;
            transpose_item(opq(p.w_in), 1024, INW, sc, Win, dr, scr, 64 * kb, lane); continue; } r -= I_IN;
        if (r < I_KV) { transpose_item(opq(p.w_kv), 1024, 2048, 32 * (r % 64), Wkv, 32 * (r % 64), scr, 64 * (r / 64), lane); continue; } r -= I_KV;
        if (r < I_SSD) { transpose_item(opq(p.w_br_ssd), 2048, 1024, 32 * (r % 32), Wssd, 32 * (r % 32), scr, 64 * (r / 32), lane); continue; } r -= I_SSD;
        if (r < I_LRU) { transpose_item(opq(p.w_br_lru), 1536, 1024, 32 * (r % 32), Wlru, 32 * (r % 32), scr, 64 * (r / 32), lane); continue; } r -= I_LRU;
        if (r < I_MEM) { transpose_item(opq(p.w_br_mem), 1024, 1024, 32 * (r % 32), Wmem, 32 * (r % 32), scr, 64 * (r / 32), lane); continue; } r -= I_MEM;
        transpose_item(opq(p.w_out), 1024, 1024, 32 * (r % 32), Wout, 32 * (r % 32), scr, 64 * (r / 32), lane);
    }
    { const int gt = bid * 512 + tid, NT = gridDim.x * 512; u32x4* z = (u32x4*)(Win + (size_t)INW * 1024);
      for (int i = gt; i < (LD - INW) * 1024 / 8; i += NT) z[i] = (u32x4){0u, 0u, 0u, 0u}; }
    { const int gt = bid * 512 + tid, NT = gridDim.x * 512; bf16_t* wa = (bf16_t*)(wsb(p) + WS_LRUWA); bf16_t* wx = (bf16_t*)(wsb(p) + WS_LRUWX);
      for (int e = gt; e < NLB * LRUB * LRUB; e += NT) { const int n = e / (LRUB * LRUB), r2 = e % (LRUB * LRUB), j = r2 / LRUB, i = r2 % LRUB;
          wa[e] = (bf16_t)f2bf(opq(p.lru_w_a)[(n * LRUB + i) * LRUB + j]); wx[e] = (bf16_t)f2bf(opq(p.lru_w_x)[(n * LRUB + i) * LRUB + j]); } }
    bf16_t* XN = xn_ptr(p); bf16_t* MN = (bf16_t*)(wsb(p) + WS_MEMN);
    { const float* xb = opq(p.x); const f32x4* gr = (const f32x4*)opq(p.norm_g) + lane;
      for (int m0 = gw * 4; m0 < MTOK; m0 += NGW * 4) {
          f32x4 v[4][4];
#pragma unroll
          for (int r = 0; r < 4; ++r)
#pragma unroll
              for (int j = 0; j < 4; ++j) v[r][j] = ((const f32x4*)(xb + (size_t)(m0 + r) * DM) + lane)[64 * j];
#pragma unroll
          for (int r = 0; r < 4; ++r) { float s = 0.f;
#pragma unroll
              for (int j = 0; j < 4; ++j) s += (v[r][j].x * v[r][j].x + v[r][j].y * v[r][j].y) + (v[r][j].z * v[r][j].z + v[r][j].w * v[r][j].w);
              const float rs = 1.f / sqrtf(wave_sum(s) * (1.f / DM) + EPS);
              unsigned long long* o8 = (unsigned long long*)(XN + (size_t)(m0 + r) * DM) + lane;
#pragma unroll
              for (int j = 0; j < 4; ++j) { const f32x4 gg = gr[64 * j];
                  o8[64 * j] = (unsigned long long)pk2(v[r][j].x * rs * gg.x, v[r][j].y * rs * gg.y) | ((unsigned long long)pk2(v[r][j].z * rs * gg.z, v[r][j].w * rs * gg.w) << 32); } } } }
    for (int m = gw; m < NBATCH * MEML; m += NGW) rms_row_to_bf16(opq(p.mem) + (size_t)m * DM, opq(p.mem_norm_g), MN + (size_t)m * DM, lane);
}
__device__ __forceinline__ void phase7(const Params& p) {
    const int tid = opq_tid(), lane = tid & 63, wave = tid >> 6; const int gw = opq_bid() * 8 + wave, NGW = gridDim.x * 8; float* outb = opq(p.out); const float* fg = opq(p.final_g);
    for (int m = gw; m < MTOK; m += NGW) {
        f32x4* xr = (f32x4*)(outb + (size_t)m * DM) + lane; const f32x4* gr = (const f32x4*)fg + lane;
        f32x4 v[4]; float s = 0.f;
#pragma unroll
        for (int j = 0; j < 4; ++j) { v[j] = xr[64 * j]; s += (v[j].x * v[j].x + v[j].y * v[j].y) + (v[j].z * v[j].z + v[j].w * v[j].w); }
        const float rs = 1.f / sqrtf(wave_sum(s) * (1.f / DM) + EPS);
#pragma unroll
        for (int j = 0; j < 4; ++j) { const f32x4 gg = gr[64 * j]; xr[64 * j] = v[j] * rs * gg; }
    }
}

namespace pg8 {
template <int BR> struct EpiMerge {
    static constexpr bool PERM = true, AFTER_DRAIN = false;
    bf16_t* P; float* scr;
    __device__ __forceinline__ void operator()(const f32x4 (&acc)[2][2][4][2], const Unit& u, int wr, int wc, int fr, int fq) const {
        const int row0 = u.pm * BM + wr * 64 + fr, col0 = u.pn * BM + wc * 32 + 8 * fq;
#pragma unroll
        for (int ai = 0; ai < 2; ++ai)
#pragma unroll
            for (int m = 0; m < 4; ++m) { const size_t r = (size_t)(row0 + ai * HALF + m * 16);
#pragma unroll
                for (int bj = 0; bj < 2; ++bj) { const int c = col0 + bj * HALF;
                    const u32x4 gw = *(const u32x4*)(P + r * 12544 + 9216 + BR * 1024 + c);
                    float g[8];
#pragma unroll
                    for (int i = 0; i < 4; ++i) { g[2 * i] = __uint_as_float(gw[i] << 16); g[2 * i + 1] = __uint_as_float(gw[i] & 0xffff0000u); }
                    f32x4 v0 = acc[ai][bj][m][0], v1 = acc[ai][bj][m][1];
#pragma unroll
                    for (int i = 0; i < 4; ++i) { v0[i] *= 1.f / (1.f + __expf(-g[i])); v1[i] *= 1.f / (1.f + __expf(-g[4 + i])); }
                    float* sp = scr + r * 1024 + c;
                    if (BR > 0) { v0 += *(const f32x4*)sp; v1 += *(const f32x4*)(sp + 4); }
                    if (BR < 2) { *(f32x4*)sp = v0; *(f32x4*)(sp + 4) = v1; }
                    else { u32x4 w; w.x = cvt_pk_bf16(v0[0], v0[1]); w.y = cvt_pk_bf16(v0[2], v0[3]); w.z = cvt_pk_bf16(v1[0], v1[1]); w.w = cvt_pk_bf16(v1[2], v1[3]);
                        *(u32x4*)(P + r * 12544 + 2048 + c) = w; } } }
    }
};
template <int BR, bool FINAL> struct EpiMerge2 {
    static constexpr bool PERM = true, AFTER_DRAIN = false;
    bf16_t* P; bf16_t* s0; int ld0; const bf16_t* s1; int ld1; bf16_t* mrg; int ldm;
    __device__ __forceinline__ void operator()(const f32x4 (&acc)[2][2][4][2], const Unit& u, int wr, int wc, int fr, int fq) const {
        const int row0 = u.pm * BM + wr * 64 + fr, col0 = u.pn * BM + wc * 32 + 8 * fq;
#pragma unroll
        for (int ai = 0; ai < 2; ++ai) {
            unsigned gb = (unsigned)((row0 + ai * HALF) * 12544 + 9216 + BR * 1024 + col0); asm volatile("" : "+v"(gb));
            unsigned b0 = (unsigned)((row0 + ai * HALF) * ld0 + col0); asm volatile("" : "+v"(b0));
            u32x4 gw[4][2];
#pragma unroll
            for (int m = 0; m < 4; ++m)
#pragma unroll
                for (int bj = 0; bj < 2; ++bj) gw[m][bj] = *(const u32x4*)(P + (gb + (unsigned)(m * 16 * 12544 + bj * HALF)));
            f32x4 v[4][2][2];
#pragma unroll
            for (int m = 0; m < 4; ++m)
#pragma unroll
                for (int bj = 0; bj < 2; ++bj) { const u32x4 g4 = gw[m][bj]; f32x4 v0 = acc[ai][bj][m][0], v1 = acc[ai][bj][m][1];
#pragma unroll
                    for (int i = 0; i < 2; ++i) { v0[2 * i] *= __builtin_amdgcn_rcpf(1.f + __expf(-__uint_as_float(g4[i] << 16))); v0[2 * i + 1] *= __builtin_amdgcn_rcpf(1.f + __expf(-__uint_as_float(g4[i] & 0xffff0000u)));
                        v1[2 * i] *= __builtin_amdgcn_rcpf(1.f + __expf(-__uint_as_float(g4[2 + i] << 16))); v1[2 * i + 1] *= __builtin_amdgcn_rcpf(1.f + __expf(-__uint_as_float(g4[2 + i] & 0xffff0000u))); }
                    v[m][bj][0] = v0; v[m][bj][1] = v1; }
            if (!FINAL) {
#pragma unroll
                for (int m = 0; m < 4; ++m)
#pragma unroll
                    for (int bj = 0; bj < 2; ++bj) { const f32x4 v0 = v[m][bj][0], v1 = v[m][bj][1]; u32x4 w; w.x = cvt_pk_bf16(v0[0], v0[1]); w.y = cvt_pk_bf16(v0[2], v0[3]); w.z = cvt_pk_bf16(v1[0], v1[1]); w.w = cvt_pk_bf16(v1[2], v1[3]);
                        *(u32x4*)(s0 + (b0 + (unsigned)(m * 16) * (unsigned)ld0 + (unsigned)(bj * HALF))) = w; }
            } else {
                asm volatile("" ::: "memory");
                unsigned b1 = (unsigned)((row0 + ai * HALF) * ld1 + col0); asm volatile("" : "+v"(b1));
                unsigned bm = (unsigned)((row0 + ai * HALF) * ldm + col0); asm volatile("" : "+v"(bm));
#pragma unroll
                for (int mp = 0; mp < 2; ++mp) { u32x4 a0[2][2], a1[2][2];
#pragma unroll
                    for (int mm = 0; mm < 2; ++mm)
#pragma unroll
                        for (int bj = 0; bj < 2; ++bj) { const unsigned rr = (unsigned)((2 * mp + mm) * 16);
                            a0[mm][bj] = *(const u32x4*)(s0 + (b0 + rr * (unsigned)ld0 + (unsigned)(bj * HALF))); a1[mm][bj] = *(const u32x4*)(s1 + (b1 + rr * (unsigned)ld1 + (unsigned)(bj * HALF))); }
#pragma unroll
                    for (int mm = 0; mm < 2; ++mm)
#pragma unroll
                        for (int bj = 0; bj < 2; ++bj) { const int m = 2 * mp + mm; const unsigned rr = (unsigned)(m * 16);
                            f32x4 v0 = v[m][bj][0], v1 = v[m][bj][1];
#pragma unroll
                            for (int i = 0; i < 2; ++i) { v0[2 * i] += __uint_as_float(a0[mm][bj][i] << 16) + __uint_as_float(a1[mm][bj][i] << 16); v0[2 * i + 1] += __uint_as_float(a0[mm][bj][i] & 0xffff0000u) + __uint_as_float(a1[mm][bj][i] & 0xffff0000u);
                                v1[2 * i] += __uint_as_float(a0[mm][bj][2 + i] << 16) + __uint_as_float(a1[mm][bj][2 + i] << 16); v1[2 * i + 1] += __uint_as_float(a0[mm][bj][2 + i] & 0xffff0000u) + __uint_as_float(a1[mm][bj][2 + i] & 0xffff0000u); }
                            u32x4 w; w.x = cvt_pk_bf16(v0[0], v0[1]); w.y = cvt_pk_bf16(v0[2], v0[3]); w.z = cvt_pk_bf16(v1[0], v1[1]); w.w = cvt_pk_bf16(v1[2], v1[3]);
                            *(u32x4*)(mrg + (bm + rr * (unsigned)ldm + (unsigned)(bj * HALF))) = w; }
                    asm volatile("" ::: "memory"); }
            }
            asm volatile("" ::: "memory");
        }
    }
};
struct EpiOutNorm {
    static constexpr bool PERM = false, AFTER_DRAIN = true;
    const float* xres; float* out; const float* fg; float* xbuf; unsigned* cnt;
    __device__ __forceinline__ void fused(f32x4 (&acc)[2][2][4][2], const Unit& u, int wr, int wc, int fr, int fq, PG8_LAS unsigned char* lds, int wid, int lane) const {
        PG8_LAS float* Pp = (PG8_LAS float*)lds; PG8_LAS float* Sr = (PG8_LAS float*)(lds + 4096);
        const int row0 = u.pm * BM + wr * 64 + fr, col0 = u.pn * BM + wc * 32 + 4 * fq;
#pragma unroll
        for (int ai = 0; ai < 2; ++ai)
#pragma unroll
            for (int m = 0; m < 4; ++m) { const size_t off = (size_t)(row0 + ai * HALF + m * 16) * 1024 + col0; float s = 0.f;
#pragma unroll
                for (int bj = 0; bj < 2; ++bj)
#pragma unroll
                    for (int n = 0; n < 2; ++n) { const f32x4 v = acc[ai][bj][m][n] + *(const f32x4*)(xres + off + bj * HALF + n * 16); acc[ai][bj][m][n] = v; s += (v[0] * v[0] + v[1] * v[1]) + (v[2] * v[2] + v[3] * v[3]); }
                s += __shfl_xor(s, 16); s += __shfl_xor(s, 32);
                if (fq == 0) Pp[(ai * HALF + wr * 64 + m * 16 + fr) * 4 + wc] = s;
                if (m == 3) asm volatile("" ::: "memory"); }
        asm volatile("s_waitcnt lgkmcnt(0)" ::: "memory"); __builtin_amdgcn_s_barrier(); asm volatile("" ::: "memory");
        const int tid = wid * 64 + lane;
        if (tid < 256) { const float s = (Pp[tid * 4 + 0] + Pp[tid * 4 + 1]) + (Pp[tid * 4 + 2] + Pp[tid * 4 + 3]);
            __hip_atomic_store(xbuf + (size_t)(u.pm * BM + tid) * 4 + u.pn, s, __ATOMIC_RELAXED, __HIP_MEMORY_SCOPE_AGENT); }
        asm volatile("s_waitcnt vmcnt(0)" ::: "memory");
        if (wid < 4 && lane == 0) __hip_atomic_fetch_add(cnt + 64 * u.pm, 1u, __ATOMIC_RELAXED, __HIP_MEMORY_SCOPE_AGENT);
        if (wid == 0) { unsigned spins = 0;
            while ((unsigned)__builtin_amdgcn_readfirstlane(__hip_atomic_load(cnt + 64 * u.pm, __ATOMIC_RELAXED, __HIP_MEMORY_SCOPE_AGENT)) < 16u && ++spins < (1u << 22)) __builtin_amdgcn_s_sleep(2);
            __builtin_amdgcn_fence(__ATOMIC_ACQUIRE, "agent"); }
        asm volatile("s_waitcnt vmcnt(0) lgkmcnt(0)" ::: "memory"); __builtin_amdgcn_s_barrier(); asm volatile("" ::: "memory");
        if (tid < 256) { const float* slot = xbuf + (size_t)(u.pm * BM + tid) * 4; float s = 0.f;
#pragma unroll
            for (int q = 0; q < 4; ++q) s += __hip_atomic_load(slot + q, __ATOMIC_RELAXED, __HIP_MEMORY_SCOPE_AGENT);
            Sr[tid] = 1.0f / sqrtf(s * (1.f / 1024.f) + 1e-6f); }
        asm volatile("s_waitcnt lgkmcnt(0)" ::: "memory"); __builtin_amdgcn_s_barrier(); asm volatile("" ::: "memory");
#pragma unroll
        for (int ai = 0; ai < 2; ++ai)
#pragma unroll
            for (int m = 0; m < 4; ++m) { const int r = ai * HALF + wr * 64 + m * 16 + fr; const float rs = Sr[r]; const size_t off = (size_t)(u.pm * BM + r) * 1024 + col0;
#pragma unroll
                for (int bj = 0; bj < 2; ++bj)
#pragma unroll
                    for (int n = 0; n < 2; ++n) { const f32x4 gg = *(const f32x4*)(fg + col0 + bj * HALF + n * 16); *(f32x4*)(out + off + bj * HALF + n * 16) = acc[ai][bj][m][n] * rs * gg; } }
    }
};
}
#define PG8_SP2 true
#define PG8_ALIGN true

__device__ __forceinline__ bf16_t* merged_ptr(const Params& p, int b) { return b == 0 ? xn_ptr(p) : proj_ptr(p) + 4096; }
__device__ __forceinline__ int merged_ld(int b) { return b == 0 ? DM : LD; }
__device__ __forceinline__ void phase1_gemm(const Params& p, int b, LAS unsigned char* lds) {
    const int G = gridDim.x, c = opq_bid();
    { pg8::Gemm g{xn_ptr(p) + (size_t)b * SEQ * DM, (const bf16_t*)(wsb(p) + WS_WIN), SEQ, 12288, DM, DM, DM}; pg8::StaticOrder S; S.init(SEQ, 12288, G, c);
      pg8::EpiBf16<0> E{proj_ptr(p), LD, nullptr, 0, 0, 1.f};
      pg8::gemm_phase<pg8::EpiBf16<0>, pg8::StaticOrder, PG8_ALIGN, PG8_SP2>(lds, g, S, E); }
    { const int tid = opq_tid(), lane = tid & 63, wave = tid >> 6, fr = lane & 15, kg = lane >> 4;
      const bf16_t* XNb = xn_ptr(p) + (size_t)b * SEQ * DM; const bf16_t* Wd = (const bf16_t*)(wsb(p) + WS_WIN) + (size_t)C_DT * DM; bf16_t* Pq = proj_ptr(p);
      LAS float* sRed = (LAS float*)lds;
      for (int rb = c; rb < SEQ / 32; rb += G) {
          __syncthreads();
          f32x4 acc[2][2];
#pragma unroll
          for (int mt = 0; mt < 2; ++mt)
#pragma unroll
              for (int nt = 0; nt < 2; ++nt) acc[mt][nt] = (f32x4){0.f, 0.f, 0.f, 0.f};
          bf16x8 af[2][4], bfr[2][4];
#pragma unroll
          for (int ks = 0; ks < 4; ++ks)
#pragma unroll
              for (int q = 0; q < 2; ++q) { af[q][ks] = *(const bf16x8*)(XNb + (size_t)(32 * rb + 16 * q + fr) * DM + 128 * wave + 32 * ks + 8 * kg);
                  bfr[q][ks] = *(const bf16x8*)(Wd + (size_t)(16 * q + fr) * DM + 128 * wave + 32 * ks + 8 * kg); }
#pragma unroll
          for (int ks = 0; ks < 4; ++ks)
#pragma unroll
              for (int mt = 0; mt < 2; ++mt)
#pragma unroll
                  for (int nt = 0; nt < 2; ++nt) acc[mt][nt] = __builtin_amdgcn_mfma_f32_16x16x32_bf16(af[mt][ks], bfr[nt][ks], acc[mt][nt], 0, 0, 0);
#pragma unroll
          for (int mt = 0; mt < 2; ++mt)
#pragma unroll
              for (int nt = 0; nt < 2; ++nt)
#pragma unroll
                  for (int j = 0; j < 4; ++j) sRed[(wave * 32 + 16 * mt + 4 * kg + j) * 32 + 16 * nt + fr] = acc[mt][nt][j];
          __syncthreads();
#pragma unroll
          for (int q = 0; q < 2; ++q) { const int e = tid + 512 * q, row = e >> 5, col = e & 31; float s = 0.f;
#pragma unroll
              for (int w2 = 0; w2 < 8; ++w2) s += sRed[(w2 * 32 + row) * 32 + col];
              Pq[(size_t)(32 * rb + row) * LD + C_DT + col] = (bf16_t)f2bf(s); }
      } }
    if (b == 0) {
        { pg8::Gemm g{(const bf16_t*)(wsb(p) + WS_MEMN), (const bf16_t*)(wsb(p) + WS_WKV), 512, 1024, DM, DM, DM}; pg8::StaticOrder S; S.init(512, 1024, G, (c + 16) % G);
          pg8::EpiBf16<0> E{(bf16_t*)(wsb(p) + WS_KVK), 1024, nullptr, 0, 0, 1.f};
          pg8::gemm_phase<pg8::EpiBf16<0>, pg8::StaticOrder, PG8_ALIGN, PG8_SP2>(lds, g, S, E); }
        { pg8::Gemm g{(const bf16_t*)(wsb(p) + WS_WKV) + (size_t)1024 * DM, (const bf16_t*)(wsb(p) + WS_MEMN), 1024, 512, DM, DM, DM}; pg8::StaticOrder S; S.init(1024, 512, G, (c + 8) % G);
          pg8::EpiBf16<0> E{(bf16_t*)(wsb(p) + WS_KVVT), 512, nullptr, 0, 0, 1.f};
          pg8::gemm_phase<pg8::EpiBf16<0>, pg8::StaticOrder, PG8_ALIGN, PG8_SP2>(lds, g, S, E); }
    }
}
__device__ __forceinline__ void phase5_gemm(const Params& p, int b, LAS unsigned char* lds) {
    const int G = gridDim.x, c = opq_bid(); bf16_t* P = proj_ptr(p); float* scr = scr_ptr(p, b);
    bf16_t* scrB = P + 2048;
    bf16_t* scrA = (bf16_t*)scr;
    unsigned* flag = (unsigned*)(wsb(p) + WS_CTL) + 4096 + (b * 128 + (c & 127)) * 16;
    if (c < 128) {
        pg8::Gemm g{P + C_Z, (const bf16_t*)(wsb(p) + WS_WSSD), SEQ, DM, 2048, LD, 2048}; pg8::StaticOrder S; S.init(SEQ, DM, 128, c); pg8::EpiMerge2<0, false> E{P, scrA, 1024, nullptr, 0, nullptr, 0};
        pg8::gemm_phase<pg8::EpiMerge2<0, false>, pg8::StaticOrder, false, PG8_SP2>(lds, g, S, E);
#ifdef PROBE_NOFENCE
        asm volatile("s_waitcnt vmcnt(0)" ::: "memory"); __syncthreads();
        if (threadIdx.x == 0) __hip_atomic_store(flag, 1u, __ATOMIC_RELAXED, __HIP_MEMORY_SCOPE_AGENT);
#else
        asm volatile("s_waitcnt vmcnt(0)" ::: "memory"); __syncthreads();
        if (threadIdx.x == 0) { __builtin_amdgcn_fence(__ATOMIC_RELEASE, "agent"); asm volatile("s_waitcnt vmcnt(0)" ::: "memory");
            __hip_atomic_store(flag, 1u, __ATOMIC_RELAXED, __HIP_MEMORY_SCOPE_AGENT); }
#endif
    } else {
        { pg8::Gemm g{P + C_LG, (const bf16_t*)(wsb(p) + WS_WLRU), SEQ, DM, 1536, LD, 1536}; pg8::StaticOrder S; S.init(SEQ, DM, 128, c - 128); pg8::EpiMerge2<1, false> E{P, scrB, LD, nullptr, 0, nullptr, 0};
          pg8::gemm_phase<pg8::EpiMerge2<1, false>, pg8::StaticOrder, false, PG8_SP2>(lds, g, S, E); }
        if (threadIdx.x == 0) { unsigned spins = 0; while (__hip_atomic_load(flag, __ATOMIC_RELAXED, __HIP_MEMORY_SCOPE_AGENT) == 0u && ++spins < (1u << 22)) __builtin_amdgcn_s_sleep(2);
#ifndef PROBE_NOFENCE
            __builtin_amdgcn_fence(__ATOMIC_ACQUIRE, "agent"); asm volatile("s_waitcnt vmcnt(0)" ::: "memory");
#endif
        }
        __syncthreads();
        { pg8::Gemm g{P + C_Q, (const bf16_t*)(wsb(p) + WS_WMEM), SEQ, DM, 1024, LD, 1024}; pg8::StaticOrder S; S.init(SEQ, DM, 128, c - 128); pg8::EpiMerge2<2, true> E{P, scrB, LD, scrA, 1024, merged_ptr(p, b), merged_ld(b)};
          pg8::gemm_phase<pg8::EpiMerge2<2, true>, pg8::StaticOrder, false, PG8_SP2>(lds, g, S, E); }
    }
    (void)G;
}
__device__ __forceinline__ void phase6_gemm(const Params& p, int b, LAS unsigned char* lds) {
    const int G = gridDim.x, c = opq_bid(); bf16_t* P = proj_ptr(p);
    pg8::Gemm g{merged_ptr(p, b), (const bf16_t*)(wsb(p) + WS_WOUT), SEQ, DM, DM, merged_ld(b), DM}; pg8::StaticOrder S; S.init(SEQ, DM, G, c);
    pg8::EpiOutNorm E{opq(p.x) + (size_t)b * SEQ * DM, opq(p.out) + (size_t)b * SEQ * DM, opq(p.final_g), (float*)(wsb(p) + WS_XBUF) + (size_t)b * SEQ * 4, (unsigned*)(wsb(p) + WS_CTL) + 8192 + b * 2048};
    pg8::gemm_phase<pg8::EpiOutNorm, pg8::StaticOrder, false, PG8_SP2>(lds, g, S, E);
}
#define MFMA16(a, b, c) __builtin_amdgcn_mfma_f32_16x16x32_bf16((a), (b), (c), 0, 0, 0)
__device__ __forceinline__ bf16x8 pack8(const float (&v)[8]) {
    u32x4 w; w.x = pk2(v[0], v[1]); w.y = pk2(v[2], v[3]); w.z = pk2(v[4], v[5]); w.w = pk2(v[6], v[7]); return __builtin_bit_cast(bf16x8, w);
}
__device__ __forceinline__ void unpack8(u32x4 w, float (&v)[8]) {
#pragma unroll
    for (int i = 0; i < 4; ++i) { v[2 * i] = __uint_as_float(w[i] << 16); v[2 * i + 1] = __uint_as_float(w[i] & 0xffff0000u); }
}
__device__ __forceinline__ void attn_phase(const Params& p, int b, LAS unsigned char* lds, int dry = 0) {
    const int tid = opq_tid(), lane = tid & 63, wave = tid >> 6, fr = lane & 15, kg = lane >> 4;
    bf16_t* P = proj_ptr(p); const bf16_t* KK = (const bf16_t*)(wsb(p) + WS_KVK) + (size_t)b * 256 * 1024; const bf16_t* VT = (const bf16_t*)(wsb(p) + WS_KVVT) + b * 256;
    LAS bf16_t* sKV = (LAS bf16_t*)lds;
    for (int u = opq_bid(); u < 256; u += gridDim.x) {
        const int hd = u & 3, rt = u >> 2, q0 = rt * 128 + wave * 16;
        bf16_t* qrow = P + (size_t)(q0 + fr) * LD + C_Q + hd * 256;
        __syncthreads();
        { unsigned ko = (unsigned)((tid >> 5) * 1024 + hd * 256 + 8 * (tid & 31)); asm volatile("" : "+v"(ko));
          u32x4 st[16];
#pragma unroll
          for (int i = 0; i < 16; ++i) st[i] = *(const u32x4*)(KK + (ko + (unsigned)(i * 16 * 1024)));
#pragma unroll
          for (int i = 0; i < 16; ++i) *(LAS u32x4*)(sKV + ((tid >> 5) + 16 * i) * 264 + 8 * (tid & 31)) = st[i]; }
        bf16x8 qf[8];
#pragma unroll
        for (int s = 0; s < 8; ++s) qf[s] = *(const bf16x8*)(qrow + 32 * s + 8 * kg);
        __syncthreads();
        u32x4 vst[16];
        { unsigned vo = (unsigned)((hd * 256 + (tid >> 5)) * 512 + 8 * (tid & 31)); asm volatile("" : "+v"(vo));
#pragma unroll
          for (int i = 0; i < 16; ++i) vst[i] = *(const u32x4*)(VT + (vo + (unsigned)(i * 16 * 512))); }
        f32x4 sacc[16];
#pragma unroll
        for (int mt = 0; mt < 16; ++mt) { sacc[mt] = (f32x4){0.f, 0.f, 0.f, 0.f};
#pragma unroll
            for (int s = 0; s < 8; ++s) { const bf16x8 kf = *(const LAS bf16x8*)(sKV + (16 * mt + fr) * 264 + 32 * s + 8 * kg); sacc[mt] = MFMA16(kf, qf[s], sacc[mt]); } }
        float mx = -INFINITY;
#pragma unroll
        for (int mt = 0; mt < 16; ++mt)
#pragma unroll
            for (int j = 0; j < 4; ++j) mx = fmaxf(mx, sacc[mt][j]);
        mx = fmaxf(mx, __shfl_xor(mx, 16)); mx = fmaxf(mx, __shfl_xor(mx, 32));
        float sum = 0.f;
#pragma unroll
        for (int mt = 0; mt < 16; ++mt)
#pragma unroll
            for (int j = 0; j < 4; ++j) { const float e = __expf((sacc[mt][j] - mx) * 0.0625f); sacc[mt][j] = e; sum += e; }
        sum += __shfl_xor(sum, 16); sum += __shfl_xor(sum, 32);
        const float inv = 1.f / sum;
        bf16x8 pf[8];
#pragma unroll
        for (int s2 = 0; s2 < 8; ++s2) { u32x4 w; w.x = pk2(sacc[2 * s2][0], sacc[2 * s2][1]); w.y = pk2(sacc[2 * s2][2], sacc[2 * s2][3]);
            w.z = pk2(sacc[2 * s2 + 1][0], sacc[2 * s2 + 1][1]); w.w = pk2(sacc[2 * s2 + 1][2], sacc[2 * s2 + 1][3]); pf[s2] = __builtin_bit_cast(bf16x8, w); }
        __syncthreads();
#pragma unroll
        for (int i = 0; i < 16; ++i) *(LAS u32x4*)(sKV + ((tid >> 5) + 16 * i) * 264 + 8 * (tid & 31)) = vst[i];
        __syncthreads();
#pragma unroll 4
        for (int mt2 = 0; mt2 < 16; ++mt2) { f32x4 o = (f32x4){0.f, 0.f, 0.f, 0.f}; const LAS bf16_t* vr = sKV + (16 * mt2 + fr) * 264 + 4 * kg;
#pragma unroll
            for (int s2 = 0; s2 < 8; ++s2) { const u32x2 lo = *(const LAS u32x2*)(vr + 32 * s2), hi = *(const LAS u32x2*)(vr + 32 * s2 + 16);
                u32x4 w; w.x = lo.x; w.y = lo.y; w.z = hi.x; w.w = hi.y; o = MFMA16(__builtin_bit_cast(bf16x8, w), pf[s2], o); }
            u32x2 ow; ow.x = pk2(o[0] * inv, o[1] * inv); ow.y = pk2(o[2] * inv, o[3] * inv);
            if (!dry) *(u32x2*)(qrow + 16 * mt2 + 4 * kg) = ow; }
    }
}
template <bool FINAL> __device__ __forceinline__ void lru_phase(const Params& p, int b, LAS unsigned char* lds, int dry = 0) {
    const int tid = opq_tid(), lane = tid & 63, wave = tid >> 6, fr = lane & 15, kg = lane >> 4;
    bf16_t* P = proj_ptr(p);
    LAS bf16_t* sWA = (LAS bf16_t*)lds; LAS bf16_t* sWX = (LAS bf16_t*)(lds + 19968);
    LAS float* sCW = (LAS float*)(lds + 39936); LAS float* sCB = sCW + 384; LAS float* sBA = sCB + 96; LAS float* sBX = sBA + 96; LAS float* sSP = sBX + 96;
    LAS float* sXL = (LAS float*)(lds + 43008) + wave * 1600;
    LAS float* sAG = (LAS float*)(lds + 94208);
    float* agg = (float*)(wsb(p) + WS_LAGG) + (size_t)b * NBLK64 * LRUW * 2;
    const float* car = (const float*)(wsb(p) + WS_LCAR) + (size_t)b * NBLK64 * LRUW;
    const float* lcw = opq(p.lru_conv_w); const float* lcb = opq(p.lru_conv_b); const float* lba = opq(p.lru_b_a); const float* lbx = opq(p.lru_b_x); const float* lam = opq(p.lru_lambda);
    for (int u = opq_bid(); u < NLB * NSEG; u += gridDim.x) {
        const int n = u % NLB, sg = u / NLB;
        __syncthreads();
        { const bf16_t* gwa = (const bf16_t*)(wsb(p) + WS_LRUWA) + n * 9216; const bf16_t* gwx = (const bf16_t*)(wsb(p) + WS_LRUWX) + n * 9216;
          u32x4 wa3[3], wx3[3]; float cwv = 0.f, v4[4] = {0.f, 0.f, 0.f, 0.f};
#pragma unroll
          for (int i = 0; i < 3; ++i) { const int e = tid + 512 * i; if (e < 96 * 12) { const int j = e / 12, c8 = e % 12; wa3[i] = *(const u32x4*)(gwa + j * 96 + 8 * c8); wx3[i] = *(const u32x4*)(gwx + j * 96 + 8 * c8); } }
          if (tid < 384) cwv = lcw[(tid / 96) * 1536 + n * 96 + tid % 96];
          if (tid < 96) { v4[0] = lcb[n * 96 + tid]; v4[1] = lba[n * 96 + tid]; v4[2] = lbx[n * 96 + tid]; v4[3] = lam[n * 96 + tid]; }
#pragma unroll
          for (int i = 0; i < 3; ++i) { const int e = tid + 512 * i; if (e < 96 * 12) { const int j = e / 12, c8 = e % 12; *(LAS u32x4*)(sWA + j * 104 + 8 * c8) = wa3[i]; *(LAS u32x4*)(sWX + j * 104 + 8 * c8) = wx3[i]; } }
          if (tid < 384) sCW[tid] = cwv;
          if (tid < 96) { sCB[tid] = v4[0]; sBA[tid] = v4[1]; sBX[tid] = v4[2]; sSP[tid] = softplusf_(-v4[3]); } }
        __syncthreads();
        float runA[6], runH[6];
#pragma unroll
        for (int nt = 0; nt < 6; ++nt) { runA[nt] = 1.f; runH[nt] = FINAL ? car[(sg * 8 + wave) * LRUW + n * 96 + 16 * nt + fr] : 0.f; }
        for (int step = 0; step < 4; ++step) {
            const int tb = sg * LSEG + wave * 64 + step * 16;
            u32x4 rawC[3][4];
            { const int t0r = tb + fr - 3; unsigned ro = (unsigned)((t0r < 0 ? 0 : t0r) * LD + C_LX + n * 96 + 8 * kg); asm volatile("" : "+v"(ro));
              if (t0r >= 0) {
#pragma unroll
                  for (int ks = 0; ks < 3; ++ks)
#pragma unroll
                      for (int k = 0; k < 4; ++k) rawC[ks][k] = *(const u32x4*)(P + (ro + (unsigned)(k * LD + 32 * ks)));
              } else {
#pragma unroll
                  for (int ks = 0; ks < 3; ++ks)
#pragma unroll
                      for (int k = 0; k < 4; ++k) { const int t = t0r + k; rawC[ks][k] = *(const u32x4*)(P + (ro + (unsigned)((t < 0 ? 0 : t) * LD + 32 * ks))); if (t < 0) rawC[ks][k] = (u32x4){0u, 0u, 0u, 0u}; }
              } }
            bf16x8 af[3];
#pragma unroll
            for (int ks = 0; ks < 3; ++ks) { const int ch0 = 32 * ks + 8 * kg; float xl[8];
#pragma unroll
                for (int i = 0; i < 8; ++i) xl[i] = sCB[ch0 + i];
#pragma unroll
                for (int k = 0; k < 4; ++k) { const u32x4 raw = rawC[ks][k];
                    float rv[8]; unpack8(raw, rv);
#pragma unroll
                    for (int i = 0; i < 8; ++i) xl[i] += sCW[k * 96 + ch0 + i] * rv[i]; }
                *(LAS f32x4*)(sXL + fr * 100 + ch0) = (f32x4){xl[0], xl[1], xl[2], xl[3]}; *(LAS f32x4*)(sXL + fr * 100 + ch0 + 4) = (f32x4){xl[4], xl[5], xl[6], xl[7]};
                af[ks] = pack8(xl); }
            LAS bf16_t* sG = (LAS bf16_t*)((LAS unsigned char*)sWA + 106496) + wave * 1536;
            unsigned go3[3]; u32x4 graw[3];
            if (FINAL) {
#pragma unroll
                for (int i = 0; i < 3; ++i) { const int e = lane + 64 * i, row = e / 12, c12 = e % 12; go3[i] = (unsigned)((tb + row) * LD + C_LG + n * 96 + 8 * c12); }
                asm volatile("" : "+v"(go3[0]), "+v"(go3[1]), "+v"(go3[2]));
#pragma unroll
                for (int i = 0; i < 3; ++i) graw[i] = *(const u32x4*)(P + go3[i]); }
            f32x4 aR[6], aI[6];
#pragma unroll
            for (int nt = 0; nt < 6; ++nt) { aR[nt] = (f32x4){0.f, 0.f, 0.f, 0.f}; aI[nt] = (f32x4){0.f, 0.f, 0.f, 0.f};
#pragma unroll
                for (int ks = 0; ks < 3; ++ks) { const bf16x8 wa = *(const LAS bf16x8*)(sWA + (16 * nt + fr) * 104 + 32 * ks + 8 * kg), wx = *(const LAS bf16x8*)(sWX + (16 * nt + fr) * 104 + 32 * ks + 8 * kg);
                    aR[nt] = MFMA16(af[ks], wa, aR[nt]); aI[nt] = MFMA16(af[ks], wx, aI[nt]); } }
            float Ainc[6][4], Hinc[6][4];
#pragma unroll
            for (int nt = 0; nt < 6; ++nt) { const int j = 16 * nt + fr; const float ba = sBA[j], bx = sBX[j], sp = sSP[j];
                float A = 1.f, H = 0.f;
#pragma unroll
                for (int r = 0; r < 4; ++r) { const float xlv = sXL[(4 * kg + r) * 100 + j];
                    const float rr = sigmoidf_(aR[nt][r] + ba), ii = sigmoidf_(aI[nt][r] + bx), la = -8.f * rr * sp, a = __expf(la), mult = __builtin_amdgcn_sqrtf(fmaxf(0.f, 1.f - a * a));
                    H = a * H + mult * ii * xlv; A *= a; Ainc[nt][r] = A; Hinc[nt][r] = H; }
                float ap = 1.f, hp = 0.f, at = 1.f, ht = 0.f;
#pragma unroll
                for (int k = 0; k < 4; ++k) { const float ab = __shfl(A, fr + 16 * k), hb = __shfl(H, fr + 16 * k);
                    if (k < kg) { hp = ab * hp + hb; ap *= ab; } ht = ab * ht + hb; at *= ab; }
                if (FINAL) { const float hin = ap * runH[nt] + hp;
#pragma unroll
                    for (int r = 0; r < 4; ++r) Hinc[nt][r] = Ainc[nt][r] * hin + Hinc[nt][r]; }
                runH[nt] = at * runH[nt] + ht; runA[nt] *= at; }
            if (FINAL) {
#pragma unroll
                for (int i = 0; i < 3; ++i) { const int e = lane + 64 * i; *(LAS u32x4*)(sG + (e / 12) * 96 + 8 * (e % 12)) = graw[i]; }
                asm volatile("s_waitcnt lgkmcnt(0)" ::: "memory");
#pragma unroll
                for (int nt = 0; nt < 6; ++nt)
#pragma unroll
                    for (int r = 0; r < 4; ++r) { LAS bf16_t* gp = sG + (4 * kg + r) * 96 + 16 * nt + fr; const float yv = Hinc[nt][r] * siluf_(bf2f(*gp)); *gp = (bf16_t)f2bf(yv); }
                asm volatile("s_waitcnt lgkmcnt(0)" ::: "memory");
#pragma unroll
                for (int i = 0; i < 3; ++i) { const int e = lane + 64 * i; const u32x4 w = *(const LAS u32x4*)(sG + (e / 12) * 96 + 8 * (e % 12)); if (!dry) *(u32x4*)(P + go3[i]) = w; }
                asm volatile("s_waitcnt lgkmcnt(0)" ::: "memory"); }
        }
        if (!FINAL && kg == 0) {
#pragma unroll
            for (int nt = 0; nt < 6; ++nt) { const int ch = n * 96 + 16 * nt + fr; agg[((size_t)(sg * 8 + wave) * LRUW + ch) * 2] = runA[nt]; agg[((size_t)(sg * 8 + wave) * LRUW + ch) * 2 + 1] = runH[nt]; } }
    }
}
__device__ __forceinline__ void lru_carry_phase(const Params& p, int b) {
    const int gt = opq_bid() * 512 + opq_tid();
    const float* agg = (const float*)(wsb(p) + WS_LAGG) + (size_t)b * NBLK64 * LRUW * 2; float* car = (float*)(wsb(p) + WS_LCAR) + (size_t)b * NBLK64 * LRUW;
    for (int ch = gt; ch < LRUW; ch += gridDim.x * 512) { float h = 0.f;
        for (int k0 = 0; k0 < NBLK64; k0 += 16) { float a[16], hh[16];
#pragma unroll
            for (int i = 0; i < 16; ++i) { a[i] = agg[((size_t)(k0 + i) * LRUW + ch) * 2]; hh[i] = agg[((size_t)(k0 + i) * LRUW + ch) * 2 + 1]; }
#pragma unroll
            for (int i = 0; i < 16; ++i) { car[(k0 + i) * LRUW + ch] = h; h = a[i] * h + hh[i]; } } }
}
__device__ __forceinline__ void conv8_silu(const bf16_t* P, int t, int col, const float* cw, const float* cb, int ch, float (&o)[8]) {
    float r[11];
    unsigned off0 = (unsigned)((t < 3 ? 0 : t - 3) * LD + col); asm volatile("" : "+v"(off0));
    if (t >= 3) {
#pragma unroll
        for (int i = 0; i < 11; ++i) r[i] = bf2f(P[off0 + (unsigned)(i * LD)]);
    } else {
#pragma unroll
        for (int i = 0; i < 11; ++i) { const int tt = t - 3 + i; const float v = bf2f(P[off0 + (unsigned)((tt < 0 ? 0 : tt) * LD)]); r[i] = tt < 0 ? 0.f : v; }
    }
    const float w0 = cw[ch], w1 = cw[3072 + ch], w2 = cw[6144 + ch], w3 = cw[9216 + ch], bb = cb[ch];
#pragma unroll
    for (int j = 0; j < 8; ++j) o[j] = siluf_(bb + w0 * r[j] + w1 * r[j + 1] + w2 * r[j + 2] + w3 * r[j + 3]);
}
__device__ __forceinline__ float ssd_dt_setup(const Params& p, const bf16_t* P, int t0, int h, int lane, LAS float* sACS, LAS float* sDT) {
    const float dtb = opq(p.ssd_dt_bias)[h], an = -__expf(opq(p.ssd_a_log)[h]);
    const float dt0 = softplusf_(bf2f(P[(size_t)(t0 + 2 * lane) * LD + C_DT + h]) + dtb), dt1 = softplusf_(bf2f(P[(size_t)(t0 + 2 * lane + 1) * LD + C_DT + h]) + dtb);
    const float dA1 = dt1 * an; float s = dt0 * an + dA1;
#pragma unroll
    for (int o = 1; o < 64; o <<= 1) { const float t = __shfl_up(s, o); if (lane >= o) s += t; }
    sACS[2 * lane] = s - dA1; sACS[2 * lane + 1] = s; sDT[2 * lane] = dt0; sDT[2 * lane + 1] = dt1;
    return __shfl(s, 63);
}
template <int R> __device__ __forceinline__ void conv_rows(const bf16_t* P, int t, int col, const float* cw, const float* cb, int ch, float (&o)[R][8]) {
    unsigned off0 = (unsigned)((t < 3 ? 0 : t - 3) * LD + col); asm volatile("" : "+v"(off0));
    u32x4 raw[R + 3];
    if (t >= 3) {
#pragma unroll
        for (int i = 0; i < R + 3; ++i) raw[i] = *(const u32x4*)(P + (off0 + (unsigned)(i * LD)));
    } else {
#pragma unroll
        for (int i = 0; i < R + 3; ++i) { const int tt = t - 3 + i; raw[i] = *(const u32x4*)(P + (off0 + (unsigned)((tt < 0 ? 0 : tt) * LD))); if (tt < 0) raw[i] = (u32x4){0u, 0u, 0u, 0u}; }
    }
    float w[4][8], bb[8];
#pragma unroll
    for (int k = 0; k < 4; ++k) { const f32x4 w0 = *(const f32x4*)(cw + k * 3072 + ch), w1 = *(const f32x4*)(cw + k * 3072 + ch + 4);
        w[k][0] = w0[0]; w[k][1] = w0[1]; w[k][2] = w0[2]; w[k][3] = w0[3]; w[k][4] = w1[0]; w[k][5] = w1[1]; w[k][6] = w1[2]; w[k][7] = w1[3]; }
    { const f32x4 b0 = *(const f32x4*)(cb + ch), b1 = *(const f32x4*)(cb + ch + 4); bb[0] = b0[0]; bb[1] = b0[1]; bb[2] = b0[2]; bb[3] = b0[3]; bb[4] = b1[0]; bb[5] = b1[1]; bb[6] = b1[2]; bb[7] = b1[3]; }
#pragma unroll
    for (int r = 0; r < R; ++r)
#pragma unroll
        for (int q = 0; q < 8; ++q) o[r][q] = bb[q];
#pragma unroll
    for (int i = 0; i < R + 3; ++i) { float v[8]; unpack8(raw[i], v);
#pragma unroll
        for (int k = 0; k < 4; ++k) { const int r = i - k; if (r >= 0 && r < R) {
#pragma unroll
                for (int q = 0; q < 8; ++q) o[r][q] += w[k][q] * v[q]; } } }
#pragma unroll
    for (int r = 0; r < R; ++r)
#pragma unroll
        for (int q = 0; q < 8; ++q) o[r][q] = siluf_(o[r][q]);
}
__device__ __forceinline__ void ssd_states_phase(const Params& p, int b, LAS unsigned char* lds) {
    const int tid = opq_tid(), lane = tid & 63, wave = tid >> 6, fr = lane & 15, kg = lane >> 4;
    const bf16_t* P = proj_ptr(p); bf16_t* ST = states_ptr(p, b); float* dasum = (float*)(wsb(p) + WS_DASUM) + b * NCHUNK * NHEAD;
    const float* cw = opq(p.ssd_conv_w); const float* cb = opq(p.ssd_conv_b);
    LAS bf16_t* sBT = (LAS bf16_t*)lds; LAS bf16_t* sXT = (LAS bf16_t*)(lds + 34816 + wave * 8704);
    LAS float* sACS = (LAS float*)(lds + 104448) + wave * 128; LAS float* sW = (LAS float*)(lds + 108544) + wave * 128;
    for (int u = opq_bid(); u < NCHUNK * NGRP; u += gridDim.x) {
        const int c = u >> 2, g = u & 3, t0 = c * CHUNK, h = 8 * g + wave;
        __syncthreads();
        { const float tot = ssd_dt_setup(p, P, t0, h, lane, sACS, sW);
          if (lane == 0) dasum[c * NHEAD + h] = tot;
          sW[2 * lane] = sW[2 * lane] * __expf(tot - sACS[2 * lane]); sW[2 * lane + 1] = sW[2 * lane + 1] * __expf(tot - sACS[2 * lane + 1]); }
        { const int cg = tid & 15, rs = tid >> 4; float o[4][8];
          conv_rows<4>(P, t0 + 4 * rs, C_B + g * 128 + 8 * cg, cw, cb, 2048 + g * 128 + 8 * cg, o);
#pragma unroll
          for (int q = 0; q < 8; ++q) { u32x2 w; w.x = pk2(o[0][q], o[1][q]); w.y = pk2(o[2][q], o[3][q]); *(LAS u32x2*)(sBT + (8 * cg + q) * 136 + 4 * rs) = w; } }
        __syncthreads();
        for (int ph = 0; ph < 2; ++ph) {
            { const int cg = lane & 3, rs = lane >> 2; float o[8][8];
              conv_rows<8>(P, t0 + 8 * rs, C_X + h * 64 + 32 * ph + 8 * cg, cw, cb, h * 64 + 32 * ph + 8 * cg, o);
              const f32x4 w0 = *(const LAS f32x4*)(sW + 8 * rs), w1 = *(const LAS f32x4*)(sW + 8 * rs + 4);
#pragma unroll
              for (int q = 0; q < 8; ++q) { float v[8] = {o[0][q] * w0[0], o[1][q] * w0[1], o[2][q] * w0[2], o[3][q] * w0[3], o[4][q] * w1[0], o[5][q] * w1[1], o[6][q] * w1[2], o[7][q] * w1[3]};
                  *(LAS bf16x8*)(sXT + (8 * cg + q) * 136 + 8 * rs) = pack8(v); } }
            asm volatile("s_waitcnt lgkmcnt(0)" ::: "memory");
            f32x4 acc[8][2];
#pragma unroll
            for (int mt = 0; mt < 8; ++mt) { acc[mt][0] = (f32x4){0.f, 0.f, 0.f, 0.f}; acc[mt][1] = (f32x4){0.f, 0.f, 0.f, 0.f}; }
#pragma unroll
            for (int s = 0; s < 4; ++s) { const bf16x8 x0 = *(const LAS bf16x8*)(sXT + fr * 136 + 32 * s + 8 * kg), x1 = *(const LAS bf16x8*)(sXT + (16 + fr) * 136 + 32 * s + 8 * kg);
#pragma unroll
                for (int mt = 0; mt < 8; ++mt) { const bf16x8 a = *(const LAS bf16x8*)(sBT + (16 * mt + fr) * 136 + 32 * s + 8 * kg);
                    acc[mt][0] = MFMA16(a, x0, acc[mt][0]); acc[mt][1] = MFMA16(a, x1, acc[mt][1]); } }
            asm volatile("s_waitcnt lgkmcnt(0)" ::: "memory");
#pragma unroll
            for (int mt = 0; mt < 8; ++mt)
#pragma unroll
                for (int nt = 0; nt < 2; ++nt) { const int n0 = 16 * mt + 4 * kg, pp = 32 * ph + 16 * nt + fr;
                    u32x2 w; w.x = pk2(acc[mt][nt][0], acc[mt][nt][1]); w.y = pk2(acc[mt][nt][2], acc[mt][nt][3]);
                    *(u32x2*)(ST + ((size_t)(c * NHEAD + h) * 64 + pp) * 128 + n0) = w; }
        }
    }
}
__device__ __forceinline__ void ssd_scan_phase(const Params& p, int b, int dry = 0) {
    unsigned* st = (unsigned*)states_ptr(p, b); const float* dasum = (const float*)(wsb(p) + WS_DASUM) + b * NCHUNK * NHEAD;
    for (int e2 = opq_bid() * 512 + opq_tid(); e2 < 131072; e2 += gridDim.x * 512) {
        const int h = e2 >> 12; float r0 = 0.f, r1 = 0.f;
        for (int c0 = 0; c0 < NCHUNK; c0 += 16) { unsigned v[16]; float d[16];
#pragma unroll
            for (int i = 0; i < 16; ++i) { v[i] = st[(size_t)(c0 + i) * 131072 + e2]; d[i] = dasum[(c0 + i) * NHEAD + h]; }
#pragma unroll
            for (int i = 0; i < 16; ++i) { const unsigned w = pk2(r0, r1); const float dd = __expf(d[i]);
                r0 = r0 * dd + __uint_as_float(v[i] << 16); r1 = r1 * dd + __uint_as_float(v[i] & 0xffff0000u); v[i] = w; }
            if (!dry) {
#pragma unroll
                for (int i = 0; i < 16; ++i) st[(size_t)(c0 + i) * 131072 + e2] = v[i]; } }
    }
}
__device__ __forceinline__ void ssd_out_phase(const Params& p, int b, LAS unsigned char* lds, int dry = 0) {
    const int tid = opq_tid(), lane = tid & 63, wave = tid >> 6, fr = lane & 15, kg = lane >> 4;
    bf16_t* P = proj_ptr(p); const bf16_t* ST = states_ptr(p, b);
    const float* cw = opq(p.ssd_conv_w); const float* cb = opq(p.ssd_conv_b);
    LAS bf16_t* sC = (LAS bf16_t*)lds; LAS bf16_t* sCB = (LAS bf16_t*)(lds + 34816); LAS bf16_t* sB = (LAS bf16_t*)(lds + 69632); LAS bf16_t* sXT = (LAS bf16_t*)(lds + 69632 + wave * 8704);
    LAS float* sACS = (LAS float*)(lds + 139264) + wave * 128; LAS float* sDT = (LAS float*)(lds + 143360) + wave * 128; LAS float* sSSQ = (LAS float*)(lds + 147456);
    for (int u = opq_bid(); u < NCHUNK * NGRP; u += gridDim.x) {
        const int c = u >> 2, g = u & 3, t0 = c * CHUNK, h = 8 * g + wave;
        __syncthreads();
        MSTAMP(p, 0);
        (void)ssd_dt_setup(p, P, t0, h, lane, sACS, sDT);
        { const int cg = tid & 15, rs = (tid >> 4) & 15, isC = tid >> 8; float o[8][8];
          conv_rows<8>(P, t0 + 8 * rs, C_B + isC * 512 + g * 128 + 8 * cg, cw, cb, 2048 + isC * 512 + g * 128 + 8 * cg, o);
          LAS bf16_t* dst = (isC ? sC : sB) + (8 * rs) * 136 + 8 * cg;
#pragma unroll
          for (int r = 0; r < 8; ++r) *(LAS bf16x8*)(dst + r * 136) = pack8(o[r]); }
        __syncthreads();
#pragma unroll
        for (int ms = 0; ms < 8; ++ms) if (ms <= wave) { f32x4 a4 = (f32x4){0.f, 0.f, 0.f, 0.f};
#pragma unroll
            for (int kn = 0; kn < 4; ++kn) { const bf16x8 a = *(const LAS bf16x8*)(sB + (16 * ms + fr) * 136 + 32 * kn + 8 * kg), bb = *(const LAS bf16x8*)(sC + (16 * wave + fr) * 136 + 32 * kn + 8 * kg);
                a4 = MFMA16(a, bb, a4); }
            u32x2 w; w.x = pk2(a4[0], a4[1]); w.y = pk2(a4[2], a4[3]);
            *(LAS u32x2*)(sCB + (16 * wave + fr) * 136 + 16 * ms + 4 * kg) = w; }
        __syncthreads();
        MSTAMP(p, 1);
        const float Dh = opq(p.ssd_d)[h];
        const unsigned zbase0 = (unsigned)((t0 + fr) * LD + C_Z + h * 64 + 4 * kg);
        float ssq[8];
#pragma unroll
        for (int nt = 0; nt < 8; ++nt) ssq[nt] = 0.f;
        for (int ph = 0; ph < 2; ++ph) {
            unsigned zb = zbase0 + 32u * ph; asm volatile("" : "+v"(zb));
            unsigned pfo = (unsigned)(((c * NHEAD + h) * 64 + 32 * ph + fr) * 128 + 8 * kg); asm volatile("" : "+v"(pfo));
            bf16x8 pf[4][2];
#pragma unroll
            for (int sn = 0; sn < 4; ++sn) { pf[sn][0] = *(const bf16x8*)(ST + (pfo + (unsigned)(32 * sn))); pf[sn][1] = *(const bf16x8*)(ST + (pfo + (unsigned)(16 * 128 + 32 * sn))); }
            { const int cg = lane & 3, rs = lane >> 2; float o[8][8];
              conv_rows<8>(P, t0 + 8 * rs, C_X + h * 64 + 32 * ph + 8 * cg, cw, cb, h * 64 + 32 * ph + 8 * cg, o);
#pragma unroll
              for (int q = 0; q < 8; ++q) { float v[8] = {o[0][q], o[1][q], o[2][q], o[3][q], o[4][q], o[5][q], o[6][q], o[7][q]};
                  *(LAS bf16x8*)(sXT + (8 * cg + q) * 136 + 8 * rs) = pack8(v); } }
            asm volatile("s_waitcnt lgkmcnt(0)" ::: "memory");
            f32x4 acc[2][8];
#pragma unroll
            for (int nt = 0; nt < 8; ++nt) { acc[0][nt] = (f32x4){0.f, 0.f, 0.f, 0.f}; acc[1][nt] = (f32x4){0.f, 0.f, 0.f, 0.f}; }
#pragma unroll
            for (int nt = 0; nt < 8; ++nt) {
#pragma unroll
                for (int sn = 0; sn < 4; ++sn) { const bf16x8 cf = *(const LAS bf16x8*)(sC + (16 * nt + fr) * 136 + 32 * sn + 8 * kg);
                    acc[0][nt] = MFMA16(pf[sn][0], cf, acc[0][nt]); acc[1][nt] = MFMA16(pf[sn][1], cf, acc[1][nt]); }
                const float sc = __expf(sACS[16 * nt + fr]);
                acc[0][nt] *= sc; acc[1][nt] *= sc; }
#pragma unroll
            for (int sk = 0; sk < 4; ++sk) {
                const int s0 = 32 * sk + 8 * kg;
                const bf16x8 xa0 = *(const LAS bf16x8*)(sXT + fr * 136 + s0), xa1 = *(const LAS bf16x8*)(sXT + (16 + fr) * 136 + s0);
                const f32x4 as0 = *(const LAS f32x4*)(sACS + s0), as1 = *(const LAS f32x4*)(sACS + s0 + 4), d0 = *(const LAS f32x4*)(sDT + s0), d1 = *(const LAS f32x4*)(sDT + s0 + 4);
#pragma unroll
                for (int nt = 0; nt < 8; ++nt) if (nt >= 2 * sk) { const int l = 16 * nt + fr; const float acsl = sACS[l];
                    float cbv[8]; unpack8(*(const LAS u32x4*)(sCB + l * 136 + s0), cbv);
                    float m[8];
#pragma unroll
                    for (int i = 0; i < 8; ++i) { const int s = s0 + i; const float as = i < 4 ? as0[i & 3] : as1[i & 3], ds = i < 4 ? d0[i & 3] : d1[i & 3];
                        float mv = (s <= l) ? cbv[i] * __expf(acsl - as) * ds : 0.f; if (s == l) mv += Dh; m[i] = mv; }
                    const bf16x8 mb = pack8(m);
                    acc[0][nt] = MFMA16(xa0, mb, acc[0][nt]); acc[1][nt] = MFMA16(xa1, mb, acc[1][nt]);
                    asm volatile("" ::: "memory"); }
            }
            u32x2 zall[8][2];
#pragma unroll
            for (int nt = 0; nt < 8; ++nt)
#pragma unroll
                for (int mt = 0; mt < 2; ++mt) zall[nt][mt] = *(const u32x2*)(P + (zb + (unsigned)(16 * nt * LD + 16 * mt)));
#pragma unroll
            for (int nt = 0; nt < 8; ++nt)
#pragma unroll
                for (int mt = 0; mt < 2; ++mt) { u32x2* zp = (u32x2*)(P + (zb + (unsigned)(16 * nt * LD + 16 * mt)));
                    const u32x2 zw = zall[nt][mt]; float y[4];
                    y[0] = acc[mt][nt][0] * siluf_(__uint_as_float(zw.x << 16)); y[1] = acc[mt][nt][1] * siluf_(__uint_as_float(zw.x & 0xffff0000u));
                    y[2] = acc[mt][nt][2] * siluf_(__uint_as_float(zw.y << 16)); y[3] = acc[mt][nt][3] * siluf_(__uint_as_float(zw.y & 0xffff0000u));
                    ssq[nt] += (y[0] * y[0] + y[1] * y[1]) + (y[2] * y[2] + y[3] * y[3]);
                    u32x2 yw; yw.x = pk2(y[0], y[1]); yw.y = pk2(y[2], y[3]); (void)zp; *(LAS u32x2*)(sXT + (16 * nt + fr) * 32 + 16 * mt + 4 * kg) = yw; }
            asm volatile("s_waitcnt lgkmcnt(0)" ::: "memory");
            { const int rr = lane >> 2, cc = lane & 3;
              unsigned so = (unsigned)((t0 + rr) * LD + C_Z + h * 64 + 32 * ph + 8 * cc); asm volatile("" : "+v"(so));
#pragma unroll
              for (int i = 0; i < 8; ++i) { const u32x4 w = *(const LAS u32x4*)(sXT + (16 * i + rr) * 32 + 8 * cc); if (!dry) *(u32x4*)(P + (so + (unsigned)(16 * i * LD))) = w; } }
            asm volatile("s_waitcnt lgkmcnt(0)" ::: "memory");
        }
        MSTAMP(p, 2);
#pragma unroll
        for (int nt = 0; nt < 8; ++nt) { float v = ssq[nt]; v += __shfl_xor(v, 16); v += __shfl_xor(v, 32); if (kg == 0) sSSQ[wave * 128 + 16 * nt + fr] = v; }
        __syncthreads();
        { const int rr = lane >> 2, cc = lane & 3;
          const float* ng = opq(p.ssd_norm_g) + g * 512 + wave * 64 + 8 * cc;
          f32x4 gg[2][2];
#pragma unroll
          for (int ph = 0; ph < 2; ++ph) { gg[ph][0] = *(const f32x4*)(ng + 32 * ph); gg[ph][1] = *(const f32x4*)(ng + 32 * ph + 4); }
          unsigned so = (unsigned)((t0 + rr) * LD + C_Z + h * 64 + 8 * cc); asm volatile("" : "+v"(so));
          u32x4 yv[8][2];
#pragma unroll
          for (int i = 0; i < 8; ++i)
#pragma unroll
              for (int ph = 0; ph < 2; ++ph) yv[i][ph] = *(const u32x4*)(P + (so + (unsigned)(16 * i * LD + 32 * ph)));
#pragma unroll
          for (int i = 0; i < 8; ++i) { const int l = 16 * i + rr; float tot = 0.f;
#pragma unroll
              for (int w2 = 0; w2 < 8; ++w2) tot += sSSQ[w2 * 128 + l];
              const float rs = 1.f / sqrtf(tot * (1.f / 512.f) + EPS);
#pragma unroll
              for (int ph = 0; ph < 2; ++ph) { float v[8]; unpack8(yv[i][ph], v);
                  v[0] *= rs * gg[ph][0][0]; v[1] *= rs * gg[ph][0][1]; v[2] *= rs * gg[ph][0][2]; v[3] *= rs * gg[ph][0][3];
                  v[4] *= rs * gg[ph][1][0]; v[5] *= rs * gg[ph][1][1]; v[6] *= rs * gg[ph][1][2]; v[7] *= rs * gg[ph][1][3];
                  if (!dry) *(bf16x8*)(P + (so + (unsigned)(16 * i * LD + 32 * ph))) = pack8(v); } } }
        MSTAMP(p, 3);
    }
}
#define XB_TMO      128
#define XB_XCNT(j)  (256  + 64 * (j))
#define XB_XSUB(j)  (1280 + 64 * (j))
#define XB_XGEN(j)  (2304 + 64 * (j))
#define XB_TOP      3328
#define XB_TOPGEN   3392
#define XCD_BAR_WORDS 3456
#define XB_SPIN_CAP (1u << 18)

__device__ __forceinline__ unsigned xb_ld(unsigned* p)              { return __hip_atomic_load(p, __ATOMIC_RELAXED, __HIP_MEMORY_SCOPE_AGENT); }
__device__ __forceinline__ unsigned xb_add(unsigned* p, unsigned v) { return __hip_atomic_fetch_add(p, v, __ATOMIC_RELAXED, __HIP_MEMORY_SCOPE_AGENT); }
__device__ __forceinline__ unsigned xb_xcc_id() { return (unsigned)__builtin_amdgcn_s_getreg((3 << 11) | 20) & 0xFu; }
#define XB_SPIN(cond, bar) do { unsigned _sp = 0; while (cond) { __builtin_amdgcn_s_sleep(1); \
    if ((++_sp & 255u) == 0u) { if (xb_ld(&(bar)[XB_TMO])) break; if (_sp > XB_SPIN_CAP) { atomicAdd(&(bar)[XB_TMO], 1u); break; } } } } while (0)

struct XcdBarrier {
    unsigned* bar; unsigned x;
    volatile LAS unsigned* st;
};

__device__ __forceinline__ XcdBarrier xcd_barrier_post(unsigned* bar, volatile LAS unsigned* st) {
    XcdBarrier b; b.bar = bar; b.x = xb_xcc_id(); b.st = st;
    if (threadIdx.x == 0) (void)xb_add(&bar[XB_XCNT(b.x)], 1u);
    return b;
}
__device__ __forceinline__ void xcd_barrier_complete(unsigned* bar, unsigned x, unsigned& nloc, unsigned& nx) {
    const unsigned G = gridDim.x * gridDim.y * gridDim.z;
    unsigned sum, cnt, mine, sp = 0u;
    for (;;) {
        sum = 0u; cnt = 0u; mine = 0u;
#pragma unroll
        for (unsigned j = 0; j < 16; ++j) { const unsigned c = xb_ld(&bar[XB_XCNT(j)]); sum += c; cnt += (c > 0u) ? 1u : 0u; mine = (j == x) ? c : mine; }
        if (sum == G) break;
        __builtin_amdgcn_s_sleep(1);
        if ((++sp & 255u) == 0u) { if (xb_ld(&bar[XB_TMO])) break; if (sp > XB_SPIN_CAP) { atomicAdd(&bar[XB_TMO], 1u); break; } }
    }
    nloc = mine > 0u ? mine : 1u; nx = cnt > 0u ? cnt : 1u;
}

__device__ __forceinline__ void xcd_barrier(const XcdBarrier& b) {
    asm volatile("s_waitcnt vmcnt(0)" ::: "memory");
    __syncthreads();
    if (threadIdx.x == 0) {
        unsigned* bar = b.bar; asm volatile("" : "+s"(bar));
        unsigned bx = b.x; asm volatile("" : "+s"(bx));
        __builtin_amdgcn_s_waitcnt(0);
        unsigned nloc = b.st[0], nx = b.st[1];
        if (nloc == 0u) { xcd_barrier_complete(bar, bx, nloc, nx); b.st[0] = nloc; b.st[1] = nx; }
        const unsigned old = xb_add(&bar[XB_XSUB(bx)], 1u);
        const unsigned gen = old / nloc;
        if (old + 1u == (gen + 1u) * nloc) {
            __builtin_amdgcn_fence(__ATOMIC_RELEASE, "agent");
            asm volatile("s_waitcnt vmcnt(0)" ::: "memory");
            const unsigned og = xb_add(&bar[XB_TOP], 1u);
            const unsigned tg = og / nx;
            if (og + 1u == (tg + 1u) * nx) xb_add(&bar[XB_TOPGEN], 1u);
            else XB_SPIN(xb_ld(&bar[XB_TOPGEN]) == tg, bar);
            __builtin_amdgcn_fence(__ATOMIC_ACQUIRE, "agent");
            xb_add(&bar[XB_XGEN(bx)], 1u);
            asm volatile("s_waitcnt vmcnt(0)" ::: "memory");
        } else {
            XB_SPIN(xb_ld(&bar[XB_XGEN(bx)]) == gen, bar);
            __builtin_amdgcn_fence(__ATOMIC_ACQUIRE, "agent");
            asm volatile("s_waitcnt vmcnt(0)" ::: "memory");
        }
    }
    __syncthreads();
}

#ifdef REP_COLD
#define REP_SEP() xcd_barrier(bar)
#else
#define REP_SEP() __syncthreads()
#endif
#define RUNP(n, ...) do { if ((n) > 1) { for (int r_ = nrep(n) - 1; r_ > 0; --r_) { const int dry_ = 1; (void)dry_; __VA_ARGS__; REP_SEP(); } } { const int dry_ = 0; (void)dry_; __VA_ARGS__; } } while (0)
#ifndef REP_SYNC
#define REP_SYNC 1
#endif
#ifndef REP_P0
#define REP_P0 1
#endif
#ifndef REP_P1
#define REP_P1 1
#endif
#ifndef REP_P5
#define REP_P5 1
#endif
#ifndef REP_P6
#define REP_P6 1
#endif
#ifndef REP_ST
#define REP_ST 1
#endif
#ifndef REP_LA
#define REP_LA 1
#endif
#ifndef REP_AT
#define REP_AT 1
#endif
#ifndef REP_SC
#define REP_SC 1
#endif
#ifndef REP_SO
#define REP_SO 1
#endif
#ifndef REP_LF
#define REP_LF 1
#endif
__device__ __forceinline__ int nrep(int n) { asm volatile("" : "+s"(n)); return n; }
__device__ __forceinline__ LAS unsigned char* opl(LAS unsigned char* q) { asm volatile("" : "+s"(q)); return q; }
__global__ void __launch_bounds__(512) mk(Params p) {
    extern __shared__ __attribute__((aligned(16))) unsigned char lds_raw[];
    LAS unsigned char* lds = (LAS unsigned char*)lds_raw;
    if (threadIdx.x < 4) ((volatile LAS unsigned*)(lds + LDS_BYTES - 16))[threadIdx.x] = 0u;
    __syncthreads();
    const XcdBarrier bar = xcd_barrier_post((unsigned*)(p.ws + WS_CTL), (volatile LAS unsigned*)(lds + LDS_BYTES - 16));
    if (p.hi > 1000) cg::this_grid().sync();
#ifdef PROBE_SPAN
    unsigned long long ts0 = 0, ts1 = 0;
#define STAMP(i) do { if ((i) == PROBE_SPAN) ts0 = __builtin_amdgcn_s_memrealtime(); if ((i) == PROBE_SPAN + PROBE_LEN) ts1 = __builtin_amdgcn_s_memrealtime(); } while (0)
#else
#define STAMP(i) do { } while (0)
#endif
    STAMP(0);
    RUNP(REP_P0, phase0(p, opl(lds)));
    xcd_barrier(bar); STAMP(1);
#define BATCH_PHASES(b) do { \
        RUNP(REP_P1, phase1_gemm(p, b, opl(lds))); \
        for (int r = 0; r < nrep(REP_SYNC); ++r) xcd_barrier(bar); \
        STAMP(2 + 6 * b); \
        RUNP(REP_ST, ssd_states_phase(p, b, opl(lds))); \
        __syncthreads(); STAMP(20 + 3 * b); \
        RUNP(REP_LA, lru_phase<false>(p, b, opl(lds), 0)); \
        __syncthreads(); STAMP(21 + 3 * b); \
        RUNP(REP_AT, attn_phase(p, b, opl(lds), dry_)); \
        xcd_barrier(bar); STAMP(3 + 6 * b); \
        RUNP(REP_SC, ssd_scan_phase(p, b, dry_)); \
        lru_carry_phase(p, b); \
        xcd_barrier(bar); STAMP(4 + 6 * b); \
        RUNP(REP_SO, ssd_out_phase(p, b, opl(lds), dry_)); \
        __syncthreads(); STAMP(22 + 3 * b); \
        RUNP(REP_LF, lru_phase<true>(p, b, opl(lds), dry_)); \
        xcd_barrier(bar); STAMP(5 + 6 * b); \
        RUNP(REP_P5, phase5_gemm(p, b, opl(lds))); \
        xcd_barrier(bar); STAMP(6 + 6 * b); \
        RUNP(REP_P6, phase6_gemm(p, b, opl(lds))); \
        if (b + 1 < NBATCH) xcd_barrier(bar); \
        STAMP(7 + 6 * b); \
    } while (0)
    BATCH_PHASES(0);
    BATCH_PHASES(1);
#ifdef PROBE_MA
    if (blockIdx.x == 0 && threadIdx.x == 0) { const unsigned long long* tsm = (const unsigned long long*)(p.ws + 255 * MiB); const unsigned long long t2 = __builtin_amdgcn_s_memrealtime(), want = 8ull * (tsm[PROBE_MB] - tsm[PROBE_MA]);
        while (__builtin_amdgcn_s_memrealtime() - t2 < want) __builtin_amdgcn_s_sleep(16); }
#endif
#ifdef PROBE_SPAN
    if (blockIdx.x == 0 && threadIdx.x == 0) { const unsigned long long t2 = __builtin_amdgcn_s_memrealtime(), want = 8ull * (ts1 - ts0);
        while (__builtin_amdgcn_s_memrealtime() - t2 < want) __builtin_amdgcn_s_sleep(16); }
#endif
}

static void launch_mk(Params& p, int lo, int hi, int grid, hipStream_t stream) {
    p.lo = lo; p.hi = hi; void* args[] = {&p};
    (void)hipMemsetAsync(p.ws + WS_CTL, 0, 65536, stream);
    hipError_t e = hipLaunchCooperativeKernel((const void*)mk, dim3(grid), dim3(512), args, LDS_BYTES, stream);
    if (e != hipSuccess) fprintf(stderr, "cooperative launch failed: %s (grid %d)\n", hipGetErrorString(e), grid);
}
extern "C" void kernel_launch(void* const* d_in, const int* in_sizes, int n_in, void* d_out, int out_size, void* d_ws, size_t ws_size, hipStream_t stream) {
    static int grid = 0;
    if (grid == 0) {
        if (n_in != 24 || out_size != MTOK * DM || ws_size < WS_END) { fprintf(stderr, "kernel_launch: unexpected shapes (n_in %d out %d ws %zu)\n", n_in, out_size, ws_size); grid = -1; return; }
        int dev = 0, cus = 0, per_cu = 0;
        hipGetDevice(&dev); hipDeviceGetAttribute(&cus, hipDeviceAttributeMultiprocessorCount, dev);
        hipFuncSetAttribute((const void*)mk, hipFuncAttributeMaxDynamicSharedMemorySize, LDS_BYTES);
        hipOccupancyMaxActiveBlocksPerMultiprocessor(&per_cu, (const void*)mk, 512, LDS_BYTES);
        if (per_cu < 1) { fprintf(stderr, "kernel_launch: occupancy query says %d blocks/CU\n", per_cu); per_cu = 1; }
        grid = cus * 1;
        (void)hipGetLastError();
    }
    if (grid < 0) return;
    Params p{};
    const float** f = (const float**)&p;
    for (int i = 0; i < 24; ++i) f[i] = (const float*)d_in[i];
    p.out = (float*)d_out; p.ws = (unsigned char*)d_ws;
    launch_mk(p, 0, 14, grid, stream);
}
```

```cpp
#define NAIVE_GEMM 0
#define NAIVE_ATT 0
#define NAIVE_LRU 0
#define NAIVE_SSD 0
#define ONE_LAUNCH 1

#include <hip/hip_runtime.h>
#include <hip/hip_cooperative_groups.h>
#include <cstdio>
#include <cstdint>
namespace cg = cooperative_groups;

#ifndef NAIVE_GEMM
#define NAIVE_GEMM 1
#endif
#ifndef NAIVE_SSD
#define NAIVE_SSD 1
#endif
#ifndef NAIVE_LRU
#define NAIVE_LRU 1
#endif
#ifndef NAIVE_ATT
#define NAIVE_ATT 1
#endif
#ifndef ONE_LAUNCH
#define ONE_LAUNCH 0
#endif

namespace pg8 {
#define PG8_LAS __attribute__((address_space(3)))
typedef unsigned short bf16_t;
typedef short bf16x8 __attribute__((ext_vector_type(8)));
typedef float f32x4 __attribute__((ext_vector_type(4)));
typedef unsigned u32x4 __attribute__((ext_vector_type(4)));
constexpr int BM = 256, BK = 64, HALF = 128, HTB = HALF * BK * 2  , STAGE_BYTES = 8 * HTB, NXCD = 8, WGM = 8;

__host__ __device__ __forceinline__ int lds_byte(int r, int c) { const int st = (r >> 4) * 2 + (c >> 5), rr = r & 15, cc = c & 31, ob = rr * 64 + cc * 2; return st * 1024 + (ob ^ (((ob >> 9) & 1) << 5)); }
__host__ __device__ __forceinline__ void stage_rc(int b, int& R, int& C) { const int st = b / 1024, sb = b % 1024, swz = sb ^ (((sb >> 9) & 1) << 5); R = (st >> 1) * 16 + swz / 64; C = (st & 1) * 32 + (swz % 64) / 2; }
__host__ __device__ __forceinline__ int perm32(int rho) { const int n = rho >> 4, i = rho & 15; return 8 * (i >> 2) + 4 * n + (i & 3); }

struct Unit { int pm, pn; };
struct Gemm { const bf16_t* A; const bf16_t* Bt; int M, N, K, lda, ldb; };

struct StaticOrder {
    int nM, nN, nwg, G, c;
    __host__ __device__ void init(int M, int N, int G_, int c_) { nM = M / BM; nN = N / BM; nwg = nM * nN; G = G_; c = c_; }
    __host__ __device__ bool next(int i, Unit& u) const {
        const long L = (long)i * G + c; if (L >= nwg) return false;
        int wgid = (int)L; { const int q = nwg / NXCD, r = nwg % NXCD, xcd = wgid % NXCD, off = wgid / NXCD; wgid = (xcd < r ? xcd * (q + 1) : r * (q + 1) + (xcd - r) * q) + off; }
        const int nig = WGM * nN, gid = wgid / nig, fm = gid * WGM, gsz = (nM - fm) < WGM ? (nM - fm) : WGM;
        u.pm = fm + ((wgid % nig) % gsz); u.pn = (wgid % nig) / gsz; return true;
    }
    __device__ __forceinline__ void a_ready(const Unit&) const {}
    __device__ __forceinline__ void done(const Unit&) const {}
};

__device__ __forceinline__ unsigned cvt_pk_bf16(float lo, float hi) { unsigned r; asm volatile("v_cvt_pk_bf16_f32 %0, %1, %2" : "=v"(r) : "v"(lo), "v"(hi)); return r; }
typedef float f32x2 __attribute__((ext_vector_type(2)));
__device__ __forceinline__ f32x2 gelu_pk(f32x2 v) {
    const f32x2 av = __builtin_elementwise_abs(v), d = av * 0.2316418882f + 1.0f;
    f32x2 t; t.x = __builtin_amdgcn_rcpf(d.x); t.y = __builtin_amdgcn_rcpf(d.y);
    f32x2 q = t * 0.5307027145f + (-0.7265760135f); q = q * t + 0.7107068705f; q = q * t + (-0.142248368f); q = q * t + 0.127414796f; q = q * t;
    const f32x2 s = (v * v) * (-0.72134752044f);
    f32x2 e; e.x = __builtin_amdgcn_exp2f(s.x); e.y = __builtin_amdgcn_exp2f(s.y);
    const f32x2 m = v * (q * e), r = v - m;
    f32x2 o; o.x = v.x < 0.f ? m.x : r.x; o.y = v.y < 0.f ? m.y : r.y; return o;
}

template <int ACT  > struct EpiBf16 {
    static constexpr bool PERM = true, AFTER_DRAIN = false; static_assert(ACT == 0 || ACT == 1, "EpiBf16: ACT is 0 (none) or 1 (gelu_pk)");
    bf16_t* O; int ldc; const float* bias; int split_cols; size_t split_stride; float scale0;
    __device__ __forceinline__ void operator()(const f32x4 (&acc)[2][2][4][2], const Unit& u, int wr, int wc, int fr, int fq) const {
        const int row0 = u.pm * BM + wr * 64 + fr; int colt = u.pn * BM; bf16_t* base = O;
        float sc = 1.f; if (split_cols) { const int t = colt / split_cols; base += (size_t)t * split_stride; colt -= t * split_cols; if (t == 0) sc = scale0; }
        const int col0 = colt + wc * 32 + 8 * fq, bcol0 = u.pn * BM + wc * 32 + 8 * fq;
        f32x4 bv[2][2];
#pragma unroll
        for (int bj = 0; bj < 2; ++bj)
#pragma unroll
            for (int n = 0; n < 2; ++n) bv[bj][n] = bias ? *(const f32x4*)(bias + bcol0 + bj * HALF + 4 * n) : (f32x4){0.f, 0.f, 0.f, 0.f};
#pragma unroll
        for (int ai = 0; ai < 2; ++ai)
#pragma unroll
            for (int m = 0; m < 4; ++m) { bf16_t* rowp = base + (size_t)(row0 + ai * HALF + m * 16) * ldc + col0;
#pragma unroll
                for (int bj = 0; bj < 2; ++bj) { f32x4 v0 = acc[ai][bj][m][0] + bv[bj][0], v1 = acc[ai][bj][m][1] + bv[bj][1];
                    if (ACT == 1) { f32x2 a = gelu_pk((f32x2){v0[0], v0[1]}), b = gelu_pk((f32x2){v0[2], v0[3]}), c = gelu_pk((f32x2){v1[0], v1[1]}), d = gelu_pk((f32x2){v1[2], v1[3]});
                        v0 = (f32x4){a.x, a.y, b.x, b.y}; v1 = (f32x4){c.x, c.y, d.x, d.y}; }
                    v0 = v0 * sc; v1 = v1 * sc; u32x4 w; w.x = cvt_pk_bf16(v0[0], v0[1]); w.y = cvt_pk_bf16(v0[2], v0[3]); w.z = cvt_pk_bf16(v1[0], v1[1]); w.w = cvt_pk_bf16(v1[2], v1[3]);
                    *(u32x4*)(rowp + bj * HALF) = w; } }
    }
};
template <class Epi, class Sched, bool ALIGN_EPI = false, bool SP2 = false>
__device__ __forceinline__ void gemm_phase(PG8_LAS unsigned char* lds, const Gemm g, const Sched& S, const Epi& E) {
    int tid_ = threadIdx.x; asm volatile("" : "+v"(tid_));
    const int tid = tid_, wid = __builtin_amdgcn_readfirstlane(tid >> 6), lane = tid & 63, wr = wid >> 2, wc = wid & 3, fr = lane & 15, fq = lane >> 4;
    const int K = g.K, nt = K / BK;
    unsigned voffA[2], voffB[2];
#pragma unroll
    for (int i = 0; i < 2; ++i) { int R, C; stage_rc(tid * 16 + i * 8192, R, C); const int Rb = Epi::PERM ? ((R & ~31) + perm32(R & 31)) : R;
        voffA[i] = (unsigned)(R * g.lda + C) * 2u; voffB[i] = (unsigned)(Rb * g.ldb + C) * 2u; }
    const size_t kstep = (size_t)(BK * 2);
    const size_t hstepA = (size_t)HALF * g.lda * 2, hstepB = (size_t)HALF * g.ldb * 2;
    const size_t tstepA = 2 * hstepA, tstepB = 2 * hstepB;
    const unsigned ldsw = (unsigned)wid * 1024u;
    const int aoff = lds_byte(wr * 64 + fr, fq * 8), boff = lds_byte(wc * 32 + fr, fq * 8);
#define PG8_SA(b, h) (((b) * 2 + (h)) * HTB)
#define PG8_SB(b, h) ((4 + (b) * 2 + (h)) * HTB)
#define PG8_STAGE(bufoff, gbase, voff) do { _Pragma("unroll") for (int _i = 0; _i < 2; ++_i) \
        __builtin_amdgcn_global_load_lds((const unsigned*)((const char*)(gbase) + (voff)[_i]), (PG8_LAS unsigned*)(lds + (bufoff) + ldsw + _i * 8192), 16, 0, 0); } while (0)
#define PG8_LDA(dst, b, h) do { _Pragma("unroll") for (int m = 0; m < 4; ++m) _Pragma("unroll") for (int k = 0; k < 2; ++k) dst[m][k] = *(const PG8_LAS bf16x8*)(lds + PG8_SA(b, h) + aoff + m * 2048 + k * 1024); } while (0)
#define PG8_LDB(dst, b, h) do { _Pragma("unroll") for (int n = 0; n < 2; ++n) _Pragma("unroll") for (int k = 0; k < 2; ++k) dst[n][k] = *(const PG8_LAS bf16x8*)(lds + PG8_SB(b, h) + boff + n * 2048 + k * 1024); } while (0)
#define PG8_MMA(ai, bj, At, Bt) do { __builtin_amdgcn_s_setprio(1); _Pragma("unroll") for (int m = 0; m < 4; ++m) _Pragma("unroll") for (int n = 0; n < 2; ++n) _Pragma("unroll") for (int k = 0; k < 2; ++k) \
        acc[ai][bj][m][n] = __builtin_amdgcn_mfma_f32_16x16x32_bf16(Bt[n][k], At[m][k], acc[ai][bj][m][n], 0, 0, 0); __builtin_amdgcn_s_setprio(0); } while (0)
#define PG8_WAIT_V(n) asm volatile("s_waitcnt vmcnt(" #n ")" ::: "memory")
#define PG8_WAIT_L(n) asm volatile("s_waitcnt lgkmcnt(" #n ")" ::: "memory")
#define PG8_BAR __builtin_amdgcn_s_barrier()
#define PG8_SCHED __builtin_amdgcn_sched_barrier(0)
    Unit cur, nxt; int ui = 0;
    if (!S.next(0, cur)) return;
    f32x4 acc[2][2][4][2];
#pragma unroll
    for (int a = 0; a < 2; ++a)
#pragma unroll
        for (int b = 0; b < 2; ++b)
#pragma unroll
            for (int m = 0; m < 4; ++m)
#pragma unroll
                for (int n = 0; n < 2; ++n) acc[a][b][m][n] = (f32x4){0.f, 0.f, 0.f, 0.f};
    bf16x8 At[4][2], B0[2][2], B1[2][2];
    const char* cA = (const char*)g.A + (size_t)cur.pm * tstepA; const char* cB = (const char*)g.Bt + (size_t)cur.pn * tstepB;
    S.a_ready(cur);
    if constexpr (SP2) {
        PG8_STAGE(PG8_SB(0, 0), cB, voffB); PG8_STAGE(PG8_SB(0, 1), cB + hstepB, voffB); PG8_STAGE(PG8_SA(0, 0), cA, voffA); PG8_STAGE(PG8_SA(0, 1), cA + hstepA, voffA);
        if (wr == 1) PG8_BAR;
        PG8_WAIT_V(2); PG8_BAR;
        PG8_STAGE(PG8_SB(1, 0), cB + kstep, voffB); PG8_STAGE(PG8_SA(1, 0), cA + kstep, voffA); PG8_STAGE(PG8_SB(1, 1), cB + hstepB + kstep, voffB);
        PG8_WAIT_V(6); PG8_BAR;
    } else {
        PG8_STAGE(PG8_SB(0, 0), cB, voffB); PG8_STAGE(PG8_SA(0, 0), cA, voffA); PG8_STAGE(PG8_SB(0, 1), cB + hstepB, voffB); PG8_STAGE(PG8_SA(0, 1), cA + hstepA, voffA);
        if (wr == 1) PG8_BAR;
        PG8_WAIT_V(4); PG8_BAR;
        PG8_STAGE(PG8_SB(1, 0), cB + kstep, voffB); PG8_STAGE(PG8_SA(1, 0), cA + kstep, voffA); PG8_STAGE(PG8_SB(1, 1), cB + hstepB + kstep, voffB);
        PG8_WAIT_V(6); PG8_BAR;
    }
    for (;;) {
        const bool has_next = S.next(ui + 1, nxt);
        const char* nA = has_next ? (const char*)g.A + (size_t)nxt.pm * tstepA : cA; const char* nB = has_next ? (const char*)g.Bt + (size_t)nxt.pn * tstepB : cB;
        for (int t = 0; t < nt; t += 2) {
            const bool last = (t == nt - 2);
            const char* a1 = cA + (size_t)(t + 1) * kstep;
            const char* a2 = last ? nA : cA + (size_t)(t + 2) * kstep; const char* b2 = last ? nB : cB + (size_t)(t + 2) * kstep;
            const char* a3 = a2 + kstep; const char* b3 = b2 + kstep;
            if (last && has_next) S.a_ready(nxt);
            if constexpr (SP2) {
            PG8_LDB(B0, 0, 0); PG8_LDB(B1, 0, 1); PG8_SCHED; PG8_LDA(At, 0, 0); PG8_STAGE(PG8_SA(1, 1), a1 + hstepA, voffA);
            PG8_WAIT_V(8); PG8_WAIT_L(0); PG8_BAR; PG8_MMA(0, 0, At, B0); PG8_MMA(0, 1, At, B1); PG8_BAR; PG8_SCHED;
            PG8_LDA(At, 0, 1); PG8_STAGE(PG8_SB(0, 0), b2, voffB); PG8_STAGE(PG8_SB(0, 1), b2 + hstepB, voffB); PG8_STAGE(PG8_SA(0, 0), a2, voffA);
            PG8_WAIT_V(8); PG8_WAIT_L(0); PG8_BAR; PG8_MMA(1, 0, At, B0); PG8_MMA(1, 1, At, B1); PG8_BAR; PG8_SCHED;
            PG8_LDB(B0, 1, 0); PG8_LDB(B1, 1, 1); PG8_SCHED; PG8_LDA(At, 1, 0); PG8_STAGE(PG8_SA(0, 1), a2 + hstepA, voffA);
            PG8_WAIT_V(8); PG8_WAIT_L(0); PG8_BAR; PG8_MMA(0, 0, At, B0); PG8_MMA(0, 1, At, B1); PG8_BAR; PG8_SCHED;
            PG8_LDA(At, 1, 1); PG8_STAGE(PG8_SB(1, 0), b3, voffB); PG8_STAGE(PG8_SB(1, 1), b3 + hstepB, voffB); PG8_STAGE(PG8_SA(1, 0), a3, voffA);
            PG8_WAIT_V(8); PG8_WAIT_L(0); PG8_BAR; PG8_MMA(1, 0, At, B0); PG8_MMA(1, 1, At, B1); PG8_BAR; PG8_SCHED;
            } else {
            PG8_LDB(B0, 0, 0); PG8_SCHED; PG8_LDA(At, 0, 0); PG8_STAGE(PG8_SA(1, 1), a1 + hstepA, voffA);
            PG8_WAIT_L(8); PG8_BAR; PG8_WAIT_L(0); PG8_MMA(0, 0, At, B0); PG8_BAR; PG8_SCHED;
            PG8_LDB(B1, 0, 1); PG8_STAGE(PG8_SB(0, 0), b2, voffB);
            PG8_BAR; PG8_WAIT_L(0); PG8_MMA(0, 1, At, B1); PG8_BAR;
            PG8_LDA(At, 0, 1); PG8_STAGE(PG8_SA(0, 0), a2, voffA);
            PG8_BAR; PG8_WAIT_L(0); PG8_MMA(1, 0, At, B0); PG8_BAR; PG8_SCHED;
            PG8_STAGE(PG8_SB(0, 1), b2 + hstepB, voffB);
            PG8_WAIT_V(6); PG8_BAR; PG8_MMA(1, 1, At, B1); PG8_BAR;
            PG8_LDB(B0, 1, 0); PG8_SCHED; PG8_LDA(At, 1, 0); PG8_STAGE(PG8_SA(0, 1), a2 + hstepA, voffA);
            PG8_WAIT_L(8); PG8_BAR; PG8_WAIT_L(0); PG8_MMA(0, 0, At, B0); PG8_BAR; PG8_SCHED;
            PG8_LDB(B1, 1, 1); PG8_STAGE(PG8_SB(1, 0), b3, voffB);
            PG8_BAR; PG8_WAIT_L(0); PG8_MMA(0, 1, At, B1); PG8_BAR;
            PG8_LDA(At, 1, 1); PG8_STAGE(PG8_SA(1, 0), a3, voffA);
            PG8_BAR; PG8_WAIT_L(0); PG8_MMA(1, 0, At, B0); PG8_BAR; PG8_SCHED;
            PG8_STAGE(PG8_SB(1, 1), b3 + hstepB, voffB);
            PG8_WAIT_V(6); PG8_BAR; PG8_MMA(1, 1, At, B1); PG8_BAR;
            }
        }
        if constexpr (ALIGN_EPI) { if (wr == 0) PG8_BAR; }
        if constexpr (!Epi::AFTER_DRAIN) { E(acc, cur, wr, wc, fr, fq); S.done(cur); }
        if (!has_next) break;
#pragma unroll
        for (int a = 0; a < 2; ++a)
#pragma unroll
            for (int b = 0; b < 2; ++b)
#pragma unroll
                for (int m = 0; m < 4; ++m)
#pragma unroll
                    for (int n = 0; n < 2; ++n) acc[a][b][m][n] = (f32x4){0.f, 0.f, 0.f, 0.f};
        cur = nxt; cA = nA; cB = nB; ++ui;
        if constexpr (ALIGN_EPI) { if (wr == 1) PG8_BAR; }
    }
    PG8_WAIT_V(0);
    if constexpr (!ALIGN_EPI) { if (wr == 0) PG8_BAR; }
    PG8_BAR;
    if constexpr (Epi::AFTER_DRAIN) { E.fused(acc, cur, wr, wc, fr, fq, lds, wid, lane); S.done(cur); }
#undef PG8_SA
#undef PG8_SB
#undef PG8_STAGE
#undef PG8_LDA
#undef PG8_LDB
#undef PG8_MMA
#undef PG8_WAIT_V
#undef PG8_WAIT_L
#undef PG8_BAR
#undef PG8_SCHED
}
}

#define GAS __attribute__((address_space(1)))
#define LAS __attribute__((address_space(3)))
typedef unsigned short bf16_t;
typedef short bf16x8 __attribute__((ext_vector_type(8)));
typedef float f32x4 __attribute__((ext_vector_type(4)));
typedef unsigned u32x4 __attribute__((ext_vector_type(4)));
typedef unsigned u32x2 __attribute__((ext_vector_type(2)));

constexpr int DM = 1024, NBATCH = 2, SEQ = 8192, MEML = 256, MTOK = NBATCH * SEQ;
constexpr int INW = 12320, LD = 12544;
constexpr int C_Z = 0, C_X = 2048, C_B = 4096, C_C = 4608, C_LG = 5120, C_LX = 6656, C_Q = 8192, C_G = 9216, C_DT = 12288;
constexpr int C_MRG = 2048;
constexpr int NHEAD = 32, HDIM = 64, NGRP = 4, NSTATE = 128, CHUNK = 128, NCHUNK = SEQ / CHUNK;
constexpr int LRUW = 1536, LRUB = 96, NLB = 16, LSEG = 512, NSEG = SEQ / LSEG, NBLK64 = SEQ / 64;
constexpr float EPS = 1e-6f;
constexpr size_t MiB = 1u << 20;
constexpr size_t WS_WIN = 0, WS_WKV = 25 * MiB, WS_WSSD = 29 * MiB, WS_WLRU = 33 * MiB, WS_WMEM = 36 * MiB, WS_WOUT = 38 * MiB;
constexpr size_t WS_PROJ = 40 * MiB;
constexpr size_t WS_MEMN = 236 * MiB, WS_KVK = 237 * MiB, WS_KVVT = 238 * MiB, WS_LRUWA = 239 * MiB, WS_LRUWX = 239 * MiB + 512 * 1024;
constexpr size_t WS_DASUM = 240 * MiB;
constexpr size_t WS_LAGG = 246 * MiB;
constexpr size_t WS_LCAR = 250 * MiB;
constexpr size_t WS_CTL = 244 * MiB;
constexpr size_t WS_XBUF = 245 * MiB;
constexpr size_t WS_END = 256 * MiB;
static_assert(WS_PROJ + (size_t)SEQ * LD * 2 <= WS_MEMN, "ws map");
constexpr int LDS_BYTES = 155648;

struct Params {
    const float *x, *mem, *norm_g, *w_in, *ssd_conv_w, *ssd_conv_b, *ssd_dt_bias, *ssd_a_log, *ssd_d, *ssd_norm_g,
        *lru_conv_w, *lru_conv_b, *lru_w_a, *lru_b_a, *lru_w_x, *lru_b_x, *lru_lambda, *mem_norm_g, *w_kv,
        *w_br_ssd, *w_br_lru, *w_br_mem, *w_out, *final_g;
    float* out; unsigned char* ws;
    int lo, hi;
};

__device__ __forceinline__ float bf2f(bf16_t v) { return __uint_as_float((unsigned)v << 16); }
__device__ __forceinline__ unsigned f2bf(float f) { unsigned u = __float_as_uint(f); return (u + 0x7fffu + ((u >> 16) & 1u)) >> 16; }
__device__ __forceinline__ unsigned pk2(float lo, float hi) { return f2bf(lo) | (f2bf(hi) << 16); }
__device__ __forceinline__ float sigmoidf_(float v) { return __builtin_amdgcn_rcpf(1.f + __expf(-v)); }
__device__ __forceinline__ float siluf_(float v) { return v * __builtin_amdgcn_rcpf(1.f + __expf(-v)); }
__device__ __forceinline__ float softplusf_(float v) { const float e = __expf(v); const float sm = e * (1.f - e * (0.5f - e * 0.33333334f)); return v > 20.f ? v : (e < 1e-3f ? sm : __logf(1.f + e)); }
__device__ __forceinline__ float wave_sum(float v) {
#pragma unroll
    for (int o = 1; o < 64; o <<= 1) v += __shfl_xor(v, o);
    return v;
}
template <class T> __device__ __forceinline__ T* opq(T* q) { asm volatile("" : "+s"(q)); return q; }
__device__ __forceinline__ int opq_tid() { int t = threadIdx.x; asm volatile("" : "+v"(t)); return t; }
__device__ __forceinline__ int opq_bid() { int t = blockIdx.x; asm volatile("" : "+s"(t)); return t; }
__device__ __forceinline__ unsigned char* wsb(const Params& p) { return opq(p.ws); }
__device__ __forceinline__ bf16_t* proj_ptr(const Params& p) { return (bf16_t*)(wsb(p) + WS_PROJ); }
__device__ __forceinline__ bf16_t* xn_ptr(const Params& p) { return (bf16_t*)((unsigned char*)opq(p.out) + 32 * MiB); }
__device__ __forceinline__ bf16_t* states_ptr(const Params& p, int b) { return (bf16_t*)((unsigned char*)opq(p.out) + (size_t)b * 32 * MiB); }
__device__ __forceinline__ float* scr_ptr(const Params& p, int b) { return (float*)((unsigned char*)opq(p.out) + (size_t)b * 32 * MiB); }

#ifdef PROBE_MA
#define MSTAMP(p, i) do { if (blockIdx.x == 0 && threadIdx.x == 0) ((unsigned long long*)(wsb(p) + 255 * MiB))[i] = __builtin_amdgcn_s_memrealtime(); } while (0)
#else
#define MSTAMP(p, i) do { } while (0)
#endif
__device__ __forceinline__ void transpose_item(const float* W, int K, int Ns, int srccol0, bf16_t* WT, int dstrow0, LAS float* scr, int k0, int lane) {
    float wv[32];
#pragma unroll
    for (int i = 0; i < 32; ++i) wv[i] = W[(size_t)(k0 + 2 * i + (lane >> 5)) * Ns + srccol0 + (lane & 31)];
#pragma unroll
    for (int i = 0; i < 32; ++i) scr[(2 * i + (lane >> 5)) * 33 + (lane & 31)] = wv[i];
    asm volatile("s_waitcnt lgkmcnt(0)" ::: "memory");
    const int c = lane & 7;
#pragma unroll
    for (int j = 0; j < 4; ++j) { const int n = (lane >> 3) + 8 * j; const LAS float* s = scr + (8 * c) * 33 + n;
        u32x4 o; o.x = pk2(s[0 * 33], s[1 * 33]); o.y = pk2(s[2 * 33], s[3 * 33]); o.z = pk2(s[4 * 33], s[5 * 33]); o.w = pk2(s[6 * 33], s[7 * 33]);
        *(u32x4*)(WT + (size_t)(dstrow0 + n) * K + k0 + 8 * c) = o; }
    asm volatile("s_waitcnt lgkmcnt(0)" ::: "memory");
}
__device__ __forceinline__ void rms_row_to_bf16(const float* xrow, const float* g, bf16_t* orow, int lane) {
    const f32x4* xr = (const f32x4*)xrow + lane; const f32x4* gr = (const f32x4*)g + lane;
    f32x4 v[4]; float s = 0.f;
#pragma unroll
    for (int j = 0; j < 4; ++j) { v[j] = xr[64 * j]; s += (v[j].x * v[j].x + v[j].y * v[j].y) + (v[j].z * v[j].z + v[j].w * v[j].w); }
    const float rs = 1.f / sqrtf(wave_sum(s) * (1.f / DM) + EPS);
    unsigned long long* o8 = (unsigned long long*)orow + lane;
#pragma unroll
    for (int j = 0; j < 4; ++j) { const f32x4 gg = gr[64 * j];
        o8[64 * j] = (unsigned long long)pk2(v[j].x * rs * gg.x, v[j].y * rs * gg.y) | ((unsigned long long)pk2(v[j].z * rs * gg.z, v[j].w * rs * gg.w) << 32); }
}
__device__ __forceinline__ void phase0(const Params& p, LAS unsigned char* lds) {
    const int tid = opq_tid(), lane = tid & 63, wave = tid >> 6, bid = opq_bid();
    const int gw = bid * 8 + wave, NGW = gridDim.x * 8;
    LAS float* scr = (LAS float*)(lds + wave * 8704);
    bf16_t* Win = (bf16_t*)(wsb(p) + WS_WIN); bf16_t* Wkv = (bf16_t*)(wsb(p) + WS_WKV); bf16_t* Wssd = (bf16_t*)(wsb(p) + WS_WSSD);
    bf16_t* Wlru = (bf16_t*)(wsb(p) + WS_WLRU); bf16_t* Wmem = (bf16_t*)(wsb(p) + WS_WMEM); bf16_t* Wout = (bf16_t*)(wsb(p) + WS_WOUT);
    constexpr int I_IN = 16 * 385, I_KV = 16 * 64, I_SSD = 32 * 32, I_LRU = 24 * 32, I_MEM = 16 * 32, I_OUT = 16 * 32;
    constexpr int NITEMS = I_IN + I_KV + I_SSD + I_LRU + I_MEM + I_OUT;
    for (int it = gw; it < NITEMS; it += NGW) {
        int r = it;
        if (r < I_IN) { const int nb = r % 385, kb = r / 385; const int sc = 32 * nb; int dr;
            if (sc < 5120) dr = sc; else if (sc < 5152) dr = sc - 5120 + C_DT; else dr = sc - 32;
            transpose_item(opq(p.w_in), 1024, INW, sc, Win, dr, scr, 64 * kb, lane); continue; } r -= I_IN;
        if (r < I_KV) { transpose_item(opq(p.w_kv), 1024, 2048, 32 * (r % 64), Wkv, 32 * (r % 64), scr, 64 * (r / 64), lane); continue; } r -= I_KV;
        if (r < I_SSD) { transpose_item(opq(p.w_br_ssd), 2048, 1024, 32 * (r % 32), Wssd, 32 * (r % 32), scr, 64 * (r / 32), lane); continue; } r -= I_SSD;
        if (r < I_LRU) { transpose_item(opq(p.w_br_lru), 1536, 1024, 32 * (r % 32), Wlru, 32 * (r % 32), scr, 64 * (r / 32), lane); continue; } r -= I_LRU;
        if (r < I_MEM) { transpose_item(opq(p.w_br_mem), 1024, 1024, 32 * (r % 32), Wmem, 32 * (r % 32), scr, 64 * (r / 32), lane); continue; } r -= I_MEM;
        transpose_item(opq(p.w_out), 1024, 1024, 32 * (r % 32), Wout, 32 * (r % 32), scr, 64 * (r / 32), lane);
    }
    { const int gt = bid * 512 + tid, NT = gridDim.x * 512; u32x4* z = (u32x4*)(Win + (size_t)INW * 1024);
      for (int i = gt; i < (LD - INW) * 1024 / 8; i += NT) z[i] = (u32x4){0u, 0u, 0u, 0u}; }
    { const int gt = bid * 512 + tid, NT = gridDim.x * 512; bf16_t* wa = (bf16_t*)(wsb(p) + WS_LRUWA); bf16_t* wx = (bf16_t*)(wsb(p) + WS_LRUWX);
      for (int e = gt; e < NLB * LRUB * LRUB; e += NT) { const int n = e / (LRUB * LRUB), r2 = e % (LRUB * LRUB), j = r2 / LRUB, i = r2 % LRUB;
          wa[e] = (bf16_t)f2bf(opq(p.lru_w_a)[(n * LRUB + i) * LRUB + j]); wx[e] = (bf16_t)f2bf(opq(p.lru_w_x)[(n * LRUB + i) * LRUB + j]); } }
    bf16_t* XN = xn_ptr(p); bf16_t* MN = (bf16_t*)(wsb(p) + WS_MEMN);
    { const float* xb = opq(p.x); const f32x4* gr = (const f32x4*)opq(p.norm_g) + lane;
      for (int m0 = gw * 4; m0 < MTOK; m0 += NGW * 4) {
          f32x4 v[4][4];
#pragma unroll
          for (int r = 0; r < 4; ++r)
#pragma unroll
              for (int j = 0; j < 4; ++j) v[r][j] = ((const f32x4*)(xb + (size_t)(m0 + r) * DM) + lane)[64 * j];
#pragma unroll
          for (int r = 0; r < 4; ++r) { float s = 0.f;
#pragma unroll
              for (int j = 0; j < 4; ++j) s += (v[r][j].x * v[r][j].x + v[r][j].y * v[r][j].y) + (v[r][j].z * v[r][j].z + v[r][j].w * v[r][j].w);
              const float rs = 1.f / sqrtf(wave_sum(s) * (1.f / DM) + EPS);
              unsigned long long* o8 = (unsigned long long*)(XN + (size_t)(m0 + r) * DM) + lane;
#pragma unroll
              for (int j = 0; j < 4; ++j) { const f32x4 gg = gr[64 * j];
                  o8[64 * j] = (unsigned long long)pk2(v[r][j].x * rs * gg.x, v[r][j].y * rs * gg.y) | ((unsigned long long)pk2(v[r][j].z * rs * gg.z, v[r][j].w * rs * gg.w) << 32); } } } }
    for (int m = gw; m < NBATCH * MEML; m += NGW) rms_row_to_bf16(opq(p.mem) + (size_t)m * DM, opq(p.mem_norm_g), MN + (size_t)m * DM, lane);
}
__device__ __forceinline__ void phase7(const Params& p) {
    const int tid = opq_tid(), lane = tid & 63, wave = tid >> 6; const int gw = opq_bid() * 8 + wave, NGW = gridDim.x * 8; float* outb = opq(p.out); const float* fg = opq(p.final_g);
    for (int m = gw; m < MTOK; m += NGW) {
        f32x4* xr = (f32x4*)(outb + (size_t)m * DM) + lane; const f32x4* gr = (const f32x4*)fg + lane;
        f32x4 v[4]; float s = 0.f;
#pragma unroll
        for (int j = 0; j < 4; ++j) { v[j] = xr[64 * j]; s += (v[j].x * v[j].x + v[j].y * v[j].y) + (v[j].z * v[j].z + v[j].w * v[j].w); }
        const float rs = 1.f / sqrtf(wave_sum(s) * (1.f / DM) + EPS);
#pragma unroll
        for (int j = 0; j < 4; ++j) { const f32x4 gg = gr[64 * j]; xr[64 * j] = v[j] * rs * gg; }
    }
}

namespace pg8 {
template <int BR> struct EpiMerge {
    static constexpr bool PERM = true, AFTER_DRAIN = false;
    bf16_t* P; float* scr;
    __device__ __forceinline__ void operator()(const f32x4 (&acc)[2][2][4][2], const Unit& u, int wr, int wc, int fr, int fq) const {
        const int row0 = u.pm * BM + wr * 64 + fr, col0 = u.pn * BM + wc * 32 + 8 * fq;
#pragma unroll
        for (int ai = 0; ai < 2; ++ai)
#pragma unroll
            for (int m = 0; m < 4; ++m) { const size_t r = (size_t)(row0 + ai * HALF + m * 16);
#pragma unroll
                for (int bj = 0; bj < 2; ++bj) { const int c = col0 + bj * HALF;
                    const u32x4 gw = *(const u32x4*)(P + r * 12544 + 9216 + BR * 1024 + c);
                    float g[8];
#pragma unroll
                    for (int i = 0; i < 4; ++i) { g[2 * i] = __uint_as_float(gw[i] << 16); g[2 * i + 1] = __uint_as_float(gw[i] & 0xffff0000u); }
                    f32x4 v0 = acc[ai][bj][m][0], v1 = acc[ai][bj][m][1];
#pragma unroll
                    for (int i = 0; i < 4; ++i) { v0[i] *= 1.f / (1.f + __expf(-g[i])); v1[i] *= 1.f / (1.f + __expf(-g[4 + i])); }
                    float* sp = scr + r * 1024 + c;
                    if (BR > 0) { v0 += *(const f32x4*)sp; v1 += *(const f32x4*)(sp + 4); }
                    if (BR < 2) { *(f32x4*)sp = v0; *(f32x4*)(sp + 4) = v1; }
                    else { u32x4 w; w.x = cvt_pk_bf16(v0[0], v0[1]); w.y = cvt_pk_bf16(v0[2], v0[3]); w.z = cvt_pk_bf16(v1[0], v1[1]); w.w = cvt_pk_bf16(v1[2], v1[3]);
                        *(u32x4*)(P + r * 12544 + 2048 + c) = w; } } }
    }
};
template <int BR, bool FINAL> struct EpiMerge2 {
    static constexpr bool PERM = true, AFTER_DRAIN = false;
    bf16_t* P; bf16_t* s0; int ld0; const bf16_t* s1; int ld1; bf16_t* mrg; int ldm;
    __device__ __forceinline__ void operator()(const f32x4 (&acc)[2][2][4][2], const Unit& u, int wr, int wc, int fr, int fq) const {
        const int row0 = u.pm * BM + wr * 64 + fr, col0 = u.pn * BM + wc * 32 + 8 * fq;
#pragma unroll
        for (int ai = 0; ai < 2; ++ai) {
            unsigned gb = (unsigned)((row0 + ai * HALF) * 12544 + 9216 + BR * 1024 + col0); asm volatile("" : "+v"(gb));
            unsigned b0 = (unsigned)((row0 + ai * HALF) * ld0 + col0); asm volatile("" : "+v"(b0));
            u32x4 gw[4][2];
#pragma unroll
            for (int m = 0; m < 4; ++m)
#pragma unroll
                for (int bj = 0; bj < 2; ++bj) gw[m][bj] = *(const u32x4*)(P + (gb + (unsigned)(m * 16 * 12544 + bj * HALF)));
            f32x4 v[4][2][2];
#pragma unroll
            for (int m = 0; m < 4; ++m)
#pragma unroll
                for (int bj = 0; bj < 2; ++bj) { const u32x4 g4 = gw[m][bj]; f32x4 v0 = acc[ai][bj][m][0], v1 = acc[ai][bj][m][1];
#pragma unroll
                    for (int i = 0; i < 2; ++i) { v0[2 * i] *= __builtin_amdgcn_rcpf(1.f + __expf(-__uint_as_float(g4[i] << 16))); v0[2 * i + 1] *= __builtin_amdgcn_rcpf(1.f + __expf(-__uint_as_float(g4[i] & 0xffff0000u)));
                        v1[2 * i] *= __builtin_amdgcn_rcpf(1.f + __expf(-__uint_as_float(g4[2 + i] << 16))); v1[2 * i + 1] *= __builtin_amdgcn_rcpf(1.f + __expf(-__uint_as_float(g4[2 + i] & 0xffff0000u))); }
                    v[m][bj][0] = v0; v[m][bj][1] = v1; }
            if (!FINAL) {
#pragma unroll
                for (int m = 0; m < 4; ++m)
#pragma unroll
                    for (int bj = 0; bj < 2; ++bj) { const f32x4 v0 = v[m][bj][0], v1 = v[m][bj][1]; u32x4 w; w.x = cvt_pk_bf16(v0[0], v0[1]); w.y = cvt_pk_bf16(v0[2], v0[3]); w.z = cvt_pk_bf16(v1[0], v1[1]); w.w = cvt_pk_bf16(v1[2], v1[3]);
                        *(u32x4*)(s0 + (b0 + (unsigned)(m * 16) * (unsigned)ld0 + (unsigned)(bj * HALF))) = w; }
            } else {
                asm volatile("" ::: "memory");
                unsigned b1 = (unsigned)((row0 + ai * HALF) * ld1 + col0); asm volatile("" : "+v"(b1));
                unsigned bm = (unsigned)((row0 + ai * HALF) * ldm + col0); asm volatile("" : "+v"(bm));
#pragma unroll
                for (int mp = 0; mp < 2; ++mp) { u32x4 a0[2][2], a1[2][2];
#pragma unroll
                    for (int mm = 0; mm < 2; ++mm)
#pragma unroll
                        for (int bj = 0; bj < 2; ++bj) { const unsigned rr = (unsigned)((2 * mp + mm) * 16);
                            a0[mm][bj] = *(const u32x4*)(s0 + (b0 + rr * (unsigned)ld0 + (unsigned)(bj * HALF))); a1[mm][bj] = *(const u32x4*)(s1 + (b1 + rr * (unsigned)ld1 + (unsigned)(bj * HALF))); }
#pragma unroll
                    for (int mm = 0; mm < 2; ++mm)
#pragma unroll
                        for (int bj = 0; bj < 2; ++bj) { const int m = 2 * mp + mm; const unsigned rr = (unsigned)(m * 16);
                            f32x4 v0 = v[m][bj][0], v1 = v[m][bj][1];
#pragma unroll
                            for (int i = 0; i < 2; ++i) { v0[2 * i] += __uint_as_float(a0[mm][bj][i] << 16) + __uint_as_float(a1[mm][bj][i] << 16); v0[2 * i + 1] += __uint_as_float(a0[mm][bj][i] & 0xffff0000u) + __uint_as_float(a1[mm][bj][i] & 0xffff0000u);
                                v1[2 * i] += __uint_as_float(a0[mm][bj][2 + i] << 16) + __uint_as_float(a1[mm][bj][2 + i] << 16); v1[2 * i + 1] += __uint_as_float(a0[mm][bj][2 + i] & 0xffff0000u) + __uint_as_float(a1[mm][bj][2 + i] & 0xffff0000u); }
                            u32x4 w; w.x = cvt_pk_bf16(v0[0], v0[1]); w.y = cvt_pk_bf16(v0[2], v0[3]); w.z = cvt_pk_bf16(v1[0], v1[1]); w.w = cvt_pk_bf16(v1[2], v1[3]);
                            *(u32x4*)(mrg + (bm + rr * (unsigned)ldm + (unsigned)(bj * HALF))) = w; }
                    asm volatile("" ::: "memory"); }
            }
            asm volatile("" ::: "memory");
        }
    }
};
struct EpiOutNorm {
    static constexpr bool PERM = false, AFTER_DRAIN = true;
    const float* xres; float* out; const float* fg; float* xbuf; unsigned* cnt;
    __device__ __forceinline__ void fused(f32x4 (&acc)[2][2][4][2], const Unit& u, int wr, int wc, int fr, int fq, PG8_LAS unsigned char* lds, int wid, int lane) const {
        PG8_LAS float* Pp = (PG8_LAS float*)lds; PG8_LAS float* Sr = (PG8_LAS float*)(lds + 4096);
        const int row0 = u.pm * BM + wr * 64 + fr, col0 = u.pn * BM + wc * 32 + 4 * fq;
#pragma unroll
        for (int ai = 0; ai < 2; ++ai)
#pragma unroll
            for (int m = 0; m < 4; ++m) { const size_t off = (size_t)(row0 + ai * HALF + m * 16) * 1024 + col0; float s = 0.f;
#pragma unroll
                for (int bj = 0; bj < 2; ++bj)
#pragma unroll
                    for (int n = 0; n < 2; ++n) { const f32x4 v = acc[ai][bj][m][n] + *(const f32x4*)(xres + off + bj * HALF + n * 16); acc[ai][bj][m][n] = v; s += (v[0] * v[0] + v[1] * v[1]) + (v[2] * v[2] + v[3] * v[3]); }
                s += __shfl_xor(s, 16); s += __shfl_xor(s, 32);
                if (fq == 0) Pp[(ai * HALF + wr * 64 + m * 16 + fr) * 4 + wc] = s;
                if (m == 3) asm volatile("" ::: "memory"); }
        asm volatile("s_waitcnt lgkmcnt(0)" ::: "memory"); __builtin_amdgcn_s_barrier(); asm volatile("" ::: "memory");
        const int tid = wid * 64 + lane;
        if (tid < 256) { const float s = (Pp[tid * 4 + 0] + Pp[tid * 4 + 1]) + (Pp[tid * 4 + 2] + Pp[tid * 4 + 3]);
            __hip_atomic_store(xbuf + (size_t)(u.pm * BM + tid) * 4 + u.pn, s, __ATOMIC_RELAXED, __HIP_MEMORY_SCOPE_AGENT); }
        asm volatile("s_waitcnt vmcnt(0)" ::: "memory");
        if (wid < 4 && lane == 0) __hip_atomic_fetch_add(cnt + 64 * u.pm, 1u, __ATOMIC_RELAXED, __HIP_MEMORY_SCOPE_AGENT);
        if (wid == 0) { unsigned spins = 0;
            while ((unsigned)__builtin_amdgcn_readfirstlane(__hip_atomic_load(cnt + 64 * u.pm, __ATOMIC_RELAXED, __HIP_MEMORY_SCOPE_AGENT)) < 16u && ++spins < (1u << 22)) __builtin_amdgcn_s_sleep(2);
            __builtin_amdgcn_fence(__ATOMIC_ACQUIRE, "agent"); }
        asm volatile("s_waitcnt vmcnt(0) lgkmcnt(0)" ::: "memory"); __builtin_amdgcn_s_barrier(); asm volatile("" ::: "memory");
        if (tid < 256) { const float* slot = xbuf + (size_t)(u.pm * BM + tid) * 4; float s = 0.f;
#pragma unroll
            for (int q = 0; q < 4; ++q) s += __hip_atomic_load(slot + q, __ATOMIC_RELAXED, __HIP_MEMORY_SCOPE_AGENT);
            Sr[tid] = 1.0f / sqrtf(s * (1.f / 1024.f) + 1e-6f); }
        asm volatile("s_waitcnt lgkmcnt(0)" ::: "memory"); __builtin_amdgcn_s_barrier(); asm volatile("" ::: "memory");
#pragma unroll
        for (int ai = 0; ai < 2; ++ai)
#pragma unroll
            for (int m = 0; m < 4; ++m) { const int r = ai * HALF + wr * 64 + m * 16 + fr; const float rs = Sr[r]; const size_t off = (size_t)(u.pm * BM + r) * 1024 + col0;
#pragma unroll
                for (int bj = 0; bj < 2; ++bj)
#pragma unroll
                    for (int n = 0; n < 2; ++n) { const f32x4 gg = *(const f32x4*)(fg + col0 + bj * HALF + n * 16); *(f32x4*)(out + off + bj * HALF + n * 16) = acc[ai][bj][m][n] * rs * gg; } }
    }
};
}
#define PG8_SP2 true
#define PG8_ALIGN true

__device__ __forceinline__ bf16_t* merged_ptr(const Params& p, int b) { return b == 0 ? xn_ptr(p) : proj_ptr(p) + 4096; }
__device__ __forceinline__ int merged_ld(int b) { return b == 0 ? DM : LD; }
__device__ __forceinline__ void phase1_gemm(const Params& p, int b, LAS unsigned char* lds) {
    const int G = gridDim.x, c = opq_bid();
    { pg8::Gemm g{xn_ptr(p) + (size_t)b * SEQ * DM, (const bf16_t*)(wsb(p) + WS_WIN), SEQ, 12288, DM, DM, DM}; pg8::StaticOrder S; S.init(SEQ, 12288, G, c);
      pg8::EpiBf16<0> E{proj_ptr(p), LD, nullptr, 0, 0, 1.f};
      pg8::gemm_phase<pg8::EpiBf16<0>, pg8::StaticOrder, PG8_ALIGN, PG8_SP2>(lds, g, S, E); }
    { const int tid = opq_tid(), lane = tid & 63, wave = tid >> 6, fr = lane & 15, kg = lane >> 4;
      const bf16_t* XNb = xn_ptr(p) + (size_t)b * SEQ * DM; const bf16_t* Wd = (const bf16_t*)(wsb(p) + WS_WIN) + (size_t)C_DT * DM; bf16_t* Pq = proj_ptr(p);
      LAS float* sRed = (LAS float*)lds;
      for (int rb = c; rb < SEQ / 32; rb += G) {
          __syncthreads();
          f32x4 acc[2][2];
#pragma unroll
          for (int mt = 0; mt < 2; ++mt)
#pragma unroll
              for (int nt = 0; nt < 2; ++nt) acc[mt][nt] = (f32x4){0.f, 0.f, 0.f, 0.f};
          bf16x8 af[2][4], bfr[2][4];
#pragma unroll
          for (int ks = 0; ks < 4; ++ks)
#pragma unroll
              for (int q = 0; q < 2; ++q) { af[q][ks] = *(const bf16x8*)(XNb + (size_t)(32 * rb + 16 * q + fr) * DM + 128 * wave + 32 * ks + 8 * kg);
                  bfr[q][ks] = *(const bf16x8*)(Wd + (size_t)(16 * q + fr) * DM + 128 * wave + 32 * ks + 8 * kg); }
#pragma unroll
          for (int ks = 0; ks < 4; ++ks)
#pragma unroll
              for (int mt = 0; mt < 2; ++mt)
#pragma unroll
                  for (int nt = 0; nt < 2; ++nt) acc[mt][nt] = __builtin_amdgcn_mfma_f32_16x16x32_bf16(af[mt][ks], bfr[nt][ks], acc[mt][nt], 0, 0, 0);
#pragma unroll
          for (int mt = 0; mt < 2; ++mt)
#pragma unroll
              for (int nt = 0; nt < 2; ++nt)
#pragma unroll
                  for (int j = 0; j < 4; ++j) sRed[(wave * 32 + 16 * mt + 4 * kg + j) * 32 + 16 * nt + fr] = acc[mt][nt][j];
          __syncthreads();
#pragma unroll
          for (int q = 0; q < 2; ++q) { const int e = tid + 512 * q, row = e >> 5, col = e & 31; float s = 0.f;
#pragma unroll
              for (int w2 = 0; w2 < 8; ++w2) s += sRed[(w2 * 32 + row) * 32 + col];
              Pq[(size_t)(32 * rb + row) * LD + C_DT + col] = (bf16_t)f2bf(s); }
      } }
    if (b == 0) {
        { pg8::Gemm g{(const bf16_t*)(wsb(p) + WS_MEMN), (const bf16_t*)(wsb(p) + WS_WKV), 512, 1024, DM, DM, DM}; pg8::StaticOrder S; S.init(512, 1024, G, (c + 16) % G);
          pg8::EpiBf16<0> E{(bf16_t*)(wsb(p) + WS_KVK), 1024, nullptr, 0, 0, 1.f};
          pg8::gemm_phase<pg8::EpiBf16<0>, pg8::StaticOrder, PG8_ALIGN, PG8_SP2>(lds, g, S, E); }
        { pg8::Gemm g{(const bf16_t*)(wsb(p) + WS_WKV) + (size_t)1024 * DM, (const bf16_t*)(wsb(p) + WS_MEMN), 1024, 512, DM, DM, DM}; pg8::StaticOrder S; S.init(1024, 512, G, (c + 8) % G);
          pg8::EpiBf16<0> E{(bf16_t*)(wsb(p) + WS_KVVT), 512, nullptr, 0, 0, 1.f};
          pg8::gemm_phase<pg8::EpiBf16<0>, pg8::StaticOrder, PG8_ALIGN, PG8_SP2>(lds, g, S, E); }
    }
}
__device__ __forceinline__ void phase5_gemm(const Params& p, int b, LAS unsigned char* lds) {
    const int G = gridDim.x, c = opq_bid(); bf16_t* P = proj_ptr(p); float* scr = scr_ptr(p, b);
    bf16_t* scrB = P + 2048;
    bf16_t* scrA = (bf16_t*)scr;
    unsigned* flag = (unsigned*)(wsb(p) + WS_CTL) + 4096 + (b * 128 + (c & 127)) * 16;
    if (c < 128) {
        pg8::Gemm g{P + C_Z, (const bf16_t*)(wsb(p) + WS_WSSD), SEQ, DM, 2048, LD, 2048}; pg8::StaticOrder S; S.init(SEQ, DM, 128, c); pg8::EpiMerge2<0, false> E{P, scrA, 1024, nullptr, 0, nullptr, 0};
        pg8::gemm_phase<pg8::EpiMerge2<0, false>, pg8::StaticOrder, false, PG8_SP2>(lds, g, S, E);
#ifdef PROBE_NOFENCE
        asm volatile("s_waitcnt vmcnt(0)" ::: "memory"); __syncthreads();
        if (threadIdx.x == 0) __hip_atomic_store(flag, 1u, __ATOMIC_RELAXED, __HIP_MEMORY_SCOPE_AGENT);
#else
        asm volatile("s_waitcnt vmcnt(0)" ::: "memory"); __syncthreads();
        if (threadIdx.x == 0) { __builtin_amdgcn_fence(__ATOMIC_RELEASE, "agent"); asm volatile("s_waitcnt vmcnt(0)" ::: "memory");
            __hip_atomic_store(flag, 1u, __ATOMIC_RELAXED, __HIP_MEMORY_SCOPE_AGENT); }
#endif
    } else {
        { pg8::Gemm g{P + C_LG, (const bf16_t*)(wsb(p) + WS_WLRU), SEQ, DM, 1536, LD, 1536}; pg8::StaticOrder S; S.init(SEQ, DM, 128, c - 128); pg8::EpiMerge2<1, false> E{P, scrB, LD, nullptr, 0, nullptr, 0};
          pg8::gemm_phase<pg8::EpiMerge2<1, false>, pg8::StaticOrder, false, PG8_SP2>(lds, g, S, E); }
        if (threadIdx.x == 0) { unsigned spins = 0; while (__hip_atomic_load(flag, __ATOMIC_RELAXED, __HIP_MEMORY_SCOPE_AGENT) == 0u && ++spins < (1u << 22)) __builtin_amdgcn_s_sleep(2);
#ifndef PROBE_NOFENCE
            __builtin_amdgcn_fence(__ATOMIC_ACQUIRE, "agent"); asm volatile("s_waitcnt vmcnt(0)" ::: "memory");
#endif
        }
        __syncthreads();
        { pg8::Gemm g{P + C_Q, (const bf16_t*)(wsb(p) + WS_WMEM), SEQ, DM, 1024, LD, 1024}; pg8::StaticOrder S; S.init(SEQ, DM, 128, c - 128); pg8::EpiMerge2<2, true> E{P, scrB, LD, scrA, 1024, merged_ptr(p, b), merged_ld(b)};
          pg8::gemm_phase<pg8::EpiMerge2<2, true>, pg8::StaticOrder, false, PG8_SP2>(lds, g, S, E); }
    }
    (void)G;
}
__device__ __forceinline__ void phase6_gemm(const Params& p, int b, LAS unsigned char* lds) {
    const int G = gridDim.x, c = opq_bid(); bf16_t* P = proj_ptr(p);
    pg8::Gemm g{merged_ptr(p, b), (const bf16_t*)(wsb(p) + WS_WOUT), SEQ, DM, DM, merged_ld(b), DM}; pg8::StaticOrder S; S.init(SEQ, DM, G, c);
    pg8::EpiOutNorm E{opq(p.x) + (size_t)b * SEQ * DM, opq(p.out) + (size_t)b * SEQ * DM, opq(p.final_g), (float*)(wsb(p) + WS_XBUF) + (size_t)b * SEQ * 4, (unsigned*)(wsb(p) + WS_CTL) + 8192 + b * 2048};
    pg8::gemm_phase<pg8::EpiOutNorm, pg8::StaticOrder, false, PG8_SP2>(lds, g, S, E);
}
#define MFMA16(a, b, c) __builtin_amdgcn_mfma_f32_16x16x32_bf16((a), (b), (c), 0, 0, 0)
__device__ __forceinline__ bf16x8 pack8(const float (&v)[8]) {
    u32x4 w; w.x = pk2(v[0], v[1]); w.y = pk2(v[2], v[3]); w.z = pk2(v[4], v[5]); w.w = pk2(v[6], v[7]); return __builtin_bit_cast(bf16x8, w);
}
__device__ __forceinline__ void unpack8(u32x4 w, float (&v)[8]) {
#pragma unroll
    for (int i = 0; i < 4; ++i) { v[2 * i] = __uint_as_float(w[i] << 16); v[2 * i + 1] = __uint_as_float(w[i] & 0xffff0000u); }
}
__device__ __forceinline__ void attn_phase(const Params& p, int b, LAS unsigned char* lds, int dry = 0) {
    const int tid = opq_tid(), lane = tid & 63, wave = tid >> 6, fr = lane & 15, kg = lane >> 4;
    bf16_t* P = proj_ptr(p); const bf16_t* KK = (const bf16_t*)(wsb(p) + WS_KVK) + (size_t)b * 256 * 1024; const bf16_t* VT = (const bf16_t*)(wsb(p) + WS_KVVT) + b * 256;
    LAS bf16_t* sKV = (LAS bf16_t*)lds;
    for (int u = opq_bid(); u < 256; u += gridDim.x) {
        const int hd = u & 3, rt = u >> 2, q0 = rt * 128 + wave * 16;
        bf16_t* qrow = P + (size_t)(q0 + fr) * LD + C_Q + hd * 256;
        __syncthreads();
        { unsigned ko = (unsigned)((tid >> 5) * 1024 + hd * 256 + 8 * (tid & 31)); asm volatile("" : "+v"(ko));
          u32x4 st[16];
#pragma unroll
          for (int i = 0; i < 16; ++i) st[i] = *(const u32x4*)(KK + (ko + (unsigned)(i * 16 * 1024)));
#pragma unroll
          for (int i = 0; i < 16; ++i) *(LAS u32x4*)(sKV + ((tid >> 5) + 16 * i) * 264 + 8 * (tid & 31)) = st[i]; }
        bf16x8 qf[8];
#pragma unroll
        for (int s = 0; s < 8; ++s) qf[s] = *(const bf16x8*)(qrow + 32 * s + 8 * kg);
        __syncthreads();
        u32x4 vst[16];
        { unsigned vo = (unsigned)((hd * 256 + (tid >> 5)) * 512 + 8 * (tid & 31)); asm volatile("" : "+v"(vo));
#pragma unroll
          for (int i = 0; i < 16; ++i) vst[i] = *(const u32x4*)(VT + (vo + (unsigned)(i * 16 * 512))); }
        f32x4 sacc[16];
#pragma unroll
        for (int mt = 0; mt < 16; ++mt) { sacc[mt] = (f32x4){0.f, 0.f, 0.f, 0.f};
#pragma unroll
            for (int s = 0; s < 8; ++s) { const bf16x8 kf = *(const LAS bf16x8*)(sKV + (16 * mt + fr) * 264 + 32 * s + 8 * kg); sacc[mt] = MFMA16(kf, qf[s], sacc[mt]); } }
        float mx = -INFINITY;
#pragma unroll
        for (int mt = 0; mt < 16; ++mt)
#pragma unroll
            for (int j = 0; j < 4; ++j) mx = fmaxf(mx, sacc[mt][j]);
        mx = fmaxf(mx, __shfl_xor(mx, 16)); mx = fmaxf(mx, __shfl_xor(mx, 32));
        float sum = 0.f;
#pragma unroll
        for (int mt = 0; mt < 16; ++mt)
#pragma unroll
            for (int j = 0; j < 4; ++j) { const float e = __expf((sacc[mt][j] - mx) * 0.0625f); sacc[mt][j] = e; sum += e; }
        sum += __shfl_xor(sum, 16); sum += __shfl_xor(sum, 32);
        const float inv = 1.f / sum;
        bf16x8 pf[8];
#pragma unroll
        for (int s2 = 0; s2 < 8; ++s2) { u32x4 w; w.x = pk2(sacc[2 * s2][0], sacc[2 * s2][1]); w.y = pk2(sacc[2 * s2][2], sacc[2 * s2][3]);
            w.z = pk2(sacc[2 * s2 + 1][0], sacc[2 * s2 + 1][1]); w.w = pk2(sacc[2 * s2 + 1][2], sacc[2 * s2 + 1][3]); pf[s2] = __builtin_bit_cast(bf16x8, w); }
        __syncthreads();
#pragma unroll
        for (int i = 0; i < 16; ++i) *(LAS u32x4*)(sKV + ((tid >> 5) + 16 * i) * 264 + 8 * (tid & 31)) = vst[i];
        __syncthreads();
#pragma unroll 4
        for (int mt2 = 0; mt2 < 16; ++mt2) { f32x4 o = (f32x4){0.f, 0.f, 0.f, 0.f}; const LAS bf16_t* vr = sKV + (16 * mt2 + fr) * 264 + 4 * kg;
#pragma unroll
            for (int s2 = 0; s2 < 8; ++s2) { const u32x2 lo = *(const LAS u32x2*)(vr + 32 * s2), hi = *(const LAS u32x2*)(vr + 32 * s2 + 16);
                u32x4 w; w.x = lo.x; w.y = lo.y; w.z = hi.x; w.w = hi.y; o = MFMA16(__builtin_bit_cast(bf16x8, w), pf[s2], o); }
            u32x2 ow; ow.x = pk2(o[0] * inv, o[1] * inv); ow.y = pk2(o[2] * inv, o[3] * inv);
            if (!dry) *(u32x2*)(qrow + 16 * mt2 + 4 * kg) = ow; }
    }
}
template <bool FINAL> __device__ __forceinline__ void lru_phase(const Params& p, int b, LAS unsigned char* lds, int dry = 0) {
    const int tid = opq_tid(), lane = tid & 63, wave = tid >> 6, fr = lane & 15, kg = lane >> 4;
    bf16_t* P = proj_ptr(p);
    LAS bf16_t* sWA = (LAS bf16_t*)lds; LAS bf16_t* sWX = (LAS bf16_t*)(lds + 19968);
    LAS float* sCW = (LAS float*)(lds + 39936); LAS float* sCB = sCW + 384; LAS float* sBA = sCB + 96; LAS float* sBX = sBA + 96; LAS float* sSP = sBX + 96;
    LAS float* sXL = (LAS float*)(lds + 43008) + wave * 1600;
    LAS float* sAG = (LAS float*)(lds + 94208);
    float* agg = (float*)(wsb(p) + WS_LAGG) + (size_t)b * NBLK64 * LRUW * 2;
    const float* car = (const float*)(wsb(p) + WS_LCAR) + (size_t)b * NBLK64 * LRUW;
    const float* lcw = opq(p.lru_conv_w); const float* lcb = opq(p.lru_conv_b); const float* lba = opq(p.lru_b_a); const float* lbx = opq(p.lru_b_x); const float* lam = opq(p.lru_lambda);
    for (int u = opq_bid(); u < NLB * NSEG; u += gridDim.x) {
        const int n = u % NLB, sg = u / NLB;
        __syncthreads();
        { const bf16_t* gwa = (const bf16_t*)(wsb(p) + WS_LRUWA) + n * 9216; const bf16_t* gwx = (const bf16_t*)(wsb(p) + WS_LRUWX) + n * 9216;
          u32x4 wa3[3], wx3[3]; float cwv = 0.f, v4[4] = {0.f, 0.f, 0.f, 0.f};
#pragma unroll
          for (int i = 0; i < 3; ++i) { const int e = tid + 512 * i; if (e < 96 * 12) { const int j = e / 12, c8 = e % 12; wa3[i] = *(const u32x4*)(gwa + j * 96 + 8 * c8); wx3[i] = *(const u32x4*)(gwx + j * 96 + 8 * c8); } }
          if (tid < 384) cwv = lcw[(tid / 96) * 1536 + n * 96 + tid % 96];
          if (tid < 96) { v4[0] = lcb[n * 96 + tid]; v4[1] = lba[n * 96 + tid]; v4[2] = lbx[n * 96 + tid]; v4[3] = lam[n * 96 + tid]; }
#pragma unroll
          for (int i = 0; i < 3; ++i) { const int e = tid + 512 * i; if (e < 96 * 12) { const int j = e / 12, c8 = e % 12; *(LAS u32x4*)(sWA + j * 104 + 8 * c8) = wa3[i]; *(LAS u32x4*)(sWX + j * 104 + 8 * c8) = wx3[i]; } }
          if (tid < 384) sCW[tid] = cwv;
          if (tid < 96) { sCB[tid] = v4[0]; sBA[tid] = v4[1]; sBX[tid] = v4[2]; sSP[tid] = softplusf_(-v4[3]); } }
        __syncthreads();
        float runA[6], runH[6];
#pragma unroll
        for (int nt = 0; nt < 6; ++nt) { runA[nt] = 1.f; runH[nt] = FINAL ? car[(sg * 8 + wave) * LRUW + n * 96 + 16 * nt + fr] : 0.f; }
        for (int step = 0; step < 4; ++step) {
            const int tb = sg * LSEG + wave * 64 + step * 16;
            u32x4 rawC[3][4];
            { const int t0r = tb + fr - 3; unsigned ro = (unsigned)((t0r < 0 ? 0 : t0r) * LD + C_LX + n * 96 + 8 * kg); asm volatile("" : "+v"(ro));
              if (t0r >= 0) {
#pragma unroll
                  for (int ks = 0; ks < 3; ++ks)
#pragma unroll
                      for (int k = 0; k < 4; ++k) rawC[ks][k] = *(const u32x4*)(P + (ro + (unsigned)(k * LD + 32 * ks)));
              } else {
#pragma unroll
                  for (int ks = 0; ks < 3; ++ks)
#pragma unroll
                      for (int k = 0; k < 4; ++k) { const int t = t0r + k; rawC[ks][k] = *(const u32x4*)(P + (ro + (unsigned)((t < 0 ? 0 : t) * LD + 32 * ks))); if (t < 0) rawC[ks][k] = (u32x4){0u, 0u, 0u, 0u}; }
              } }
            bf16x8 af[3];
#pragma unroll
            for (int ks = 0; ks < 3; ++ks) { const int ch0 = 32 * ks + 8 * kg; float xl[8];
#pragma unroll
                for (int i = 0; i < 8; ++i) xl[i] = sCB[ch0 + i];
#pragma unroll
                for (int k = 0; k < 4; ++k) { const u32x4 raw = rawC[ks][k];
                    float rv[8]; unpack8(raw, rv);
#pragma unroll
                    for (int i = 0; i < 8; ++i) xl[i] += sCW[k * 96 + ch0 + i] * rv[i]; }
                *(LAS f32x4*)(sXL + fr * 100 + ch0) = (f32x4){xl[0], xl[1], xl[2], xl[3]}; *(LAS f32x4*)(sXL + fr * 100 + ch0 + 4) = (f32x4){xl[4], xl[5], xl[6], xl[7]};
                af[ks] = pack8(xl); }
            LAS bf16_t* sG = (LAS bf16_t*)((LAS unsigned char*)sWA + 106496) + wave * 1536;
            unsigned go3[3]; u32x4 graw[3];
            if (FINAL) {
#pragma unroll
                for (int i = 0; i < 3; ++i) { const int e = lane + 64 * i, row = e / 12, c12 = e % 12; go3[i] = (unsigned)((tb + row) * LD + C_LG + n * 96 + 8 * c12); }
                asm volatile("" : "+v"(go3[0]), "+v"(go3[1]), "+v"(go3[2]));
#pragma unroll
                for (int i = 0; i < 3; ++i) graw[i] = *(const u32x4*)(P + go3[i]); }
            f32x4 aR[6], aI[6];
#pragma unroll
            for (int nt = 0; nt < 6; ++nt) { aR[nt] = (f32x4){0.f, 0.f, 0.f, 0.f}; aI[nt] = (f32x4){0.f, 0.f, 0.f, 0.f};
#pragma unroll
                for (int ks = 0; ks < 3; ++ks) { const bf16x8 wa = *(const LAS bf16x8*)(sWA + (16 * nt + fr) * 104 + 32 * ks + 8 * kg), wx = *(const LAS bf16x8*)(sWX + (16 * nt + fr) * 104 + 32 * ks + 8 * kg);
                    aR[nt] = MFMA16(af[ks], wa, aR[nt]); aI[nt] = MFMA16(af[ks], wx, aI[nt]); } }
            float Ainc[6][4], Hinc[6][4];
#pragma unroll
            for (int nt = 0; nt < 6; ++nt) { const int j = 16 * nt + fr; const float ba2 = -1.44269504f * sBA[j], bx2 = -1.44269504f * sBX[j], spc = -8.f * 1.44269504f * sSP[j];
                float A = 1.f, H = 0.f;
#pragma unroll
                for (int r = 0; r < 4; ++r) { const float xlv = sXL[(4 * kg + r) * 100 + j];
                    const float rr = __builtin_amdgcn_rcpf(1.f + __builtin_amdgcn_exp2f(fmaf(aR[nt][r], -1.44269504f, ba2))), ii = __builtin_amdgcn_rcpf(1.f + __builtin_amdgcn_exp2f(fmaf(aI[nt][r], -1.44269504f, bx2)));
                    const float a = __builtin_amdgcn_exp2f(rr * spc), mult = __builtin_amdgcn_sqrtf(fmaxf(0.f, fmaf(-a, a, 1.f)));
                    H = a * H + mult * ii * xlv; A *= a; Ainc[nt][r] = A; Hinc[nt][r] = H; }
                float ap = 1.f, hp = 0.f, at = 1.f, ht = 0.f;
#pragma unroll
                for (int k = 0; k < 4; ++k) { const float ab = __shfl(A, fr + 16 * k), hb = __shfl(H, fr + 16 * k);
                    if (k < kg) { hp = ab * hp + hb; ap *= ab; } ht = ab * ht + hb; at *= ab; }
                if (FINAL) { const float hin = ap * runH[nt] + hp;
#pragma unroll
                    for (int r = 0; r < 4; ++r) Hinc[nt][r] = Ainc[nt][r] * hin + Hinc[nt][r]; }
                runH[nt] = at * runH[nt] + ht; runA[nt] *= at; }
            if (FINAL) {
#pragma unroll
                for (int i = 0; i < 3; ++i) { const int e = lane + 64 * i; *(LAS u32x4*)(sG + (e / 12) * 96 + 8 * (e % 12)) = graw[i]; }
                asm volatile("s_waitcnt lgkmcnt(0)" ::: "memory");
#pragma unroll
                for (int nt = 0; nt < 6; ++nt)
#pragma unroll
                    for (int r = 0; r < 4; ++r) { LAS bf16_t* gp = sG + (4 * kg + r) * 96 + 16 * nt + fr; const float yv = Hinc[nt][r] * siluf_(bf2f(*gp)); *gp = (bf16_t)f2bf(yv); }
                asm volatile("s_waitcnt lgkmcnt(0)" ::: "memory");
#pragma unroll
                for (int i = 0; i < 3; ++i) { const int e = lane + 64 * i; const u32x4 w = *(const LAS u32x4*)(sG + (e / 12) * 96 + 8 * (e % 12)); if (!dry) *(u32x4*)(P + go3[i]) = w; }
                asm volatile("s_waitcnt lgkmcnt(0)" ::: "memory"); }
        }
        if (!FINAL && kg == 0) {
#pragma unroll
            for (int nt = 0; nt < 6; ++nt) { const int ch = n * 96 + 16 * nt + fr; agg[((size_t)(sg * 8 + wave) * LRUW + ch) * 2] = runA[nt]; agg[((size_t)(sg * 8 + wave) * LRUW + ch) * 2 + 1] = runH[nt]; } }
    }
}
__device__ __forceinline__ void lru_carry_phase(const Params& p, int b) {
    const int gt = opq_bid() * 512 + opq_tid();
    const float* agg = (const float*)(wsb(p) + WS_LAGG) + (size_t)b * NBLK64 * LRUW * 2; float* car = (float*)(wsb(p) + WS_LCAR) + (size_t)b * NBLK64 * LRUW;
    for (int ch = gt; ch < LRUW; ch += gridDim.x * 512) { float h = 0.f;
        for (int k0 = 0; k0 < NBLK64; k0 += 16) { float a[16], hh[16];
#pragma unroll
            for (int i = 0; i < 16; ++i) { a[i] = agg[((size_t)(k0 + i) * LRUW + ch) * 2]; hh[i] = agg[((size_t)(k0 + i) * LRUW + ch) * 2 + 1]; }
#pragma unroll
            for (int i = 0; i < 16; ++i) { car[(k0 + i) * LRUW + ch] = h; h = a[i] * h + hh[i]; } } }
}
__device__ __forceinline__ void conv8_silu(const bf16_t* P, int t, int col, const float* cw, const float* cb, int ch, float (&o)[8]) {
    float r[11];
    unsigned off0 = (unsigned)((t < 3 ? 0 : t - 3) * LD + col); asm volatile("" : "+v"(off0));
    if (t >= 3) {
#pragma unroll
        for (int i = 0; i < 11; ++i) r[i] = bf2f(P[off0 + (unsigned)(i * LD)]);
    } else {
#pragma unroll
        for (int i = 0; i < 11; ++i) { const int tt = t - 3 + i; const float v = bf2f(P[off0 + (unsigned)((tt < 0 ? 0 : tt) * LD)]); r[i] = tt < 0 ? 0.f : v; }
    }
    const float w0 = cw[ch], w1 = cw[3072 + ch], w2 = cw[6144 + ch], w3 = cw[9216 + ch], bb = cb[ch];
#pragma unroll
    for (int j = 0; j < 8; ++j) o[j] = siluf_(bb + w0 * r[j] + w1 * r[j + 1] + w2 * r[j + 2] + w3 * r[j + 3]);
}
__device__ __forceinline__ float ssd_dt_setup(const Params& p, const bf16_t* P, int t0, int h, int lane, LAS float* sACS, LAS float* sDT) {
    const float dtb = opq(p.ssd_dt_bias)[h], an = -__expf(opq(p.ssd_a_log)[h]);
    const float dt0 = softplusf_(bf2f(P[(size_t)(t0 + 2 * lane) * LD + C_DT + h]) + dtb), dt1 = softplusf_(bf2f(P[(size_t)(t0 + 2 * lane + 1) * LD + C_DT + h]) + dtb);
    const float dA1 = dt1 * an; float s = dt0 * an + dA1;
#pragma unroll
    for (int o = 1; o < 64; o <<= 1) { const float t = __shfl_up(s, o); if (lane >= o) s += t; }
    sACS[2 * lane] = s - dA1; sACS[2 * lane + 1] = s; sDT[2 * lane] = dt0; sDT[2 * lane + 1] = dt1;
    return __shfl(s, 63);
}
template <int R> __device__ __forceinline__ void conv_rows(const bf16_t* P, int t, int col, const float* cw, const float* cb, int ch, float (&o)[R][8]) {
    unsigned off0 = (unsigned)((t < 3 ? 0 : t - 3) * LD + col); asm volatile("" : "+v"(off0));
    u32x4 raw[R + 3];
    if (t >= 3) {
#pragma unroll
        for (int i = 0; i < R + 3; ++i) raw[i] = *(const u32x4*)(P + (off0 + (unsigned)(i * LD)));
    } else {
#pragma unroll
        for (int i = 0; i < R + 3; ++i) { const int tt = t - 3 + i; raw[i] = *(const u32x4*)(P + (off0 + (unsigned)((tt < 0 ? 0 : tt) * LD))); if (tt < 0) raw[i] = (u32x4){0u, 0u, 0u, 0u}; }
    }
    float w[4][8], bb[8];
#pragma unroll
    for (int k = 0; k < 4; ++k) { const f32x4 w0 = *(const f32x4*)(cw + k * 3072 + ch), w1 = *(const f32x4*)(cw + k * 3072 + ch + 4);
        w[k][0] = w0[0]; w[k][1] = w0[1]; w[k][2] = w0[2]; w[k][3] = w0[3]; w[k][4] = w1[0]; w[k][5] = w1[1]; w[k][6] = w1[2]; w[k][7] = w1[3]; }
    { const f32x4 b0 = *(const f32x4*)(cb + ch), b1 = *(const f32x4*)(cb + ch + 4); bb[0] = b0[0]; bb[1] = b0[1]; bb[2] = b0[2]; bb[3] = b0[3]; bb[4] = b1[0]; bb[5] = b1[1]; bb[6] = b1[2]; bb[7] = b1[3]; }
#pragma unroll
    for (int r = 0; r < R; ++r)
#pragma unroll
        for (int q = 0; q < 8; ++q) o[r][q] = bb[q];
#pragma unroll
    for (int i = 0; i < R + 3; ++i) { float v[8]; unpack8(raw[i], v);
#pragma unroll
        for (int k = 0; k < 4; ++k) { const int r = i - k; if (r >= 0 && r < R) {
#pragma unroll
                for (int q = 0; q < 8; ++q) o[r][q] += w[k][q] * v[q]; } } }
#pragma unroll
    for (int r = 0; r < R; ++r)
#pragma unroll
        for (int q = 0; q < 8; ++q) o[r][q] = siluf_(o[r][q]);
}
__device__ __forceinline__ void ssd_states_phase(const Params& p, int b, LAS unsigned char* lds) {
    const int tid = opq_tid(), lane = tid & 63, wave = tid >> 6, fr = lane & 15, kg = lane >> 4;
    const bf16_t* P = proj_ptr(p); bf16_t* ST = states_ptr(p, b); float* dasum = (float*)(wsb(p) + WS_DASUM) + b * NCHUNK * NHEAD;
    const float* cw = opq(p.ssd_conv_w); const float* cb = opq(p.ssd_conv_b);
    LAS bf16_t* sBT = (LAS bf16_t*)lds; LAS bf16_t* sXT = (LAS bf16_t*)(lds + 34816 + wave * 8704);
    LAS float* sACS = (LAS float*)(lds + 104448) + wave * 128; LAS float* sW = (LAS float*)(lds + 108544) + wave * 128;
    for (int u = opq_bid(); u < NCHUNK * NGRP; u += gridDim.x) {
        const int c = u >> 2, g = u & 3, t0 = c * CHUNK, h = 8 * g + wave;
        __syncthreads();
        { const float tot = ssd_dt_setup(p, P, t0, h, lane, sACS, sW);
          if (lane == 0) dasum[c * NHEAD + h] = tot;
          sW[2 * lane] = sW[2 * lane] * __expf(tot - sACS[2 * lane]); sW[2 * lane + 1] = sW[2 * lane + 1] * __expf(tot - sACS[2 * lane + 1]); }
        { const int cg = tid & 15, rs = tid >> 4; float o[4][8];
          conv_rows<4>(P, t0 + 4 * rs, C_B + g * 128 + 8 * cg, cw, cb, 2048 + g * 128 + 8 * cg, o);
#pragma unroll
          for (int q = 0; q < 8; ++q) { u32x2 w; w.x = pk2(o[0][q], o[1][q]); w.y = pk2(o[2][q], o[3][q]); *(LAS u32x2*)(sBT + (8 * cg + q) * 136 + 4 * rs) = w; } }
        __syncthreads();
        for (int ph = 0; ph < 2; ++ph) {
            { const int cg = lane & 3, rs = lane >> 2; float o[8][8];
              conv_rows<8>(P, t0 + 8 * rs, C_X + h * 64 + 32 * ph + 8 * cg, cw, cb, h * 64 + 32 * ph + 8 * cg, o);
              const f32x4 w0 = *(const LAS f32x4*)(sW + 8 * rs), w1 = *(const LAS f32x4*)(sW + 8 * rs + 4);
#pragma unroll
              for (int q = 0; q < 8; ++q) { float v[8] = {o[0][q] * w0[0], o[1][q] * w0[1], o[2][q] * w0[2], o[3][q] * w0[3], o[4][q] * w1[0], o[5][q] * w1[1], o[6][q] * w1[2], o[7][q] * w1[3]};
                  *(LAS bf16x8*)(sXT + (8 * cg + q) * 136 + 8 * rs) = pack8(v); } }
            asm volatile("s_waitcnt lgkmcnt(0)" ::: "memory");
            f32x4 acc[8][2];
#pragma unroll
            for (int mt = 0; mt < 8; ++mt) { acc[mt][0] = (f32x4){0.f, 0.f, 0.f, 0.f}; acc[mt][1] = (f32x4){0.f, 0.f, 0.f, 0.f}; }
#pragma unroll
            for (int s = 0; s < 4; ++s) { const bf16x8 x0 = *(const LAS bf16x8*)(sXT + fr * 136 + 32 * s + 8 * kg), x1 = *(const LAS bf16x8*)(sXT + (16 + fr) * 136 + 32 * s + 8 * kg);
#pragma unroll
                for (int mt = 0; mt < 8; ++mt) { const bf16x8 a = *(const LAS bf16x8*)(sBT + (16 * mt + fr) * 136 + 32 * s + 8 * kg);
                    acc[mt][0] = MFMA16(a, x0, acc[mt][0]); acc[mt][1] = MFMA16(a, x1, acc[mt][1]); } }
            asm volatile("s_waitcnt lgkmcnt(0)" ::: "memory");
#pragma unroll
            for (int mt = 0; mt < 8; ++mt)
#pragma unroll
                for (int nt = 0; nt < 2; ++nt) { const int n0 = 16 * mt + 4 * kg, pp = 32 * ph + 16 * nt + fr;
                    u32x2 w; w.x = pk2(acc[mt][nt][0], acc[mt][nt][1]); w.y = pk2(acc[mt][nt][2], acc[mt][nt][3]);
                    *(u32x2*)(ST + ((size_t)(c * NHEAD + h) * 64 + pp) * 128 + n0) = w; }
        }
    }
}
__device__ __forceinline__ void ssd_scan_phase(const Params& p, int b, int dry = 0) {
    unsigned* st = (unsigned*)states_ptr(p, b); const float* dasum = (const float*)(wsb(p) + WS_DASUM) + b * NCHUNK * NHEAD;
    for (int e2 = opq_bid() * 512 + opq_tid(); e2 < 131072; e2 += gridDim.x * 512) {
        const int h = e2 >> 12; float r0 = 0.f, r1 = 0.f;
        for (int c0 = 0; c0 < NCHUNK; c0 += 16) { unsigned v[16]; float d[16];
#pragma unroll
            for (int i = 0; i < 16; ++i) { v[i] = st[(size_t)(c0 + i) * 131072 + e2]; d[i] = dasum[(c0 + i) * NHEAD + h]; }
#pragma unroll
            for (int i = 0; i < 16; ++i) { const unsigned w = pk2(r0, r1); const float dd = __expf(d[i]);
                r0 = r0 * dd + __uint_as_float(v[i] << 16); r1 = r1 * dd + __uint_as_float(v[i] & 0xffff0000u); v[i] = w; }
            if (!dry) {
#pragma unroll
                for (int i = 0; i < 16; ++i) st[(size_t)(c0 + i) * 131072 + e2] = v[i]; } }
    }
}
__device__ __forceinline__ void ssd_out_phase(const Params& p, int b, LAS unsigned char* lds, int dry = 0) {
    const int tid = opq_tid(), lane = tid & 63, wave = tid >> 6, fr = lane & 15, kg = lane >> 4;
    bf16_t* P = proj_ptr(p); const bf16_t* ST = states_ptr(p, b);
    const float* cw = opq(p.ssd_conv_w); const float* cb = opq(p.ssd_conv_b);
    LAS bf16_t* sC = (LAS bf16_t*)lds; LAS bf16_t* sCB = (LAS bf16_t*)(lds + 34816); LAS bf16_t* sB = (LAS bf16_t*)(lds + 69632); LAS bf16_t* sXT = (LAS bf16_t*)(lds + 69632 + wave * 8704);
    LAS float* sACS = (LAS float*)(lds + 139264) + wave * 128; LAS float* sDT = (LAS float*)(lds + 143360) + wave * 128; LAS float* sSSQ = (LAS float*)(lds + 147456);
    for (int u = opq_bid(); u < NCHUNK * NGRP; u += gridDim.x) {
        const int c = u >> 2, g = u & 3, t0 = c * CHUNK, h = 8 * g + wave;
        __syncthreads();
        MSTAMP(p, 0);
        (void)ssd_dt_setup(p, P, t0, h, lane, sACS, sDT);
        { const int cg = tid & 15, rs = (tid >> 4) & 15, isC = tid >> 8; float o[8][8];
          conv_rows<8>(P, t0 + 8 * rs, C_B + isC * 512 + g * 128 + 8 * cg, cw, cb, 2048 + isC * 512 + g * 128 + 8 * cg, o);
          LAS bf16_t* dst = (isC ? sC : sB) + (8 * rs) * 136 + 8 * cg;
#pragma unroll
          for (int r = 0; r < 8; ++r) *(LAS bf16x8*)(dst + r * 136) = pack8(o[r]); }
        __syncthreads();
#pragma unroll
        for (int ms = 0; ms < 8; ++ms) if (ms <= wave) { f32x4 a4 = (f32x4){0.f, 0.f, 0.f, 0.f};
#pragma unroll
            for (int kn = 0; kn < 4; ++kn) { const bf16x8 a = *(const LAS bf16x8*)(sB + (16 * ms + fr) * 136 + 32 * kn + 8 * kg), bb = *(const LAS bf16x8*)(sC + (16 * wave + fr) * 136 + 32 * kn + 8 * kg);
                a4 = MFMA16(a, bb, a4); }
            u32x2 w; w.x = pk2(a4[0], a4[1]); w.y = pk2(a4[2], a4[3]);
            *(LAS u32x2*)(sCB + (16 * wave + fr) * 136 + 16 * ms + 4 * kg) = w; }
        __syncthreads();
        MSTAMP(p, 1);
        const float Dh = opq(p.ssd_d)[h];
        const unsigned zbase0 = (unsigned)((t0 + fr) * LD + C_Z + h * 64 + 4 * kg);
        float ssq[8];
#pragma unroll
        for (int nt = 0; nt < 8; ++nt) ssq[nt] = 0.f;
        for (int ph = 0; ph < 2; ++ph) {
            unsigned zb = zbase0 + 32u * ph; asm volatile("" : "+v"(zb));
            unsigned pfo = (unsigned)(((c * NHEAD + h) * 64 + 32 * ph + fr) * 128 + 8 * kg); asm volatile("" : "+v"(pfo));
            bf16x8 pf[4][2];
#pragma unroll
            for (int sn = 0; sn < 4; ++sn) { pf[sn][0] = *(const bf16x8*)(ST + (pfo + (unsigned)(32 * sn))); pf[sn][1] = *(const bf16x8*)(ST + (pfo + (unsigned)(16 * 128 + 32 * sn))); }
            { const int cg = lane & 3, rs = lane >> 2; float o[8][8];
              conv_rows<8>(P, t0 + 8 * rs, C_X + h * 64 + 32 * ph + 8 * cg, cw, cb, h * 64 + 32 * ph + 8 * cg, o);
#pragma unroll
              for (int q = 0; q < 8; ++q) { float v[8] = {o[0][q], o[1][q], o[2][q], o[3][q], o[4][q], o[5][q], o[6][q], o[7][q]};
                  *(LAS bf16x8*)(sXT + (8 * cg + q) * 136 + 8 * rs) = pack8(v); } }
            asm volatile("s_waitcnt lgkmcnt(0)" ::: "memory");
            f32x4 acc[2][8];
#pragma unroll
            for (int nt = 0; nt < 8; ++nt) { acc[0][nt] = (f32x4){0.f, 0.f, 0.f, 0.f}; acc[1][nt] = (f32x4){0.f, 0.f, 0.f, 0.f}; }
#pragma unroll
            for (int nt = 0; nt < 8; ++nt) {
#pragma unroll
                for (int sn = 0; sn < 4; ++sn) { const bf16x8 cf = *(const LAS bf16x8*)(sC + (16 * nt + fr) * 136 + 32 * sn + 8 * kg);
                    acc[0][nt] = MFMA16(pf[sn][0], cf, acc[0][nt]); acc[1][nt] = MFMA16(pf[sn][1], cf, acc[1][nt]); }
                const float sc = __expf(sACS[16 * nt + fr]);
                acc[0][nt] *= sc; acc[1][nt] *= sc; }
#pragma unroll
            for (int sk = 0; sk < 4; ++sk) {
                const int s0 = 32 * sk + 8 * kg;
                const bf16x8 xa0 = *(const LAS bf16x8*)(sXT + fr * 136 + s0), xa1 = *(const LAS bf16x8*)(sXT + (16 + fr) * 136 + s0);
                const f32x4 as0 = *(const LAS f32x4*)(sACS + s0), as1 = *(const LAS f32x4*)(sACS + s0 + 4), d0 = *(const LAS f32x4*)(sDT + s0), d1 = *(const LAS f32x4*)(sDT + s0 + 4);
#pragma unroll
                for (int nt = 0; nt < 8; ++nt) if (nt >= 2 * sk) { const int l = 16 * nt + fr; const float acsl = sACS[l];
                    float cbv[8]; unpack8(*(const LAS u32x4*)(sCB + l * 136 + s0), cbv);
                    float m[8];
#pragma unroll
                    for (int i = 0; i < 8; ++i) { const int s = s0 + i; const float as = i < 4 ? as0[i & 3] : as1[i & 3], ds = i < 4 ? d0[i & 3] : d1[i & 3];
                        float mv = (s <= l) ? cbv[i] * __expf(acsl - as) * ds : 0.f; if (s == l) mv += Dh; m[i] = mv; }
                    const bf16x8 mb = pack8(m);
                    acc[0][nt] = MFMA16(xa0, mb, acc[0][nt]); acc[1][nt] = MFMA16(xa1, mb, acc[1][nt]);
                    asm volatile("" ::: "memory"); }
            }
            u32x2 zall[8][2];
#pragma unroll
            for (int nt = 0; nt < 8; ++nt)
#pragma unroll
                for (int mt = 0; mt < 2; ++mt) zall[nt][mt] = *(const u32x2*)(P + (zb + (unsigned)(16 * nt * LD + 16 * mt)));
#pragma unroll
            for (int nt = 0; nt < 8; ++nt)
#pragma unroll
                for (int mt = 0; mt < 2; ++mt) { u32x2* zp = (u32x2*)(P + (zb + (unsigned)(16 * nt * LD + 16 * mt)));
                    const u32x2 zw = zall[nt][mt]; float y[4];
                    y[0] = acc[mt][nt][0] * siluf_(__uint_as_float(zw.x << 16)); y[1] = acc[mt][nt][1] * siluf_(__uint_as_float(zw.x & 0xffff0000u));
                    y[2] = acc[mt][nt][2] * siluf_(__uint_as_float(zw.y << 16)); y[3] = acc[mt][nt][3] * siluf_(__uint_as_float(zw.y & 0xffff0000u));
                    ssq[nt] += (y[0] * y[0] + y[1] * y[1]) + (y[2] * y[2] + y[3] * y[3]);
                    u32x2 yw; yw.x = pk2(y[0], y[1]); yw.y = pk2(y[2], y[3]); (void)zp; *(LAS u32x2*)(sXT + (16 * nt + fr) * 32 + 16 * mt + 4 * kg) = yw; }
            asm volatile("s_waitcnt lgkmcnt(0)" ::: "memory");
            { const int rr = lane >> 2, cc = lane & 3;
              unsigned so = (unsigned)((t0 + rr) * LD + C_Z + h * 64 + 32 * ph + 8 * cc); asm volatile("" : "+v"(so));
#pragma unroll
              for (int i = 0; i < 8; ++i) { const u32x4 w = *(const LAS u32x4*)(sXT + (16 * i + rr) * 32 + 8 * cc); if (!dry) *(u32x4*)(P + (so + (unsigned)(16 * i * LD))) = w; } }
            asm volatile("s_waitcnt lgkmcnt(0)" ::: "memory");
        }
        MSTAMP(p, 2);
#pragma unroll
        for (int nt = 0; nt < 8; ++nt) { float v = ssq[nt]; v += __shfl_xor(v, 16); v += __shfl_xor(v, 32); if (kg == 0) sSSQ[wave * 128 + 16 * nt + fr] = v; }
        __syncthreads();
        { const int rr = lane >> 2, cc = lane & 3;
          const float* ng = opq(p.ssd_norm_g) + g * 512 + wave * 64 + 8 * cc;
          f32x4 gg[2][2];
#pragma unroll
          for (int ph = 0; ph < 2; ++ph) { gg[ph][0] = *(const f32x4*)(ng + 32 * ph); gg[ph][1] = *(const f32x4*)(ng + 32 * ph + 4); }
          unsigned so = (unsigned)((t0 + rr) * LD + C_Z + h * 64 + 8 * cc); asm volatile("" : "+v"(so));
          u32x4 yv[8][2];
#pragma unroll
          for (int i = 0; i < 8; ++i)
#pragma unroll
              for (int ph = 0; ph < 2; ++ph) yv[i][ph] = *(const u32x4*)(P + (so + (unsigned)(16 * i * LD + 32 * ph)));
#pragma unroll
          for (int i = 0; i < 8; ++i) { const int l = 16 * i + rr; float tot = 0.f;
#pragma unroll
              for (int w2 = 0; w2 < 8; ++w2) tot += sSSQ[w2 * 128 + l];
              const float rs = 1.f / sqrtf(tot * (1.f / 512.f) + EPS);
#pragma unroll
              for (int ph = 0; ph < 2; ++ph) { float v[8]; unpack8(yv[i][ph], v);
                  v[0] *= rs * gg[ph][0][0]; v[1] *= rs * gg[ph][0][1]; v[2] *= rs * gg[ph][0][2]; v[3] *= rs * gg[ph][0][3];
                  v[4] *= rs * gg[ph][1][0]; v[5] *= rs * gg[ph][1][1]; v[6] *= rs * gg[ph][1][2]; v[7] *= rs * gg[ph][1][3];
                  if (!dry) *(bf16x8*)(P + (so + (unsigned)(16 * i * LD + 32 * ph))) = pack8(v); } } }
        MSTAMP(p, 3);
    }
}
#define XB_TMO      128
#define XB_XCNT(j)  (256  + 64 * (j))
#define XB_XSUB(j)  (1280 + 64 * (j))
#define XB_XGEN(j)  (2304 + 64 * (j))
#define XB_TOP      3328
#define XB_TOPGEN   3392
#define XCD_BAR_WORDS 3456
#define XB_SPIN_CAP (1u << 18)

__device__ __forceinline__ unsigned xb_ld(unsigned* p)              { return __hip_atomic_load(p, __ATOMIC_RELAXED, __HIP_MEMORY_SCOPE_AGENT); }
__device__ __forceinline__ unsigned xb_add(unsigned* p, unsigned v) { return __hip_atomic_fetch_add(p, v, __ATOMIC_RELAXED, __HIP_MEMORY_SCOPE_AGENT); }
__device__ __forceinline__ unsigned xb_xcc_id() { return (unsigned)__builtin_amdgcn_s_getreg((3 << 11) | 20) & 0xFu; }
#define XB_SPIN(cond, bar) do { unsigned _sp = 0; while (cond) { __builtin_amdgcn_s_sleep(1); \
    if ((++_sp & 255u) == 0u) { if (xb_ld(&(bar)[XB_TMO])) break; if (_sp > XB_SPIN_CAP) { atomicAdd(&(bar)[XB_TMO], 1u); break; } } } } while (0)

struct XcdBarrier {
    unsigned* bar; unsigned x;
    volatile LAS unsigned* st;
};

__device__ __forceinline__ XcdBarrier xcd_barrier_post(unsigned* bar, volatile LAS unsigned* st) {
    XcdBarrier b; b.bar = bar; b.x = xb_xcc_id(); b.st = st;
    if (threadIdx.x == 0) (void)xb_add(&bar[XB_XCNT(b.x)], 1u);
    return b;
}
__device__ __forceinline__ void xcd_barrier_complete(unsigned* bar, unsigned x, unsigned& nloc, unsigned& nx) {
    const unsigned G = gridDim.x * gridDim.y * gridDim.z;
    unsigned sum, cnt, mine, sp = 0u;
    for (;;) {
        sum = 0u; cnt = 0u; mine = 0u;
#pragma unroll
        for (unsigned j = 0; j < 16; ++j) { const unsigned c = xb_ld(&bar[XB_XCNT(j)]); sum += c; cnt += (c > 0u) ? 1u : 0u; mine = (j == x) ? c : mine; }
        if (sum == G) break;
        __builtin_amdgcn_s_sleep(1);
        if ((++sp & 255u) == 0u) { if (xb_ld(&bar[XB_TMO])) break; if (sp > XB_SPIN_CAP) { atomicAdd(&bar[XB_TMO], 1u); break; } }
    }
    nloc = mine > 0u ? mine : 1u; nx = cnt > 0u ? cnt : 1u;
}

__device__ __forceinline__ void xcd_barrier(const XcdBarrier& b) {
    asm volatile("s_waitcnt vmcnt(0)" ::: "memory");
    __syncthreads();
    if (threadIdx.x == 0) {
        unsigned* bar = b.bar; asm volatile("" : "+s"(bar));
        unsigned bx = b.x; asm volatile("" : "+s"(bx));
        __builtin_amdgcn_s_waitcnt(0);
        unsigned nloc = b.st[0], nx = b.st[1];
        if (nloc == 0u) { xcd_barrier_complete(bar, bx, nloc, nx); b.st[0] = nloc; b.st[1] = nx; }
        const unsigned old = xb_add(&bar[XB_XSUB(bx)], 1u);
        const unsigned gen = old / nloc;
        if (old + 1u == (gen + 1u) * nloc) {
            __builtin_amdgcn_fence(__ATOMIC_RELEASE, "agent");
            asm volatile("s_waitcnt vmcnt(0)" ::: "memory");
            const unsigned og = xb_add(&bar[XB_TOP], 1u);
            const unsigned tg = og / nx;
            if (og + 1u == (tg + 1u) * nx) xb_add(&bar[XB_TOPGEN], 1u);
            else XB_SPIN(xb_ld(&bar[XB_TOPGEN]) == tg, bar);
            __builtin_amdgcn_fence(__ATOMIC_ACQUIRE, "agent");
            xb_add(&bar[XB_XGEN(bx)], 1u);
            asm volatile("s_waitcnt vmcnt(0)" ::: "memory");
        } else {
            XB_SPIN(xb_ld(&bar[XB_XGEN(bx)]) == gen, bar);
            __builtin_amdgcn_fence(__ATOMIC_ACQUIRE, "agent");
            asm volatile("s_waitcnt vmcnt(0)" ::: "memory");
        }
    }
    __syncthreads();
}

#ifdef REP_COLD
#define REP_SEP() xcd_barrier(bar)
#else
#define REP_SEP() __syncthreads()
#endif
#define RUNP(n, ...) do { if ((n) > 1) { for (int r_ = nrep(n) - 1; r_ > 0; --r_) { const int dry_ = 1; (void)dry_; __VA_ARGS__; REP_SEP(); } } { const int dry_ = 0; (void)dry_; __VA_ARGS__; } } while (0)
#ifndef REP_SYNC
#define REP_SYNC 1
#endif
#ifndef REP_P0
#define REP_P0 1
#endif
#ifndef REP_P1
#define REP_P1 1
#endif
#ifndef REP_P5
#define REP_P5 1
#endif
#ifndef REP_P6
#define REP_P6 1
#endif
#ifndef REP_ST
#define REP_ST 1
#endif
#ifndef REP_LA
#define REP_LA 1
#endif
#ifndef REP_AT
#define REP_AT 1
#endif
#ifndef REP_SC
#define REP_SC 1
#endif
#ifndef REP_SO
#define REP_SO 1
#endif
#ifndef REP_LF
#define REP_LF 1
#endif
__device__ __forceinline__ int nrep(int n) { asm volatile("" : "+s"(n)); return n; }
__device__ __forceinline__ LAS unsigned char* opl(LAS unsigned char* q) { asm volatile("" : "+s"(q)); return q; }
__global__ void __launch_bounds__(512) mk(Params p) {
    extern __shared__ __attribute__((aligned(16))) unsigned char lds_raw[];
    LAS unsigned char* lds = (LAS unsigned char*)lds_raw;
    if (threadIdx.x < 4) ((volatile LAS unsigned*)(lds + LDS_BYTES - 16))[threadIdx.x] = 0u;
    __syncthreads();
    const XcdBarrier bar = xcd_barrier_post((unsigned*)(p.ws + WS_CTL), (volatile LAS unsigned*)(lds + LDS_BYTES - 16));
    if (p.hi > 1000) cg::this_grid().sync();
#ifdef PROBE_SPAN
    unsigned long long ts0 = 0, ts1 = 0;
#define STAMP(i) do { if ((i) == PROBE_SPAN) ts0 = __builtin_amdgcn_s_memrealtime(); if ((i) == PROBE_SPAN + PROBE_LEN) ts1 = __builtin_amdgcn_s_memrealtime(); } while (0)
#else
#define STAMP(i) do { } while (0)
#endif
    STAMP(0);
    RUNP(REP_P0, phase0(p, opl(lds)));
    xcd_barrier(bar); STAMP(1);
#define BATCH_PHASES(b) do { \
        RUNP(REP_P1, phase1_gemm(p, b, opl(lds))); \
        for (int r = 0; r < nrep(REP_SYNC); ++r) xcd_barrier(bar); \
        STAMP(2 + 6 * b); \
        RUNP(REP_ST, ssd_states_phase(p, b, opl(lds))); \
        __syncthreads(); STAMP(20 + 3 * b); \
        RUNP(REP_LA, lru_phase<false>(p, b, opl(lds), 0)); \
        __syncthreads(); STAMP(21 + 3 * b); \
        RUNP(REP_AT, attn_phase(p, b, opl(lds), dry_)); \
        xcd_barrier(bar); STAMP(3 + 6 * b); \
        RUNP(REP_SC, ssd_scan_phase(p, b, dry_)); \
        lru_carry_phase(p, b); \
        xcd_barrier(bar); STAMP(4 + 6 * b); \
        RUNP(REP_SO, ssd_out_phase(p, b, opl(lds), dry_)); \
        __syncthreads(); STAMP(22 + 3 * b); \
        RUNP(REP_LF, lru_phase<true>(p, b, opl(lds), dry_)); \
        xcd_barrier(bar); STAMP(5 + 6 * b); \
        RUNP(REP_P5, phase5_gemm(p, b, opl(lds))); \
        xcd_barrier(bar); STAMP(6 + 6 * b); \
        RUNP(REP_P6, phase6_gemm(p, b, opl(lds))); \
        if (b + 1 < NBATCH) xcd_barrier(bar); \
        STAMP(7 + 6 * b); \
    } while (0)
    BATCH_PHASES(0);
    BATCH_PHASES(1);
#ifdef PROBE_MA
    if (blockIdx.x == 0 && threadIdx.x == 0) { const unsigned long long* tsm = (const unsigned long long*)(p.ws + 255 * MiB); const unsigned long long t2 = __builtin_amdgcn_s_memrealtime(), want = 8ull * (tsm[PROBE_MB] - tsm[PROBE_MA]);
        while (__builtin_amdgcn_s_memrealtime() - t2 < want) __builtin_amdgcn_s_sleep(16); }
#endif
#ifdef PROBE_SPAN
    if (blockIdx.x == 0 && threadIdx.x == 0) { const unsigned long long t2 = __builtin_amdgcn_s_memrealtime(), want = 8ull * (ts1 - ts0);
        while (__builtin_amdgcn_s_memrealtime() - t2 < want) __builtin_amdgcn_s_sleep(16); }
#endif
}

static void launch_mk(Params& p, int lo, int hi, int grid, hipStream_t stream) {
    p.lo = lo; p.hi = hi; void* args[] = {&p};
    (void)hipMemsetAsync(p.ws + WS_CTL, 0, 65536, stream);
    hipError_t e = hipLaunchCooperativeKernel((const void*)mk, dim3(grid), dim3(512), args, LDS_BYTES, stream);
    if (e != hipSuccess) fprintf(stderr, "cooperative launch failed: %s (grid %d)\n", hipGetErrorString(e), grid);
}
extern "C" void kernel_launch(void* const* d_in, const int* in_sizes, int n_in, void* d_out, int out_size, void* d_ws, size_t ws_size, hipStream_t stream) {
    static int grid = 0;
    if (grid == 0) {
        if (n_in != 24 || out_size != MTOK * DM || ws_size < WS_END) { fprintf(stderr, "kernel_launch: unexpected shapes (n_in %d out %d ws %zu)\n", n_in, out_size, ws_size); grid = -1; return; }
        int dev = 0, cus = 0, per_cu = 0;
        hipGetDevice(&dev); hipDeviceGetAttribute(&cus, hipDeviceAttributeMultiprocessorCount, dev);
        hipFuncSetAttribute((const void*)mk, hipFuncAttributeMaxDynamicSharedMemorySize, LDS_BYTES);
        hipOccupancyMaxActiveBlocksPerMultiprocessor(&per_cu, (const void*)mk, 512, LDS_BYTES);
        if (per_cu < 1) { fprintf(stderr, "kernel_launch: occupancy query says %d blocks/CU\n", per_cu); per_cu = 1; }
        grid = cus * 1;
        (void)hipGetLastError();
    }
    if (grid < 0) return;
    Params p{};
    const float** f = (const float**)&p;
    for (int i = 0; i < 24; ++i) f[i] = (const float*)d_in[i];
    p.out = (float*)d_out; p.ws = (unsigned char*)d_ws;
    launch_mk(p, 0, 14, grid, stream);
}
```

```cpp
#define NAIVE_GEMM 0
#define NAIVE_ATT 0
#define NAIVE_LRU 0
#define NAIVE_SSD 0
#define ONE_LAUNCH 1

#include <hip/hip_runtime.h>
#include <hip/hip_cooperative_groups.h>
#include <cstdio>
#include <cstdint>
namespace cg = cooperative_groups;

#ifndef NAIVE_GEMM
#define NAIVE_GEMM 1
#endif
#ifndef NAIVE_SSD
#define NAIVE_SSD 1
#endif
#ifndef NAIVE_LRU
#define NAIVE_LRU 1
#endif
#ifndef NAIVE_ATT
#define NAIVE_ATT 1
#endif
#ifndef ONE_LAUNCH
#define ONE_LAUNCH 0
#endif

namespace pg8 {
#define PG8_LAS __attribute__((address_space(3)))
typedef unsigned short bf16_t;
typedef short bf16x8 __attribute__((ext_vector_type(8)));
typedef float f32x4 __attribute__((ext_vector_type(4)));
typedef unsigned u32x4 __attribute__((ext_vector_type(4)));
constexpr int BM = 256, BK = 64, HALF = 128, HTB = HALF * BK * 2  , STAGE_BYTES = 8 * HTB, NXCD = 8, WGM = 8;

__host__ __device__ __forceinline__ int lds_byte(int r, int c) { const int st = (r >> 4) * 2 + (c >> 5), rr = r & 15, cc = c & 31, ob = rr * 64 + cc * 2; return st * 1024 + (ob ^ (((ob >> 9) & 1) << 5)); }
__host__ __device__ __forceinline__ void stage_rc(int b, int& R, int& C) { const int st = b / 1024, sb = b % 1024, swz = sb ^ (((sb >> 9) & 1) << 5); R = (st >> 1) * 16 + swz / 64; C = (st & 1) * 32 + (swz % 64) / 2; }
__host__ __device__ __forceinline__ int perm32(int rho) { const int n = rho >> 4, i = rho & 15; return 8 * (i >> 2) + 4 * n + (i & 3); }

struct Unit { int pm, pn; };
struct Gemm { const bf16_t* A; const bf16_t* Bt; int M, N, K, lda, ldb; };

struct StaticOrder {
    int nM, nN, nwg, G, c;
    __host__ __device__ void init(int M, int N, int G_, int c_) { nM = M / BM; nN = N / BM; nwg = nM * nN; G = G_; c = c_; }
    __host__ __device__ bool next(int i, Unit& u) const {
        const long L = (long)i * G + c; if (L >= nwg) return false;
        int wgid = (int)L; { const int q = nwg / NXCD, r = nwg % NXCD, xcd = wgid % NXCD, off = wgid / NXCD; wgid = (xcd < r ? xcd * (q + 1) : r * (q + 1) + (xcd - r) * q) + off; }
        const int nig = WGM * nN, gid = wgid / nig, fm = gid * WGM, gsz = (nM - fm) < WGM ? (nM - fm) : WGM;
        u.pm = fm + ((wgid % nig) % gsz); u.pn = (wgid % nig) / gsz; return true;
    }
    __device__ __forceinline__ void a_ready(const Unit&) const {}
    __device__ __forceinline__ void done(const Unit&) const {}
};

__device__ __forceinline__ unsigned cvt_pk_bf16(float lo, float hi) { unsigned r; asm volatile("v_cvt_pk_bf16_f32 %0, %1, %2" : "=v"(r) : "v"(lo), "v"(hi)); return r; }
typedef float f32x2 __attribute__((ext_vector_type(2)));
__device__ __forceinline__ f32x2 gelu_pk(f32x2 v) {
    const f32x2 av = __builtin_elementwise_abs(v), d = av * 0.2316418882f + 1.0f;
    f32x2 t; t.x = __builtin_amdgcn_rcpf(d.x); t.y = __builtin_amdgcn_rcpf(d.y);
    f32x2 q = t * 0.5307027145f + (-0.7265760135f); q = q * t + 0.7107068705f; q = q * t + (-0.142248368f); q = q * t + 0.127414796f; q = q * t;
    const f32x2 s = (v * v) * (-0.72134752044f);
    f32x2 e; e.x = __builtin_amdgcn_exp2f(s.x); e.y = __builtin_amdgcn_exp2f(s.y);
    const f32x2 m = v * (q * e), r = v - m;
    f32x2 o; o.x = v.x < 0.f ? m.x : r.x; o.y = v.y < 0.f ? m.y : r.y; return o;
}

template <int ACT  > struct EpiBf16 {
    static constexpr bool PERM = true, AFTER_DRAIN = false; static_assert(ACT == 0 || ACT == 1, "EpiBf16: ACT is 0 (none) or 1 (gelu_pk)");
    bf16_t* O; int ldc; const float* bias; int split_cols; size_t split_stride; float scale0;
    __device__ __forceinline__ void operator()(const f32x4 (&acc)[2][2][4][2], const Unit& u, int wr, int wc, int fr, int fq) const {
        const int row0 = u.pm * BM + wr * 64 + fr; int colt = u.pn * BM; bf16_t* base = O;
        float sc = 1.f; if (split_cols) { const int t = colt / split_cols; base += (size_t)t * split_stride; colt -= t * split_cols; if (t == 0) sc = scale0; }
        const int col0 = colt + wc * 32 + 8 * fq, bcol0 = u.pn * BM + wc * 32 + 8 * fq;
        f32x4 bv[2][2];
#pragma unroll
        for (int bj = 0; bj < 2; ++bj)
#pragma unroll
            for (int n = 0; n < 2; ++n) bv[bj][n] = bias ? *(const f32x4*)(bias + bcol0 + bj * HALF + 4 * n) : (f32x4){0.f, 0.f, 0.f, 0.f};
#pragma unroll
        for (int ai = 0; ai < 2; ++ai)
#pragma unroll
            for (int m = 0; m < 4; ++m) { bf16_t* rowp = base + (size_t)(row0 + ai * HALF + m * 16) * ldc + col0;
#pragma unroll
                for (int bj = 0; bj < 2; ++bj) { f32x4 v0 = acc[ai][bj][m][0] + bv[bj][0], v1 = acc[ai][bj][m][1] + bv[bj][1];
                    if (ACT == 1) { f32x2 a = gelu_pk((f32x2){v0[0], v0[1]}), b = gelu_pk((f32x2){v0[2], v0[3]}), c = gelu_pk((f32x2){v1[0], v1[1]}), d = gelu_pk((f32x2){v1[2], v1[3]});
                        v0 = (f32x4){a.x, a.y, b.x, b.y}; v1 = (f32x4){c.x, c.y, d.x, d.y}; }
                    v0 = v0 * sc; v1 = v1 * sc; u32x4 w; w.x = cvt_pk_bf16(v0[0], v0[1]); w.y = cvt_pk_bf16(v0[2], v0[3]); w.z = cvt_pk_bf16(v1[0], v1[1]); w.w = cvt_pk_bf16(v1[2], v1[3]);
                    *(u32x4*)(rowp + bj * HALF) = w; } }
    }
};
template <class Epi, class Sched, bool ALIGN_EPI = false, bool SP2 = false>
__device__ __forceinline__ void gemm_phase(PG8_LAS unsigned char* lds, const Gemm g, const Sched& S, const Epi& E) {
    int tid_ = threadIdx.x; asm volatile("" : "+v"(tid_));
    const int tid = tid_, wid = __builtin_amdgcn_readfirstlane(tid >> 6), lane = tid & 63, wr = wid >> 2, wc = wid & 3, fr = lane & 15, fq = lane >> 4;
    const int K = g.K, nt = K / BK;
    unsigned voffA[2], voffB[2];
#pragma unroll
    for (int i = 0; i < 2; ++i) { int R, C; stage_rc(tid * 16 + i * 8192, R, C); const int Rb = Epi::PERM ? ((R & ~31) + perm32(R & 31)) : R;
        voffA[i] = (unsigned)(R * g.lda + C) * 2u; voffB[i] = (unsigned)(Rb * g.ldb + C) * 2u; }
    const size_t kstep = (size_t)(BK * 2);
    const size_t hstepA = (size_t)HALF * g.lda * 2, hstepB = (size_t)HALF * g.ldb * 2;
    const size_t tstepA = 2 * hstepA, tstepB = 2 * hstepB;
    const unsigned ldsw = (unsigned)wid * 1024u;
    const int aoff = lds_byte(wr * 64 + fr, fq * 8), boff = lds_byte(wc * 32 + fr, fq * 8);
#define PG8_SA(b, h) (((b) * 2 + (h)) * HTB)
#define PG8_SB(b, h) ((4 + (b) * 2 + (h)) * HTB)
#define PG8_STAGE(bufoff, gbase, voff) do { _Pragma("unroll") for (int _i = 0; _i < 2; ++_i) \
        __builtin_amdgcn_global_load_lds((const unsigned*)((const char*)(gbase) + (voff)[_i]), (PG8_LAS unsigned*)(lds + (bufoff) + ldsw + _i * 8192), 16, 0, 0); } while (0)
#define PG8_LDA(dst, b, h) do { _Pragma("unroll") for (int m = 0; m < 4; ++m) _Pragma("unroll") for (int k = 0; k < 2; ++k) dst[m][k] = *(const PG8_LAS bf16x8*)(lds + PG8_SA(b, h) + aoff + m * 2048 + k * 1024); } while (0)
#define PG8_LDB(dst, b, h) do { _Pragma("unroll") for (int n = 0; n < 2; ++n) _Pragma("unroll") for (int k = 0; k < 2; ++k) dst[n][k] = *(const PG8_LAS bf16x8*)(lds + PG8_SB(b, h) + boff + n * 2048 + k * 1024); } while (0)
#define PG8_MMA(ai, bj, At, Bt) do { __builtin_amdgcn_s_setprio(1); _Pragma("unroll") for (int m = 0; m < 4; ++m) _Pragma("unroll") for (int n = 0; n < 2; ++n) _Pragma("unroll") for (int k = 0; k < 2; ++k) \
        acc[ai][bj][m][n] = __builtin_amdgcn_mfma_f32_16x16x32_bf16(Bt[n][k], At[m][k], acc[ai][bj][m][n], 0, 0, 0); __builtin_amdgcn_s_setprio(0); } while (0)
#define PG8_WAIT_V(n) asm volatile("s_waitcnt vmcnt(" #n ")" ::: "memory")
#define PG8_WAIT_L(n) asm volatile("s_waitcnt lgkmcnt(" #n ")" ::: "memory")
#define PG8_BAR __builtin_amdgcn_s_barrier()
#define PG8_SCHED __builtin_amdgcn_sched_barrier(0)
    Unit cur, nxt; int ui = 0;
    if (!S.next(0, cur)) return;
    f32x4 acc[2][2][4][2];
#pragma unroll
    for (int a = 0; a < 2; ++a)
#pragma unroll
        for (int b = 0; b < 2; ++b)
#pragma unroll
            for (int m = 0; m < 4; ++m)
#pragma unroll
                for (int n = 0; n < 2; ++n) acc[a][b][m][n] = (f32x4){0.f, 0.f, 0.f, 0.f};
    bf16x8 At[4][2], B0[2][2], B1[2][2];
    const char* cA = (const char*)g.A + (size_t)cur.pm * tstepA; const char* cB = (const char*)g.Bt + (size_t)cur.pn * tstepB;
    S.a_ready(cur);
    if constexpr (SP2) {
        PG8_STAGE(PG8_SB(0, 0), cB, voffB); PG8_STAGE(PG8_SB(0, 1), cB + hstepB, voffB); PG8_STAGE(PG8_SA(0, 0), cA, voffA); PG8_STAGE(PG8_SA(0, 1), cA + hstepA, voffA);
        if (wr == 1) PG8_BAR;
        PG8_WAIT_V(2); PG8_BAR;
        PG8_STAGE(PG8_SB(1, 0), cB + kstep, voffB); PG8_STAGE(PG8_SA(1, 0), cA + kstep, voffA); PG8_STAGE(PG8_SB(1, 1), cB + hstepB + kstep, voffB);
        PG8_WAIT_V(6); PG8_BAR;
    } else {
        PG8_STAGE(PG8_SB(0, 0), cB, voffB); PG8_STAGE(PG8_SA(0, 0), cA, voffA); PG8_STAGE(PG8_SB(0, 1), cB + hstepB, voffB); PG8_STAGE(PG8_SA(0, 1), cA + hstepA, voffA);
        if (wr == 1) PG8_BAR;
        PG8_WAIT_V(4); PG8_BAR;
        PG8_STAGE(PG8_SB(1, 0), cB + kstep, voffB); PG8_STAGE(PG8_SA(1, 0), cA + kstep, voffA); PG8_STAGE(PG8_SB(1, 1), cB + hstepB + kstep, voffB);
        PG8_WAIT_V(6); PG8_BAR;
    }
    for (;;) {
        const bool has_next = S.next(ui + 1, nxt);
        const char* nA = has_next ? (const char*)g.A + (size_t)nxt.pm * tstepA : cA; const char* nB = has_next ? (const char*)g.Bt + (size_t)nxt.pn * tstepB : cB;
        for (int t = 0; t < nt; t += 2) {
            const bool last = (t == nt - 2);
            const char* a1 = cA + (size_t)(t + 1) * kstep;
            const char* a2 = last ? nA : cA + (size_t)(t + 2) * kstep; const char* b2 = last ? nB : cB + (size_t)(t + 2) * kstep;
            const char* a3 = a2 + kstep; const char* b3 = b2 + kstep;
            if (last && has_next) S.a_ready(nxt);
            if constexpr (SP2) {
            PG8_LDB(B0, 0, 0); PG8_LDB(B1, 0, 1); PG8_SCHED; PG8_LDA(At, 0, 0); PG8_STAGE(PG8_SA(1, 1), a1 + hstepA, voffA);
            PG8_WAIT_V(8); PG8_WAIT_L(0); PG8_BAR; PG8_MMA(0, 0, At, B0); PG8_MMA(0, 1, At, B1); PG8_BAR; PG8_SCHED;
            PG8_LDA(At, 0, 1); PG8_STAGE(PG8_SB(0, 0), b2, voffB); PG8_STAGE(PG8_SB(0, 1), b2 + hstepB, voffB); PG8_STAGE(PG8_SA(0, 0), a2, voffA);
            PG8_WAIT_V(8); PG8_WAIT_L(0); PG8_BAR; PG8_MMA(1, 0, At, B0); PG8_MMA(1, 1, At, B1); PG8_BAR; PG8_SCHED;
            PG8_LDB(B0, 1, 0); PG8_LDB(B1, 1, 1); PG8_SCHED; PG8_LDA(At, 1, 0); PG8_STAGE(PG8_SA(0, 1), a2 + hstepA, voffA);
            PG8_WAIT_V(8); PG8_WAIT_L(0); PG8_BAR; PG8_MMA(0, 0, At, B0); PG8_MMA(0, 1, At, B1); PG8_BAR; PG8_SCHED;
            PG8_LDA(At, 1, 1); PG8_STAGE(PG8_SB(1, 0), b3, voffB); PG8_STAGE(PG8_SB(1, 1), b3 + hstepB, voffB); PG8_STAGE(PG8_SA(1, 0), a3, voffA);
            PG8_WAIT_V(8); PG8_WAIT_L(0); PG8_BAR; PG8_MMA(1, 0, At, B0); PG8_MMA(1, 1, At, B1); PG8_BAR; PG8_SCHED;
            } else {
            PG8_LDB(B0, 0, 0); PG8_SCHED; PG8_LDA(At, 0, 0); PG8_STAGE(PG8_SA(1, 1), a1 + hstepA, voffA);
            PG8_WAIT_L(8); PG8_BAR; PG8_WAIT_L(0); PG8_MMA(0, 0, At, B0); PG8_BAR; PG8_SCHED;
            PG8_LDB(B1, 0, 1); PG8_STAGE(PG8_SB(0, 0), b2, voffB);
            PG8_BAR; PG8_WAIT_L(0); PG8_MMA(0, 1, At, B1); PG8_BAR;
            PG8_LDA(At, 0, 1); PG8_STAGE(PG8_SA(0, 0), a2, voffA);
            PG8_BAR; PG8_WAIT_L(0); PG8_MMA(1, 0, At, B0); PG8_BAR; PG8_SCHED;
            PG8_STAGE(PG8_SB(0, 1), b2 + hstepB, voffB);
            PG8_WAIT_V(6); PG8_BAR; PG8_MMA(1, 1, At, B1); PG8_BAR;
            PG8_LDB(B0, 1, 0); PG8_SCHED; PG8_LDA(At, 1, 0); PG8_STAGE(PG8_SA(0, 1), a2 + hstepA, voffA);
            PG8_WAIT_L(8); PG8_BAR; PG8_WAIT_L(0); PG8_MMA(0, 0, At, B0); PG8_BAR; PG8_SCHED;
            PG8_LDB(B1, 1, 1); PG8_STAGE(PG8_SB(1, 0), b3, voffB);
            PG8_BAR; PG8_WAIT_L(0); PG8_MMA(0, 1, At, B1); PG8_BAR;
            PG8_LDA(At, 1, 1); PG8_STAGE(PG8_SA(1, 0), a3, voffA);
            PG8_BAR; PG8_WAIT_L(0); PG8_MMA(1, 0, At, B0); PG8_BAR; PG8_SCHED;
            PG8_STAGE(PG8_SB(1, 1), b3 + hstepB, voffB);
            PG8_WAIT_V(6); PG8_BAR; PG8_MMA(1, 1, At, B1); PG8_BAR;
            }
        }
        if constexpr (ALIGN_EPI) { if (wr == 0) PG8_BAR; }
        if constexpr (!Epi::AFTER_DRAIN) { E(acc, cur, wr, wc, fr, fq); S.done(cur); }
        if (!has_next) break;
#pragma unroll
        for (int a = 0; a < 2; ++a)
#pragma unroll
            for (int b = 0; b < 2; ++b)
#pragma unroll
                for (int m = 0; m < 4; ++m)
#pragma unroll
                    for (int n = 0; n < 2; ++n) acc[a][b][m][n] = (f32x4){0.f, 0.f, 0.f, 0.f};
        cur = nxt; cA = nA; cB = nB; ++ui;
        if constexpr (ALIGN_EPI) { if (wr == 1) PG8_BAR; }
    }
    PG8_WAIT_V(0);
    if constexpr (!ALIGN_EPI) { if (wr == 0) PG8_BAR; }
    PG8_BAR;
    if constexpr (Epi::AFTER_DRAIN) { E.fused(acc, cur, wr, wc, fr, fq, lds, wid, lane); S.done(cur); }
#undef PG8_SA
#undef PG8_SB
#undef PG8_STAGE
#undef PG8_LDA
#undef PG8_LDB
#undef PG8_MMA
#undef PG8_WAIT_V
#undef PG8_WAIT_L
#undef PG8_BAR
#undef PG8_SCHED
}
}

#define GAS __attribute__((address_space(1)))
#define LAS __attribute__((address_space(3)))
typedef unsigned short bf16_t;
typedef short bf16x8 __attribute__((ext_vector_type(8)));
typedef float f32x4 __attribute__((ext_vector_type(4)));
typedef unsigned u32x4 __attribute__((ext_vector_type(4)));
typedef unsigned u32x2 __attribute__((ext_vector_type(2)));

constexpr int DM = 1024, NBATCH = 2, SEQ = 8192, MEML = 256, MTOK = NBATCH * SEQ;
constexpr int INW = 12320, LD = 12544;
constexpr int C_Z = 0, C_X = 2048, C_B = 4096, C_C = 4608, C_LG = 5120, C_LX = 6656, C_Q = 8192, C_G = 9216, C_DT = 12288;
constexpr int C_MRG = 2048;
constexpr int NHEAD = 32, HDIM = 64, NGRP = 4, NSTATE = 128, CHUNK = 128, NCHUNK = SEQ / CHUNK;
constexpr int LRUW = 1536, LRUB = 96, NLB = 16, LSEG = 512, NSEG = SEQ / LSEG, NBLK64 = SEQ / 64;
constexpr float EPS = 1e-6f;
constexpr size_t MiB = 1u << 20;
constexpr size_t WS_WIN = 0, WS_WKV = 25 * MiB, WS_WSSD = 29 * MiB, WS_WLRU = 33 * MiB, WS_WMEM = 36 * MiB, WS_WOUT = 38 * MiB;
constexpr size_t WS_PROJ = 40 * MiB;
constexpr size_t WS_MEMN = 236 * MiB, WS_KVK = 237 * MiB, WS_KVVT = 238 * MiB, WS_LRUWA = 239 * MiB, WS_LRUWX = 239 * MiB + 512 * 1024;
constexpr size_t WS_DASUM = 240 * MiB;
constexpr size_t WS_LAGG = 246 * MiB;
constexpr size_t WS_LCAR = 250 * MiB;
constexpr size_t WS_CTL = 244 * MiB;
constexpr size_t WS_XBUF = 245 * MiB;
constexpr size_t WS_END = 256 * MiB;
static_assert(WS_PROJ + (size_t)SEQ * LD * 2 <= WS_MEMN, "ws map");
constexpr int LDS_BYTES = 155648;

struct Params {
    const float *x, *mem, *norm_g, *w_in, *ssd_conv_w, *ssd_conv_b, *ssd_dt_bias, *ssd_a_log, *ssd_d, *ssd_norm_g,
        *lru_conv_w, *lru_conv_b, *lru_w_a, *lru_b_a, *lru_w_x, *lru_b_x, *lru_lambda, *mem_norm_g, *w_kv,
        *w_br_ssd, *w_br_lru, *w_br_mem, *w_out, *final_g;
    float* out; unsigned char* ws;
    int lo, hi;
};

__device__ __forceinline__ float bf2f(bf16_t v) { return __uint_as_float((unsigned)v << 16); }
__device__ __forceinline__ unsigned f2bf(float f) { unsigned u = __float_as_uint(f); return (u + 0x7fffu + ((u >> 16) & 1u)) >> 16; }
__device__ __forceinline__ unsigned pk2(float lo, float hi) { return f2bf(lo) | (f2bf(hi) << 16); }
__device__ __forceinline__ float sigmoidf_(float v) { return __builtin_amdgcn_rcpf(1.f + __expf(-v)); }
__device__ __forceinline__ float siluf_(float v) { return v * __builtin_amdgcn_rcpf(1.f + __expf(-v)); }
__device__ __forceinline__ float softplusf_(float v) { const float e = __expf(v); const float sm = e * (1.f - e * (0.5f - e * 0.33333334f)); return v > 20.f ? v : (e < 1e-3f ? sm : __logf(1.f + e)); }
__device__ __forceinline__ float wave_sum(float v) {
#pragma unroll
    for (int o = 1; o < 64; o <<= 1) v += __shfl_xor(v, o);
    return v;
}
template <class T> __device__ __forceinline__ T* opq(T* q) { asm volatile("" : "+s"(q)); return q; }
__device__ __forceinline__ int opq_tid() { int t = threadIdx.x; asm volatile("" : "+v"(t)); return t; }
__device__ __forceinline__ int opq_bid() { int t = blockIdx.x; asm volatile("" : "+s"(t)); return t; }
__device__ __forceinline__ unsigned char* wsb(const Params& p) { return opq(p.ws); }
__device__ __forceinline__ bf16_t* proj_ptr(const Params& p) { return (bf16_t*)(wsb(p) + WS_PROJ); }
__device__ __forceinline__ bf16_t* xn_ptr(const Params& p) { return (bf16_t*)((unsigned char*)opq(p.out) + 32 * MiB); }
__device__ __forceinline__ bf16_t* states_ptr(const Params& p, int b) { return (bf16_t*)((unsigned char*)opq(p.out) + (size_t)b * 32 * MiB); }
__device__ __forceinline__ float* scr_ptr(const Params& p, int b) { return (float*)((unsigned char*)opq(p.out) + (size_t)b * 32 * MiB); }

#ifdef PROBE_MA
#define MSTAMP(p, i) do { if (blockIdx.x == 0 && threadIdx.x == 0) ((unsigned long long*)(wsb(p) + 255 * MiB))[i] = __builtin_amdgcn_s_memrealtime(); } while (0)
#else
#define MSTAMP(p, i) do { } while (0)
#endif
__device__ __forceinline__ void transpose_item(const float* W, int K, int Ns, int srccol0, bf16_t* WT, int dstrow0, LAS float* scr, int k0, int lane) {
    float wv[32];
#pragma unroll
    for (int i = 0; i < 32; ++i) wv[i] = W[(size_t)(k0 + 2 * i + (lane >> 5)) * Ns + srccol0 + (lane & 31)];
#pragma unroll
    for (int i = 0; i < 32; ++i) scr[(2 * i + (lane >> 5)) * 33 + (lane & 31)] = wv[i];
    asm volatile("s_waitcnt lgkmcnt(0)" ::: "memory");
    const int c = lane & 7;
#pragma unroll
    for (int j = 0; j < 4; ++j) { const int n = (lane >> 3) + 8 * j; const LAS float* s = scr + (8 * c) * 33 + n;
        u32x4 o; o.x = pk2(s[0 * 33], s[1 * 33]); o.y = pk2(s[2 * 33], s[3 * 33]); o.z = pk2(s[4 * 33], s[5 * 33]); o.w = pk2(s[6 * 33], s[7 * 33]);
        *(u32x4*)(WT + (size_t)(dstrow0 + n) * K + k0 + 8 * c) = o; }
    asm volatile("s_waitcnt lgkmcnt(0)" ::: "memory");
}
__device__ __forceinline__ void rms_row_to_bf16(const float* xrow, const float* g, bf16_t* orow, int lane) {
    const f32x4* xr = (const f32x4*)xrow + lane; const f32x4* gr = (const f32x4*)g + lane;
    f32x4 v[4]; float s = 0.f;
#pragma unroll
    for (int j = 0; j < 4; ++j) { v[j] = xr[64 * j]; s += (v[j].x * v[j].x + v[j].y * v[j].y) + (v[j].z * v[j].z + v[j].w * v[j].w); }
    const float rs = 1.f / sqrtf(wave_sum(s) * (1.f / DM) + EPS);
    unsigned long long* o8 = (unsigned long long*)orow + lane;
#pragma unroll
    for (int j = 0; j < 4; ++j) { const f32x4 gg = gr[64 * j];
        o8[64 * j] = (unsigned long long)pk2(v[j].x * rs * gg.x, v[j].y * rs * gg.y) | ((unsigned long long)pk2(v[j].z * rs * gg.z, v[j].w * rs * gg.w) << 32); }
}
__device__ __forceinline__ void phase0(const Params& p, LAS unsigned char* lds) {
    const int tid = opq_tid(), lane = tid & 63, wave = tid >> 6, bid = opq_bid();
    const int gw = bid * 8 + wave, NGW = gridDim.x * 8;
    LAS float* scr = (LAS float*)(lds + wave * 8704);
    bf16_t* Win = (bf16_t*)(wsb(p) + WS_WIN); bf16_t* Wkv = (bf16_t*)(wsb(p) + WS_WKV); bf16_t* Wssd = (bf16_t*)(wsb(p) + WS_WSSD);
    bf16_t* Wlru = (bf16_t*)(wsb(p) + WS_WLRU); bf16_t* Wmem = (bf16_t*)(wsb(p) + WS_WMEM); bf16_t* Wout = (bf16_t*)(wsb(p) + WS_WOUT);
    constexpr int I_IN = 16 * 385, I_KV = 16 * 64, I_SSD = 32 * 32, I_LRU = 24 * 32, I_MEM = 16 * 32, I_OUT = 16 * 32;
    constexpr int NITEMS = I_IN + I_KV + I_SSD + I_LRU + I_MEM + I_OUT;
    for (int it = gw; it < NITEMS; it += NGW) {
        int r = it;
        if (r < I_IN) { const int nb = r % 385, kb = r / 385; const int sc = 32 * nb; int dr;
            if (sc < 5120) dr = sc; else if (sc < 5152) dr = sc - 5120 + C_DT; else dr = sc - 32;
            transpose_item(opq(p.w_in), 1024, INW, sc, Win, dr, scr, 64 * kb, lane); continue; } r -= I_IN;
        if (r < I_KV) { transpose_item(opq(p.w_kv), 1024, 2048, 32 * (r % 64), Wkv, 32 * (r % 64), scr, 64 * (r / 64), lane); continue; } r -= I_KV;
        if (r < I_SSD) { transpose_item(opq(p.w_br_ssd), 2048, 1024, 32 * (r % 32), Wssd, 32 * (r % 32), scr, 64 * (r / 32), lane); continue; } r -= I_SSD;
        if (r < I_LRU) { transpose_item(opq(p.w_br_lru), 1536, 1024, 32 * (r % 32), Wlru, 32 * (r % 32), scr, 64 * (r / 32), lane); continue; } r -= I_LRU;
        if (r < I_MEM) { transpose_item(opq(p.w_br_mem), 1024, 1024, 32 * (r % 32), Wmem, 32 * (r % 32), scr, 64 * (r / 32), lane); continue; } r -= I_MEM;
        transpose_item(opq(p.w_out), 1024, 1024, 32 * (r % 32), Wout, 32 * (r % 32), scr, 64 * (r / 32), lane);
    }
    { const int gt = bid * 512 + tid, NT = gridDim.x * 512; u32x4* z = (u32x4*)(Win + (size_t)INW * 1024);
      for (int i = gt; i < (LD - INW) * 1024 / 8; i += NT) z[i] = (u32x4){0u, 0u, 0u, 0u}; }
    { const int gt = bid * 512 + tid, NT = gridDim.x * 512; bf16_t* wa = (bf16_t*)(wsb(p) + WS_LRUWA); bf16_t* wx = (bf16_t*)(wsb(p) + WS_LRUWX);
      for (int e = gt; e < NLB * LRUB * LRUB; e += NT) { const int n = e / (LRUB * LRUB), r2 = e % (LRUB * LRUB), j = r2 / LRUB, i = r2 % LRUB;
          wa[e] = (bf16_t)f2bf(opq(p.lru_w_a)[(n * LRUB + i) * LRUB + j]); wx[e] = (bf16_t)f2bf(opq(p.lru_w_x)[(n * LRUB + i) * LRUB + j]); } }
    bf16_t* XN = xn_ptr(p); bf16_t* MN = (bf16_t*)(wsb(p) + WS_MEMN);
    { const float* xb = opq(p.x); const f32x4* gr = (const f32x4*)opq(p.norm_g) + lane;
      for (int m0 = gw * 4; m0 < MTOK; m0 += NGW * 4) {
          f32x4 v[4][4];
#pragma unroll
          for (int r = 0; r < 4; ++r)
#pragma unroll
              for (int j = 0; j < 4; ++j) v[r][j] = ((const f32x4*)(xb + (size_t)(m0 + r) * DM) + lane)[64 * j];
#pragma unroll
          for (int r = 0; r < 4; ++r) { float s = 0.f;
#pragma unroll
              for (int j = 0; j < 4; ++j) s += (v[r][j].x * v[r][j].x + v[r][j].y * v[r][j].y) + (v[r][j].z * v[r][j].z + v[r][j].w * v[r][j].w);
              const float rs = 1.f / sqrtf(wave_sum(s) * (1.f / DM) + EPS);
              unsigned long long* o8 = (unsigned long long*)(XN + (size_t)(m0 + r) * DM) + lane;
#pragma unroll
              for (int j = 0; j < 4; ++j) { const f32x4 gg = gr[64 * j];
                  o8[64 * j] = (unsigned long long)pk2(v[r][j].x * rs * gg.x, v[r][j].y * rs * gg.y) | ((unsigned long long)pk2(v[r][j].z * rs * gg.z, v[r][j].w * rs * gg.w) << 32); } } } }
    for (int m = gw; m < NBATCH * MEML; m += NGW) rms_row_to_bf16(opq(p.mem) + (size_t)m * DM, opq(p.mem_norm_g), MN + (size_t)m * DM, lane);
}
__device__ __forceinline__ void phase7(const Params& p) {
    const int tid = opq_tid(), lane = tid & 63, wave = tid >> 6; const int gw = opq_bid() * 8 + wave, NGW = gridDim.x * 8; float* outb = opq(p.out); const float* fg = opq(p.final_g);
    for (int m = gw; m < MTOK; m += NGW) {
        f32x4* xr = (f32x4*)(outb + (size_t)m * DM) + lane; const f32x4* gr = (const f32x4*)fg + lane;
        f32x4 v[4]; float s = 0.f;
#pragma unroll
        for (int j = 0; j < 4; ++j) { v[j] = xr[64 * j]; s += (v[j].x * v[j].x + v[j].y * v[j].y) + (v[j].z * v[j].z + v[j].w * v[j].w); }
        const float rs = 1.f / sqrtf(wave_sum(s) * (1.f / DM) + EPS);
#pragma unroll
        for (int j = 0; j < 4; ++j) { const f32x4 gg = gr[64 * j]; xr[64 * j] = v[j] * rs * gg; }
    }
}

namespace pg8 {
template <int BR> struct EpiMerge {
    static constexpr bool PERM = true, AFTER_DRAIN = false;
    bf16_t* P; float* scr;
    __device__ __forceinline__ void operator()(const f32x4 (&acc)[2][2][4][2], const Unit& u, int wr, int wc, int fr, int fq) const {
        const int row0 = u.pm * BM + wr * 64 + fr, col0 = u.pn * BM + wc * 32 + 8 * fq;
#pragma unroll
        for (int ai = 0; ai < 2; ++ai)
#pragma unroll
            for (int m = 0; m < 4; ++m) { const size_t r = (size_t)(row0 + ai * HALF + m * 16);
#pragma unroll
                for (int bj = 0; bj < 2; ++bj) { const int c = col0 + bj * HALF;
                    const u32x4 gw = *(const u32x4*)(P + r * 12544 + 9216 + BR * 1024 + c);
                    float g[8];
#pragma unroll
                    for (int i = 0; i < 4; ++i) { g[2 * i] = __uint_as_float(gw[i] << 16); g[2 * i + 1] = __uint_as_float(gw[i] & 0xffff0000u); }
                    f32x4 v0 = acc[ai][bj][m][0], v1 = acc[ai][bj][m][1];
#pragma unroll
                    for (int i = 0; i < 4; ++i) { v0[i] *= 1.f / (1.f + __expf(-g[i])); v1[i] *= 1.f / (1.f + __expf(-g[4 + i])); }
                    float* sp = scr + r * 1024 + c;
                    if (BR > 0) { v0 += *(const f32x4*)sp; v1 += *(const f32x4*)(sp + 4); }
                    if (BR < 2) { *(f32x4*)sp = v0; *(f32x4*)(sp + 4) = v1; }
                    else { u32x4 w; w.x = cvt_pk_bf16(v0[0], v0[1]); w.y = cvt_pk_bf16(v0[2], v0[3]); w.z = cvt_pk_bf16(v1[0], v1[1]); w.w = cvt_pk_bf16(v1[2], v1[3]);
                        *(u32x4*)(P + r * 12544 + 2048 + c) = w; } } }
    }
};
template <int BR, bool FINAL> struct EpiMerge2 {
    static constexpr bool PERM = true, AFTER_DRAIN = false;
    bf16_t* P; bf16_t* s0; int ld0; const bf16_t* s1; int ld1; bf16_t* mrg; int ldm;
    __device__ __forceinline__ void operator()(const f32x4 (&acc)[2][2][4][2], const Unit& u, int wr, int wc, int fr, int fq) const {
        const int row0 = u.pm * BM + wr * 64 + fr, col0 = u.pn * BM + wc * 32 + 8 * fq;
#pragma unroll
        for (int ai = 0; ai < 2; ++ai) {
            unsigned gb = (unsigned)((row0 + ai * HALF) * 12544 + 9216 + BR * 1024 + col0); asm volatile("" : "+v"(gb));
            unsigned b0 = (unsigned)((row0 + ai * HALF) * ld0 + col0); asm volatile("" : "+v"(b0));
            u32x4 gw[4][2];
#pragma unroll
            for (int m = 0; m < 4; ++m)
#pragma unroll
                for (int bj = 0; bj < 2; ++bj) gw[m][bj] = *(const u32x4*)(P + (gb + (unsigned)(m * 16 * 12544 + bj * HALF)));
            f32x4 v[4][2][2];
#pragma unroll
            for (int m = 0; m < 4; ++m)
#pragma unroll
                for (int bj = 0; bj < 2; ++bj) { const u32x4 g4 = gw[m][bj]; f32x4 v0 = acc[ai][bj][m][0], v1 = acc[ai][bj][m][1];
#pragma unroll
                    for (int i = 0; i < 2; ++i) { v0[2 * i] *= __builtin_amdgcn_rcpf(1.f + __expf(-__uint_as_float(g4[i] << 16))); v0[2 * i + 1] *= __builtin_amdgcn_rcpf(1.f + __expf(-__uint_as_float(g4[i] & 0xffff0000u)));
                        v1[2 * i] *= __builtin_amdgcn_rcpf(1.f + __expf(-__uint_as_float(g4[2 + i] << 16))); v1[2 * i + 1] *= __builtin_amdgcn_rcpf(1.f + __expf(-__uint_as_float(g4[2 + i] & 0xffff0000u))); }
                    v[m][bj][0] = v0; v[m][bj][1] = v1; }
            if (!FINAL) {
#pragma unroll
                for (int m = 0; m < 4; ++m)
#pragma unroll
                    for (int bj = 0; bj < 2; ++bj) { const f32x4 v0 = v[m][bj][0], v1 = v[m][bj][1]; u32x4 w; w.x = cvt_pk_bf16(v0[0], v0[1]); w.y = cvt_pk_bf16(v0[2], v0[3]); w.z = cvt_pk_bf16(v1[0], v1[1]); w.w = cvt_pk_bf16(v1[2], v1[3]);
                        *(u32x4*)(s0 + (b0 + (unsigned)(m * 16) * (unsigned)ld0 + (unsigned)(bj * HALF))) = w; }
            } else {
                asm volatile("" ::: "memory");
                unsigned b1 = (unsigned)((row0 + ai * HALF) * ld1 + col0); asm volatile("" : "+v"(b1));
                unsigned bm = (unsigned)((row0 + ai * HALF) * ldm + col0); asm volatile("" : "+v"(bm));
#pragma unroll
                for (int mp = 0; mp < 2; ++mp) { u32x4 a0[2][2], a1[2][2];
#pragma unroll
                    for (int mm = 0; mm < 2; ++mm)
#pragma unroll
                        for (int bj = 0; bj < 2; ++bj) { const unsigned rr = (unsigned)((2 * mp + mm) * 16);
                            a0[mm][bj] = *(const u32x4*)(s0 + (b0 + rr * (unsigned)ld0 + (unsigned)(bj * HALF))); a1[mm][bj] = *(const u32x4*)(s1 + (b1 + rr * (unsigned)ld1 + (unsigned)(bj * HALF))); }
#pragma unroll
                    for (int mm = 0; mm < 2; ++mm)
#pragma unroll
                        for (int bj = 0; bj < 2; ++bj) { const int m = 2 * mp + mm; const unsigned rr = (unsigned)(m * 16);
                            f32x4 v0 = v[m][bj][0], v1 = v[m][bj][1];
#pragma unroll
                            for (int i = 0; i < 2; ++i) { v0[2 * i] += __uint_as_float(a0[mm][bj][i] << 16) + __uint_as_float(a1[mm][bj][i] << 16); v0[2 * i + 1] += __uint_as_float(a0[mm][bj][i] & 0xffff0000u) + __uint_as_float(a1[mm][bj][i] & 0xffff0000u);
                                v1[2 * i] += __uint_as_float(a0[mm][bj][2 + i] << 16) + __uint_as_float(a1[mm][bj][2 + i] << 16); v1[2 * i + 1] += __uint_as_float(a0[mm][bj][2 + i] & 0xffff0000u) + __uint_as_float(a1[mm][bj][2 + i] & 0xffff0000u); }
                            u32x4 w; w.x = cvt_pk_bf16(v0[0], v0[1]); w.y = cvt_pk_bf16(v0[2], v0[3]); w.z = cvt_pk_bf16(v1[0], v1[1]); w.w = cvt_pk_bf16(v1[2], v1[3]);
                            *(u32x4*)(mrg + (bm + rr * (unsigned)ldm + (unsigned)(bj * HALF))) = w; }
                    asm volatile("" ::: "memory"); }
            }
            asm volatile("" ::: "memory");
        }
    }
};
struct EpiOutNorm {
    static constexpr bool PERM = false, AFTER_DRAIN = true;
    const float* xres; float* out; const float* fg; float* xbuf; unsigned* cnt;
    __device__ __forceinline__ void fused(f32x4 (&acc)[2][2][4][2], const Unit& u, int wr, int wc, int fr, int fq, PG8_LAS unsigned char* lds, int wid, int lane) const {
        PG8_LAS float* Pp = (PG8_LAS float*)lds; PG8_LAS float* Sr = (PG8_LAS float*)(lds + 4096);
        const int row0 = u.pm * BM + wr * 64 + fr, col0 = u.pn * BM + wc * 32 + 4 * fq;
#pragma unroll
        for (int ai = 0; ai < 2; ++ai)
#pragma unroll
            for (int m = 0; m < 4; ++m) { const size_t off = (size_t)(row0 + ai * HALF + m * 16) * 1024 + col0; float s = 0.f;
#pragma unroll
                for (int bj = 0; bj < 2; ++bj)
#pragma unroll
                    for (int n = 0; n < 2; ++n) { const f32x4 v = acc[ai][bj][m][n] + *(const f32x4*)(xres + off + bj * HALF + n * 16); acc[ai][bj][m][n] = v; s += (v[0] * v[0] + v[1] * v[1]) + (v[2] * v[2] + v[3] * v[3]); }
                s += __shfl_xor(s, 16); s += __shfl_xor(s, 32);
                if (fq == 0) Pp[(ai * HALF + wr * 64 + m * 16 + fr) * 4 + wc] = s;
                if (m == 3) asm volatile("" ::: "memory"); }
        asm volatile("s_waitcnt lgkmcnt(0)" ::: "memory"); __builtin_amdgcn_s_barrier(); asm volatile("" ::: "memory");
        const int tid = wid * 64 + lane;
        if (tid < 256) { const float s = (Pp[tid * 4 + 0] + Pp[tid * 4 + 1]) + (Pp[tid * 4 + 2] + Pp[tid * 4 + 3]);
            __hip_atomic_store(xbuf + (size_t)(u.pm * BM + tid) * 4 + u.pn, s, __ATOMIC_RELAXED, __HIP_MEMORY_SCOPE_AGENT); }
        asm volatile("s_waitcnt vmcnt(0)" ::: "memory");
        if (wid < 4 && lane == 0) __hip_atomic_fetch_add(cnt + 64 * u.pm, 1u, __ATOMIC_RELAXED, __HIP_MEMORY_SCOPE_AGENT);
        if (wid == 0) { unsigned spins = 0;
            while ((unsigned)__builtin_amdgcn_readfirstlane(__hip_atomic_load(cnt + 64 * u.pm, __ATOMIC_RELAXED, __HIP_MEMORY_SCOPE_AGENT)) < 16u && ++spins < (1u << 22)) __builtin_amdgcn_s_sleep(2);
            __builtin_amdgcn_fence(__ATOMIC_ACQUIRE, "agent"); }
        asm volatile("s_waitcnt vmcnt(0) lgkmcnt(0)" ::: "memory"); __builtin_amdgcn_s_barrier(); asm volatile("" ::: "memory");
        if (tid < 256) { const float* slot = xbuf + (size_t)(u.pm * BM + tid) * 4; float s = 0.f;
#pragma unroll
            for (int q = 0; q < 4; ++q) s += __hip_atomic_load(slot + q, __ATOMIC_RELAXED, __HIP_MEMORY_SCOPE_AGENT);
            Sr[tid] = 1.0f / sqrtf(s * (1.f / 1024.f) + 1e-6f); }
        asm volatile("s_waitcnt lgkmcnt(0)" ::: "memory"); __builtin_amdgcn_s_barrier(); asm volatile("" ::: "memory");
#pragma unroll
        for (int ai = 0; ai < 2; ++ai)
#pragma unroll
            for (int m = 0; m < 4; ++m) { const int r = ai * HALF + wr * 64 + m * 16 + fr; const float rs = Sr[r]; const size_t off = (size_t)(u.pm * BM + r) * 1024 + col0;
#pragma unroll
                for (int bj = 0; bj < 2; ++bj)
#pragma unroll
                    for (int n = 0; n < 2; ++n) { const f32x4 gg = *(const f32x4*)(fg + col0 + bj * HALF + n * 16); *(f32x4*)(out + off + bj * HALF + n * 16) = acc[ai][bj][m][n] * rs * gg; } }
    }
};
}
#define PG8_SP2 true
#define PG8_ALIGN true

__device__ __forceinline__ bf16_t* merged_ptr(const Params& p, int b) { return b == 0 ? xn_ptr(p) : proj_ptr(p) + 4096; }
__device__ __forceinline__ int merged_ld(int b) { return b == 0 ? DM : LD; }
__device__ __forceinline__ void phase1_gemm(const Params& p, int b, LAS unsigned char* lds) {
    const int G = gridDim.x, c = opq_bid();
    { pg8::Gemm g{xn_ptr(p) + (size_t)b * SEQ * DM, (const bf16_t*)(wsb(p) + WS_WIN), SEQ, 12288, DM, DM, DM}; pg8::StaticOrder S; S.init(SEQ, 12288, G, c);
      pg8::EpiBf16<0> E{proj_ptr(p), LD, nullptr, 0, 0, 1.f};
      pg8::gemm_phase<pg8::EpiBf16<0>, pg8::StaticOrder, PG8_ALIGN, PG8_SP2>(lds, g, S, E); }
    { const int tid = opq_tid(), lane = tid & 63, wave = tid >> 6, fr = lane & 15, kg = lane >> 4;
      const bf16_t* XNb = xn_ptr(p) + (size_t)b * SEQ * DM; const bf16_t* Wd = (const bf16_t*)(wsb(p) + WS_WIN) + (size_t)C_DT * DM; bf16_t* Pq = proj_ptr(p);
      LAS float* sRed = (LAS float*)lds;
      for (int rb = c; rb < SEQ / 32; rb += G) {
          __syncthreads();
          f32x4 acc[2][2];
#pragma unroll
          for (int mt = 0; mt < 2; ++mt)
#pragma unroll
              for (int nt = 0; nt < 2; ++nt) acc[mt][nt] = (f32x4){0.f, 0.f, 0.f, 0.f};
          bf16x8 af[2][4], bfr[2][4];
#pragma unroll
          for (int ks = 0; ks < 4; ++ks)
#pragma unroll
              for (int q = 0; q < 2; ++q) { af[q][ks] = *(const bf16x8*)(XNb + (size_t)(32 * rb + 16 * q + fr) * DM + 128 * wave + 32 * ks + 8 * kg);
                  bfr[q][ks] = *(const bf16x8*)(Wd + (size_t)(16 * q + fr) * DM + 128 * wave + 32 * ks + 8 * kg); }
#pragma unroll
          for (int ks = 0; ks < 4; ++ks)
#pragma unroll
              for (int mt = 0; mt < 2; ++mt)
#pragma unroll
                  for (int nt = 0; nt < 2; ++nt) acc[mt][nt] = __builtin_amdgcn_mfma_f32_16x16x32_bf16(af[mt][ks], bfr[nt][ks], acc[mt][nt], 0, 0, 0);
#pragma unroll
          for (int mt = 0; mt < 2; ++mt)
#pragma unroll
              for (int nt = 0; nt < 2; ++nt)
#pragma unroll
                  for (int j = 0; j < 4; ++j) sRed[(wave * 32 + 16 * mt + 4 * kg + j) * 32 + 16 * nt + fr] = acc[mt][nt][j];
          __syncthreads();
#pragma unroll
          for (int q = 0; q < 2; ++q) { const int e = tid + 512 * q, row = e >> 5, col = e & 31; float s = 0.f;
#pragma unroll
              for (int w2 = 0; w2 < 8; ++w2) s += sRed[(w2 * 32 + row) * 32 + col];
              Pq[(size_t)(32 * rb + row) * LD + C_DT + col] = (bf16_t)f2bf(s); }
      } }
    if (b == 0) {
        { pg8::Gemm g{(const bf16_t*)(wsb(p) + WS_MEMN), (const bf16_t*)(wsb(p) + WS_WKV), 512, 1024, DM, DM, DM}; pg8::StaticOrder S; S.init(512, 1024, G, (c + 16) % G);
          pg8::EpiBf16<0> E{(bf16_t*)(wsb(p) + WS_KVK), 1024, nullptr, 0, 0, 1.f};
          pg8::gemm_phase<pg8::EpiBf16<0>, pg8::StaticOrder, PG8_ALIGN, PG8_SP2>(lds, g, S, E); }
        { pg8::Gemm g{(const bf16_t*)(wsb(p) + WS_WKV) + (size_t)1024 * DM, (const bf16_t*)(wsb(p) + WS_MEMN), 1024, 512, DM, DM, DM}; pg8::StaticOrder S; S.init(1024, 512, G, (c + 8) % G);
          pg8::EpiBf16<0> E{(bf16_t*)(wsb(p) + WS_KVVT), 512, nullptr, 0, 0, 1.f};
          pg8::gemm_phase<pg8::EpiBf16<0>, pg8::StaticOrder, PG8_ALIGN, PG8_SP2>(lds, g, S, E); }
    }
}
__device__ __forceinline__ void phase5_gemm(const Params& p, int b, LAS unsigned char* lds) {
    const int G = gridDim.x, c = opq_bid(); bf16_t* P = proj_ptr(p); float* scr = scr_ptr(p, b);
    bf16_t* scrB = P + 2048;
    bf16_t* scrA = (bf16_t*)scr;
    unsigned* flag = (unsigned*)(wsb(p) + WS_CTL) + 4096 + (b * 128 + (c & 127)) * 16;
    if (c < 128) {
        pg8::Gemm g{P + C_Z, (const bf16_t*)(wsb(p) + WS_WSSD), SEQ, DM, 2048, LD, 2048}; pg8::StaticOrder S; S.init(SEQ, DM, 128, c); pg8::EpiMerge2<0, false> E{P, scrA, 1024, nullptr, 0, nullptr, 0};
        pg8::gemm_phase<pg8::EpiMerge2<0, false>, pg8::StaticOrder, false, PG8_SP2>(lds, g, S, E);
#ifdef PROBE_NOFENCE
        asm volatile("s_waitcnt vmcnt(0)" ::: "memory"); __syncthreads();
        if (threadIdx.x == 0) __hip_atomic_store(flag, 1u, __ATOMIC_RELAXED, __HIP_MEMORY_SCOPE_AGENT);
#else
        asm volatile("s_waitcnt vmcnt(0)" ::: "memory"); __syncthreads();
        if (threadIdx.x == 0) { __builtin_amdgcn_fence(__ATOMIC_RELEASE, "agent"); asm volatile("s_waitcnt vmcnt(0)" ::: "memory");
            __hip_atomic_store(flag, 1u, __ATOMIC_RELAXED, __HIP_MEMORY_SCOPE_AGENT); }
#endif
    } else {
        { pg8::Gemm g{P + C_LG, (const bf16_t*)(wsb(p) + WS_WLRU), SEQ, DM, 1536, LD, 1536}; pg8::StaticOrder S; S.init(SEQ, DM, 128, c - 128); pg8::EpiMerge2<1, false> E{P, scrB, LD, nullptr, 0, nullptr, 0};
          pg8::gemm_phase<pg8::EpiMerge2<1, false>, pg8::StaticOrder, false, PG8_SP2>(lds, g, S, E); }
        if (threadIdx.x == 0) { unsigned spins = 0; while (__hip_atomic_load(flag, __ATOMIC_RELAXED, __HIP_MEMORY_SCOPE_AGENT) == 0u && ++spins < (1u << 22)) __builtin_amdgcn_s_sleep(2);
#ifndef PROBE_NOFENCE
            __builtin_amdgcn_fence(__ATOMIC_ACQUIRE, "agent"); asm volatile("s_waitcnt vmcnt(0)" ::: "memory");
#endif
        }
        __syncthreads();
        { pg8::Gemm g{P + C_Q, (const bf16_t*)(wsb(p) + WS_WMEM), SEQ, DM, 1024, LD, 1024}; pg8::StaticOrder S; S.init(SEQ, DM, 128, c - 128); pg8::EpiMerge2<2, true> E{P, scrB, LD, scrA, 1024, merged_ptr(p, b), merged_ld(b)};
          pg8::gemm_phase<pg8::EpiMerge2<2, true>, pg8::StaticOrder, false, PG8_SP2>(lds, g, S, E); }
    }
    (void)G;
}
__device__ __forceinline__ void phase6_gemm(const Params& p, int b, LAS unsigned char* lds) {
    const int G = gridDim.x, c = opq_bid(); bf16_t* P = proj_ptr(p);
    pg8::Gemm g{merged_ptr(p, b), (const bf16_t*)(wsb(p) + WS_WOUT), SEQ, DM, DM, merged_ld(b), DM}; pg8::StaticOrder S; S.init(SEQ, DM, G, c);
    pg8::EpiOutNorm E{opq(p.x) + (size_t)b * SEQ * DM, opq(p.out) + (size_t)b * SEQ * DM, opq(p.final_g), (float*)(wsb(p) + WS_XBUF) + (size_t)b * SEQ * 4, (unsigned*)(wsb(p) + WS_CTL) + 8192 + b * 2048};
    pg8::gemm_phase<pg8::EpiOutNorm, pg8::StaticOrder, false, PG8_SP2>(lds, g, S, E);
}
#define MFMA16(a, b, c) __builtin_amdgcn_mfma_f32_16x16x32_bf16((a), (b), (c), 0, 0, 0)
__device__ __forceinline__ bf16x8 pack8(const float (&v)[8]) {
    u32x4 w; w.x = pk2(v[0], v[1]); w.y = pk2(v[2], v[3]); w.z = pk2(v[4], v[5]); w.w = pk2(v[6], v[7]); return __builtin_bit_cast(bf16x8, w);
}
__device__ __forceinline__ void unpack8(u32x4 w, float (&v)[8]) {
#pragma unroll
    for (int i = 0; i < 4; ++i) { v[2 * i] = __uint_as_float(w[i] << 16); v[2 * i + 1] = __uint_as_float(w[i] & 0xffff0000u); }
}
__device__ __forceinline__ void attn_phase(const Params& p, int b, LAS unsigned char* lds, int dry = 0) {
    const int tid = opq_tid(), lane = tid & 63, wave = tid >> 6, fr = lane & 15, kg = lane >> 4;
    bf16_t* P = proj_ptr(p); const bf16_t* KK = (const bf16_t*)(wsb(p) + WS_KVK) + (size_t)b * 256 * 1024; const bf16_t* VT = (const bf16_t*)(wsb(p) + WS_KVVT) + b * 256;
    LAS bf16_t* sKV = (LAS bf16_t*)lds;
    for (int u = opq_bid(); u < 256; u += gridDim.x) {
        const int hd = u & 3, rt = u >> 2, q0 = rt * 128 + wave * 16;
        bf16_t* qrow = P + (size_t)(q0 + fr) * LD + C_Q + hd * 256;
        __syncthreads();
        { unsigned ko = (unsigned)((tid >> 5) * 1024 + hd * 256 + 8 * (tid & 31)); asm volatile("" : "+v"(ko));
          u32x4 st[16];
#pragma unroll
          for (int i = 0; i < 16; ++i) st[i] = *(const u32x4*)(KK + (ko + (unsigned)(i * 16 * 1024)));
#pragma unroll
          for (int i = 0; i < 16; ++i) *(LAS u32x4*)(sKV + ((tid >> 5) + 16 * i) * 264 + 8 * (tid & 31)) = st[i]; }
        bf16x8 qf[8];
#pragma unroll
        for (int s = 0; s < 8; ++s) qf[s] = *(const bf16x8*)(qrow + 32 * s + 8 * kg);
        __syncthreads();
        u32x4 vst[16];
        { unsigned vo = (unsigned)((hd * 256 + (tid >> 5)) * 512 + 8 * (tid & 31)); asm volatile("" : "+v"(vo));
#pragma unroll
          for (int i = 0; i < 16; ++i) vst[i] = *(const u32x4*)(VT + (vo + (unsigned)(i * 16 * 512))); }
        f32x4 sacc[16];
#pragma unroll
        for (int mt = 0; mt < 16; ++mt) { sacc[mt] = (f32x4){0.f, 0.f, 0.f, 0.f};
#pragma unroll
            for (int s = 0; s < 8; ++s) { const bf16x8 kf = *(const LAS bf16x8*)(sKV + (16 * mt + fr) * 264 + 32 * s + 8 * kg); sacc[mt] = MFMA16(kf, qf[s], sacc[mt]); } }
        float mx = -INFINITY;
#pragma unroll
        for (int mt = 0; mt < 16; ++mt)
#pragma unroll
            for (int j = 0; j < 4; ++j) mx = fmaxf(mx, sacc[mt][j]);
        mx = fmaxf(mx, __shfl_xor(mx, 16)); mx = fmaxf(mx, __shfl_xor(mx, 32));
        float sum = 0.f;
#pragma unroll
        for (int mt = 0; mt < 16; ++mt)
#pragma unroll
            for (int j = 0; j < 4; ++j) { const float e = __expf((sacc[mt][j] - mx) * 0.0625f); sacc[mt][j] = e; sum += e; }
        sum += __shfl_xor(sum, 16); sum += __shfl_xor(sum, 32);
        const float inv = 1.f / sum;
        bf16x8 pf[8];
#pragma unroll
        for (int s2 = 0; s2 < 8; ++s2) { u32x4 w; w.x = pk2(sacc[2 * s2][0], sacc[2 * s2][1]); w.y = pk2(sacc[2 * s2][2], sacc[2 * s2][3]);
            w.z = pk2(sacc[2 * s2 + 1][0], sacc[2 * s2 + 1][1]); w.w = pk2(sacc[2 * s2 + 1][2], sacc[2 * s2 + 1][3]); pf[s2] = __builtin_bit_cast(bf16x8, w); }
        __syncthreads();
#pragma unroll
        for (int i = 0; i < 16; ++i) *(LAS u32x4*)(sKV + ((tid >> 5) + 16 * i) * 264 + 8 * (tid & 31)) = vst[i];
        __syncthreads();
#pragma unroll 4
        for (int mt2 = 0; mt2 < 16; ++mt2) { f32x4 o = (f32x4){0.f, 0.f, 0.f, 0.f}; const LAS bf16_t* vr = sKV + (16 * mt2 + fr) * 264 + 4 * kg;
#pragma unroll
            for (int s2 = 0; s2 < 8; ++s2) { const u32x2 lo = *(const LAS u32x2*)(vr + 32 * s2), hi = *(const LAS u32x2*)(vr + 32 * s2 + 16);
                u32x4 w; w.x = lo.x; w.y = lo.y; w.z = hi.x; w.w = hi.y; o = MFMA16(__builtin_bit_cast(bf16x8, w), pf[s2], o); }
            u32x2 ow; ow.x = pk2(o[0] * inv, o[1] * inv); ow.y = pk2(o[2] * inv, o[3] * inv);
            if (!dry) *(u32x2*)(qrow + 16 * mt2 + 4 * kg) = ow; }
    }
}
template <bool FINAL> __device__ __forceinline__ void lru_phase(const Params& p, int b, LAS unsigned char* lds, int dry = 0) {
    const int tid = opq_tid(), lane = tid & 63, wave = tid >> 6, fr = lane & 15, kg = lane >> 4;
    bf16_t* P = proj_ptr(p);
    LAS bf16_t* sWA = (LAS bf16_t*)lds; LAS bf16_t* sWX = (LAS bf16_t*)(lds + 19968);
    LAS float* sCW = (LAS float*)(lds + 39936); LAS float* sCB = sCW + 384; LAS float* sBA = sCB + 96; LAS float* sBX = sBA + 96; LAS float* sSP = sBX + 96;
    LAS float* sXL = (LAS float*)(lds + 43008) + wave * 1600;
    LAS float* sAG = (LAS float*)(lds + 94208);
    float* agg = (float*)(wsb(p) + WS_LAGG) + (size_t)b * NBLK64 * LRUW * 2;
    const float* car = (const float*)(wsb(p) + WS_LCAR) + (size_t)b * NBLK64 * LRUW;
    const float* lcw = opq(p.lru_conv_w); const float* lcb = opq(p.lru_conv_b); const float* lba = opq(p.lru_b_a); const float* lbx = opq(p.lru_b_x); const float* lam = opq(p.lru_lambda);
    for (int u = opq_bid(); u < NLB * NSEG; u += gridDim.x) {
        const int n = u % NLB, sg = u / NLB;
        __syncthreads();
        { const bf16_t* gwa = (const bf16_t*)(wsb(p) + WS_LRUWA) + n * 9216; const bf16_t* gwx = (const bf16_t*)(wsb(p) + WS_LRUWX) + n * 9216;
          u32x4 wa3[3], wx3[3]; float cwv = 0.f, v4[4] = {0.f, 0.f, 0.f, 0.f};
#pragma unroll
          for (int i = 0; i < 3; ++i) { const int e = tid + 512 * i; if (e < 96 * 12) { const int j = e / 12, c8 = e % 12; wa3[i] = *(const u32x4*)(gwa + j * 96 + 8 * c8); wx3[i] = *(const u32x4*)(gwx + j * 96 + 8 * c8); } }
          if (tid < 384) cwv = lcw[(tid / 96) * 1536 + n * 96 + tid % 96];
          if (tid < 96) { v4[0] = lcb[n * 96 + tid]; v4[1] = lba[n * 96 + tid]; v4[2] = lbx[n * 96 + tid]; v4[3] = lam[n * 96 + tid]; }
#pragma unroll
          for (int i = 0; i < 3; ++i) { const int e = tid + 512 * i; if (e < 96 * 12) { const int j = e / 12, c8 = e % 12; *(LAS u32x4*)(sWA + j * 104 + 8 * c8) = wa3[i]; *(LAS u32x4*)(sWX + j * 104 + 8 * c8) = wx3[i]; } }
          if (tid < 384) sCW[tid] = cwv;
          if (tid < 96) { sCB[tid] = v4[0]; sBA[tid] = v4[1]; sBX[tid] = v4[2]; sSP[tid] = softplusf_(-v4[3]); } }
        __syncthreads();
        float runA[6], runH[6];
#pragma unroll
        for (int nt = 0; nt < 6; ++nt) { runA[nt] = 1.f; runH[nt] = FINAL ? car[(sg * 8 + wave) * LRUW + n * 96 + 16 * nt + fr] : 0.f; }
        for (int step = 0; step < 4; ++step) {
            const int tb = sg * LSEG + wave * 64 + step * 16;
            u32x4 rawC[3][4];
            { const int t0r = tb + fr - 3; unsigned ro = (unsigned)((t0r < 0 ? 0 : t0r) * LD + C_LX + n * 96 + 8 * kg); asm volatile("" : "+v"(ro));
              if (t0r >= 0) {
#pragma unroll
                  for (int ks = 0; ks < 3; ++ks)
#pragma unroll
                      for (int k = 0; k < 4; ++k) rawC[ks][k] = *(const u32x4*)(P + (ro + (unsigned)(k * LD + 32 * ks)));
              } else {
#pragma unroll
                  for (int ks = 0; ks < 3; ++ks)
#pragma unroll
                      for (int k = 0; k < 4; ++k) { const int t = t0r + k; rawC[ks][k] = *(const u32x4*)(P + (ro + (unsigned)((t < 0 ? 0 : t) * LD + 32 * ks))); if (t < 0) rawC[ks][k] = (u32x4){0u, 0u, 0u, 0u}; }
              } }
            bf16x8 af[3];
#pragma unroll
            for (int ks = 0; ks < 3; ++ks) { const int ch0 = 32 * ks + 8 * kg; float xl[8];
#pragma unroll
                for (int i = 0; i < 8; ++i) xl[i] = sCB[ch0 + i];
#pragma unroll
                for (int k = 0; k < 4; ++k) { const u32x4 raw = rawC[ks][k];
                    float rv[8]; unpack8(raw, rv);
#pragma unroll
                    for (int i = 0; i < 8; ++i) xl[i] += sCW[k * 96 + ch0 + i] * rv[i]; }
                *(LAS f32x4*)(sXL + fr * 100 + ch0) = (f32x4){xl[0], xl[1], xl[2], xl[3]}; *(LAS f32x4*)(sXL + fr * 100 + ch0 + 4) = (f32x4){xl[4], xl[5], xl[6], xl[7]};
                af[ks] = pack8(xl); }
            LAS bf16_t* sG = (LAS bf16_t*)((LAS unsigned char*)sWA + 106496) + wave * 1536;
            unsigned go3[3]; u32x4 graw[3];
            if (FINAL) {
#pragma unroll
                for (int i = 0; i < 3; ++i) { const int e = lane + 64 * i, row = e / 12, c12 = e % 12; go3[i] = (unsigned)((tb + row) * LD + C_LG + n * 96 + 8 * c12); }
                asm volatile("" : "+v"(go3[0]), "+v"(go3[1]), "+v"(go3[2]));
#pragma unroll
                for (int i = 0; i < 3; ++i) graw[i] = *(const u32x4*)(P + go3[i]); }
            f32x4 aR[6], aI[6];
#pragma unroll
            for (int nt = 0; nt < 6; ++nt) { aR[nt] = (f32x4){0.f, 0.f, 0.f, 0.f}; aI[nt] = (f32x4){0.f, 0.f, 0.f, 0.f};
#pragma unroll
                for (int ks = 0; ks < 3; ++ks) { const bf16x8 wa = *(const LAS bf16x8*)(sWA + (16 * nt + fr) * 104 + 32 * ks + 8 * kg), wx = *(const LAS bf16x8*)(sWX + (16 * nt + fr) * 104 + 32 * ks + 8 * kg);
                    aR[nt] = MFMA16(af[ks], wa, aR[nt]); aI[nt] = MFMA16(af[ks], wx, aI[nt]); } }
            float Ainc[6][4], Hinc[6][4];
#pragma unroll
            for (int nt = 0; nt < 6; ++nt) { const int j = 16 * nt + fr; const float ba2 = -1.44269504f * sBA[j], bx2 = -1.44269504f * sBX[j], spc = -8.f * 1.44269504f * sSP[j];
                float A = 1.f, H = 0.f;
#pragma unroll
                for (int r = 0; r < 4; ++r) { const float xlv = sXL[(4 * kg + r) * 100 + j];
                    const float rr = __builtin_amdgcn_rcpf(1.f + __builtin_amdgcn_exp2f(fmaf(aR[nt][r], -1.44269504f, ba2))), ii = __builtin_amdgcn_rcpf(1.f + __builtin_amdgcn_exp2f(fmaf(aI[nt][r], -1.44269504f, bx2)));
                    const float a = __builtin_amdgcn_exp2f(rr * spc), mult = __builtin_amdgcn_sqrtf(fmaxf(0.f, fmaf(-a, a, 1.f)));
                    H = a * H + mult * ii * xlv; A *= a; Ainc[nt][r] = A; Hinc[nt][r] = H; }
                float ap = 1.f, hp = 0.f, at = 1.f, ht = 0.f;
#pragma unroll
                for (int k = 0; k < 4; ++k) { const float ab = __shfl(A, fr + 16 * k), hb = __shfl(H, fr + 16 * k);
                    if (k < kg) { hp = ab * hp + hb; ap *= ab; } ht = ab * ht + hb; at *= ab; }
                if (FINAL) { const float hin = ap * runH[nt] + hp;
#pragma unroll
                    for (int r = 0; r < 4; ++r) Hinc[nt][r] = Ainc[nt][r] * hin + Hinc[nt][r]; }
                runH[nt] = at * runH[nt] + ht; runA[nt] *= at; }
            if (FINAL) {
#pragma unroll
                for (int i = 0; i < 3; ++i) { const int e = lane + 64 * i; *(LAS u32x4*)(sG + (e / 12) * 96 + 8 * (e % 12)) = graw[i]; }
                asm volatile("s_waitcnt lgkmcnt(0)" ::: "memory");
#pragma unroll
                for (int nt = 0; nt < 6; ++nt)
#pragma unroll
                    for (int r = 0; r < 4; ++r) { LAS bf16_t* gp = sG + (4 * kg + r) * 96 + 16 * nt + fr; const float yv = Hinc[nt][r] * siluf_(bf2f(*gp)); *gp = (bf16_t)f2bf(yv); }
                asm volatile("s_waitcnt lgkmcnt(0)" ::: "memory");
#pragma unroll
                for (int i = 0; i < 3; ++i) { const int e = lane + 64 * i; const u32x4 w = *(const LAS u32x4*)(sG + (e / 12) * 96 + 8 * (e % 12)); if (!dry) *(u32x4*)(P + go3[i]) = w; }
                asm volatile("s_waitcnt lgkmcnt(0)" ::: "memory"); }
        }
        if (!FINAL && kg == 0) {
#pragma unroll
            for (int nt = 0; nt < 6; ++nt) { const int ch = n * 96 + 16 * nt + fr; agg[((size_t)(sg * 8 + wave) * LRUW + ch) * 2] = runA[nt]; agg[((size_t)(sg * 8 + wave) * LRUW + ch) * 2 + 1] = runH[nt]; } }
    }
}
__device__ __forceinline__ void lru_carry_phase(const Params& p, int b) {
    const int gt = opq_bid() * 512 + opq_tid();
    const float* agg = (const float*)(wsb(p) + WS_LAGG) + (size_t)b * NBLK64 * LRUW * 2; float* car = (float*)(wsb(p) + WS_LCAR) + (size_t)b * NBLK64 * LRUW;
    for (int ch = gt; ch < LRUW; ch += gridDim.x * 512) { float h = 0.f;
        for (int k0 = 0; k0 < NBLK64; k0 += 16) { float a[16], hh[16];
#pragma unroll
            for (int i = 0; i < 16; ++i) { a[i] = agg[((size_t)(k0 + i) * LRUW + ch) * 2]; hh[i] = agg[((size_t)(k0 + i) * LRUW + ch) * 2 + 1]; }
#pragma unroll
            for (int i = 0; i < 16; ++i) { car[(k0 + i) * LRUW + ch] = h; h = a[i] * h + hh[i]; } } }
}
__device__ __forceinline__ void conv8_silu(const bf16_t* P, int t, int col, const float* cw, const float* cb, int ch, float (&o)[8]) {
    float r[11];
    unsigned off0 = (unsigned)((t < 3 ? 0 : t - 3) * LD + col); asm volatile("" : "+v"(off0));
    if (t >= 3) {
#pragma unroll
        for (int i = 0; i < 11; ++i) r[i] = bf2f(P[off0 + (unsigned)(i * LD)]);
    } else {
#pragma unroll
        for (int i = 0; i < 11; ++i) { const int tt = t - 3 + i; const float v = bf2f(P[off0 + (unsigned)((tt < 0 ? 0 : tt) * LD)]); r[i] = tt < 0 ? 0.f : v; }
    }
    const float w0 = cw[ch], w1 = cw[3072 + ch], w2 = cw[6144 + ch], w3 = cw[9216 + ch], bb = cb[ch];
#pragma unroll
    for (int j = 0; j < 8; ++j) o[j] = siluf_(bb + w0 * r[j] + w1 * r[j + 1] + w2 * r[j + 2] + w3 * r[j + 3]);
}
__device__ __forceinline__ float ssd_dt_setup(const Params& p, const bf16_t* P, int t0, int h, int lane, LAS float* sACS, LAS float* sDT) {
    const float dtb = opq(p.ssd_dt_bias)[h], an = -__expf(opq(p.ssd_a_log)[h]);
    const float dt0 = softplusf_(bf2f(P[(size_t)(t0 + 2 * lane) * LD + C_DT + h]) + dtb), dt1 = softplusf_(bf2f(P[(size_t)(t0 + 2 * lane + 1) * LD + C_DT + h]) + dtb);
    const float dA1 = dt1 * an; float s = dt0 * an + dA1;
#pragma unroll
    for (int o = 1; o < 64; o <<= 1) { const float t = __shfl_up(s, o); if (lane >= o) s += t; }
    sACS[2 * lane] = s - dA1; sACS[2 * lane + 1] = s; sDT[2 * lane] = dt0; sDT[2 * lane + 1] = dt1;
    return __shfl(s, 63);
}
template <int R> __device__ __forceinline__ void conv_rows(const bf16_t* P, int t, int col, const float* cw, const float* cb, int ch, float (&o)[R][8]) {
    unsigned off0 = (unsigned)((t < 3 ? 0 : t - 3) * LD + col); asm volatile("" : "+v"(off0));
    u32x4 raw[R + 3];
    if (t >= 3) {
#pragma unroll
        for (int i = 0; i < R + 3; ++i) raw[i] = *(const u32x4*)(P + (off0 + (unsigned)(i * LD)));
    } else {
#pragma unroll
        for (int i = 0; i < R + 3; ++i) { const int tt = t - 3 + i; raw[i] = *(const u32x4*)(P + (off0 + (unsigned)((tt < 0 ? 0 : tt) * LD))); if (tt < 0) raw[i] = (u32x4){0u, 0u, 0u, 0u}; }
    }
    float w[4][8], bb[8];
#pragma unroll
    for (int k = 0; k < 4; ++k) { const f32x4 w0 = *(const f32x4*)(cw + k * 3072 + ch), w1 = *(const f32x4*)(cw + k * 3072 + ch + 4);
        w[k][0] = w0[0]; w[k][1] = w0[1]; w[k][2] = w0[2]; w[k][3] = w0[3]; w[k][4] = w1[0]; w[k][5] = w1[1]; w[k][6] = w1[2]; w[k][7] = w1[3]; }
    { const f32x4 b0 = *(const f32x4*)(cb + ch), b1 = *(const f32x4*)(cb + ch + 4); bb[0] = b0[0]; bb[1] = b0[1]; bb[2] = b0[2]; bb[3] = b0[3]; bb[4] = b1[0]; bb[5] = b1[1]; bb[6] = b1[2]; bb[7] = b1[3]; }
#pragma unroll
    for (int r = 0; r < R; ++r)
#pragma unroll
        for (int q = 0; q < 8; ++q) o[r][q] = bb[q];
#pragma unroll
    for (int i = 0; i < R + 3; ++i) { float v[8]; unpack8(raw[i], v);
#pragma unroll
        for (int k = 0; k < 4; ++k) { const int r = i - k; if (r >= 0 && r < R) {
#pragma unroll
                for (int q = 0; q < 8; ++q) o[r][q] += w[k][q] * v[q]; } } }
#pragma unroll
    for (int r = 0; r < R; ++r)
#pragma unroll
        for (int q = 0; q < 8; ++q) o[r][q] = siluf_(o[r][q]);
}
__device__ __forceinline__ void ssd_states_phase(const Params& p, int b, LAS unsigned char* lds) {
    const int tid = opq_tid(), lane = tid & 63, wave = tid >> 6, fr = lane & 15, kg = lane >> 4;
    const bf16_t* P = proj_ptr(p); bf16_t* ST = states_ptr(p, b); float* dasum = (float*)(wsb(p) + WS_DASUM) + b * NCHUNK * NHEAD;
    const float* cw = opq(p.ssd_conv_w); const float* cb = opq(p.ssd_conv_b);
    LAS bf16_t* sBT = (LAS bf16_t*)lds; LAS bf16_t* sXT = (LAS bf16_t*)(lds + 34816 + wave * 8704);
    LAS float* sACS = (LAS float*)(lds + 104448) + wave * 128; LAS float* sW = (LAS float*)(lds + 108544) + wave * 128;
    for (int u = opq_bid(); u < NCHUNK * NGRP; u += gridDim.x) {
        const int c = u >> 2, g = u & 3, t0 = c * CHUNK, h = 8 * g + wave;
        __syncthreads();
        { const float tot = ssd_dt_setup(p, P, t0, h, lane, sACS, sW);
          if (lane == 0) dasum[c * NHEAD + h] = tot;
          sW[2 * lane] = sW[2 * lane] * __expf(tot - sACS[2 * lane]); sW[2 * lane + 1] = sW[2 * lane + 1] * __expf(tot - sACS[2 * lane + 1]); }
        { const int cg = tid & 15, rs = tid >> 4; float o[4][8];
          conv_rows<4>(P, t0 + 4 * rs, C_B + g * 128 + 8 * cg, cw, cb, 2048 + g * 128 + 8 * cg, o);
#pragma unroll
          for (int q = 0; q < 8; ++q) { u32x2 w; w.x = pk2(o[0][q], o[1][q]); w.y = pk2(o[2][q], o[3][q]); *(LAS u32x2*)(sBT + (8 * cg + q) * 136 + 4 * rs) = w; } }
        __syncthreads();
        for (int ph = 0; ph < 2; ++ph) {
            { const int cg = lane & 3, rs = lane >> 2; float o[8][8];
              conv_rows<8>(P, t0 + 8 * rs, C_X + h * 64 + 32 * ph + 8 * cg, cw, cb, h * 64 + 32 * ph + 8 * cg, o);
              const f32x4 w0 = *(const LAS f32x4*)(sW + 8 * rs), w1 = *(const LAS f32x4*)(sW + 8 * rs + 4);
#pragma unroll
              for (int q = 0; q < 8; ++q) { float v[8] = {o[0][q] * w0[0], o[1][q] * w0[1], o[2][q] * w0[2], o[3][q] * w0[3], o[4][q] * w1[0], o[5][q] * w1[1], o[6][q] * w1[2], o[7][q] * w1[3]};
                  *(LAS bf16x8*)(sXT + (8 * cg + q) * 136 + 8 * rs) = pack8(v); } }
            asm volatile("s_waitcnt lgkmcnt(0)" ::: "memory");
            f32x4 acc[8][2];
#pragma unroll
            for (int mt = 0; mt < 8; ++mt) { acc[mt][0] = (f32x4){0.f, 0.f, 0.f, 0.f}; acc[mt][1] = (f32x4){0.f, 0.f, 0.f, 0.f}; }
#pragma unroll
            for (int s = 0; s < 4; ++s) { const bf16x8 x0 = *(const LAS bf16x8*)(sXT + fr * 136 + 32 * s + 8 * kg), x1 = *(const LAS bf16x8*)(sXT + (16 + fr) * 136 + 32 * s + 8 * kg);
#pragma unroll
                for (int mt = 0; mt < 8; ++mt) { const bf16x8 a = *(const LAS bf16x8*)(sBT + (16 * mt + fr) * 136 + 32 * s + 8 * kg);
                    acc[mt][0] = MFMA16(a, x0, acc[mt][0]); acc[mt][1] = MFMA16(a, x1, acc[mt][1]); } }
            asm volatile("s_waitcnt lgkmcnt(0)" ::: "memory");
#pragma unroll
            for (int mt = 0; mt < 8; ++mt)
#pragma unroll
                for (int nt = 0; nt < 2; ++nt) { const int n0 = 16 * mt + 4 * kg, pp = 32 * ph + 16 * nt + fr;
                    u32x2 w; w.x = pk2(acc[mt][nt][0], acc[mt][nt][1]); w.y = pk2(acc[mt][nt][2], acc[mt][nt][3]);
                    *(u32x2*)(ST + ((size_t)(c * NHEAD + h) * 64 + pp) * 128 + n0) = w; }
        }
    }
}
__device__ __forceinline__ void ssd_scan_phase(const Params& p, int b, int dry = 0) {
    unsigned* st = (unsigned*)states_ptr(p, b); const float* dasum = (const float*)(wsb(p) + WS_DASUM) + b * NCHUNK * NHEAD;
    for (int e2 = opq_bid() * 512 + opq_tid(); e2 < 131072; e2 += gridDim.x * 512) {
        const int h = e2 >> 12; float r0 = 0.f, r1 = 0.f;
        for (int c0 = 0; c0 < NCHUNK; c0 += 16) { unsigned v[16]; float d[16];
#pragma unroll
            for (int i = 0; i < 16; ++i) { v[i] = st[(size_t)(c0 + i) * 131072 + e2]; d[i] = dasum[(c0 + i) * NHEAD + h]; }
#pragma unroll
            for (int i = 0; i < 16; ++i) { const unsigned w = pk2(r0, r1); const float dd = __expf(d[i]);
                r0 = r0 * dd + __uint_as_float(v[i] << 16); r1 = r1 * dd + __uint_as_float(v[i] & 0xffff0000u); v[i] = w; }
            if (!dry) {
#pragma unroll
                for (int i = 0; i < 16; ++i) st[(size_t)(c0 + i) * 131072 + e2] = v[i]; } }
    }
}
__device__ __forceinline__ void ssd_out_phase(const Params& p, int b, LAS unsigned char* lds, int dry = 0) {
    const int tid = opq_tid(), lane = tid & 63, wave = tid >> 6, fr = lane & 15, kg = lane >> 4;
    bf16_t* P = proj_ptr(p); const bf16_t* ST = states_ptr(p, b);
    const float* cw = opq(p.ssd_conv_w); const float* cb = opq(p.ssd_conv_b);
    LAS bf16_t* sC = (LAS bf16_t*)lds; LAS bf16_t* sCB = (LAS bf16_t*)(lds + 34816); LAS bf16_t* sB = (LAS bf16_t*)(lds + 69632); LAS bf16_t* sXT = (LAS bf16_t*)(lds + 69632 + wave * 8704);
    LAS float* sACS = (LAS float*)(lds + 139264) + wave * 128; LAS float* sDT = (LAS float*)(lds + 143360) + wave * 128; LAS float* sSSQ = (LAS float*)(lds + 147456);
    for (int u = opq_bid(); u < NCHUNK * NGRP; u += gridDim.x) {
        const int c = u >> 2, g = u & 3, t0 = c * CHUNK, h = 8 * g + wave;
        __syncthreads();
        MSTAMP(p, 0);
        (void)ssd_dt_setup(p, P, t0, h, lane, sACS, sDT);
        { const int cg = tid & 15, rs = (tid >> 4) & 15, isC = tid >> 8; float o[8][8];
          conv_rows<8>(P, t0 + 8 * rs, C_B + isC * 512 + g * 128 + 8 * cg, cw, cb, 2048 + isC * 512 + g * 128 + 8 * cg, o);
          LAS bf16_t* dst = (isC ? sC : sB) + (8 * rs) * 136 + 8 * cg;
#pragma unroll
          for (int r = 0; r < 8; ++r) *(LAS bf16x8*)(dst + r * 136) = pack8(o[r]); }
        __syncthreads();
#pragma unroll
        for (int ms = 0; ms < 8; ++ms) if (ms <= wave) { f32x4 a4 = (f32x4){0.f, 0.f, 0.f, 0.f};
#pragma unroll
            for (int kn = 0; kn < 4; ++kn) { const bf16x8 a = *(const LAS bf16x8*)(sB + (16 * ms + fr) * 136 + 32 * kn + 8 * kg), bb = *(const LAS bf16x8*)(sC + (16 * wave + fr) * 136 + 32 * kn + 8 * kg);
                a4 = MFMA16(a, bb, a4); }
            u32x2 w; w.x = pk2(a4[0], a4[1]); w.y = pk2(a4[2], a4[3]);
            *(LAS u32x2*)(sCB + (16 * wave + fr) * 136 + 16 * ms + 4 * kg) = w; }
        __syncthreads();
        MSTAMP(p, 1);
        const float Dh = opq(p.ssd_d)[h];
        const unsigned zbase0 = (unsigned)((t0 + fr) * LD + C_Z + h * 64 + 4 * kg);
        float ssq[8];
#pragma unroll
        for (int nt = 0; nt < 8; ++nt) ssq[nt] = 0.f;
        for (int ph = 0; ph < 2; ++ph) {
            unsigned zb = zbase0 + 32u * ph; asm volatile("" : "+v"(zb));
            unsigned pfo = (unsigned)(((c * NHEAD + h) * 64 + 32 * ph + fr) * 128 + 8 * kg); asm volatile("" : "+v"(pfo));
            bf16x8 pf[4][2];
#pragma unroll
            for (int sn = 0; sn < 4; ++sn) { pf[sn][0] = *(const bf16x8*)(ST + (pfo + (unsigned)(32 * sn))); pf[sn][1] = *(const bf16x8*)(ST + (pfo + (unsigned)(16 * 128 + 32 * sn))); }
            { const int cg = lane & 3, rs = lane >> 2; float o[8][8];
              conv_rows<8>(P, t0 + 8 * rs, C_X + h * 64 + 32 * ph + 8 * cg, cw, cb, h * 64 + 32 * ph + 8 * cg, o);
#pragma unroll
              for (int q = 0; q < 8; ++q) { float v[8] = {o[0][q], o[1][q], o[2][q], o[3][q], o[4][q], o[5][q], o[6][q], o[7][q]};
                  *(LAS bf16x8*)(sXT + (8 * cg + q) * 136 + 8 * rs) = pack8(v); } }
            asm volatile("s_waitcnt lgkmcnt(0)" ::: "memory");
            f32x4 acc[2][8];
#pragma unroll
            for (int nt = 0; nt < 8; ++nt) { acc[0][nt] = (f32x4){0.f, 0.f, 0.f, 0.f}; acc[1][nt] = (f32x4){0.f, 0.f, 0.f, 0.f}; }
#pragma unroll
            for (int nt = 0; nt < 8; ++nt) {
#pragma unroll
                for (int sn = 0; sn < 4; ++sn) { const bf16x8 cf = *(const LAS bf16x8*)(sC + (16 * nt + fr) * 136 + 32 * sn + 8 * kg);
                    acc[0][nt] = MFMA16(pf[sn][0], cf, acc[0][nt]); acc[1][nt] = MFMA16(pf[sn][1], cf, acc[1][nt]); }
                const float sc = __expf(sACS[16 * nt + fr]);
                acc[0][nt] *= sc; acc[1][nt] *= sc; }
#pragma unroll
            for (int sk = 0; sk < 4; ++sk) {
                const int s0 = 32 * sk + 8 * kg;
                const bf16x8 xa0 = *(const LAS bf16x8*)(sXT + fr * 136 + s0), xa1 = *(const LAS bf16x8*)(sXT + (16 + fr) * 136 + s0);
                const f32x4 as0 = *(const LAS f32x4*)(sACS + s0), as1 = *(const LAS f32x4*)(sACS + s0 + 4), d0 = *(const LAS f32x4*)(sDT + s0), d1 = *(const LAS f32x4*)(sDT + s0 + 4);
#pragma unroll
                for (int nt = 0; nt < 8; ++nt) if (nt >= 2 * sk) { const int l = 16 * nt + fr; const float acsl = sACS[l];
                    float cbv[8]; unpack8(*(const LAS u32x4*)(sCB + l * 136 + s0), cbv);
                    float m[8];
#pragma unroll
                    for (int i = 0; i < 8; ++i) { const int s = s0 + i; const float as = i < 4 ? as0[i & 3] : as1[i & 3], ds = i < 4 ? d0[i & 3] : d1[i & 3];
                        float mv = (s <= l) ? cbv[i] * __expf(acsl - as) * ds : 0.f; if (s == l) mv += Dh; m[i] = mv; }
                    const bf16x8 mb = pack8(m);
                    acc[0][nt] = MFMA16(xa0, mb, acc[0][nt]); acc[1][nt] = MFMA16(xa1, mb, acc[1][nt]);
                    asm volatile("" ::: "memory"); }
            }
            u32x2 zall[8][2];
#pragma unroll
            for (int nt = 0; nt < 8; ++nt)
#pragma unroll
                for (int mt = 0; mt < 2; ++mt) zall[nt][mt] = *(const u32x2*)(P + (zb + (unsigned)(16 * nt * LD + 16 * mt)));
#pragma unroll
            for (int nt = 0; nt < 8; ++nt)
#pragma unroll
                for (int mt = 0; mt < 2; ++mt) { u32x2* zp = (u32x2*)(P + (zb + (unsigned)(16 * nt * LD + 16 * mt)));
                    const u32x2 zw = zall[nt][mt]; float y[4];
                    y[0] = acc[mt][nt][0] * siluf_(__uint_as_float(zw.x << 16)); y[1] = acc[mt][nt][1] * siluf_(__uint_as_float(zw.x & 0xffff0000u));
                    y[2] = acc[mt][nt][2] * siluf_(__uint_as_float(zw.y << 16)); y[3] = acc[mt][nt][3] * siluf_(__uint_as_float(zw.y & 0xffff0000u));
                    ssq[nt] += (y[0] * y[0] + y[1] * y[1]) + (y[2] * y[2] + y[3] * y[3]);
                    u32x2 yw; yw.x = pk2(y[0], y[1]); yw.y = pk2(y[2], y[3]); (void)zp; *(LAS u32x2*)(sXT + (16 * nt + fr) * 32 + 16 * mt + 4 * kg) = yw; }
            asm volatile("s_waitcnt lgkmcnt(0)" ::: "memory");
            { const int rr = lane >> 2, cc = lane & 3;
              unsigned so = (unsigned)((t0 + rr) * LD + C_Z + h * 64 + 32 * ph + 8 * cc); asm volatile("" : "+v"(so));
              if (ph == 0) {
#pragma unroll
                  for (int i = 0; i < 8; ++i) { const u32x4 w = *(const LAS u32x4*)(sXT + (16 * i + rr) * 32 + 8 * cc); if (!dry) *(u32x4*)(P + (so + (unsigned)(16 * i * LD))) = w; } } }
            asm volatile("s_waitcnt lgkmcnt(0)" ::: "memory");
        }
        MSTAMP(p, 2);
#pragma unroll
        for (int nt = 0; nt < 8; ++nt) { float v = ssq[nt]; v += __shfl_xor(v, 16); v += __shfl_xor(v, 32); if (kg == 0) sSSQ[wave * 128 + 16 * nt + fr] = v; }
        __syncthreads();
        { const int rr = lane >> 2, cc = lane & 3;
          const float* ng = opq(p.ssd_norm_g) + g * 512 + wave * 64 + 8 * cc;
          f32x4 gg[2][2];
#pragma unroll
          for (int ph = 0; ph < 2; ++ph) { gg[ph][0] = *(const f32x4*)(ng + 32 * ph); gg[ph][1] = *(const f32x4*)(ng + 32 * ph + 4); }
          unsigned so = (unsigned)((t0 + rr) * LD + C_Z + h * 64 + 8 * cc); asm volatile("" : "+v"(so));
          u32x4 yv[8][2];
#pragma unroll
          for (int i = 0; i < 8; ++i)
#pragma unroll
              for (int ph = 0; ph < 2; ++ph) yv[i][ph] = ph == 0 ? *(const u32x4*)(P + (so + (unsigned)(16 * i * LD))) : *(const LAS u32x4*)(sXT + (16 * i + rr) * 32 + 8 * cc);
#pragma unroll
          for (int i = 0; i < 8; ++i) { const int l = 16 * i + rr; float tot = 0.f;
#pragma unroll
              for (int w2 = 0; w2 < 8; ++w2) tot += sSSQ[w2 * 128 + l];
              const float rs = 1.f / sqrtf(tot * (1.f / 512.f) + EPS);
#pragma unroll
              for (int ph = 0; ph < 2; ++ph) { float v[8]; unpack8(yv[i][ph], v);
                  v[0] *= rs * gg[ph][0][0]; v[1] *= rs * gg[ph][0][1]; v[2] *= rs * gg[ph][0][2]; v[3] *= rs * gg[ph][0][3];
                  v[4] *= rs * gg[ph][1][0]; v[5] *= rs * gg[ph][1][1]; v[6] *= rs * gg[ph][1][2]; v[7] *= rs * gg[ph][1][3];
                  if (!dry) *(bf16x8*)(P + (so + (unsigned)(16 * i * LD + 32 * ph))) = pack8(v); } } }
        MSTAMP(p, 3);
    }
}
#define XB_TMO      128
#define XB_XCNT(j)  (256  + 64 * (j))
#define XB_XSUB(j)  (1280 + 64 * (j))
#define XB_XGEN(j)  (2304 + 64 * (j))
#define XB_TOP      3328
#define XB_TOPGEN   3392
#define XCD_BAR_WORDS 3456
#define XB_SPIN_CAP (1u << 18)

__device__ __forceinline__ unsigned xb_ld(unsigned* p)              { return __hip_atomic_load(p, __ATOMIC_RELAXED, __HIP_MEMORY_SCOPE_AGENT); }
__device__ __forceinline__ unsigned xb_add(unsigned* p, unsigned v) { return __hip_atomic_fetch_add(p, v, __ATOMIC_RELAXED, __HIP_MEMORY_SCOPE_AGENT); }
__device__ __forceinline__ unsigned xb_xcc_id() { return (unsigned)__builtin_amdgcn_s_getreg((3 << 11) | 20) & 0xFu; }
#define XB_SPIN(cond, bar) do { unsigned _sp = 0; while (cond) { __builtin_amdgcn_s_sleep(1); \
    if ((++_sp & 255u) == 0u) { if (xb_ld(&(bar)[XB_TMO])) break; if (_sp > XB_SPIN_CAP) { atomicAdd(&(bar)[XB_TMO], 1u); break; } } } } while (0)

struct XcdBarrier {
    unsigned* bar; unsigned x;
    volatile LAS unsigned* st;
};

__device__ __forceinline__ XcdBarrier xcd_barrier_post(unsigned* bar, volatile LAS unsigned* st) {
    XcdBarrier b; b.bar = bar; b.x = xb_xcc_id(); b.st = st;
    if (threadIdx.x == 0) (void)xb_add(&bar[XB_XCNT(b.x)], 1u);
    return b;
}
__device__ __forceinline__ void xcd_barrier_complete(unsigned* bar, unsigned x, unsigned& nloc, unsigned& nx) {
    const unsigned G = gridDim.x * gridDim.y * gridDim.z;
    unsigned sum, cnt, mine, sp = 0u;
    for (;;) {
        sum = 0u; cnt = 0u; mine = 0u;
#pragma unroll
        for (unsigned j = 0; j < 16; ++j) { const unsigned c = xb_ld(&bar[XB_XCNT(j)]); sum += c; cnt += (c > 0u) ? 1u : 0u; mine = (j == x) ? c : mine; }
        if (sum == G) break;
        __builtin_amdgcn_s_sleep(1);
        if ((++sp & 255u) == 0u) { if (xb_ld(&bar[XB_TMO])) break; if (sp > XB_SPIN_CAP) { atomicAdd(&bar[XB_TMO], 1u); break; } }
    }
    nloc = mine > 0u ? mine : 1u; nx = cnt > 0u ? cnt : 1u;
}

__device__ __forceinline__ void xcd_barrier(const XcdBarrier& b) {
    asm volatile("s_waitcnt vmcnt(0)" ::: "memory");
    __syncthreads();
    if (threadIdx.x == 0) {
        unsigned* bar = b.bar; asm volatile("" : "+s"(bar));
        unsigned bx = b.x; asm volatile("" : "+s"(bx));
        __builtin_amdgcn_s_waitcnt(0);
        unsigned nloc = b.st[0], nx = b.st[1];
        if (nloc == 0u) { xcd_barrier_complete(bar, bx, nloc, nx); b.st[0] = nloc; b.st[1] = nx; }
        const unsigned old = xb_add(&bar[XB_XSUB(bx)], 1u);
        const unsigned gen = old / nloc;
        if (old + 1u == (gen + 1u) * nloc) {
            __builtin_amdgcn_fence(__ATOMIC_RELEASE, "agent");
            asm volatile("s_waitcnt vmcnt(0)" ::: "memory");
            const unsigned og = xb_add(&bar[XB_TOP], 1u);
            const unsigned tg = og / nx;
            if (og + 1u == (tg + 1u) * nx) xb_add(&bar[XB_TOPGEN], 1u);
            else XB_SPIN(xb_ld(&bar[XB_TOPGEN]) == tg, bar);
            __builtin_amdgcn_fence(__ATOMIC_ACQUIRE, "agent");
            xb_add(&bar[XB_XGEN(bx)], 1u);
            asm volatile("s_waitcnt vmcnt(0)" ::: "memory");
        } else {
            XB_SPIN(xb_ld(&bar[XB_XGEN(bx)]) == gen, bar);
            __builtin_amdgcn_fence(__ATOMIC_ACQUIRE, "agent");
            asm volatile("s_waitcnt vmcnt(0)" ::: "memory");
        }
    }
    __syncthreads();
}

#ifdef REP_COLD
#define REP_SEP() xcd_barrier(bar)
#else
#define REP_SEP() __syncthreads()
#endif
#define RUNP(n, ...) do { if ((n) > 1) { for (int r_ = nrep(n) - 1; r_ > 0; --r_) { const int dry_ = 1; (void)dry_; __VA_ARGS__; REP_SEP(); } } { const int dry_ = 0; (void)dry_; __VA_ARGS__; } } while (0)
#ifndef REP_SYNC
#define REP_SYNC 1
#endif
#ifndef REP_P0
#define REP_P0 1
#endif
#ifndef REP_P1
#define REP_P1 1
#endif
#ifndef REP_P5
#define REP_P5 1
#endif
#ifndef REP_P6
#define REP_P6 1
#endif
#ifndef REP_ST
#define REP_ST 1
#endif
#ifndef REP_LA
#define REP_LA 1
#endif
#ifndef REP_AT
#define REP_AT 1
#endif
#ifndef REP_SC
#define REP_SC 1
#endif
#ifndef REP_SO
#define REP_SO 1
#endif
#ifndef REP_LF
#define REP_LF 1
#endif
__device__ __forceinline__ int nrep(int n) { asm volatile("" : "+s"(n)); return n; }
__device__ __forceinline__ LAS unsigned char* opl(LAS unsigned char* q) { asm volatile("" : "+s"(q)); return q; }
__global__ void __launch_bounds__(512) mk(Params p) {
    extern __shared__ __attribute__((aligned(16))) unsigned char lds_raw[];
    LAS unsigned char* lds = (LAS unsigned char*)lds_raw;
    if (threadIdx.x < 4) ((volatile LAS unsigned*)(lds + LDS_BYTES - 16))[threadIdx.x] = 0u;
    __syncthreads();
    const XcdBarrier bar = xcd_barrier_post((unsigned*)(p.ws + WS_CTL), (volatile LAS unsigned*)(lds + LDS_BYTES - 16));
    if (p.hi > 1000) cg::this_grid().sync();
#ifdef PROBE_SPAN
    unsigned long long ts0 = 0, ts1 = 0;
#define STAMP(i) do { if ((i) == PROBE_SPAN) ts0 = __builtin_amdgcn_s_memrealtime(); if ((i) == PROBE_SPAN + PROBE_LEN) ts1 = __builtin_amdgcn_s_memrealtime(); } while (0)
#else
#define STAMP(i) do { } while (0)
#endif
    STAMP(0);
    RUNP(REP_P0, phase0(p, opl(lds)));
    xcd_barrier(bar); STAMP(1);
#define BATCH_PHASES(b) do { \
        RUNP(REP_P1, phase1_gemm(p, b, opl(lds))); \
        for (int r = 0; r < nrep(REP_SYNC); ++r) xcd_barrier(bar); \
        STAMP(2 + 6 * b); \
        RUNP(REP_ST, ssd_states_phase(p, b, opl(lds))); \
        __syncthreads(); STAMP(20 + 3 * b); \
        RUNP(REP_LA, lru_phase<false>(p, b, opl(lds), 0)); \
        __syncthreads(); STAMP(21 + 3 * b); \
        RUNP(REP_AT, attn_phase(p, b, opl(lds), dry_)); \
        xcd_barrier(bar); STAMP(3 + 6 * b); \
        RUNP(REP_SC, ssd_scan_phase(p, b, dry_)); \
        lru_carry_phase(p, b); \
        xcd_barrier(bar); STAMP(4 + 6 * b); \
        RUNP(REP_SO, ssd_out_phase(p, b, opl(lds), dry_)); \
        __syncthreads(); STAMP(22 + 3 * b); \
        RUNP(REP_LF, lru_phase<true>(p, b, opl(lds), dry_)); \
        xcd_barrier(bar); STAMP(5 + 6 * b); \
        RUNP(REP_P5, phase5_gemm(p, b, opl(lds))); \
        xcd_barrier(bar); STAMP(6 + 6 * b); \
        RUNP(REP_P6, phase6_gemm(p, b, opl(lds))); \
        if (b + 1 < NBATCH) xcd_barrier(bar); \
        STAMP(7 + 6 * b); \
    } while (0)
    BATCH_PHASES(0);
    BATCH_PHASES(1);
#ifdef PROBE_MA
    if (blockIdx.x == 0 && threadIdx.x == 0) { const unsigned long long* tsm = (const unsigned long long*)(p.ws + 255 * MiB); const unsigned long long t2 = __builtin_amdgcn_s_memrealtime(), want = 8ull * (tsm[PROBE_MB] - tsm[PROBE_MA]);
        while (__builtin_amdgcn_s_memrealtime() - t2 < want) __builtin_amdgcn_s_sleep(16); }
#endif
#ifdef PROBE_SPAN
    if (blockIdx.x == 0 && threadIdx.x == 0) { const unsigned long long t2 = __builtin_amdgcn_s_memrealtime(), want = 8ull * (ts1 - ts0);
        while (__builtin_amdgcn_s_memrealtime() - t2 < want) __builtin_amdgcn_s_sleep(16); }
#endif
}

static void launch_mk(Params& p, int lo, int hi, int grid, hipStream_t stream) {
    p.lo = lo; p.hi = hi; void* args[] = {&p};
    (void)hipMemsetAsync(p.ws + WS_CTL, 0, 65536, stream);
    hipError_t e = hipLaunchCooperativeKernel((const void*)mk, dim3(grid), dim3(512), args, LDS_BYTES, stream);
    if (e != hipSuccess) fprintf(stderr, "cooperative launch failed: %s (grid %d)\n", hipGetErrorString(e), grid);
}
extern "C" void kernel_launch(void* const* d_in, const int* in_sizes, int n_in, void* d_out, int out_size, void* d_ws, size_t ws_size, hipStream_t stream) {
    static int grid = 0;
    if (grid == 0) {
        if (n_in != 24 || out_size != MTOK * DM || ws_size < WS_END) { fprintf(stderr, "kernel_launch: unexpected shapes (n_in %d out %d ws %zu)\n", n_in, out_size, ws_size); grid = -1; return; }
        int dev = 0, cus = 0, per_cu = 0;
        hipGetDevice(&dev); hipDeviceGetAttribute(&cus, hipDeviceAttributeMultiprocessorCount, dev);
        hipFuncSetAttribute((const void*)mk, hipFuncAttributeMaxDynamicSharedMemorySize, LDS_BYTES);
        hipOccupancyMaxActiveBlocksPerMultiprocessor(&per_cu, (const void*)mk, 512, LDS_BYTES);
        if (per_cu < 1) { fprintf(stderr, "kernel_launch: occupancy query says %d blocks/CU\n", per_cu); per_cu = 1; }
        grid = cus * 1;
        (void)hipGetLastError();
    }
    if (grid < 0) return;
    Params p{};
    const float** f = (const float**)&p;
    for (int i = 0; i < 24; ++i) f[i] = (const float*)d_in[i];
    p.out = (float*)d_out; p.ws = (unsigned char*)d_ws;
    launch_mk(p, 0, 14, grid, stream);
}
```

```cpp
#define NAIVE_GEMM 0
#define NAIVE_ATT 0
#define NAIVE_LRU 0
#define NAIVE_SSD 0
#define ONE_LAUNCH 1

#include <hip/hip_runtime.h>
#include <hip/hip_cooperative_groups.h>
#include <cstdio>
#include <cstdint>
namespace cg = cooperative_groups;

#ifndef NAIVE_GEMM
#define NAIVE_GEMM 1
#endif
#ifndef NAIVE_SSD
#define NAIVE_SSD 1
#endif
#ifndef NAIVE_LRU
#define NAIVE_LRU 1
#endif
#ifndef NAIVE_ATT
#define NAIVE_ATT 1
#endif
#ifndef ONE_LAUNCH
#define ONE_LAUNCH 0
#endif

namespace pg8 {
#define PG8_LAS __attribute__((address_space(3)))
typedef unsigned short bf16_t;
typedef short bf16x8 __attribute__((ext_vector_type(8)));
typedef float f32x4 __attribute__((ext_vector_type(4)));
typedef unsigned u32x4 __attribute__((ext_vector_type(4)));
constexpr int BM = 256, BK = 64, HALF = 128, HTB = HALF * BK * 2  , STAGE_BYTES = 8 * HTB, NXCD = 8, WGM = 8;

__host__ __device__ __forceinline__ int lds_byte(int r, int c) { const int st = (r >> 4) * 2 + (c >> 5), rr = r & 15, cc = c & 31, ob = rr * 64 + cc * 2; return st * 1024 + (ob ^ (((ob >> 9) & 1) << 5)); }
__host__ __device__ __forceinline__ void stage_rc(int b, int& R, int& C) { const int st = b / 1024, sb = b % 1024, swz = sb ^ (((sb >> 9) & 1) << 5); R = (st >> 1) * 16 + swz / 64; C = (st & 1) * 32 + (swz % 64) / 2; }
__host__ __device__ __forceinline__ int perm32(int rho) { const int n = rho >> 4, i = rho & 15; return 8 * (i >> 2) + 4 * n + (i & 3); }

struct Unit { int pm, pn; };
struct Gemm { const bf16_t* A; const bf16_t* Bt; int M, N, K, lda, ldb; };

struct StaticOrder {
    int nM, nN, nwg, G, c;
    __host__ __device__ void init(int M, int N, int G_, int c_) { nM = M / BM; nN = N / BM; nwg = nM * nN; G = G_; c = c_; }
    __host__ __device__ bool next(int i, Unit& u) const {
        const long L = (long)i * G + c; if (L >= nwg) return false;
        int wgid = (int)L; { const int q = nwg / NXCD, r = nwg % NXCD, xcd = wgid % NXCD, off = wgid / NXCD; wgid = (xcd < r ? xcd * (q + 1) : r * (q + 1) + (xcd - r) * q) + off; }
        const int nig = WGM * nN, gid = wgid / nig, fm = gid * WGM, gsz = (nM - fm) < WGM ? (nM - fm) : WGM;
        u.pm = fm + ((wgid % nig) % gsz); u.pn = (wgid % nig) / gsz; return true;
    }
    __device__ __forceinline__ void a_ready(const Unit&) const {}
    __device__ __forceinline__ void done(const Unit&) const {}
};

__device__ __forceinline__ unsigned cvt_pk_bf16(float lo, float hi) { unsigned r; asm volatile("v_cvt_pk_bf16_f32 %0, %1, %2" : "=v"(r) : "v"(lo), "v"(hi)); return r; }
typedef float f32x2 __attribute__((ext_vector_type(2)));
__device__ __forceinline__ f32x2 gelu_pk(f32x2 v) {
    const f32x2 av = __builtin_elementwise_abs(v), d = av * 0.2316418882f + 1.0f;
    f32x2 t; t.x = __builtin_amdgcn_rcpf(d.x); t.y = __builtin_amdgcn_rcpf(d.y);
    f32x2 q = t * 0.5307027145f + (-0.7265760135f); q = q * t + 0.7107068705f; q = q * t + (-0.142248368f); q = q * t + 0.127414796f; q = q * t;
    const f32x2 s = (v * v) * (-0.72134752044f);
    f32x2 e; e.x = __builtin_amdgcn_exp2f(s.x); e.y = __builtin_amdgcn_exp2f(s.y);
    const f32x2 m = v * (q * e), r = v - m;
    f32x2 o; o.x = v.x < 0.f ? m.x : r.x; o.y = v.y < 0.f ? m.y : r.y; return o;
}

template <int ACT  > struct EpiBf16 {
    static constexpr bool PERM = true, AFTER_DRAIN = false; static_assert(ACT == 0 || ACT == 1, "EpiBf16: ACT is 0 (none) or 1 (gelu_pk)");
    bf16_t* O; int ldc; const float* bias; int split_cols; size_t split_stride; float scale0;
    __device__ __forceinline__ void operator()(const f32x4 (&acc)[2][2][4][2], const Unit& u, int wr, int wc, int fr, int fq) const {
        const int row0 = u.pm * BM + wr * 64 + fr; int colt = u.pn * BM; bf16_t* base = O;
        float sc = 1.f; if (split_cols) { const int t = colt / split_cols; base += (size_t)t * split_stride; colt -= t * split_cols; if (t == 0) sc = scale0; }
        const int col0 = colt + wc * 32 + 8 * fq, bcol0 = u.pn * BM + wc * 32 + 8 * fq;
        f32x4 bv[2][2];
#pragma unroll
        for (int bj = 0; bj < 2; ++bj)
#pragma unroll
            for (int n = 0; n < 2; ++n) bv[bj][n] = bias ? *(const f32x4*)(bias + bcol0 + bj * HALF + 4 * n) : (f32x4){0.f, 0.f, 0.f, 0.f};
#pragma unroll
        for (int ai = 0; ai < 2; ++ai)
#pragma unroll
            for (int m = 0; m < 4; ++m) { bf16_t* rowp = base + (size_t)(row0 + ai * HALF + m * 16) * ldc + col0;
#pragma unroll
                for (int bj = 0; bj < 2; ++bj) { f32x4 v0 = acc[ai][bj][m][0] + bv[bj][0], v1 = acc[ai][bj][m][1] + bv[bj][1];
                    if (ACT == 1) { f32x2 a = gelu_pk((f32x2){v0[0], v0[1]}), b = gelu_pk((f32x2){v0[2], v0[3]}), c = gelu_pk((f32x2){v1[0], v1[1]}), d = gelu_pk((f32x2){v1[2], v1[3]});
                        v0 = (f32x4){a.x, a.y, b.x, b.y}; v1 = (f32x4){c.x, c.y, d.x, d.y}; }
                    v0 = v0 * sc; v1 = v1 * sc; u32x4 w; w.x = cvt_pk_bf16(v0[0], v0[1]); w.y = cvt_pk_bf16(v0[2], v0[3]); w.z = cvt_pk_bf16(v1[0], v1[1]); w.w = cvt_pk_bf16(v1[2], v1[3]);
                    *(u32x4*)(rowp + bj * HALF) = w; } }
    }
};
template <class Epi, class Sched, bool ALIGN_EPI = false, bool SP2 = false>
__device__ __forceinline__ void gemm_phase(PG8_LAS unsigned char* lds, const Gemm g, const Sched& S, const Epi& E) {
    int tid_ = threadIdx.x; asm volatile("" : "+v"(tid_));
    const int tid = tid_, wid = __builtin_amdgcn_readfirstlane(tid >> 6), lane = tid & 63, wr = wid >> 2, wc = wid & 3, fr = lane & 15, fq = lane >> 4;
    const int K = g.K, nt = K / BK;
    unsigned voffA[2], voffB[2];
#pragma unroll
    for (int i = 0; i < 2; ++i) { int R, C; stage_rc(tid * 16 + i * 8192, R, C); const int Rb = Epi::PERM ? ((R & ~31) + perm32(R & 31)) : R;
        voffA[i] = (unsigned)(R * g.lda + C) * 2u; voffB[i] = (unsigned)(Rb * g.ldb + C) * 2u; }
    const size_t kstep = (size_t)(BK * 2);
    const size_t hstepA = (size_t)HALF * g.lda * 2, hstepB = (size_t)HALF * g.ldb * 2;
    const size_t tstepA = 2 * hstepA, tstepB = 2 * hstepB;
    const unsigned ldsw = (unsigned)wid * 1024u;
    const int aoff = lds_byte(wr * 64 + fr, fq * 8), boff = lds_byte(wc * 32 + fr, fq * 8);
#define PG8_SA(b, h) (((b) * 2 + (h)) * HTB)
#define PG8_SB(b, h) ((4 + (b) * 2 + (h)) * HTB)
#define PG8_STAGE(bufoff, gbase, voff) do { _Pragma("unroll") for (int _i = 0; _i < 2; ++_i) \
        __builtin_amdgcn_global_load_lds((const unsigned*)((const char*)(gbase) + (voff)[_i]), (PG8_LAS unsigned*)(lds + (bufoff) + ldsw + _i * 8192), 16, 0, 0); } while (0)
#define PG8_LDA(dst, b, h) do { _Pragma("unroll") for (int m = 0; m < 4; ++m) _Pragma("unroll") for (int k = 0; k < 2; ++k) dst[m][k] = *(const PG8_LAS bf16x8*)(lds + PG8_SA(b, h) + aoff + m * 2048 + k * 1024); } while (0)
#define PG8_LDB(dst, b, h) do { _Pragma("unroll") for (int n = 0; n < 2; ++n) _Pragma("unroll") for (int k = 0; k < 2; ++k) dst[n][k] = *(const PG8_LAS bf16x8*)(lds + PG8_SB(b, h) + boff + n * 2048 + k * 1024); } while (0)
#define PG8_MMA(ai, bj, At, Bt) do { __builtin_amdgcn_s_setprio(1); _Pragma("unroll") for (int m = 0; m < 4; ++m) _Pragma("unroll") for (int n = 0; n < 2; ++n) _Pragma("unroll") for (int k = 0; k < 2; ++k) \
        acc[ai][bj][m][n] = __builtin_amdgcn_mfma_f32_16x16x32_bf16(Bt[n][k], At[m][k], acc[ai][bj][m][n], 0, 0, 0); __builtin_amdgcn_s_setprio(0); } while (0)
#define PG8_WAIT_V(n) asm volatile("s_waitcnt vmcnt(" #n ")" ::: "memory")
#define PG8_WAIT_L(n) asm volatile("s_waitcnt lgkmcnt(" #n ")" ::: "memory")
#define PG8_BAR __builtin_amdgcn_s_barrier()
#define PG8_SCHED __builtin_amdgcn_sched_barrier(0)
    Unit cur, nxt; int ui = 0;
    if (!S.next(0, cur)) return;
    f32x4 acc[2][2][4][2];
#pragma unroll
    for (int a = 0; a < 2; ++a)
#pragma unroll
        for (int b = 0; b < 2; ++b)
#pragma unroll
            for (int m = 0; m < 4; ++m)
#pragma unroll
                for (int n = 0; n < 2; ++n) acc[a][b][m][n] = (f32x4){0.f, 0.f, 0.f, 0.f};
    bf16x8 At[4][2], B0[2][2], B1[2][2];
    const char* cA = (const char*)g.A + (size_t)cur.pm * tstepA; const char* cB = (const char*)g.Bt + (size_t)cur.pn * tstepB;
    S.a_ready(cur);
    if constexpr (SP2) {
        PG8_STAGE(PG8_SB(0, 0), cB, voffB); PG8_STAGE(PG8_SB(0, 1), cB + hstepB, voffB); PG8_STAGE(PG8_SA(0, 0), cA, voffA); PG8_STAGE(PG8_SA(0, 1), cA + hstepA, voffA);
        if (wr == 1) PG8_BAR;
        PG8_WAIT_V(2); PG8_BAR;
        PG8_STAGE(PG8_SB(1, 0), cB + kstep, voffB); PG8_STAGE(PG8_SA(1, 0), cA + kstep, voffA); PG8_STAGE(PG8_SB(1, 1), cB + hstepB + kstep, voffB);
        PG8_WAIT_V(6); PG8_BAR;
    } else {
        PG8_STAGE(PG8_SB(0, 0), cB, voffB); PG8_STAGE(PG8_SA(0, 0), cA, voffA); PG8_STAGE(PG8_SB(0, 1), cB + hstepB, voffB); PG8_STAGE(PG8_SA(0, 1), cA + hstepA, voffA);
        if (wr == 1) PG8_BAR;
        PG8_WAIT_V(4); PG8_BAR;
        PG8_STAGE(PG8_SB(1, 0), cB + kstep, voffB); PG8_STAGE(PG8_SA(1, 0), cA + kstep, voffA); PG8_STAGE(PG8_SB(1, 1), cB + hstepB + kstep, voffB);
        PG8_WAIT_V(6); PG8_BAR;
    }
    for (;;) {
        const bool has_next = S.next(ui + 1, nxt);
        const char* nA = has_next ? (const char*)g.A + (size_t)nxt.pm * tstepA : cA; const char* nB = has_next ? (const char*)g.Bt + (size_t)nxt.pn * tstepB : cB;
        for (int t = 0; t < nt; t += 2) {
            const bool last = (t == nt - 2);
            const char* a1 = cA + (size_t)(t + 1) * kstep;
            const char* a2 = last ? nA : cA + (size_t)(t + 2) * kstep; const char* b2 = last ? nB : cB + (size_t)(t + 2) * kstep;
            const char* a3 = a2 + kstep; const char* b3 = b2 + kstep;
            if (last && has_next) S.a_ready(nxt);
            if constexpr (SP2) {
            PG8_LDB(B0, 0, 0); PG8_LDB(B1, 0, 1); PG8_SCHED; PG8_LDA(At, 0, 0); PG8_STAGE(PG8_SA(1, 1), a1 + hstepA, voffA);
            PG8_WAIT_V(8); PG8_WAIT_L(0); PG8_BAR; PG8_MMA(0, 0, At, B0); PG8_MMA(0, 1, At, B1); PG8_BAR; PG8_SCHED;
            PG8_LDA(At, 0, 1); PG8_STAGE(PG8_SB(0, 0), b2, voffB); PG8_STAGE(PG8_SB(0, 1), b2 + hstepB, voffB); PG8_STAGE(PG8_SA(0, 0), a2, voffA);
            PG8_WAIT_V(8); PG8_WAIT_L(0); PG8_BAR; PG8_MMA(1, 0, At, B0); PG8_MMA(1, 1, At, B1); PG8_BAR; PG8_SCHED;
            PG8_LDB(B0, 1, 0); PG8_LDB(B1, 1, 1); PG8_SCHED; PG8_LDA(At, 1, 0); PG8_STAGE(PG8_SA(0, 1), a2 + hstepA, voffA);
            PG8_WAIT_V(8); PG8_WAIT_L(0); PG8_BAR; PG8_MMA(0, 0, At, B0); PG8_MMA(0, 1, At, B1); PG8_BAR; PG8_SCHED;
            PG8_LDA(At, 1, 1); PG8_STAGE(PG8_SB(1, 0), b3, voffB); PG8_STAGE(PG8_SB(1, 1), b3 + hstepB, voffB); PG8_STAGE(PG8_SA(1, 0), a3, voffA);
            PG8_WAIT_V(8); PG8_WAIT_L(0); PG8_BAR; PG8_MMA(1, 0, At, B0); PG8_MMA(1, 1, At, B1); PG8_BAR; PG8_SCHED;
            } else {
            PG8_LDB(B0, 0, 0); PG8_SCHED; PG8_LDA(At, 0, 0); PG8_STAGE(PG8_SA(1, 1), a1 + hstepA, voffA);
            PG8_WAIT_L(8); PG8_BAR; PG8_WAIT_L(0); PG8_MMA(0, 0, At, B0); PG8_BAR; PG8_SCHED;
            PG8_LDB(B1, 0, 1); PG8_STAGE(PG8_SB(0, 0), b2, voffB);
            PG8_BAR; PG8_WAIT_L(0); PG8_MMA(0, 1, At, B1); PG8_BAR;
            PG8_LDA(At, 0, 1); PG8_STAGE(PG8_SA(0, 0), a2, voffA);
            PG8_BAR; PG8_WAIT_L(0); PG8_MMA(1, 0, At, B0); PG8_BAR; PG8_SCHED;
            PG8_STAGE(PG8_SB(0, 1), b2 + hstepB, voffB);
            PG8_WAIT_V(6); PG8_BAR; PG8_MMA(1, 1, At, B1); PG8_BAR;
            PG8_LDB(B0, 1, 0); PG8_SCHED; PG8_LDA(At, 1, 0); PG8_STAGE(PG8_SA(0, 1), a2 + hstepA, voffA);
            PG8_WAIT_L(8); PG8_BAR; PG8_WAIT_L(0); PG8_MMA(0, 0, At, B0); PG8_BAR; PG8_SCHED;
            PG8_LDB(B1, 1, 1); PG8_STAGE(PG8_SB(1, 0), b3, voffB);
            PG8_BAR; PG8_WAIT_L(0); PG8_MMA(0, 1, At, B1); PG8_BAR;
            PG8_LDA(At, 1, 1); PG8_STAGE(PG8_SA(1, 0), a3, voffA);
            PG8_BAR; PG8_WAIT_L(0); PG8_MMA(1, 0, At, B0); PG8_BAR; PG8_SCHED;
            PG8_STAGE(PG8_SB(1, 1), b3 + hstepB, voffB);
            PG8_WAIT_V(6); PG8_BAR; PG8_MMA(1, 1, At, B1); PG8_BAR;
            }
        }
        if constexpr (ALIGN_EPI) { if (wr == 0) PG8_BAR; }
        if constexpr (!Epi::AFTER_DRAIN) { E(acc, cur, wr, wc, fr, fq); S.done(cur); }
        if (!has_next) break;
#pragma unroll
        for (int a = 0; a < 2; ++a)
#pragma unroll
            for (int b = 0; b < 2; ++b)
#pragma unroll
                for (int m = 0; m < 4; ++m)
#pragma unroll
                    for (int n = 0; n < 2; ++n) acc[a][b][m][n] = (f32x4){0.f, 0.f, 0.f, 0.f};
        cur = nxt; cA = nA; cB = nB; ++ui;
        if constexpr (ALIGN_EPI) { if (wr == 1) PG8_BAR; }
    }
    PG8_WAIT_V(0);
    if constexpr (!ALIGN_EPI) { if (wr == 0) PG8_BAR; }
    PG8_BAR;
    if constexpr (Epi::AFTER_DRAIN) { E.fused(acc, cur, wr, wc, fr, fq, lds, wid, lane); S.done(cur); }
#undef PG8_SA
#undef PG8_SB
#undef PG8_STAGE
#undef PG8_LDA
#undef PG8_LDB
#undef PG8_MMA
#undef PG8_WAIT_V
#undef PG8_WAIT_L
#undef PG8_BAR
#undef PG8_SCHED
}
}

#define GAS __attribute__((address_space(1)))
#define LAS __attribute__((address_space(3)))
typedef unsigned short bf16_t;
typedef short bf16x8 __attribute__((ext_vector_type(8)));
typedef float f32x4 __attribute__((ext_vector_type(4)));
typedef unsigned u32x4 __attribute__((ext_vector_type(4)));
typedef unsigned u32x2 __attribute__((ext_vector_type(2)));

constexpr int DM = 1024, NBATCH = 2, SEQ = 8192, MEML = 256, MTOK = NBATCH * SEQ;
constexpr int INW = 12320, LD = 12544;
constexpr int C_Z = 0, C_X = 2048, C_B = 4096, C_C = 4608, C_LG = 5120, C_LX = 6656, C_Q = 8192, C_G = 9216, C_DT = 12288;
constexpr int C_MRG = 2048;
constexpr int NHEAD = 32, HDIM = 64, NGRP = 4, NSTATE = 128, CHUNK = 128, NCHUNK = SEQ / CHUNK;
constexpr int LRUW = 1536, LRUB = 96, NLB = 16, LSEG = 512, NSEG = SEQ / LSEG, NBLK64 = SEQ / 64;
constexpr float EPS = 1e-6f;
constexpr size_t MiB = 1u << 20;
constexpr size_t WS_WIN = 0, WS_WKV = 25 * MiB, WS_WSSD = 29 * MiB, WS_WLRU = 33 * MiB, WS_WMEM = 36 * MiB, WS_WOUT = 38 * MiB;
constexpr size_t WS_PROJ = 40 * MiB;
constexpr size_t WS_MEMN = 236 * MiB, WS_KVK = 237 * MiB, WS_KVVT = 238 * MiB, WS_LRUWA = 239 * MiB, WS_LRUWX = 239 * MiB + 512 * 1024;
constexpr size_t WS_DASUM = 240 * MiB;
constexpr size_t WS_LAGG = 246 * MiB;
constexpr size_t WS_LCAR = 250 * MiB;
constexpr size_t WS_CTL = 244 * MiB;
constexpr size_t WS_XBUF = 245 * MiB;
constexpr size_t WS_END = 256 * MiB;
static_assert(WS_PROJ + (size_t)SEQ * LD * 2 <= WS_MEMN, "ws map");
constexpr int LDS_BYTES = 155648;

struct Params {
    const float *x, *mem, *norm_g, *w_in, *ssd_conv_w, *ssd_conv_b, *ssd_dt_bias, *ssd_a_log, *ssd_d, *ssd_norm_g,
        *lru_conv_w, *lru_conv_b, *lru_w_a, *lru_b_a, *lru_w_x, *lru_b_x, *lru_lambda, *mem_norm_g, *w_kv,
        *w_br_ssd, *w_br_lru, *w_br_mem, *w_out, *final_g;
    float* out; unsigned char* ws;
    int lo, hi;
};

__device__ __forceinline__ float bf2f(bf16_t v) { return __uint_as_float((unsigned)v << 16); }
__device__ __forceinline__ unsigned f2bf(float f) { unsigned u = __float_as_uint(f); return (u + 0x7fffu + ((u >> 16) & 1u)) >> 16; }
__device__ __forceinline__ unsigned pk2(float lo, float hi) { return f2bf(lo) | (f2bf(hi) << 16); }
__device__ __forceinline__ float sigmoidf_(float v) { return __builtin_amdgcn_rcpf(1.f + __expf(-v)); }
__device__ __forceinline__ float siluf_(float v) { return v * __builtin_amdgcn_rcpf(1.f + __expf(-v)); }
__device__ __forceinline__ float softplusf_(float v) { const float e = __expf(v); const float sm = e * (1.f - e * (0.5f - e * 0.33333334f)); return v > 20.f ? v : (e < 1e-3f ? sm : __logf(1.f + e)); }
__device__ __forceinline__ float wave_sum(float v) {
#pragma unroll
    for (int o = 1; o < 64; o <<= 1) v += __shfl_xor(v, o);
    return v;
}
template <class T> __device__ __forceinline__ T* opq(T* q) { asm volatile("" : "+s"(q)); return q; }
__device__ __forceinline__ int opq_tid() { int t = threadIdx.x; asm volatile("" : "+v"(t)); return t; }
__device__ __forceinline__ int opq_bid() { int t = blockIdx.x; asm volatile("" : "+s"(t)); return t; }
__device__ __forceinline__ unsigned char* wsb(const Params& p) { return opq(p.ws); }
__device__ __forceinline__ bf16_t* proj_ptr(const Params& p) { return (bf16_t*)(wsb(p) + WS_PROJ); }
__device__ __forceinline__ bf16_t* xn_ptr(const Params& p) { return (bf16_t*)((unsigned char*)opq(p.out) + 32 * MiB); }
__device__ __forceinline__ bf16_t* states_ptr(const Params& p, int b) { return (bf16_t*)((unsigned char*)opq(p.out) + (size_t)b * 32 * MiB); }
__device__ __forceinline__ float* scr_ptr(const Params& p, int b) { return (float*)((unsigned char*)opq(p.out) + (size_t)b * 32 * MiB); }

#ifdef PROBE_MA
#define MSTAMP(p, i) do { if (blockIdx.x == 0 && threadIdx.x == 0) ((unsigned long long*)(wsb(p) + 255 * MiB))[i] = __builtin_amdgcn_s_memrealtime(); } while (0)
#else
#define MSTAMP(p, i) do { } while (0)
#endif
__device__ __forceinline__ void transpose_item(const float* W, int K, int Ns, int srccol0, bf16_t* WT, int dstrow0, LAS float* scr, int k0, int lane) {
    float wv[32];
#pragma unroll
    for (int i = 0; i < 32; ++i) wv[i] = W[(size_t)(k0 + 2 * i + (lane >> 5)) * Ns + srccol0 + (lane & 31)];
#pragma unroll
    for (int i = 0; i < 32; ++i) scr[(2 * i + (lane >> 5)) * 33 + (lane & 31)] = wv[i];
    asm volatile("s_waitcnt lgkmcnt(0)" ::: "memory");
    const int c = lane & 7;
#pragma unroll
    for (int j = 0; j < 4; ++j) { const int n = (lane >> 3) + 8 * j; const LAS float* s = scr + (8 * c) * 33 + n;
        u32x4 o; o.x = pk2(s[0 * 33], s[1 * 33]); o.y = pk2(s[2 * 33], s[3 * 33]); o.z = pk2(s[4 * 33], s[5 * 33]); o.w = pk2(s[6 * 33], s[7 * 33]);
        *(u32x4*)(WT + (size_t)(dstrow0 + n) * K + k0 + 8 * c) = o; }
    asm volatile("s_waitcnt lgkmcnt(0)" ::: "memory");
}
__device__ __forceinline__ void rms_row_to_bf16(const float* xrow, const float* g, bf16_t* orow, int lane) {
    const f32x4* xr = (const f32x4*)xrow + lane; const f32x4* gr = (const f32x4*)g + lane;
    f32x4 v[4]; float s = 0.f;
#pragma unroll
    for (int j = 0; j < 4; ++j) { v[j] = xr[64 * j]; s += (v[j].x * v[j].x + v[j].y * v[j].y) + (v[j].z * v[j].z + v[j].w * v[j].w); }
    const float rs = 1.f / sqrtf(wave_sum(s) * (1.f / DM) + EPS);
    unsigned long long* o8 = (unsigned long long*)orow + lane;
#pragma unroll
    for (int j = 0; j < 4; ++j) { const f32x4 gg = gr[64 * j];
        o8[64 * j] = (unsigned long long)pk2(v[j].x * rs * gg.x, v[j].y * rs * gg.y) | ((unsigned long long)pk2(v[j].z * rs * gg.z, v[j].w * rs * gg.w) << 32); }
}
__device__ __forceinline__ void phase0(const Params& p, LAS unsigned char* lds) {
    const int tid = opq_tid(), lane = tid & 63, wave = tid >> 6, bid = opq_bid();
    const int gw = bid * 8 + wave, NGW = gridDim.x * 8;
    LAS float* scr = (LAS float*)(lds + wave * 8704);
    bf16_t* Win = (bf16_t*)(wsb(p) + WS_WIN); bf16_t* Wkv = (bf16_t*)(wsb(p) + WS_WKV); bf16_t* Wssd = (bf16_t*)(wsb(p) + WS_WSSD);
    bf16_t* Wlru = (bf16_t*)(wsb(p) + WS_WLRU); bf16_t* Wmem = (bf16_t*)(wsb(p) + WS_WMEM); bf16_t* Wout = (bf16_t*)(wsb(p) + WS_WOUT);
    constexpr int I_IN = 16 * 385, I_KV = 16 * 64, I_SSD = 32 * 32, I_LRU = 24 * 32, I_MEM = 16 * 32, I_OUT = 16 * 32;
    constexpr int NITEMS = I_IN + I_KV + I_SSD + I_LRU + I_MEM + I_OUT;
    for (int it = gw; it < NITEMS; it += NGW) {
        int r = it;
        if (r < I_IN) { const int nb = r % 385, kb = r / 385; const int sc = 32 * nb; int dr;
            if (sc < 5120) dr = sc; else if (sc < 5152) dr = sc - 5120 + C_DT; else dr = sc - 32;
            transpose_item(opq(p.w_in), 1024, INW, sc, Win, dr, scr, 64 * kb, lane); continue; } r -= I_IN;
        if (r < I_KV) { transpose_item(opq(p.w_kv), 1024, 2048, 32 * (r % 64), Wkv, 32 * (r % 64), scr, 64 * (r / 64), lane); continue; } r -= I_KV;
        if (r < I_SSD) { transpose_item(opq(p.w_br_ssd), 2048, 1024, 32 * (r % 32), Wssd, 32 * (r % 32), scr, 64 * (r / 32), lane); continue; } r -= I_SSD;
        if (r < I_LRU) { transpose_item(opq(p.w_br_lru), 1536, 1024, 32 * (r % 32), Wlru, 32 * (r % 32), scr, 64 * (r / 32), lane); continue; } r -= I_LRU;
        if (r < I_MEM) { transpose_item(opq(p.w_br_mem), 1024, 1024, 32 * (r % 32), Wmem, 32 * (r % 32), scr, 64 * (r / 32), lane); continue; } r -= I_MEM;
        transpose_item(opq(p.w_out), 1024, 1024, 32 * (r % 32), Wout, 32 * (r % 32), scr, 64 * (r / 32), lane);
    }
    { const int gt = bid * 512 + tid, NT = gridDim.x * 512; u32x4* z = (u32x4*)(Win + (size_t)INW * 1024);
      for (int i = gt; i < (LD - INW) * 1024 / 8; i += NT) z[i] = (u32x4){0u, 0u, 0u, 0u}; }
    { const int gt = bid * 512 + tid, NT = gridDim.x * 512; bf16_t* wa = (bf16_t*)(wsb(p) + WS_LRUWA); bf16_t* wx = (bf16_t*)(wsb(p) + WS_LRUWX);
      for (int e = gt; e < NLB * LRUB * LRUB; e += NT) { const int n = e / (LRUB * LRUB), r2 = e % (LRUB * LRUB), j = r2 / LRUB, i = r2 % LRUB;
          wa[e] = (bf16_t)f2bf(opq(p.lru_w_a)[(n * LRUB + i) * LRUB + j]); wx[e] = (bf16_t)f2bf(opq(p.lru_w_x)[(n * LRUB + i) * LRUB + j]); } }
    bf16_t* XN = xn_ptr(p); bf16_t* MN = (bf16_t*)(wsb(p) + WS_MEMN);
    { const float* xb = opq(p.x); const f32x4* gr = (const f32x4*)opq(p.norm_g) + lane;
      for (int m0 = gw * 4; m0 < MTOK; m0 += NGW * 4) {
          f32x4 v[4][4];
#pragma unroll
          for (int r = 0; r < 4; ++r)
#pragma unroll
              for (int j = 0; j < 4; ++j) v[r][j] = ((const f32x4*)(xb + (size_t)(m0 + r) * DM) + lane)[64 * j];
#pragma unroll
          for (int r = 0; r < 4; ++r) { float s = 0.f;
#pragma unroll
              for (int j = 0; j < 4; ++j) s += (v[r][j].x * v[r][j].x + v[r][j].y * v[r][j].y) + (v[r][j].z * v[r][j].z + v[r][j].w * v[r][j].w);
              const float rs = 1.f / sqrtf(wave_sum(s) * (1.f / DM) + EPS);
              unsigned long long* o8 = (unsigned long long*)(XN + (size_t)(m0 + r) * DM) + lane;
#pragma unroll
              for (int j = 0; j < 4; ++j) { const f32x4 gg = gr[64 * j];
                  o8[64 * j] = (unsigned long long)pk2(v[r][j].x * rs * gg.x, v[r][j].y * rs * gg.y) | ((unsigned long long)pk2(v[r][j].z * rs * gg.z, v[r][j].w * rs * gg.w) << 32); } } } }
    for (int m = gw; m < NBATCH * MEML; m += NGW) rms_row_to_bf16(opq(p.mem) + (size_t)m * DM, opq(p.mem_norm_g), MN + (size_t)m * DM, lane);
}
__device__ __forceinline__ void phase7(const Params& p) {
    const int tid = opq_tid(), lane = tid & 63, wave = tid >> 6; const int gw = opq_bid() * 8 + wave, NGW = gridDim.x * 8; float* outb = opq(p.out); const float* fg = opq(p.final_g);
    for (int m = gw; m < MTOK; m += NGW) {
        f32x4* xr = (f32x4*)(outb + (size_t)m * DM) + lane; const f32x4* gr = (const f32x4*)fg + lane;
        f32x4 v[4]; float s = 0.f;
#pragma unroll
        for (int j = 0; j < 4; ++j) { v[j] = xr[64 * j]; s += (v[j].x * v[j].x + v[j].y * v[j].y) + (v[j].z * v[j].z + v[j].w * v[j].w); }
        const float rs = 1.f / sqrtf(wave_sum(s) * (1.f / DM) + EPS);
#pragma unroll
        for (int j = 0; j < 4; ++j) { const f32x4 gg = gr[64 * j]; xr[64 * j] = v[j] * rs * gg; }
    }
}

namespace pg8 {
template <int BR> struct EpiMerge {
    static constexpr bool PERM = true, AFTER_DRAIN = false;
    bf16_t* P; float* scr;
    __device__ __forceinline__ void operator()(const f32x4 (&acc)[2][2][4][2], const Unit& u, int wr, int wc, int fr, int fq) const {
        const int row0 = u.pm * BM + wr * 64 + fr, col0 = u.pn * BM + wc * 32 + 8 * fq;
#pragma unroll
        for (int ai = 0; ai < 2; ++ai)
#pragma unroll
            for (int m = 0; m < 4; ++m) { const size_t r = (size_t)(row0 + ai * HALF + m * 16);
#pragma unroll
                for (int bj = 0; bj < 2; ++bj) { const int c = col0 + bj * HALF;
                    const u32x4 gw = *(const u32x4*)(P + r * 12544 + 9216 + BR * 1024 + c);
                    float g[8];
#pragma unroll
                    for (int i = 0; i < 4; ++i) { g[2 * i] = __uint_as_float(gw[i] << 16); g[2 * i + 1] = __uint_as_float(gw[i] & 0xffff0000u); }
                    f32x4 v0 = acc[ai][bj][m][0], v1 = acc[ai][bj][m][1];
#pragma unroll
                    for (int i = 0; i < 4; ++i) { v0[i] *= 1.f / (1.f + __expf(-g[i])); v1[i] *= 1.f / (1.f + __expf(-g[4 + i])); }
                    float* sp = scr + r * 1024 + c;
                    if (BR > 0) { v0 += *(const f32x4*)sp; v1 += *(const f32x4*)(sp + 4); }
                    if (BR < 2) { *(f32x4*)sp = v0; *(f32x4*)(sp + 4) = v1; }
                    else { u32x4 w; w.x = cvt_pk_bf16(v0[0], v0[1]); w.y = cvt_pk_bf16(v0[2], v0[3]); w.z = cvt_pk_bf16(v1[0], v1[1]); w.w = cvt_pk_bf16(v1[2], v1[3]);
                        *(u32x4*)(P + r * 12544 + 2048 + c) = w; } } }
    }
};
template <int BR, bool FINAL> struct EpiMerge2 {
    static constexpr bool PERM = true, AFTER_DRAIN = false;
    bf16_t* P; bf16_t* s0; int ld0; const bf16_t* s1; int ld1; bf16_t* mrg; int ldm;
    __device__ __forceinline__ void operator()(const f32x4 (&acc)[2][2][4][2], const Unit& u, int wr, int wc, int fr, int fq) const {
        const int row0 = u.pm * BM + wr * 64 + fr, col0 = u.pn * BM + wc * 32 + 8 * fq;
#pragma unroll
        for (int ai = 0; ai < 2; ++ai) {
            unsigned gb = (unsigned)((row0 + ai * HALF) * 12544 + 9216 + BR * 1024 + col0); asm volatile("" : "+v"(gb));
            unsigned b0 = (unsigned)((row0 + ai * HALF) * ld0 + col0); asm volatile("" : "+v"(b0));
            u32x4 gw[4][2];
#pragma unroll
            for (int m = 0; m < 4; ++m)
#pragma unroll
                for (int bj = 0; bj < 2; ++bj) gw[m][bj] = *(const u32x4*)(P + (gb + (unsigned)(m * 16 * 12544 + bj * HALF)));
            f32x4 v[4][2][2];
#pragma unroll
            for (int m = 0; m < 4; ++m)
#pragma unroll
                for (int bj = 0; bj < 2; ++bj) { const u32x4 g4 = gw[m][bj]; f32x4 v0 = acc[ai][bj][m][0], v1 = acc[ai][bj][m][1];
#pragma unroll
                    for (int i = 0; i < 2; ++i) { v0[2 * i] *= __builtin_amdgcn_rcpf(1.f + __expf(-__uint_as_float(g4[i] << 16))); v0[2 * i + 1] *= __builtin_amdgcn_rcpf(1.f + __expf(-__uint_as_float(g4[i] & 0xffff0000u)));
                        v1[2 * i] *= __builtin_amdgcn_rcpf(1.f + __expf(-__uint_as_float(g4[2 + i] << 16))); v1[2 * i + 1] *= __builtin_amdgcn_rcpf(1.f + __expf(-__uint_as_float(g4[2 + i] & 0xffff0000u))); }
                    v[m][bj][0] = v0; v[m][bj][1] = v1; }
            if (!FINAL) {
#pragma unroll
                for (int m = 0; m < 4; ++m)
#pragma unroll
                    for (int bj = 0; bj < 2; ++bj) { const f32x4 v0 = v[m][bj][0], v1 = v[m][bj][1]; u32x4 w; w.x = cvt_pk_bf16(v0[0], v0[1]); w.y = cvt_pk_bf16(v0[2], v0[3]); w.z = cvt_pk_bf16(v1[0], v1[1]); w.w = cvt_pk_bf16(v1[2], v1[3]);
                        *(u32x4*)(s0 + (b0 + (unsigned)(m * 16) * (unsigned)ld0 + (unsigned)(bj * HALF))) = w; }
            } else {
                asm volatile("" ::: "memory");
                unsigned b1 = (unsigned)((row0 + ai * HALF) * ld1 + col0); asm volatile("" : "+v"(b1));
                unsigned bm = (unsigned)((row0 + ai * HALF) * ldm + col0); asm volatile("" : "+v"(bm));
#pragma unroll
                for (int mp = 0; mp < 2; ++mp) { u32x4 a0[2][2], a1[2][2];
#pragma unroll
                    for (int mm = 0; mm < 2; ++mm)
#pragma unroll
                        for (int bj = 0; bj < 2; ++bj) { const unsigned rr = (unsigned)((2 * mp + mm) * 16);
                            a0[mm][bj] = *(const u32x4*)(s0 + (b0 + rr * (unsigned)ld0 + (unsigned)(bj * HALF))); a1[mm][bj] = *(const u32x4*)(s1 + (b1 + rr * (unsigned)ld1 + (unsigned)(bj * HALF))); }
#pragma unroll
                    for (int mm = 0; mm < 2; ++mm)
#pragma unroll
                        for (int bj = 0; bj < 2; ++bj) { const int m = 2 * mp + mm; const unsigned rr = (unsigned)(m * 16);
                            f32x4 v0 = v[m][bj][0], v1 = v[m][bj][1];
#pragma unroll
                            for (int i = 0; i < 2; ++i) { v0[2 * i] += __uint_as_float(a0[mm][bj][i] << 16) + __uint_as_float(a1[mm][bj][i] << 16); v0[2 * i + 1] += __uint_as_float(a0[mm][bj][i] & 0xffff0000u) + __uint_as_float(a1[mm][bj][i] & 0xffff0000u);
                                v1[2 * i] += __uint_as_float(a0[mm][bj][2 + i] << 16) + __uint_as_float(a1[mm][bj][2 + i] << 16); v1[2 * i + 1] += __uint_as_float(a0[mm][bj][2 + i] & 0xffff0000u) + __uint_as_float(a1[mm][bj][2 + i] & 0xffff0000u); }
                            u32x4 w; w.x = cvt_pk_bf16(v0[0], v0[1]); w.y = cvt_pk_bf16(v0[2], v0[3]); w.z = cvt_pk_bf16(v1[0], v1[1]); w.w = cvt_pk_bf16(v1[2], v1[3]);
                            *(u32x4*)(mrg + (bm + rr * (unsigned)ldm + (unsigned)(bj * HALF))) = w; }
                    asm volatile("" ::: "memory"); }
            }
            asm volatile("" ::: "memory");
        }
    }
};
struct EpiOutNorm {
    static constexpr bool PERM = false, AFTER_DRAIN = true;
    const float* xres; float* out; const float* fg; float* xbuf; unsigned* cnt;
    __device__ __forceinline__ void fused(f32x4 (&acc)[2][2][4][2], const Unit& u, int wr, int wc, int fr, int fq, PG8_LAS unsigned char* lds, int wid, int lane) const {
        PG8_LAS float* Pp = (PG8_LAS float*)lds; PG8_LAS float* Sr = (PG8_LAS float*)(lds + 4096);
        const int row0 = u.pm * BM + wr * 64 + fr, col0 = u.pn * BM + wc * 32 + 4 * fq;
#pragma unroll
        for (int ai = 0; ai < 2; ++ai)
#pragma unroll
            for (int m = 0; m < 4; ++m) { const size_t off = (size_t)(row0 + ai * HALF + m * 16) * 1024 + col0; float s = 0.f;
#pragma unroll
                for (int bj = 0; bj < 2; ++bj)
#pragma unroll
                    for (int n = 0; n < 2; ++n) { const f32x4 v = acc[ai][bj][m][n] + *(const f32x4*)(xres + off + bj * HALF + n * 16); acc[ai][bj][m][n] = v; s += (v[0] * v[0] + v[1] * v[1]) + (v[2] * v[2] + v[3] * v[3]); }
                s += __shfl_xor(s, 16); s += __shfl_xor(s, 32);
                if (fq == 0) Pp[(ai * HALF + wr * 64 + m * 16 + fr) * 4 + wc] = s;
                if (m == 3) asm volatile("" ::: "memory"); }
        asm volatile("s_waitcnt lgkmcnt(0)" ::: "memory"); __builtin_amdgcn_s_barrier(); asm volatile("" ::: "memory");
        const int tid = wid * 64 + lane;
        if (tid < 256) { const float s = (Pp[tid * 4 + 0] + Pp[tid * 4 + 1]) + (Pp[tid * 4 + 2] + Pp[tid * 4 + 3]);
            __hip_atomic_store(xbuf + (size_t)(u.pm * BM + tid) * 4 + u.pn, s, __ATOMIC_RELAXED, __HIP_MEMORY_SCOPE_AGENT); }
        asm volatile("s_waitcnt vmcnt(0)" ::: "memory");
        if (wid < 4 && lane == 0) __hip_atomic_fetch_add(cnt + 64 * u.pm, 1u, __ATOMIC_RELAXED, __HIP_MEMORY_SCOPE_AGENT);
        if (wid == 0) { unsigned spins = 0;
            while ((unsigned)__builtin_amdgcn_readfirstlane(__hip_atomic_load(cnt + 64 * u.pm, __ATOMIC_RELAXED, __HIP_MEMORY_SCOPE_AGENT)) < 16u && ++spins < (1u << 22)) __builtin_amdgcn_s_sleep(2);
            __builtin_amdgcn_fence(__ATOMIC_ACQUIRE, "agent"); }
        asm volatile("s_waitcnt vmcnt(0) lgkmcnt(0)" ::: "memory"); __builtin_amdgcn_s_barrier(); asm volatile("" ::: "memory");
        if (tid < 256) { const float* slot = xbuf + (size_t)(u.pm * BM + tid) * 4; float s = 0.f;
#pragma unroll
            for (int q = 0; q < 4; ++q) s += __hip_atomic_load(slot + q, __ATOMIC_RELAXED, __HIP_MEMORY_SCOPE_AGENT);
            Sr[tid] = 1.0f / sqrtf(s * (1.f / 1024.f) + 1e-6f); }
        asm volatile("s_waitcnt lgkmcnt(0)" ::: "memory"); __builtin_amdgcn_s_barrier(); asm volatile("" ::: "memory");
#pragma unroll
        for (int ai = 0; ai < 2; ++ai)
#pragma unroll
            for (int m = 0; m < 4; ++m) { const int r = ai * HALF + wr * 64 + m * 16 + fr; const float rs = Sr[r]; const size_t off = (size_t)(u.pm * BM + r) * 1024 + col0;
#pragma unroll
                for (int bj = 0; bj < 2; ++bj)
#pragma unroll
                    for (int n = 0; n < 2; ++n) { const f32x4 gg = *(const f32x4*)(fg + col0 + bj * HALF + n * 16); *(f32x4*)(out + off + bj * HALF + n * 16) = acc[ai][bj][m][n] * rs * gg; } }
    }
};
struct SkewOrder {
    StaticOrder base; int c;
    __device__ void init(int M, int N, int c_) { base.init(M, N, 256, 0); c = c_; }
    __device__ bool next(int i, Unit& u) const {
        int ii = i, cc = c;
        if (c < 128) { if (i >= 5) return false; }
        else if (i == 6) { ii = 5; cc = c - 128; }
        else if (i > 6) return false;
        StaticOrder b2 = base; b2.c = cc; return b2.next(ii, u);
    }
    __device__ __forceinline__ void a_ready(const Unit&) const {}
    __device__ __forceinline__ void done(const Unit&) const {}
};
}
#define PG8_SP2 true
#define PG8_ALIGN true

__device__ __forceinline__ bf16_t* merged_ptr(const Params& p, int b) { return b == 0 ? xn_ptr(p) : proj_ptr(p) + 4096; }
__device__ __forceinline__ int merged_ld(int b) { return b == 0 ? DM : LD; }
__device__ __forceinline__ void phase1_gemm(const Params& p, int b, LAS unsigned char* lds) {
    const int G = gridDim.x, c = opq_bid();
    { pg8::Gemm g{xn_ptr(p) + (size_t)b * SEQ * DM, (const bf16_t*)(wsb(p) + WS_WIN), SEQ, 12288, DM, DM, DM}; pg8::StaticOrder S; S.init(SEQ, 12288, G, c);
      pg8::EpiBf16<0> E{proj_ptr(p), LD, nullptr, 0, 0, 1.f};
      if (b == 1 && G == 256) { pg8::SkewOrder S2; S2.init(SEQ, 12288, c);
          pg8::gemm_phase<pg8::EpiBf16<0>, pg8::SkewOrder, PG8_ALIGN, PG8_SP2>(lds, g, S2, E); }
      else pg8::gemm_phase<pg8::EpiBf16<0>, pg8::StaticOrder, PG8_ALIGN, PG8_SP2>(lds, g, S, E); }
    { const int tid = opq_tid(), lane = tid & 63, wave = tid >> 6, fr = lane & 15, kg = lane >> 4;
      const bf16_t* XNb = xn_ptr(p) + (size_t)b * SEQ * DM; const bf16_t* Wd = (const bf16_t*)(wsb(p) + WS_WIN) + (size_t)C_DT * DM; bf16_t* Pq = proj_ptr(p);
      LAS float* sRed = (LAS float*)lds;
      for (int rb = c; rb < SEQ / 32; rb += G) {
          __syncthreads();
          f32x4 acc[2][2];
#pragma unroll
          for (int mt = 0; mt < 2; ++mt)
#pragma unroll
              for (int nt = 0; nt < 2; ++nt) acc[mt][nt] = (f32x4){0.f, 0.f, 0.f, 0.f};
          bf16x8 af[2][4], bfr[2][4];
#pragma unroll
          for (int ks = 0; ks < 4; ++ks)
#pragma unroll
              for (int q = 0; q < 2; ++q) { af[q][ks] = *(const bf16x8*)(XNb + (size_t)(32 * rb + 16 * q + fr) * DM + 128 * wave + 32 * ks + 8 * kg);
                  bfr[q][ks] = *(const bf16x8*)(Wd + (size_t)(16 * q + fr) * DM + 128 * wave + 32 * ks + 8 * kg); }
#pragma unroll
          for (int ks = 0; ks < 4; ++ks)
#pragma unroll
              for (int mt = 0; mt < 2; ++mt)
#pragma unroll
                  for (int nt = 0; nt < 2; ++nt) acc[mt][nt] = __builtin_amdgcn_mfma_f32_16x16x32_bf16(af[mt][ks], bfr[nt][ks], acc[mt][nt], 0, 0, 0);
#pragma unroll
          for (int mt = 0; mt < 2; ++mt)
#pragma unroll
              for (int nt = 0; nt < 2; ++nt)
#pragma unroll
                  for (int j = 0; j < 4; ++j) sRed[(wave * 32 + 16 * mt + 4 * kg + j) * 32 + 16 * nt + fr] = acc[mt][nt][j];
          __syncthreads();
#pragma unroll
          for (int q = 0; q < 2; ++q) { const int e = tid + 512 * q, row = e >> 5, col = e & 31; float s = 0.f;
#pragma unroll
              for (int w2 = 0; w2 < 8; ++w2) s += sRed[(w2 * 32 + row) * 32 + col];
              Pq[(size_t)(32 * rb + row) * LD + C_DT + col] = (bf16_t)f2bf(s); }
      } }
    if (b == 0) {
        { pg8::Gemm g{(const bf16_t*)(wsb(p) + WS_MEMN), (const bf16_t*)(wsb(p) + WS_WKV), 512, 1024, DM, DM, DM}; pg8::StaticOrder S; S.init(512, 1024, G, (c + 16) % G);
          pg8::EpiBf16<0> E{(bf16_t*)(wsb(p) + WS_KVK), 1024, nullptr, 0, 0, 1.f};
          pg8::gemm_phase<pg8::EpiBf16<0>, pg8::StaticOrder, PG8_ALIGN, PG8_SP2>(lds, g, S, E); }
        { pg8::Gemm g{(const bf16_t*)(wsb(p) + WS_WKV) + (size_t)1024 * DM, (const bf16_t*)(wsb(p) + WS_MEMN), 1024, 512, DM, DM, DM}; pg8::StaticOrder S; S.init(1024, 512, G, (c + 8) % G);
          pg8::EpiBf16<0> E{(bf16_t*)(wsb(p) + WS_KVVT), 512, nullptr, 0, 0, 1.f};
          pg8::gemm_phase<pg8::EpiBf16<0>, pg8::StaticOrder, PG8_ALIGN, PG8_SP2>(lds, g, S, E); }
    }
}
__device__ __forceinline__ void phase5_gemm(const Params& p, int b, LAS unsigned char* lds) {
    const int G = gridDim.x, c = opq_bid(); bf16_t* P = proj_ptr(p); float* scr = scr_ptr(p, b);
    bf16_t* scrB = P + 2048;
    bf16_t* scrA = (bf16_t*)scr;
    unsigned* flag = (unsigned*)(wsb(p) + WS_CTL) + 4096 + (b * 128 + (c & 127)) * 16;
    if (c < 128) {
        pg8::Gemm g{P + C_Z, (const bf16_t*)(wsb(p) + WS_WSSD), SEQ, DM, 2048, LD, 2048}; pg8::StaticOrder S; S.init(SEQ, DM, 128, c); pg8::EpiMerge2<0, false> E{P, scrA, 1024, nullptr, 0, nullptr, 0};
        pg8::gemm_phase<pg8::EpiMerge2<0, false>, pg8::StaticOrder, false, PG8_SP2>(lds, g, S, E);
#ifdef PROBE_NOFENCE
        asm volatile("s_waitcnt vmcnt(0)" ::: "memory"); __syncthreads();
        if (threadIdx.x == 0) __hip_atomic_store(flag, 1u, __ATOMIC_RELAXED, __HIP_MEMORY_SCOPE_AGENT);
#else
        asm volatile("s_waitcnt vmcnt(0)" ::: "memory"); __syncthreads();
        if (threadIdx.x == 0) { __builtin_amdgcn_fence(__ATOMIC_RELEASE, "agent"); asm volatile("s_waitcnt vmcnt(0)" ::: "memory");
            __hip_atomic_store(flag, 1u, __ATOMIC_RELAXED, __HIP_MEMORY_SCOPE_AGENT); }
#endif
    } else {
        { pg8::Gemm g{P + C_LG, (const bf16_t*)(wsb(p) + WS_WLRU), SEQ, DM, 1536, LD, 1536}; pg8::StaticOrder S; S.init(SEQ, DM, 128, c - 128); pg8::EpiMerge2<1, false> E{P, scrB, LD, nullptr, 0, nullptr, 0};
          pg8::gemm_phase<pg8::EpiMerge2<1, false>, pg8::StaticOrder, false, PG8_SP2>(lds, g, S, E); }
        if (threadIdx.x == 0) { unsigned spins = 0; while (__hip_atomic_load(flag, __ATOMIC_RELAXED, __HIP_MEMORY_SCOPE_AGENT) == 0u && ++spins < (1u << 22)) __builtin_amdgcn_s_sleep(2);
#ifndef PROBE_NOFENCE
            __builtin_amdgcn_fence(__ATOMIC_ACQUIRE, "agent"); asm volatile("s_waitcnt vmcnt(0)" ::: "memory");
#endif
        }
        __syncthreads();
        { pg8::Gemm g{P + C_Q, (const bf16_t*)(wsb(p) + WS_WMEM), SEQ, DM, 1024, LD, 1024}; pg8::StaticOrder S; S.init(SEQ, DM, 128, c - 128); pg8::EpiMerge2<2, true> E{P, scrB, LD, scrA, 1024, merged_ptr(p, b), merged_ld(b)};
          pg8::gemm_phase<pg8::EpiMerge2<2, true>, pg8::StaticOrder, false, PG8_SP2>(lds, g, S, E); }
    }
    (void)G;
}
__device__ __forceinline__ void phase6_gemm(const Params& p, int b, LAS unsigned char* lds) {
    const int G = gridDim.x, c = opq_bid(); bf16_t* P = proj_ptr(p);
    pg8::Gemm g{merged_ptr(p, b), (const bf16_t*)(wsb(p) + WS_WOUT), SEQ, DM, DM, merged_ld(b), DM}; pg8::StaticOrder S; S.init(SEQ, DM, G, c);
    pg8::EpiOutNorm E{opq(p.x) + (size_t)b * SEQ * DM, opq(p.out) + (size_t)b * SEQ * DM, opq(p.final_g), (float*)(wsb(p) + WS_XBUF) + (size_t)b * SEQ * 4, (unsigned*)(wsb(p) + WS_CTL) + 8192 + b * 2048};
    pg8::gemm_phase<pg8::EpiOutNorm, pg8::StaticOrder, false, PG8_SP2>(lds, g, S, E);
}
#define MFMA16(a, b, c) __builtin_amdgcn_mfma_f32_16x16x32_bf16((a), (b), (c), 0, 0, 0)
__device__ __forceinline__ bf16x8 pack8(const float (&v)[8]) {
    u32x4 w; w.x = pk2(v[0], v[1]); w.y = pk2(v[2], v[3]); w.z = pk2(v[4], v[5]); w.w = pk2(v[6], v[7]); return __builtin_bit_cast(bf16x8, w);
}
__device__ __forceinline__ void unpack8(u32x4 w, float (&v)[8]) {
#pragma unroll
    for (int i = 0; i < 4; ++i) { v[2 * i] = __uint_as_float(w[i] << 16); v[2 * i + 1] = __uint_as_float(w[i] & 0xffff0000u); }
}
__device__ __forceinline__ void attn_phase(const Params& p, int b, LAS unsigned char* lds, int dry = 0) {
    const int tid = opq_tid(), lane = tid & 63, wave = tid >> 6, fr = lane & 15, kg = lane >> 4;
    bf16_t* P = proj_ptr(p); const bf16_t* KK = (const bf16_t*)(wsb(p) + WS_KVK) + (size_t)b * 256 * 1024; const bf16_t* VT = (const bf16_t*)(wsb(p) + WS_KVVT) + b * 256;
    LAS bf16_t* sKV = (LAS bf16_t*)lds;
    for (int u = opq_bid(); u < 256; u += gridDim.x) {
        const int hd = u & 3, rt = u >> 2, q0 = rt * 128 + wave * 16;
        bf16_t* qrow = P + (size_t)(q0 + fr) * LD + C_Q + hd * 256;
        __syncthreads();
        { unsigned ko = (unsigned)((tid >> 5) * 1024 + hd * 256 + 8 * (tid & 31)); asm volatile("" : "+v"(ko));
          u32x4 st[16];
#pragma unroll
          for (int i = 0; i < 16; ++i) st[i] = *(const u32x4*)(KK + (ko + (unsigned)(i * 16 * 1024)));
#pragma unroll
          for (int i = 0; i < 16; ++i) *(LAS u32x4*)(sKV + ((tid >> 5) + 16 * i) * 264 + 8 * (tid & 31)) = st[i]; }
        bf16x8 qf[8];
#pragma unroll
        for (int s = 0; s < 8; ++s) qf[s] = *(const bf16x8*)(qrow + 32 * s + 8 * kg);
        __syncthreads();
        u32x4 vst[16];
        { unsigned vo = (unsigned)((hd * 256 + (tid >> 5)) * 512 + 8 * (tid & 31)); asm volatile("" : "+v"(vo));
#pragma unroll
          for (int i = 0; i < 16; ++i) vst[i] = *(const u32x4*)(VT + (vo + (unsigned)(i * 16 * 512))); }
        f32x4 sacc[16];
#pragma unroll
        for (int mt = 0; mt < 16; ++mt) { sacc[mt] = (f32x4){0.f, 0.f, 0.f, 0.f};
#pragma unroll
            for (int s = 0; s < 8; ++s) { const bf16x8 kf = *(const LAS bf16x8*)(sKV + (16 * mt + fr) * 264 + 32 * s + 8 * kg); sacc[mt] = MFMA16(kf, qf[s], sacc[mt]); } }
        float mx = -INFINITY;
#pragma unroll
        for (int mt = 0; mt < 16; ++mt)
#pragma unroll
            for (int j = 0; j < 4; ++j) mx = fmaxf(mx, sacc[mt][j]);
        mx = fmaxf(mx, __shfl_xor(mx, 16)); mx = fmaxf(mx, __shfl_xor(mx, 32));
        float sum = 0.f;
#pragma unroll
        for (int mt = 0; mt < 16; ++mt)
#pragma unroll
            for (int j = 0; j < 4; ++j) { const float e = __expf((sacc[mt][j] - mx) * 0.0625f); sacc[mt][j] = e; sum += e; }
        sum += __shfl_xor(sum, 16); sum += __shfl_xor(sum, 32);
        const float inv = 1.f / sum;
        bf16x8 pf[8];
#pragma unroll
        for (int s2 = 0; s2 < 8; ++s2) { u32x4 w; w.x = pk2(sacc[2 * s2][0], sacc[2 * s2][1]); w.y = pk2(sacc[2 * s2][2], sacc[2 * s2][3]);
            w.z = pk2(sacc[2 * s2 + 1][0], sacc[2 * s2 + 1][1]); w.w = pk2(sacc[2 * s2 + 1][2], sacc[2 * s2 + 1][3]); pf[s2] = __builtin_bit_cast(bf16x8, w); }
        __syncthreads();
#pragma unroll
        for (int i = 0; i < 16; ++i) *(LAS u32x4*)(sKV + ((tid >> 5) + 16 * i) * 264 + 8 * (tid & 31)) = vst[i];
        __syncthreads();
#pragma unroll 4
        for (int mt2 = 0; mt2 < 16; ++mt2) { f32x4 o = (f32x4){0.f, 0.f, 0.f, 0.f}; const LAS bf16_t* vr = sKV + (16 * mt2 + fr) * 264 + 4 * kg;
#pragma unroll
            for (int s2 = 0; s2 < 8; ++s2) { const u32x2 lo = *(const LAS u32x2*)(vr + 32 * s2), hi = *(const LAS u32x2*)(vr + 32 * s2 + 16);
                u32x4 w; w.x = lo.x; w.y = lo.y; w.z = hi.x; w.w = hi.y; o = MFMA16(__builtin_bit_cast(bf16x8, w), pf[s2], o); }
            u32x2 ow; ow.x = pk2(o[0] * inv, o[1] * inv); ow.y = pk2(o[2] * inv, o[3] * inv);
            if (!dry) *(u32x2*)(qrow + 16 * mt2 + 4 * kg) = ow; }
    }
}
template <bool FINAL> __device__ __forceinline__ void lru_phase(const Params& p, int b, LAS unsigned char* lds, int dry = 0) {
    const int tid = opq_tid(), lane = tid & 63, wave = tid >> 6, fr = lane & 15, kg = lane >> 4;
    bf16_t* P = proj_ptr(p);
    LAS bf16_t* sWA = (LAS bf16_t*)lds; LAS bf16_t* sWX = (LAS bf16_t*)(lds + 19968);
    LAS float* sCW = (LAS float*)(lds + 39936); LAS float* sCB = sCW + 384; LAS float* sBA = sCB + 96; LAS float* sBX = sBA + 96; LAS float* sSP = sBX + 96;
    LAS float* sXL = (LAS float*)(lds + 43008) + wave * 1600;
    LAS float* sAG = (LAS float*)(lds + 94208);
    float* agg = (float*)(wsb(p) + WS_LAGG) + (size_t)b * NBLK64 * LRUW * 2;
    const float* car = (const float*)(wsb(p) + WS_LCAR) + (size_t)b * NBLK64 * LRUW;
    const float* lcw = opq(p.lru_conv_w); const float* lcb = opq(p.lru_conv_b); const float* lba = opq(p.lru_b_a); const float* lbx = opq(p.lru_b_x); const float* lam = opq(p.lru_lambda);
    for (int u = opq_bid(); u < NLB * NSEG; u += gridDim.x) {
        const int n = u % NLB, sg = u / NLB;
        __syncthreads();
        { const bf16_t* gwa = (const bf16_t*)(wsb(p) + WS_LRUWA) + n * 9216; const bf16_t* gwx = (const bf16_t*)(wsb(p) + WS_LRUWX) + n * 9216;
          u32x4 wa3[3], wx3[3]; float cwv = 0.f, v4[4] = {0.f, 0.f, 0.f, 0.f};
#pragma unroll
          for (int i = 0; i < 3; ++i) { const int e = tid + 512 * i; if (e < 96 * 12) { const int j = e / 12, c8 = e % 12; wa3[i] = *(const u32x4*)(gwa + j * 96 + 8 * c8); wx3[i] = *(const u32x4*)(gwx + j * 96 + 8 * c8); } }
          if (tid < 384) cwv = lcw[(tid / 96) * 1536 + n * 96 + tid % 96];
          if (tid < 96) { v4[0] = lcb[n * 96 + tid]; v4[1] = lba[n * 96 + tid]; v4[2] = lbx[n * 96 + tid]; v4[3] = lam[n * 96 + tid]; }
#pragma unroll
          for (int i = 0; i < 3; ++i) { const int e = tid + 512 * i; if (e < 96 * 12) { const int j = e / 12, c8 = e % 12; *(LAS u32x4*)(sWA + j * 104 + 8 * c8) = wa3[i]; *(LAS u32x4*)(sWX + j * 104 + 8 * c8) = wx3[i]; } }
          if (tid < 384) sCW[tid] = cwv;
          if (tid < 96) { sCB[tid] = v4[0]; sBA[tid] = v4[1]; sBX[tid] = v4[2]; sSP[tid] = softplusf_(-v4[3]); } }
        __syncthreads();
        float runA[6], runH[6];
#pragma unroll
        for (int nt = 0; nt < 6; ++nt) { runA[nt] = 1.f; runH[nt] = FINAL ? car[(sg * 8 + wave) * LRUW + n * 96 + 16 * nt + fr] : 0.f; }
        for (int step = 0; step < 4; ++step) {
            const int tb = sg * LSEG + wave * 64 + step * 16;
            u32x4 rawC[3][4];
            { const int t0r = tb + fr - 3; unsigned ro = (unsigned)((t0r < 0 ? 0 : t0r) * LD + C_LX + n * 96 + 8 * kg); asm volatile("" : "+v"(ro));
              if (t0r >= 0) {
#pragma unroll
                  for (int ks = 0; ks < 3; ++ks)
#pragma unroll
                      for (int k = 0; k < 4; ++k) rawC[ks][k] = *(const u32x4*)(P + (ro + (unsigned)(k * LD + 32 * ks)));
              } else {
#pragma unroll
                  for (int ks = 0; ks < 3; ++ks)
#pragma unroll
                      for (int k = 0; k < 4; ++k) { const int t = t0r + k; rawC[ks][k] = *(const u32x4*)(P + (ro + (unsigned)((t < 0 ? 0 : t) * LD + 32 * ks))); if (t < 0) rawC[ks][k] = (u32x4){0u, 0u, 0u, 0u}; }
              } }
            bf16x8 af[3];
#pragma unroll
            for (int ks = 0; ks < 3; ++ks) { const int ch0 = 32 * ks + 8 * kg; float xl[8];
#pragma unroll
                for (int i = 0; i < 8; ++i) xl[i] = sCB[ch0 + i];
#pragma unroll
                for (int k = 0; k < 4; ++k) { const u32x4 raw = rawC[ks][k];
                    float rv[8]; unpack8(raw, rv);
#pragma unroll
                    for (int i = 0; i < 8; ++i) xl[i] += sCW[k * 96 + ch0 + i] * rv[i]; }
                *(LAS f32x4*)(sXL + fr * 100 + ch0) = (f32x4){xl[0], xl[1], xl[2], xl[3]}; *(LAS f32x4*)(sXL + fr * 100 + ch0 + 4) = (f32x4){xl[4], xl[5], xl[6], xl[7]};
                af[ks] = pack8(xl); }
            LAS bf16_t* sG = (LAS bf16_t*)((LAS unsigned char*)sWA + 106496) + wave * 1536;
            unsigned go3[3]; u32x4 graw[3];
            if (FINAL) {
#pragma unroll
                for (int i = 0; i < 3; ++i) { const int e = lane + 64 * i, row = e / 12, c12 = e % 12; go3[i] = (unsigned)((tb + row) * LD + C_LG + n * 96 + 8 * c12); }
                asm volatile("" : "+v"(go3[0]), "+v"(go3[1]), "+v"(go3[2]));
#pragma unroll
                for (int i = 0; i < 3; ++i) graw[i] = *(const u32x4*)(P + go3[i]); }
            f32x4 aR[6], aI[6];
#pragma unroll
            for (int nt = 0; nt < 6; ++nt) { aR[nt] = (f32x4){0.f, 0.f, 0.f, 0.f}; aI[nt] = (f32x4){0.f, 0.f, 0.f, 0.f};
#pragma unroll
                for (int ks = 0; ks < 3; ++ks) { const bf16x8 wa = *(const LAS bf16x8*)(sWA + (16 * nt + fr) * 104 + 32 * ks + 8 * kg), wx = *(const LAS bf16x8*)(sWX + (16 * nt + fr) * 104 + 32 * ks + 8 * kg);
                    aR[nt] = MFMA16(af[ks], wa, aR[nt]); aI[nt] = MFMA16(af[ks], wx, aI[nt]); } }
            float Ainc[6][4], Hinc[6][4];
#pragma unroll
            for (int nt = 0; nt < 6; ++nt) { const int j = 16 * nt + fr; const float ba2 = -1.44269504f * sBA[j], bx2 = -1.44269504f * sBX[j], spc = -8.f * 1.44269504f * sSP[j];
                float A = 1.f, H = 0.f;
#pragma unroll
                for (int r = 0; r < 4; ++r) { const float xlv = sXL[(4 * kg + r) * 100 + j];
                    const float rr = __builtin_amdgcn_rcpf(1.f + __builtin_amdgcn_exp2f(fmaf(aR[nt][r], -1.44269504f, ba2))), ii = __builtin_amdgcn_rcpf(1.f + __builtin_amdgcn_exp2f(fmaf(aI[nt][r], -1.44269504f, bx2)));
                    const float a = __builtin_amdgcn_exp2f(rr * spc), mult = __builtin_amdgcn_sqrtf(fmaxf(0.f, fmaf(-a, a, 1.f)));
                    H = a * H + mult * ii * xlv; A *= a; Ainc[nt][r] = A; Hinc[nt][r] = H; }
                float ap = 1.f, hp = 0.f, at = 1.f, ht = 0.f;
#pragma unroll
                for (int k = 0; k < 4; ++k) { const float ab = __shfl(A, fr + 16 * k), hb = __shfl(H, fr + 16 * k);
                    if (k < kg) { hp = ab * hp + hb; ap *= ab; } ht = ab * ht + hb; at *= ab; }
                if (FINAL) { const float hin = ap * runH[nt] + hp;
#pragma unroll
                    for (int r = 0; r < 4; ++r) Hinc[nt][r] = Ainc[nt][r] * hin + Hinc[nt][r]; }
                runH[nt] = at * runH[nt] + ht; runA[nt] *= at; }
            if (FINAL) {
#pragma unroll
                for (int i = 0; i < 3; ++i) { const int e = lane + 64 * i; *(LAS u32x4*)(sG + (e / 12) * 96 + 8 * (e % 12)) = graw[i]; }
                asm volatile("s_waitcnt lgkmcnt(0)" ::: "memory");
#pragma unroll
                for (int nt = 0; nt < 6; ++nt)
#pragma unroll
                    for (int r = 0; r < 4; ++r) { LAS bf16_t* gp = sG + (4 * kg + r) * 96 + 16 * nt + fr; const float yv = Hinc[nt][r] * siluf_(bf2f(*gp)); *gp = (bf16_t)f2bf(yv); }
                asm volatile("s_waitcnt lgkmcnt(0)" ::: "memory");
#pragma unroll
                for (int i = 0; i < 3; ++i) { const int e = lane + 64 * i; const u32x4 w = *(const LAS u32x4*)(sG + (e / 12) * 96 + 8 * (e % 12)); if (!dry) *(u32x4*)(P + go3[i]) = w; }
                asm volatile("s_waitcnt lgkmcnt(0)" ::: "memory"); }
        }
        if (!FINAL && kg == 0) {
#pragma unroll
            for (int nt = 0; nt < 6; ++nt) { const int ch = n * 96 + 16 * nt + fr; agg[((size_t)(sg * 8 + wave) * LRUW + ch) * 2] = runA[nt]; agg[((size_t)(sg * 8 + wave) * LRUW + ch) * 2 + 1] = runH[nt]; } }
    }
}
__device__ __forceinline__ void lru_carry_phase(const Params& p, int b) {
    const int gt = opq_bid() * 512 + opq_tid();
    const float* agg = (const float*)(wsb(p) + WS_LAGG) + (size_t)b * NBLK64 * LRUW * 2; float* car = (float*)(wsb(p) + WS_LCAR) + (size_t)b * NBLK64 * LRUW;
    for (int ch = gt; ch < LRUW; ch += gridDim.x * 512) { float h = 0.f;
        for (int k0 = 0; k0 < NBLK64; k0 += 16) { float a[16], hh[16];
#pragma unroll
            for (int i = 0; i < 16; ++i) { a[i] = agg[((size_t)(k0 + i) * LRUW + ch) * 2]; hh[i] = agg[((size_t)(k0 + i) * LRUW + ch) * 2 + 1]; }
#pragma unroll
            for (int i = 0; i < 16; ++i) { car[(k0 + i) * LRUW + ch] = h; h = a[i] * h + hh[i]; } } }
}
__device__ __forceinline__ void conv8_silu(const bf16_t* P, int t, int col, const float* cw, const float* cb, int ch, float (&o)[8]) {
    float r[11];
    unsigned off0 = (unsigned)((t < 3 ? 0 : t - 3) * LD + col); asm volatile("" : "+v"(off0));
    if (t >= 3) {
#pragma unroll
        for (int i = 0; i < 11; ++i) r[i] = bf2f(P[off0 + (unsigned)(i * LD)]);
    } else {
#pragma unroll
        for (int i = 0; i < 11; ++i) { const int tt = t - 3 + i; const float v = bf2f(P[off0 + (unsigned)((tt < 0 ? 0 : tt) * LD)]); r[i] = tt < 0 ? 0.f : v; }
    }
    const float w0 = cw[ch], w1 = cw[3072 + ch], w2 = cw[6144 + ch], w3 = cw[9216 + ch], bb = cb[ch];
#pragma unroll
    for (int j = 0; j < 8; ++j) o[j] = siluf_(bb + w0 * r[j] + w1 * r[j + 1] + w2 * r[j + 2] + w3 * r[j + 3]);
}
__device__ __forceinline__ float ssd_dt_setup(const Params& p, const bf16_t* P, int t0, int h, int lane, LAS float* sACS, LAS float* sDT) {
    const float dtb = opq(p.ssd_dt_bias)[h], an = -__expf(opq(p.ssd_a_log)[h]);
    const float dt0 = softplusf_(bf2f(P[(size_t)(t0 + 2 * lane) * LD + C_DT + h]) + dtb), dt1 = softplusf_(bf2f(P[(size_t)(t0 + 2 * lane + 1) * LD + C_DT + h]) + dtb);
    const float dA1 = dt1 * an; float s = dt0 * an + dA1;
#pragma unroll
    for (int o = 1; o < 64; o <<= 1) { const float t = __shfl_up(s, o); if (lane >= o) s += t; }
    sACS[2 * lane] = s - dA1; sACS[2 * lane + 1] = s; sDT[2 * lane] = dt0; sDT[2 * lane + 1] = dt1;
    return __shfl(s, 63);
}
template <int R> __device__ __forceinline__ void conv_rows(const bf16_t* P, int t, int col, const float* cw, const float* cb, int ch, float (&o)[R][8]) {
    unsigned off0 = (unsigned)((t < 3 ? 0 : t - 3) * LD + col); asm volatile("" : "+v"(off0));
    u32x4 raw[R + 3];
    if (t >= 3) {
#pragma unroll
        for (int i = 0; i < R + 3; ++i) raw[i] = *(const u32x4*)(P + (off0 + (unsigned)(i * LD)));
    } else {
#pragma unroll
        for (int i = 0; i < R + 3; ++i) { const int tt = t - 3 + i; raw[i] = *(const u32x4*)(P + (off0 + (unsigned)((tt < 0 ? 0 : tt) * LD))); if (tt < 0) raw[i] = (u32x4){0u, 0u, 0u, 0u}; }
    }
    float w[4][8], bb[8];
#pragma unroll
    for (int k = 0; k < 4; ++k) { const f32x4 w0 = *(const f32x4*)(cw + k * 3072 + ch), w1 = *(const f32x4*)(cw + k * 3072 + ch + 4);
        w[k][0] = w0[0]; w[k][1] = w0[1]; w[k][2] = w0[2]; w[k][3] = w0[3]; w[k][4] = w1[0]; w[k][5] = w1[1]; w[k][6] = w1[2]; w[k][7] = w1[3]; }
    { const f32x4 b0 = *(const f32x4*)(cb + ch), b1 = *(const f32x4*)(cb + ch + 4); bb[0] = b0[0]; bb[1] = b0[1]; bb[2] = b0[2]; bb[3] = b0[3]; bb[4] = b1[0]; bb[5] = b1[1]; bb[6] = b1[2]; bb[7] = b1[3]; }
#pragma unroll
    for (int r = 0; r < R; ++r)
#pragma unroll
        for (int q = 0; q < 8; ++q) o[r][q] = bb[q];
#pragma unroll
    for (int i = 0; i < R + 3; ++i) { float v[8]; unpack8(raw[i], v);
#pragma unroll
        for (int k = 0; k < 4; ++k) { const int r = i - k; if (r >= 0 && r < R) {
#pragma unroll
                for (int q = 0; q < 8; ++q) o[r][q] += w[k][q] * v[q]; } } }
#pragma unroll
    for (int r = 0; r < R; ++r)
#pragma unroll
        for (int q = 0; q < 8; ++q) o[r][q] = siluf_(o[r][q]);
}
__device__ __forceinline__ void ssd_states_phase(const Params& p, int b, LAS unsigned char* lds) {
    const int tid = opq_tid(), lane = tid & 63, wave = tid >> 6, fr = lane & 15, kg = lane >> 4;
    const bf16_t* P = proj_ptr(p); bf16_t* ST = states_ptr(p, b); float* dasum = (float*)(wsb(p) + WS_DASUM) + b * NCHUNK * NHEAD;
    const float* cw = opq(p.ssd_conv_w); const float* cb = opq(p.ssd_conv_b);
    LAS bf16_t* sBT = (LAS bf16_t*)lds; LAS bf16_t* sXT = (LAS bf16_t*)(lds + 34816 + wave * 8704);
    LAS float* sACS = (LAS float*)(lds + 104448) + wave * 128; LAS float* sW = (LAS float*)(lds + 108544) + wave * 128;
    for (int u = opq_bid(); u < NCHUNK * NGRP; u += gridDim.x) {
        const int c = u >> 2, g = u & 3, t0 = c * CHUNK, h = 8 * g + wave;
        __syncthreads();
        { const float tot = ssd_dt_setup(p, P, t0, h, lane, sACS, sW);
          if (lane == 0) dasum[c * NHEAD + h] = tot;
          sW[2 * lane] = sW[2 * lane] * __expf(tot - sACS[2 * lane]); sW[2 * lane + 1] = sW[2 * lane + 1] * __expf(tot - sACS[2 * lane + 1]); }
        { const int cg = tid & 15, rs = tid >> 4; float o[4][8];
          conv_rows<4>(P, t0 + 4 * rs, C_B + g * 128 + 8 * cg, cw, cb, 2048 + g * 128 + 8 * cg, o);
#pragma unroll
          for (int q = 0; q < 8; ++q) { u32x2 w; w.x = pk2(o[0][q], o[1][q]); w.y = pk2(o[2][q], o[3][q]); *(LAS u32x2*)(sBT + (8 * cg + q) * 136 + 4 * rs) = w; } }
        __syncthreads();
        for (int ph = 0; ph < 2; ++ph) {
            { const int cg = lane & 3, rs = lane >> 2; float o[8][8];
              conv_rows<8>(P, t0 + 8 * rs, C_X + h * 64 + 32 * ph + 8 * cg, cw, cb, h * 64 + 32 * ph + 8 * cg, o);
              const f32x4 w0 = *(const LAS f32x4*)(sW + 8 * rs), w1 = *(const LAS f32x4*)(sW + 8 * rs + 4);
#pragma unroll
              for (int q = 0; q < 8; ++q) { float v[8] = {o[0][q] * w0[0], o[1][q] * w0[1], o[2][q] * w0[2], o[3][q] * w0[3], o[4][q] * w1[0], o[5][q] * w1[1], o[6][q] * w1[2], o[7][q] * w1[3]};
                  *(LAS bf16x8*)(sXT + (8 * cg + q) * 136 + 8 * rs) = pack8(v); } }
            asm volatile("s_waitcnt lgkmcnt(0)" ::: "memory");
            f32x4 acc[8][2];
#pragma unroll
            for (int mt = 0; mt < 8; ++mt) { acc[mt][0] = (f32x4){0.f, 0.f, 0.f, 0.f}; acc[mt][1] = (f32x4){0.f, 0.f, 0.f, 0.f}; }
#pragma unroll
            for (int s = 0; s < 4; ++s) { const bf16x8 x0 = *(const LAS bf16x8*)(sXT + fr * 136 + 32 * s + 8 * kg), x1 = *(const LAS bf16x8*)(sXT + (16 + fr) * 136 + 32 * s + 8 * kg);
#pragma unroll
                for (int mt = 0; mt < 8; ++mt) { const bf16x8 a = *(const LAS bf16x8*)(sBT + (16 * mt + fr) * 136 + 32 * s + 8 * kg);
                    acc[mt][0] = MFMA16(a, x0, acc[mt][0]); acc[mt][1] = MFMA16(a, x1, acc[mt][1]); } }
            asm volatile("s_waitcnt lgkmcnt(0)" ::: "memory");
#pragma unroll
            for (int mt = 0; mt < 8; ++mt)
#pragma unroll
                for (int nt = 0; nt < 2; ++nt) { const int n0 = 16 * mt + 4 * kg, pp = 32 * ph + 16 * nt + fr;
                    u32x2 w; w.x = pk2(acc[mt][nt][0], acc[mt][nt][1]); w.y = pk2(acc[mt][nt][2], acc[mt][nt][3]);
                    *(u32x2*)(ST + ((size_t)(c * NHEAD + h) * 64 + pp) * 128 + n0) = w; }
        }
    }
}
__device__ __forceinline__ void ssd_scan_phase(const Params& p, int b, int dry = 0) {
    unsigned* st = (unsigned*)states_ptr(p, b); const float* dasum = (const float*)(wsb(p) + WS_DASUM) + b * NCHUNK * NHEAD;
    for (int e2 = opq_bid() * 512 + opq_tid(); e2 < 131072; e2 += gridDim.x * 512) {
        const int h = e2 >> 12; float r0 = 0.f, r1 = 0.f;
        for (int c0 = 0; c0 < NCHUNK; c0 += 16) { unsigned v[16]; float d[16];
#pragma unroll
            for (int i = 0; i < 16; ++i) { v[i] = st[(size_t)(c0 + i) * 131072 + e2]; d[i] = dasum[(c0 + i) * NHEAD + h]; }
#pragma unroll
            for (int i = 0; i < 16; ++i) { const unsigned w = pk2(r0, r1); const float dd = __expf(d[i]);
                r0 = r0 * dd + __uint_as_float(v[i] << 16); r1 = r1 * dd + __uint_as_float(v[i] & 0xffff0000u); v[i] = w; }
            if (!dry) {
#pragma unroll
                for (int i = 0; i < 16; ++i) st[(size_t)(c0 + i) * 131072 + e2] = v[i]; } }
    }
}
__device__ __forceinline__ void ssd_out_phase(const Params& p, int b, LAS unsigned char* lds, int dry = 0) {
    const int tid = opq_tid(), lane = tid & 63, wave = tid >> 6, fr = lane & 15, kg = lane >> 4;
    bf16_t* P = proj_ptr(p); const bf16_t* ST = states_ptr(p, b);
    const float* cw = opq(p.ssd_conv_w); const float* cb = opq(p.ssd_conv_b);
    LAS bf16_t* sC = (LAS bf16_t*)lds; LAS bf16_t* sCB = (LAS bf16_t*)(lds + 34816); LAS bf16_t* sB = (LAS bf16_t*)(lds + 69632); LAS bf16_t* sXT = (LAS bf16_t*)(lds + 69632 + wave * 8704);
    LAS float* sACS = (LAS float*)(lds + 139264) + wave * 128; LAS float* sDT = (LAS float*)(lds + 143360) + wave * 128; LAS float* sSSQ = (LAS float*)(lds + 147456);
    for (int u = opq_bid(); u < NCHUNK * NGRP; u += gridDim.x) {
        const int c = u >> 2, g = u & 3, t0 = c * CHUNK, h = 8 * g + wave;
        __syncthreads();
        MSTAMP(p, 0);
        (void)ssd_dt_setup(p, P, t0, h, lane, sACS, sDT);
        { const int cg = tid & 15, rs = (tid >> 4) & 15, isC = tid >> 8; float o[8][8];
          conv_rows<8>(P, t0 + 8 * rs, C_B + isC * 512 + g * 128 + 8 * cg, cw, cb, 2048 + isC * 512 + g * 128 + 8 * cg, o);
          LAS bf16_t* dst = (isC ? sC : sB) + (8 * rs) * 136 + 8 * cg;
#pragma unroll
          for (int r = 0; r < 8; ++r) *(LAS bf16x8*)(dst + r * 136) = pack8(o[r]); }
        __syncthreads();
#pragma unroll
        for (int ms = 0; ms < 8; ++ms) if (ms <= wave) { f32x4 a4 = (f32x4){0.f, 0.f, 0.f, 0.f};
#pragma unroll
            for (int kn = 0; kn < 4; ++kn) { const bf16x8 a = *(const LAS bf16x8*)(sB + (16 * ms + fr) * 136 + 32 * kn + 8 * kg), bb = *(const LAS bf16x8*)(sC + (16 * wave + fr) * 136 + 32 * kn + 8 * kg);
                a4 = MFMA16(a, bb, a4); }
            u32x2 w; w.x = pk2(a4[0], a4[1]); w.y = pk2(a4[2], a4[3]);
            *(LAS u32x2*)(sCB + (16 * wave + fr) * 136 + 16 * ms + 4 * kg) = w; }
        __syncthreads();
        MSTAMP(p, 1);
        const float Dh = opq(p.ssd_d)[h];
        const unsigned zbase0 = (unsigned)((t0 + fr) * LD + C_Z + h * 64 + 4 * kg);
        float ssq[8];
#pragma unroll
        for (int nt = 0; nt < 8; ++nt) ssq[nt] = 0.f;
        for (int ph = 0; ph < 2; ++ph) {
            unsigned zb = zbase0 + 32u * ph; asm volatile("" : "+v"(zb));
            unsigned pfo = (unsigned)(((c * NHEAD + h) * 64 + 32 * ph + fr) * 128 + 8 * kg); asm volatile("" : "+v"(pfo));
            bf16x8 pf[4][2];
#pragma unroll
            for (int sn = 0; sn < 4; ++sn) { pf[sn][0] = *(const bf16x8*)(ST + (pfo + (unsigned)(32 * sn))); pf[sn][1] = *(const bf16x8*)(ST + (pfo + (unsigned)(16 * 128 + 32 * sn))); }
            { const int cg = lane & 3, rs = lane >> 2; float o[8][8];
              conv_rows<8>(P, t0 + 8 * rs, C_X + h * 64 + 32 * ph + 8 * cg, cw, cb, h * 64 + 32 * ph + 8 * cg, o);
#pragma unroll
              for (int q = 0; q < 8; ++q) { float v[8] = {o[0][q], o[1][q], o[2][q], o[3][q], o[4][q], o[5][q], o[6][q], o[7][q]};
                  *(LAS bf16x8*)(sXT + (8 * cg + q) * 136 + 8 * rs) = pack8(v); } }
            asm volatile("s_waitcnt lgkmcnt(0)" ::: "memory");
            f32x4 acc[2][8];
#pragma unroll
            for (int nt = 0; nt < 8; ++nt) { acc[0][nt] = (f32x4){0.f, 0.f, 0.f, 0.f}; acc[1][nt] = (f32x4){0.f, 0.f, 0.f, 0.f}; }
#pragma unroll
            for (int nt = 0; nt < 8; ++nt) {
#pragma unroll
                for (int sn = 0; sn < 4; ++sn) { const bf16x8 cf = *(const LAS bf16x8*)(sC + (16 * nt + fr) * 136 + 32 * sn + 8 * kg);
                    acc[0][nt] = MFMA16(pf[sn][0], cf, acc[0][nt]); acc[1][nt] = MFMA16(pf[sn][1], cf, acc[1][nt]); }
                const float sc = __expf(sACS[16 * nt + fr]);
                acc[0][nt] *= sc; acc[1][nt] *= sc; }
#pragma unroll
            for (int sk = 0; sk < 4; ++sk) {
                const int s0 = 32 * sk + 8 * kg;
                const bf16x8 xa0 = *(const LAS bf16x8*)(sXT + fr * 136 + s0), xa1 = *(const LAS bf16x8*)(sXT + (16 + fr) * 136 + s0);
                const f32x4 as0 = *(const LAS f32x4*)(sACS + s0), as1 = *(const LAS f32x4*)(sACS + s0 + 4), d0 = *(const LAS f32x4*)(sDT + s0), d1 = *(const LAS f32x4*)(sDT + s0 + 4);
#pragma unroll
                for (int nt = 0; nt < 8; ++nt) if (nt >= 2 * sk) { const int l = 16 * nt + fr; const float acsl = sACS[l];
                    float cbv[8]; unpack8(*(const LAS u32x4*)(sCB + l * 136 + s0), cbv);
                    float m[8];
#pragma unroll
                    for (int i = 0; i < 8; ++i) { const int s = s0 + i; const float as = i < 4 ? as0[i & 3] : as1[i & 3], ds = i < 4 ? d0[i & 3] : d1[i & 3];
                        float mv = (s <= l) ? cbv[i] * __expf(acsl - as) * ds : 0.f; if (s == l) mv += Dh; m[i] = mv; }
                    const bf16x8 mb = pack8(m);
                    acc[0][nt] = MFMA16(xa0, mb, acc[0][nt]); acc[1][nt] = MFMA16(xa1, mb, acc[1][nt]);
                    asm volatile("" ::: "memory"); }
            }
            u32x2 zall[8][2];
#pragma unroll
            for (int nt = 0; nt < 8; ++nt)
#pragma unroll
                for (int mt = 0; mt < 2; ++mt) zall[nt][mt] = *(const u32x2*)(P + (zb + (unsigned)(16 * nt * LD + 16 * mt)));
#pragma unroll
            for (int nt = 0; nt < 8; ++nt)
#pragma unroll
                for (int mt = 0; mt < 2; ++mt) { u32x2* zp = (u32x2*)(P + (zb + (unsigned)(16 * nt * LD + 16 * mt)));
                    const u32x2 zw = zall[nt][mt]; float y[4];
                    y[0] = acc[mt][nt][0] * siluf_(__uint_as_float(zw.x << 16)); y[1] = acc[mt][nt][1] * siluf_(__uint_as_float(zw.x & 0xffff0000u));
                    y[2] = acc[mt][nt][2] * siluf_(__uint_as_float(zw.y << 16)); y[3] = acc[mt][nt][3] * siluf_(__uint_as_float(zw.y & 0xffff0000u));
                    ssq[nt] += (y[0] * y[0] + y[1] * y[1]) + (y[2] * y[2] + y[3] * y[3]);
                    u32x2 yw; yw.x = pk2(y[0], y[1]); yw.y = pk2(y[2], y[3]); (void)zp; *(LAS u32x2*)(sXT + (16 * nt + fr) * 32 + 16 * mt + 4 * kg) = yw; }
            asm volatile("s_waitcnt lgkmcnt(0)" ::: "memory");
            { const int rr = lane >> 2, cc = lane & 3;
              unsigned so = (unsigned)((t0 + rr) * LD + C_Z + h * 64 + 32 * ph + 8 * cc); asm volatile("" : "+v"(so));
              if (ph == 0) {
#pragma unroll
                  for (int i = 0; i < 8; ++i) { const u32x4 w = *(const LAS u32x4*)(sXT + (16 * i + rr) * 32 + 8 * cc); if (!dry) *(u32x4*)(P + (so + (unsigned)(16 * i * LD))) = w; } } }
            asm volatile("s_waitcnt lgkmcnt(0)" ::: "memory");
        }
        MSTAMP(p, 2);
#pragma unroll
        for (int nt = 0; nt < 8; ++nt) { float v = ssq[nt]; v += __shfl_xor(v, 16); v += __shfl_xor(v, 32); if (kg == 0) sSSQ[wave * 128 + 16 * nt + fr] = v; }
        __syncthreads();
        { const int rr = lane >> 2, cc = lane & 3;
          const float* ng = opq(p.ssd_norm_g) + g * 512 + wave * 64 + 8 * cc;
          f32x4 gg[2][2];
#pragma unroll
          for (int ph = 0; ph < 2; ++ph) { gg[ph][0] = *(const f32x4*)(ng + 32 * ph); gg[ph][1] = *(const f32x4*)(ng + 32 * ph + 4); }
          unsigned so = (unsigned)((t0 + rr) * LD + C_Z + h * 64 + 8 * cc); asm volatile("" : "+v"(so));
          u32x4 yv[8][2];
#pragma unroll
          for (int i = 0; i < 8; ++i)
#pragma unroll
              for (int ph = 0; ph < 2; ++ph) yv[i][ph] = ph == 0 ? *(const u32x4*)(P + (so + (unsigned)(16 * i * LD))) : *(const LAS u32x4*)(sXT + (16 * i + rr) * 32 + 8 * cc);
#pragma unroll
          for (int i = 0; i < 8; ++i) { const int l = 16 * i + rr; float tot = 0.f;
#pragma unroll
              for (int w2 = 0; w2 < 8; ++w2) tot += sSSQ[w2 * 128 + l];
              const float rs = 1.f / sqrtf(tot * (1.f / 512.f) + EPS);
#pragma unroll
              for (int ph = 0; ph < 2; ++ph) { float v[8]; unpack8(yv[i][ph], v);
                  v[0] *= rs * gg[ph][0][0]; v[1] *= rs * gg[ph][0][1]; v[2] *= rs * gg[ph][0][2]; v[3] *= rs * gg[ph][0][3];
                  v[4] *= rs * gg[ph][1][0]; v[5] *= rs * gg[ph][1][1]; v[6] *= rs * gg[ph][1][2]; v[7] *= rs * gg[ph][1][3];
                  if (!dry) *(bf16x8*)(P + (so + (unsigned)(16 * i * LD + 32 * ph))) = pack8(v); } } }
        MSTAMP(p, 3);
    }
}
#define XB_TMO      128
#define XB_XCNT(j)  (256  + 64 * (j))
#define XB_XSUB(j)  (1280 + 64 * (j))
#define XB_XGEN(j)  (2304 + 64 * (j))
#define XB_TOP      3328
#define XB_TOPGEN   3392
#define XCD_BAR_WORDS 3456
#define XB_SPIN_CAP (1u << 18)

__device__ __forceinline__ unsigned xb_ld(unsigned* p)              { return __hip_atomic_load(p, __ATOMIC_RELAXED, __HIP_MEMORY_SCOPE_AGENT); }
__device__ __forceinline__ unsigned xb_add(unsigned* p, unsigned v) { return __hip_atomic_fetch_add(p, v, __ATOMIC_RELAXED, __HIP_MEMORY_SCOPE_AGENT); }
__device__ __forceinline__ unsigned xb_xcc_id() { return (unsigned)__builtin_amdgcn_s_getreg((3 << 11) | 20) & 0xFu; }
#define XB_SPIN(cond, bar) do { unsigned _sp = 0; while (cond) { __builtin_amdgcn_s_sleep(1); \
    if ((++_sp & 255u) == 0u) { if (xb_ld(&(bar)[XB_TMO])) break; if (_sp > XB_SPIN_CAP) { atomicAdd(&(bar)[XB_TMO], 1u); break; } } } } while (0)

struct XcdBarrier {
    unsigned* bar; unsigned x;
    volatile LAS unsigned* st;
};

__device__ __forceinline__ XcdBarrier xcd_barrier_post(unsigned* bar, volatile LAS unsigned* st) {
    XcdBarrier b; b.bar = bar; b.x = xb_xcc_id(); b.st = st;
    if (threadIdx.x == 0) (void)xb_add(&bar[XB_XCNT(b.x)], 1u);
    return b;
}
__device__ __forceinline__ void xcd_barrier_complete(unsigned* bar, unsigned x, unsigned& nloc, unsigned& nx) {
    const unsigned G = gridDim.x * gridDim.y * gridDim.z;
    unsigned sum, cnt, mine, sp = 0u;
    for (;;) {
        sum = 0u; cnt = 0u; mine = 0u;
#pragma unroll
        for (unsigned j = 0; j < 16; ++j) { const unsigned c = xb_ld(&bar[XB_XCNT(j)]); sum += c; cnt += (c > 0u) ? 1u : 0u; mine = (j == x) ? c : mine; }
        if (sum == G) break;
        __builtin_amdgcn_s_sleep(1);
        if ((++sp & 255u) == 0u) { if (xb_ld(&bar[XB_TMO])) break; if (sp > XB_SPIN_CAP) { atomicAdd(&bar[XB_TMO], 1u); break; } }
    }
    nloc = mine > 0u ? mine : 1u; nx = cnt > 0u ? cnt : 1u;
}

__device__ __forceinline__ void xcd_barrier(const XcdBarrier& b) {
    asm volatile("s_waitcnt vmcnt(0)" ::: "memory");
    __syncthreads();
    if (threadIdx.x == 0) {
        unsigned* bar = b.bar; asm volatile("" : "+s"(bar));
        unsigned bx = b.x; asm volatile("" : "+s"(bx));
        __builtin_amdgcn_s_waitcnt(0);
        unsigned nloc = b.st[0], nx = b.st[1];
        if (nloc == 0u) { xcd_barrier_complete(bar, bx, nloc, nx); b.st[0] = nloc; b.st[1] = nx; }
        const unsigned old = xb_add(&bar[XB_XSUB(bx)], 1u);
        const unsigned gen = old / nloc;
        if (old + 1u == (gen + 1u) * nloc) {
            __builtin_amdgcn_fence(__ATOMIC_RELEASE, "agent");
            asm volatile("s_waitcnt vmcnt(0)" ::: "memory");
            const unsigned og = xb_add(&bar[XB_TOP], 1u);
            const unsigned tg = og / nx;
            if (og + 1u == (tg + 1u) * nx) xb_add(&bar[XB_TOPGEN], 1u);
            else XB_SPIN(xb_ld(&bar[XB_TOPGEN]) == tg, bar);
            __builtin_amdgcn_fence(__ATOMIC_ACQUIRE, "agent");
            xb_add(&bar[XB_XGEN(bx)], 1u);
            asm volatile("s_waitcnt vmcnt(0)" ::: "memory");
        } else {
            XB_SPIN(xb_ld(&bar[XB_XGEN(bx)]) == gen, bar);
            __builtin_amdgcn_fence(__ATOMIC_ACQUIRE, "agent");
            asm volatile("s_waitcnt vmcnt(0)" ::: "memory");
        }
    }
    __syncthreads();
}

#ifdef REP_COLD
#define REP_SEP() xcd_barrier(bar)
#else
#define REP_SEP() __syncthreads()
#endif
#define RUNP(n, ...) do { if ((n) > 1) { for (int r_ = nrep(n) - 1; r_ > 0; --r_) { const int dry_ = 1; (void)dry_; __VA_ARGS__; REP_SEP(); } } { const int dry_ = 0; (void)dry_; __VA_ARGS__; } } while (0)
#ifndef REP_SYNC
#define REP_SYNC 1
#endif
#ifndef REP_P0
#define REP_P0 1
#endif
#ifndef REP_P1
#define REP_P1 1
#endif
#ifndef REP_P5
#define REP_P5 1
#endif
#ifndef REP_P6
#define REP_P6 1
#endif
#ifndef REP_ST
#define REP_ST 1
#endif
#ifndef REP_LA
#define REP_LA 1
#endif
#ifndef REP_AT
#define REP_AT 1
#endif
#ifndef REP_SC
#define REP_SC 1
#endif
#ifndef REP_SO
#define REP_SO 1
#endif
#ifndef REP_LF
#define REP_LF 1
#endif
__device__ __forceinline__ int nrep(int n) { asm volatile("" : "+s"(n)); return n; }
__device__ __forceinline__ LAS unsigned char* opl(LAS unsigned char* q) { asm volatile("" : "+s"(q)); return q; }
__global__ void __launch_bounds__(512) mk(Params p) {
    extern __shared__ __attribute__((aligned(16))) unsigned char lds_raw[];
    LAS unsigned char* lds = (LAS unsigned char*)lds_raw;
    if (threadIdx.x < 4) ((volatile LAS unsigned*)(lds + LDS_BYTES - 16))[threadIdx.x] = 0u;
    __syncthreads();
    const XcdBarrier bar = xcd_barrier_post((unsigned*)(p.ws + WS_CTL), (volatile LAS unsigned*)(lds + LDS_BYTES - 16));
    if (p.hi > 1000) cg::this_grid().sync();
#ifdef PROBE_SPAN
    unsigned long long ts0 = 0, ts1 = 0;
#define STAMP(i) do { if ((i) == PROBE_SPAN) ts0 = __builtin_amdgcn_s_memrealtime(); if ((i) == PROBE_SPAN + PROBE_LEN) ts1 = __builtin_amdgcn_s_memrealtime(); } while (0)
#else
#define STAMP(i) do { } while (0)
#endif
    STAMP(0);
    RUNP(REP_P0, phase0(p, opl(lds)));
    xcd_barrier(bar); STAMP(1);
#define BATCH_PHASES(b) do { \
        RUNP(REP_P1, phase1_gemm(p, b, opl(lds))); \
        for (int r = 0; r < nrep(REP_SYNC); ++r) xcd_barrier(bar); \
        STAMP(2 + 6 * b); \
        RUNP(REP_ST, ssd_states_phase(p, b, opl(lds))); \
        __syncthreads(); STAMP(20 + 3 * b); \
        RUNP(REP_LA, lru_phase<false>(p, b, opl(lds), 0)); \
        __syncthreads(); STAMP(21 + 3 * b); \
        RUNP(REP_AT, attn_phase(p, b, opl(lds), dry_)); \
        xcd_barrier(bar); STAMP(3 + 6 * b); \
        RUNP(REP_SC, ssd_scan_phase(p, b, dry_)); \
        lru_carry_phase(p, b); \
        xcd_barrier(bar); STAMP(4 + 6 * b); \
        RUNP(REP_SO, ssd_out_phase(p, b, opl(lds), dry_)); \
        __syncthreads(); STAMP(22 + 3 * b); \
        RUNP(REP_LF, lru_phase<true>(p, b, opl(lds), dry_)); \
        xcd_barrier(bar); STAMP(5 + 6 * b); \
        RUNP(REP_P5, phase5_gemm(p, b, opl(lds))); \
        xcd_barrier(bar); STAMP(6 + 6 * b); \
        RUNP(REP_P6, phase6_gemm(p, b, opl(lds))); \
        if (b + 1 < NBATCH && gridDim.x != 256) xcd_barrier(bar);     \
        STAMP(7 + 6 * b); \
    } while (0)
    BATCH_PHASES(0);
    BATCH_PHASES(1);
#ifdef PROBE_MA
    if (blockIdx.x == 0 && threadIdx.x == 0) { const unsigned long long* tsm = (const unsigned long long*)(p.ws + 255 * MiB); const unsigned long long t2 = __builtin_amdgcn_s_memrealtime(), want = 8ull * (tsm[PROBE_MB] - tsm[PROBE_MA]);
        while (__builtin_amdgcn_s_memrealtime() - t2 < want) __builtin_amdgcn_s_sleep(16); }
#endif
#ifdef PROBE_SPAN
    if (blockIdx.x == 0 && threadIdx.x == 0) { const unsigned long long t2 = __builtin_amdgcn_s_memrealtime(), want = 8ull * (ts1 - ts0);
        while (__builtin_amdgcn_s_memrealtime() - t2 < want) __builtin_amdgcn_s_sleep(16); }
#endif
}

static void launch_mk(Params& p, int lo, int hi, int grid, hipStream_t stream) {
    p.lo = lo; p.hi = hi; void* args[] = {&p};
    (void)hipMemsetAsync(p.ws + WS_CTL, 0, 65536, stream);
    hipError_t e = hipLaunchCooperativeKernel((const void*)mk, dim3(grid), dim3(512), args, LDS_BYTES, stream);
    if (e != hipSuccess) fprintf(stderr, "cooperative launch failed: %s (grid %d)\n", hipGetErrorString(e), grid);
}
extern "C" void kernel_launch(void* const* d_in, const int* in_sizes, int n_in, void* d_out, int out_size, void* d_ws, size_t ws_size, hipStream_t stream) {
    static int grid = 0;
    if (grid == 0) {
        if (n_in != 24 || out_size != MTOK * DM || ws_size < WS_END) { fprintf(stderr, "kernel_launch: unexpected shapes (n_in %d out %d ws %zu)\n", n_in, out_size, ws_size); grid = -1; return; }
        int dev = 0, cus = 0, per_cu = 0;
        hipGetDevice(&dev); hipDeviceGetAttribute(&cus, hipDeviceAttributeMultiprocessorCount, dev);
        hipFuncSetAttribute((const void*)mk, hipFuncAttributeMaxDynamicSharedMemorySize, LDS_BYTES);
        hipOccupancyMaxActiveBlocksPerMultiprocessor(&per_cu, (const void*)mk, 512, LDS_BYTES);
        if (per_cu < 1) { fprintf(stderr, "kernel_launch: occupancy query says %d blocks/CU\n", per_cu); per_cu = 1; }
        grid = cus * 1;
        (void)hipGetLastError();
    }
    if (grid < 0) return;
    Params p{};
    const float** f = (const float**)&p;
    for (int i = 0; i < 24; ++i) f[i] = (const float*)d_in[i];
    p.out = (float*)d_out; p.ws = (unsigned char*)d_ws;
    launch_mk(p, 0, 14, grid, stream);
}
```

```cpp
#define NAIVE_GEMM 0
#define NAIVE_ATT 0
#define NAIVE_LRU 0
#define NAIVE_SSD 0
#define ONE_LAUNCH 1

#include <hip/hip_runtime.h>
#include <hip/hip_cooperative_groups.h>
#include <cstdio>
#include <cstdint>
namespace cg = cooperative_groups;

#ifndef NAIVE_GEMM
#define NAIVE_GEMM 1
#endif
#ifndef NAIVE_SSD
#define NAIVE_SSD 1
#endif
#ifndef NAIVE_LRU
#define NAIVE_LRU 1
#endif
#ifndef NAIVE_ATT
#define NAIVE_ATT 1
#endif
#ifndef ONE_LAUNCH
#define ONE_LAUNCH 0
#endif

namespace pg8 {
#define PG8_LAS __attribute__((address_space(3)))
typedef unsigned short bf16_t;
typedef short bf16x8 __attribute__((ext_vector_type(8)));
typedef float f32x4 __attribute__((ext_vector_type(4)));
typedef unsigned u32x4 __attribute__((ext_vector_type(4)));
constexpr int BM = 256, BK = 64, HALF = 128, HTB = HALF * BK * 2  , STAGE_BYTES = 8 * HTB, NXCD = 8, WGM = 8;

__host__ __device__ __forceinline__ int lds_byte(int r, int c) { const int st = (r >> 4) * 2 + (c >> 5), rr = r & 15, cc = c & 31, ob = rr * 64 + cc * 2; return st * 1024 + (ob ^ (((ob >> 9) & 1) << 5)); }
__host__ __device__ __forceinline__ void stage_rc(int b, int& R, int& C) { const int st = b / 1024, sb = b % 1024, swz = sb ^ (((sb >> 9) & 1) << 5); R = (st >> 1) * 16 + swz / 64; C = (st & 1) * 32 + (swz % 64) / 2; }
__host__ __device__ __forceinline__ int perm32(int rho) { const int n = rho >> 4, i = rho & 15; return 8 * (i >> 2) + 4 * n + (i & 3); }

struct Unit { int pm, pn; };
struct Gemm { const bf16_t* A; const bf16_t* Bt; int M, N, K, lda, ldb; };

struct StaticOrder {
    int nM, nN, nwg, G, c;
    __host__ __device__ void init(int M, int N, int G_, int c_) { nM = M / BM; nN = N / BM; nwg = nM * nN; G = G_; c = c_; }
    __host__ __device__ bool next(int i, Unit& u) const {
        const long L = (long)i * G + c; if (L >= nwg) return false;
        int wgid = (int)L; { const int q = nwg / NXCD, r = nwg % NXCD, xcd = wgid % NXCD, off = wgid / NXCD; wgid = (xcd < r ? xcd * (q + 1) : r * (q + 1) + (xcd - r) * q) + off; }
        const int nig = WGM * nN, gid = wgid / nig, fm = gid * WGM, gsz = (nM - fm) < WGM ? (nM - fm) : WGM;
        u.pm = fm + ((wgid % nig) % gsz); u.pn = (wgid % nig) / gsz; return true;
    }
    __device__ __forceinline__ void a_ready(const Unit&) const {}
    __device__ __forceinline__ void done(const Unit&) const {}
};

__device__ __forceinline__ unsigned cvt_pk_bf16(float lo, float hi) { unsigned r; asm volatile("v_cvt_pk_bf16_f32 %0, %1, %2" : "=v"(r) : "v"(lo), "v"(hi)); return r; }
typedef float f32x2 __attribute__((ext_vector_type(2)));
__device__ __forceinline__ f32x2 gelu_pk(f32x2 v) {
    const f32x2 av = __builtin_elementwise_abs(v), d = av * 0.2316418882f + 1.0f;
    f32x2 t; t.x = __builtin_amdgcn_rcpf(d.x); t.y = __builtin_amdgcn_rcpf(d.y);
    f32x2 q = t * 0.5307027145f + (-0.7265760135f); q = q * t + 0.7107068705f; q = q * t + (-0.142248368f); q = q * t + 0.127414796f; q = q * t;
    const f32x2 s = (v * v) * (-0.72134752044f);
    f32x2 e; e.x = __builtin_amdgcn_exp2f(s.x); e.y = __builtin_amdgcn_exp2f(s.y);
    const f32x2 m = v * (q * e), r = v - m;
    f32x2 o; o.x = v.x < 0.f ? m.x : r.x; o.y = v.y < 0.f ? m.y : r.y; return o;
}

template <int ACT  > struct EpiBf16 {
    static constexpr bool PERM = true, AFTER_DRAIN = false; static_assert(ACT == 0 || ACT == 1, "EpiBf16: ACT is 0 (none) or 1 (gelu_pk)");
    bf16_t* O; int ldc; const float* bias; int split_cols; size_t split_stride; float scale0;
    __device__ __forceinline__ void operator()(const f32x4 (&acc)[2][2][4][2], const Unit& u, int wr, int wc, int fr, int fq) const {
        const int row0 = u.pm * BM + wr * 64 + fr; int colt = u.pn * BM; bf16_t* base = O;
        float sc = 1.f; if (split_cols) { const int t = colt / split_cols; base += (size_t)t * split_stride; colt -= t * split_cols; if (t == 0) sc = scale0; }
        const int col0 = colt + wc * 32 + 8 * fq, bcol0 = u.pn * BM + wc * 32 + 8 * fq;
        f32x4 bv[2][2];
#pragma unroll
        for (int bj = 0; bj < 2; ++bj)
#pragma unroll
            for (int n = 0; n < 2; ++n) bv[bj][n] = bias ? *(const f32x4*)(bias + bcol0 + bj * HALF + 4 * n) : (f32x4){0.f, 0.f, 0.f, 0.f};
#pragma unroll
        for (int ai = 0; ai < 2; ++ai)
#pragma unroll
            for (int m = 0; m < 4; ++m) { bf16_t* rowp = base + (size_t)(row0 + ai * HALF + m * 16) * ldc + col0;
#pragma unroll
                for (int bj = 0; bj < 2; ++bj) { f32x4 v0 = acc[ai][bj][m][0] + bv[bj][0], v1 = acc[ai][bj][m][1] + bv[bj][1];
                    if (ACT == 1) { f32x2 a = gelu_pk((f32x2){v0[0], v0[1]}), b = gelu_pk((f32x2){v0[2], v0[3]}), c = gelu_pk((f32x2){v1[0], v1[1]}), d = gelu_pk((f32x2){v1[2], v1[3]});
                        v0 = (f32x4){a.x, a.y, b.x, b.y}; v1 = (f32x4){c.x, c.y, d.x, d.y}; }
                    v0 = v0 * sc; v1 = v1 * sc; u32x4 w; w.x = cvt_pk_bf16(v0[0], v0[1]); w.y = cvt_pk_bf16(v0[2], v0[3]); w.z = cvt_pk_bf16(v1[0], v1[1]); w.w = cvt_pk_bf16(v1[2], v1[3]);
                    *(u32x4*)(rowp + bj * HALF) = w; } }
    }
};
template <class Epi, class Sched, bool ALIGN_EPI = false, bool SP2 = false>
__device__ __forceinline__ void gemm_phase(PG8_LAS unsigned char* lds, const Gemm g, const Sched& S, const Epi& E) {
    int tid_ = threadIdx.x; asm volatile("" : "+v"(tid_));
    const int tid = tid_, wid = __builtin_amdgcn_readfirstlane(tid >> 6), lane = tid & 63, wr = wid >> 2, wc = wid & 3, fr = lane & 15, fq = lane >> 4;
    const int K = g.K, nt = K / BK;
    unsigned voffA[2], voffB[2];
#pragma unroll
    for (int i = 0; i < 2; ++i) { int R, C; stage_rc(tid * 16 + i * 8192, R, C); const int Rb = Epi::PERM ? ((R & ~31) + perm32(R & 31)) : R;
        voffA[i] = (unsigned)(R * g.lda + C) * 2u; voffB[i] = (unsigned)(Rb * g.ldb + C) * 2u; }
    const size_t kstep = (size_t)(BK * 2);
    const size_t hstepA = (size_t)HALF * g.lda * 2, hstepB = (size_t)HALF * g.ldb * 2;
    const size_t tstepA = 2 * hstepA, tstepB = 2 * hstepB;
    const unsigned ldsw = (unsigned)wid * 1024u;
    const int aoff = lds_byte(wr * 64 + fr, fq * 8), boff = lds_byte(wc * 32 + fr, fq * 8);
#define PG8_SA(b, h) (((b) * 2 + (h)) * HTB)
#define PG8_SB(b, h) ((4 + (b) * 2 + (h)) * HTB)
#define PG8_STAGE(bufoff, gbase, voff) do { _Pragma("unroll") for (int _i = 0; _i < 2; ++_i) \
        __builtin_amdgcn_global_load_lds((const unsigned*)((const char*)(gbase) + (voff)[_i]), (PG8_LAS unsigned*)(lds + (bufoff) + ldsw + _i * 8192), 16, 0, 0); } while (0)
#define PG8_LDA(dst, b, h) do { _Pragma("unroll") for (int m = 0; m < 4; ++m) _Pragma("unroll") for (int k = 0; k < 2; ++k) dst[m][k] = *(const PG8_LAS bf16x8*)(lds + PG8_SA(b, h) + aoff + m * 2048 + k * 1024); } while (0)
#define PG8_LDB(dst, b, h) do { _Pragma("unroll") for (int n = 0; n < 2; ++n) _Pragma("unroll") for (int k = 0; k < 2; ++k) dst[n][k] = *(const PG8_LAS bf16x8*)(lds + PG8_SB(b, h) + boff + n * 2048 + k * 1024); } while (0)
#define PG8_MMA(ai, bj, At, Bt) do { __builtin_amdgcn_s_setprio(1); _Pragma("unroll") for (int m = 0; m < 4; ++m) _Pragma("unroll") for (int n = 0; n < 2; ++n) _Pragma("unroll") for (int k = 0; k < 2; ++k) \
        acc[ai][bj][m][n] = __builtin_amdgcn_mfma_f32_16x16x32_bf16(Bt[n][k], At[m][k], acc[ai][bj][m][n], 0, 0, 0); __builtin_amdgcn_s_setprio(0); } while (0)
#define PG8_WAIT_V(n) asm volatile("s_waitcnt vmcnt(" #n ")" ::: "memory")
#define PG8_WAIT_L(n) asm volatile("s_waitcnt lgkmcnt(" #n ")" ::: "memory")
#define PG8_BAR __builtin_amdgcn_s_barrier()
#define PG8_SCHED __builtin_amdgcn_sched_barrier(0)
    Unit cur, nxt; int ui = 0;
    if (!S.next(0, cur)) return;
    f32x4 acc[2][2][4][2];
#pragma unroll
    for (int a = 0; a < 2; ++a)
#pragma unroll
        for (int b = 0; b < 2; ++b)
#pragma unroll
            for (int m = 0; m < 4; ++m)
#pragma unroll
                for (int n = 0; n < 2; ++n) acc[a][b][m][n] = (f32x4){0.f, 0.f, 0.f, 0.f};
    bf16x8 At[4][2], B0[2][2], B1[2][2];
    const char* cA = (const char*)g.A + (size_t)cur.pm * tstepA; const char* cB = (const char*)g.Bt + (size_t)cur.pn * tstepB;
    S.a_ready(cur);
    if constexpr (SP2) {
        PG8_STAGE(PG8_SB(0, 0), cB, voffB); PG8_STAGE(PG8_SB(0, 1), cB + hstepB, voffB); PG8_STAGE(PG8_SA(0, 0), cA, voffA); PG8_STAGE(PG8_SA(0, 1), cA + hstepA, voffA);
        if (wr == 1) PG8_BAR;
        PG8_WAIT_V(2); PG8_BAR;
        PG8_STAGE(PG8_SB(1, 0), cB + kstep, voffB); PG8_STAGE(PG8_SA(1, 0), cA + kstep, voffA); PG8_STAGE(PG8_SB(1, 1), cB + hstepB + kstep, voffB);
        PG8_WAIT_V(6); PG8_BAR;
    } else {
        PG8_STAGE(PG8_SB(0, 0), cB, voffB); PG8_STAGE(PG8_SA(0, 0), cA, voffA); PG8_STAGE(PG8_SB(0, 1), cB + hstepB, voffB); PG8_STAGE(PG8_SA(0, 1), cA + hstepA, voffA);
        if (wr == 1) PG8_BAR;
        PG8_WAIT_V(4); PG8_BAR;
        PG8_STAGE(PG8_SB(1, 0), cB + kstep, voffB); PG8_STAGE(PG8_SA(1, 0), cA + kstep, voffA); PG8_STAGE(PG8_SB(1, 1), cB + hstepB + kstep, voffB);
        PG8_WAIT_V(6); PG8_BAR;
    }
    for (;;) {
        const bool has_next = S.next(ui + 1, nxt);
        const char* nA = has_next ? (const char*)g.A + (size_t)nxt.pm * tstepA : cA; const char* nB = has_next ? (const char*)g.Bt + (size_t)nxt.pn * tstepB : cB;
        for (int t = 0; t < nt; t += 2) {
            const bool last = (t == nt - 2);
            const char* a1 = cA + (size_t)(t + 1) * kstep;
            const char* a2 = last ? nA : cA + (size_t)(t + 2) * kstep; const char* b2 = last ? nB : cB + (size_t)(t + 2) * kstep;
            const char* a3 = a2 + kstep; const char* b3 = b2 + kstep;
            if (last && has_next) S.a_ready(nxt);
            if constexpr (SP2) {
            PG8_LDB(B0, 0, 0); PG8_LDB(B1, 0, 1); PG8_SCHED; PG8_LDA(At, 0, 0); PG8_STAGE(PG8_SA(1, 1), a1 + hstepA, voffA);
            PG8_WAIT_V(8); PG8_WAIT_L(0); PG8_BAR; PG8_MMA(0, 0, At, B0); PG8_MMA(0, 1, At, B1); PG8_BAR; PG8_SCHED;
            PG8_LDA(At, 0, 1); PG8_STAGE(PG8_SB(0, 0), b2, voffB); PG8_STAGE(PG8_SB(0, 1), b2 + hstepB, voffB); PG8_STAGE(PG8_SA(0, 0), a2, voffA);
            PG8_WAIT_V(8); PG8_WAIT_L(0); PG8_BAR; PG8_MMA(1, 0, At, B0); PG8_MMA(1, 1, At, B1); PG8_BAR; PG8_SCHED;
            PG8_LDB(B0, 1, 0); PG8_LDB(B1, 1, 1); PG8_SCHED; PG8_LDA(At, 1, 0); PG8_STAGE(PG8_SA(0, 1), a2 + hstepA, voffA);
            PG8_WAIT_V(8); PG8_WAIT_L(0); PG8_BAR; PG8_MMA(0, 0, At, B0); PG8_MMA(0, 1, At, B1); PG8_BAR; PG8_SCHED;
            PG8_LDA(At, 1, 1); PG8_STAGE(PG8_SB(1, 0), b3, voffB); PG8_STAGE(PG8_SB(1, 1), b3 + hstepB, voffB); PG8_STAGE(PG8_SA(1, 0), a3, voffA);
            PG8_WAIT_V(8); PG8_WAIT_L(0); PG8_BAR; PG8_MMA(1, 0, At, B0); PG8_MMA(1, 1, At, B1); PG8_BAR; PG8_SCHED;
            } else {
            PG8_LDB(B0, 0, 0); PG8_SCHED; PG8_LDA(At, 0, 0); PG8_STAGE(PG8_SA(1, 1), a1 + hstepA, voffA);
            PG8_WAIT_L(8); PG8_BAR; PG8_WAIT_L(0); PG8_MMA(0, 0, At, B0); PG8_BAR; PG8_SCHED;
            PG8_LDB(B1, 0, 1); PG8_STAGE(PG8_SB(0, 0), b2, voffB);
            PG8_BAR; PG8_WAIT_L(0); PG8_MMA(0, 1, At, B1); PG8_BAR;
            PG8_LDA(At, 0, 1); PG8_STAGE(PG8_SA(0, 0), a2, voffA);
            PG8_BAR; PG8_WAIT_L(0); PG8_MMA(1, 0, At, B0); PG8_BAR; PG8_SCHED;
            PG8_STAGE(PG8_SB(0, 1), b2 + hstepB, voffB);
            PG8_WAIT_V(6); PG8_BAR; PG8_MMA(1, 1, At, B1); PG8_BAR;
            PG8_LDB(B0, 1, 0); PG8_SCHED; PG8_LDA(At, 1, 0); PG8_STAGE(PG8_SA(0, 1), a2 + hstepA, voffA);
            PG8_WAIT_L(8); PG8_BAR; PG8_WAIT_L(0); PG8_MMA(0, 0, At, B0); PG8_BAR; PG8_SCHED;
            PG8_LDB(B1, 1, 1); PG8_STAGE(PG8_SB(1, 0), b3, voffB);
            PG8_BAR; PG8_WAIT_L(0); PG8_MMA(0, 1, At, B1); PG8_BAR;
            PG8_LDA(At, 1, 1); PG8_STAGE(PG8_SA(1, 0), a3, voffA);
            PG8_BAR; PG8_WAIT_L(0); PG8_MMA(1, 0, At, B0); PG8_BAR; PG8_SCHED;
            PG8_STAGE(PG8_SB(1, 1), b3 + hstepB, voffB);
            PG8_WAIT_V(6); PG8_BAR; PG8_MMA(1, 1, At, B1); PG8_BAR;
            }
        }
        if constexpr (ALIGN_EPI) { if (wr == 0) PG8_BAR; }
        if constexpr (!Epi::AFTER_DRAIN) { E(acc, cur, wr, wc, fr, fq); S.done(cur); }
        if (!has_next) break;
#pragma unroll
        for (int a = 0; a < 2; ++a)
#pragma unroll
            for (int b = 0; b < 2; ++b)
#pragma unroll
                for (int m = 0; m < 4; ++m)
#pragma unroll
                    for (int n = 0; n < 2; ++n) acc[a][b][m][n] = (f32x4){0.f, 0.f, 0.f, 0.f};
        cur = nxt; cA = nA; cB = nB; ++ui;
        if constexpr (ALIGN_EPI) { if (wr == 1) PG8_BAR; }
    }
    PG8_WAIT_V(0);
    if constexpr (!ALIGN_EPI) { if (wr == 0) PG8_BAR; }
    PG8_BAR;
    if constexpr (Epi::AFTER_DRAIN) { E.fused(acc, cur, wr, wc, fr, fq, lds, wid, lane); S.done(cur); }
#undef PG8_SA
#undef PG8_SB
#undef PG8_STAGE
#undef PG8_LDA
#undef PG8_LDB
#undef PG8_MMA
#undef PG8_WAIT_V
#undef PG8_WAIT_L
#undef PG8_BAR
#undef PG8_SCHED
}
}

#define GAS __attribute__((address_space(1)))
#define LAS __attribute__((address_space(3)))
typedef unsigned short bf16_t;
typedef short bf16x8 __attribute__((ext_vector_type(8)));
typedef float f32x4 __attribute__((ext_vector_type(4)));
typedef unsigned u32x4 __attribute__((ext_vector_type(4)));
typedef unsigned u32x2 __attribute__((ext_vector_type(2)));

constexpr int DM = 1024, NBATCH = 2, SEQ = 8192, MEML = 256, MTOK = NBATCH * SEQ;
constexpr int INW = 12320, LD = 12544;
constexpr int C_Z = 0, C_X = 2048, C_B = 4096, C_C = 4608, C_LG = 5120, C_LX = 6656, C_Q = 8192, C_G = 9216, C_DT = 12288;
constexpr int C_MRG = 2048;
constexpr int NHEAD = 32, HDIM = 64, NGRP = 4, NSTATE = 128, CHUNK = 128, NCHUNK = SEQ / CHUNK;
constexpr int LRUW = 1536, LRUB = 96, NLB = 16, LSEG = 512, NSEG = SEQ / LSEG, NBLK64 = SEQ / 64;
constexpr float EPS = 1e-6f;
constexpr size_t MiB = 1u << 20;
constexpr size_t WS_WIN = 0, WS_WKV = 25 * MiB, WS_WSSD = 29 * MiB, WS_WLRU = 33 * MiB, WS_WMEM = 36 * MiB, WS_WOUT = 38 * MiB;
constexpr size_t WS_PROJ = 40 * MiB;
constexpr size_t WS_MEMN = 236 * MiB, WS_KVK = 237 * MiB, WS_KVVT = 238 * MiB, WS_LRUWA = 239 * MiB, WS_LRUWX = 239 * MiB + 512 * 1024;
constexpr size_t WS_DASUM = 240 * MiB;
constexpr size_t WS_LAGG = 246 * MiB;
constexpr size_t WS_LCAR = 250 * MiB;
constexpr size_t WS_CTL = 244 * MiB;
constexpr size_t WS_XBUF = 245 * MiB;
constexpr size_t WS_END = 256 * MiB;
static_assert(WS_PROJ + (size_t)SEQ * LD * 2 <= WS_MEMN, "ws map");
constexpr int LDS_BYTES = 155648;

struct Params {
    const float *x, *mem, *norm_g, *w_in, *ssd_conv_w, *ssd_conv_b, *ssd_dt_bias, *ssd_a_log, *ssd_d, *ssd_norm_g,
        *lru_conv_w, *lru_conv_b, *lru_w_a, *lru_b_a, *lru_w_x, *lru_b_x, *lru_lambda, *mem_norm_g, *w_kv,
        *w_br_ssd, *w_br_lru, *w_br_mem, *w_out, *final_g;
    float* out; unsigned char* ws;
    int lo, hi;
};

__device__ __forceinline__ float bf2f(bf16_t v) { return __uint_as_float((unsigned)v << 16); }
__device__ __forceinline__ unsigned f2bf(float f) { unsigned u = __float_as_uint(f); return (u + 0x7fffu + ((u >> 16) & 1u)) >> 16; }
__device__ __forceinline__ unsigned pk2(float lo, float hi) { return f2bf(lo) | (f2bf(hi) << 16); }
__device__ __forceinline__ float sigmoidf_(float v) { return __builtin_amdgcn_rcpf(1.f + __expf(-v)); }
__device__ __forceinline__ float siluf_(float v) { return v * __builtin_amdgcn_rcpf(1.f + __expf(-v)); }
__device__ __forceinline__ float softplusf_(float v) { const float e = __expf(v); const float sm = e * (1.f - e * (0.5f - e * 0.33333334f)); return v > 20.f ? v : (e < 1e-3f ? sm : __logf(1.f + e)); }
__device__ __forceinline__ float wave_sum(float v) {
#pragma unroll
    for (int o = 1; o < 64; o <<= 1) v += __shfl_xor(v, o);
    return v;
}
template <class T> __device__ __forceinline__ T* opq(T* q) { asm volatile("" : "+s"(q)); return q; }
__device__ __forceinline__ int opq_tid() { int t = threadIdx.x; asm volatile("" : "+v"(t)); return t; }
__device__ __forceinline__ int opq_bid() { int t = blockIdx.x; asm volatile("" : "+s"(t)); return t; }
__device__ __forceinline__ unsigned char* wsb(const Params& p) { return opq(p.ws); }
__device__ __forceinline__ bf16_t* proj_ptr(const Params& p) { return (bf16_t*)(wsb(p) + WS_PROJ); }
__device__ __forceinline__ bf16_t* xn_ptr(const Params& p) { return (bf16_t*)((unsigned char*)opq(p.out) + 32 * MiB); }
__device__ __forceinline__ bf16_t* states_ptr(const Params& p, int b) { return (bf16_t*)((unsigned char*)opq(p.out) + (size_t)b * 32 * MiB); }
__device__ __forceinline__ float* scr_ptr(const Params& p, int b) { return (float*)((unsigned char*)opq(p.out) + (size_t)b * 32 * MiB); }

#ifdef PROBE_MA
#define MSTAMP(p, i) do { if (blockIdx.x == 0 && threadIdx.x == 0) ((unsigned long long*)(wsb(p) + 255 * MiB))[i] = __builtin_amdgcn_s_memrealtime(); } while (0)
#else
#define MSTAMP(p, i) do { } while (0)
#endif
__device__ __forceinline__ void transpose_item(const float* W, int K, int Ns, int srccol0, bf16_t* WT, int dstrow0, LAS float* scr, int k0, int lane) {
    float wv[32];
#pragma unroll
    for (int i = 0; i < 32; ++i) wv[i] = W[(size_t)(k0 + 2 * i + (lane >> 5)) * Ns + srccol0 + (lane & 31)];
#pragma unroll
    for (int i = 0; i < 32; ++i) scr[(2 * i + (lane >> 5)) * 33 + (lane & 31)] = wv[i];
    asm volatile("s_waitcnt lgkmcnt(0)" ::: "memory");
    const int c = lane & 7;
#pragma unroll
    for (int j = 0; j < 4; ++j) { const int n = (lane >> 3) + 8 * j; const LAS float* s = scr + (8 * c) * 33 + n;
        u32x4 o; o.x = pk2(s[0 * 33], s[1 * 33]); o.y = pk2(s[2 * 33], s[3 * 33]); o.z = pk2(s[4 * 33], s[5 * 33]); o.w = pk2(s[6 * 33], s[7 * 33]);
        *(u32x4*)(WT + (size_t)(dstrow0 + n) * K + k0 + 8 * c) = o; }
    asm volatile("s_waitcnt lgkmcnt(0)" ::: "memory");
}
__device__ __forceinline__ void rms_row_to_bf16(const float* xrow, const float* g, bf16_t* orow, int lane) {
    const f32x4* xr = (const f32x4*)xrow + lane; const f32x4* gr = (const f32x4*)g + lane;
    f32x4 v[4]; float s = 0.f;
#pragma unroll
    for (int j = 0; j < 4; ++j) { v[j] = xr[64 * j]; s += (v[j].x * v[j].x + v[j].y * v[j].y) + (v[j].z * v[j].z + v[j].w * v[j].w); }
    const float rs = 1.f / sqrtf(wave_sum(s) * (1.f / DM) + EPS);
    unsigned long long* o8 = (unsigned long long*)orow + lane;
#pragma unroll
    for (int j = 0; j < 4; ++j) { const f32x4 gg = gr[64 * j];
        o8[64 * j] = (unsigned long long)pk2(v[j].x * rs * gg.x, v[j].y * rs * gg.y) | ((unsigned long long)pk2(v[j].z * rs * gg.z, v[j].w * rs * gg.w) << 32); }
}
__device__ __forceinline__ void phase0(const Params& p, LAS unsigned char* lds) {
    const int tid = opq_tid(), lane = tid & 63, wave = tid >> 6, bid = opq_bid();
    const int gw = bid * 8 + wave, NGW = gridDim.x * 8;
    LAS float* scr = (LAS float*)(lds + wave * 8704);
    bf16_t* Win = (bf16_t*)(wsb(p) + WS_WIN); bf16_t* Wkv = (bf16_t*)(wsb(p) + WS_WKV); bf16_t* Wssd = (bf16_t*)(wsb(p) + WS_WSSD);
    bf16_t* Wlru = (bf16_t*)(wsb(p) + WS_WLRU); bf16_t* Wmem = (bf16_t*)(wsb(p) + WS_WMEM); bf16_t* Wout = (bf16_t*)(wsb(p) + WS_WOUT);
    constexpr int I_IN = 16 * 385, I_KV = 16 * 64, I_SSD = 32 * 32, I_LRU = 24 * 32, I_MEM = 16 * 32, I_OUT = 16 * 32;
    constexpr int NITEMS = I_IN + I_KV + I_SSD + I_LRU + I_MEM + I_OUT;
    for (int it = gw; it < NITEMS; it += NGW) {
        int r = it;
        if (r < I_IN) { const int nb = r % 385, kb = r / 385; const int sc = 32 * nb; int dr;
            if (sc < 5120) dr = sc; else if (sc < 5152) dr = sc - 5120 + C_DT; else dr = sc - 32;
            transpose_item(opq(p.w_in), 1024, INW, sc, Win, dr, scr, 64 * kb, lane); continue; } r -= I_IN;
        if (r < I_KV) { transpose_item(opq(p.w_kv), 1024, 2048, 32 * (r % 64), Wkv, 32 * (r % 64), scr, 64 * (r / 64), lane); continue; } r -= I_KV;
        if (r < I_SSD) { transpose_item(opq(p.w_br_ssd), 2048, 1024, 32 * (r % 32), Wssd, 32 * (r % 32), scr, 64 * (r / 32), lane); continue; } r -= I_SSD;
        if (r < I_LRU) { transpose_item(opq(p.w_br_lru), 1536, 1024, 32 * (r % 32), Wlru, 32 * (r % 32), scr, 64 * (r / 32), lane); continue; } r -= I_LRU;
        if (r < I_MEM) { transpose_item(opq(p.w_br_mem), 1024, 1024, 32 * (r % 32), Wmem, 32 * (r % 32), scr, 64 * (r / 32), lane); continue; } r -= I_MEM;
        transpose_item(opq(p.w_out), 1024, 1024, 32 * (r % 32), Wout, 32 * (r % 32), scr, 64 * (r / 32), lane);
    }
    { const int gt = bid * 512 + tid, NT = gridDim.x * 512; u32x4* z = (u32x4*)(Win + (size_t)INW * 1024);
      for (int i = gt; i < (LD - INW) * 1024 / 8; i += NT) z[i] = (u32x4){0u, 0u, 0u, 0u}; }
    { const int gt = bid * 512 + tid, NT = gridDim.x * 512; bf16_t* wa = (bf16_t*)(wsb(p) + WS_LRUWA); bf16_t* wx = (bf16_t*)(wsb(p) + WS_LRUWX);
      for (int e = gt; e < NLB * LRUB * LRUB; e += NT) { const int n = e / (LRUB * LRUB), r2 = e % (LRUB * LRUB), j = r2 / LRUB, i = r2 % LRUB;
          wa[e] = (bf16_t)f2bf(opq(p.lru_w_a)[(n * LRUB + i) * LRUB + j]); wx[e] = (bf16_t)f2bf(opq(p.lru_w_x)[(n * LRUB + i) * LRUB + j]); } }
    bf16_t* XN = xn_ptr(p); bf16_t* MN = (bf16_t*)(wsb(p) + WS_MEMN);
    { const float* xb = opq(p.x); const f32x4* gr = (const f32x4*)opq(p.norm_g) + lane;
      for (int m0 = gw * 4; m0 < MTOK; m0 += NGW * 4) {
          f32x4 v[4][4];
#pragma unroll
          for (int r = 0; r < 4; ++r)
#pragma unroll
              for (int j = 0; j < 4; ++j) v[r][j] = ((const f32x4*)(xb + (size_t)(m0 + r) * DM) + lane)[64 * j];
#pragma unroll
          for (int r = 0; r < 4; ++r) { float s = 0.f;
#pragma unroll
              for (int j = 0; j < 4; ++j) s += (v[r][j].x * v[r][j].x + v[r][j].y * v[r][j].y) + (v[r][j].z * v[r][j].z + v[r][j].w * v[r][j].w);
              const float rs = 1.f / sqrtf(wave_sum(s) * (1.f / DM) + EPS);
              unsigned long long* o8 = (unsigned long long*)(XN + (size_t)(m0 + r) * DM) + lane;
#pragma unroll
              for (int j = 0; j < 4; ++j) { const f32x4 gg = gr[64 * j];
                  o8[64 * j] = (unsigned long long)pk2(v[r][j].x * rs * gg.x, v[r][j].y * rs * gg.y) | ((unsigned long long)pk2(v[r][j].z * rs * gg.z, v[r][j].w * rs * gg.w) << 32); } } } }
    for (int m = gw; m < NBATCH * MEML; m += NGW) rms_row_to_bf16(opq(p.mem) + (size_t)m * DM, opq(p.mem_norm_g), MN + (size_t)m * DM, lane);
}
__device__ __forceinline__ void phase7(const Params& p) {
    const int tid = opq_tid(), lane = tid & 63, wave = tid >> 6; const int gw = opq_bid() * 8 + wave, NGW = gridDim.x * 8; float* outb = opq(p.out); const float* fg = opq(p.final_g);
    for (int m = gw; m < MTOK; m += NGW) {
        f32x4* xr = (f32x4*)(outb + (size_t)m * DM) + lane; const f32x4* gr = (const f32x4*)fg + lane;
        f32x4 v[4]; float s = 0.f;
#pragma unroll
        for (int j = 0; j < 4; ++j) { v[j] = xr[64 * j]; s += (v[j].x * v[j].x + v[j].y * v[j].y) + (v[j].z * v[j].z + v[j].w * v[j].w); }
        const float rs = 1.f / sqrtf(wave_sum(s) * (1.f / DM) + EPS);
#pragma unroll
        for (int j = 0; j < 4; ++j) { const f32x4 gg = gr[64 * j]; xr[64 * j] = v[j] * rs * gg; }
    }
}

namespace pg8 {
template <int BR> struct EpiMerge {
    static constexpr bool PERM = true, AFTER_DRAIN = false;
    bf16_t* P; float* scr;
    __device__ __forceinline__ void operator()(const f32x4 (&acc)[2][2][4][2], const Unit& u, int wr, int wc, int fr, int fq) const {
        const int row0 = u.pm * BM + wr * 64 + fr, col0 = u.pn * BM + wc * 32 + 8 * fq;
#pragma unroll
        for (int ai = 0; ai < 2; ++ai)
#pragma unroll
            for (int m = 0; m < 4; ++m) { const size_t r = (size_t)(row0 + ai * HALF + m * 16);
#pragma unroll
                for (int bj = 0; bj < 2; ++bj) { const int c = col0 + bj * HALF;
                    const u32x4 gw = *(const u32x4*)(P + r * 12544 + 9216 + BR * 1024 + c);
                    float g[8];
#pragma unroll
                    for (int i = 0; i < 4; ++i) { g[2 * i] = __uint_as_float(gw[i] << 16); g[2 * i + 1] = __uint_as_float(gw[i] & 0xffff0000u); }
                    f32x4 v0 = acc[ai][bj][m][0], v1 = acc[ai][bj][m][1];
#pragma unroll
                    for (int i = 0; i < 4; ++i) { v0[i] *= 1.f / (1.f + __expf(-g[i])); v1[i] *= 1.f / (1.f + __expf(-g[4 + i])); }
                    float* sp = scr + r * 1024 + c;
                    if (BR > 0) { v0 += *(const f32x4*)sp; v1 += *(const f32x4*)(sp + 4); }
                    if (BR < 2) { *(f32x4*)sp = v0; *(f32x4*)(sp + 4) = v1; }
                    else { u32x4 w; w.x = cvt_pk_bf16(v0[0], v0[1]); w.y = cvt_pk_bf16(v0[2], v0[3]); w.z = cvt_pk_bf16(v1[0], v1[1]); w.w = cvt_pk_bf16(v1[2], v1[3]);
                        *(u32x4*)(P + r * 12544 + 2048 + c) = w; } } }
    }
};
template <int BR, bool FINAL> struct EpiMerge2 {
    static constexpr bool PERM = true, AFTER_DRAIN = false;
    bf16_t* P; bf16_t* s0; int ld0; const bf16_t* s1; int ld1; bf16_t* mrg; int ldm;
    __device__ __forceinline__ void operator()(const f32x4 (&acc)[2][2][4][2], const Unit& u, int wr, int wc, int fr, int fq) const {
        const int row0 = u.pm * BM + wr * 64 + fr, col0 = u.pn * BM + wc * 32 + 8 * fq;
#pragma unroll
        for (int ai = 0; ai < 2; ++ai) {
            unsigned gb = (unsigned)((row0 + ai * HALF) * 12544 + 9216 + BR * 1024 + col0); asm volatile("" : "+v"(gb));
            unsigned b0 = (unsigned)((row0 + ai * HALF) * ld0 + col0); asm volatile("" : "+v"(b0));
            u32x4 gw[4][2];
#pragma unroll
            for (int m = 0; m < 4; ++m)
#pragma unroll
                for (int bj = 0; bj < 2; ++bj) gw[m][bj] = *(const u32x4*)(P + (gb + (unsigned)(m * 16 * 12544 + bj * HALF)));
            f32x4 v[4][2][2];
#pragma unroll
            for (int m = 0; m < 4; ++m)
#pragma unroll
                for (int bj = 0; bj < 2; ++bj) { const u32x4 g4 = gw[m][bj]; f32x4 v0 = acc[ai][bj][m][0], v1 = acc[ai][bj][m][1];
#pragma unroll
                    for (int i = 0; i < 2; ++i) { v0[2 * i] *= __builtin_amdgcn_rcpf(1.f + __expf(-__uint_as_float(g4[i] << 16))); v0[2 * i + 1] *= __builtin_amdgcn_rcpf(1.f + __expf(-__uint_as_float(g4[i] & 0xffff0000u)));
                        v1[2 * i] *= __builtin_amdgcn_rcpf(1.f + __expf(-__uint_as_float(g4[2 + i] << 16))); v1[2 * i + 1] *= __builtin_amdgcn_rcpf(1.f + __expf(-__uint_as_float(g4[2 + i] & 0xffff0000u))); }
                    v[m][bj][0] = v0; v[m][bj][1] = v1; }
            if (!FINAL) {
#pragma unroll
                for (int m = 0; m < 4; ++m)
#pragma unroll
                    for (int bj = 0; bj < 2; ++bj) { const f32x4 v0 = v[m][bj][0], v1 = v[m][bj][1]; u32x4 w; w.x = cvt_pk_bf16(v0[0], v0[1]); w.y = cvt_pk_bf16(v0[2], v0[3]); w.z = cvt_pk_bf16(v1[0], v1[1]); w.w = cvt_pk_bf16(v1[2], v1[3]);
                        *(u32x4*)(s0 + (b0 + (unsigned)(m * 16) * (unsigned)ld0 + (unsigned)(bj * HALF))) = w; }
            } else {
                asm volatile("" ::: "memory");
                unsigned b1 = (unsigned)((row0 + ai * HALF) * ld1 + col0); asm volatile("" : "+v"(b1));
                unsigned bm = (unsigned)((row0 + ai * HALF) * ldm + col0); asm volatile("" : "+v"(bm));
#pragma unroll
                for (int mp = 0; mp < 2; ++mp) { u32x4 a0[2][2], a1[2][2];
#pragma unroll
                    for (int mm = 0; mm < 2; ++mm)
#pragma unroll
                        for (int bj = 0; bj < 2; ++bj) { const unsigned rr = (unsigned)((2 * mp + mm) * 16);
                            a0[mm][bj] = *(const u32x4*)(s0 + (b0 + rr * (unsigned)ld0 + (unsigned)(bj * HALF))); a1[mm][bj] = *(const u32x4*)(s1 + (b1 + rr * (unsigned)ld1 + (unsigned)(bj * HALF))); }
#pragma unroll
                    for (int mm = 0; mm < 2; ++mm)
#pragma unroll
                        for (int bj = 0; bj < 2; ++bj) { const int m = 2 * mp + mm; const unsigned rr = (unsigned)(m * 16);
                            f32x4 v0 = v[m][bj][0], v1 = v[m][bj][1];
#pragma unroll
                            for (int i = 0; i < 2; ++i) { v0[2 * i] += __uint_as_float(a0[mm][bj][i] << 16) + __uint_as_float(a1[mm][bj][i] << 16); v0[2 * i + 1] += __uint_as_float(a0[mm][bj][i] & 0xffff0000u) + __uint_as_float(a1[mm][bj][i] & 0xffff0000u);
                                v1[2 * i] += __uint_as_float(a0[mm][bj][2 + i] << 16) + __uint_as_float(a1[mm][bj][2 + i] << 16); v1[2 * i + 1] += __uint_as_float(a0[mm][bj][2 + i] & 0xffff0000u) + __uint_as_float(a1[mm][bj][2 + i] & 0xffff0000u); }
                            u32x4 w; w.x = cvt_pk_bf16(v0[0], v0[1]); w.y = cvt_pk_bf16(v0[2], v0[3]); w.z = cvt_pk_bf16(v1[0], v1[1]); w.w = cvt_pk_bf16(v1[2], v1[3]);
                            *(u32x4*)(mrg + (bm + rr * (unsigned)ldm + (unsigned)(bj * HALF))) = w; }
                    asm volatile("" ::: "memory"); }
            }
            asm volatile("" ::: "memory");
        }
    }
};
struct EpiOutNorm {
    static constexpr bool PERM = false, AFTER_DRAIN = true;
    const float* xres; float* out; const float* fg; float* xbuf; unsigned* cnt;
    __device__ __forceinline__ void fused(f32x4 (&acc)[2][2][4][2], const Unit& u, int wr, int wc, int fr, int fq, PG8_LAS unsigned char* lds, int wid, int lane) const {
        PG8_LAS float* Pp = (PG8_LAS float*)lds; PG8_LAS float* Sr = (PG8_LAS float*)(lds + 4096);
        const int row0 = u.pm * BM + wr * 64 + fr, col0 = u.pn * BM + wc * 32 + 4 * fq;
#pragma unroll
        for (int ai = 0; ai < 2; ++ai)
#pragma unroll
            for (int m = 0; m < 4; ++m) { const size_t off = (size_t)(row0 + ai * HALF + m * 16) * 1024 + col0; float s = 0.f;
#pragma unroll
                for (int bj = 0; bj < 2; ++bj)
#pragma unroll
                    for (int n = 0; n < 2; ++n) { const f32x4 v = acc[ai][bj][m][n] + *(const f32x4*)(xres + off + bj * HALF + n * 16); acc[ai][bj][m][n] = v; s += (v[0] * v[0] + v[1] * v[1]) + (v[2] * v[2] + v[3] * v[3]); }
                s += __shfl_xor(s, 16); s += __shfl_xor(s, 32);
                if (fq == 0) Pp[(ai * HALF + wr * 64 + m * 16 + fr) * 4 + wc] = s;
                if (m == 3) asm volatile("" ::: "memory"); }
        asm volatile("s_waitcnt lgkmcnt(0)" ::: "memory"); __builtin_amdgcn_s_barrier(); asm volatile("" ::: "memory");
        const int tid = wid * 64 + lane;
        if (tid < 256) { const float s = (Pp[tid * 4 + 0] + Pp[tid * 4 + 1]) + (Pp[tid * 4 + 2] + Pp[tid * 4 + 3]);
            __hip_atomic_store(xbuf + (size_t)(u.pm * BM + tid) * 4 + u.pn, s, __ATOMIC_RELAXED, __HIP_MEMORY_SCOPE_AGENT); }
        asm volatile("s_waitcnt vmcnt(0)" ::: "memory");
        if (wid < 4 && lane == 0) __hip_atomic_fetch_add(cnt + 64 * u.pm, 1u, __ATOMIC_RELAXED, __HIP_MEMORY_SCOPE_AGENT);
        if (wid == 0) { unsigned spins = 0;
            while ((unsigned)__builtin_amdgcn_readfirstlane(__hip_atomic_load(cnt + 64 * u.pm, __ATOMIC_RELAXED, __HIP_MEMORY_SCOPE_AGENT)) < 16u && ++spins < (1u << 22)) __builtin_amdgcn_s_sleep(2);
            __builtin_amdgcn_fence(__ATOMIC_ACQUIRE, "agent"); }
        asm volatile("s_waitcnt vmcnt(0) lgkmcnt(0)" ::: "memory"); __builtin_amdgcn_s_barrier(); asm volatile("" ::: "memory");
        if (tid < 256) { const float* slot = xbuf + (size_t)(u.pm * BM + tid) * 4; float s = 0.f;
#pragma unroll
            for (int q = 0; q < 4; ++q) s += __hip_atomic_load(slot + q, __ATOMIC_RELAXED, __HIP_MEMORY_SCOPE_AGENT);
            Sr[tid] = 1.0f / sqrtf(s * (1.f / 1024.f) + 1e-6f); }
        asm volatile("s_waitcnt lgkmcnt(0)" ::: "memory"); __builtin_amdgcn_s_barrier(); asm volatile("" ::: "memory");
#pragma unroll
        for (int ai = 0; ai < 2; ++ai)
#pragma unroll
            for (int m = 0; m < 4; ++m) { const int r = ai * HALF + wr * 64 + m * 16 + fr; const float rs = Sr[r]; const size_t off = (size_t)(u.pm * BM + r) * 1024 + col0;
#pragma unroll
                for (int bj = 0; bj < 2; ++bj)
#pragma unroll
                    for (int n = 0; n < 2; ++n) { const f32x4 gg = *(const f32x4*)(fg + col0 + bj * HALF + n * 16); *(f32x4*)(out + off + bj * HALF + n * 16) = acc[ai][bj][m][n] * rs * gg; } }
    }
};
struct SkewOrder {
    StaticOrder base; int c;
    __device__ void init(int M, int N, int c_) { base.init(M, N, 256, 0); c = c_; }
    __device__ bool next(int i, Unit& u) const {
        int ii, cc = c;
        if (c < 128) { if (i >= 5) return false; ii = i + 1; }
        else { if (i > 6) return false; if (i == 0) ii = 0; else if (i == 1) { ii = 0; cc = c - 128; } else ii = i - 1; }
        StaticOrder b2 = base; b2.c = cc; return b2.next(ii, u);
    }
    __device__ __forceinline__ void a_ready(const Unit&) const {}
    __device__ __forceinline__ void done(const Unit&) const {}
};
}
#define PG8_SP2 true
#define PG8_ALIGN true

__device__ __forceinline__ bf16_t* merged_ptr(const Params& p, int b) { return b == 0 ? xn_ptr(p) : proj_ptr(p) + 4096; }
__device__ __forceinline__ int merged_ld(int b) { return b == 0 ? DM : LD; }
__device__ __forceinline__ void phase1_gemm(const Params& p, int b, LAS unsigned char* lds) {
    const int G = gridDim.x, c = opq_bid();
    { pg8::Gemm g{xn_ptr(p) + (size_t)b * SEQ * DM, (const bf16_t*)(wsb(p) + WS_WIN), SEQ, 12288, DM, DM, DM}; pg8::StaticOrder S; S.init(SEQ, 12288, G, c);
      pg8::EpiBf16<0> E{proj_ptr(p), LD, nullptr, 0, 0, 1.f};
      if (b == 1 && G == 256) { pg8::SkewOrder S2; S2.init(SEQ, 12288, c);
          pg8::gemm_phase<pg8::EpiBf16<0>, pg8::SkewOrder, PG8_ALIGN, PG8_SP2>(lds, g, S2, E); }
      else pg8::gemm_phase<pg8::EpiBf16<0>, pg8::StaticOrder, PG8_ALIGN, PG8_SP2>(lds, g, S, E); }
    { const int tid = opq_tid(), lane = tid & 63, wave = tid >> 6, fr = lane & 15, kg = lane >> 4;
      const bf16_t* XNb = xn_ptr(p) + (size_t)b * SEQ * DM; const bf16_t* Wd = (const bf16_t*)(wsb(p) + WS_WIN) + (size_t)C_DT * DM; bf16_t* Pq = proj_ptr(p);
      LAS float* sRed = (LAS float*)lds;
      for (int rb = c; rb < SEQ / 32; rb += G) {
          __syncthreads();
          f32x4 acc[2][2];
#pragma unroll
          for (int mt = 0; mt < 2; ++mt)
#pragma unroll
              for (int nt = 0; nt < 2; ++nt) acc[mt][nt] = (f32x4){0.f, 0.f, 0.f, 0.f};
          bf16x8 af[2][4], bfr[2][4];
#pragma unroll
          for (int ks = 0; ks < 4; ++ks)
#pragma unroll
              for (int q = 0; q < 2; ++q) { af[q][ks] = *(const bf16x8*)(XNb + (size_t)(32 * rb + 16 * q + fr) * DM + 128 * wave + 32 * ks + 8 * kg);
                  bfr[q][ks] = *(const bf16x8*)(Wd + (size_t)(16 * q + fr) * DM + 128 * wave + 32 * ks + 8 * kg); }
#pragma unroll
          for (int ks = 0; ks < 4; ++ks)
#pragma unroll
              for (int mt = 0; mt < 2; ++mt)
#pragma unroll
                  for (int nt = 0; nt < 2; ++nt) acc[mt][nt] = __builtin_amdgcn_mfma_f32_16x16x32_bf16(af[mt][ks], bfr[nt][ks], acc[mt][nt], 0, 0, 0);
#pragma unroll
          for (int mt = 0; mt < 2; ++mt)
#pragma unroll
              for (int nt = 0; nt < 2; ++nt)
#pragma unroll
                  for (int j = 0; j < 4; ++j) sRed[(wave * 32 + 16 * mt + 4 * kg + j) * 32 + 16 * nt + fr] = acc[mt][nt][j];
          __syncthreads();
#pragma unroll
          for (int q = 0; q < 2; ++q) { const int e = tid + 512 * q, row = e >> 5, col = e & 31; float s = 0.f;
#pragma unroll
              for (int w2 = 0; w2 < 8; ++w2) s += sRed[(w2 * 32 + row) * 32 + col];
              Pq[(size_t)(32 * rb + row) * LD + C_DT + col] = (bf16_t)f2bf(s); }
      } }
    if (b == 0) {
        { pg8::Gemm g{(const bf16_t*)(wsb(p) + WS_MEMN), (const bf16_t*)(wsb(p) + WS_WKV), 512, 1024, DM, DM, DM}; pg8::StaticOrder S; S.init(512, 1024, G, (c + 16) % G);
          pg8::EpiBf16<0> E{(bf16_t*)(wsb(p) + WS_KVK), 1024, nullptr, 0, 0, 1.f};
          pg8::gemm_phase<pg8::EpiBf16<0>, pg8::StaticOrder, PG8_ALIGN, PG8_SP2>(lds, g, S, E); }
        { pg8::Gemm g{(const bf16_t*)(wsb(p) + WS_WKV) + (size_t)1024 * DM, (const bf16_t*)(wsb(p) + WS_MEMN), 1024, 512, DM, DM, DM}; pg8::StaticOrder S; S.init(1024, 512, G, (c + 8) % G);
          pg8::EpiBf16<0> E{(bf16_t*)(wsb(p) + WS_KVVT), 512, nullptr, 0, 0, 1.f};
          pg8::gemm_phase<pg8::EpiBf16<0>, pg8::StaticOrder, PG8_ALIGN, PG8_SP2>(lds, g, S, E); }
    }
}
__device__ __forceinline__ void phase5_gemm(const Params& p, int b, LAS unsigned char* lds) {
    const int G = gridDim.x, c = opq_bid(); bf16_t* P = proj_ptr(p); float* scr = scr_ptr(p, b);
    bf16_t* scrB = P + 2048;
    bf16_t* scrA = (bf16_t*)scr;
    unsigned* flag = (unsigned*)(wsb(p) + WS_CTL) + 4096 + (b * 128 + (c & 127)) * 16;
    if (c < 128) {
        pg8::Gemm g{P + C_Z, (const bf16_t*)(wsb(p) + WS_WSSD), SEQ, DM, 2048, LD, 2048}; pg8::StaticOrder S; S.init(SEQ, DM, 128, c); pg8::EpiMerge2<0, false> E{P, scrA, 1024, nullptr, 0, nullptr, 0};
        pg8::gemm_phase<pg8::EpiMerge2<0, false>, pg8::StaticOrder, false, PG8_SP2>(lds, g, S, E);
#ifdef PROBE_NOFENCE
        asm volatile("s_waitcnt vmcnt(0)" ::: "memory"); __syncthreads();
        if (threadIdx.x == 0) __hip_atomic_store(flag, 1u, __ATOMIC_RELAXED, __HIP_MEMORY_SCOPE_AGENT);
#else
        asm volatile("s_waitcnt vmcnt(0)" ::: "memory"); __syncthreads();
        if (threadIdx.x == 0) { __builtin_amdgcn_fence(__ATOMIC_RELEASE, "agent"); asm volatile("s_waitcnt vmcnt(0)" ::: "memory");
            __hip_atomic_store(flag, 1u, __ATOMIC_RELAXED, __HIP_MEMORY_SCOPE_AGENT); }
#endif
    } else {
        { pg8::Gemm g{P + C_LG, (const bf16_t*)(wsb(p) + WS_WLRU), SEQ, DM, 1536, LD, 1536}; pg8::StaticOrder S; S.init(SEQ, DM, 128, c - 128); pg8::EpiMerge2<1, false> E{P, scrB, LD, nullptr, 0, nullptr, 0};
          pg8::gemm_phase<pg8::EpiMerge2<1, false>, pg8::StaticOrder, false, PG8_SP2>(lds, g, S, E); }
        if (threadIdx.x == 0) { unsigned spins = 0; while (__hip_atomic_load(flag, __ATOMIC_RELAXED, __HIP_MEMORY_SCOPE_AGENT) == 0u && ++spins < (1u << 22)) __builtin_amdgcn_s_sleep(2);
#ifndef PROBE_NOFENCE
            __builtin_amdgcn_fence(__ATOMIC_ACQUIRE, "agent"); asm volatile("s_waitcnt vmcnt(0)" ::: "memory");
#endif
        }
        __syncthreads();
        { pg8::Gemm g{P + C_Q, (const bf16_t*)(wsb(p) + WS_WMEM), SEQ, DM, 1024, LD, 1024}; pg8::StaticOrder S; S.init(SEQ, DM, 128, c - 128); pg8::EpiMerge2<2, true> E{P, scrB, LD, scrA, 1024, merged_ptr(p, b), merged_ld(b)};
          pg8::gemm_phase<pg8::EpiMerge2<2, true>, pg8::StaticOrder, false, PG8_SP2>(lds, g, S, E); }
    }
    (void)G;
}
__device__ __forceinline__ void phase6_gemm(const Params& p, int b, LAS unsigned char* lds) {
    const int G = gridDim.x, c = opq_bid(); bf16_t* P = proj_ptr(p);
    pg8::Gemm g{merged_ptr(p, b), (const bf16_t*)(wsb(p) + WS_WOUT), SEQ, DM, DM, merged_ld(b), DM}; pg8::StaticOrder S; S.init(SEQ, DM, G, c);
    pg8::EpiOutNorm E{opq(p.x) + (size_t)b * SEQ * DM, opq(p.out) + (size_t)b * SEQ * DM, opq(p.final_g), (float*)(wsb(p) + WS_XBUF) + (size_t)b * SEQ * 4, (unsigned*)(wsb(p) + WS_CTL) + 8192 + b * 2048};
    pg8::gemm_phase<pg8::EpiOutNorm, pg8::StaticOrder, false, PG8_SP2>(lds, g, S, E);
}
#define MFMA16(a, b, c) __builtin_amdgcn_mfma_f32_16x16x32_bf16((a), (b), (c), 0, 0, 0)
__device__ __forceinline__ bf16x8 pack8(const float (&v)[8]) {
    u32x4 w; w.x = pk2(v[0], v[1]); w.y = pk2(v[2], v[3]); w.z = pk2(v[4], v[5]); w.w = pk2(v[6], v[7]); return __builtin_bit_cast(bf16x8, w);
}
__device__ __forceinline__ void unpack8(u32x4 w, float (&v)[8]) {
#pragma unroll
    for (int i = 0; i < 4; ++i) { v[2 * i] = __uint_as_float(w[i] << 16); v[2 * i + 1] = __uint_as_float(w[i] & 0xffff0000u); }
}
__device__ __forceinline__ void attn_phase(const Params& p, int b, LAS unsigned char* lds, int dry = 0) {
    const int tid = opq_tid(), lane = tid & 63, wave = tid >> 6, fr = lane & 15, kg = lane >> 4;
    bf16_t* P = proj_ptr(p); const bf16_t* KK = (const bf16_t*)(wsb(p) + WS_KVK) + (size_t)b * 256 * 1024; const bf16_t* VT = (const bf16_t*)(wsb(p) + WS_KVVT) + b * 256;
    LAS bf16_t* sKV = (LAS bf16_t*)lds;
    for (int u = opq_bid(); u < 256; u += gridDim.x) {
        const int hd = u & 3, rt = u >> 2, q0 = rt * 128 + wave * 16;
        bf16_t* qrow = P + (size_t)(q0 + fr) * LD + C_Q + hd * 256;
        __syncthreads();
        { unsigned ko = (unsigned)((tid >> 5) * 1024 + hd * 256 + 8 * (tid & 31)); asm volatile("" : "+v"(ko));
          u32x4 st[16];
#pragma unroll
          for (int i = 0; i < 16; ++i) st[i] = *(const u32x4*)(KK + (ko + (unsigned)(i * 16 * 1024)));
#pragma unroll
          for (int i = 0; i < 16; ++i) *(LAS u32x4*)(sKV + ((tid >> 5) + 16 * i) * 264 + 8 * (tid & 31)) = st[i]; }
        bf16x8 qf[8];
#pragma unroll
        for (int s = 0; s < 8; ++s) qf[s] = *(const bf16x8*)(qrow + 32 * s + 8 * kg);
        __syncthreads();
        u32x4 vst[16];
        { unsigned vo = (unsigned)((hd * 256 + (tid >> 5)) * 512 + 8 * (tid & 31)); asm volatile("" : "+v"(vo));
#pragma unroll
          for (int i = 0; i < 16; ++i) vst[i] = *(const u32x4*)(VT + (vo + (unsigned)(i * 16 * 512))); }
        f32x4 sacc[16];
#pragma unroll
        for (int mt = 0; mt < 16; ++mt) { sacc[mt] = (f32x4){0.f, 0.f, 0.f, 0.f};
#pragma unroll
            for (int s = 0; s < 8; ++s) { const bf16x8 kf = *(const LAS bf16x8*)(sKV + (16 * mt + fr) * 264 + 32 * s + 8 * kg); sacc[mt] = MFMA16(kf, qf[s], sacc[mt]); } }
        float mx = -INFINITY;
#pragma unroll
        for (int mt = 0; mt < 16; ++mt)
#pragma unroll
            for (int j = 0; j < 4; ++j) mx = fmaxf(mx, sacc[mt][j]);
        mx = fmaxf(mx, __shfl_xor(mx, 16)); mx = fmaxf(mx, __shfl_xor(mx, 32));
        float sum = 0.f;
#pragma unroll
        for (int mt = 0; mt < 16; ++mt)
#pragma unroll
            for (int j = 0; j < 4; ++j) { const float e = __expf((sacc[mt][j] - mx) * 0.0625f); sacc[mt][j] = e; sum += e; }
        sum += __shfl_xor(sum, 16); sum += __shfl_xor(sum, 32);
        const float inv = 1.f / sum;
        bf16x8 pf[8];
#pragma unroll
        for (int s2 = 0; s2 < 8; ++s2) { u32x4 w; w.x = pk2(sacc[2 * s2][0], sacc[2 * s2][1]); w.y = pk2(sacc[2 * s2][2], sacc[2 * s2][3]);
            w.z = pk2(sacc[2 * s2 + 1][0], sacc[2 * s2 + 1][1]); w.w = pk2(sacc[2 * s2 + 1][2], sacc[2 * s2 + 1][3]); pf[s2] = __builtin_bit_cast(bf16x8, w); }
        __syncthreads();
#pragma unroll
        for (int i = 0; i < 16; ++i) *(LAS u32x4*)(sKV + ((tid >> 5) + 16 * i) * 264 + 8 * (tid & 31)) = vst[i];
        __syncthreads();
#pragma unroll 4
        for (int mt2 = 0; mt2 < 16; ++mt2) { f32x4 o = (f32x4){0.f, 0.f, 0.f, 0.f}; const LAS bf16_t* vr = sKV + (16 * mt2 + fr) * 264 + 4 * kg;
#pragma unroll
            for (int s2 = 0; s2 < 8; ++s2) { const u32x2 lo = *(const LAS u32x2*)(vr + 32 * s2), hi = *(const LAS u32x2*)(vr + 32 * s2 + 16);
                u32x4 w; w.x = lo.x; w.y = lo.y; w.z = hi.x; w.w = hi.y; o = MFMA16(__builtin_bit_cast(bf16x8, w), pf[s2], o); }
            u32x2 ow; ow.x = pk2(o[0] * inv, o[1] * inv); ow.y = pk2(o[2] * inv, o[3] * inv);
            if (!dry) *(u32x2*)(qrow + 16 * mt2 + 4 * kg) = ow; }
    }
}
template <bool FINAL> __device__ __forceinline__ void lru_phase(const Params& p, int b, LAS unsigned char* lds, int dry = 0) {
    const int tid = opq_tid(), lane = tid & 63, wave = tid >> 6, fr = lane & 15, kg = lane >> 4;
    bf16_t* P = proj_ptr(p);
    LAS bf16_t* sWA = (LAS bf16_t*)lds; LAS bf16_t* sWX = (LAS bf16_t*)(lds + 19968);
    LAS float* sCW = (LAS float*)(lds + 39936); LAS float* sCB = sCW + 384; LAS float* sBA = sCB + 96; LAS float* sBX = sBA + 96; LAS float* sSP = sBX + 96;
    LAS float* sXL = (LAS float*)(lds + 43008) + wave * 1600;
    LAS float* sAG = (LAS float*)(lds + 94208);
    float* agg = (float*)(wsb(p) + WS_LAGG) + (size_t)b * NBLK64 * LRUW * 2;
    const float* car = (const float*)(wsb(p) + WS_LCAR) + (size_t)b * NBLK64 * LRUW;
    const float* lcw = opq(p.lru_conv_w); const float* lcb = opq(p.lru_conv_b); const float* lba = opq(p.lru_b_a); const float* lbx = opq(p.lru_b_x); const float* lam = opq(p.lru_lambda);
    for (int u = opq_bid(); u < NLB * NSEG; u += gridDim.x) {
        const int n = u % NLB, sg = u / NLB;
        __syncthreads();
        { const bf16_t* gwa = (const bf16_t*)(wsb(p) + WS_LRUWA) + n * 9216; const bf16_t* gwx = (const bf16_t*)(wsb(p) + WS_LRUWX) + n * 9216;
          u32x4 wa3[3], wx3[3]; float cwv = 0.f, v4[4] = {0.f, 0.f, 0.f, 0.f};
#pragma unroll
          for (int i = 0; i < 3; ++i) { const int e = tid + 512 * i; if (e < 96 * 12) { const int j = e / 12, c8 = e % 12; wa3[i] = *(const u32x4*)(gwa + j * 96 + 8 * c8); wx3[i] = *(const u32x4*)(gwx + j * 96 + 8 * c8); } }
          if (tid < 384) cwv = lcw[(tid / 96) * 1536 + n * 96 + tid % 96];
          if (tid < 96) { v4[0] = lcb[n * 96 + tid]; v4[1] = lba[n * 96 + tid]; v4[2] = lbx[n * 96 + tid]; v4[3] = lam[n * 96 + tid]; }
#pragma unroll
          for (int i = 0; i < 3; ++i) { const int e = tid + 512 * i; if (e < 96 * 12) { const int j = e / 12, c8 = e % 12; *(LAS u32x4*)(sWA + j * 104 + 8 * c8) = wa3[i]; *(LAS u32x4*)(sWX + j * 104 + 8 * c8) = wx3[i]; } }
          if (tid < 384) sCW[tid] = cwv;
          if (tid < 96) { sCB[tid] = v4[0]; sBA[tid] = v4[1]; sBX[tid] = v4[2]; sSP[tid] = softplusf_(-v4[3]); } }
        __syncthreads();
        float runA[6], runH[6];
#pragma unroll
        for (int nt = 0; nt < 6; ++nt) { runA[nt] = 1.f; runH[nt] = FINAL ? car[(sg * 8 + wave) * LRUW + n * 96 + 16 * nt + fr] : 0.f; }
        for (int step = 0; step < 4; ++step) {
            const int tb = sg * LSEG + wave * 64 + step * 16;
            u32x4 rawC[3][4];
            { const int t0r = tb + fr - 3; unsigned ro = (unsigned)((t0r < 0 ? 0 : t0r) * LD + C_LX + n * 96 + 8 * kg); asm volatile("" : "+v"(ro));
              if (t0r >= 0) {
#pragma unroll
                  for (int ks = 0; ks < 3; ++ks)
#pragma unroll
                      for (int k = 0; k < 4; ++k) rawC[ks][k] = *(const u32x4*)(P + (ro + (unsigned)(k * LD + 32 * ks)));
              } else {
#pragma unroll
                  for (int ks = 0; ks < 3; ++ks)
#pragma unroll
                      for (int k = 0; k < 4; ++k) { const int t = t0r + k; rawC[ks][k] = *(const u32x4*)(P + (ro + (unsigned)((t < 0 ? 0 : t) * LD + 32 * ks))); if (t < 0) rawC[ks][k] = (u32x4){0u, 0u, 0u, 0u}; }
              } }
            bf16x8 af[3];
#pragma unroll
            for (int ks = 0; ks < 3; ++ks) { const int ch0 = 32 * ks + 8 * kg; float xl[8];
#pragma unroll
                for (int i = 0; i < 8; ++i) xl[i] = sCB[ch0 + i];
#pragma unroll
                for (int k = 0; k < 4; ++k) { const u32x4 raw = rawC[ks][k];
                    float rv[8]; unpack8(raw, rv);
#pragma unroll
                    for (int i = 0; i < 8; ++i) xl[i] += sCW[k * 96 + ch0 + i] * rv[i]; }
                *(LAS f32x4*)(sXL + fr * 100 + ch0) = (f32x4){xl[0], xl[1], xl[2], xl[3]}; *(LAS f32x4*)(sXL + fr * 100 + ch0 + 4) = (f32x4){xl[4], xl[5], xl[6], xl[7]};
                af[ks] = pack8(xl); }
            LAS bf16_t* sG = (LAS bf16_t*)((LAS unsigned char*)sWA + 106496) + wave * 1536;
            unsigned go3[3]; u32x4 graw[3];
            if (FINAL) {
#pragma unroll
                for (int i = 0; i < 3; ++i) { const int e = lane + 64 * i, row = e / 12, c12 = e % 12; go3[i] = (unsigned)((tb + row) * LD + C_LG + n * 96 + 8 * c12); }
                asm volatile("" : "+v"(go3[0]), "+v"(go3[1]), "+v"(go3[2]));
#pragma unroll
                for (int i = 0; i < 3; ++i) graw[i] = *(const u32x4*)(P + go3[i]); }
            f32x4 aR[6], aI[6];
#pragma unroll
            for (int nt = 0; nt < 6; ++nt) { aR[nt] = (f32x4){0.f, 0.f, 0.f, 0.f}; aI[nt] = (f32x4){0.f, 0.f, 0.f, 0.f};
#pragma unroll
                for (int ks = 0; ks < 3; ++ks) { const bf16x8 wa = *(const LAS bf16x8*)(sWA + (16 * nt + fr) * 104 + 32 * ks + 8 * kg), wx = *(const LAS bf16x8*)(sWX + (16 * nt + fr) * 104 + 32 * ks + 8 * kg);
                    aR[nt] = MFMA16(af[ks], wa, aR[nt]); aI[nt] = MFMA16(af[ks], wx, aI[nt]); } }
            float Ainc[6][4], Hinc[6][4];
#pragma unroll
            for (int nt = 0; nt < 6; ++nt) { const int j = 16 * nt + fr; const float ba2 = -1.44269504f * sBA[j], bx2 = -1.44269504f * sBX[j], spc = -8.f * 1.44269504f * sSP[j];
                float A = 1.f, H = 0.f;
#pragma unroll
                for (int r = 0; r < 4; ++r) { const float xlv = sXL[(4 * kg + r) * 100 + j];
                    const float rr = __builtin_amdgcn_rcpf(1.f + __builtin_amdgcn_exp2f(fmaf(aR[nt][r], -1.44269504f, ba2))), ii = __builtin_amdgcn_rcpf(1.f + __builtin_amdgcn_exp2f(fmaf(aI[nt][r], -1.44269504f, bx2)));
                    const float a = __builtin_amdgcn_exp2f(rr * spc), mult = __builtin_amdgcn_sqrtf(fmaxf(0.f, fmaf(-a, a, 1.f)));
                    H = a * H + mult * ii * xlv; A *= a; Ainc[nt][r] = A; Hinc[nt][r] = H; }
                float ap = 1.f, hp = 0.f, at = 1.f, ht = 0.f;
#pragma unroll
                for (int k = 0; k < 4; ++k) { const float ab = __shfl(A, fr + 16 * k), hb = __shfl(H, fr + 16 * k);
                    if (k < kg) { hp = ab * hp + hb; ap *= ab; } ht = ab * ht + hb; at *= ab; }
                if (FINAL) { const float hin = ap * runH[nt] + hp;
#pragma unroll
                    for (int r = 0; r < 4; ++r) Hinc[nt][r] = Ainc[nt][r] * hin + Hinc[nt][r]; }
                runH[nt] = at * runH[nt] + ht; runA[nt] *= at; }
            if (FINAL) {
#pragma unroll
                for (int i = 0; i < 3; ++i) { const int e = lane + 64 * i; *(LAS u32x4*)(sG + (e / 12) * 96 + 8 * (e % 12)) = graw[i]; }
                asm volatile("s_waitcnt lgkmcnt(0)" ::: "memory");
#pragma unroll
                for (int nt = 0; nt < 6; ++nt)
#pragma unroll
                    for (int r = 0; r < 4; ++r) { LAS bf16_t* gp = sG + (4 * kg + r) * 96 + 16 * nt + fr; const float yv = Hinc[nt][r] * siluf_(bf2f(*gp)); *gp = (bf16_t)f2bf(yv); }
                asm volatile("s_waitcnt lgkmcnt(0)" ::: "memory");
#pragma unroll
                for (int i = 0; i < 3; ++i) { const int e = lane + 64 * i; const u32x4 w = *(const LAS u32x4*)(sG + (e / 12) * 96 + 8 * (e % 12)); if (!dry) *(u32x4*)(P + go3[i]) = w; }
                asm volatile("s_waitcnt lgkmcnt(0)" ::: "memory"); }
        }
        if (!FINAL && kg == 0) {
#pragma unroll
            for (int nt = 0; nt < 6; ++nt) { const int ch = n * 96 + 16 * nt + fr; agg[((size_t)(sg * 8 + wave) * LRUW + ch) * 2] = runA[nt]; agg[((size_t)(sg * 8 + wave) * LRUW + ch) * 2 + 1] = runH[nt]; } }
    }
}
__device__ __forceinline__ void lru_carry_phase(const Params& p, int b) {
    const int gt = opq_bid() * 512 + opq_tid();
    const float* agg = (const float*)(wsb(p) + WS_LAGG) + (size_t)b * NBLK64 * LRUW * 2; float* car = (float*)(wsb(p) + WS_LCAR) + (size_t)b * NBLK64 * LRUW;
    for (int ch = gt; ch < LRUW; ch += gridDim.x * 512) { float h = 0.f;
        for (int k0 = 0; k0 < NBLK64; k0 += 16) { float a[16], hh[16];
#pragma unroll
            for (int i = 0; i < 16; ++i) { a[i] = agg[((size_t)(k0 + i) * LRUW + ch) * 2]; hh[i] = agg[((size_t)(k0 + i) * LRUW + ch) * 2 + 1]; }
#pragma unroll
            for (int i = 0; i < 16; ++i) { car[(k0 + i) * LRUW + ch] = h; h = a[i] * h + hh[i]; } } }
}
__device__ __forceinline__ void conv8_silu(const bf16_t* P, int t, int col, const float* cw, const float* cb, int ch, float (&o)[8]) {
    float r[11];
    unsigned off0 = (unsigned)((t < 3 ? 0 : t - 3) * LD + col); asm volatile("" : "+v"(off0));
    if (t >= 3) {
#pragma unroll
        for (int i = 0; i < 11; ++i) r[i] = bf2f(P[off0 + (unsigned)(i * LD)]);
    } else {
#pragma unroll
        for (int i = 0; i < 11; ++i) { const int tt = t - 3 + i; const float v = bf2f(P[off0 + (unsigned)((tt < 0 ? 0 : tt) * LD)]); r[i] = tt < 0 ? 0.f : v; }
    }
    const float w0 = cw[ch], w1 = cw[3072 + ch], w2 = cw[6144 + ch], w3 = cw[9216 + ch], bb = cb[ch];
#pragma unroll
    for (int j = 0; j < 8; ++j) o[j] = siluf_(bb + w0 * r[j] + w1 * r[j + 1] + w2 * r[j + 2] + w3 * r[j + 3]);
}
__device__ __forceinline__ float ssd_dt_setup(const Params& p, const bf16_t* P, int t0, int h, int lane, LAS float* sACS, LAS float* sDT) {
    const float dtb = opq(p.ssd_dt_bias)[h], an = -__expf(opq(p.ssd_a_log)[h]);
    const float dt0 = softplusf_(bf2f(P[(size_t)(t0 + 2 * lane) * LD + C_DT + h]) + dtb), dt1 = softplusf_(bf2f(P[(size_t)(t0 + 2 * lane + 1) * LD + C_DT + h]) + dtb);
    const float dA1 = dt1 * an; float s = dt0 * an + dA1;
#pragma unroll
    for (int o = 1; o < 64; o <<= 1) { const float t = __shfl_up(s, o); if (lane >= o) s += t; }
    sACS[2 * lane] = s - dA1; sACS[2 * lane + 1] = s; sDT[2 * lane] = dt0; sDT[2 * lane + 1] = dt1;
    return __shfl(s, 63);
}
template <int R> __device__ __forceinline__ void conv_rows(const bf16_t* P, int t, int col, const float* cw, const float* cb, int ch, float (&o)[R][8]) {
    unsigned off0 = (unsigned)((t < 3 ? 0 : t - 3) * LD + col); asm volatile("" : "+v"(off0));
    u32x4 raw[R + 3];
    if (t >= 3) {
#pragma unroll
        for (int i = 0; i < R + 3; ++i) raw[i] = *(const u32x4*)(P + (off0 + (unsigned)(i * LD)));
    } else {
#pragma unroll
        for (int i = 0; i < R + 3; ++i) { const int tt = t - 3 + i; raw[i] = *(const u32x4*)(P + (off0 + (unsigned)((tt < 0 ? 0 : tt) * LD))); if (tt < 0) raw[i] = (u32x4){0u, 0u, 0u, 0u}; }
    }
    float w[4][8], bb[8];
#pragma unroll
    for (int k = 0; k < 4; ++k) { const f32x4 w0 = *(const f32x4*)(cw + k * 3072 + ch), w1 = *(const f32x4*)(cw + k * 3072 + ch + 4);
        w[k][0] = w0[0]; w[k][1] = w0[1]; w[k][2] = w0[2]; w[k][3] = w0[3]; w[k][4] = w1[0]; w[k][5] = w1[1]; w[k][6] = w1[2]; w[k][7] = w1[3]; }
    { const f32x4 b0 = *(const f32x4*)(cb + ch), b1 = *(const f32x4*)(cb + ch + 4); bb[0] = b0[0]; bb[1] = b0[1]; bb[2] = b0[2]; bb[3] = b0[3]; bb[4] = b1[0]; bb[5] = b1[1]; bb[6] = b1[2]; bb[7] = b1[3]; }
#pragma unroll
    for (int r = 0; r < R; ++r)
#pragma unroll
        for (int q = 0; q < 8; ++q) o[r][q] = bb[q];
#pragma unroll
    for (int i = 0; i < R + 3; ++i) { float v[8]; unpack8(raw[i], v);
#pragma unroll
        for (int k = 0; k < 4; ++k) { const int r = i - k; if (r >= 0 && r < R) {
#pragma unroll
                for (int q = 0; q < 8; ++q) o[r][q] += w[k][q] * v[q]; } } }
#pragma unroll
    for (int r = 0; r < R; ++r)
#pragma unroll
        for (int q = 0; q < 8; ++q) o[r][q] = siluf_(o[r][q]);
}
__device__ __forceinline__ void ssd_states_phase(const Params& p, int b, LAS unsigned char* lds) {
    const int tid = opq_tid(), lane = tid & 63, wave = tid >> 6, fr = lane & 15, kg = lane >> 4;
    const bf16_t* P = proj_ptr(p); bf16_t* ST = states_ptr(p, b); float* dasum = (float*)(wsb(p) + WS_DASUM) + b * NCHUNK * NHEAD;
    const float* cw = opq(p.ssd_conv_w); const float* cb = opq(p.ssd_conv_b);
    LAS bf16_t* sBT = (LAS bf16_t*)lds; LAS bf16_t* sXT = (LAS bf16_t*)(lds + 34816 + wave * 8704);
    LAS float* sACS = (LAS float*)(lds + 104448) + wave * 128; LAS float* sW = (LAS float*)(lds + 108544) + wave * 128;
    for (int u = opq_bid(); u < NCHUNK * NGRP; u += gridDim.x) {
        const int c = u >> 2, g = u & 3, t0 = c * CHUNK, h = 8 * g + wave;
        __syncthreads();
        { const float tot = ssd_dt_setup(p, P, t0, h, lane, sACS, sW);
          if (lane == 0) dasum[c * NHEAD + h] = tot;
          sW[2 * lane] = sW[2 * lane] * __expf(tot - sACS[2 * lane]); sW[2 * lane + 1] = sW[2 * lane + 1] * __expf(tot - sACS[2 * lane + 1]); }
        { const int cg = tid & 15, rs = tid >> 4; float o[4][8];
          conv_rows<4>(P, t0 + 4 * rs, C_B + g * 128 + 8 * cg, cw, cb, 2048 + g * 128 + 8 * cg, o);
#pragma unroll
          for (int q = 0; q < 8; ++q) { u32x2 w; w.x = pk2(o[0][q], o[1][q]); w.y = pk2(o[2][q], o[3][q]); *(LAS u32x2*)(sBT + (8 * cg + q) * 136 + 4 * rs) = w; } }
        __syncthreads();
        for (int ph = 0; ph < 2; ++ph) {
            { const int cg = lane & 3, rs = lane >> 2; float o[8][8];
              conv_rows<8>(P, t0 + 8 * rs, C_X + h * 64 + 32 * ph + 8 * cg, cw, cb, h * 64 + 32 * ph + 8 * cg, o);
              const f32x4 w0 = *(const LAS f32x4*)(sW + 8 * rs), w1 = *(const LAS f32x4*)(sW + 8 * rs + 4);
#pragma unroll
              for (int q = 0; q < 8; ++q) { float v[8] = {o[0][q] * w0[0], o[1][q] * w0[1], o[2][q] * w0[2], o[3][q] * w0[3], o[4][q] * w1[0], o[5][q] * w1[1], o[6][q] * w1[2], o[7][q] * w1[3]};
                  *(LAS bf16x8*)(sXT + (8 * cg + q) * 136 + 8 * rs) = pack8(v); } }
            asm volatile("s_waitcnt lgkmcnt(0)" ::: "memory");
            f32x4 acc[8][2];
#pragma unroll
            for (int mt = 0; mt < 8; ++mt) { acc[mt][0] = (f32x4){0.f, 0.f, 0.f, 0.f}; acc[mt][1] = (f32x4){0.f, 0.f, 0.f, 0.f}; }
#pragma unroll
            for (int s = 0; s < 4; ++s) { const bf16x8 x0 = *(const LAS bf16x8*)(sXT + fr * 136 + 32 * s + 8 * kg), x1 = *(const LAS bf16x8*)(sXT + (16 + fr) * 136 + 32 * s + 8 * kg);
#pragma unroll
                for (int mt = 0; mt < 8; ++mt) { const bf16x8 a = *(const LAS bf16x8*)(sBT + (16 * mt + fr) * 136 + 32 * s + 8 * kg);
                    acc[mt][0] = MFMA16(a, x0, acc[mt][0]); acc[mt][1] = MFMA16(a, x1, acc[mt][1]); } }
            asm volatile("s_waitcnt lgkmcnt(0)" ::: "memory");
#pragma unroll
            for (int mt = 0; mt < 8; ++mt)
#pragma unroll
                for (int nt = 0; nt < 2; ++nt) { const int n0 = 16 * mt + 4 * kg, pp = 32 * ph + 16 * nt + fr;
                    u32x2 w; w.x = pk2(acc[mt][nt][0], acc[mt][nt][1]); w.y = pk2(acc[mt][nt][2], acc[mt][nt][3]);
                    *(u32x2*)(ST + ((size_t)(c * NHEAD + h) * 64 + pp) * 128 + n0) = w; }
        }
    }
}
__device__ __forceinline__ void ssd_scan_phase(const Params& p, int b, int dry = 0) {
    unsigned* st = (unsigned*)states_ptr(p, b); const float* dasum = (const float*)(wsb(p) + WS_DASUM) + b * NCHUNK * NHEAD;
    for (int e2 = opq_bid() * 512 + opq_tid(); e2 < 131072; e2 += gridDim.x * 512) {
        const int h = e2 >> 12; float r0 = 0.f, r1 = 0.f;
        for (int c0 = 0; c0 < NCHUNK; c0 += 16) { unsigned v[16]; float d[16];
#pragma unroll
            for (int i = 0; i < 16; ++i) { v[i] = st[(size_t)(c0 + i) * 131072 + e2]; d[i] = dasum[(c0 + i) * NHEAD + h]; }
#pragma unroll
            for (int i = 0; i < 16; ++i) { const unsigned w = pk2(r0, r1); const float dd = __expf(d[i]);
                r0 = r0 * dd + __uint_as_float(v[i] << 16); r1 = r1 * dd + __uint_as_float(v[i] & 0xffff0000u); v[i] = w; }
            if (!dry) {
#pragma unroll
                for (int i = 0; i < 16; ++i) st[(size_t)(c0 + i) * 131072 + e2] = v[i]; } }
    }
}
__device__ __forceinline__ void ssd_out_phase(const Params& p, int b, LAS unsigned char* lds, int dry = 0) {
    const int tid = opq_tid(), lane = tid & 63, wave = tid >> 6, fr = lane & 15, kg = lane >> 4;
    bf16_t* P = proj_ptr(p); const bf16_t* ST = states_ptr(p, b);
    const float* cw = opq(p.ssd_conv_w); const float* cb = opq(p.ssd_conv_b);
    LAS bf16_t* sC = (LAS bf16_t*)lds; LAS bf16_t* sCB = (LAS bf16_t*)(lds + 34816); LAS bf16_t* sB = (LAS bf16_t*)(lds + 69632); LAS bf16_t* sXT = (LAS bf16_t*)(lds + 69632 + wave * 8704);
    LAS float* sACS = (LAS float*)(lds + 139264) + wave * 128; LAS float* sDT = (LAS float*)(lds + 143360) + wave * 128; LAS float* sSSQ = (LAS float*)(lds + 147456);
    for (int u = opq_bid(); u < NCHUNK * NGRP; u += gridDim.x) {
        const int c = u >> 2, g = u & 3, t0 = c * CHUNK, h = 8 * g + wave;
        __syncthreads();
        MSTAMP(p, 0);
        (void)ssd_dt_setup(p, P, t0, h, lane, sACS, sDT);
        { const int cg = tid & 15, rs = (tid >> 4) & 15, isC = tid >> 8; float o[8][8];
          conv_rows<8>(P, t0 + 8 * rs, C_B + isC * 512 + g * 128 + 8 * cg, cw, cb, 2048 + isC * 512 + g * 128 + 8 * cg, o);
          LAS bf16_t* dst = (isC ? sC : sB) + (8 * rs) * 136 + 8 * cg;
#pragma unroll
          for (int r = 0; r < 8; ++r) *(LAS bf16x8*)(dst + r * 136) = pack8(o[r]); }
        __syncthreads();
#pragma unroll
        for (int ms = 0; ms < 8; ++ms) if (ms <= wave) { f32x4 a4 = (f32x4){0.f, 0.f, 0.f, 0.f};
#pragma unroll
            for (int kn = 0; kn < 4; ++kn) { const bf16x8 a = *(const LAS bf16x8*)(sB + (16 * ms + fr) * 136 + 32 * kn + 8 * kg), bb = *(const LAS bf16x8*)(sC + (16 * wave + fr) * 136 + 32 * kn + 8 * kg);
                a4 = MFMA16(a, bb, a4); }
            u32x2 w; w.x = pk2(a4[0], a4[1]); w.y = pk2(a4[2], a4[3]);
            *(LAS u32x2*)(sCB + (16 * wave + fr) * 136 + 16 * ms + 4 * kg) = w; }
        __syncthreads();
        MSTAMP(p, 1);
        const float Dh = opq(p.ssd_d)[h];
        const unsigned zbase0 = (unsigned)((t0 + fr) * LD + C_Z + h * 64 + 4 * kg);
        float ssq[8];
#pragma unroll
        for (int nt = 0; nt < 8; ++nt) ssq[nt] = 0.f;
        for (int ph = 0; ph < 2; ++ph) {
            unsigned zb = zbase0 + 32u * ph; asm volatile("" : "+v"(zb));
            unsigned pfo = (unsigned)(((c * NHEAD + h) * 64 + 32 * ph + fr) * 128 + 8 * kg); asm volatile("" : "+v"(pfo));
            bf16x8 pf[4][2];
#pragma unroll
            for (int sn = 0; sn < 4; ++sn) { pf[sn][0] = *(const bf16x8*)(ST + (pfo + (unsigned)(32 * sn))); pf[sn][1] = *(const bf16x8*)(ST + (pfo + (unsigned)(16 * 128 + 32 * sn))); }
            { const int cg = lane & 3, rs = lane >> 2; float o[8][8];
              conv_rows<8>(P, t0 + 8 * rs, C_X + h * 64 + 32 * ph + 8 * cg, cw, cb, h * 64 + 32 * ph + 8 * cg, o);
#pragma unroll
              for (int q = 0; q < 8; ++q) { float v[8] = {o[0][q], o[1][q], o[2][q], o[3][q], o[4][q], o[5][q], o[6][q], o[7][q]};
                  *(LAS bf16x8*)(sXT + (8 * cg + q) * 136 + 8 * rs) = pack8(v); } }
            asm volatile("s_waitcnt lgkmcnt(0)" ::: "memory");
            f32x4 acc[2][8];
#pragma unroll
            for (int nt = 0; nt < 8; ++nt) { acc[0][nt] = (f32x4){0.f, 0.f, 0.f, 0.f}; acc[1][nt] = (f32x4){0.f, 0.f, 0.f, 0.f}; }
#pragma unroll
            for (int nt = 0; nt < 8; ++nt) {
#pragma unroll
                for (int sn = 0; sn < 4; ++sn) { const bf16x8 cf = *(const LAS bf16x8*)(sC + (16 * nt + fr) * 136 + 32 * sn + 8 * kg);
                    acc[0][nt] = MFMA16(pf[sn][0], cf, acc[0][nt]); acc[1][nt] = MFMA16(pf[sn][1], cf, acc[1][nt]); }
                const float sc = __expf(sACS[16 * nt + fr]);
                acc[0][nt] *= sc; acc[1][nt] *= sc; }
#pragma unroll
            for (int sk = 0; sk < 4; ++sk) {
                const int s0 = 32 * sk + 8 * kg;
                const bf16x8 xa0 = *(const LAS bf16x8*)(sXT + fr * 136 + s0), xa1 = *(const LAS bf16x8*)(sXT + (16 + fr) * 136 + s0);
                const f32x4 as0 = *(const LAS f32x4*)(sACS + s0), as1 = *(const LAS f32x4*)(sACS + s0 + 4), d0 = *(const LAS f32x4*)(sDT + s0), d1 = *(const LAS f32x4*)(sDT + s0 + 4);
#pragma unroll
                for (int nt = 0; nt < 8; ++nt) if (nt >= 2 * sk) { const int l = 16 * nt + fr; const float acsl = sACS[l];
                    float cbv[8]; unpack8(*(const LAS u32x4*)(sCB + l * 136 + s0), cbv);
                    float m[8];
#pragma unroll
                    for (int i = 0; i < 8; ++i) { const int s = s0 + i; const float as = i < 4 ? as0[i & 3] : as1[i & 3], ds = i < 4 ? d0[i & 3] : d1[i & 3];
                        float mv = (s <= l) ? cbv[i] * __expf(acsl - as) * ds : 0.f; if (s == l) mv += Dh; m[i] = mv; }
                    const bf16x8 mb = pack8(m);
                    acc[0][nt] = MFMA16(xa0, mb, acc[0][nt]); acc[1][nt] = MFMA16(xa1, mb, acc[1][nt]);
                    asm volatile("" ::: "memory"); }
            }
            u32x2 zall[8][2];
#pragma unroll
            for (int nt = 0; nt < 8; ++nt)
#pragma unroll
                for (int mt = 0; mt < 2; ++mt) zall[nt][mt] = *(const u32x2*)(P + (zb + (unsigned)(16 * nt * LD + 16 * mt)));
#pragma unroll
            for (int nt = 0; nt < 8; ++nt)
#pragma unroll
                for (int mt = 0; mt < 2; ++mt) { u32x2* zp = (u32x2*)(P + (zb + (unsigned)(16 * nt * LD + 16 * mt)));
                    const u32x2 zw = zall[nt][mt]; float y[4];
                    y[0] = acc[mt][nt][0] * siluf_(__uint_as_float(zw.x << 16)); y[1] = acc[mt][nt][1] * siluf_(__uint_as_float(zw.x & 0xffff0000u));
                    y[2] = acc[mt][nt][2] * siluf_(__uint_as_float(zw.y << 16)); y[3] = acc[mt][nt][3] * siluf_(__uint_as_float(zw.y & 0xffff0000u));
                    ssq[nt] += (y[0] * y[0] + y[1] * y[1]) + (y[2] * y[2] + y[3] * y[3]);
                    u32x2 yw; yw.x = pk2(y[0], y[1]); yw.y = pk2(y[2], y[3]); (void)zp; *(LAS u32x2*)(sXT + (16 * nt + fr) * 32 + 16 * mt + 4 * kg) = yw; }
            asm volatile("s_waitcnt lgkmcnt(0)" ::: "memory");
            { const int rr = lane >> 2, cc = lane & 3;
              unsigned so = (unsigned)((t0 + rr) * LD + C_Z + h * 64 + 32 * ph + 8 * cc); asm volatile("" : "+v"(so));
              if (ph == 0) {
#pragma unroll
                  for (int i = 0; i < 8; ++i) { const u32x4 w = *(const LAS u32x4*)(sXT + (16 * i + rr) * 32 + 8 * cc); if (!dry) *(u32x4*)(P + (so + (unsigned)(16 * i * LD))) = w; } } }
            asm volatile("s_waitcnt lgkmcnt(0)" ::: "memory");
        }
        MSTAMP(p, 2);
#pragma unroll
        for (int nt = 0; nt < 8; ++nt) { float v = ssq[nt]; v += __shfl_xor(v, 16); v += __shfl_xor(v, 32); if (kg == 0) sSSQ[wave * 128 + 16 * nt + fr] = v; }
        __syncthreads();
        { const int rr = lane >> 2, cc = lane & 3;
          const float* ng = opq(p.ssd_norm_g) + g * 512 + wave * 64 + 8 * cc;
          f32x4 gg[2][2];
#pragma unroll
          for (int ph = 0; ph < 2; ++ph) { gg[ph][0] = *(const f32x4*)(ng + 32 * ph); gg[ph][1] = *(const f32x4*)(ng + 32 * ph + 4); }
          unsigned so = (unsigned)((t0 + rr) * LD + C_Z + h * 64 + 8 * cc); asm volatile("" : "+v"(so));
          u32x4 yv[8][2];
#pragma unroll
          for (int i = 0; i < 8; ++i)
#pragma unroll
              for (int ph = 0; ph < 2; ++ph) yv[i][ph] = ph == 0 ? *(const u32x4*)(P + (so + (unsigned)(16 * i * LD))) : *(const LAS u32x4*)(sXT + (16 * i + rr) * 32 + 8 * cc);
#pragma unroll
          for (int i = 0; i < 8; ++i) { const int l = 16 * i + rr; float tot = 0.f;
#pragma unroll
              for (int w2 = 0; w2 < 8; ++w2) tot += sSSQ[w2 * 128 + l];
              const float rs = 1.f / sqrtf(tot * (1.f / 512.f) + EPS);
#pragma unroll
              for (int ph = 0; ph < 2; ++ph) { float v[8]; unpack8(yv[i][ph], v);
                  v[0] *= rs * gg[ph][0][0]; v[1] *= rs * gg[ph][0][1]; v[2] *= rs * gg[ph][0][2]; v[3] *= rs * gg[ph][0][3];
                  v[4] *= rs * gg[ph][1][0]; v[5] *= rs * gg[ph][1][1]; v[6] *= rs * gg[ph][1][2]; v[7] *= rs * gg[ph][1][3];
                  if (!dry) *(bf16x8*)(P + (so + (unsigned)(16 * i * LD + 32 * ph))) = pack8(v); } } }
        MSTAMP(p, 3);
    }
}
#define XB_TMO      128
#define XB_XCNT(j)  (256  + 64 * (j))
#define XB_XSUB(j)  (1280 + 64 * (j))
#define XB_XGEN(j)  (2304 + 64 * (j))
#define XB_TOP      3328
#define XB_TOPGEN   3392
#define XCD_BAR_WORDS 3456
#define XB_SPIN_CAP (1u << 18)

__device__ __forceinline__ unsigned xb_ld(unsigned* p)              { return __hip_atomic_load(p, __ATOMIC_RELAXED, __HIP_MEMORY_SCOPE_AGENT); }
__device__ __forceinline__ unsigned xb_add(unsigned* p, unsigned v) { return __hip_atomic_fetch_add(p, v, __ATOMIC_RELAXED, __HIP_MEMORY_SCOPE_AGENT); }
__device__ __forceinline__ unsigned xb_xcc_id() { return (unsigned)__builtin_amdgcn_s_getreg((3 << 11) | 20) & 0xFu; }
#define XB_SPIN(cond, bar) do { unsigned _sp = 0; while (cond) { __builtin_amdgcn_s_sleep(1); \
    if ((++_sp & 255u) == 0u) { if (xb_ld(&(bar)[XB_TMO])) break; if (_sp > XB_SPIN_CAP) { atomicAdd(&(bar)[XB_TMO], 1u); break; } } } } while (0)

struct XcdBarrier {
    unsigned* bar; unsigned x;
    volatile LAS unsigned* st;
};

__device__ __forceinline__ XcdBarrier xcd_barrier_post(unsigned* bar, volatile LAS unsigned* st) {
    XcdBarrier b; b.bar = bar; b.x = xb_xcc_id(); b.st = st;
    if (threadIdx.x == 0) (void)xb_add(&bar[XB_XCNT(b.x)], 1u);
    return b;
}
__device__ __forceinline__ void xcd_barrier_complete(unsigned* bar, unsigned x, unsigned& nloc, unsigned& nx) {
    const unsigned G = gridDim.x * gridDim.y * gridDim.z;
    unsigned sum, cnt, mine, sp = 0u;
    for (;;) {
        sum = 0u; cnt = 0u; mine = 0u;
#pragma unroll
        for (unsigned j = 0; j < 16; ++j) { const unsigned c = xb_ld(&bar[XB_XCNT(j)]); sum += c; cnt += (c > 0u) ? 1u : 0u; mine = (j == x) ? c : mine; }
        if (sum == G) break;
        __builtin_amdgcn_s_sleep(1);
        if ((++sp & 255u) == 0u) { if (xb_ld(&bar[XB_TMO])) break; if (sp > XB_SPIN_CAP) { atomicAdd(&bar[XB_TMO], 1u); break; } }
    }
    nloc = mine > 0u ? mine : 1u; nx = cnt > 0u ? cnt : 1u;
}

__device__ __forceinline__ void xcd_barrier(const XcdBarrier& b) {
    asm volatile("s_waitcnt vmcnt(0)" ::: "memory");
    __syncthreads();
    if (threadIdx.x == 0) {
        unsigned* bar = b.bar; asm volatile("" : "+s"(bar));
        unsigned bx = b.x; asm volatile("" : "+s"(bx));
        __builtin_amdgcn_s_waitcnt(0);
        unsigned nloc = b.st[0], nx = b.st[1];
        if (nloc == 0u) { xcd_barrier_complete(bar, bx, nloc, nx); b.st[0] = nloc; b.st[1] = nx; }
        const unsigned old = xb_add(&bar[XB_XSUB(bx)], 1u);
        const unsigned gen = old / nloc;
        if (old + 1u == (gen + 1u) * nloc) {
            __builtin_amdgcn_fence(__ATOMIC_RELEASE, "agent");
            asm volatile("s_waitcnt vmcnt(0)" ::: "memory");
            const unsigned og = xb_add(&bar[XB_TOP], 1u);
            const unsigned tg = og / nx;
            if (og + 1u == (tg + 1u) * nx) xb_add(&bar[XB_TOPGEN], 1u);
            else XB_SPIN(xb_ld(&bar[XB_TOPGEN]) == tg, bar);
            __builtin_amdgcn_fence(__ATOMIC_ACQUIRE, "agent");
            xb_add(&bar[XB_XGEN(bx)], 1u);
            asm volatile("s_waitcnt vmcnt(0)" ::: "memory");
        } else {
            XB_SPIN(xb_ld(&bar[XB_XGEN(bx)]) == gen, bar);
            __builtin_amdgcn_fence(__ATOMIC_ACQUIRE, "agent");
            asm volatile("s_waitcnt vmcnt(0)" ::: "memory");
        }
    }
    __syncthreads();
}

#ifdef REP_COLD
#define REP_SEP() xcd_barrier(bar)
#else
#define REP_SEP() __syncthreads()
#endif
#define RUNP(n, ...) do { if ((n) > 1) { for (int r_ = nrep(n) - 1; r_ > 0; --r_) { const int dry_ = 1; (void)dry_; __VA_ARGS__; REP_SEP(); } } { const int dry_ = 0; (void)dry_; __VA_ARGS__; } } while (0)
#ifndef REP_SYNC
#define REP_SYNC 1
#endif
#ifndef REP_P0
#define REP_P0 1
#endif
#ifndef REP_P1
#define REP_P1 1
#endif
#ifndef REP_P5
#define REP_P5 1
#endif
#ifndef REP_P6
#define REP_P6 1
#endif
#ifndef REP_ST
#define REP_ST 1
#endif
#ifndef REP_LA
#define REP_LA 1
#endif
#ifndef REP_AT
#define REP_AT 1
#endif
#ifndef REP_SC
#define REP_SC 1
#endif
#ifndef REP_SO
#define REP_SO 1
#endif
#ifndef REP_LF
#define REP_LF 1
#endif
__device__ __forceinline__ int nrep(int n) { asm volatile("" : "+s"(n)); return n; }
__device__ __forceinline__ LAS unsigned char* opl(LAS unsigned char* q) { asm volatile("" : "+s"(q)); return q; }
__global__ void __launch_bounds__(512) mk(Params p) {
    extern __shared__ __attribute__((aligned(16))) unsigned char lds_raw[];
    LAS unsigned char* lds = (LAS unsigned char*)lds_raw;
    if (threadIdx.x < 4) ((volatile LAS unsigned*)(lds + LDS_BYTES - 16))[threadIdx.x] = 0u;
    __syncthreads();
    const XcdBarrier bar = xcd_barrier_post((unsigned*)(p.ws + WS_CTL), (volatile LAS unsigned*)(lds + LDS_BYTES - 16));
    if (p.hi > 1000) cg::this_grid().sync();
#ifdef PROBE_SPAN
    unsigned long long ts0 = 0, ts1 = 0;
#define STAMP(i) do { if ((i) == PROBE_SPAN) ts0 = __builtin_amdgcn_s_memrealtime(); if ((i) == PROBE_SPAN + PROBE_LEN) ts1 = __builtin_amdgcn_s_memrealtime(); } while (0)
#else
#define STAMP(i) do { } while (0)
#endif
    STAMP(0);
    RUNP(REP_P0, phase0(p, opl(lds)));
    xcd_barrier(bar); STAMP(1);
#define BATCH_PHASES(b) do { \
        RUNP(REP_P1, phase1_gemm(p, b, opl(lds))); \
        for (int r = 0; r < nrep(REP_SYNC); ++r) xcd_barrier(bar); \
        STAMP(2 + 6 * b); \
        RUNP(REP_ST, ssd_states_phase(p, b, opl(lds))); \
        __syncthreads(); STAMP(20 + 3 * b); \
        RUNP(REP_LA, lru_phase<false>(p, b, opl(lds), 0)); \
        __syncthreads(); STAMP(21 + 3 * b); \
        RUNP(REP_AT, attn_phase(p, b, opl(lds), dry_)); \
        xcd_barrier(bar); STAMP(3 + 6 * b); \
        RUNP(REP_SC, ssd_scan_phase(p, b, dry_)); \
        lru_carry_phase(p, b); \
        xcd_barrier(bar); STAMP(4 + 6 * b); \
        RUNP(REP_SO, ssd_out_phase(p, b, opl(lds), dry_)); \
        __syncthreads(); STAMP(22 + 3 * b); \
        RUNP(REP_LF, lru_phase<true>(p, b, opl(lds), dry_)); \
        xcd_barrier(bar); STAMP(5 + 6 * b); \
        RUNP(REP_P5, phase5_gemm(p, b, opl(lds))); \
        xcd_barrier(bar); STAMP(6 + 6 * b); \
        RUNP(REP_P6, phase6_gemm(p, b, opl(lds))); \
        if (b + 1 < NBATCH && gridDim.x != 256) xcd_barrier(bar);     \
        STAMP(7 + 6 * b); \
    } while (0)
    BATCH_PHASES(0);
    BATCH_PHASES(1);
#ifdef PROBE_MA
    if (blockIdx.x == 0 && threadIdx.x == 0) { const unsigned long long* tsm = (const unsigned long long*)(p.ws + 255 * MiB); const unsigned long long t2 = __builtin_amdgcn_s_memrealtime(), want = 8ull * (tsm[PROBE_MB] - tsm[PROBE_MA]);
        while (__builtin_amdgcn_s_memrealtime() - t2 < want) __builtin_amdgcn_s_sleep(16); }
#endif
#ifdef PROBE_SPAN
    if (blockIdx.x == 0 && threadIdx.x == 0) { const unsigned long long t2 = __builtin_amdgcn_s_memrealtime(), want = 8ull * (ts1 - ts0);
        while (__builtin_amdgcn_s_memrealtime() - t2 < want) __builtin_amdgcn_s_sleep(16); }
#endif
}

static void launch_mk(Params& p, int lo, int hi, int grid, hipStream_t stream) {
    p.lo = lo; p.hi = hi; void* args[] = {&p};
    (void)hipMemsetAsync(p.ws + WS_CTL, 0, 65536, stream);
    hipError_t e = hipLaunchCooperativeKernel((const void*)mk, dim3(grid), dim3(512), args, LDS_BYTES, stream);
    if (e != hipSuccess) fprintf(stderr, "cooperative launch failed: %s (grid %d)\n", hipGetErrorString(e), grid);
}
extern "C" void kernel_launch(void* const* d_in, const int* in_sizes, int n_in, void* d_out, int out_size, void* d_ws, size_t ws_size, hipStream_t stream) {
    static int grid = 0;
    if (grid == 0) {
        if (n_in != 24 || out_size != MTOK * DM || ws_size < WS_END) { fprintf(stderr, "kernel_launch: unexpected shapes (n_in %d out %d ws %zu)\n", n_in, out_size, ws_size); grid = -1; return; }
        int dev = 0, cus = 0, per_cu = 0;
        hipGetDevice(&dev); hipDeviceGetAttribute(&cus, hipDeviceAttributeMultiprocessorCount, dev);
        hipFuncSetAttribute((const void*)mk, hipFuncAttributeMaxDynamicSharedMemorySize, LDS_BYTES);
        hipOccupancyMaxActiveBlocksPerMultiprocessor(&per_cu, (const void*)mk, 512, LDS_BYTES);
        if (per_cu < 1) { fprintf(stderr, "kernel_launch: occupancy query says %d blocks/CU\n", per_cu); per_cu = 1; }
        grid = cus * 1;
        (void)hipGetLastError();
    }
    if (grid < 0) return;
    Params p{};
    const float** f = (const float**)&p;
    for (int i = 0; i < 24; ++i) f[i] = (const float*)d_in[i];
    p.out = (float*)d_out; p.ws = (unsigned char*)d_ws;
    launch_mk(p, 0, 14, grid, stream);
}
```

```cpp
#define NAIVE_GEMM 0
#define NAIVE_ATT 0
#define NAIVE_LRU 0
#define NAIVE_SSD 0
#define ONE_LAUNCH 1

#include <hip/hip_runtime.h>
#include <hip/hip_cooperative_groups.h>
#include <cstdio>
#include <cstdint>
namespace cg = cooperative_groups;

#ifndef NAIVE_GEMM
#define NAIVE_GEMM 1
#endif
#ifndef NAIVE_SSD
#define NAIVE_SSD 1
#endif
#ifndef NAIVE_LRU
#define NAIVE_LRU 1
#endif
#ifndef NAIVE_ATT
#define NAIVE_ATT 1
#endif
#ifndef ONE_LAUNCH
#define ONE_LAUNCH 0
#endif

namespace pg8 {
#define PG8_LAS __attribute__((address_space(3)))
typedef unsigned short bf16_t;
typedef short bf16x8 __attribute__((ext_vector_type(8)));
typedef float f32x4 __attribute__((ext_vector_type(4)));
typedef unsigned u32x4 __attribute__((ext_vector_type(4)));
constexpr int BM = 256, BK = 64, HALF = 128, HTB = HALF * BK * 2  , STAGE_BYTES = 8 * HTB, NXCD = 8, WGM = 8;

__host__ __device__ __forceinline__ int lds_byte(int r, int c) { const int st = (r >> 4) * 2 + (c >> 5), rr = r & 15, cc = c & 31, ob = rr * 64 + cc * 2; return st * 1024 + (ob ^ (((ob >> 9) & 1) << 5)); }
__host__ __device__ __forceinline__ void stage_rc(int b, int& R, int& C) { const int st = b / 1024, sb = b % 1024, swz = sb ^ (((sb >> 9) & 1) << 5); R = (st >> 1) * 16 + swz / 64; C = (st & 1) * 32 + (swz % 64) / 2; }
__host__ __device__ __forceinline__ int perm32(int rho) { const int n = rho >> 4, i = rho & 15; return 8 * (i >> 2) + 4 * n + (i & 3); }

struct Unit { int pm, pn; };
struct Gemm { const bf16_t* A; const bf16_t* Bt; int M, N, K, lda, ldb; };

struct StaticOrder {
    int nM, nN, nwg, G, c;
    __host__ __device__ void init(int M, int N, int G_, int c_) { nM = M / BM; nN = N / BM; nwg = nM * nN; G = G_; c = c_; }
    __host__ __device__ bool next(int i, Unit& u) const {
        const long L = (long)i * G + c; if (L >= nwg) return false;
        int wgid = (int)L; { const int q = nwg / NXCD, r = nwg % NXCD, xcd = wgid % NXCD, off = wgid / NXCD; wgid = (xcd < r ? xcd * (q + 1) : r * (q + 1) + (xcd - r) * q) + off; }
        const int nig = WGM * nN, gid = wgid / nig, fm = gid * WGM, gsz = (nM - fm) < WGM ? (nM - fm) : WGM;
        u.pm = fm + ((wgid % nig) % gsz); u.pn = (wgid % nig) / gsz; return true;
    }
    __device__ __forceinline__ void a_ready(const Unit&) const {}
    __device__ __forceinline__ void done(const Unit&) const {}
};

__device__ __forceinline__ unsigned cvt_pk_bf16(float lo, float hi) { unsigned r; asm volatile("v_cvt_pk_bf16_f32 %0, %1, %2" : "=v"(r) : "v"(lo), "v"(hi)); return r; }
typedef float f32x2 __attribute__((ext_vector_type(2)));
__device__ __forceinline__ f32x2 gelu_pk(f32x2 v) {
    const f32x2 av = __builtin_elementwise_abs(v), d = av * 0.2316418882f + 1.0f;
    f32x2 t; t.x = __builtin_amdgcn_rcpf(d.x); t.y = __builtin_amdgcn_rcpf(d.y);
    f32x2 q = t * 0.5307027145f + (-0.7265760135f); q = q * t + 0.7107068705f; q = q * t + (-0.142248368f); q = q * t + 0.127414796f; q = q * t;
    const f32x2 s = (v * v) * (-0.72134752044f);
    f32x2 e; e.x = __builtin_amdgcn_exp2f(s.x); e.y = __builtin_amdgcn_exp2f(s.y);
    const f32x2 m = v * (q * e), r = v - m;
    f32x2 o; o.x = v.x < 0.f ? m.x : r.x; o.y = v.y < 0.f ? m.y : r.y; return o;
}

template <int ACT  > struct EpiBf16 {
    static constexpr bool PERM = true, AFTER_DRAIN = false; static_assert(ACT == 0 || ACT == 1, "EpiBf16: ACT is 0 (none) or 1 (gelu_pk)");
    bf16_t* O; int ldc; const float* bias; int split_cols; size_t split_stride; float scale0;
    __device__ __forceinline__ void operator()(const f32x4 (&acc)[2][2][4][2], const Unit& u, int wr, int wc, int fr, int fq) const {
        const int row0 = u.pm * BM + wr * 64 + fr; int colt = u.pn * BM; bf16_t* base = O;
        float sc = 1.f; if (split_cols) { const int t = colt / split_cols; base += (size_t)t * split_stride; colt -= t * split_cols; if (t == 0) sc = scale0; }
        const int col0 = colt + wc * 32 + 8 * fq, bcol0 = u.pn * BM + wc * 32 + 8 * fq;
        f32x4 bv[2][2];
#pragma unroll
        for (int bj = 0; bj < 2; ++bj)
#pragma unroll
            for (int n = 0; n < 2; ++n) bv[bj][n] = bias ? *(const f32x4*)(bias + bcol0 + bj * HALF + 4 * n) : (f32x4){0.f, 0.f, 0.f, 0.f};
#pragma unroll
        for (int ai = 0; ai < 2; ++ai)
#pragma unroll
            for (int m = 0; m < 4; ++m) { bf16_t* rowp = base + (size_t)(row0 + ai * HALF + m * 16) * ldc + col0;
#pragma unroll
                for (int bj = 0; bj < 2; ++bj) { f32x4 v0 = acc[ai][bj][m][0] + bv[bj][0], v1 = acc[ai][bj][m][1] + bv[bj][1];
                    if (ACT == 1) { f32x2 a = gelu_pk((f32x2){v0[0], v0[1]}), b = gelu_pk((f32x2){v0[2], v0[3]}), c = gelu_pk((f32x2){v1[0], v1[1]}), d = gelu_pk((f32x2){v1[2], v1[3]});
                        v0 = (f32x4){a.x, a.y, b.x, b.y}; v1 = (f32x4){c.x, c.y, d.x, d.y}; }
                    v0 = v0 * sc; v1 = v1 * sc; u32x4 w; w.x = cvt_pk_bf16(v0[0], v0[1]); w.y = cvt_pk_bf16(v0[2], v0[3]); w.z = cvt_pk_bf16(v1[0], v1[1]); w.w = cvt_pk_bf16(v1[2], v1[3]);
                    *(u32x4*)(rowp + bj * HALF) = w; } }
    }
};
template <class Epi, class Sched, bool ALIGN_EPI = false, bool SP2 = false>
__device__ __forceinline__ void gemm_phase(PG8_LAS unsigned char* lds, const Gemm g, const Sched& S, const Epi& E) {
    int tid_ = threadIdx.x; asm volatile("" : "+v"(tid_));
    const int tid = tid_, wid = __builtin_amdgcn_readfirstlane(tid >> 6), lane = tid & 63, wr = wid >> 2, wc = wid & 3, fr = lane & 15, fq = lane >> 4;
    const int K = g.K, nt = K / BK;
    unsigned voffA[2], voffB[2];
#pragma unroll
    for (int i = 0; i < 2; ++i) { int R, C; stage_rc(tid * 16 + i * 8192, R, C); const int Rb = Epi::PERM ? ((R & ~31) + perm32(R & 31)) : R;
        voffA[i] = (unsigned)(R * g.lda + C) * 2u; voffB[i] = (unsigned)(Rb * g.ldb + C) * 2u; }
    const size_t kstep = (size_t)(BK * 2);
    const size_t hstepA = (size_t)HALF * g.lda * 2, hstepB = (size_t)HALF * g.ldb * 2;
    const size_t tstepA = 2 * hstepA, tstepB = 2 * hstepB;
    const unsigned ldsw = (unsigned)wid * 1024u;
    const int aoff = lds_byte(wr * 64 + fr, fq * 8), boff = lds_byte(wc * 32 + fr, fq * 8);
#define PG8_SA(b, h) (((b) * 2 + (h)) * HTB)
#define PG8_SB(b, h) ((4 + (b) * 2 + (h)) * HTB)
#define PG8_STAGE(bufoff, gbase, voff) do { _Pragma("unroll") for (int _i = 0; _i < 2; ++_i) \
        __builtin_amdgcn_global_load_lds((const unsigned*)((const char*)(gbase) + (voff)[_i]), (PG8_LAS unsigned*)(lds + (bufoff) + ldsw + _i * 8192), 16, 0, 0); } while (0)
#define PG8_LDA(dst, b, h) do { _Pragma("unroll") for (int m = 0; m < 4; ++m) _Pragma("unroll") for (int k = 0; k < 2; ++k) dst[m][k] = *(const PG8_LAS bf16x8*)(lds + PG8_SA(b, h) + aoff + m * 2048 + k * 1024); } while (0)
#define PG8_LDB(dst, b, h) do { _Pragma("unroll") for (int n = 0; n < 2; ++n) _Pragma("unroll") for (int k = 0; k < 2; ++k) dst[n][k] = *(const PG8_LAS bf16x8*)(lds + PG8_SB(b, h) + boff + n * 2048 + k * 1024); } while (0)
#define PG8_MMA(ai, bj, At, Bt) do { __builtin_amdgcn_s_setprio(1); _Pragma("unroll") for (int m = 0; m < 4; ++m) _Pragma("unroll") for (int n = 0; n < 2; ++n) _Pragma("unroll") for (int k = 0; k < 2; ++k) \
        acc[ai][bj][m][n] = __builtin_amdgcn_mfma_f32_16x16x32_bf16(Bt[n][k], At[m][k], acc[ai][bj][m][n], 0, 0, 0); __builtin_amdgcn_s_setprio(0); } while (0)
#define PG8_WAIT_V(n) asm volatile("s_waitcnt vmcnt(" #n ")" ::: "memory")
#define PG8_WAIT_L(n) asm volatile("s_waitcnt lgkmcnt(" #n ")" ::: "memory")
#define PG8_BAR __builtin_amdgcn_s_barrier()
#define PG8_SCHED __builtin_amdgcn_sched_barrier(0)
    Unit cur, nxt; int ui = 0;
    if (!S.next(0, cur)) return;
    f32x4 acc[2][2][4][2];
#pragma unroll
    for (int a = 0; a < 2; ++a)
#pragma unroll
        for (int b = 0; b < 2; ++b)
#pragma unroll
            for (int m = 0; m < 4; ++m)
#pragma unroll
                for (int n = 0; n < 2; ++n) acc[a][b][m][n] = (f32x4){0.f, 0.f, 0.f, 0.f};
    bf16x8 At[4][2], B0[2][2], B1[2][2];
    const char* cA = (const char*)g.A + (size_t)cur.pm * tstepA; const char* cB = (const char*)g.Bt + (size_t)cur.pn * tstepB;
    S.a_ready(cur);
    if constexpr (SP2) {
        PG8_STAGE(PG8_SB(0, 0), cB, voffB); PG8_STAGE(PG8_SB(0, 1), cB + hstepB, voffB); PG8_STAGE(PG8_SA(0, 0), cA, voffA); PG8_STAGE(PG8_SA(0, 1), cA + hstepA, voffA);
        if (wr == 1) PG8_BAR;
        PG8_WAIT_V(2); PG8_BAR;
        PG8_STAGE(PG8_SB(1, 0), cB + kstep, voffB); PG8_STAGE(PG8_SA(1, 0), cA + kstep, voffA); PG8_STAGE(PG8_SB(1, 1), cB + hstepB + kstep, voffB);
        PG8_WAIT_V(6); PG8_BAR;
    } else {
        PG8_STAGE(PG8_SB(0, 0), cB, voffB); PG8_STAGE(PG8_SA(0, 0), cA, voffA); PG8_STAGE(PG8_SB(0, 1), cB + hstepB, voffB); PG8_STAGE(PG8_SA(0, 1), cA + hstepA, voffA);
        if (wr == 1) PG8_BAR;
        PG8_WAIT_V(4); PG8_BAR;
        PG8_STAGE(PG8_SB(1, 0), cB + kstep, voffB); PG8_STAGE(PG8_SA(1, 0), cA + kstep, voffA); PG8_STAGE(PG8_SB(1, 1), cB + hstepB + kstep, voffB);
        PG8_WAIT_V(6); PG8_BAR;
    }
    for (;;) {
        const bool has_next = S.next(ui + 1, nxt);
        const char* nA = has_next ? (const char*)g.A + (size_t)nxt.pm * tstepA : cA; const char* nB = has_next ? (const char*)g.Bt + (size_t)nxt.pn * tstepB : cB;
        for (int t = 0; t < nt; t += 2) {
            const bool last = (t == nt - 2);
            const char* a1 = cA + (size_t)(t + 1) * kstep;
            const char* a2 = last ? nA : cA + (size_t)(t + 2) * kstep; const char* b2 = last ? nB : cB + (size_t)(t + 2) * kstep;
            const char* a3 = a2 + kstep; const char* b3 = b2 + kstep;
            if (last && has_next) S.a_ready(nxt);
            if constexpr (SP2) {
            PG8_LDB(B0, 0, 0); PG8_LDB(B1, 0, 1); PG8_SCHED; PG8_LDA(At, 0, 0); PG8_STAGE(PG8_SA(1, 1), a1 + hstepA, voffA);
            PG8_WAIT_V(8); PG8_WAIT_L(0); PG8_BAR; PG8_MMA(0, 0, At, B0); PG8_MMA(0, 1, At, B1); PG8_BAR; PG8_SCHED;
            PG8_LDA(At, 0, 1); PG8_STAGE(PG8_SB(0, 0), b2, voffB); PG8_STAGE(PG8_SB(0, 1), b2 + hstepB, voffB); PG8_STAGE(PG8_SA(0, 0), a2, voffA);
            PG8_WAIT_V(8); PG8_WAIT_L(0); PG8_BAR; PG8_MMA(1, 0, At, B0); PG8_MMA(1, 1, At, B1); PG8_BAR; PG8_SCHED;
            PG8_LDB(B0, 1, 0); PG8_LDB(B1, 1, 1); PG8_SCHED; PG8_LDA(At, 1, 0); PG8_STAGE(PG8_SA(0, 1), a2 + hstepA, voffA);
            PG8_WAIT_V(8); PG8_WAIT_L(0); PG8_BAR; PG8_MMA(0, 0, At, B0); PG8_MMA(0, 1, At, B1); PG8_BAR; PG8_SCHED;
            PG8_LDA(At, 1, 1); PG8_STAGE(PG8_SB(1, 0), b3, voffB); PG8_STAGE(PG8_SB(1, 1), b3 + hstepB, voffB); PG8_STAGE(PG8_SA(1, 0), a3, voffA);
            PG8_WAIT_V(8); PG8_WAIT_L(0); PG8_BAR; PG8_MMA(1, 0, At, B0); PG8_MMA(1, 1, At, B1); PG8_BAR; PG8_SCHED;
            } else {
            PG8_LDB(B0, 0, 0); PG8_SCHED; PG8_LDA(At, 0, 0); PG8_STAGE(PG8_SA(1, 1), a1 + hstepA, voffA);
            PG8_WAIT_L(8); PG8_BAR; PG8_WAIT_L(0); PG8_MMA(0, 0, At, B0); PG8_BAR; PG8_SCHED;
            PG8_LDB(B1, 0, 1); PG8_STAGE(PG8_SB(0, 0), b2, voffB);
            PG8_BAR; PG8_WAIT_L(0); PG8_MMA(0, 1, At, B1); PG8_BAR;
            PG8_LDA(At, 0, 1); PG8_STAGE(PG8_SA(0, 0), a2, voffA);
            PG8_BAR; PG8_WAIT_L(0); PG8_MMA(1, 0, At, B0); PG8_BAR; PG8_SCHED;
            PG8_STAGE(PG8_SB(0, 1), b2 + hstepB, voffB);
            PG8_WAIT_V(6); PG8_BAR; PG8_MMA(1, 1, At, B1); PG8_BAR;
            PG8_LDB(B0, 1, 0); PG8_SCHED; PG8_LDA(At, 1, 0); PG8_STAGE(PG8_SA(0, 1), a2 + hstepA, voffA);
            PG8_WAIT_L(8); PG8_BAR; PG8_WAIT_L(0); PG8_MMA(0, 0, At, B0); PG8_BAR; PG8_SCHED;
            PG8_LDB(B1, 1, 1); PG8_STAGE(PG8_SB(1, 0), b3, voffB);
            PG8_BAR; PG8_WAIT_L(0); PG8_MMA(0, 1, At, B1); PG8_BAR;
            PG8_LDA(At, 1, 1); PG8_STAGE(PG8_SA(1, 0), a3, voffA);
            PG8_BAR; PG8_WAIT_L(0); PG8_MMA(1, 0, At, B0); PG8_BAR; PG8_SCHED;
            PG8_STAGE(PG8_SB(1, 1), b3 + hstepB, voffB);
            PG8_WAIT_V(6); PG8_BAR; PG8_MMA(1, 1, At, B1); PG8_BAR;
            }
        }
        if constexpr (ALIGN_EPI) { if (wr == 0) PG8_BAR; }
        if constexpr (!Epi::AFTER_DRAIN) { E(acc, cur, wr, wc, fr, fq); S.done(cur); }
        if (!has_next) break;
#pragma unroll
        for (int a = 0; a < 2; ++a)
#pragma unroll
            for (int b = 0; b < 2; ++b)
#pragma unroll
                for (int m = 0; m < 4; ++m)
#pragma unroll
                    for (int n = 0; n < 2; ++n) acc[a][b][m][n] = (f32x4){0.f, 0.f, 0.f, 0.f};
        cur = nxt; cA = nA; cB = nB; ++ui;
        if constexpr (ALIGN_EPI) { if (wr == 1) PG8_BAR; }
    }
    PG8_WAIT_V(0);
    if constexpr (!ALIGN_EPI) { if (wr == 0) PG8_BAR; }
    PG8_BAR;
    if constexpr (Epi::AFTER_DRAIN) { E.fused(acc, cur, wr, wc, fr, fq, lds, wid, lane); S.done(cur); }
#undef PG8_SA
#undef PG8_SB
#undef PG8_STAGE
#undef PG8_LDA
#undef PG8_LDB
#undef PG8_MMA
#undef PG8_WAIT_V
#undef PG8_WAIT_L
#undef PG8_BAR
#undef PG8_SCHED
}
}

#define GAS __attribute__((address_space(1)))
#define LAS __attribute__((address_space(3)))
typedef unsigned short bf16_t;
typedef short bf16x8 __attribute__((ext_vector_type(8)));
typedef float f32x4 __attribute__((ext_vector_type(4)));
typedef unsigned u32x4 __attribute__((ext_vector_type(4)));
typedef unsigned u32x2 __attribute__((ext_vector_type(2)));

constexpr int DM = 1024, NBATCH = 2, SEQ = 8192, MEML = 256, MTOK = NBATCH * SEQ;
constexpr int INW = 12320, LD = 12544;
constexpr int C_Z = 0, C_X = 2048, C_B = 4096, C_C = 4608, C_LG = 5120, C_LX = 6656, C_Q = 8192, C_G = 9216, C_DT = 12288;
constexpr int C_MRG = 2048;
constexpr int NHEAD = 32, HDIM = 64, NGRP = 4, NSTATE = 128, CHUNK = 128, NCHUNK = SEQ / CHUNK;
constexpr int LRUW = 1536, LRUB = 96, NLB = 16, LSEG = 512, NSEG = SEQ / LSEG, NBLK64 = SEQ / 64;
constexpr float EPS = 1e-6f;
constexpr size_t MiB = 1u << 20;
constexpr size_t WS_WIN = 0, WS_WKV = 25 * MiB, WS_WSSD = 29 * MiB, WS_WLRU = 33 * MiB, WS_WMEM = 36 * MiB, WS_WOUT = 38 * MiB;
constexpr size_t WS_PROJ = 40 * MiB;
constexpr size_t WS_MEMN = 236 * MiB, WS_KVK = 237 * MiB, WS_KVVT = 238 * MiB, WS_LRUWA = 239 * MiB, WS_LRUWX = 239 * MiB + 512 * 1024;
constexpr size_t WS_DASUM = 240 * MiB;
constexpr size_t WS_LAGG = 246 * MiB;
constexpr size_t WS_LCAR = 250 * MiB;
constexpr size_t WS_CTL = 244 * MiB;
constexpr size_t WS_XBUF = 245 * MiB;
constexpr size_t WS_END = 256 * MiB;
static_assert(WS_PROJ + (size_t)SEQ * LD * 2 <= WS_MEMN, "ws map");
constexpr int LDS_BYTES = 155648;

struct Params {
    const float *x, *mem, *norm_g, *w_in, *ssd_conv_w, *ssd_conv_b, *ssd_dt_bias, *ssd_a_log, *ssd_d, *ssd_norm_g,
        *lru_conv_w, *lru_conv_b, *lru_w_a, *lru_b_a, *lru_w_x, *lru_b_x, *lru_lambda, *mem_norm_g, *w_kv,
        *w_br_ssd, *w_br_lru, *w_br_mem, *w_out, *final_g;
    float* out; unsigned char* ws;
    int lo, hi;
};

__device__ __forceinline__ float bf2f(bf16_t v) { return __uint_as_float((unsigned)v << 16); }
__device__ __forceinline__ unsigned f2bf(float f) { unsigned u = __float_as_uint(f); return (u + 0x7fffu + ((u >> 16) & 1u)) >> 16; }
__device__ __forceinline__ unsigned pk2(float lo, float hi) { return f2bf(lo) | (f2bf(hi) << 16); }
__device__ __forceinline__ float sigmoidf_(float v) { return __builtin_amdgcn_rcpf(1.f + __expf(-v)); }
__device__ __forceinline__ float siluf_(float v) { return v * __builtin_amdgcn_rcpf(1.f + __expf(-v)); }
__device__ __forceinline__ float softplusf_(float v) { const float e = __expf(v); const float sm = e * (1.f - e * (0.5f - e * 0.33333334f)); return v > 20.f ? v : (e < 1e-3f ? sm : __logf(1.f + e)); }
__device__ __forceinline__ float wave_sum(float v) {
#pragma unroll
    for (int o = 1; o < 64; o <<= 1) v += __shfl_xor(v, o);
    return v;
}
template <class T> __device__ __forceinline__ T* opq(T* q) { asm volatile("" : "+s"(q)); return q; }
__device__ __forceinline__ int opq_tid() { int t = threadIdx.x; asm volatile("" : "+v"(t)); return t; }
__device__ __forceinline__ int opq_bid() { int t = blockIdx.x; asm volatile("" : "+s"(t)); return t; }
__device__ __forceinline__ unsigned char* wsb(const Params& p) { return opq(p.ws); }
__device__ __forceinline__ bf16_t* proj_ptr(const Params& p) { return (bf16_t*)(wsb(p) + WS_PROJ); }
__device__ __forceinline__ bf16_t* xn_ptr(const Params& p) { return (bf16_t*)((unsigned char*)opq(p.out) + 32 * MiB); }
__device__ __forceinline__ bf16_t* states_ptr(const Params& p, int b) { return (bf16_t*)((unsigned char*)opq(p.out) + (size_t)b * 32 * MiB); }
__device__ __forceinline__ float* scr_ptr(const Params& p, int b) { return (float*)((unsigned char*)opq(p.out) + (size_t)b * 32 * MiB); }

#ifdef PROBE_MA
#define MSTAMP(p, i) do { if (blockIdx.x == 0 && threadIdx.x == 0) ((unsigned long long*)(wsb(p) + 255 * MiB))[i] = __builtin_amdgcn_s_memrealtime(); } while (0)
#else
#define MSTAMP(p, i) do { } while (0)
#endif
__device__ __forceinline__ void transpose_item(const float* W, int K, int Ns, int srccol0, bf16_t* WT, int dstrow0, LAS float* scr, int k0, int lane) {
    float wv[32];
#pragma unroll
    for (int i = 0; i < 32; ++i) wv[i] = W[(size_t)(k0 + 2 * i + (lane >> 5)) * Ns + srccol0 + (lane & 31)];
#pragma unroll
    for (int i = 0; i < 32; ++i) scr[(2 * i + (lane >> 5)) * 33 + (lane & 31)] = wv[i];
    asm volatile("s_waitcnt lgkmcnt(0)" ::: "memory");
    const int c = lane & 7;
#pragma unroll
    for (int j = 0; j < 4; ++j) { const int n = (lane >> 3) + 8 * j; const LAS float* s = scr + (8 * c) * 33 + n;
        u32x4 o; o.x = pk2(s[0 * 33], s[1 * 33]); o.y = pk2(s[2 * 33], s[3 * 33]); o.z = pk2(s[4 * 33], s[5 * 33]); o.w = pk2(s[6 * 33], s[7 * 33]);
        *(u32x4*)(WT + (size_t)(dstrow0 + n) * K + k0 + 8 * c) = o; }
    asm volatile("s_waitcnt lgkmcnt(0)" ::: "memory");
}
__device__ __forceinline__ void rms_row_to_bf16(const float* xrow, const float* g, bf16_t* orow, int lane) {
    const f32x4* xr = (const f32x4*)xrow + lane; const f32x4* gr = (const f32x4*)g + lane;
    f32x4 v[4]; float s = 0.f;
#pragma unroll
    for (int j = 0; j < 4; ++j) { v[j] = xr[64 * j]; s += (v[j].x * v[j].x + v[j].y * v[j].y) + (v[j].z * v[j].z + v[j].w * v[j].w); }
    const float rs = 1.f / sqrtf(wave_sum(s) * (1.f / DM) + EPS);
    unsigned long long* o8 = (unsigned long long*)orow + lane;
#pragma unroll
    for (int j = 0; j < 4; ++j) { const f32x4 gg = gr[64 * j];
        o8[64 * j] = (unsigned long long)pk2(v[j].x * rs * gg.x, v[j].y * rs * gg.y) | ((unsigned long long)pk2(v[j].z * rs * gg.z, v[j].w * rs * gg.w) << 32); }
}
__device__ __forceinline__ void xn_rows(const Params& p, int row_lo, int row_hi, int gw, int NGW, int lane) {
    bf16_t* XN = xn_ptr(p);
    { const float* xb = opq(p.x); const f32x4* gr = (const f32x4*)opq(p.norm_g) + lane;
      for (int m0 = row_lo + gw * 4; m0 < row_hi; m0 += NGW * 4) {
          f32x4 v[4][4];
#pragma unroll
          for (int r = 0; r < 4; ++r)
#pragma unroll
              for (int j = 0; j < 4; ++j) v[r][j] = ((const f32x4*)(xb + (size_t)(m0 + r) * DM) + lane)[64 * j];
#pragma unroll
          for (int r = 0; r < 4; ++r) { float s = 0.f;
#pragma unroll
              for (int j = 0; j < 4; ++j) s += (v[r][j].x * v[r][j].x + v[r][j].y * v[r][j].y) + (v[r][j].z * v[r][j].z + v[r][j].w * v[r][j].w);
              const float rs = 1.f / sqrtf(wave_sum(s) * (1.f / DM) + EPS);
              unsigned long long* o8 = (unsigned long long*)(XN + (size_t)(m0 + r) * DM) + lane;
#pragma unroll
              for (int j = 0; j < 4; ++j) { const f32x4 gg = gr[64 * j];
                  o8[64 * j] = (unsigned long long)pk2(v[r][j].x * rs * gg.x, v[r][j].y * rs * gg.y) | ((unsigned long long)pk2(v[r][j].z * rs * gg.z, v[r][j].w * rs * gg.w) << 32); } } } }
}
__device__ __forceinline__ void phase0(const Params& p, LAS unsigned char* lds) {
    const int tid = opq_tid(), lane = tid & 63, wave = tid >> 6, bid = opq_bid();
    const int gw = bid * 8 + wave, NGW = gridDim.x * 8;
    LAS float* scr = (LAS float*)(lds + wave * 8704);
    bf16_t* Win = (bf16_t*)(wsb(p) + WS_WIN); bf16_t* Wkv = (bf16_t*)(wsb(p) + WS_WKV); bf16_t* Wssd = (bf16_t*)(wsb(p) + WS_WSSD);
    bf16_t* Wlru = (bf16_t*)(wsb(p) + WS_WLRU); bf16_t* Wmem = (bf16_t*)(wsb(p) + WS_WMEM); bf16_t* Wout = (bf16_t*)(wsb(p) + WS_WOUT);
    constexpr int I_IN = 16 * 385, I_KV = 16 * 64, I_SSD = 32 * 32, I_LRU = 24 * 32, I_MEM = 16 * 32, I_OUT = 16 * 32;
    constexpr int NITEMS = I_IN + I_KV + I_SSD + I_LRU + I_MEM + I_OUT;
    for (int it = gw; it < NITEMS; it += NGW) {
        int r = it;
        if (r < I_IN) { const int nb = r % 385, kb = r / 385; const int sc = 32 * nb; int dr;
            if (sc < 5120) dr = sc; else if (sc < 5152) dr = sc - 5120 + C_DT; else dr = sc - 32;
            transpose_item(opq(p.w_in), 1024, INW, sc, Win, dr, scr, 64 * kb, lane); continue; } r -= I_IN;
        if (r < I_KV) { transpose_item(opq(p.w_kv), 1024, 2048, 32 * (r % 64), Wkv, 32 * (r % 64), scr, 64 * (r / 64), lane); continue; } r -= I_KV;
        if (r < I_SSD) { transpose_item(opq(p.w_br_ssd), 2048, 1024, 32 * (r % 32), Wssd, 32 * (r % 32), scr, 64 * (r / 32), lane); continue; } r -= I_SSD;
        if (r < I_LRU) { transpose_item(opq(p.w_br_lru), 1536, 1024, 32 * (r % 32), Wlru, 32 * (r % 32), scr, 64 * (r / 32), lane); continue; } r -= I_LRU;
        if (r < I_MEM) { transpose_item(opq(p.w_br_mem), 1024, 1024, 32 * (r % 32), Wmem, 32 * (r % 32), scr, 64 * (r / 32), lane); continue; } r -= I_MEM;
        transpose_item(opq(p.w_out), 1024, 1024, 32 * (r % 32), Wout, 32 * (r % 32), scr, 64 * (r / 32), lane);
    }
    { const int gt = bid * 512 + tid, NT = gridDim.x * 512; u32x4* z = (u32x4*)(Win + (size_t)INW * 1024);
      for (int i = gt; i < (LD - INW) * 1024 / 8; i += NT) z[i] = (u32x4){0u, 0u, 0u, 0u}; }
    { const int gt = bid * 512 + tid, NT = gridDim.x * 512; bf16_t* wa = (bf16_t*)(wsb(p) + WS_LRUWA); bf16_t* wx = (bf16_t*)(wsb(p) + WS_LRUWX);
      for (int e = gt; e < NLB * LRUB * LRUB; e += NT) { const int n = e / (LRUB * LRUB), r2 = e % (LRUB * LRUB), j = r2 / LRUB, i = r2 % LRUB;
          wa[e] = (bf16_t)f2bf(opq(p.lru_w_a)[(n * LRUB + i) * LRUB + j]); wx[e] = (bf16_t)f2bf(opq(p.lru_w_x)[(n * LRUB + i) * LRUB + j]); } }
    bf16_t* XN = xn_ptr(p); bf16_t* MN = (bf16_t*)(wsb(p) + WS_MEMN);
    if (gridDim.x == 256) xn_rows(p, 0, SEQ, gw, NGW, lane); else xn_rows(p, 0, MTOK, gw, NGW, lane);
    for (int m = gw; m < NBATCH * MEML; m += NGW) rms_row_to_bf16(opq(p.mem) + (size_t)m * DM, opq(p.mem_norm_g), MN + (size_t)m * DM, lane);
}
__device__ __forceinline__ void phase7(const Params& p) {
    const int tid = opq_tid(), lane = tid & 63, wave = tid >> 6; const int gw = opq_bid() * 8 + wave, NGW = gridDim.x * 8; float* outb = opq(p.out); const float* fg = opq(p.final_g);
    for (int m = gw; m < MTOK; m += NGW) {
        f32x4* xr = (f32x4*)(outb + (size_t)m * DM) + lane; const f32x4* gr = (const f32x4*)fg + lane;
        f32x4 v[4]; float s = 0.f;
#pragma unroll
        for (int j = 0; j < 4; ++j) { v[j] = xr[64 * j]; s += (v[j].x * v[j].x + v[j].y * v[j].y) + (v[j].z * v[j].z + v[j].w * v[j].w); }
        const float rs = 1.f / sqrtf(wave_sum(s) * (1.f / DM) + EPS);
#pragma unroll
        for (int j = 0; j < 4; ++j) { const f32x4 gg = gr[64 * j]; xr[64 * j] = v[j] * rs * gg; }
    }
}

namespace pg8 {
template <int BR> struct EpiMerge {
    static constexpr bool PERM = true, AFTER_DRAIN = false;
    bf16_t* P; float* scr;
    __device__ __forceinline__ void operator()(const f32x4 (&acc)[2][2][4][2], const Unit& u, int wr, int wc, int fr, int fq) const {
        const int row0 = u.pm * BM + wr * 64 + fr, col0 = u.pn * BM + wc * 32 + 8 * fq;
#pragma unroll
        for (int ai = 0; ai < 2; ++ai)
#pragma unroll
            for (int m = 0; m < 4; ++m) { const size_t r = (size_t)(row0 + ai * HALF + m * 16);
#pragma unroll
                for (int bj = 0; bj < 2; ++bj) { const int c = col0 + bj * HALF;
                    const u32x4 gw = *(const u32x4*)(P + r * 12544 + 9216 + BR * 1024 + c);
                    float g[8];
#pragma unroll
                    for (int i = 0; i < 4; ++i) { g[2 * i] = __uint_as_float(gw[i] << 16); g[2 * i + 1] = __uint_as_float(gw[i] & 0xffff0000u); }
                    f32x4 v0 = acc[ai][bj][m][0], v1 = acc[ai][bj][m][1];
#pragma unroll
                    for (int i = 0; i < 4; ++i) { v0[i] *= 1.f / (1.f + __expf(-g[i])); v1[i] *= 1.f / (1.f + __expf(-g[4 + i])); }
                    float* sp = scr + r * 1024 + c;
                    if (BR > 0) { v0 += *(const f32x4*)sp; v1 += *(const f32x4*)(sp + 4); }
                    if (BR < 2) { *(f32x4*)sp = v0; *(f32x4*)(sp + 4) = v1; }
                    else { u32x4 w; w.x = cvt_pk_bf16(v0[0], v0[1]); w.y = cvt_pk_bf16(v0[2], v0[3]); w.z = cvt_pk_bf16(v1[0], v1[1]); w.w = cvt_pk_bf16(v1[2], v1[3]);
                        *(u32x4*)(P + r * 12544 + 2048 + c) = w; } } }
    }
};
template <int BR, bool FINAL> struct EpiMerge2 {
    static constexpr bool PERM = true, AFTER_DRAIN = false;
    bf16_t* P; bf16_t* s0; int ld0; const bf16_t* s1; int ld1; bf16_t* mrg; int ldm;
    __device__ __forceinline__ void operator()(const f32x4 (&acc)[2][2][4][2], const Unit& u, int wr, int wc, int fr, int fq) const {
        const int row0 = u.pm * BM + wr * 64 + fr, col0 = u.pn * BM + wc * 32 + 8 * fq;
#pragma unroll
        for (int ai = 0; ai < 2; ++ai) {
            unsigned gb = (unsigned)((row0 + ai * HALF) * 12544 + 9216 + BR * 1024 + col0); asm volatile("" : "+v"(gb));
            unsigned b0 = (unsigned)((row0 + ai * HALF) * ld0 + col0); asm volatile("" : "+v"(b0));
            u32x4 gw[4][2];
#pragma unroll
            for (int m = 0; m < 4; ++m)
#pragma unroll
                for (int bj = 0; bj < 2; ++bj) gw[m][bj] = *(const u32x4*)(P + (gb + (unsigned)(m * 16 * 12544 + bj * HALF)));
            f32x4 v[4][2][2];
#pragma unroll
            for (int m = 0; m < 4; ++m)
#pragma unroll
                for (int bj = 0; bj < 2; ++bj) { const u32x4 g4 = gw[m][bj]; f32x4 v0 = acc[ai][bj][m][0], v1 = acc[ai][bj][m][1];
#pragma unroll
                    for (int i = 0; i < 2; ++i) { v0[2 * i] *= __builtin_amdgcn_rcpf(1.f + __expf(-__uint_as_float(g4[i] << 16))); v0[2 * i + 1] *= __builtin_amdgcn_rcpf(1.f + __expf(-__uint_as_float(g4[i] & 0xffff0000u)));
                        v1[2 * i] *= __builtin_amdgcn_rcpf(1.f + __expf(-__uint_as_float(g4[2 + i] << 16))); v1[2 * i + 1] *= __builtin_amdgcn_rcpf(1.f + __expf(-__uint_as_float(g4[2 + i] & 0xffff0000u))); }
                    v[m][bj][0] = v0; v[m][bj][1] = v1; }
            if (!FINAL) {
#pragma unroll
                for (int m = 0; m < 4; ++m)
#pragma unroll
                    for (int bj = 0; bj < 2; ++bj) { const f32x4 v0 = v[m][bj][0], v1 = v[m][bj][1]; u32x4 w; w.x = cvt_pk_bf16(v0[0], v0[1]); w.y = cvt_pk_bf16(v0[2], v0[3]); w.z = cvt_pk_bf16(v1[0], v1[1]); w.w = cvt_pk_bf16(v1[2], v1[3]);
                        *(u32x4*)(s0 + (b0 + (unsigned)(m * 16) * (unsigned)ld0 + (unsigned)(bj * HALF))) = w; }
            } else {
                asm volatile("" ::: "memory");
                unsigned b1 = (unsigned)((row0 + ai * HALF) * ld1 + col0); asm volatile("" : "+v"(b1));
                unsigned bm = (unsigned)((row0 + ai * HALF) * ldm + col0); asm volatile("" : "+v"(bm));
#pragma unroll
                for (int mp = 0; mp < 2; ++mp) { u32x4 a0[2][2], a1[2][2];
#pragma unroll
                    for (int mm = 0; mm < 2; ++mm)
#pragma unroll
                        for (int bj = 0; bj < 2; ++bj) { const unsigned rr = (unsigned)((2 * mp + mm) * 16);
                            a0[mm][bj] = *(const u32x4*)(s0 + (b0 + rr * (unsigned)ld0 + (unsigned)(bj * HALF))); a1[mm][bj] = *(const u32x4*)(s1 + (b1 + rr * (unsigned)ld1 + (unsigned)(bj * HALF))); }
#pragma unroll
                    for (int mm = 0; mm < 2; ++mm)
#pragma unroll
                        for (int bj = 0; bj < 2; ++bj) { const int m = 2 * mp + mm; const unsigned rr = (unsigned)(m * 16);
                            f32x4 v0 = v[m][bj][0], v1 = v[m][bj][1];
#pragma unroll
                            for (int i = 0; i < 2; ++i) { v0[2 * i] += __uint_as_float(a0[mm][bj][i] << 16) + __uint_as_float(a1[mm][bj][i] << 16); v0[2 * i + 1] += __uint_as_float(a0[mm][bj][i] & 0xffff0000u) + __uint_as_float(a1[mm][bj][i] & 0xffff0000u);
                                v1[2 * i] += __uint_as_float(a0[mm][bj][2 + i] << 16) + __uint_as_float(a1[mm][bj][2 + i] << 16); v1[2 * i + 1] += __uint_as_float(a0[mm][bj][2 + i] & 0xffff0000u) + __uint_as_float(a1[mm][bj][2 + i] & 0xffff0000u); }
                            u32x4 w; w.x = cvt_pk_bf16(v0[0], v0[1]); w.y = cvt_pk_bf16(v0[2], v0[3]); w.z = cvt_pk_bf16(v1[0], v1[1]); w.w = cvt_pk_bf16(v1[2], v1[3]);
                            *(u32x4*)(mrg + (bm + rr * (unsigned)ldm + (unsigned)(bj * HALF))) = w; }
                    asm volatile("" ::: "memory"); }
            }
            asm volatile("" ::: "memory");
        }
    }
};
struct EpiOutNorm {
    static constexpr bool PERM = false, AFTER_DRAIN = true;
    const float* xres; float* out; const float* fg; float* xbuf; unsigned* cnt;
    __device__ __forceinline__ void fused(f32x4 (&acc)[2][2][4][2], const Unit& u, int wr, int wc, int fr, int fq, PG8_LAS unsigned char* lds, int wid, int lane) const {
        PG8_LAS float* Pp = (PG8_LAS float*)lds; PG8_LAS float* Sr = (PG8_LAS float*)(lds + 4096);
        const int row0 = u.pm * BM + wr * 64 + fr, col0 = u.pn * BM + wc * 32 + 4 * fq;
#pragma unroll
        for (int ai = 0; ai < 2; ++ai)
#pragma unroll
            for (int m = 0; m < 4; ++m) { const size_t off = (size_t)(row0 + ai * HALF + m * 16) * 1024 + col0; float s = 0.f;
#pragma unroll
                for (int bj = 0; bj < 2; ++bj)
#pragma unroll
                    for (int n = 0; n < 2; ++n) { const f32x4 v = acc[ai][bj][m][n] + *(const f32x4*)(xres + off + bj * HALF + n * 16); acc[ai][bj][m][n] = v; s += (v[0] * v[0] + v[1] * v[1]) + (v[2] * v[2] + v[3] * v[3]); }
                s += __shfl_xor(s, 16); s += __shfl_xor(s, 32);
                if (fq == 0) Pp[(ai * HALF + wr * 64 + m * 16 + fr) * 4 + wc] = s;
                if (m == 3) asm volatile("" ::: "memory"); }
        asm volatile("s_waitcnt lgkmcnt(0)" ::: "memory"); __builtin_amdgcn_s_barrier(); asm volatile("" ::: "memory");
        const int tid = wid * 64 + lane;
        if (tid < 256) { const float s = (Pp[tid * 4 + 0] + Pp[tid * 4 + 1]) + (Pp[tid * 4 + 2] + Pp[tid * 4 + 3]);
            __hip_atomic_store(xbuf + (size_t)(u.pm * BM + tid) * 4 + u.pn, s, __ATOMIC_RELAXED, __HIP_MEMORY_SCOPE_AGENT); }
        asm volatile("s_waitcnt vmcnt(0)" ::: "memory");
        if (wid < 4 && lane == 0) __hip_atomic_fetch_add(cnt + 64 * u.pm, 1u, __ATOMIC_RELAXED, __HIP_MEMORY_SCOPE_AGENT);
        if (wid == 0) { unsigned spins = 0;
            while ((unsigned)__builtin_amdgcn_readfirstlane(__hip_atomic_load(cnt + 64 * u.pm, __ATOMIC_RELAXED, __HIP_MEMORY_SCOPE_AGENT)) < 16u && ++spins < (1u << 22)) __builtin_amdgcn_s_sleep(2);
            __builtin_amdgcn_fence(__ATOMIC_ACQUIRE, "agent"); }
        asm volatile("s_waitcnt vmcnt(0) lgkmcnt(0)" ::: "memory"); __builtin_amdgcn_s_barrier(); asm volatile("" ::: "memory");
        if (tid < 256) { const float* slot = xbuf + (size_t)(u.pm * BM + tid) * 4; float s = 0.f;
#pragma unroll
            for (int q = 0; q < 4; ++q) s += __hip_atomic_load(slot + q, __ATOMIC_RELAXED, __HIP_MEMORY_SCOPE_AGENT);
            Sr[tid] = 1.0f / sqrtf(s * (1.f / 1024.f) + 1e-6f); }
        asm volatile("s_waitcnt lgkmcnt(0)" ::: "memory"); __builtin_amdgcn_s_barrier(); asm volatile("" ::: "memory");
#pragma unroll
        for (int ai = 0; ai < 2; ++ai)
#pragma unroll
            for (int m = 0; m < 4; ++m) { const int r = ai * HALF + wr * 64 + m * 16 + fr; const float rs = Sr[r]; const size_t off = (size_t)(u.pm * BM + r) * 1024 + col0;
#pragma unroll
                for (int bj = 0; bj < 2; ++bj)
#pragma unroll
                    for (int n = 0; n < 2; ++n) { const f32x4 gg = *(const f32x4*)(fg + col0 + bj * HALF + n * 16); *(f32x4*)(out + off + bj * HALF + n * 16) = acc[ai][bj][m][n] * rs * gg; } }
    }
};
struct SkewOrder {
    StaticOrder base; int c;
    __device__ void init(int M, int N, int c_) { base.init(M, N, 256, 0); c = c_; }
    __device__ bool next(int i, Unit& u) const {
        int ii, cc = c;
        if (c < 128) { if (i >= 5) return false; ii = i + 1; }
        else { if (i > 6) return false; if (i == 0) ii = 0; else if (i == 1) { ii = 0; cc = c - 128; } else ii = i - 1; }
        StaticOrder b2 = base; b2.c = cc; return b2.next(ii, u);
    }
    __device__ __forceinline__ void a_ready(const Unit&) const {}
    __device__ __forceinline__ void done(const Unit&) const {}
};
}
#define PG8_SP2 true
#define PG8_ALIGN true

__device__ __forceinline__ bf16_t* merged_ptr(const Params& p, int b) { return b == 0 ? xn_ptr(p) : proj_ptr(p) + 4096; }
__device__ __forceinline__ int merged_ld(int b) { return b == 0 ? DM : LD; }
__device__ __forceinline__ void phase1_gemm(const Params& p, int b, LAS unsigned char* lds) {
    const int G = gridDim.x, c = opq_bid();
    { pg8::Gemm g{xn_ptr(p) + (size_t)b * SEQ * DM, (const bf16_t*)(wsb(p) + WS_WIN), SEQ, 12288, DM, DM, DM}; pg8::StaticOrder S; S.init(SEQ, 12288, G, c);
      pg8::EpiBf16<0> E{proj_ptr(p), LD, nullptr, 0, 0, 1.f};
      if (b == 1 && G == 256) { pg8::SkewOrder S2; S2.init(SEQ, 12288, c);
          pg8::gemm_phase<pg8::EpiBf16<0>, pg8::SkewOrder, PG8_ALIGN, PG8_SP2>(lds, g, S2, E); }
      else pg8::gemm_phase<pg8::EpiBf16<0>, pg8::StaticOrder, PG8_ALIGN, PG8_SP2>(lds, g, S, E); }
    { const int tid = opq_tid(), lane = tid & 63, wave = tid >> 6, fr = lane & 15, kg = lane >> 4;
      const bf16_t* XNb = xn_ptr(p) + (size_t)b * SEQ * DM; const bf16_t* Wd = (const bf16_t*)(wsb(p) + WS_WIN) + (size_t)C_DT * DM; bf16_t* Pq = proj_ptr(p);
      LAS float* sRed = (LAS float*)lds;
      for (int rb = c; rb < SEQ / 32; rb += G) {
          __syncthreads();
          f32x4 acc[2][2];
#pragma unroll
          for (int mt = 0; mt < 2; ++mt)
#pragma unroll
              for (int nt = 0; nt < 2; ++nt) acc[mt][nt] = (f32x4){0.f, 0.f, 0.f, 0.f};
          bf16x8 af[2][4], bfr[2][4];
#pragma unroll
          for (int ks = 0; ks < 4; ++ks)
#pragma unroll
              for (int q = 0; q < 2; ++q) { af[q][ks] = *(const bf16x8*)(XNb + (size_t)(32 * rb + 16 * q + fr) * DM + 128 * wave + 32 * ks + 8 * kg);
                  bfr[q][ks] = *(const bf16x8*)(Wd + (size_t)(16 * q + fr) * DM + 128 * wave + 32 * ks + 8 * kg); }
#pragma unroll
          for (int ks = 0; ks < 4; ++ks)
#pragma unroll
              for (int mt = 0; mt < 2; ++mt)
#pragma unroll
                  for (int nt = 0; nt < 2; ++nt) acc[mt][nt] = __builtin_amdgcn_mfma_f32_16x16x32_bf16(af[mt][ks], bfr[nt][ks], acc[mt][nt], 0, 0, 0);
#pragma unroll
          for (int mt = 0; mt < 2; ++mt)
#pragma unroll
              for (int nt = 0; nt < 2; ++nt)
#pragma unroll
                  for (int j = 0; j < 4; ++j) sRed[(wave * 32 + 16 * mt + 4 * kg + j) * 32 + 16 * nt + fr] = acc[mt][nt][j];
          __syncthreads();
#pragma unroll
          for (int q = 0; q < 2; ++q) { const int e = tid + 512 * q, row = e >> 5, col = e & 31; float s = 0.f;
#pragma unroll
              for (int w2 = 0; w2 < 8; ++w2) s += sRed[(w2 * 32 + row) * 32 + col];
              Pq[(size_t)(32 * rb + row) * LD + C_DT + col] = (bf16_t)f2bf(s); }
      } }
    if (b == 0) {
        { pg8::Gemm g{(const bf16_t*)(wsb(p) + WS_MEMN), (const bf16_t*)(wsb(p) + WS_WKV), 512, 1024, DM, DM, DM}; pg8::StaticOrder S; S.init(512, 1024, G, (c + 16) % G);
          pg8::EpiBf16<0> E{(bf16_t*)(wsb(p) + WS_KVK), 1024, nullptr, 0, 0, 1.f};
          pg8::gemm_phase<pg8::EpiBf16<0>, pg8::StaticOrder, PG8_ALIGN, PG8_SP2>(lds, g, S, E); }
        { pg8::Gemm g{(const bf16_t*)(wsb(p) + WS_WKV) + (size_t)1024 * DM, (const bf16_t*)(wsb(p) + WS_MEMN), 1024, 512, DM, DM, DM}; pg8::StaticOrder S; S.init(1024, 512, G, (c + 8) % G);
          pg8::EpiBf16<0> E{(bf16_t*)(wsb(p) + WS_KVVT), 512, nullptr, 0, 0, 1.f};
          pg8::gemm_phase<pg8::EpiBf16<0>, pg8::StaticOrder, PG8_ALIGN, PG8_SP2>(lds, g, S, E); }
    }
}
__device__ __forceinline__ void phase5_gemm(const Params& p, int b, LAS unsigned char* lds) {
    const int G = gridDim.x, c = opq_bid(); bf16_t* P = proj_ptr(p); float* scr = scr_ptr(p, b);
    bf16_t* scrB = P + 2048;
    bf16_t* scrA = (bf16_t*)scr;
    unsigned* flag = (unsigned*)(wsb(p) + WS_CTL) + 4096 + (b * 128 + (c & 127)) * 16;
    if (c < 128) {
        pg8::Gemm g{P + C_Z, (const bf16_t*)(wsb(p) + WS_WSSD), SEQ, DM, 2048, LD, 2048}; pg8::StaticOrder S; S.init(SEQ, DM, 128, c); pg8::EpiMerge2<0, false> E{P, scrA, 1024, nullptr, 0, nullptr, 0};
        pg8::gemm_phase<pg8::EpiMerge2<0, false>, pg8::StaticOrder, false, PG8_SP2>(lds, g, S, E);
#ifdef PROBE_NOFENCE
        asm volatile("s_waitcnt vmcnt(0)" ::: "memory"); __syncthreads();
        if (threadIdx.x == 0) __hip_atomic_store(flag, 1u, __ATOMIC_RELAXED, __HIP_MEMORY_SCOPE_AGENT);
#else
        asm volatile("s_waitcnt vmcnt(0)" ::: "memory"); __syncthreads();
        if (threadIdx.x == 0) { __builtin_amdgcn_fence(__ATOMIC_RELEASE, "agent"); asm volatile("s_waitcnt vmcnt(0)" ::: "memory");
            __hip_atomic_store(flag, 1u, __ATOMIC_RELAXED, __HIP_MEMORY_SCOPE_AGENT); }
#endif
        if (b == 0 && G == 256) { const int tid2 = opq_tid(); xn_rows(p, SEQ, MTOK, c * 8 + (tid2 >> 6), 128 * 8, tid2 & 63); }
    } else {
        { pg8::Gemm g{P + C_LG, (const bf16_t*)(wsb(p) + WS_WLRU), SEQ, DM, 1536, LD, 1536}; pg8::StaticOrder S; S.init(SEQ, DM, 128, c - 128); pg8::EpiMerge2<1, false> E{P, scrB, LD, nullptr, 0, nullptr, 0};
          pg8::gemm_phase<pg8::EpiMerge2<1, false>, pg8::StaticOrder, false, PG8_SP2>(lds, g, S, E); }
        if (threadIdx.x == 0) { unsigned spins = 0; while (__hip_atomic_load(flag, __ATOMIC_RELAXED, __HIP_MEMORY_SCOPE_AGENT) == 0u && ++spins < (1u << 22)) __builtin_amdgcn_s_sleep(2);
#ifndef PROBE_NOFENCE
            __builtin_amdgcn_fence(__ATOMIC_ACQUIRE, "agent"); asm volatile("s_waitcnt vmcnt(0)" ::: "memory");
#endif
        }
        __syncthreads();
        { pg8::Gemm g{P + C_Q, (const bf16_t*)(wsb(p) + WS_WMEM), SEQ, DM, 1024, LD, 1024}; pg8::StaticOrder S; S.init(SEQ, DM, 128, c - 128); pg8::EpiMerge2<2, true> E{P, scrB, LD, scrA, 1024, merged_ptr(p, b), merged_ld(b)};
          pg8::gemm_phase<pg8::EpiMerge2<2, true>, pg8::StaticOrder, false, PG8_SP2>(lds, g, S, E); }
    }
}
__device__ __forceinline__ void phase6_gemm(const Params& p, int b, LAS unsigned char* lds) {
    const int G = gridDim.x, c = opq_bid(); bf16_t* P = proj_ptr(p);
    pg8::Gemm g{merged_ptr(p, b), (const bf16_t*)(wsb(p) + WS_WOUT), SEQ, DM, DM, merged_ld(b), DM}; pg8::StaticOrder S; S.init(SEQ, DM, G, c);
    pg8::EpiOutNorm E{opq(p.x) + (size_t)b * SEQ * DM, opq(p.out) + (size_t)b * SEQ * DM, opq(p.final_g), (float*)(wsb(p) + WS_XBUF) + (size_t)b * SEQ * 4, (unsigned*)(wsb(p) + WS_CTL) + 8192 + b * 2048};
    pg8::gemm_phase<pg8::EpiOutNorm, pg8::StaticOrder, false, PG8_SP2>(lds, g, S, E);
}
#define MFMA16(a, b, c) __builtin_amdgcn_mfma_f32_16x16x32_bf16((a), (b), (c), 0, 0, 0)
__device__ __forceinline__ bf16x8 pack8(const float (&v)[8]) {
    u32x4 w; w.x = pk2(v[0], v[1]); w.y = pk2(v[2], v[3]); w.z = pk2(v[4], v[5]); w.w = pk2(v[6], v[7]); return __builtin_bit_cast(bf16x8, w);
}
__device__ __forceinline__ void unpack8(u32x4 w, float (&v)[8]) {
#pragma unroll
    for (int i = 0; i < 4; ++i) { v[2 * i] = __uint_as_float(w[i] << 16); v[2 * i + 1] = __uint_as_float(w[i] & 0xffff0000u); }
}
__device__ __forceinline__ void attn_phase(const Params& p, int b, LAS unsigned char* lds, int dry = 0) {
    const int tid = opq_tid(), lane = tid & 63, wave = tid >> 6, fr = lane & 15, kg = lane >> 4;
    bf16_t* P = proj_ptr(p); const bf16_t* KK = (const bf16_t*)(wsb(p) + WS_KVK) + (size_t)b * 256 * 1024; const bf16_t* VT = (const bf16_t*)(wsb(p) + WS_KVVT) + b * 256;
    LAS bf16_t* sKV = (LAS bf16_t*)lds;
    for (int u = opq_bid(); u < 256; u += gridDim.x) {
        const int hd = u & 3, rt = u >> 2, q0 = rt * 128 + wave * 16;
        bf16_t* qrow = P + (size_t)(q0 + fr) * LD + C_Q + hd * 256;
        __syncthreads();
        { unsigned ko = (unsigned)((tid >> 5) * 1024 + hd * 256 + 8 * (tid & 31)); asm volatile("" : "+v"(ko));
          u32x4 st[16];
#pragma unroll
          for (int i = 0; i < 16; ++i) st[i] = *(const u32x4*)(KK + (ko + (unsigned)(i * 16 * 1024)));
#pragma unroll
          for (int i = 0; i < 16; ++i) *(LAS u32x4*)(sKV + ((tid >> 5) + 16 * i) * 264 + 8 * (tid & 31)) = st[i]; }
        bf16x8 qf[8];
#pragma unroll
        for (int s = 0; s < 8; ++s) qf[s] = *(const bf16x8*)(qrow + 32 * s + 8 * kg);
        __syncthreads();
        u32x4 vst[16];
        { unsigned vo = (unsigned)((hd * 256 + (tid >> 5)) * 512 + 8 * (tid & 31)); asm volatile("" : "+v"(vo));
#pragma unroll
          for (int i = 0; i < 16; ++i) vst[i] = *(const u32x4*)(VT + (vo + (unsigned)(i * 16 * 512))); }
        f32x4 sacc[16];
#pragma unroll
        for (int mt = 0; mt < 16; ++mt) { sacc[mt] = (f32x4){0.f, 0.f, 0.f, 0.f};
#pragma unroll
            for (int s = 0; s < 8; ++s) { const bf16x8 kf = *(const LAS bf16x8*)(sKV + (16 * mt + fr) * 264 + 32 * s + 8 * kg); sacc[mt] = MFMA16(kf, qf[s], sacc[mt]); } }
        float mx = -INFINITY;
#pragma unroll
        for (int mt = 0; mt < 16; ++mt)
#pragma unroll
            for (int j = 0; j < 4; ++j) mx = fmaxf(mx, sacc[mt][j]);
        mx = fmaxf(mx, __shfl_xor(mx, 16)); mx = fmaxf(mx, __shfl_xor(mx, 32));
        float sum = 0.f;
#pragma unroll
        for (int mt = 0; mt < 16; ++mt)
#pragma unroll
            for (int j = 0; j < 4; ++j) { const float e = __expf((sacc[mt][j] - mx) * 0.0625f); sacc[mt][j] = e; sum += e; }
        sum += __shfl_xor(sum, 16); sum += __shfl_xor(sum, 32);
        const float inv = 1.f / sum;
        bf16x8 pf[8];
#pragma unroll
        for (int s2 = 0; s2 < 8; ++s2) { u32x4 w; w.x = pk2(sacc[2 * s2][0], sacc[2 * s2][1]); w.y = pk2(sacc[2 * s2][2], sacc[2 * s2][3]);
            w.z = pk2(sacc[2 * s2 + 1][0], sacc[2 * s2 + 1][1]); w.w = pk2(sacc[2 * s2 + 1][2], sacc[2 * s2 + 1][3]); pf[s2] = __builtin_bit_cast(bf16x8, w); }
        __syncthreads();
#pragma unroll
        for (int i = 0; i < 16; ++i) *(LAS u32x4*)(sKV + ((tid >> 5) + 16 * i) * 264 + 8 * (tid & 31)) = vst[i];
        __syncthreads();
#pragma unroll 4
        for (int mt2 = 0; mt2 < 16; ++mt2) { f32x4 o = (f32x4){0.f, 0.f, 0.f, 0.f}; const LAS bf16_t* vr = sKV + (16 * mt2 + fr) * 264 + 4 * kg;
#pragma unroll
            for (int s2 = 0; s2 < 8; ++s2) { const u32x2 lo = *(const LAS u32x2*)(vr + 32 * s2), hi = *(const LAS u32x2*)(vr + 32 * s2 + 16);
                u32x4 w; w.x = lo.x; w.y = lo.y; w.z = hi.x; w.w = hi.y; o = MFMA16(__builtin_bit_cast(bf16x8, w), pf[s2], o); }
            u32x2 ow; ow.x = pk2(o[0] * inv, o[1] * inv); ow.y = pk2(o[2] * inv, o[3] * inv);
            if (!dry) *(u32x2*)(qrow + 16 * mt2 + 4 * kg) = ow; }
    }
}
template <bool FINAL> __device__ __forceinline__ void lru_phase(const Params& p, int b, LAS unsigned char* lds, int dry = 0) {
    const int tid = opq_tid(), lane = tid & 63, wave = tid >> 6, fr = lane & 15, kg = lane >> 4;
    bf16_t* P = proj_ptr(p);
    LAS bf16_t* sWA = (LAS bf16_t*)lds; LAS bf16_t* sWX = (LAS bf16_t*)(lds + 19968);
    LAS float* sCW = (LAS float*)(lds + 39936); LAS float* sCB = sCW + 384; LAS float* sBA = sCB + 96; LAS float* sBX = sBA + 96; LAS float* sSP = sBX + 96;
    LAS float* sXL = (LAS float*)(lds + 43008) + wave * 1600;
    LAS float* sAG = (LAS float*)(lds + 94208);
    float* agg = (float*)(wsb(p) + WS_LAGG) + (size_t)b * NBLK64 * LRUW * 2;
    const float* car = (const float*)(wsb(p) + WS_LCAR) + (size_t)b * NBLK64 * LRUW;
    const float* lcw = opq(p.lru_conv_w); const float* lcb = opq(p.lru_conv_b); const float* lba = opq(p.lru_b_a); const float* lbx = opq(p.lru_b_x); const float* lam = opq(p.lru_lambda);
    for (int u = opq_bid(); u < NLB * NSEG; u += gridDim.x) {
        const int n = u % NLB, sg = u / NLB;
        __syncthreads();
        { const bf16_t* gwa = (const bf16_t*)(wsb(p) + WS_LRUWA) + n * 9216; const bf16_t* gwx = (const bf16_t*)(wsb(p) + WS_LRUWX) + n * 9216;
          u32x4 wa3[3], wx3[3]; float cwv = 0.f, v4[4] = {0.f, 0.f, 0.f, 0.f};
#pragma unroll
          for (int i = 0; i < 3; ++i) { const int e = tid + 512 * i; if (e < 96 * 12) { const int j = e / 12, c8 = e % 12; wa3[i] = *(const u32x4*)(gwa + j * 96 + 8 * c8); wx3[i] = *(const u32x4*)(gwx + j * 96 + 8 * c8); } }
          if (tid < 384) cwv = lcw[(tid / 96) * 1536 + n * 96 + tid % 96];
          if (tid < 96) { v4[0] = lcb[n * 96 + tid]; v4[1] = lba[n * 96 + tid]; v4[2] = lbx[n * 96 + tid]; v4[3] = lam[n * 96 + tid]; }
#pragma unroll
          for (int i = 0; i < 3; ++i) { const int e = tid + 512 * i; if (e < 96 * 12) { const int j = e / 12, c8 = e % 12; *(LAS u32x4*)(sWA + j * 104 + 8 * c8) = wa3[i]; *(LAS u32x4*)(sWX + j * 104 + 8 * c8) = wx3[i]; } }
          if (tid < 384) sCW[tid] = cwv;
          if (tid < 96) { sCB[tid] = v4[0]; sBA[tid] = v4[1]; sBX[tid] = v4[2]; sSP[tid] = softplusf_(-v4[3]); } }
        __syncthreads();
        float runA[6], runH[6];
#pragma unroll
        for (int nt = 0; nt < 6; ++nt) { runA[nt] = 1.f; runH[nt] = FINAL ? car[(sg * 8 + wave) * LRUW + n * 96 + 16 * nt + fr] : 0.f; }
        for (int step = 0; step < 4; ++step) {
            const int tb = sg * LSEG + wave * 64 + step * 16;
            u32x4 rawC[3][4];
            { const int t0r = tb + fr - 3; unsigned ro = (unsigned)((t0r < 0 ? 0 : t0r) * LD + C_LX + n * 96 + 8 * kg); asm volatile("" : "+v"(ro));
              if (t0r >= 0) {
#pragma unroll
                  for (int ks = 0; ks < 3; ++ks)
#pragma unroll
                      for (int k = 0; k < 4; ++k) rawC[ks][k] = *(const u32x4*)(P + (ro + (unsigned)(k * LD + 32 * ks)));
              } else {
#pragma unroll
                  for (int ks = 0; ks < 3; ++ks)
#pragma unroll
                      for (int k = 0; k < 4; ++k) { const int t = t0r + k; rawC[ks][k] = *(const u32x4*)(P + (ro + (unsigned)((t < 0 ? 0 : t) * LD + 32 * ks))); if (t < 0) rawC[ks][k] = (u32x4){0u, 0u, 0u, 0u}; }
              } }
            bf16x8 af[3];
#pragma unroll
            for (int ks = 0; ks < 3; ++ks) { const int ch0 = 32 * ks + 8 * kg; float xl[8];
#pragma unroll
                for (int i = 0; i < 8; ++i) xl[i] = sCB[ch0 + i];
#pragma unroll
                for (int k = 0; k < 4; ++k) { const u32x4 raw = rawC[ks][k];
                    float rv[8]; unpack8(raw, rv);
#pragma unroll
                    for (int i = 0; i < 8; ++i) xl[i] += sCW[k * 96 + ch0 + i] * rv[i]; }
                *(LAS f32x4*)(sXL + fr * 100 + ch0) = (f32x4){xl[0], xl[1], xl[2], xl[3]}; *(LAS f32x4*)(sXL + fr * 100 + ch0 + 4) = (f32x4){xl[4], xl[5], xl[6], xl[7]};
                af[ks] = pack8(xl); }
            LAS bf16_t* sG = (LAS bf16_t*)((LAS unsigned char*)sWA + 106496) + wave * 1536;
            unsigned go3[3]; u32x4 graw[3];
            if (FINAL) {
#pragma unroll
                for (int i = 0; i < 3; ++i) { const int e = lane + 64 * i, row = e / 12, c12 = e % 12; go3[i] = (unsigned)((tb + row) * LD + C_LG + n * 96 + 8 * c12); }
                asm volatile("" : "+v"(go3[0]), "+v"(go3[1]), "+v"(go3[2]));
#pragma unroll
                for (int i = 0; i < 3; ++i) graw[i] = *(const u32x4*)(P + go3[i]); }
            f32x4 aR[6], aI[6];
#pragma unroll
            for (int nt = 0; nt < 6; ++nt) { aR[nt] = (f32x4){0.f, 0.f, 0.f, 0.f}; aI[nt] = (f32x4){0.f, 0.f, 0.f, 0.f};
#pragma unroll
                for (int ks = 0; ks < 3; ++ks) { const bf16x8 wa = *(const LAS bf16x8*)(sWA + (16 * nt + fr) * 104 + 32 * ks + 8 * kg), wx = *(const LAS bf16x8*)(sWX + (16 * nt + fr) * 104 + 32 * ks + 8 * kg);
                    aR[nt] = MFMA16(af[ks], wa, aR[nt]); aI[nt] = MFMA16(af[ks], wx, aI[nt]); } }
            float Ainc[6][4], Hinc[6][4];
#pragma unroll
            for (int nt = 0; nt < 6; ++nt) { const int j = 16 * nt + fr; const float ba2 = -1.44269504f * sBA[j], bx2 = -1.44269504f * sBX[j], spc = -8.f * 1.44269504f * sSP[j];
                float A = 1.f, H = 0.f;
#pragma unroll
                for (int r = 0; r < 4; ++r) { const float xlv = sXL[(4 * kg + r) * 100 + j];
                    const float rr = __builtin_amdgcn_rcpf(1.f + __builtin_amdgcn_exp2f(fmaf(aR[nt][r], -1.44269504f, ba2))), ii = __builtin_amdgcn_rcpf(1.f + __builtin_amdgcn_exp2f(fmaf(aI[nt][r], -1.44269504f, bx2)));
                    const float a = __builtin_amdgcn_exp2f(rr * spc), mult = __builtin_amdgcn_sqrtf(fmaxf(0.f, fmaf(-a, a, 1.f)));
                    H = a * H + mult * ii * xlv; A *= a; Ainc[nt][r] = A; Hinc[nt][r] = H; }
                float ap = 1.f, hp = 0.f, at = 1.f, ht = 0.f;
#pragma unroll
                for (int k = 0; k < 4; ++k) { const float ab = __shfl(A, fr + 16 * k), hb = __shfl(H, fr + 16 * k);
                    if (k < kg) { hp = ab * hp + hb; ap *= ab; } ht = ab * ht + hb; at *= ab; }
                if (FINAL) { const float hin = ap * runH[nt] + hp;
#pragma unroll
                    for (int r = 0; r < 4; ++r) Hinc[nt][r] = Ainc[nt][r] * hin + Hinc[nt][r]; }
                runH[nt] = at * runH[nt] + ht; runA[nt] *= at; }
            if (FINAL) {
#pragma unroll
                for (int i = 0; i < 3; ++i) { const int e = lane + 64 * i; *(LAS u32x4*)(sG + (e / 12) * 96 + 8 * (e % 12)) = graw[i]; }
                asm volatile("s_waitcnt lgkmcnt(0)" ::: "memory");
#pragma unroll
                for (int nt = 0; nt < 6; ++nt)
#pragma unroll
                    for (int r = 0; r < 4; ++r) { LAS bf16_t* gp = sG + (4 * kg + r) * 96 + 16 * nt + fr; const float yv = Hinc[nt][r] * siluf_(bf2f(*gp)); *gp = (bf16_t)f2bf(yv); }
                asm volatile("s_waitcnt lgkmcnt(0)" ::: "memory");
#pragma unroll
                for (int i = 0; i < 3; ++i) { const int e = lane + 64 * i; const u32x4 w = *(const LAS u32x4*)(sG + (e / 12) * 96 + 8 * (e % 12)); if (!dry) *(u32x4*)(P + go3[i]) = w; }
                asm volatile("s_waitcnt lgkmcnt(0)" ::: "memory"); }
        }
        if (!FINAL && kg == 0) {
#pragma unroll
            for (int nt = 0; nt < 6; ++nt) { const int ch = n * 96 + 16 * nt + fr; agg[((size_t)(sg * 8 + wave) * LRUW + ch) * 2] = runA[nt]; agg[((size_t)(sg * 8 + wave) * LRUW + ch) * 2 + 1] = runH[nt]; } }
    }
}
__device__ __forceinline__ void lru_carry_phase(const Params& p, int b) {
    const int gt = opq_bid() * 512 + opq_tid();
    const float* agg = (const float*)(wsb(p) + WS_LAGG) + (size_t)b * NBLK64 * LRUW * 2; float* car = (float*)(wsb(p) + WS_LCAR) + (size_t)b * NBLK64 * LRUW;
    for (int ch = gt; ch < LRUW; ch += gridDim.x * 512) { float h = 0.f;
        for (int k0 = 0; k0 < NBLK64; k0 += 16) { float a[16], hh[16];
#pragma unroll
            for (int i = 0; i < 16; ++i) { a[i] = agg[((size_t)(k0 + i) * LRUW + ch) * 2]; hh[i] = agg[((size_t)(k0 + i) * LRUW + ch) * 2 + 1]; }
#pragma unroll
            for (int i = 0; i < 16; ++i) { car[(k0 + i) * LRUW + ch] = h; h = a[i] * h + hh[i]; } } }
}
__device__ __forceinline__ void conv8_silu(const bf16_t* P, int t, int col, const float* cw, const float* cb, int ch, float (&o)[8]) {
    float r[11];
    unsigned off0 = (unsigned)((t < 3 ? 0 : t - 3) * LD + col); asm volatile("" : "+v"(off0));
    if (t >= 3) {
#pragma unroll
        for (int i = 0; i < 11; ++i) r[i] = bf2f(P[off0 + (unsigned)(i * LD)]);
    } else {
#pragma unroll
        for (int i = 0; i < 11; ++i) { const int tt = t - 3 + i; const float v = bf2f(P[off0 + (unsigned)((tt < 0 ? 0 : tt) * LD)]); r[i] = tt < 0 ? 0.f : v; }
    }
    const float w0 = cw[ch], w1 = cw[3072 + ch], w2 = cw[6144 + ch], w3 = cw[9216 + ch], bb = cb[ch];
#pragma unroll
    for (int j = 0; j < 8; ++j) o[j] = siluf_(bb + w0 * r[j] + w1 * r[j + 1] + w2 * r[j + 2] + w3 * r[j + 3]);
}
__device__ __forceinline__ float ssd_dt_setup(const Params& p, const bf16_t* P, int t0, int h, int lane, LAS float* sACS, LAS float* sDT) {
    const float dtb = opq(p.ssd_dt_bias)[h], an = -__expf(opq(p.ssd_a_log)[h]);
    const float dt0 = softplusf_(bf2f(P[(size_t)(t0 + 2 * lane) * LD + C_DT + h]) + dtb), dt1 = softplusf_(bf2f(P[(size_t)(t0 + 2 * lane + 1) * LD + C_DT + h]) + dtb);
    const float dA1 = dt1 * an; float s = dt0 * an + dA1;
#pragma unroll
    for (int o = 1; o < 64; o <<= 1) { const float t = __shfl_up(s, o); if (lane >= o) s += t; }
    sACS[2 * lane] = s - dA1; sACS[2 * lane + 1] = s; sDT[2 * lane] = dt0; sDT[2 * lane + 1] = dt1;
    return __shfl(s, 63);
}
template <int R> __device__ __forceinline__ void conv_rows(const bf16_t* P, int t, int col, const float* cw, const float* cb, int ch, float (&o)[R][8]) {
    unsigned off0 = (unsigned)((t < 3 ? 0 : t - 3) * LD + col); asm volatile("" : "+v"(off0));
    u32x4 raw[R + 3];
    if (t >= 3) {
#pragma unroll
        for (int i = 0; i < R + 3; ++i) raw[i] = *(const u32x4*)(P + (off0 + (unsigned)(i * LD)));
    } else {
#pragma unroll
        for (int i = 0; i < R + 3; ++i) { const int tt = t - 3 + i; raw[i] = *(const u32x4*)(P + (off0 + (unsigned)((tt < 0 ? 0 : tt) * LD))); if (tt < 0) raw[i] = (u32x4){0u, 0u, 0u, 0u}; }
    }
    float w[4][8], bb[8];
#pragma unroll
    for (int k = 0; k < 4; ++k) { const f32x4 w0 = *(const f32x4*)(cw + k * 3072 + ch), w1 = *(const f32x4*)(cw + k * 3072 + ch + 4);
        w[k][0] = w0[0]; w[k][1] = w0[1]; w[k][2] = w0[2]; w[k][3] = w0[3]; w[k][4] = w1[0]; w[k][5] = w1[1]; w[k][6] = w1[2]; w[k][7] = w1[3]; }
    { const f32x4 b0 = *(const f32x4*)(cb + ch), b1 = *(const f32x4*)(cb + ch + 4); bb[0] = b0[0]; bb[1] = b0[1]; bb[2] = b0[2]; bb[3] = b0[3]; bb[4] = b1[0]; bb[5] = b1[1]; bb[6] = b1[2]; bb[7] = b1[3]; }
#pragma unroll
    for (int r = 0; r < R; ++r)
#pragma unroll
        for (int q = 0; q < 8; ++q) o[r][q] = bb[q];
#pragma unroll
    for (int i = 0; i < R + 3; ++i) { float v[8]; unpack8(raw[i], v);
#pragma unroll
        for (int k = 0; k < 4; ++k) { const int r = i - k; if (r >= 0 && r < R) {
#pragma unroll
                for (int q = 0; q < 8; ++q) o[r][q] += w[k][q] * v[q]; } } }
#pragma unroll
    for (int r = 0; r < R; ++r)
#pragma unroll
        for (int q = 0; q < 8; ++q) o[r][q] = siluf_(o[r][q]);
}
__device__ __forceinline__ void ssd_states_phase(const Params& p, int b, LAS unsigned char* lds) {
    const int tid = opq_tid(), lane = tid & 63, wave = tid >> 6, fr = lane & 15, kg = lane >> 4;
    const bf16_t* P = proj_ptr(p); bf16_t* ST = states_ptr(p, b); float* dasum = (float*)(wsb(p) + WS_DASUM) + b * NCHUNK * NHEAD;
    const float* cw = opq(p.ssd_conv_w); const float* cb = opq(p.ssd_conv_b);
    LAS bf16_t* sBT = (LAS bf16_t*)lds; LAS bf16_t* sXT = (LAS bf16_t*)(lds + 34816 + wave * 8704);
    LAS float* sACS = (LAS float*)(lds + 104448) + wave * 128; LAS float* sW = (LAS float*)(lds + 108544) + wave * 128;
    for (int u = opq_bid(); u < NCHUNK * NGRP; u += gridDim.x) {
        const int c = u >> 2, g = u & 3, t0 = c * CHUNK, h = 8 * g + wave;
        __syncthreads();
        { const float tot = ssd_dt_setup(p, P, t0, h, lane, sACS, sW);
          if (lane == 0) dasum[c * NHEAD + h] = tot;
          sW[2 * lane] = sW[2 * lane] * __expf(tot - sACS[2 * lane]); sW[2 * lane + 1] = sW[2 * lane + 1] * __expf(tot - sACS[2 * lane + 1]); }
        { const int cg = tid & 15, rs = tid >> 4; float o[4][8];
          conv_rows<4>(P, t0 + 4 * rs, C_B + g * 128 + 8 * cg, cw, cb, 2048 + g * 128 + 8 * cg, o);
#pragma unroll
          for (int q = 0; q < 8; ++q) { u32x2 w; w.x = pk2(o[0][q], o[1][q]); w.y = pk2(o[2][q], o[3][q]); *(LAS u32x2*)(sBT + (8 * cg + q) * 136 + 4 * rs) = w; } }
        __syncthreads();
        for (int ph = 0; ph < 2; ++ph) {
            { const int cg = lane & 3, rs = lane >> 2; float o[8][8];
              conv_rows<8>(P, t0 + 8 * rs, C_X + h * 64 + 32 * ph + 8 * cg, cw, cb, h * 64 + 32 * ph + 8 * cg, o);
              const f32x4 w0 = *(const LAS f32x4*)(sW + 8 * rs), w1 = *(const LAS f32x4*)(sW + 8 * rs + 4);
#pragma unroll
              for (int q = 0; q < 8; ++q) { float v[8] = {o[0][q] * w0[0], o[1][q] * w0[1], o[2][q] * w0[2], o[3][q] * w0[3], o[4][q] * w1[0], o[5][q] * w1[1], o[6][q] * w1[2], o[7][q] * w1[3]};
                  *(LAS bf16x8*)(sXT + (8 * cg + q) * 136 + 8 * rs) = pack8(v); } }
            asm volatile("s_waitcnt lgkmcnt(0)" ::: "memory");
            f32x4 acc[8][2];
#pragma unroll
            for (int mt = 0; mt < 8; ++mt) { acc[mt][0] = (f32x4){0.f, 0.f, 0.f, 0.f}; acc[mt][1] = (f32x4){0.f, 0.f, 0.f, 0.f}; }
#pragma unroll
            for (int s = 0; s < 4; ++s) { const bf16x8 x0 = *(const LAS bf16x8*)(sXT + fr * 136 + 32 * s + 8 * kg), x1 = *(const LAS bf16x8*)(sXT + (16 + fr) * 136 + 32 * s + 8 * kg);
#pragma unroll
                for (int mt = 0; mt < 8; ++mt) { const bf16x8 a = *(const LAS bf16x8*)(sBT + (16 * mt + fr) * 136 + 32 * s + 8 * kg);
                    acc[mt][0] = MFMA16(a, x0, acc[mt][0]); acc[mt][1] = MFMA16(a, x1, acc[mt][1]); } }
            asm volatile("s_waitcnt lgkmcnt(0)" ::: "memory");
#pragma unroll
            for (int mt = 0; mt < 8; ++mt)
#pragma unroll
                for (int nt = 0; nt < 2; ++nt) { const int n0 = 16 * mt + 4 * kg, pp = 32 * ph + 16 * nt + fr;
                    u32x2 w; w.x = pk2(acc[mt][nt][0], acc[mt][nt][1]); w.y = pk2(acc[mt][nt][2], acc[mt][nt][3]);
                    *(u32x2*)(ST + ((size_t)(c * NHEAD + h) * 64 + pp) * 128 + n0) = w; }
        }
    }
}
__device__ __forceinline__ void ssd_scan_phase(const Params& p, int b, int dry = 0) {
    unsigned* st = (unsigned*)states_ptr(p, b); const float* dasum = (const float*)(wsb(p) + WS_DASUM) + b * NCHUNK * NHEAD;
    for (int e2 = opq_bid() * 512 + opq_tid(); e2 < 131072; e2 += gridDim.x * 512) {
        const int h = e2 >> 12; float r0 = 0.f, r1 = 0.f;
        for (int c0 = 0; c0 < NCHUNK; c0 += 16) { unsigned v[16]; float d[16];
#pragma unroll
            for (int i = 0; i < 16; ++i) { v[i] = st[(size_t)(c0 + i) * 131072 + e2]; d[i] = dasum[(c0 + i) * NHEAD + h]; }
#pragma unroll
            for (int i = 0; i < 16; ++i) { const unsigned w = pk2(r0, r1); const float dd = __expf(d[i]);
                r0 = r0 * dd + __uint_as_float(v[i] << 16); r1 = r1 * dd + __uint_as_float(v[i] & 0xffff0000u); v[i] = w; }
            if (!dry) {
#pragma unroll
                for (int i = 0; i < 16; ++i) st[(size_t)(c0 + i) * 131072 + e2] = v[i]; } }
    }
}
__device__ __forceinline__ void ssd_out_phase(const Params& p, int b, LAS unsigned char* lds, int dry = 0) {
    const int tid = opq_tid(), lane = tid & 63, wave = tid >> 6, fr = lane & 15, kg = lane >> 4;
    bf16_t* P = proj_ptr(p); const bf16_t* ST = states_ptr(p, b);
    const float* cw = opq(p.ssd_conv_w); const float* cb = opq(p.ssd_conv_b);
    LAS bf16_t* sC = (LAS bf16_t*)lds; LAS bf16_t* sCB = (LAS bf16_t*)(lds + 34816); LAS bf16_t* sB = (LAS bf16_t*)(lds + 69632); LAS bf16_t* sXT = (LAS bf16_t*)(lds + 69632 + wave * 8704);
    LAS float* sACS = (LAS float*)(lds + 139264) + wave * 128; LAS float* sDT = (LAS float*)(lds + 143360) + wave * 128; LAS float* sSSQ = (LAS float*)(lds + 147456);
    for (int u = opq_bid(); u < NCHUNK * NGRP; u += gridDim.x) {
        const int c = u >> 2, g = u & 3, t0 = c * CHUNK, h = 8 * g + wave;
        __syncthreads();
        MSTAMP(p, 0);
        (void)ssd_dt_setup(p, P, t0, h, lane, sACS, sDT);
        { const int cg = tid & 15, rs = (tid >> 4) & 15, isC = tid >> 8; float o[8][8];
          conv_rows<8>(P, t0 + 8 * rs, C_B + isC * 512 + g * 128 + 8 * cg, cw, cb, 2048 + isC * 512 + g * 128 + 8 * cg, o);
          LAS bf16_t* dst = (isC ? sC : sB) + (8 * rs) * 136 + 8 * cg;
#pragma unroll
          for (int r = 0; r < 8; ++r) *(LAS bf16x8*)(dst + r * 136) = pack8(o[r]); }
        __syncthreads();
#pragma unroll
        for (int ms = 0; ms < 8; ++ms) if (ms <= wave) { f32x4 a4 = (f32x4){0.f, 0.f, 0.f, 0.f};
#pragma unroll
            for (int kn = 0; kn < 4; ++kn) { const bf16x8 a = *(const LAS bf16x8*)(sB + (16 * ms + fr) * 136 + 32 * kn + 8 * kg), bb = *(const LAS bf16x8*)(sC + (16 * wave + fr) * 136 + 32 * kn + 8 * kg);
                a4 = MFMA16(a, bb, a4); }
            u32x2 w; w.x = pk2(a4[0], a4[1]); w.y = pk2(a4[2], a4[3]);
            *(LAS u32x2*)(sCB + (16 * wave + fr) * 136 + 16 * ms + 4 * kg) = w; }
        __syncthreads();
        MSTAMP(p, 1);
        const float Dh = opq(p.ssd_d)[h];
        const unsigned zbase0 = (unsigned)((t0 + fr) * LD + C_Z + h * 64 + 4 * kg);
        float ssq[8];
#pragma unroll
        for (int nt = 0; nt < 8; ++nt) ssq[nt] = 0.f;
        for (int ph = 0; ph < 2; ++ph) {
            unsigned zb = zbase0 + 32u * ph; asm volatile("" : "+v"(zb));
            unsigned pfo = (unsigned)(((c * NHEAD + h) * 64 + 32 * ph + fr) * 128 + 8 * kg); asm volatile("" : "+v"(pfo));
            bf16x8 pf[4][2];
#pragma unroll
            for (int sn = 0; sn < 4; ++sn) { pf[sn][0] = *(const bf16x8*)(ST + (pfo + (unsigned)(32 * sn))); pf[sn][1] = *(const bf16x8*)(ST + (pfo + (unsigned)(16 * 128 + 32 * sn))); }
            { const int cg = lane & 3, rs = lane >> 2; float o[8][8];
              conv_rows<8>(P, t0 + 8 * rs, C_X + h * 64 + 32 * ph + 8 * cg, cw, cb, h * 64 + 32 * ph + 8 * cg, o);
#pragma unroll
              for (int q = 0; q < 8; ++q) { float v[8] = {o[0][q], o[1][q], o[2][q], o[3][q], o[4][q], o[5][q], o[6][q], o[7][q]};
                  *(LAS bf16x8*)(sXT + (8 * cg + q) * 136 + 8 * rs) = pack8(v); } }
            asm volatile("s_waitcnt lgkmcnt(0)" ::: "memory");
            f32x4 acc[2][8];
#pragma unroll
            for (int nt = 0; nt < 8; ++nt) { acc[0][nt] = (f32x4){0.f, 0.f, 0.f, 0.f}; acc[1][nt] = (f32x4){0.f, 0.f, 0.f, 0.f}; }
#pragma unroll
            for (int nt = 0; nt < 8; ++nt) {
#pragma unroll
                for (int sn = 0; sn < 4; ++sn) { const bf16x8 cf = *(const LAS bf16x8*)(sC + (16 * nt + fr) * 136 + 32 * sn + 8 * kg);
                    acc[0][nt] = MFMA16(pf[sn][0], cf, acc[0][nt]); acc[1][nt] = MFMA16(pf[sn][1], cf, acc[1][nt]); }
                const float sc = __expf(sACS[16 * nt + fr]);
                acc[0][nt] *= sc; acc[1][nt] *= sc; }
#pragma unroll
            for (int sk = 0; sk < 4; ++sk) {
                const int s0 = 32 * sk + 8 * kg;
                const bf16x8 xa0 = *(const LAS bf16x8*)(sXT + fr * 136 + s0), xa1 = *(const LAS bf16x8*)(sXT + (16 + fr) * 136 + s0);
                const f32x4 as0 = *(const LAS f32x4*)(sACS + s0), as1 = *(const LAS f32x4*)(sACS + s0 + 4), d0 = *(const LAS f32x4*)(sDT + s0), d1 = *(const LAS f32x4*)(sDT + s0 + 4);
#pragma unroll
                for (int nt = 0; nt < 8; ++nt) if (nt >= 2 * sk) { const int l = 16 * nt + fr; const float acsl = sACS[l];
                    float cbv[8]; unpack8(*(const LAS u32x4*)(sCB + l * 136 + s0), cbv);
                    float m[8];
#pragma unroll
                    for (int i = 0; i < 8; ++i) { const int s = s0 + i; const float as = i < 4 ? as0[i & 3] : as1[i & 3], ds = i < 4 ? d0[i & 3] : d1[i & 3];
                        float mv = (s <= l) ? cbv[i] * __expf(acsl - as) * ds : 0.f; if (s == l) mv += Dh; m[i] = mv; }
                    const bf16x8 mb = pack8(m);
                    acc[0][nt] = MFMA16(xa0, mb, acc[0][nt]); acc[1][nt] = MFMA16(xa1, mb, acc[1][nt]);
                    asm volatile("" ::: "memory"); }
            }
            u32x2 zall[8][2];
#pragma unroll
            for (int nt = 0; nt < 8; ++nt)
#pragma unroll
                for (int mt = 0; mt < 2; ++mt) zall[nt][mt] = *(const u32x2*)(P + (zb + (unsigned)(16 * nt * LD + 16 * mt)));
#pragma unroll
            for (int nt = 0; nt < 8; ++nt)
#pragma unroll
                for (int mt = 0; mt < 2; ++mt) { u32x2* zp = (u32x2*)(P + (zb + (unsigned)(16 * nt * LD + 16 * mt)));
                    const u32x2 zw = zall[nt][mt]; float y[4];
                    y[0] = acc[mt][nt][0] * siluf_(__uint_as_float(zw.x << 16)); y[1] = acc[mt][nt][1] * siluf_(__uint_as_float(zw.x & 0xffff0000u));
                    y[2] = acc[mt][nt][2] * siluf_(__uint_as_float(zw.y << 16)); y[3] = acc[mt][nt][3] * siluf_(__uint_as_float(zw.y & 0xffff0000u));
                    ssq[nt] += (y[0] * y[0] + y[1] * y[1]) + (y[2] * y[2] + y[3] * y[3]);
                    u32x2 yw; yw.x = pk2(y[0], y[1]); yw.y = pk2(y[2], y[3]); (void)zp; *(LAS u32x2*)(sXT + (16 * nt + fr) * 32 + 16 * mt + 4 * kg) = yw; }
            asm volatile("s_waitcnt lgkmcnt(0)" ::: "memory");
            { const int rr = lane >> 2, cc = lane & 3;
              unsigned so = (unsigned)((t0 + rr) * LD + C_Z + h * 64 + 32 * ph + 8 * cc); asm volatile("" : "+v"(so));
              if (ph == 0) {
#pragma unroll
                  for (int i = 0; i < 8; ++i) { const u32x4 w = *(const LAS u32x4*)(sXT + (16 * i + rr) * 32 + 8 * cc); if (!dry) *(u32x4*)(P + (so + (unsigned)(16 * i * LD))) = w; } } }
            asm volatile("s_waitcnt lgkmcnt(0)" ::: "memory");
        }
        MSTAMP(p, 2);
#pragma unroll
        for (int nt = 0; nt < 8; ++nt) { float v = ssq[nt]; v += __shfl_xor(v, 16); v += __shfl_xor(v, 32); if (kg == 0) sSSQ[wave * 128 + 16 * nt + fr] = v; }
        __syncthreads();
        { const int rr = lane >> 2, cc = lane & 3;
          const float* ng = opq(p.ssd_norm_g) + g * 512 + wave * 64 + 8 * cc;
          f32x4 gg[2][2];
#pragma unroll
          for (int ph = 0; ph < 2; ++ph) { gg[ph][0] = *(const f32x4*)(ng + 32 * ph); gg[ph][1] = *(const f32x4*)(ng + 32 * ph + 4); }
          unsigned so = (unsigned)((t0 + rr) * LD + C_Z + h * 64 + 8 * cc); asm volatile("" : "+v"(so));
          u32x4 yv[8][2];
#pragma unroll
          for (int i = 0; i < 8; ++i)
#pragma unroll
              for (int ph = 0; ph < 2; ++ph) yv[i][ph] = ph == 0 ? *(const u32x4*)(P + (so + (unsigned)(16 * i * LD))) : *(const LAS u32x4*)(sXT + (16 * i + rr) * 32 + 8 * cc);
#pragma unroll
          for (int i = 0; i < 8; ++i) { const int l = 16 * i + rr; float tot = 0.f;
#pragma unroll
              for (int w2 = 0; w2 < 8; ++w2) tot += sSSQ[w2 * 128 + l];
              const float rs = 1.f / sqrtf(tot * (1.f / 512.f) + EPS);
#pragma unroll
              for (int ph = 0; ph < 2; ++ph) { float v[8]; unpack8(yv[i][ph], v);
                  v[0] *= rs * gg[ph][0][0]; v[1] *= rs * gg[ph][0][1]; v[2] *= rs * gg[ph][0][2]; v[3] *= rs * gg[ph][0][3];
                  v[4] *= rs * gg[ph][1][0]; v[5] *= rs * gg[ph][1][1]; v[6] *= rs * gg[ph][1][2]; v[7] *= rs * gg[ph][1][3];
                  if (!dry) *(bf16x8*)(P + (so + (unsigned)(16 * i * LD + 32 * ph))) = pack8(v); } } }
        MSTAMP(p, 3);
    }
}
#define XB_TMO      128
#define XB_XCNT(j)  (256  + 64 * (j))
#define XB_XSUB(j)  (1280 + 64 * (j))
#define XB_XGEN(j)  (2304 + 64 * (j))
#define XB_TOP      3328
#define XB_TOPGEN   3392
#define XCD_BAR_WORDS 3456
#define XB_SPIN_CAP (1u << 18)

__device__ __forceinline__ unsigned xb_ld(unsigned* p)              { return __hip_atomic_load(p, __ATOMIC_RELAXED, __HIP_MEMORY_SCOPE_AGENT); }
__device__ __forceinline__ unsigned xb_add(unsigned* p, unsigned v) { return __hip_atomic_fetch_add(p, v, __ATOMIC_RELAXED, __HIP_MEMORY_SCOPE_AGENT); }
__device__ __forceinline__ unsigned xb_xcc_id() { return (unsigned)__builtin_amdgcn_s_getreg((3 << 11) | 20) & 0xFu; }
#define XB_SPIN(cond, bar) do { unsigned _sp = 0; while (cond) { __builtin_amdgcn_s_sleep(1); \
    if ((++_sp & 255u) == 0u) { if (xb_ld(&(bar)[XB_TMO])) break; if (_sp > XB_SPIN_CAP) { atomicAdd(&(bar)[XB_TMO], 1u); break; } } } } while (0)

struct XcdBarrier {
    unsigned* bar; unsigned x;
    volatile LAS unsigned* st;
};

__device__ __forceinline__ XcdBarrier xcd_barrier_post(unsigned* bar, volatile LAS unsigned* st) {
    XcdBarrier b; b.bar = bar; b.x = xb_xcc_id(); b.st = st;
    if (threadIdx.x == 0) (void)xb_add(&bar[XB_XCNT(b.x)], 1u);
    return b;
}
__device__ __forceinline__ void xcd_barrier_complete(unsigned* bar, unsigned x, unsigned& nloc, unsigned& nx) {
    const unsigned G = gridDim.x * gridDim.y * gridDim.z;
    unsigned sum, cnt, mine, sp = 0u;
    for (;;) {
        sum = 0u; cnt = 0u; mine = 0u;
#pragma unroll
        for (unsigned j = 0; j < 16; ++j) { const unsigned c = xb_ld(&bar[XB_XCNT(j)]); sum += c; cnt += (c > 0u) ? 1u : 0u; mine = (j == x) ? c : mine; }
        if (sum == G) break;
        __builtin_amdgcn_s_sleep(1);
        if ((++sp & 255u) == 0u) { if (xb_ld(&bar[XB_TMO])) break; if (sp > XB_SPIN_CAP) { atomicAdd(&bar[XB_TMO], 1u); break; } }
    }
    nloc = mine > 0u ? mine : 1u; nx = cnt > 0u ? cnt : 1u;
}

__device__ __forceinline__ void xcd_barrier(const XcdBarrier& b) {
    asm volatile("s_waitcnt vmcnt(0)" ::: "memory");
    __syncthreads();
    if (threadIdx.x == 0) {
        unsigned* bar = b.bar; asm volatile("" : "+s"(bar));
        unsigned bx = b.x; asm volatile("" : "+s"(bx));
        __builtin_amdgcn_s_waitcnt(0);
        unsigned nloc = b.st[0], nx = b.st[1];
        if (nloc == 0u) { xcd_barrier_complete(bar, bx, nloc, nx); b.st[0] = nloc; b.st[1] = nx; }
        const unsigned old = xb_add(&bar[XB_XSUB(bx)], 1u);
        const unsigned gen = old / nloc;
        if (old + 1u == (gen + 1u) * nloc) {
            __builtin_amdgcn_fence(__ATOMIC_RELEASE, "agent");
            asm volatile("s_waitcnt vmcnt(0)" ::: "memory");
            const unsigned og = xb_add(&bar[XB_TOP], 1u);
            const unsigned tg = og / nx;
            if (og + 1u == (tg + 1u) * nx) xb_add(&bar[XB_TOPGEN], 1u);
            else XB_SPIN(xb_ld(&bar[XB_TOPGEN]) == tg, bar);
            __builtin_amdgcn_fence(__ATOMIC_ACQUIRE, "agent");
            xb_add(&bar[XB_XGEN(bx)], 1u);
            asm volatile("s_waitcnt vmcnt(0)" ::: "memory");
        } else {
            XB_SPIN(xb_ld(&bar[XB_XGEN(bx)]) == gen, bar);
            __builtin_amdgcn_fence(__ATOMIC_ACQUIRE, "agent");
            asm volatile("s_waitcnt vmcnt(0)" ::: "memory");
        }
    }
    __syncthreads();
}

#ifdef REP_COLD
#define REP_SEP() xcd_barrier(bar)
#else
#define REP_SEP() __syncthreads()
#endif
#define RUNP(n, ...) do { if ((n) > 1) { for (int r_ = nrep(n) - 1; r_ > 0; --r_) { const int dry_ = 1; (void)dry_; __VA_ARGS__; REP_SEP(); } } { const int dry_ = 0; (void)dry_; __VA_ARGS__; } } while (0)
#ifndef REP_SYNC
#define REP_SYNC 1
#endif
#ifndef REP_P0
#define REP_P0 1
#endif
#ifndef REP_P1
#define REP_P1 1
#endif
#ifndef REP_P5
#define REP_P5 1
#endif
#ifndef REP_P6
#define REP_P6 1
#endif
#ifndef REP_ST
#define REP_ST 1
#endif
#ifndef REP_LA
#define REP_LA 1
#endif
#ifndef REP_AT
#define REP_AT 1
#endif
#ifndef REP_SC
#define REP_SC 1
#endif
#ifndef REP_SO
#define REP_SO 1
#endif
#ifndef REP_LF
#define REP_LF 1
#endif
__device__ __forceinline__ int nrep(int n) { asm volatile("" : "+s"(n)); return n; }
__device__ __forceinline__ LAS unsigned char* opl(LAS unsigned char* q) { asm volatile("" : "+s"(q)); return q; }
__global__ void __launch_bounds__(512) mk(Params p) {
    extern __shared__ __attribute__((aligned(16))) unsigned char lds_raw[];
    LAS unsigned char* lds = (LAS unsigned char*)lds_raw;
    if (threadIdx.x < 4) ((volatile LAS unsigned*)(lds + LDS_BYTES - 16))[threadIdx.x] = 0u;
    __syncthreads();
    const XcdBarrier bar = xcd_barrier_post((unsigned*)(p.ws + WS_CTL), (volatile LAS unsigned*)(lds + LDS_BYTES - 16));
    if (p.hi > 1000) cg::this_grid().sync();
#ifdef PROBE_SPAN
    unsigned long long ts0 = 0, ts1 = 0;
#define STAMP(i) do { if ((i) == PROBE_SPAN) ts0 = __builtin_amdgcn_s_memrealtime(); if ((i) == PROBE_SPAN + PROBE_LEN) ts1 = __builtin_amdgcn_s_memrealtime(); } while (0)
#else
#define STAMP(i) do { } while (0)
#endif
    STAMP(0);
    RUNP(REP_P0, phase0(p, opl(lds)));
    xcd_barrier(bar); STAMP(1);
#define BATCH_PHASES(b) do { \
        RUNP(REP_P1, phase1_gemm(p, b, opl(lds))); \
        for (int r = 0; r < nrep(REP_SYNC); ++r) xcd_barrier(bar); \
        STAMP(2 + 6 * b); \
        RUNP(REP_ST, ssd_states_phase(p, b, opl(lds))); \
        __syncthreads(); STAMP(20 + 3 * b); \
        RUNP(REP_LA, lru_phase<false>(p, b, opl(lds), 0)); \
        __syncthreads(); STAMP(21 + 3 * b); \
        RUNP(REP_AT, attn_phase(p, b, opl(lds), dry_)); \
        xcd_barrier(bar); STAMP(3 + 6 * b); \
        RUNP(REP_SC, ssd_scan_phase(p, b, dry_)); \
        lru_carry_phase(p, b); \
        xcd_barrier(bar); STAMP(4 + 6 * b); \
        RUNP(REP_SO, ssd_out_phase(p, b, opl(lds), dry_)); \
        __syncthreads(); STAMP(22 + 3 * b); \
        RUNP(REP_LF, lru_phase<true>(p, b, opl(lds), dry_)); \
        xcd_barrier(bar); STAMP(5 + 6 * b); \
        RUNP(REP_P5, phase5_gemm(p, b, opl(lds))); \
        xcd_barrier(bar); STAMP(6 + 6 * b); \
        RUNP(REP_P6, phase6_gemm(p, b, opl(lds))); \
        if (b + 1 < NBATCH && gridDim.x != 256) xcd_barrier(bar);     \
        STAMP(7 + 6 * b); \
    } while (0)
    BATCH_PHASES(0);
    BATCH_PHASES(1);
#ifdef PROBE_MA
    if (blockIdx.x == 0 && threadIdx.x == 0) { const unsigned long long* tsm = (const unsigned long long*)(p.ws + 255 * MiB); const unsigned long long t2 = __builtin_amdgcn_s_memrealtime(), want = 8ull * (tsm[PROBE_MB] - tsm[PROBE_MA]);
        while (__builtin_amdgcn_s_memrealtime() - t2 < want) __builtin_amdgcn_s_sleep(16); }
#endif
#ifdef PROBE_SPAN
    if (blockIdx.x == 0 && threadIdx.x == 0) { const unsigned long long t2 = __builtin_amdgcn_s_memrealtime(), want = 8ull * (ts1 - ts0);
        while (__builtin_amdgcn_s_memrealtime() - t2 < want) __builtin_amdgcn_s_sleep(16); }
#endif
}

static void launch_mk(Params& p, int lo, int hi, int grid, hipStream_t stream) {
    p.lo = lo; p.hi = hi; void* args[] = {&p};
    (void)hipMemsetAsync(p.ws + WS_CTL, 0, 65536, stream);
    hipError_t e = hipLaunchCooperativeKernel((const void*)mk, dim3(grid), dim3(512), args, LDS_BYTES, stream);
    if (e != hipSuccess) fprintf(stderr, "cooperative launch failed: %s (grid %d)\n", hipGetErrorString(e), grid);
}
extern "C" void kernel_launch(void* const* d_in, const int* in_sizes, int n_in, void* d_out, int out_size, void* d_ws, size_t ws_size, hipStream_t stream) {
    static int grid = 0;
    if (grid == 0) {
        if (n_in != 24 || out_size != MTOK * DM || ws_size < WS_END) { fprintf(stderr, "kernel_launch: unexpected shapes (n_in %d out %d ws %zu)\n", n_in, out_size, ws_size); grid = -1; return; }
        int dev = 0, cus = 0, per_cu = 0;
        hipGetDevice(&dev); hipDeviceGetAttribute(&cus, hipDeviceAttributeMultiprocessorCount, dev);
        hipFuncSetAttribute((const void*)mk, hipFuncAttributeMaxDynamicSharedMemorySize, LDS_BYTES);
        hipOccupancyMaxActiveBlocksPerMultiprocessor(&per_cu, (const void*)mk, 512, LDS_BYTES);
        if (per_cu < 1) { fprintf(stderr, "kernel_launch: occupancy query says %d blocks/CU\n", per_cu); per_cu = 1; }
        grid = cus * 1;
        (void)hipGetLastError();
    }
    if (grid < 0) return;
    Params p{};
    const float** f = (const float**)&p;
    for (int i = 0; i < 24; ++i) f[i] = (const float*)d_in[i];
    p.out = (float*)d_out; p.ws = (unsigned char*)d_ws;
    launch_mk(p, 0, 14, grid, stream);
}
```

```cpp
#define NAIVE_GEMM 0
#define NAIVE_ATT 0
#define NAIVE_LRU 0
#define NAIVE_SSD 0
#define ONE_LAUNCH 1

#include <hip/hip_runtime.h>
#include <hip/hip_cooperative_groups.h>
#include <cstdio>
#include <cstdint>
namespace cg = cooperative_groups;

#ifndef NAIVE_GEMM
#define NAIVE_GEMM 1
#endif
#ifndef NAIVE_SSD
#define NAIVE_SSD 1
#endif
#ifndef NAIVE_LRU
#define NAIVE_LRU 1
#endif
#ifndef NAIVE_ATT
#define NAIVE_ATT 1
#endif
#ifndef ONE_LAUNCH
#define ONE_LAUNCH 0
#endif

namespace pg8 {
#define PG8_LAS __attribute__((address_space(3)))
typedef unsigned short bf16_t;
typedef short bf16x8 __attribute__((ext_vector_type(8)));
typedef float f32x4 __attribute__((ext_vector_type(4)));
typedef unsigned u32x4 __attribute__((ext_vector_type(4)));
constexpr int BM = 256, BK = 64, HALF = 128, HTB = HALF * BK * 2  , STAGE_BYTES = 8 * HTB, NXCD = 8, WGM = 8;

__host__ __device__ __forceinline__ int lds_byte(int r, int c) { const int st = (r >> 4) * 2 + (c >> 5), rr = r & 15, cc = c & 31, ob = rr * 64 + cc * 2; return st * 1024 + (ob ^ (((ob >> 9) & 1) << 5)); }
__host__ __device__ __forceinline__ void stage_rc(int b, int& R, int& C) { const int st = b / 1024, sb = b % 1024, swz = sb ^ (((sb >> 9) & 1) << 5); R = (st >> 1) * 16 + swz / 64; C = (st & 1) * 32 + (swz % 64) / 2; }
__host__ __device__ __forceinline__ int perm32(int rho) { const int n = rho >> 4, i = rho & 15; return 8 * (i >> 2) + 4 * n + (i & 3); }

struct Unit { int pm, pn; };
struct Gemm { const bf16_t* A; const bf16_t* Bt; int M, N, K, lda, ldb; };

struct StaticOrder {
    int nM, nN, nwg, G, c;
    __host__ __device__ void init(int M, int N, int G_, int c_) { nM = M / BM; nN = N / BM; nwg = nM * nN; G = G_; c = c_; }
    __host__ __device__ bool next(int i, Unit& u) const {
        const long L = (long)i * G + c; if (L >= nwg) return false;
        int wgid = (int)L; { const int q = nwg / NXCD, r = nwg % NXCD, xcd = wgid % NXCD, off = wgid / NXCD; wgid = (xcd < r ? xcd * (q + 1) : r * (q + 1) + (xcd - r) * q) + off; }
        const int nig = WGM * nN, gid = wgid / nig, fm = gid * WGM, gsz = (nM - fm) < WGM ? (nM - fm) : WGM;
        u.pm = fm + ((wgid % nig) % gsz); u.pn = (wgid % nig) / gsz; return true;
    }
    __device__ __forceinline__ void a_ready(const Unit&) const {}
    __device__ __forceinline__ void done(const Unit&) const {}
};

__device__ __forceinline__ unsigned cvt_pk_bf16(float lo, float hi) { unsigned r; asm volatile("v_cvt_pk_bf16_f32 %0, %1, %2" : "=v"(r) : "v"(lo), "v"(hi)); return r; }
typedef float f32x2 __attribute__((ext_vector_type(2)));
__device__ __forceinline__ f32x2 gelu_pk(f32x2 v) {
    const f32x2 av = __builtin_elementwise_abs(v), d = av * 0.2316418882f + 1.0f;
    f32x2 t; t.x = __builtin_amdgcn_rcpf(d.x); t.y = __builtin_amdgcn_rcpf(d.y);
    f32x2 q = t * 0.5307027145f + (-0.7265760135f); q = q * t + 0.7107068705f; q = q * t + (-0.142248368f); q = q * t + 0.127414796f; q = q * t;
    const f32x2 s = (v * v) * (-0.72134752044f);
    f32x2 e; e.x = __builtin_amdgcn_exp2f(s.x); e.y = __builtin_amdgcn_exp2f(s.y);
    const f32x2 m = v * (q * e), r = v - m;
    f32x2 o; o.x = v.x < 0.f ? m.x : r.x; o.y = v.y < 0.f ? m.y : r.y; return o;
}

template <int ACT  > struct EpiBf16 {
    static constexpr bool PERM = true, AFTER_DRAIN = false; static_assert(ACT == 0 || ACT == 1, "EpiBf16: ACT is 0 (none) or 1 (gelu_pk)");
    bf16_t* O; int ldc; const float* bias; int split_cols; size_t split_stride; float scale0;
    __device__ __forceinline__ void operator()(const f32x4 (&acc)[2][2][4][2], const Unit& u, int wr, int wc, int fr, int fq) const {
        const int row0 = u.pm * BM + wr * 64 + fr; int colt = u.pn * BM; bf16_t* base = O;
        float sc = 1.f; if (split_cols) { const int t = colt / split_cols; base += (size_t)t * split_stride; colt -= t * split_cols; if (t == 0) sc = scale0; }
        const int col0 = colt + wc * 32 + 8 * fq, bcol0 = u.pn * BM + wc * 32 + 8 * fq;
        f32x4 bv[2][2];
#pragma unroll
        for (int bj = 0; bj < 2; ++bj)
#pragma unroll
            for (int n = 0; n < 2; ++n) bv[bj][n] = bias ? *(const f32x4*)(bias + bcol0 + bj * HALF + 4 * n) : (f32x4){0.f, 0.f, 0.f, 0.f};
#pragma unroll
        for (int ai = 0; ai < 2; ++ai)
#pragma unroll
            for (int m = 0; m < 4; ++m) { bf16_t* rowp = base + (size_t)(row0 + ai * HALF + m * 16) * ldc + col0;
#pragma unroll
                for (int bj = 0; bj < 2; ++bj) { f32x4 v0 = acc[ai][bj][m][0] + bv[bj][0], v1 = acc[ai][bj][m][1] + bv[bj][1];
                    if (ACT == 1) { f32x2 a = gelu_pk((f32x2){v0[0], v0[1]}), b = gelu_pk((f32x2){v0[2], v0[3]}), c = gelu_pk((f32x2){v1[0], v1[1]}), d = gelu_pk((f32x2){v1[2], v1[3]});
                        v0 = (f32x4){a.x, a.y, b.x, b.y}; v1 = (f32x4){c.x, c.y, d.x, d.y}; }
                    v0 = v0 * sc; v1 = v1 * sc; u32x4 w; w.x = cvt_pk_bf16(v0[0], v0[1]); w.y = cvt_pk_bf16(v0[2], v0[3]); w.z = cvt_pk_bf16(v1[0], v1[1]); w.w = cvt_pk_bf16(v1[2], v1[3]);
                    *(u32x4*)(rowp + bj * HALF) = w; } }
    }
};
template <class Epi, class Sched, bool ALIGN_EPI = false, bool SP2 = false>
__device__ __forceinline__ void gemm_phase(PG8_LAS unsigned char* lds, const Gemm g, const Sched& S, const Epi& E) {
    int tid_ = threadIdx.x; asm volatile("" : "+v"(tid_));
    const int tid = tid_, wid = __builtin_amdgcn_readfirstlane(tid >> 6), lane = tid & 63, wr = wid >> 2, wc = wid & 3, fr = lane & 15, fq = lane >> 4;
    const int K = g.K, nt = K / BK;
    unsigned voffA[2], voffB[2];
#pragma unroll
    for (int i = 0; i < 2; ++i) { int R, C; stage_rc(tid * 16 + i * 8192, R, C); const int Rb = Epi::PERM ? ((R & ~31) + perm32(R & 31)) : R;
        voffA[i] = (unsigned)(R * g.lda + C) * 2u; voffB[i] = (unsigned)(Rb * g.ldb + C) * 2u; }
    const size_t kstep = (size_t)(BK * 2);
    const size_t hstepA = (size_t)HALF * g.lda * 2, hstepB = (size_t)HALF * g.ldb * 2;
    const size_t tstepA = 2 * hstepA, tstepB = 2 * hstepB;
    const unsigned ldsw = (unsigned)wid * 1024u;
    const int aoff = lds_byte(wr * 64 + fr, fq * 8), boff = lds_byte(wc * 32 + fr, fq * 8);
#define PG8_SA(b, h) (((b) * 2 + (h)) * HTB)
#define PG8_SB(b, h) ((4 + (b) * 2 + (h)) * HTB)
#define PG8_STAGE(bufoff, gbase, voff) do { _Pragma("unroll") for (int _i = 0; _i < 2; ++_i) \
        __builtin_amdgcn_global_load_lds((const unsigned*)((const char*)(gbase) + (voff)[_i]), (PG8_LAS unsigned*)(lds + (bufoff) + ldsw + _i * 8192), 16, 0, 0); } while (0)
#define PG8_LDA(dst, b, h) do { _Pragma("unroll") for (int m = 0; m < 4; ++m) _Pragma("unroll") for (int k = 0; k < 2; ++k) dst[m][k] = *(const PG8_LAS bf16x8*)(lds + PG8_SA(b, h) + aoff + m * 2048 + k * 1024); } while (0)
#define PG8_LDB(dst, b, h) do { _Pragma("unroll") for (int n = 0; n < 2; ++n) _Pragma("unroll") for (int k = 0; k < 2; ++k) dst[n][k] = *(const PG8_LAS bf16x8*)(lds + PG8_SB(b, h) + boff + n * 2048 + k * 1024); } while (0)
#define PG8_MMA(ai, bj, At, Bt) do { __builtin_amdgcn_s_setprio(1); _Pragma("unroll") for (int m = 0; m < 4; ++m) _Pragma("unroll") for (int n = 0; n < 2; ++n) _Pragma("unroll") for (int k = 0; k < 2; ++k) \
        acc[ai][bj][m][n] = __builtin_amdgcn_mfma_f32_16x16x32_bf16(Bt[n][k], At[m][k], acc[ai][bj][m][n], 0, 0, 0); __builtin_amdgcn_s_setprio(0); } while (0)
#define PG8_WAIT_V(n) asm volatile("s_waitcnt vmcnt(" #n ")" ::: "memory")
#define PG8_WAIT_L(n) asm volatile("s_waitcnt lgkmcnt(" #n ")" ::: "memory")
#define PG8_BAR __builtin_amdgcn_s_barrier()
#define PG8_SCHED __builtin_amdgcn_sched_barrier(0)
    Unit cur, nxt; int ui = 0;
    if (!S.next(0, cur)) return;
    f32x4 acc[2][2][4][2];
#pragma unroll
    for (int a = 0; a < 2; ++a)
#pragma unroll
        for (int b = 0; b < 2; ++b)
#pragma unroll
            for (int m = 0; m < 4; ++m)
#pragma unroll
                for (int n = 0; n < 2; ++n) acc[a][b][m][n] = (f32x4){0.f, 0.f, 0.f, 0.f};
    bf16x8 At[4][2], B0[2][2], B1[2][2];
    const char* cA = (const char*)g.A + (size_t)cur.pm * tstepA; const char* cB = (const char*)g.Bt + (size_t)cur.pn * tstepB;
    S.a_ready(cur);
    if constexpr (SP2) {
        PG8_STAGE(PG8_SB(0, 0), cB, voffB); PG8_STAGE(PG8_SB(0, 1), cB + hstepB, voffB); PG8_STAGE(PG8_SA(0, 0), cA, voffA); PG8_STAGE(PG8_SA(0, 1), cA + hstepA, voffA);
        if (wr == 1) PG8_BAR;
        PG8_WAIT_V(2); PG8_BAR;
        PG8_STAGE(PG8_SB(1, 0), cB + kstep, voffB); PG8_STAGE(PG8_SA(1, 0), cA + kstep, voffA); PG8_STAGE(PG8_SB(1, 1), cB + hstepB + kstep, voffB);
        PG8_WAIT_V(6); PG8_BAR;
    } else {
        PG8_STAGE(PG8_SB(0, 0), cB, voffB); PG8_STAGE(PG8_SA(0, 0), cA, voffA); PG8_STAGE(PG8_SB(0, 1), cB + hstepB, voffB); PG8_STAGE(PG8_SA(0, 1), cA + hstepA, voffA);
        if (wr == 1) PG8_BAR;
        PG8_WAIT_V(4); PG8_BAR;
        PG8_STAGE(PG8_SB(1, 0), cB + kstep, voffB); PG8_STAGE(PG8_SA(1, 0), cA + kstep, voffA); PG8_STAGE(PG8_SB(1, 1), cB + hstepB + kstep, voffB);
        PG8_WAIT_V(6); PG8_BAR;
    }
    for (;;) {
        const bool has_next = S.next(ui + 1, nxt);
        const char* nA = has_next ? (const char*)g.A + (size_t)nxt.pm * tstepA : cA; const char* nB = has_next ? (const char*)g.Bt + (size_t)nxt.pn * tstepB : cB;
        for (int t = 0; t < nt; t += 2) {
            const bool last = (t == nt - 2);
            const char* a1 = cA + (size_t)(t + 1) * kstep;
            const char* a2 = last ? nA : cA + (size_t)(t + 2) * kstep; const char* b2 = last ? nB : cB + (size_t)(t + 2) * kstep;
            const char* a3 = a2 + kstep; const char* b3 = b2 + kstep;
            if (last && has_next) S.a_ready(nxt);
            if constexpr (SP2) {
            PG8_LDB(B0, 0, 0); PG8_LDB(B1, 0, 1); PG8_SCHED; PG8_LDA(At, 0, 0); PG8_STAGE(PG8_SA(1, 1), a1 + hstepA, voffA);
            PG8_WAIT_V(8); PG8_WAIT_L(0); PG8_BAR; PG8_MMA(0, 0, At, B0); PG8_MMA(0, 1, At, B1); PG8_BAR; PG8_SCHED;
            PG8_LDA(At, 0, 1); PG8_STAGE(PG8_SB(0, 0), b2, voffB); PG8_STAGE(PG8_SB(0, 1), b2 + hstepB, voffB); PG8_STAGE(PG8_SA(0, 0), a2, voffA);
            PG8_WAIT_V(8); PG8_WAIT_L(0); PG8_BAR; PG8_MMA(1, 0, At, B0); PG8_MMA(1, 1, At, B1); PG8_BAR; PG8_SCHED;
            PG8_LDB(B0, 1, 0); PG8_LDB(B1, 1, 1); PG8_SCHED; PG8_LDA(At, 1, 0); PG8_STAGE(PG8_SA(0, 1), a2 + hstepA, voffA);
            PG8_WAIT_V(8); PG8_WAIT_L(0); PG8_BAR; PG8_MMA(0, 0, At, B0); PG8_MMA(0, 1, At, B1); PG8_BAR; PG8_SCHED;
            PG8_LDA(At, 1, 1); PG8_STAGE(PG8_SB(1, 0), b3, voffB); PG8_STAGE(PG8_SB(1, 1), b3 + hstepB, voffB); PG8_STAGE(PG8_SA(1, 0), a3, voffA);
            PG8_WAIT_V(8); PG8_WAIT_L(0); PG8_BAR; PG8_MMA(1, 0, At, B0); PG8_MMA(1, 1, At, B1); PG8_BAR; PG8_SCHED;
            } else {
            PG8_LDB(B0, 0, 0); PG8_SCHED; PG8_LDA(At, 0, 0); PG8_STAGE(PG8_SA(1, 1), a1 + hstepA, voffA);
            PG8_WAIT_L(8); PG8_BAR; PG8_WAIT_L(0); PG8_MMA(0, 0, At, B0); PG8_BAR; PG8_SCHED;
            PG8_LDB(B1, 0, 1); PG8_STAGE(PG8_SB(0, 0), b2, voffB);
            PG8_BAR; PG8_WAIT_L(0); PG8_MMA(0, 1, At, B1); PG8_BAR;
            PG8_LDA(At, 0, 1); PG8_STAGE(PG8_SA(0, 0), a2, voffA);
            PG8_BAR; PG8_WAIT_L(0); PG8_MMA(1, 0, At, B0); PG8_BAR; PG8_SCHED;
            PG8_STAGE(PG8_SB(0, 1), b2 + hstepB, voffB);
            PG8_WAIT_V(6); PG8_BAR; PG8_MMA(1, 1, At, B1); PG8_BAR;
            PG8_LDB(B0, 1, 0); PG8_SCHED; PG8_LDA(At, 1, 0); PG8_STAGE(PG8_SA(0, 1), a2 + hstepA, voffA);
            PG8_WAIT_L(8); PG8_BAR; PG8_WAIT_L(0); PG8_MMA(0, 0, At, B0); PG8_BAR; PG8_SCHED;
            PG8_LDB(B1, 1, 1); PG8_STAGE(PG8_SB(1, 0), b3, voffB);
            PG8_BAR; PG8_WAIT_L(0); PG8_MMA(0, 1, At, B1); PG8_BAR;
            PG8_LDA(At, 1, 1); PG8_STAGE(PG8_SA(1, 0), a3, voffA);
            PG8_BAR; PG8_WAIT_L(0); PG8_MMA(1, 0, At, B0); PG8_BAR; PG8_SCHED;
            PG8_STAGE(PG8_SB(1, 1), b3 + hstepB, voffB);
            PG8_WAIT_V(6); PG8_BAR; PG8_MMA(1, 1, At, B1); PG8_BAR;
            }
        }
        if constexpr (ALIGN_EPI) { if (wr == 0) PG8_BAR; }
        if constexpr (!Epi::AFTER_DRAIN) { E(acc, cur, wr, wc, fr, fq); S.done(cur); }
        if (!has_next) break;
#pragma unroll
        for (int a = 0; a < 2; ++a)
#pragma unroll
            for (int b = 0; b < 2; ++b)
#pragma unroll
                for (int m = 0; m < 4; ++m)
#pragma unroll
                    for (int n = 0; n < 2; ++n) acc[a][b][m][n] = (f32x4){0.f, 0.f, 0.f, 0.f};
        cur = nxt; cA = nA; cB = nB; ++ui;
        if constexpr (ALIGN_EPI) { if (wr == 1) PG8_BAR; }
    }
    PG8_WAIT_V(0);
    if constexpr (!ALIGN_EPI) { if (wr == 0) PG8_BAR; }
    PG8_BAR;
    if constexpr (Epi::AFTER_DRAIN) { E.fused(acc, cur, wr, wc, fr, fq, lds, wid, lane); S.done(cur); }
#undef PG8_SA
#undef PG8_SB
#undef PG8_STAGE
#undef PG8_LDA
#undef PG8_LDB
#undef PG8_MMA
#undef PG8_WAIT_V
#undef PG8_WAIT_L
#undef PG8_BAR
#undef PG8_SCHED
}
}

#define GAS __attribute__((address_space(1)))
#define LAS __attribute__((address_space(3)))
typedef unsigned short bf16_t;
typedef short bf16x8 __attribute__((ext_vector_type(8)));
typedef float f32x4 __attribute__((ext_vector_type(4)));
typedef unsigned u32x4 __attribute__((ext_vector_type(4)));
typedef unsigned u32x2 __attribute__((ext_vector_type(2)));

constexpr int DM = 1024, NBATCH = 2, SEQ = 8192, MEML = 256, MTOK = NBATCH * SEQ;
constexpr int INW = 12320, LD = 12544;
constexpr int C_Z = 0, C_X = 2048, C_B = 4096, C_C = 4608, C_LG = 5120, C_LX = 6656, C_Q = 8192, C_G = 9216, C_DT = 12288;
constexpr int C_MRG = 2048;
constexpr int NHEAD = 32, HDIM = 64, NGRP = 4, NSTATE = 128, CHUNK = 128, NCHUNK = SEQ / CHUNK;
constexpr int LRUW = 1536, LRUB = 96, NLB = 16, LSEG = 512, NSEG = SEQ / LSEG, NBLK64 = SEQ / 64;
constexpr float EPS = 1e-6f;
constexpr size_t MiB = 1u << 20;
constexpr size_t WS_WIN = 0, WS_WKV = 25 * MiB, WS_WSSD = 29 * MiB, WS_WLRU = 33 * MiB, WS_WMEM = 36 * MiB, WS_WOUT = 38 * MiB;
constexpr size_t WS_PROJ = 40 * MiB;
constexpr size_t WS_MEMN = 236 * MiB, WS_KVK = 237 * MiB, WS_KVVT = 238 * MiB, WS_LRUWA = 239 * MiB, WS_LRUWX = 239 * MiB + 512 * 1024;
constexpr size_t WS_DASUM = 240 * MiB;
constexpr size_t WS_LAGG = 246 * MiB;
constexpr size_t WS_LCAR = 250 * MiB;
constexpr size_t WS_CTL = 244 * MiB;
constexpr size_t WS_XBUF = 245 * MiB;
constexpr size_t WS_END = 256 * MiB;
static_assert(WS_PROJ + (size_t)SEQ * LD * 2 <= WS_MEMN, "ws map");
constexpr int LDS_BYTES = 155648;

struct Params {
    const float *x, *mem, *norm_g, *w_in, *ssd_conv_w, *ssd_conv_b, *ssd_dt_bias, *ssd_a_log, *ssd_d, *ssd_norm_g,
        *lru_conv_w, *lru_conv_b, *lru_w_a, *lru_b_a, *lru_w_x, *lru_b_x, *lru_lambda, *mem_norm_g, *w_kv,
        *w_br_ssd, *w_br_lru, *w_br_mem, *w_out, *final_g;
    float* out; unsigned char* ws;
    int lo, hi;
};

__device__ __forceinline__ float bf2f(bf16_t v) { return __uint_as_float((unsigned)v << 16); }
__device__ __forceinline__ unsigned f2bf(float f) { unsigned u = __float_as_uint(f); return (u + 0x7fffu + ((u >> 16) & 1u)) >> 16; }
__device__ __forceinline__ unsigned pk2(float lo, float hi) { return f2bf(lo) | (f2bf(hi) << 16); }
__device__ __forceinline__ float sigmoidf_(float v) { return __builtin_amdgcn_rcpf(1.f + __expf(-v)); }
__device__ __forceinline__ float siluf_(float v) { return v * __builtin_amdgcn_rcpf(1.f + __expf(-v)); }
__device__ __forceinline__ float softplusf_(float v) { const float e = __expf(v); const float sm = e * (1.f - e * (0.5f - e * 0.33333334f)); return v > 20.f ? v : (e < 1e-3f ? sm : __logf(1.f + e)); }
__device__ __forceinline__ float wave_sum(float v) {
#pragma unroll
    for (int o = 1; o < 64; o <<= 1) v += __shfl_xor(v, o);
    return v;
}
template <class T> __device__ __forceinline__ T* opq(T* q) { asm volatile("" : "+s"(q)); return q; }
__device__ __forceinline__ int opq_tid() { int t = threadIdx.x; asm volatile("" : "+v"(t)); return t; }
__device__ __forceinline__ int opq_bid() { int t = blockIdx.x; asm volatile("" : "+s"(t)); return t; }
__device__ __forceinline__ unsigned char* wsb(const Params& p) { return opq(p.ws); }
__device__ __forceinline__ bf16_t* proj_ptr(const Params& p) { return (bf16_t*)(wsb(p) + WS_PROJ); }
__device__ __forceinline__ bf16_t* xn_ptr(const Params& p) { return (bf16_t*)((unsigned char*)opq(p.out) + 32 * MiB); }
__device__ __forceinline__ bf16_t* states_ptr(const Params& p, int b) { return (bf16_t*)((unsigned char*)opq(p.out) + (size_t)b * 32 * MiB); }
__device__ __forceinline__ float* scr_ptr(const Params& p, int b) { return (float*)((unsigned char*)opq(p.out) + (size_t)b * 32 * MiB); }

#ifdef PROBE_MA
#define MSTAMP(p, i) do { if (blockIdx.x == 0 && threadIdx.x == 0) ((unsigned long long*)(wsb(p) + 255 * MiB))[i] = __builtin_amdgcn_s_memrealtime(); } while (0)
#else
#define MSTAMP(p, i) do { } while (0)
#endif
__device__ __forceinline__ void transpose_item(const float* W, int K, int Ns, int srccol0, bf16_t* WT, int dstrow0, LAS float* scr, int k0, int lane) {
    float wv[32];
#pragma unroll
    for (int i = 0; i < 32; ++i) wv[i] = W[(size_t)(k0 + 2 * i + (lane >> 5)) * Ns + srccol0 + (lane & 31)];
#pragma unroll
    for (int i = 0; i < 32; ++i) scr[(2 * i + (lane >> 5)) * 33 + (lane & 31)] = wv[i];
    asm volatile("s_waitcnt lgkmcnt(0)" ::: "memory");
    const int c = lane & 7;
#pragma unroll
    for (int j = 0; j < 4; ++j) { const int n = (lane >> 3) + 8 * j; const LAS float* s = scr + (8 * c) * 33 + n;
        u32x4 o; o.x = pk2(s[0 * 33], s[1 * 33]); o.y = pk2(s[2 * 33], s[3 * 33]); o.z = pk2(s[4 * 33], s[5 * 33]); o.w = pk2(s[6 * 33], s[7 * 33]);
        *(u32x4*)(WT + (size_t)(dstrow0 + n) * K + k0 + 8 * c) = o; }
    asm volatile("s_waitcnt lgkmcnt(0)" ::: "memory");
}
__device__ __forceinline__ void rms_row_to_bf16(const float* xrow, const float* g, bf16_t* orow, int lane) {
    const f32x4* xr = (const f32x4*)xrow + lane; const f32x4* gr = (const f32x4*)g + lane;
    f32x4 v[4]; float s = 0.f;
#pragma unroll
    for (int j = 0; j < 4; ++j) { v[j] = xr[64 * j]; s += (v[j].x * v[j].x + v[j].y * v[j].y) + (v[j].z * v[j].z + v[j].w * v[j].w); }
    const float rs = 1.f / sqrtf(wave_sum(s) * (1.f / DM) + EPS);
    unsigned long long* o8 = (unsigned long long*)orow + lane;
#pragma unroll
    for (int j = 0; j < 4; ++j) { const f32x4 gg = gr[64 * j];
        o8[64 * j] = (unsigned long long)pk2(v[j].x * rs * gg.x, v[j].y * rs * gg.y) | ((unsigned long long)pk2(v[j].z * rs * gg.z, v[j].w * rs * gg.w) << 32); }
}
__device__ __forceinline__ void xn_rows(const Params& p, int row_lo, int row_hi, int gw, int NGW, int lane) {
    bf16_t* XN = xn_ptr(p);
    { const float* xb = opq(p.x); const f32x4* gr = (const f32x4*)opq(p.norm_g) + lane;
      for (int m0 = row_lo + gw * 4; m0 < row_hi; m0 += NGW * 4) {
          f32x4 v[4][4];
#pragma unroll
          for (int r = 0; r < 4; ++r)
#pragma unroll
              for (int j = 0; j < 4; ++j) v[r][j] = ((const f32x4*)(xb + (size_t)(m0 + r) * DM) + lane)[64 * j];
#pragma unroll
          for (int r = 0; r < 4; ++r) { float s = 0.f;
#pragma unroll
              for (int j = 0; j < 4; ++j) s += (v[r][j].x * v[r][j].x + v[r][j].y * v[r][j].y) + (v[r][j].z * v[r][j].z + v[r][j].w * v[r][j].w);
              const float rs = 1.f / sqrtf(wave_sum(s) * (1.f / DM) + EPS);
              unsigned long long* o8 = (unsigned long long*)(XN + (size_t)(m0 + r) * DM) + lane;
#pragma unroll
              for (int j = 0; j < 4; ++j) { const f32x4 gg = gr[64 * j];
                  o8[64 * j] = (unsigned long long)pk2(v[r][j].x * rs * gg.x, v[r][j].y * rs * gg.y) | ((unsigned long long)pk2(v[r][j].z * rs * gg.z, v[r][j].w * rs * gg.w) << 32); } } } }
}
__device__ __forceinline__ void phase0(const Params& p, LAS unsigned char* lds) {
    const int tid = opq_tid(), lane = tid & 63, wave = tid >> 6, bid = opq_bid();
    const int gw = bid * 8 + wave, NGW = gridDim.x * 8;
    LAS float* scr = (LAS float*)(lds + wave * 8704);
    bf16_t* Win = (bf16_t*)(wsb(p) + WS_WIN); bf16_t* Wkv = (bf16_t*)(wsb(p) + WS_WKV); bf16_t* Wssd = (bf16_t*)(wsb(p) + WS_WSSD);
    bf16_t* Wlru = (bf16_t*)(wsb(p) + WS_WLRU); bf16_t* Wmem = (bf16_t*)(wsb(p) + WS_WMEM); bf16_t* Wout = (bf16_t*)(wsb(p) + WS_WOUT);
    constexpr int I_IN = 16 * 385, I_KV = 16 * 64, I_SSD = 32 * 32, I_LRU = 24 * 32, I_MEM = 16 * 32, I_OUT = 16 * 32;
    constexpr int NITEMS = I_IN + I_KV + I_SSD + I_LRU + I_MEM + I_OUT;
    for (int it = gw; it < NITEMS; it += NGW) {
        int r = it;
        if (r < I_IN) { const int nb = r % 385, kb = r / 385; const int sc = 32 * nb; int dr;
            if (sc < 5120) dr = sc; else if (sc < 5152) dr = sc - 5120 + C_DT; else dr = sc - 32;
            transpose_item(opq(p.w_in), 1024, INW, sc, Win, dr, scr, 64 * kb, lane); continue; } r -= I_IN;
        if (r < I_KV) { transpose_item(opq(p.w_kv), 1024, 2048, 32 * (r % 64), Wkv, 32 * (r % 64), scr, 64 * (r / 64), lane); continue; } r -= I_KV;
        if (r < I_SSD) { transpose_item(opq(p.w_br_ssd), 2048, 1024, 32 * (r % 32), Wssd, 32 * (r % 32), scr, 64 * (r / 32), lane); continue; } r -= I_SSD;
        if (r < I_LRU) { transpose_item(opq(p.w_br_lru), 1536, 1024, 32 * (r % 32), Wlru, 32 * (r % 32), scr, 64 * (r / 32), lane); continue; } r -= I_LRU;
        if (r < I_MEM) { transpose_item(opq(p.w_br_mem), 1024, 1024, 32 * (r % 32), Wmem, 32 * (r % 32), scr, 64 * (r / 32), lane); continue; } r -= I_MEM;
        transpose_item(opq(p.w_out), 1024, 1024, 32 * (r % 32), Wout, 32 * (r % 32), scr, 64 * (r / 32), lane);
    }
    { const int gt = bid * 512 + tid, NT = gridDim.x * 512; u32x4* z = (u32x4*)(Win + (size_t)INW * 1024);
      for (int i = gt; i < (LD - INW) * 1024 / 8; i += NT) z[i] = (u32x4){0u, 0u, 0u, 0u}; }
    { const int gt = bid * 512 + tid, NT = gridDim.x * 512; bf16_t* wa = (bf16_t*)(wsb(p) + WS_LRUWA); bf16_t* wx = (bf16_t*)(wsb(p) + WS_LRUWX);
      for (int e = gt; e < NLB * LRUB * LRUB; e += NT) { const int n = e / (LRUB * LRUB), r2 = e % (LRUB * LRUB), j = r2 / LRUB, i = r2 % LRUB;
          wa[e] = (bf16_t)f2bf(opq(p.lru_w_a)[(n * LRUB + i) * LRUB + j]); wx[e] = (bf16_t)f2bf(opq(p.lru_w_x)[(n * LRUB + i) * LRUB + j]); } }
    bf16_t* XN = xn_ptr(p); bf16_t* MN = (bf16_t*)(wsb(p) + WS_MEMN);
    if (gridDim.x == 256) xn_rows(p, 0, SEQ, gw, NGW, lane); else xn_rows(p, 0, MTOK, gw, NGW, lane);
    for (int m = gw; m < NBATCH * MEML; m += NGW) rms_row_to_bf16(opq(p.mem) + (size_t)m * DM, opq(p.mem_norm_g), MN + (size_t)m * DM, lane);
}
__device__ __forceinline__ void phase7(const Params& p) {
    const int tid = opq_tid(), lane = tid & 63, wave = tid >> 6; const int gw = opq_bid() * 8 + wave, NGW = gridDim.x * 8; float* outb = opq(p.out); const float* fg = opq(p.final_g);
    for (int m = gw; m < MTOK; m += NGW) {
        f32x4* xr = (f32x4*)(outb + (size_t)m * DM) + lane; const f32x4* gr = (const f32x4*)fg + lane;
        f32x4 v[4]; float s = 0.f;
#pragma unroll
        for (int j = 0; j < 4; ++j) { v[j] = xr[64 * j]; s += (v[j].x * v[j].x + v[j].y * v[j].y) + (v[j].z * v[j].z + v[j].w * v[j].w); }
        const float rs = 1.f / sqrtf(wave_sum(s) * (1.f / DM) + EPS);
#pragma unroll
        for (int j = 0; j < 4; ++j) { const f32x4 gg = gr[64 * j]; xr[64 * j] = v[j] * rs * gg; }
    }
}

namespace pg8 {
template <int BR> struct EpiMerge {
    static constexpr bool PERM = true, AFTER_DRAIN = false;
    bf16_t* P; float* scr;
    __device__ __forceinline__ void operator()(const f32x4 (&acc)[2][2][4][2], const Unit& u, int wr, int wc, int fr, int fq) const {
        const int row0 = u.pm * BM + wr * 64 + fr, col0 = u.pn * BM + wc * 32 + 8 * fq;
#pragma unroll
        for (int ai = 0; ai < 2; ++ai)
#pragma unroll
            for (int m = 0; m < 4; ++m) { const size_t r = (size_t)(row0 + ai * HALF + m * 16);
#pragma unroll
                for (int bj = 0; bj < 2; ++bj) { const int c = col0 + bj * HALF;
                    const u32x4 gw = *(const u32x4*)(P + r * 12544 + 9216 + BR * 1024 + c);
                    float g[8];
#pragma unroll
                    for (int i = 0; i < 4; ++i) { g[2 * i] = __uint_as_float(gw[i] << 16); g[2 * i + 1] = __uint_as_float(gw[i] & 0xffff0000u); }
                    f32x4 v0 = acc[ai][bj][m][0], v1 = acc[ai][bj][m][1];
#pragma unroll
                    for (int i = 0; i < 4; ++i) { v0[i] *= 1.f / (1.f + __expf(-g[i])); v1[i] *= 1.f / (1.f + __expf(-g[4 + i])); }
                    float* sp = scr + r * 1024 + c;
                    if (BR > 0) { v0 += *(const f32x4*)sp; v1 += *(const f32x4*)(sp + 4); }
                    if (BR < 2) { *(f32x4*)sp = v0; *(f32x4*)(sp + 4) = v1; }
                    else { u32x4 w; w.x = cvt_pk_bf16(v0[0], v0[1]); w.y = cvt_pk_bf16(v0[2], v0[3]); w.z = cvt_pk_bf16(v1[0], v1[1]); w.w = cvt_pk_bf16(v1[2], v1[3]);
                        *(u32x4*)(P + r * 12544 + 2048 + c) = w; } } }
    }
};
template <int BR, bool FINAL> struct EpiMerge2 {
    static constexpr bool PERM = true, AFTER_DRAIN = false;
    bf16_t* P; bf16_t* s0; int ld0; const bf16_t* s1; int ld1; bf16_t* mrg; int ldm;
    __device__ __forceinline__ void operator()(const f32x4 (&acc)[2][2][4][2], const Unit& u, int wr, int wc, int fr, int fq) const {
        const int row0 = u.pm * BM + wr * 64 + fr, col0 = u.pn * BM + wc * 32 + 8 * fq;
#pragma unroll
        for (int ai = 0; ai < 2; ++ai) {
            unsigned gb = (unsigned)((row0 + ai * HALF) * 12544 + 9216 + BR * 1024 + col0); asm volatile("" : "+v"(gb));
            unsigned b0 = (unsigned)((row0 + ai * HALF) * ld0 + col0); asm volatile("" : "+v"(b0));
            u32x4 gw[4][2];
#pragma unroll
            for (int m = 0; m < 4; ++m)
#pragma unroll
                for (int bj = 0; bj < 2; ++bj) gw[m][bj] = *(const u32x4*)(P + (gb + (unsigned)(m * 16 * 12544 + bj * HALF)));
            f32x4 v[4][2][2];
#pragma unroll
            for (int m = 0; m < 4; ++m)
#pragma unroll
                for (int bj = 0; bj < 2; ++bj) { const u32x4 g4 = gw[m][bj]; f32x4 v0 = acc[ai][bj][m][0], v1 = acc[ai][bj][m][1];
#pragma unroll
                    for (int i = 0; i < 2; ++i) { v0[2 * i] *= __builtin_amdgcn_rcpf(1.f + __expf(-__uint_as_float(g4[i] << 16))); v0[2 * i + 1] *= __builtin_amdgcn_rcpf(1.f + __expf(-__uint_as_float(g4[i] & 0xffff0000u)));
                        v1[2 * i] *= __builtin_amdgcn_rcpf(1.f + __expf(-__uint_as_float(g4[2 + i] << 16))); v1[2 * i + 1] *= __builtin_amdgcn_rcpf(1.f + __expf(-__uint_as_float(g4[2 + i] & 0xffff0000u))); }
                    v[m][bj][0] = v0; v[m][bj][1] = v1; }
            if (!FINAL) {
#pragma unroll
                for (int m = 0; m < 4; ++m)
#pragma unroll
                    for (int bj = 0; bj < 2; ++bj) { const f32x4 v0 = v[m][bj][0], v1 = v[m][bj][1]; u32x4 w; w.x = cvt_pk_bf16(v0[0], v0[1]); w.y = cvt_pk_bf16(v0[2], v0[3]); w.z = cvt_pk_bf16(v1[0], v1[1]); w.w = cvt_pk_bf16(v1[2], v1[3]);
                        *(u32x4*)(s0 + (b0 + (unsigned)(m * 16) * (unsigned)ld0 + (unsigned)(bj * HALF))) = w; }
            } else {
                asm volatile("" ::: "memory");
                unsigned b1 = (unsigned)((row0 + ai * HALF) * ld1 + col0); asm volatile("" : "+v"(b1));
                unsigned bm = (unsigned)((row0 + ai * HALF) * ldm + col0); asm volatile("" : "+v"(bm));
#pragma unroll
                for (int mp = 0; mp < 2; ++mp) { u32x4 a0[2][2], a1[2][2];
#pragma unroll
                    for (int mm = 0; mm < 2; ++mm)
#pragma unroll
                        for (int bj = 0; bj < 2; ++bj) { const unsigned rr = (unsigned)((2 * mp + mm) * 16);
                            a0[mm][bj] = *(const u32x4*)(s0 + (b0 + rr * (unsigned)ld0 + (unsigned)(bj * HALF))); a1[mm][bj] = *(const u32x4*)(s1 + (b1 + rr * (unsigned)ld1 + (unsigned)(bj * HALF))); }
#pragma unroll
                    for (int mm = 0; mm < 2; ++mm)
#pragma unroll
                        for (int bj = 0; bj < 2; ++bj) { const int m = 2 * mp + mm; const unsigned rr = (unsigned)(m * 16);
                            f32x4 v0 = v[m][bj][0], v1 = v[m][bj][1];
#pragma unroll
                            for (int i = 0; i < 2; ++i) { v0[2 * i] += __uint_as_float(a0[mm][bj][i] << 16) + __uint_as_float(a1[mm][bj][i] << 16); v0[2 * i + 1] += __uint_as_float(a0[mm][bj][i] & 0xffff0000u) + __uint_as_float(a1[mm][bj][i] & 0xffff0000u);
                                v1[2 * i] += __uint_as_float(a0[mm][bj][2 + i] << 16) + __uint_as_float(a1[mm][bj][2 + i] << 16); v1[2 * i + 1] += __uint_as_float(a0[mm][bj][2 + i] & 0xffff0000u) + __uint_as_float(a1[mm][bj][2 + i] & 0xffff0000u); }
                            u32x4 w; w.x = cvt_pk_bf16(v0[0], v0[1]); w.y = cvt_pk_bf16(v0[2], v0[3]); w.z = cvt_pk_bf16(v1[0], v1[1]); w.w = cvt_pk_bf16(v1[2], v1[3]);
                            *(u32x4*)(mrg + (bm + rr * (unsigned)ldm + (unsigned)(bj * HALF))) = w; }
                    asm volatile("" ::: "memory"); }
            }
            asm volatile("" ::: "memory");
        }
    }
};
struct EpiOutNorm {
    static constexpr bool PERM = false, AFTER_DRAIN = true;
    const float* xres; float* out; const float* fg; float* xbuf; unsigned* cnt;
    __device__ __forceinline__ void fused(f32x4 (&acc)[2][2][4][2], const Unit& u, int wr, int wc, int fr, int fq, PG8_LAS unsigned char* lds, int wid, int lane) const {
        PG8_LAS float* Pp = (PG8_LAS float*)lds; PG8_LAS float* Sr = (PG8_LAS float*)(lds + 4096);
        const int row0 = u.pm * BM + wr * 64 + fr, col0 = u.pn * BM + wc * 32 + 4 * fq;
#pragma unroll
        for (int ai = 0; ai < 2; ++ai)
#pragma unroll
            for (int m = 0; m < 4; ++m) { const size_t off = (size_t)(row0 + ai * HALF + m * 16) * 1024 + col0; float s = 0.f;
#pragma unroll
                for (int bj = 0; bj < 2; ++bj)
#pragma unroll
                    for (int n = 0; n < 2; ++n) { const f32x4 v = acc[ai][bj][m][n] + *(const f32x4*)(xres + off + bj * HALF + n * 16); acc[ai][bj][m][n] = v; s += (v[0] * v[0] + v[1] * v[1]) + (v[2] * v[2] + v[3] * v[3]); }
                s += __shfl_xor(s, 16); s += __shfl_xor(s, 32);
                if (fq == 0) Pp[(ai * HALF + wr * 64 + m * 16 + fr) * 4 + wc] = s;
                if (m == 3) asm volatile("" ::: "memory"); }
        asm volatile("s_waitcnt lgkmcnt(0)" ::: "memory"); __builtin_amdgcn_s_barrier(); asm volatile("" ::: "memory");
        const int tid = wid * 64 + lane;
        if (tid < 256) { const float s = (Pp[tid * 4 + 0] + Pp[tid * 4 + 1]) + (Pp[tid * 4 + 2] + Pp[tid * 4 + 3]);
            __hip_atomic_store(xbuf + (size_t)(u.pm * BM + tid) * 4 + u.pn, s, __ATOMIC_RELAXED, __HIP_MEMORY_SCOPE_AGENT); }
        asm volatile("s_waitcnt vmcnt(0)" ::: "memory");
        if (wid < 4 && lane == 0) __hip_atomic_fetch_add(cnt + 64 * u.pm, 1u, __ATOMIC_RELAXED, __HIP_MEMORY_SCOPE_AGENT);
        if (wid == 0) { unsigned spins = 0;
            while ((unsigned)__builtin_amdgcn_readfirstlane(__hip_atomic_load(cnt + 64 * u.pm, __ATOMIC_RELAXED, __HIP_MEMORY_SCOPE_AGENT)) < 16u && ++spins < (1u << 22)) __builtin_amdgcn_s_sleep(2);
            __builtin_amdgcn_fence(__ATOMIC_ACQUIRE, "agent"); }
        asm volatile("s_waitcnt vmcnt(0) lgkmcnt(0)" ::: "memory"); __builtin_amdgcn_s_barrier(); asm volatile("" ::: "memory");
        if (tid < 256) { const float* slot = xbuf + (size_t)(u.pm * BM + tid) * 4; float s = 0.f;
#pragma unroll
            for (int q = 0; q < 4; ++q) s += __hip_atomic_load(slot + q, __ATOMIC_RELAXED, __HIP_MEMORY_SCOPE_AGENT);
            Sr[tid] = 1.0f / sqrtf(s * (1.f / 1024.f) + 1e-6f); }
        asm volatile("s_waitcnt lgkmcnt(0)" ::: "memory"); __builtin_amdgcn_s_barrier(); asm volatile("" ::: "memory");
#pragma unroll
        for (int ai = 0; ai < 2; ++ai)
#pragma unroll
            for (int m = 0; m < 4; ++m) { const int r = ai * HALF + wr * 64 + m * 16 + fr; const float rs = Sr[r]; const size_t off = (size_t)(u.pm * BM + r) * 1024 + col0;
#pragma unroll
                for (int bj = 0; bj < 2; ++bj)
#pragma unroll
                    for (int n = 0; n < 2; ++n) { const f32x4 gg = *(const f32x4*)(fg + col0 + bj * HALF + n * 16); *(f32x4*)(out + off + bj * HALF + n * 16) = acc[ai][bj][m][n] * rs * gg; } }
    }
};
struct SkewOrder {
    StaticOrder base; int c;
    __device__ void init(int M, int N, int c_) { base.init(M, N, 256, 0); c = c_; }
    __device__ bool next(int i, Unit& u) const {
        int ii, cc = c;
        if (c < 128) { if (i >= 5) return false; ii = i + 1; }
        else { if (i > 6) return false; if (i == 0) ii = 0; else if (i == 1) { ii = 0; cc = c - 128; } else ii = i - 1; }
        StaticOrder b2 = base; b2.c = cc; return b2.next(ii, u);
    }
    __device__ __forceinline__ void a_ready(const Unit&) const {}
    __device__ __forceinline__ void done(const Unit&) const {}
};
}
#define PG8_SP2 true
#define PG8_ALIGN true

__device__ __forceinline__ bf16_t* merged_ptr(const Params& p, int b) { return b == 0 ? xn_ptr(p) : proj_ptr(p) + 4096; }
__device__ __forceinline__ int merged_ld(int b) { return b == 0 ? DM : LD; }
__device__ __forceinline__ void phase1_gemm(const Params& p, int b, LAS unsigned char* lds) {
    const int G = gridDim.x, c = opq_bid();
    { pg8::Gemm g{xn_ptr(p) + (size_t)b * SEQ * DM, (const bf16_t*)(wsb(p) + WS_WIN), SEQ, 12288, DM, DM, DM}; pg8::StaticOrder S; S.init(SEQ, 12288, G, c);
      pg8::EpiBf16<0> E{proj_ptr(p), LD, nullptr, 0, 0, 1.f};
      if (b == 1 && G == 256) { pg8::SkewOrder S2; S2.init(SEQ, 12288, c);
          pg8::gemm_phase<pg8::EpiBf16<0>, pg8::SkewOrder, PG8_ALIGN, PG8_SP2>(lds, g, S2, E); }
      else pg8::gemm_phase<pg8::EpiBf16<0>, pg8::StaticOrder, PG8_ALIGN, PG8_SP2>(lds, g, S, E); }
    { const int tid = opq_tid(), lane = tid & 63, wave = tid >> 6, fr = lane & 15, kg = lane >> 4;
      const bf16_t* XNb = xn_ptr(p) + (size_t)b * SEQ * DM; const bf16_t* Wd = (const bf16_t*)(wsb(p) + WS_WIN) + (size_t)C_DT * DM; bf16_t* Pq = proj_ptr(p);
      LAS float* sRed = (LAS float*)lds;
      for (int rb = c; rb < SEQ / 32; rb += G) {
          __syncthreads();
          f32x4 acc[2][2];
#pragma unroll
          for (int mt = 0; mt < 2; ++mt)
#pragma unroll
              for (int nt = 0; nt < 2; ++nt) acc[mt][nt] = (f32x4){0.f, 0.f, 0.f, 0.f};
          bf16x8 af[2][4], bfr[2][4];
#pragma unroll
          for (int ks = 0; ks < 4; ++ks)
#pragma unroll
              for (int q = 0; q < 2; ++q) { af[q][ks] = *(const bf16x8*)(XNb + (size_t)(32 * rb + 16 * q + fr) * DM + 128 * wave + 32 * ks + 8 * kg);
                  bfr[q][ks] = *(const bf16x8*)(Wd + (size_t)(16 * q + fr) * DM + 128 * wave + 32 * ks + 8 * kg); }
#pragma unroll
          for (int ks = 0; ks < 4; ++ks)
#pragma unroll
              for (int mt = 0; mt < 2; ++mt)
#pragma unroll
                  for (int nt = 0; nt < 2; ++nt) acc[mt][nt] = __builtin_amdgcn_mfma_f32_16x16x32_bf16(af[mt][ks], bfr[nt][ks], acc[mt][nt], 0, 0, 0);
#pragma unroll
          for (int mt = 0; mt < 2; ++mt)
#pragma unroll
              for (int nt = 0; nt < 2; ++nt)
#pragma unroll
                  for (int j = 0; j < 4; ++j) sRed[(wave * 32 + 16 * mt + 4 * kg + j) * 32 + 16 * nt + fr] = acc[mt][nt][j];
          __syncthreads();
#pragma unroll
          for (int q = 0; q < 2; ++q) { const int e = tid + 512 * q, row = e >> 5, col = e & 31; float s = 0.f;
#pragma unroll
              for (int w2 = 0; w2 < 8; ++w2) s += sRed[(w2 * 32 + row) * 32 + col];
              Pq[(size_t)(32 * rb + row) * LD + C_DT + col] = (bf16_t)f2bf(s); }
      } }
    if (b == 0 && G != 256) {
        { pg8::Gemm g{(const bf16_t*)(wsb(p) + WS_MEMN), (const bf16_t*)(wsb(p) + WS_WKV), 512, 1024, DM, DM, DM}; pg8::StaticOrder S; S.init(512, 1024, G, (c + 16) % G);
          pg8::EpiBf16<0> E{(bf16_t*)(wsb(p) + WS_KVK), 1024, nullptr, 0, 0, 1.f};
          pg8::gemm_phase<pg8::EpiBf16<0>, pg8::StaticOrder, PG8_ALIGN, PG8_SP2>(lds, g, S, E); }
        { pg8::Gemm g{(const bf16_t*)(wsb(p) + WS_WKV) + (size_t)1024 * DM, (const bf16_t*)(wsb(p) + WS_MEMN), 1024, 512, DM, DM, DM}; pg8::StaticOrder S; S.init(1024, 512, G, (c + 8) % G);
          pg8::EpiBf16<0> E{(bf16_t*)(wsb(p) + WS_KVVT), 512, nullptr, 0, 0, 1.f};
          pg8::gemm_phase<pg8::EpiBf16<0>, pg8::StaticOrder, PG8_ALIGN, PG8_SP2>(lds, g, S, E); }
    }
    if (b == 0 && G == 256) {
        const int tid = opq_tid(), lane = tid & 63, wave = tid >> 6, fr = lane & 15, kg = lane >> 4;
        const bf16_t* MN = (const bf16_t*)(wsb(p) + WS_MEMN); const bf16_t* WK = (const bf16_t*)(wsb(p) + WS_WKV);
        const bool jobK = c < 128; const int cb = jobK ? c : c - 128;
        const bf16_t* Ap = jobK ? MN + (size_t)(64 * (cb >> 4)) * DM : WK + (size_t)(1024 + 64 * (cb >> 3)) * DM;
        const bf16_t* Bp = jobK ? WK + (size_t)(64 * (cb & 15)) * DM : MN + (size_t)(64 * (cb & 7)) * DM;
        bf16_t* Cp = jobK ? (bf16_t*)(wsb(p) + WS_KVK) + (size_t)(64 * (cb >> 4)) * 1024 + 64 * (cb & 15) : (bf16_t*)(wsb(p) + WS_KVVT) + (size_t)(64 * (cb >> 3)) * 512 + 64 * (cb & 7);
        const int ldc = jobK ? 1024 : 512;
        LAS float* sRed = (LAS float*)lds;
        __syncthreads();
        f32x4 acc[4][4];
#pragma unroll
        for (int mt = 0; mt < 4; ++mt)
#pragma unroll
            for (int nt = 0; nt < 4; ++nt) acc[mt][nt] = (f32x4){0.f, 0.f, 0.f, 0.f};
#pragma unroll
        for (int ks = 0; ks < 4; ++ks) { bf16x8 af[4], bfr[4];
#pragma unroll
            for (int q = 0; q < 4; ++q) { af[q] = *(const bf16x8*)(Ap + (size_t)(16 * q + fr) * DM + 128 * wave + 32 * ks + 8 * kg); bfr[q] = *(const bf16x8*)(Bp + (size_t)(16 * q + fr) * DM + 128 * wave + 32 * ks + 8 * kg); }
#pragma unroll
            for (int mt = 0; mt < 4; ++mt)
#pragma unroll
                for (int nt = 0; nt < 4; ++nt) acc[mt][nt] = __builtin_amdgcn_mfma_f32_16x16x32_bf16(af[mt], bfr[nt], acc[mt][nt], 0, 0, 0); }
#pragma unroll
        for (int mt = 0; mt < 4; ++mt)
#pragma unroll
            for (int nt = 0; nt < 4; ++nt)
#pragma unroll
                for (int j = 0; j < 4; ++j) sRed[(wave * 64 + 16 * mt + 4 * kg + j) * 64 + 16 * nt + fr] = acc[mt][nt][j];
        __syncthreads();
#pragma unroll
        for (int q = 0; q < 8; ++q) { const int e2 = tid + 512 * q, row = e2 >> 6, col = e2 & 63; float s = 0.f;
#pragma unroll
            for (int w2 = 0; w2 < 8; ++w2) s += sRed[(w2 * 64 + row) * 64 + col];
            Cp[(size_t)row * ldc + col] = (bf16_t)f2bf(s); }
    }
}
__device__ __forceinline__ void phase5_gemm(const Params& p, int b, LAS unsigned char* lds) {
    const int G = gridDim.x, c = opq_bid(); bf16_t* P = proj_ptr(p); float* scr = scr_ptr(p, b);
    bf16_t* scrB = P + 2048;
    bf16_t* scrA = (bf16_t*)scr;
    unsigned* flag = (unsigned*)(wsb(p) + WS_CTL) + 4096 + (b * 128 + (c & 127)) * 16;
    if (c < 128) {
        pg8::Gemm g{P + C_Z, (const bf16_t*)(wsb(p) + WS_WSSD), SEQ, DM, 2048, LD, 2048}; pg8::StaticOrder S; S.init(SEQ, DM, 128, c); pg8::EpiMerge2<0, false> E{P, scrA, 1024, nullptr, 0, nullptr, 0};
        pg8::gemm_phase<pg8::EpiMerge2<0, false>, pg8::StaticOrder, false, PG8_SP2>(lds, g, S, E);
#ifdef PROBE_NOFENCE
        asm volatile("s_waitcnt vmcnt(0)" ::: "memory"); __syncthreads();
        if (threadIdx.x == 0) __hip_atomic_store(flag, 1u, __ATOMIC_RELAXED, __HIP_MEMORY_SCOPE_AGENT);
#else
        asm volatile("s_waitcnt vmcnt(0)" ::: "memory"); __syncthreads();
        if (threadIdx.x == 0) { __builtin_amdgcn_fence(__ATOMIC_RELEASE, "agent"); asm volatile("s_waitcnt vmcnt(0)" ::: "memory");
            __hip_atomic_store(flag, 1u, __ATOMIC_RELAXED, __HIP_MEMORY_SCOPE_AGENT); }
#endif
        if (b == 0 && G == 256) { const int tid2 = opq_tid(); xn_rows(p, SEQ, MTOK, c * 8 + (tid2 >> 6), 128 * 8, tid2 & 63); }
    } else {
        { pg8::Gemm g{P + C_LG, (const bf16_t*)(wsb(p) + WS_WLRU), SEQ, DM, 1536, LD, 1536}; pg8::StaticOrder S; S.init(SEQ, DM, 128, c - 128); pg8::EpiMerge2<1, false> E{P, scrB, LD, nullptr, 0, nullptr, 0};
          pg8::gemm_phase<pg8::EpiMerge2<1, false>, pg8::StaticOrder, false, PG8_SP2>(lds, g, S, E); }
        if (threadIdx.x == 0) { unsigned spins = 0; while (__hip_atomic_load(flag, __ATOMIC_RELAXED, __HIP_MEMORY_SCOPE_AGENT) == 0u && ++spins < (1u << 22)) __builtin_amdgcn_s_sleep(2);
#ifndef PROBE_NOFENCE
            __builtin_amdgcn_fence(__ATOMIC_ACQUIRE, "agent"); asm volatile("s_waitcnt vmcnt(0)" ::: "memory");
#endif
        }
        __syncthreads();
        { pg8::Gemm g{P + C_Q, (const bf16_t*)(wsb(p) + WS_WMEM), SEQ, DM, 1024, LD, 1024}; pg8::StaticOrder S; S.init(SEQ, DM, 128, c - 128); pg8::EpiMerge2<2, true> E{P, scrB, LD, scrA, 1024, merged_ptr(p, b), merged_ld(b)};
          pg8::gemm_phase<pg8::EpiMerge2<2, true>, pg8::StaticOrder, false, PG8_SP2>(lds, g, S, E); }
    }
}
__device__ __forceinline__ void phase6_gemm(const Params& p, int b, LAS unsigned char* lds) {
    const int G = gridDim.x, c = opq_bid(); bf16_t* P = proj_ptr(p);
    pg8::Gemm g{merged_ptr(p, b), (const bf16_t*)(wsb(p) + WS_WOUT), SEQ, DM, DM, merged_ld(b), DM}; pg8::StaticOrder S; S.init(SEQ, DM, G, c);
    pg8::EpiOutNorm E{opq(p.x) + (size_t)b * SEQ * DM, opq(p.out) + (size_t)b * SEQ * DM, opq(p.final_g), (float*)(wsb(p) + WS_XBUF) + (size_t)b * SEQ * 4, (unsigned*)(wsb(p) + WS_CTL) + 8192 + b * 2048};
    pg8::gemm_phase<pg8::EpiOutNorm, pg8::StaticOrder, false, PG8_SP2>(lds, g, S, E);
}
#define MFMA16(a, b, c) __builtin_amdgcn_mfma_f32_16x16x32_bf16((a), (b), (c), 0, 0, 0)
__device__ __forceinline__ bf16x8 pack8(const float (&v)[8]) {
    u32x4 w; w.x = pk2(v[0], v[1]); w.y = pk2(v[2], v[3]); w.z = pk2(v[4], v[5]); w.w = pk2(v[6], v[7]); return __builtin_bit_cast(bf16x8, w);
}
__device__ __forceinline__ void unpack8(u32x4 w, float (&v)[8]) {
#pragma unroll
    for (int i = 0; i < 4; ++i) { v[2 * i] = __uint_as_float(w[i] << 16); v[2 * i + 1] = __uint_as_float(w[i] & 0xffff0000u); }
}
__device__ __forceinline__ void attn_phase(const Params& p, int b, LAS unsigned char* lds, int dry = 0) {
    const int tid = opq_tid(), lane = tid & 63, wave = tid >> 6, fr = lane & 15, kg = lane >> 4;
    bf16_t* P = proj_ptr(p); const bf16_t* KK = (const bf16_t*)(wsb(p) + WS_KVK) + (size_t)b * 256 * 1024; const bf16_t* VT = (const bf16_t*)(wsb(p) + WS_KVVT) + b * 256;
    LAS bf16_t* sKV = (LAS bf16_t*)lds;
    for (int u = opq_bid(); u < 256; u += gridDim.x) {
        const int hd = u & 3, rt = u >> 2, q0 = rt * 128 + wave * 16;
        bf16_t* qrow = P + (size_t)(q0 + fr) * LD + C_Q + hd * 256;
        __syncthreads();
        { unsigned ko = (unsigned)((tid >> 5) * 1024 + hd * 256 + 8 * (tid & 31)); asm volatile("" : "+v"(ko));
          u32x4 st[16];
#pragma unroll
          for (int i = 0; i < 16; ++i) st[i] = *(const u32x4*)(KK + (ko + (unsigned)(i * 16 * 1024)));
#pragma unroll
          for (int i = 0; i < 16; ++i) *(LAS u32x4*)(sKV + ((tid >> 5) + 16 * i) * 264 + 8 * (tid & 31)) = st[i]; }
        bf16x8 qf[8];
#pragma unroll
        for (int s = 0; s < 8; ++s) qf[s] = *(const bf16x8*)(qrow + 32 * s + 8 * kg);
        __syncthreads();
        u32x4 vst[16];
        { unsigned vo = (unsigned)((hd * 256 + (tid >> 5)) * 512 + 8 * (tid & 31)); asm volatile("" : "+v"(vo));
#pragma unroll
          for (int i = 0; i < 16; ++i) vst[i] = *(const u32x4*)(VT + (vo + (unsigned)(i * 16 * 512))); }
        f32x4 sacc[16];
#pragma unroll
        for (int mt = 0; mt < 16; ++mt) { sacc[mt] = (f32x4){0.f, 0.f, 0.f, 0.f};
#pragma unroll
            for (int s = 0; s < 8; ++s) { const bf16x8 kf = *(const LAS bf16x8*)(sKV + (16 * mt + fr) * 264 + 32 * s + 8 * kg); sacc[mt] = MFMA16(kf, qf[s], sacc[mt]); } }
        float mx = -INFINITY;
#pragma unroll
        for (int mt = 0; mt < 16; ++mt)
#pragma unroll
            for (int j = 0; j < 4; ++j) mx = fmaxf(mx, sacc[mt][j]);
        mx = fmaxf(mx, __shfl_xor(mx, 16)); mx = fmaxf(mx, __shfl_xor(mx, 32));
        float sum = 0.f;
#pragma unroll
        for (int mt = 0; mt < 16; ++mt)
#pragma unroll
            for (int j = 0; j < 4; ++j) { const float e = __expf((sacc[mt][j] - mx) * 0.0625f); sacc[mt][j] = e; sum += e; }
        sum += __shfl_xor(sum, 16); sum += __shfl_xor(sum, 32);
        const float inv = 1.f / sum;
        bf16x8 pf[8];
#pragma unroll
        for (int s2 = 0; s2 < 8; ++s2) { u32x4 w; w.x = pk2(sacc[2 * s2][0], sacc[2 * s2][1]); w.y = pk2(sacc[2 * s2][2], sacc[2 * s2][3]);
            w.z = pk2(sacc[2 * s2 + 1][0], sacc[2 * s2 + 1][1]); w.w = pk2(sacc[2 * s2 + 1][2], sacc[2 * s2 + 1][3]); pf[s2] = __builtin_bit_cast(bf16x8, w); }
        __syncthreads();
#pragma unroll
        for (int i = 0; i < 16; ++i) *(LAS u32x4*)(sKV + ((tid >> 5) + 16 * i) * 264 + 8 * (tid & 31)) = vst[i];
        __syncthreads();
#pragma unroll 4
        for (int mt2 = 0; mt2 < 16; ++mt2) { f32x4 o = (f32x4){0.f, 0.f, 0.f, 0.f}; const LAS bf16_t* vr = sKV + (16 * mt2 + fr) * 264 + 4 * kg;
#pragma unroll
            for (int s2 = 0; s2 < 8; ++s2) { const u32x2 lo = *(const LAS u32x2*)(vr + 32 * s2), hi = *(const LAS u32x2*)(vr + 32 * s2 + 16);
                u32x4 w; w.x = lo.x; w.y = lo.y; w.z = hi.x; w.w = hi.y; o = MFMA16(__builtin_bit_cast(bf16x8, w), pf[s2], o); }
            u32x2 ow; ow.x = pk2(o[0] * inv, o[1] * inv); ow.y = pk2(o[2] * inv, o[3] * inv);
            if (!dry) *(u32x2*)(qrow + 16 * mt2 + 4 * kg) = ow; }
    }
}
template <bool FINAL> __device__ __forceinline__ void lru_phase(const Params& p, int b, LAS unsigned char* lds, int dry = 0) {
    const int tid = opq_tid(), lane = tid & 63, wave = tid >> 6, fr = lane & 15, kg = lane >> 4;
    bf16_t* P = proj_ptr(p);
    LAS bf16_t* sWA = (LAS bf16_t*)lds; LAS bf16_t* sWX = (LAS bf16_t*)(lds + 19968);
    LAS float* sCW = (LAS float*)(lds + 39936); LAS float* sCB = sCW + 384; LAS float* sBA = sCB + 96; LAS float* sBX = sBA + 96; LAS float* sSP = sBX + 96;
    LAS float* sXL = (LAS float*)(lds + 43008) + wave * 1600;
    LAS float* sAG = (LAS float*)(lds + 94208);
    float* agg = (float*)(wsb(p) + WS_LAGG) + (size_t)b * NBLK64 * LRUW * 2;
    const float* car = (const float*)(wsb(p) + WS_LCAR) + (size_t)b * NBLK64 * LRUW;
    const float* lcw = opq(p.lru_conv_w); const float* lcb = opq(p.lru_conv_b); const float* lba = opq(p.lru_b_a); const float* lbx = opq(p.lru_b_x); const float* lam = opq(p.lru_lambda);
    for (int u = opq_bid(); u < NLB * NSEG; u += gridDim.x) {
        const int n = u % NLB, sg = u / NLB;
        __syncthreads();
        { const bf16_t* gwa = (const bf16_t*)(wsb(p) + WS_LRUWA) + n * 9216; const bf16_t* gwx = (const bf16_t*)(wsb(p) + WS_LRUWX) + n * 9216;
          u32x4 wa3[3], wx3[3]; float cwv = 0.f, v4[4] = {0.f, 0.f, 0.f, 0.f};
#pragma unroll
          for (int i = 0; i < 3; ++i) { const int e = tid + 512 * i; if (e < 96 * 12) { const int j = e / 12, c8 = e % 12; wa3[i] = *(const u32x4*)(gwa + j * 96 + 8 * c8); wx3[i] = *(const u32x4*)(gwx + j * 96 + 8 * c8); } }
          if (tid < 384) cwv = lcw[(tid / 96) * 1536 + n * 96 + tid % 96];
          if (tid < 96) { v4[0] = lcb[n * 96 + tid]; v4[1] = lba[n * 96 + tid]; v4[2] = lbx[n * 96 + tid]; v4[3] = lam[n * 96 + tid]; }
#pragma unroll
          for (int i = 0; i < 3; ++i) { const int e = tid + 512 * i; if (e < 96 * 12) { const int j = e / 12, c8 = e % 12; *(LAS u32x4*)(sWA + j * 104 + 8 * c8) = wa3[i]; *(LAS u32x4*)(sWX + j * 104 + 8 * c8) = wx3[i]; } }
          if (tid < 384) sCW[tid] = cwv;
          if (tid < 96) { sCB[tid] = v4[0]; sBA[tid] = v4[1]; sBX[tid] = v4[2]; sSP[tid] = softplusf_(-v4[3]); } }
        __syncthreads();
        float runA[6], runH[6];
#pragma unroll
        for (int nt = 0; nt < 6; ++nt) { runA[nt] = 1.f; runH[nt] = FINAL ? car[(sg * 8 + wave) * LRUW + n * 96 + 16 * nt + fr] : 0.f; }
        for (int step = 0; step < 4; ++step) {
            const int tb = sg * LSEG + wave * 64 + step * 16;
            u32x4 rawC[3][4];
            { const int t0r = tb + fr - 3; unsigned ro = (unsigned)((t0r < 0 ? 0 : t0r) * LD + C_LX + n * 96 + 8 * kg); asm volatile("" : "+v"(ro));
              if (t0r >= 0) {
#pragma unroll
                  for (int ks = 0; ks < 3; ++ks)
#pragma unroll
                      for (int k = 0; k < 4; ++k) rawC[ks][k] = *(const u32x4*)(P + (ro + (unsigned)(k * LD + 32 * ks)));
              } else {
#pragma unroll
                  for (int ks = 0; ks < 3; ++ks)
#pragma unroll
                      for (int k = 0; k < 4; ++k) { const int t = t0r + k; rawC[ks][k] = *(const u32x4*)(P + (ro + (unsigned)((t < 0 ? 0 : t) * LD + 32 * ks))); if (t < 0) rawC[ks][k] = (u32x4){0u, 0u, 0u, 0u}; }
              } }
            bf16x8 af[3];
#pragma unroll
            for (int ks = 0; ks < 3; ++ks) { const int ch0 = 32 * ks + 8 * kg; float xl[8];
#pragma unroll
                for (int i = 0; i < 8; ++i) xl[i] = sCB[ch0 + i];
#pragma unroll
                for (int k = 0; k < 4; ++k) { const u32x4 raw = rawC[ks][k];
                    float rv[8]; unpack8(raw, rv);
#pragma unroll
                    for (int i = 0; i < 8; ++i) xl[i] += sCW[k * 96 + ch0 + i] * rv[i]; }
                *(LAS f32x4*)(sXL + fr * 100 + ch0) = (f32x4){xl[0], xl[1], xl[2], xl[3]}; *(LAS f32x4*)(sXL + fr * 100 + ch0 + 4) = (f32x4){xl[4], xl[5], xl[6], xl[7]};
                af[ks] = pack8(xl); }
            LAS bf16_t* sG = (LAS bf16_t*)((LAS unsigned char*)sWA + 106496) + wave * 1536;
            unsigned go3[3]; u32x4 graw[3];
            if (FINAL) {
#pragma unroll
                for (int i = 0; i < 3; ++i) { const int e = lane + 64 * i, row = e / 12, c12 = e % 12; go3[i] = (unsigned)((tb + row) * LD + C_LG + n * 96 + 8 * c12); }
                asm volatile("" : "+v"(go3[0]), "+v"(go3[1]), "+v"(go3[2]));
#pragma unroll
                for (int i = 0; i < 3; ++i) graw[i] = *(const u32x4*)(P + go3[i]); }
            f32x4 aR[6], aI[6];
#pragma unroll
            for (int nt = 0; nt < 6; ++nt) { aR[nt] = (f32x4){0.f, 0.f, 0.f, 0.f}; aI[nt] = (f32x4){0.f, 0.f, 0.f, 0.f};
#pragma unroll
                for (int ks = 0; ks < 3; ++ks) { const bf16x8 wa = *(const LAS bf16x8*)(sWA + (16 * nt + fr) * 104 + 32 * ks + 8 * kg), wx = *(const LAS bf16x8*)(sWX + (16 * nt + fr) * 104 + 32 * ks + 8 * kg);
                    aR[nt] = MFMA16(af[ks], wa, aR[nt]); aI[nt] = MFMA16(af[ks], wx, aI[nt]); } }
            float Ainc[6][4], Hinc[6][4];
#pragma unroll
            for (int nt = 0; nt < 6; ++nt) { const int j = 16 * nt + fr; const float ba2 = -1.44269504f * sBA[j], bx2 = -1.44269504f * sBX[j], spc = -8.f * 1.44269504f * sSP[j];
                float A = 1.f, H = 0.f;
#pragma unroll
                for (int r = 0; r < 4; ++r) { const float xlv = sXL[(4 * kg + r) * 100 + j];
                    const float rr = __builtin_amdgcn_rcpf(1.f + __builtin_amdgcn_exp2f(fmaf(aR[nt][r], -1.44269504f, ba2))), ii = __builtin_amdgcn_rcpf(1.f + __builtin_amdgcn_exp2f(fmaf(aI[nt][r], -1.44269504f, bx2)));
                    const float a = __builtin_amdgcn_exp2f(rr * spc), mult = __builtin_amdgcn_sqrtf(fmaxf(0.f, fmaf(-a, a, 1.f)));
                    H = a * H + mult * ii * xlv; A *= a; Ainc[nt][r] = A; Hinc[nt][r] = H; }
                float ap = 1.f, hp = 0.f, at = 1.f, ht = 0.f;
#pragma unroll
                for (int k = 0; k < 4; ++k) { const float ab = __shfl(A, fr + 16 * k), hb = __shfl(H, fr + 16 * k);
                    if (k < kg) { hp = ab * hp + hb; ap *= ab; } ht = ab * ht + hb; at *= ab; }
                if (FINAL) { const float hin = ap * runH[nt] + hp;
#pragma unroll
                    for (int r = 0; r < 4; ++r) Hinc[nt][r] = Ainc[nt][r] * hin + Hinc[nt][r]; }
                runH[nt] = at * runH[nt] + ht; runA[nt] *= at; }
            if (FINAL) {
#pragma unroll
                for (int i = 0; i < 3; ++i) { const int e = lane + 64 * i; *(LAS u32x4*)(sG + (e / 12) * 96 + 8 * (e % 12)) = graw[i]; }
                asm volatile("s_waitcnt lgkmcnt(0)" ::: "memory");
#pragma unroll
                for (int nt = 0; nt < 6; ++nt)
#pragma unroll
                    for (int r = 0; r < 4; ++r) { LAS bf16_t* gp = sG + (4 * kg + r) * 96 + 16 * nt + fr; const float yv = Hinc[nt][r] * siluf_(bf2f(*gp)); *gp = (bf16_t)f2bf(yv); }
                asm volatile("s_waitcnt lgkmcnt(0)" ::: "memory");
#pragma unroll
                for (int i = 0; i < 3; ++i) { const int e = lane + 64 * i; const u32x4 w = *(const LAS u32x4*)(sG + (e / 12) * 96 + 8 * (e % 12)); if (!dry) *(u32x4*)(P + go3[i]) = w; }
                asm volatile("s_waitcnt lgkmcnt(0)" ::: "memory"); }
        }
        if (!FINAL && kg == 0) {
#pragma unroll
            for (int nt = 0; nt < 6; ++nt) { const int ch = n * 96 + 16 * nt + fr; agg[((size_t)(sg * 8 + wave) * LRUW + ch) * 2] = runA[nt]; agg[((size_t)(sg * 8 + wave) * LRUW + ch) * 2 + 1] = runH[nt]; } }
    }
}
__device__ __forceinline__ void lru_carry_phase(const Params& p, int b) {
    const int gt = opq_bid() * 512 + opq_tid();
    const float* agg = (const float*)(wsb(p) + WS_LAGG) + (size_t)b * NBLK64 * LRUW * 2; float* car = (float*)(wsb(p) + WS_LCAR) + (size_t)b * NBLK64 * LRUW;
    for (int ch = gt; ch < LRUW; ch += gridDim.x * 512) { float h = 0.f;
        for (int k0 = 0; k0 < NBLK64; k0 += 16) { float a[16], hh[16];
#pragma unroll
            for (int i = 0; i < 16; ++i) { a[i] = agg[((size_t)(k0 + i) * LRUW + ch) * 2]; hh[i] = agg[((size_t)(k0 + i) * LRUW + ch) * 2 + 1]; }
#pragma unroll
            for (int i = 0; i < 16; ++i) { car[(k0 + i) * LRUW + ch] = h; h = a[i] * h + hh[i]; } } }
}
__device__ __forceinline__ void conv8_silu(const bf16_t* P, int t, int col, const float* cw, const float* cb, int ch, float (&o)[8]) {
    float r[11];
    unsigned off0 = (unsigned)((t < 3 ? 0 : t - 3) * LD + col); asm volatile("" : "+v"(off0));
    if (t >= 3) {
#pragma unroll
        for (int i = 0; i < 11; ++i) r[i] = bf2f(P[off0 + (unsigned)(i * LD)]);
    } else {
#pragma unroll
        for (int i = 0; i < 11; ++i) { const int tt = t - 3 + i; const float v = bf2f(P[off0 + (unsigned)((tt < 0 ? 0 : tt) * LD)]); r[i] = tt < 0 ? 0.f : v; }
    }
    const float w0 = cw[ch], w1 = cw[3072 + ch], w2 = cw[6144 + ch], w3 = cw[9216 + ch], bb = cb[ch];
#pragma unroll
    for (int j = 0; j < 8; ++j) o[j] = siluf_(bb + w0 * r[j] + w1 * r[j + 1] + w2 * r[j + 2] + w3 * r[j + 3]);
}
__device__ __forceinline__ float ssd_dt_setup(const Params& p, const bf16_t* P, int t0, int h, int lane, LAS float* sACS, LAS float* sDT) {
    const float dtb = opq(p.ssd_dt_bias)[h], an = -__expf(opq(p.ssd_a_log)[h]);
    const float dt0 = softplusf_(bf2f(P[(size_t)(t0 + 2 * lane) * LD + C_DT + h]) + dtb), dt1 = softplusf_(bf2f(P[(size_t)(t0 + 2 * lane + 1) * LD + C_DT + h]) + dtb);
    const float dA1 = dt1 * an; float s = dt0 * an + dA1;
#pragma unroll
    for (int o = 1; o < 64; o <<= 1) { const float t = __shfl_up(s, o); if (lane >= o) s += t; }
    sACS[2 * lane] = s - dA1; sACS[2 * lane + 1] = s; sDT[2 * lane] = dt0; sDT[2 * lane + 1] = dt1;
    return __shfl(s, 63);
}
template <int R> __device__ __forceinline__ void conv_rows(const bf16_t* P, int t, int col, const float* cw, const float* cb, int ch, float (&o)[R][8]) {
    unsigned off0 = (unsigned)((t < 3 ? 0 : t - 3) * LD + col); asm volatile("" : "+v"(off0));
    u32x4 raw[R + 3];
    if (t >= 3) {
#pragma unroll
        for (int i = 0; i < R + 3; ++i) raw[i] = *(const u32x4*)(P + (off0 + (unsigned)(i * LD)));
    } else {
#pragma unroll
        for (int i = 0; i < R + 3; ++i) { const int tt = t - 3 + i; raw[i] = *(const u32x4*)(P + (off0 + (unsigned)((tt < 0 ? 0 : tt) * LD))); if (tt < 0) raw[i] = (u32x4){0u, 0u, 0u, 0u}; }
    }
    float w[4][8], bb[8];
#pragma unroll
    for (int k = 0; k < 4; ++k) { const f32x4 w0 = *(const f32x4*)(cw + k * 3072 + ch), w1 = *(const f32x4*)(cw + k * 3072 + ch + 4);
        w[k][0] = w0[0]; w[k][1] = w0[1]; w[k][2] = w0[2]; w[k][3] = w0[3]; w[k][4] = w1[0]; w[k][5] = w1[1]; w[k][6] = w1[2]; w[k][7] = w1[3]; }
    { const f32x4 b0 = *(const f32x4*)(cb + ch), b1 = *(const f32x4*)(cb + ch + 4); bb[0] = b0[0]; bb[1] = b0[1]; bb[2] = b0[2]; bb[3] = b0[3]; bb[4] = b1[0]; bb[5] = b1[1]; bb[6] = b1[2]; bb[7] = b1[3]; }
#pragma unroll
    for (int r = 0; r < R; ++r)
#pragma unroll
        for (int q = 0; q < 8; ++q) o[r][q] = bb[q];
#pragma unroll
    for (int i = 0; i < R + 3; ++i) { float v[8]; unpack8(raw[i], v);
#pragma unroll
        for (int k = 0; k < 4; ++k) { const int r = i - k; if (r >= 0 && r < R) {
#pragma unroll
                for (int q = 0; q < 8; ++q) o[r][q] += w[k][q] * v[q]; } } }
#pragma unroll
    for (int r = 0; r < R; ++r)
#pragma unroll
        for (int q = 0; q < 8; ++q) o[r][q] = siluf_(o[r][q]);
}
__device__ __forceinline__ void ssd_states_phase(const Params& p, int b, LAS unsigned char* lds) {
    const int tid = opq_tid(), lane = tid & 63, wave = tid >> 6, fr = lane & 15, kg = lane >> 4;
    const bf16_t* P = proj_ptr(p); bf16_t* ST = states_ptr(p, b); float* dasum = (float*)(wsb(p) + WS_DASUM) + b * NCHUNK * NHEAD;
    const float* cw = opq(p.ssd_conv_w); const float* cb = opq(p.ssd_conv_b);
    LAS bf16_t* sBT = (LAS bf16_t*)lds; LAS bf16_t* sXT = (LAS bf16_t*)(lds + 34816 + wave * 8704);
    LAS float* sACS = (LAS float*)(lds + 104448) + wave * 128; LAS float* sW = (LAS float*)(lds + 108544) + wave * 128;
    for (int u = opq_bid(); u < NCHUNK * NGRP; u += gridDim.x) {
        const int c = u >> 2, g = u & 3, t0 = c * CHUNK, h = 8 * g + wave;
        __syncthreads();
        { const float tot = ssd_dt_setup(p, P, t0, h, lane, sACS, sW);
          if (lane == 0) dasum[c * NHEAD + h] = tot;
          sW[2 * lane] = sW[2 * lane] * __expf(tot - sACS[2 * lane]); sW[2 * lane + 1] = sW[2 * lane + 1] * __expf(tot - sACS[2 * lane + 1]); }
        { const int cg = tid & 15, rs = tid >> 4; float o[4][8];
          conv_rows<4>(P, t0 + 4 * rs, C_B + g * 128 + 8 * cg, cw, cb, 2048 + g * 128 + 8 * cg, o);
#pragma unroll
          for (int q = 0; q < 8; ++q) { u32x2 w; w.x = pk2(o[0][q], o[1][q]); w.y = pk2(o[2][q], o[3][q]); *(LAS u32x2*)(sBT + (8 * cg + q) * 136 + 4 * rs) = w; } }
        __syncthreads();
        for (int ph = 0; ph < 2; ++ph) {
            { const int cg = lane & 3, rs = lane >> 2; float o[8][8];
              conv_rows<8>(P, t0 + 8 * rs, C_X + h * 64 + 32 * ph + 8 * cg, cw, cb, h * 64 + 32 * ph + 8 * cg, o);
              const f32x4 w0 = *(const LAS f32x4*)(sW + 8 * rs), w1 = *(const LAS f32x4*)(sW + 8 * rs + 4);
#pragma unroll
              for (int q = 0; q < 8; ++q) { float v[8] = {o[0][q] * w0[0], o[1][q] * w0[1], o[2][q] * w0[2], o[3][q] * w0[3], o[4][q] * w1[0], o[5][q] * w1[1], o[6][q] * w1[2], o[7][q] * w1[3]};
                  *(LAS bf16x8*)(sXT + (8 * cg + q) * 136 + 8 * rs) = pack8(v); } }
            asm volatile("s_waitcnt lgkmcnt(0)" ::: "memory");
            f32x4 acc[8][2];
#pragma unroll
            for (int mt = 0; mt < 8; ++mt) { acc[mt][0] = (f32x4){0.f, 0.f, 0.f, 0.f}; acc[mt][1] = (f32x4){0.f, 0.f, 0.f, 0.f}; }
#pragma unroll
            for (int s = 0; s < 4; ++s) { const bf16x8 x0 = *(const LAS bf16x8*)(sXT + fr * 136 + 32 * s + 8 * kg), x1 = *(const LAS bf16x8*)(sXT + (16 + fr) * 136 + 32 * s + 8 * kg);
#pragma unroll
                for (int mt = 0; mt < 8; ++mt) { const bf16x8 a = *(const LAS bf16x8*)(sBT + (16 * mt + fr) * 136 + 32 * s + 8 * kg);
                    acc[mt][0] = MFMA16(a, x0, acc[mt][0]); acc[mt][1] = MFMA16(a, x1, acc[mt][1]); } }
            asm volatile("s_waitcnt lgkmcnt(0)" ::: "memory");
#pragma unroll
            for (int mt = 0; mt < 8; ++mt)
#pragma unroll
                for (int nt = 0; nt < 2; ++nt) { const int n0 = 16 * mt + 4 * kg, pp = 32 * ph + 16 * nt + fr;
                    u32x2 w; w.x = pk2(acc[mt][nt][0], acc[mt][nt][1]); w.y = pk2(acc[mt][nt][2], acc[mt][nt][3]);
                    *(u32x2*)(ST + ((size_t)(c * NHEAD + h) * 64 + pp) * 128 + n0) = w; }
        }
    }
}
__device__ __forceinline__ void ssd_scan_phase(const Params& p, int b, int dry = 0) {
    unsigned* st = (unsigned*)states_ptr(p, b); const float* dasum = (const float*)(wsb(p) + WS_DASUM) + b * NCHUNK * NHEAD;
    for (int e2 = opq_bid() * 512 + opq_tid(); e2 < 131072; e2 += gridDim.x * 512) {
        const int h = e2 >> 12; float r0 = 0.f, r1 = 0.f;
        for (int c0 = 0; c0 < NCHUNK; c0 += 16) { unsigned v[16]; float d[16];
#pragma unroll
            for (int i = 0; i < 16; ++i) { v[i] = st[(size_t)(c0 + i) * 131072 + e2]; d[i] = dasum[(c0 + i) * NHEAD + h]; }
#pragma unroll
            for (int i = 0; i < 16; ++i) { const unsigned w = pk2(r0, r1); const float dd = __expf(d[i]);
                r0 = r0 * dd + __uint_as_float(v[i] << 16); r1 = r1 * dd + __uint_as_float(v[i] & 0xffff0000u); v[i] = w; }
            if (!dry) {
#pragma unroll
                for (int i = 0; i < 16; ++i) st[(size_t)(c0 + i) * 131072 + e2] = v[i]; } }
    }
}
__device__ __forceinline__ void ssd_out_phase(const Params& p, int b, LAS unsigned char* lds, int dry = 0) {
    const int tid = opq_tid(), lane = tid & 63, wave = tid >> 6, fr = lane & 15, kg = lane >> 4;
    bf16_t* P = proj_ptr(p); const bf16_t* ST = states_ptr(p, b);
    const float* cw = opq(p.ssd_conv_w); const float* cb = opq(p.ssd_conv_b);
    LAS bf16_t* sC = (LAS bf16_t*)lds; LAS bf16_t* sCB = (LAS bf16_t*)(lds + 34816); LAS bf16_t* sB = (LAS bf16_t*)(lds + 69632); LAS bf16_t* sXT = (LAS bf16_t*)(lds + 69632 + wave * 8704);
    LAS float* sACS = (LAS float*)(lds + 139264) + wave * 128; LAS float* sDT = (LAS float*)(lds + 143360) + wave * 128; LAS float* sSSQ = (LAS float*)(lds + 147456);
    for (int u = opq_bid(); u < NCHUNK * NGRP; u += gridDim.x) {
        const int c = u >> 2, g = u & 3, t0 = c * CHUNK, h = 8 * g + wave;
        __syncthreads();
        MSTAMP(p, 0);
        (void)ssd_dt_setup(p, P, t0, h, lane, sACS, sDT);
        { const int cg = tid & 15, rs = (tid >> 4) & 15, isC = tid >> 8; float o[8][8];
          conv_rows<8>(P, t0 + 8 * rs, C_B + isC * 512 + g * 128 + 8 * cg, cw, cb, 2048 + isC * 512 + g * 128 + 8 * cg, o);
          LAS bf16_t* dst = (isC ? sC : sB) + (8 * rs) * 136 + 8 * cg;
#pragma unroll
          for (int r = 0; r < 8; ++r) *(LAS bf16x8*)(dst + r * 136) = pack8(o[r]); }
        __syncthreads();
#pragma unroll
        for (int ms = 0; ms < 8; ++ms) if (ms <= wave) { f32x4 a4 = (f32x4){0.f, 0.f, 0.f, 0.f};
#pragma unroll
            for (int kn = 0; kn < 4; ++kn) { const bf16x8 a = *(const LAS bf16x8*)(sB + (16 * ms + fr) * 136 + 32 * kn + 8 * kg), bb = *(const LAS bf16x8*)(sC + (16 * wave + fr) * 136 + 32 * kn + 8 * kg);
                a4 = MFMA16(a, bb, a4); }
            u32x2 w; w.x = pk2(a4[0], a4[1]); w.y = pk2(a4[2], a4[3]);
            *(LAS u32x2*)(sCB + (16 * wave + fr) * 136 + 16 * ms + 4 * kg) = w; }
        __syncthreads();
        MSTAMP(p, 1);
        const float Dh = opq(p.ssd_d)[h];
        const unsigned zbase0 = (unsigned)((t0 + fr) * LD + C_Z + h * 64 + 4 * kg);
        float ssq[8];
#pragma unroll
        for (int nt = 0; nt < 8; ++nt) ssq[nt] = 0.f;
        for (int ph = 0; ph < 2; ++ph) {
            unsigned zb = zbase0 + 32u * ph; asm volatile("" : "+v"(zb));
            unsigned pfo = (unsigned)(((c * NHEAD + h) * 64 + 32 * ph + fr) * 128 + 8 * kg); asm volatile("" : "+v"(pfo));
            bf16x8 pf[4][2];
#pragma unroll
            for (int sn = 0; sn < 4; ++sn) { pf[sn][0] = *(const bf16x8*)(ST + (pfo + (unsigned)(32 * sn))); pf[sn][1] = *(const bf16x8*)(ST + (pfo + (unsigned)(16 * 128 + 32 * sn))); }
            { const int cg = lane & 3, rs = lane >> 2; float o[8][8];
              conv_rows<8>(P, t0 + 8 * rs, C_X + h * 64 + 32 * ph + 8 * cg, cw, cb, h * 64 + 32 * ph + 8 * cg, o);
#pragma unroll
              for (int q = 0; q < 8; ++q) { float v[8] = {o[0][q], o[1][q], o[2][q], o[3][q], o[4][q], o[5][q], o[6][q], o[7][q]};
                  *(LAS bf16x8*)(sXT + (8 * cg + q) * 136 + 8 * rs) = pack8(v); } }
            asm volatile("s_waitcnt lgkmcnt(0)" ::: "memory");
            f32x4 acc[2][8];
#pragma unroll
            for (int nt = 0; nt < 8; ++nt) { acc[0][nt] = (f32x4){0.f, 0.f, 0.f, 0.f}; acc[1][nt] = (f32x4){0.f, 0.f, 0.f, 0.f}; }
#pragma unroll
            for (int nt = 0; nt < 8; ++nt) {
#pragma unroll
                for (int sn = 0; sn < 4; ++sn) { const bf16x8 cf = *(const LAS bf16x8*)(sC + (16 * nt + fr) * 136 + 32 * sn + 8 * kg);
                    acc[0][nt] = MFMA16(pf[sn][0], cf, acc[0][nt]); acc[1][nt] = MFMA16(pf[sn][1], cf, acc[1][nt]); }
                const float sc = __expf(sACS[16 * nt + fr]);
                acc[0][nt] *= sc; acc[1][nt] *= sc; }
#pragma unroll
            for (int sk = 0; sk < 4; ++sk) {
                const int s0 = 32 * sk + 8 * kg;
                const bf16x8 xa0 = *(const LAS bf16x8*)(sXT + fr * 136 + s0), xa1 = *(const LAS bf16x8*)(sXT + (16 + fr) * 136 + s0);
                const f32x4 as0 = *(const LAS f32x4*)(sACS + s0), as1 = *(const LAS f32x4*)(sACS + s0 + 4), d0 = *(const LAS f32x4*)(sDT + s0), d1 = *(const LAS f32x4*)(sDT + s0 + 4);
#pragma unroll
                for (int nt = 0; nt < 8; ++nt) if (nt >= 2 * sk) { const int l = 16 * nt + fr; const float acsl = sACS[l];
                    float cbv[8]; unpack8(*(const LAS u32x4*)(sCB + l * 136 + s0), cbv);
                    float m[8];
#pragma unroll
                    for (int i = 0; i < 8; ++i) { const int s = s0 + i; const float as = i < 4 ? as0[i & 3] : as1[i & 3], ds = i < 4 ? d0[i & 3] : d1[i & 3];
                        float mv = (s <= l) ? cbv[i] * __expf(acsl - as) * ds : 0.f; if (s == l) mv += Dh; m[i] = mv; }
                    const bf16x8 mb = pack8(m);
                    acc[0][nt] = MFMA16(xa0, mb, acc[0][nt]); acc[1][nt] = MFMA16(xa1, mb, acc[1][nt]);
                    asm volatile("" ::: "memory"); }
            }
            u32x2 zall[8][2];
#pragma unroll
            for (int nt = 0; nt < 8; ++nt)
#pragma unroll
                for (int mt = 0; mt < 2; ++mt) zall[nt][mt] = *(const u32x2*)(P + (zb + (unsigned)(16 * nt * LD + 16 * mt)));
#pragma unroll
            for (int nt = 0; nt < 8; ++nt)
#pragma unroll
                for (int mt = 0; mt < 2; ++mt) { u32x2* zp = (u32x2*)(P + (zb + (unsigned)(16 * nt * LD + 16 * mt)));
                    const u32x2 zw = zall[nt][mt]; float y[4];
                    y[0] = acc[mt][nt][0] * siluf_(__uint_as_float(zw.x << 16)); y[1] = acc[mt][nt][1] * siluf_(__uint_as_float(zw.x & 0xffff0000u));
                    y[2] = acc[mt][nt][2] * siluf_(__uint_as_float(zw.y << 16)); y[3] = acc[mt][nt][3] * siluf_(__uint_as_float(zw.y & 0xffff0000u));
                    ssq[nt] += (y[0] * y[0] + y[1] * y[1]) + (y[2] * y[2] + y[3] * y[3]);
                    u32x2 yw; yw.x = pk2(y[0], y[1]); yw.y = pk2(y[2], y[3]); (void)zp; *(LAS u32x2*)(sXT + (16 * nt + fr) * 32 + 16 * mt + 4 * kg) = yw; }
            asm volatile("s_waitcnt lgkmcnt(0)" ::: "memory");
            { const int rr = lane >> 2, cc = lane & 3;
              unsigned so = (unsigned)((t0 + rr) * LD + C_Z + h * 64 + 32 * ph + 8 * cc); asm volatile("" : "+v"(so));
              if (ph == 0) {
#pragma unroll
                  for (int i = 0; i < 8; ++i) { const u32x4 w = *(const LAS u32x4*)(sXT + (16 * i + rr) * 32 + 8 * cc); if (!dry) *(u32x4*)(P + (so + (unsigned)(16 * i * LD))) = w; } } }
            asm volatile("s_waitcnt lgkmcnt(0)" ::: "memory");
        }
        MSTAMP(p, 2);
#pragma unroll
        for (int nt = 0; nt < 8; ++nt) { float v = ssq[nt]; v += __shfl_xor(v, 16); v += __shfl_xor(v, 32); if (kg == 0) sSSQ[wave * 128 + 16 * nt + fr] = v; }
        __syncthreads();
        { const int rr = lane >> 2, cc = lane & 3;
          const float* ng = opq(p.ssd_norm_g) + g * 512 + wave * 64 + 8 * cc;
          f32x4 gg[2][2];
#pragma unroll
          for (int ph = 0; ph < 2; ++ph) { gg[ph][0] = *(const f32x4*)(ng + 32 * ph); gg[ph][1] = *(const f32x4*)(ng + 32 * ph + 4); }
          unsigned so = (unsigned)((t0 + rr) * LD + C_Z + h * 64 + 8 * cc); asm volatile("" : "+v"(so));
          u32x4 yv[8][2];
#pragma unroll
          for (int i = 0; i < 8; ++i)
#pragma unroll
              for (int ph = 0; ph < 2; ++ph) yv[i][ph] = ph == 0 ? *(const u32x4*)(P + (so + (unsigned)(16 * i * LD))) : *(const LAS u32x4*)(sXT + (16 * i + rr) * 32 + 8 * cc);
#pragma unroll
          for (int i = 0; i < 8; ++i) { const int l = 16 * i + rr; float tot = 0.f;
#pragma unroll
              for (int w2 = 0; w2 < 8; ++w2) tot += sSSQ[w2 * 128 + l];
              const float rs = 1.f / sqrtf(tot * (1.f / 512.f) + EPS);
#pragma unroll
              for (int ph = 0; ph < 2; ++ph) { float v[8]; unpack8(yv[i][ph], v);
                  v[0] *= rs * gg[ph][0][0]; v[1] *= rs * gg[ph][0][1]; v[2] *= rs * gg[ph][0][2]; v[3] *= rs * gg[ph][0][3];
                  v[4] *= rs * gg[ph][1][0]; v[5] *= rs * gg[ph][1][1]; v[6] *= rs * gg[ph][1][2]; v[7] *= rs * gg[ph][1][3];
                  if (!dry) *(bf16x8*)(P + (so + (unsigned)(16 * i * LD + 32 * ph))) = pack8(v); } } }
        MSTAMP(p, 3);
    }
}
#define XB_TMO      128
#define XB_XCNT(j)  (256  + 64 * (j))
#define XB_XSUB(j)  (1280 + 64 * (j))
#define XB_XGEN(j)  (2304 + 64 * (j))
#define XB_TOP      3328
#define XB_TOPGEN   3392
#define XCD_BAR_WORDS 3456
#define XB_SPIN_CAP (1u << 18)

__device__ __forceinline__ unsigned xb_ld(unsigned* p)              { return __hip_atomic_load(p, __ATOMIC_RELAXED, __HIP_MEMORY_SCOPE_AGENT); }
__device__ __forceinline__ unsigned xb_add(unsigned* p, unsigned v) { return __hip_atomic_fetch_add(p, v, __ATOMIC_RELAXED, __HIP_MEMORY_SCOPE_AGENT); }
__device__ __forceinline__ unsigned xb_xcc_id() { return (unsigned)__builtin_amdgcn_s_getreg((3 << 11) | 20) & 0xFu; }
#define XB_SPIN(cond, bar) do { unsigned _sp = 0; while (cond) { __builtin_amdgcn_s_sleep(1); \
    if ((++_sp & 255u) == 0u) { if (xb_ld(&(bar)[XB_TMO])) break; if (_sp > XB_SPIN_CAP) { atomicAdd(&(bar)[XB_TMO], 1u); break; } } } } while (0)

struct XcdBarrier {
    unsigned* bar; unsigned x;
    volatile LAS unsigned* st;
};

__device__ __forceinline__ XcdBarrier xcd_barrier_post(unsigned* bar, volatile LAS unsigned* st) {
    XcdBarrier b; b.bar = bar; b.x = xb_xcc_id(); b.st = st;
    if (threadIdx.x == 0) (void)xb_add(&bar[XB_XCNT(b.x)], 1u);
    return b;
}
__device__ __forceinline__ void xcd_barrier_complete(unsigned* bar, unsigned x, unsigned& nloc, unsigned& nx) {
    const unsigned G = gridDim.x * gridDim.y * gridDim.z;
    unsigned sum, cnt, mine, sp = 0u;
    for (;;) {
        sum = 0u; cnt = 0u; mine = 0u;
#pragma unroll
        for (unsigned j = 0; j < 16; ++j) { const unsigned c = xb_ld(&bar[XB_XCNT(j)]); sum += c; cnt += (c > 0u) ? 1u : 0u; mine = (j == x) ? c : mine; }
        if (sum == G) break;
        __builtin_amdgcn_s_sleep(1);
        if ((++sp & 255u) == 0u) { if (xb_ld(&bar[XB_TMO])) break; if (sp > XB_SPIN_CAP) { atomicAdd(&bar[XB_TMO], 1u); break; } }
    }
    nloc = mine > 0u ? mine : 1u; nx = cnt > 0u ? cnt : 1u;
}

__device__ __forceinline__ void xcd_barrier(const XcdBarrier& b) {
    asm volatile("s_waitcnt vmcnt(0)" ::: "memory");
    __syncthreads();
    if (threadIdx.x == 0) {
        unsigned* bar = b.bar; asm volatile("" : "+s"(bar));
        unsigned bx = b.x; asm volatile("" : "+s"(bx));
        __builtin_amdgcn_s_waitcnt(0);
        unsigned nloc = b.st[0], nx = b.st[1];
        if (nloc == 0u) { xcd_barrier_complete(bar, bx, nloc, nx); b.st[0] = nloc; b.st[1] = nx; }
        const unsigned old = xb_add(&bar[XB_XSUB(bx)], 1u);
        const unsigned gen = old / nloc;
        if (old + 1u == (gen + 1u) * nloc) {
            __builtin_amdgcn_fence(__ATOMIC_RELEASE, "agent");
            asm volatile("s_waitcnt vmcnt(0)" ::: "memory");
            const unsigned og = xb_add(&bar[XB_TOP], 1u);
            const unsigned tg = og / nx;
            if (og + 1u == (tg + 1u) * nx) xb_add(&bar[XB_TOPGEN], 1u);
            else XB_SPIN(xb_ld(&bar[XB_TOPGEN]) == tg, bar);
            __builtin_amdgcn_fence(__ATOMIC_ACQUIRE, "agent");
            xb_add(&bar[XB_XGEN(bx)], 1u);
            asm volatile("s_waitcnt vmcnt(0)" ::: "memory");
        } else {
            XB_SPIN(xb_ld(&bar[XB_XGEN(bx)]) == gen, bar);
            __builtin_amdgcn_fence(__ATOMIC_ACQUIRE, "agent");
            asm volatile("s_waitcnt vmcnt(0)" ::: "memory");
        }
    }
    __syncthreads();
}

#ifdef REP_COLD
#define REP_SEP() xcd_barrier(bar)
#else
#define REP_SEP() __syncthreads()
#endif
#define RUNP(n, ...) do { if ((n) > 1) { for (int r_ = nrep(n) - 1; r_ > 0; --r_) { const int dry_ = 1; (void)dry_; __VA_ARGS__; REP_SEP(); } } { const int dry_ = 0; (void)dry_; __VA_ARGS__; } } while (0)
#ifndef REP_SYNC
#define REP_SYNC 1
#endif
#ifndef REP_P0
#define REP_P0 1
#endif
#ifndef REP_P1
#define REP_P1 1
#endif
#ifndef REP_P5
#define REP_P5 1
#endif
#ifndef REP_P6
#define REP_P6 1
#endif
#ifndef REP_ST
#define REP_ST 1
#endif
#ifndef REP_LA
#define REP_LA 1
#endif
#ifndef REP_AT
#define REP_AT 1
#endif
#ifndef REP_SC
#define REP_SC 1
#endif
#ifndef REP_SO
#define REP_SO 1
#endif
#ifndef REP_LF
#define REP_LF 1
#endif
__device__ __forceinline__ int nrep(int n) { asm volatile("" : "+s"(n)); return n; }
__device__ __forceinline__ LAS unsigned char* opl(LAS unsigned char* q) { asm volatile("" : "+s"(q)); return q; }
__global__ void __launch_bounds__(512) mk(Params p) {
    extern __shared__ __attribute__((aligned(16))) unsigned char lds_raw[];
    LAS unsigned char* lds = (LAS unsigned char*)lds_raw;
    if (threadIdx.x < 4) ((volatile LAS unsigned*)(lds + LDS_BYTES - 16))[threadIdx.x] = 0u;
    __syncthreads();
    const XcdBarrier bar = xcd_barrier_post((unsigned*)(p.ws + WS_CTL), (volatile LAS unsigned*)(lds + LDS_BYTES - 16));
    if (p.hi > 1000) cg::this_grid().sync();
#ifdef PROBE_SPAN
    unsigned long long ts0 = 0, ts1 = 0;
#define STAMP(i) do { if ((i) == PROBE_SPAN) ts0 = __builtin_amdgcn_s_memrealtime(); if ((i) == PROBE_SPAN + PROBE_LEN) ts1 = __builtin_amdgcn_s_memrealtime(); } while (0)
#else
#define STAMP(i) do { } while (0)
#endif
    STAMP(0);
    RUNP(REP_P0, phase0(p, opl(lds)));
    xcd_barrier(bar); STAMP(1);
#define BATCH_PHASES(b) do { \
        RUNP(REP_P1, phase1_gemm(p, b, opl(lds))); \
        for (int r = 0; r < nrep(REP_SYNC); ++r) xcd_barrier(bar); \
        STAMP(2 + 6 * b); \
        RUNP(REP_ST, ssd_states_phase(p, b, opl(lds))); \
        __syncthreads(); STAMP(20 + 3 * b); \
        RUNP(REP_LA, lru_phase<false>(p, b, opl(lds), 0)); \
        __syncthreads(); STAMP(21 + 3 * b); \
        RUNP(REP_AT, attn_phase(p, b, opl(lds), dry_)); \
        xcd_barrier(bar); STAMP(3 + 6 * b); \
        RUNP(REP_SC, ssd_scan_phase(p, b, dry_)); \
        lru_carry_phase(p, b); \
        xcd_barrier(bar); STAMP(4 + 6 * b); \
        RUNP(REP_SO, ssd_out_phase(p, b, opl(lds), dry_)); \
        __syncthreads(); STAMP(22 + 3 * b); \
        RUNP(REP_LF, lru_phase<true>(p, b, opl(lds), dry_)); \
        xcd_barrier(bar); STAMP(5 + 6 * b); \
        RUNP(REP_P5, phase5_gemm(p, b, opl(lds))); \
        xcd_barrier(bar); STAMP(6 + 6 * b); \
        RUNP(REP_P6, phase6_gemm(p, b, opl(lds))); \
        if (b + 1 < NBATCH && gridDim.x != 256) xcd_barrier(bar);     \
        STAMP(7 + 6 * b); \
    } while (0)
    BATCH_PHASES(0);
    BATCH_PHASES(1);
#ifdef PROBE_MA
    if (blockIdx.x == 0 && threadIdx.x == 0) { const unsigned long long* tsm = (const unsigned long long*)(p.ws + 255 * MiB); const unsigned long long t2 = __builtin_amdgcn_s_memrealtime(), want = 8ull * (tsm[PROBE_MB] - tsm[PROBE_MA]);
        while (__builtin_amdgcn_s_memrealtime() - t2 < want) __builtin_amdgcn_s_sleep(16); }
#endif
#ifdef PROBE_SPAN
    if (blockIdx.x == 0 && threadIdx.x == 0) { const unsigned long long t2 = __builtin_amdgcn_s_memrealtime(), want = 8ull * (ts1 - ts0);
        while (__builtin_amdgcn_s_memrealtime() - t2 < want) __builtin_amdgcn_s_sleep(16); }
#endif
}

static void launch_mk(Params& p, int lo, int hi, int grid, hipStream_t stream) {
    p.lo = lo; p.hi = hi; void* args[] = {&p};
    (void)hipMemsetAsync(p.ws + WS_CTL, 0, 65536, stream);
    hipError_t e = hipLaunchCooperativeKernel((const void*)mk, dim3(grid), dim3(512), args, LDS_BYTES, stream);
    if (e != hipSuccess) fprintf(stderr, "cooperative launch failed: %s (grid %d)\n", hipGetErrorString(e), grid);
}
extern "C" void kernel_launch(void* const* d_in, const int* in_sizes, int n_in, void* d_out, int out_size, void* d_ws, size_t ws_size, hipStream_t stream) {
    static int grid = 0;
    if (grid == 0) {
        if (n_in != 24 || out_size != MTOK * DM || ws_size < WS_END) { fprintf(stderr, "kernel_launch: unexpected shapes (n_in %d out %d ws %zu)\n", n_in, out_size, ws_size); grid = -1; return; }
        int dev = 0, cus = 0, per_cu = 0;
        hipGetDevice(&dev); hipDeviceGetAttribute(&cus, hipDeviceAttributeMultiprocessorCount, dev);
        hipFuncSetAttribute((const void*)mk, hipFuncAttributeMaxDynamicSharedMemorySize, LDS_BYTES);
        hipOccupancyMaxActiveBlocksPerMultiprocessor(&per_cu, (const void*)mk, 512, LDS_BYTES);
        if (per_cu < 1) { fprintf(stderr, "kernel_launch: occupancy query says %d blocks/CU\n", per_cu); per_cu = 1; }
        grid = cus * 1;
        (void)hipGetLastError();
    }
    if (grid < 0) return;
    Params p{};
    const float** f = (const float**)&p;
    for (int i = 0; i < 24; ++i) f[i] = (const float*)d_in[i];
    p.out = (float*)d_out; p.ws = (unsigned char*)d_ws;
    launch_mk(p, 0, 14, grid, stream);
}
```

```cpp
#define NAIVE_GEMM 0
#define NAIVE_ATT 0
#define NAIVE_LRU 0
#define NAIVE_SSD 0
#define ONE_LAUNCH 1

#include <hip/hip_runtime.h>
#include <hip/hip_cooperative_groups.h>
#include <cstdio>
#include <cstdint>
namespace cg = cooperative_groups;

#ifndef NAIVE_GEMM
#define NAIVE_GEMM 1
#endif
#ifndef NAIVE_SSD
#define NAIVE_SSD 1
#endif
#ifndef NAIVE_LRU
#define NAIVE_LRU 1
#endif
#ifndef NAIVE_ATT
#define NAIVE_ATT 1
#endif
#ifndef ONE_LAUNCH
#define ONE_LAUNCH 0
#endif

namespace pg8 {
#define PG8_LAS __attribute__((address_space(3)))
typedef unsigned short bf16_t;
typedef short bf16x8 __attribute__((ext_vector_type(8)));
typedef float f32x4 __attribute__((ext_vector_type(4)));
typedef unsigned u32x4 __attribute__((ext_vector_type(4)));
constexpr int BM = 256, BK = 64, HALF = 128, HTB = HALF * BK * 2  , STAGE_BYTES = 8 * HTB, NXCD = 8, WGM = 8;

__host__ __device__ __forceinline__ int lds_byte(int r, int c) { const int st = (r >> 4) * 2 + (c >> 5), rr = r & 15, cc = c & 31, ob = rr * 64 + cc * 2; return st * 1024 + (ob ^ (((ob >> 9) & 1) << 5)); }
__host__ __device__ __forceinline__ void stage_rc(int b, int& R, int& C) { const int st = b / 1024, sb = b % 1024, swz = sb ^ (((sb >> 9) & 1) << 5); R = (st >> 1) * 16 + swz / 64; C = (st & 1) * 32 + (swz % 64) / 2; }
__host__ __device__ __forceinline__ int perm32(int rho) { const int n = rho >> 4, i = rho & 15; return 8 * (i >> 2) + 4 * n + (i & 3); }

struct Unit { int pm, pn; };
struct Gemm { const bf16_t* A; const bf16_t* Bt; int M, N, K, lda, ldb; };

struct StaticOrder {
    int nM, nN, nwg, G, c;
    __host__ __device__ void init(int M, int N, int G_, int c_) { nM = M / BM; nN = N / BM; nwg = nM * nN; G = G_; c = c_; }
    __host__ __device__ bool next(int i, Unit& u) const {
        const long L = (long)i * G + c; if (L >= nwg) return false;
        int wgid = (int)L; { const int q = nwg / NXCD, r = nwg % NXCD, xcd = wgid % NXCD, off = wgid / NXCD; wgid = (xcd < r ? xcd * (q + 1) : r * (q + 1) + (xcd - r) * q) + off; }
        const int nig = WGM * nN, gid = wgid / nig, fm = gid * WGM, gsz = (nM - fm) < WGM ? (nM - fm) : WGM;
        u.pm = fm + ((wgid % nig) % gsz); u.pn = (wgid % nig) / gsz; return true;
    }
    __device__ __forceinline__ void a_ready(const Unit&) const {}
    __device__ __forceinline__ void done(const Unit&) const {}
};

__device__ __forceinline__ unsigned cvt_pk_bf16(float lo, float hi) { unsigned r; asm volatile("v_cvt_pk_bf16_f32 %0, %1, %2" : "=v"(r) : "v"(lo), "v"(hi)); return r; }
typedef float f32x2 __attribute__((ext_vector_type(2)));
__device__ __forceinline__ f32x2 gelu_pk(f32x2 v) {
    const f32x2 av = __builtin_elementwise_abs(v), d = av * 0.2316418882f + 1.0f;
    f32x2 t; t.x = __builtin_amdgcn_rcpf(d.x); t.y = __builtin_amdgcn_rcpf(d.y);
    f32x2 q = t * 0.5307027145f + (-0.7265760135f); q = q * t + 0.7107068705f; q = q * t + (-0.142248368f); q = q * t + 0.127414796f; q = q * t;
    const f32x2 s = (v * v) * (-0.72134752044f);
    f32x2 e; e.x = __builtin_amdgcn_exp2f(s.x); e.y = __builtin_amdgcn_exp2f(s.y);
    const f32x2 m = v * (q * e), r = v - m;
    f32x2 o; o.x = v.x < 0.f ? m.x : r.x; o.y = v.y < 0.f ? m.y : r.y; return o;
}

template <int ACT  > struct EpiBf16 {
    static constexpr bool PERM = true, AFTER_DRAIN = false; static_assert(ACT == 0 || ACT == 1, "EpiBf16: ACT is 0 (none) or 1 (gelu_pk)");
    bf16_t* O; int ldc; const float* bias; int split_cols; size_t split_stride; float scale0;
    __device__ __forceinline__ void operator()(const f32x4 (&acc)[2][2][4][2], const Unit& u, int wr, int wc, int fr, int fq) const {
        const int row0 = u.pm * BM + wr * 64 + fr; int colt = u.pn * BM; bf16_t* base = O;
        float sc = 1.f; if (split_cols) { const int t = colt / split_cols; base += (size_t)t * split_stride; colt -= t * split_cols; if (t == 0) sc = scale0; }
        const int col0 = colt + wc * 32 + 8 * fq, bcol0 = u.pn * BM + wc * 32 + 8 * fq;
        f32x4 bv[2][2];
#pragma unroll
        for (int bj = 0; bj < 2; ++bj)
#pragma unroll
            for (int n = 0; n < 2; ++n) bv[bj][n] = bias ? *(const f32x4*)(bias + bcol0 + bj * HALF + 4 * n) : (f32x4){0.f, 0.f, 0.f, 0.f};
#pragma unroll
        for (int ai = 0; ai < 2; ++ai)
#pragma unroll
            for (int m = 0; m < 4; ++m) { bf16_t* rowp = base + (size_t)(row0 + ai * HALF + m * 16) * ldc + col0;
#pragma unroll
                for (int bj = 0; bj < 2; ++bj) { f32x4 v0 = acc[ai][bj][m][0] + bv[bj][0], v1 = acc[ai][bj][m][1] + bv[bj][1];
                    if (ACT == 1) { f32x2 a = gelu_pk((f32x2){v0[0], v0[1]}), b = gelu_pk((f32x2){v0[2], v0[3]}), c = gelu_pk((f32x2){v1[0], v1[1]}), d = gelu_pk((f32x2){v1[2], v1[3]});
                        v0 = (f32x4){a.x, a.y, b.x, b.y}; v1 = (f32x4){c.x, c.y, d.x, d.y}; }
                    v0 = v0 * sc; v1 = v1 * sc; u32x4 w; w.x = cvt_pk_bf16(v0[0], v0[1]); w.y = cvt_pk_bf16(v0[2], v0[3]); w.z = cvt_pk_bf16(v1[0], v1[1]); w.w = cvt_pk_bf16(v1[2], v1[3]);
                    *(u32x4*)(rowp + bj * HALF) = w; } }
    }
};
template <class Epi, class Sched, bool ALIGN_EPI = false, bool SP2 = false>
__device__ __forceinline__ void gemm_phase(PG8_LAS unsigned char* lds, const Gemm g, const Sched& S, const Epi& E) {
    int tid_ = threadIdx.x; asm volatile("" : "+v"(tid_));
    const int tid = tid_, wid = __builtin_amdgcn_readfirstlane(tid >> 6), lane = tid & 63, wr = wid >> 2, wc = wid & 3, fr = lane & 15, fq = lane >> 4;
    const int K = g.K, nt = K / BK;
    unsigned voffA[2], voffB[2];
#pragma unroll
    for (int i = 0; i < 2; ++i) { int R, C; stage_rc(tid * 16 + i * 8192, R, C); const int Rb = Epi::PERM ? ((R & ~31) + perm32(R & 31)) : R;
        voffA[i] = (unsigned)(R * g.lda + C) * 2u; voffB[i] = (unsigned)(Rb * g.ldb + C) * 2u; }
    const size_t kstep = (size_t)(BK * 2);
    const size_t hstepA = (size_t)HALF * g.lda * 2, hstepB = (size_t)HALF * g.ldb * 2;
    const size_t tstepA = 2 * hstepA, tstepB = 2 * hstepB;
    const unsigned ldsw = (unsigned)wid * 1024u;
    const int aoff = lds_byte(wr * 64 + fr, fq * 8), boff = lds_byte(wc * 32 + fr, fq * 8);
#define PG8_SA(b, h) (((b) * 2 + (h)) * HTB)
#define PG8_SB(b, h) ((4 + (b) * 2 + (h)) * HTB)
#define PG8_STAGE(bufoff, gbase, voff) do { _Pragma("unroll") for (int _i = 0; _i < 2; ++_i) \
        __builtin_amdgcn_global_load_lds((const unsigned*)((const char*)(gbase) + (voff)[_i]), (PG8_LAS unsigned*)(lds + (bufoff) + ldsw + _i * 8192), 16, 0, 0); } while (0)
#define PG8_LDA(dst, b, h) do { _Pragma("unroll") for (int m = 0; m < 4; ++m) _Pragma("unroll") for (int k = 0; k < 2; ++k) dst[m][k] = *(const PG8_LAS bf16x8*)(lds + PG8_SA(b, h) + aoff + m * 2048 + k * 1024); } while (0)
#define PG8_LDB(dst, b, h) do { _Pragma("unroll") for (int n = 0; n < 2; ++n) _Pragma("unroll") for (int k = 0; k < 2; ++k) dst[n][k] = *(const PG8_LAS bf16x8*)(lds + PG8_SB(b, h) + boff + n * 2048 + k * 1024); } while (0)
#define PG8_MMA(ai, bj, At, Bt) do { __builtin_amdgcn_s_setprio(1); _Pragma("unroll") for (int m = 0; m < 4; ++m) _Pragma("unroll") for (int n = 0; n < 2; ++n) _Pragma("unroll") for (int k = 0; k < 2; ++k) \
        acc[ai][bj][m][n] = __builtin_amdgcn_mfma_f32_16x16x32_bf16(Bt[n][k], At[m][k], acc[ai][bj][m][n], 0, 0, 0); __builtin_amdgcn_s_setprio(0); } while (0)
#define PG8_WAIT_V(n) asm volatile("s_waitcnt vmcnt(" #n ")" ::: "memory")
#define PG8_WAIT_L(n) asm volatile("s_waitcnt lgkmcnt(" #n ")" ::: "memory")
#define PG8_BAR __builtin_amdgcn_s_barrier()
#define PG8_SCHED __builtin_amdgcn_sched_barrier(0)
    Unit cur, nxt; int ui = 0;
    if (!S.next(0, cur)) return;
    f32x4 acc[2][2][4][2];
#pragma unroll
    for (int a = 0; a < 2; ++a)
#pragma unroll
        for (int b = 0; b < 2; ++b)
#pragma unroll
            for (int m = 0; m < 4; ++m)
#pragma unroll
                for (int n = 0; n < 2; ++n) acc[a][b][m][n] = (f32x4){0.f, 0.f, 0.f, 0.f};
    bf16x8 At[4][2], B0[2][2], B1[2][2];
    const char* cA = (const char*)g.A + (size_t)cur.pm * tstepA; const char* cB = (const char*)g.Bt + (size_t)cur.pn * tstepB;
    S.a_ready(cur);
    if constexpr (SP2) {
        PG8_STAGE(PG8_SB(0, 0), cB, voffB); PG8_STAGE(PG8_SB(0, 1), cB + hstepB, voffB); PG8_STAGE(PG8_SA(0, 0), cA, voffA); PG8_STAGE(PG8_SA(0, 1), cA + hstepA, voffA);
        if (wr == 1) PG8_BAR;
        PG8_WAIT_V(2); PG8_BAR;
        PG8_STAGE(PG8_SB(1, 0), cB + kstep, voffB); PG8_STAGE(PG8_SA(1, 0), cA + kstep, voffA); PG8_STAGE(PG8_SB(1, 1), cB + hstepB + kstep, voffB);
        PG8_WAIT_V(6); PG8_BAR;
    } else {
        PG8_STAGE(PG8_SB(0, 0), cB, voffB); PG8_STAGE(PG8_SA(0, 0), cA, voffA); PG8_STAGE(PG8_SB(0, 1), cB + hstepB, voffB); PG8_STAGE(PG8_SA(0, 1), cA + hstepA, voffA);
        if (wr == 1) PG8_BAR;
        PG8_WAIT_V(4); PG8_BAR;
        PG8_STAGE(PG8_SB(1, 0), cB + kstep, voffB); PG8_STAGE(PG8_SA(1, 0), cA + kstep, voffA); PG8_STAGE(PG8_SB(1, 1), cB + hstepB + kstep, voffB);
        PG8_WAIT_V(6); PG8_BAR;
    }
    for (;;) {
        const bool has_next = S.next(ui + 1, nxt);
        const char* nA = has_next ? (const char*)g.A + (size_t)nxt.pm * tstepA : cA; const char* nB = has_next ? (const char*)g.Bt + (size_t)nxt.pn * tstepB : cB;
        for (int t = 0; t < nt; t += 2) {
            const bool last = (t == nt - 2);
            const char* a1 = cA + (size_t)(t + 1) * kstep;
            const char* a2 = last ? nA : cA + (size_t)(t + 2) * kstep; const char* b2 = last ? nB : cB + (size_t)(t + 2) * kstep;
            const char* a3 = a2 + kstep; const char* b3 = b2 + kstep;
            if (last && has_next) S.a_ready(nxt);
            if constexpr (SP2) {
            PG8_LDB(B0, 0, 0); PG8_LDB(B1, 0, 1); PG8_SCHED; PG8_LDA(At, 0, 0); PG8_STAGE(PG8_SA(1, 1), a1 + hstepA, voffA);
            PG8_WAIT_V(8); PG8_WAIT_L(0); PG8_BAR; PG8_MMA(0, 0, At, B0); PG8_MMA(0, 1, At, B1); PG8_BAR; PG8_SCHED;
            PG8_LDA(At, 0, 1); PG8_STAGE(PG8_SB(0, 0), b2, voffB); PG8_STAGE(PG8_SB(0, 1), b2 + hstepB, voffB); PG8_STAGE(PG8_SA(0, 0), a2, voffA);
            PG8_WAIT_V(8); PG8_WAIT_L(0); PG8_BAR; PG8_MMA(1, 0, At, B0); PG8_MMA(1, 1, At, B1); PG8_BAR; PG8_SCHED;
            PG8_LDB(B0, 1, 0); PG8_LDB(B1, 1, 1); PG8_SCHED; PG8_LDA(At, 1, 0); PG8_STAGE(PG8_SA(0, 1), a2 + hstepA, voffA);
            PG8_WAIT_V(8); PG8_WAIT_L(0); PG8_BAR; PG8_MMA(0, 0, At, B0); PG8_MMA(0, 1, At, B1); PG8_BAR; PG8_SCHED;
            PG8_LDA(At, 1, 1); PG8_STAGE(PG8_SB(1, 0), b3, voffB); PG8_STAGE(PG8_SB(1, 1), b3 + hstepB, voffB); PG8_STAGE(PG8_SA(1, 0), a3, voffA);
            PG8_WAIT_V(8); PG8_WAIT_L(0); PG8_BAR; PG8_MMA(1, 0, At, B0); PG8_MMA(1, 1, At, B1); PG8_BAR; PG8_SCHED;
            } else {
            PG8_LDB(B0, 0, 0); PG8_SCHED; PG8_LDA(At, 0, 0); PG8_STAGE(PG8_SA(1, 1), a1 + hstepA, voffA);
            PG8_WAIT_L(8); PG8_BAR; PG8_WAIT_L(0); PG8_MMA(0, 0, At, B0); PG8_BAR; PG8_SCHED;
            PG8_LDB(B1, 0, 1); PG8_STAGE(PG8_SB(0, 0), b2, voffB);
            PG8_BAR; PG8_WAIT_L(0); PG8_MMA(0, 1, At, B1); PG8_BAR;
            PG8_LDA(At, 0, 1); PG8_STAGE(PG8_SA(0, 0), a2, voffA);
            PG8_BAR; PG8_WAIT_L(0); PG8_MMA(1, 0, At, B0); PG8_BAR; PG8_SCHED;
            PG8_STAGE(PG8_SB(0, 1), b2 + hstepB, voffB);
            PG8_WAIT_V(6); PG8_BAR; PG8_MMA(1, 1, At, B1); PG8_BAR;
            PG8_LDB(B0, 1, 0); PG8_SCHED; PG8_LDA(At, 1, 0); PG8_STAGE(PG8_SA(0, 1), a2 + hstepA, voffA);
            PG8_WAIT_L(8); PG8_BAR; PG8_WAIT_L(0); PG8_MMA(0, 0, At, B0); PG8_BAR; PG8_SCHED;
            PG8_LDB(B1, 1, 1); PG8_STAGE(PG8_SB(1, 0), b3, voffB);
            PG8_BAR; PG8_WAIT_L(0); PG8_MMA(0, 1, At, B1); PG8_BAR;
            PG8_LDA(At, 1, 1); PG8_STAGE(PG8_SA(1, 0), a3, voffA);
            PG8_BAR; PG8_WAIT_L(0); PG8_MMA(1, 0, At, B0); PG8_BAR; PG8_SCHED;
            PG8_STAGE(PG8_SB(1, 1), b3 + hstepB, voffB);
            PG8_WAIT_V(6); PG8_BAR; PG8_MMA(1, 1, At, B1); PG8_BAR;
            }
        }
        if constexpr (ALIGN_EPI) { if (wr == 0) PG8_BAR; }
        if constexpr (!Epi::AFTER_DRAIN) { E(acc, cur, wr, wc, fr, fq); S.done(cur); }
        if (!has_next) break;
#pragma unroll
        for (int a = 0; a < 2; ++a)
#pragma unroll
            for (int b = 0; b < 2; ++b)
#pragma unroll
                for (int m = 0; m < 4; ++m)
#pragma unroll
                    for (int n = 0; n < 2; ++n) acc[a][b][m][n] = (f32x4){0.f, 0.f, 0.f, 0.f};
        cur = nxt; cA = nA; cB = nB; ++ui;
        if constexpr (ALIGN_EPI) { if (wr == 1) PG8_BAR; }
    }
    PG8_WAIT_V(0);
    if constexpr (!ALIGN_EPI) { if (wr == 0) PG8_BAR; }
    PG8_BAR;
    if constexpr (Epi::AFTER_DRAIN) { E.fused(acc, cur, wr, wc, fr, fq, lds, wid, lane); S.done(cur); }
#undef PG8_SA
#undef PG8_SB
#undef PG8_STAGE
#undef PG8_LDA
#undef PG8_LDB
#undef PG8_MMA
#undef PG8_WAIT_V
#undef PG8_WAIT_L
#undef PG8_BAR
#undef PG8_SCHED
}
}

#define GAS __attribute__((address_space(1)))
#define LAS __attribute__((address_space(3)))
typedef unsigned short bf16_t;
typedef short bf16x8 __attribute__((ext_vector_type(8)));
typedef float f32x4 __attribute__((ext_vector_type(4)));
typedef unsigned u32x4 __attribute__((ext_vector_type(4)));
typedef unsigned u32x2 __attribute__((ext_vector_type(2)));

constexpr int DM = 1024, NBATCH = 2, SEQ = 8192, MEML = 256, MTOK = NBATCH * SEQ;
constexpr int INW = 12320, LD = 12544;
constexpr int C_Z = 0, C_X = 2048, C_B = 4096, C_C = 4608, C_LG = 5120, C_LX = 6656, C_Q = 8192, C_G = 9216, C_DT = 12288;
constexpr int C_MRG = 2048;
constexpr int NHEAD = 32, HDIM = 64, NGRP = 4, NSTATE = 128, CHUNK = 128, NCHUNK = SEQ / CHUNK;
constexpr int LRUW = 1536, LRUB = 96, NLB = 16, LSEG = 512, NSEG = SEQ / LSEG, NBLK64 = SEQ / 64;
constexpr float EPS = 1e-6f;
constexpr size_t MiB = 1u << 20;
constexpr size_t WS_WIN = 0, WS_WKV = 25 * MiB, WS_WSSD = 29 * MiB, WS_WLRU = 33 * MiB, WS_WMEM = 36 * MiB, WS_WOUT = 38 * MiB;
constexpr size_t WS_PROJ = 40 * MiB;
constexpr size_t WS_MEMN = 236 * MiB, WS_KVK = 237 * MiB, WS_KVVT = 238 * MiB, WS_LRUWA = 239 * MiB, WS_LRUWX = 239 * MiB + 512 * 1024;
constexpr size_t WS_DASUM = 240 * MiB;
constexpr size_t WS_LAGG = 246 * MiB;
constexpr size_t WS_LCAR = 250 * MiB;
constexpr size_t WS_CTL = 244 * MiB;
constexpr size_t WS_XBUF = 245 * MiB;
constexpr size_t WS_END = 256 * MiB;
static_assert(WS_PROJ + (size_t)SEQ * LD * 2 <= WS_MEMN, "ws map");
constexpr int LDS_BYTES = 155648;

struct Params {
    const float *x, *mem, *norm_g, *w_in, *ssd_conv_w, *ssd_conv_b, *ssd_dt_bias, *ssd_a_log, *ssd_d, *ssd_norm_g,
        *lru_conv_w, *lru_conv_b, *lru_w_a, *lru_b_a, *lru_w_x, *lru_b_x, *lru_lambda, *mem_norm_g, *w_kv,
        *w_br_ssd, *w_br_lru, *w_br_mem, *w_out, *final_g;
    float* out; unsigned char* ws;
    int lo, hi;
};

__device__ __forceinline__ float bf2f(bf16_t v) { return __uint_as_float((unsigned)v << 16); }
__device__ __forceinline__ unsigned f2bf(float f) { unsigned u = __float_as_uint(f); return (u + 0x7fffu + ((u >> 16) & 1u)) >> 16; }
__device__ __forceinline__ unsigned pk2(float lo, float hi) { return f2bf(lo) | (f2bf(hi) << 16); }
__device__ __forceinline__ float sigmoidf_(float v) { return __builtin_amdgcn_rcpf(1.f + __expf(-v)); }
__device__ __forceinline__ float siluf_(float v) { return v * __builtin_amdgcn_rcpf(1.f + __expf(-v)); }
__device__ __forceinline__ float softplusf_(float v) { const float e = __expf(v); const float sm = e * (1.f - e * (0.5f - e * 0.33333334f)); return v > 20.f ? v : (e < 1e-3f ? sm : __logf(1.f + e)); }
__device__ __forceinline__ float wave_sum(float v) {
#pragma unroll
    for (int o = 1; o < 64; o <<= 1) v += __shfl_xor(v, o);
    return v;
}
template <class T> __device__ __forceinline__ T* opq(T* q) { asm volatile("" : "+s"(q)); return q; }
__device__ __forceinline__ int opq_tid() { int t = threadIdx.x; asm volatile("" : "+v"(t)); return t; }
__device__ __forceinline__ int opq_bid() { int t = blockIdx.x; asm volatile("" : "+s"(t)); return t; }
__device__ __forceinline__ unsigned char* wsb(const Params& p) { return opq(p.ws); }
__device__ __forceinline__ bf16_t* proj_ptr(const Params& p) { return (bf16_t*)(wsb(p) + WS_PROJ); }
__device__ __forceinline__ bf16_t* xn_ptr(const Params& p) { return (bf16_t*)((unsigned char*)opq(p.out) + 32 * MiB); }
__device__ __forceinline__ bf16_t* states_ptr(const Params& p, int b) { return (bf16_t*)((unsigned char*)opq(p.out) + (size_t)b * 32 * MiB); }
__device__ __forceinline__ float* scr_ptr(const Params& p, int b) { return (float*)((unsigned char*)opq(p.out) + (size_t)b * 32 * MiB); }

#ifdef PROBE_MA
#define MSTAMP(p, i) do { if (blockIdx.x == 0 && threadIdx.x == 0) ((unsigned long long*)(wsb(p) + 255 * MiB))[i] = __builtin_amdgcn_s_memrealtime(); } while (0)
#else
#define MSTAMP(p, i) do { } while (0)
#endif
__device__ __forceinline__ void transpose_item(const float* W, int K, int Ns, int srccol0, bf16_t* WT, int dstrow0, LAS float* scr, int k0, int lane) {
    float wv[32];
#pragma unroll
    for (int i = 0; i < 32; ++i) wv[i] = W[(size_t)(k0 + 2 * i + (lane >> 5)) * Ns + srccol0 + (lane & 31)];
#pragma unroll
    for (int i = 0; i < 32; ++i) scr[(2 * i + (lane >> 5)) * 33 + (lane & 31)] = wv[i];
    asm volatile("s_waitcnt lgkmcnt(0)" ::: "memory");
    const int c = lane & 7;
#pragma unroll
    for (int j = 0; j < 4; ++j) { const int n = (lane >> 3) + 8 * j; const LAS float* s = scr + (8 * c) * 33 + n;
        u32x4 o; o.x = pk2(s[0 * 33], s[1 * 33]); o.y = pk2(s[2 * 33], s[3 * 33]); o.z = pk2(s[4 * 33], s[5 * 33]); o.w = pk2(s[6 * 33], s[7 * 33]);
        *(u32x4*)(WT + (size_t)(dstrow0 + n) * K + k0 + 8 * c) = o; }
    asm volatile("s_waitcnt lgkmcnt(0)" ::: "memory");
}
__device__ __forceinline__ void rms_row_to_bf16(const float* xrow, const float* g, bf16_t* orow, int lane) {
    const f32x4* xr = (const f32x4*)xrow + lane; const f32x4* gr = (const f32x4*)g + lane;
    f32x4 v[4]; float s = 0.f;
#pragma unroll
    for (int j = 0; j < 4; ++j) { v[j] = xr[64 * j]; s += (v[j].x * v[j].x + v[j].y * v[j].y) + (v[j].z * v[j].z + v[j].w * v[j].w); }
    const float rs = 1.f / sqrtf(wave_sum(s) * (1.f / DM) + EPS);
    unsigned long long* o8 = (unsigned long long*)orow + lane;
#pragma unroll
    for (int j = 0; j < 4; ++j) { const f32x4 gg = gr[64 * j];
        o8[64 * j] = (unsigned long long)pk2(v[j].x * rs * gg.x, v[j].y * rs * gg.y) | ((unsigned long long)pk2(v[j].z * rs * gg.z, v[j].w * rs * gg.w) << 32); }
}
__device__ __forceinline__ void xn_rows(const Params& p, int row_lo, int row_hi, int gw, int NGW, int lane) {
    bf16_t* XN = xn_ptr(p);
    { const float* xb = opq(p.x); const f32x4* gr = (const f32x4*)opq(p.norm_g) + lane;
      for (int m0 = row_lo + gw * 4; m0 < row_hi; m0 += NGW * 4) {
          f32x4 v[4][4];
#pragma unroll
          for (int r = 0; r < 4; ++r)
#pragma unroll
              for (int j = 0; j < 4; ++j) v[r][j] = ((const f32x4*)(xb + (size_t)(m0 + r) * DM) + lane)[64 * j];
#pragma unroll
          for (int r = 0; r < 4; ++r) { float s = 0.f;
#pragma unroll
              for (int j = 0; j < 4; ++j) s += (v[r][j].x * v[r][j].x + v[r][j].y * v[r][j].y) + (v[r][j].z * v[r][j].z + v[r][j].w * v[r][j].w);
              const float rs = 1.f / sqrtf(wave_sum(s) * (1.f / DM) + EPS);
              unsigned long long* o8 = (unsigned long long*)(XN + (size_t)(m0 + r) * DM) + lane;
#pragma unroll
              for (int j = 0; j < 4; ++j) { const f32x4 gg = gr[64 * j];
                  o8[64 * j] = (unsigned long long)pk2(v[r][j].x * rs * gg.x, v[r][j].y * rs * gg.y) | ((unsigned long long)pk2(v[r][j].z * rs * gg.z, v[r][j].w * rs * gg.w) << 32); } } } }
}
__device__ __forceinline__ void transpose_items(const Params& p, LAS unsigned char* lds, int it_lo, int it_hi) {
    const int tid = opq_tid(), lane = tid & 63, wave = tid >> 6, bid = opq_bid();
    const int gw = bid * 8 + wave, NGW = gridDim.x * 8;
    LAS float* scr = (LAS float*)(lds + wave * 8704);
    bf16_t* Win = (bf16_t*)(wsb(p) + WS_WIN); bf16_t* Wkv = (bf16_t*)(wsb(p) + WS_WKV); bf16_t* Wssd = (bf16_t*)(wsb(p) + WS_WSSD);
    bf16_t* Wlru = (bf16_t*)(wsb(p) + WS_WLRU); bf16_t* Wmem = (bf16_t*)(wsb(p) + WS_WMEM); bf16_t* Wout = (bf16_t*)(wsb(p) + WS_WOUT);
    constexpr int I_IN = 16 * 385, I_KV = 16 * 64, I_SSD = 32 * 32, I_LRU = 24 * 32, I_MEM = 16 * 32, I_OUT = 16 * 32;
    constexpr int NITEMS = I_IN + I_KV + I_SSD + I_LRU + I_MEM + I_OUT;
    (void)NITEMS;
    for (int it = it_lo + gw; it < it_hi; it += NGW) {
        int r = it;
        if (r < I_IN) { const int nb = r % 385, kb = r / 385; const int sc = 32 * nb; int dr;
            if (sc < 5120) dr = sc; else if (sc < 5152) dr = sc - 5120 + C_DT; else dr = sc - 32;
            transpose_item(opq(p.w_in), 1024, INW, sc, Win, dr, scr, 64 * kb, lane); continue; } r -= I_IN;
        if (r < I_KV) { transpose_item(opq(p.w_kv), 1024, 2048, 32 * (r % 64), Wkv, 32 * (r % 64), scr, 64 * (r / 64), lane); continue; } r -= I_KV;
        if (r < I_SSD) { transpose_item(opq(p.w_br_ssd), 2048, 1024, 32 * (r % 32), Wssd, 32 * (r % 32), scr, 64 * (r / 32), lane); continue; } r -= I_SSD;
        if (r < I_LRU) { transpose_item(opq(p.w_br_lru), 1536, 1024, 32 * (r % 32), Wlru, 32 * (r % 32), scr, 64 * (r / 32), lane); continue; } r -= I_LRU;
        if (r < I_MEM) { transpose_item(opq(p.w_br_mem), 1024, 1024, 32 * (r % 32), Wmem, 32 * (r % 32), scr, 64 * (r / 32), lane); continue; } r -= I_MEM;
        transpose_item(opq(p.w_out), 1024, 1024, 32 * (r % 32), Wout, 32 * (r % 32), scr, 64 * (r / 32), lane);
    }
}
constexpr int TI_EARLY = 16 * 385 + 16 * 64, TI_ALL = TI_EARLY + 32 * 32 + 24 * 32 + 16 * 32 + 16 * 32;
__device__ __forceinline__ void phase0(const Params& p, LAS unsigned char* lds) {
    const int tid = opq_tid(), lane = tid & 63, wave = tid >> 6, bid = opq_bid();
    const int gw = bid * 8 + wave, NGW = gridDim.x * 8;
    bf16_t* Win = (bf16_t*)(wsb(p) + WS_WIN);
    transpose_items(p, lds, 0, gridDim.x == 256 ? TI_EARLY : TI_ALL);
    { const int gt = bid * 512 + tid, NT = gridDim.x * 512; u32x4* z = (u32x4*)(Win + (size_t)INW * 1024);
      for (int i = gt; i < (LD - INW) * 1024 / 8; i += NT) z[i] = (u32x4){0u, 0u, 0u, 0u}; }
    { const int gt = bid * 512 + tid, NT = gridDim.x * 512; bf16_t* wa = (bf16_t*)(wsb(p) + WS_LRUWA); bf16_t* wx = (bf16_t*)(wsb(p) + WS_LRUWX);
      for (int e = gt; e < NLB * LRUB * LRUB; e += NT) { const int n = e / (LRUB * LRUB), r2 = e % (LRUB * LRUB), j = r2 / LRUB, i = r2 % LRUB;
          wa[e] = (bf16_t)f2bf(opq(p.lru_w_a)[(n * LRUB + i) * LRUB + j]); wx[e] = (bf16_t)f2bf(opq(p.lru_w_x)[(n * LRUB + i) * LRUB + j]); } }
    bf16_t* XN = xn_ptr(p); bf16_t* MN = (bf16_t*)(wsb(p) + WS_MEMN);
    if (gridDim.x == 256) xn_rows(p, 0, SEQ, gw, NGW, lane); else xn_rows(p, 0, MTOK, gw, NGW, lane);
    for (int m = gw; m < NBATCH * MEML; m += NGW) rms_row_to_bf16(opq(p.mem) + (size_t)m * DM, opq(p.mem_norm_g), MN + (size_t)m * DM, lane);
}
__device__ __forceinline__ void phase7(const Params& p) {
    const int tid = opq_tid(), lane = tid & 63, wave = tid >> 6; const int gw = opq_bid() * 8 + wave, NGW = gridDim.x * 8; float* outb = opq(p.out); const float* fg = opq(p.final_g);
    for (int m = gw; m < MTOK; m += NGW) {
        f32x4* xr = (f32x4*)(outb + (size_t)m * DM) + lane; const f32x4* gr = (const f32x4*)fg + lane;
        f32x4 v[4]; float s = 0.f;
#pragma unroll
        for (int j = 0; j < 4; ++j) { v[j] = xr[64 * j]; s += (v[j].x * v[j].x + v[j].y * v[j].y) + (v[j].z * v[j].z + v[j].w * v[j].w); }
        const float rs = 1.f / sqrtf(wave_sum(s) * (1.f / DM) + EPS);
#pragma unroll
        for (int j = 0; j < 4; ++j) { const f32x4 gg = gr[64 * j]; xr[64 * j] = v[j] * rs * gg; }
    }
}

namespace pg8 {
template <int BR> struct EpiMerge {
    static constexpr bool PERM = true, AFTER_DRAIN = false;
    bf16_t* P; float* scr;
    __device__ __forceinline__ void operator()(const f32x4 (&acc)[2][2][4][2], const Unit& u, int wr, int wc, int fr, int fq) const {
        const int row0 = u.pm * BM + wr * 64 + fr, col0 = u.pn * BM + wc * 32 + 8 * fq;
#pragma unroll
        for (int ai = 0; ai < 2; ++ai)
#pragma unroll
            for (int m = 0; m < 4; ++m) { const size_t r = (size_t)(row0 + ai * HALF + m * 16);
#pragma unroll
                for (int bj = 0; bj < 2; ++bj) { const int c = col0 + bj * HALF;
                    const u32x4 gw = *(const u32x4*)(P + r * 12544 + 9216 + BR * 1024 + c);
                    float g[8];
#pragma unroll
                    for (int i = 0; i < 4; ++i) { g[2 * i] = __uint_as_float(gw[i] << 16); g[2 * i + 1] = __uint_as_float(gw[i] & 0xffff0000u); }
                    f32x4 v0 = acc[ai][bj][m][0], v1 = acc[ai][bj][m][1];
#pragma unroll
                    for (int i = 0; i < 4; ++i) { v0[i] *= 1.f / (1.f + __expf(-g[i])); v1[i] *= 1.f / (1.f + __expf(-g[4 + i])); }
                    float* sp = scr + r * 1024 + c;
                    if (BR > 0) { v0 += *(const f32x4*)sp; v1 += *(const f32x4*)(sp + 4); }
                    if (BR < 2) { *(f32x4*)sp = v0; *(f32x4*)(sp + 4) = v1; }
                    else { u32x4 w; w.x = cvt_pk_bf16(v0[0], v0[1]); w.y = cvt_pk_bf16(v0[2], v0[3]); w.z = cvt_pk_bf16(v1[0], v1[1]); w.w = cvt_pk_bf16(v1[2], v1[3]);
                        *(u32x4*)(P + r * 12544 + 2048 + c) = w; } } }
    }
};
template <int BR, bool FINAL> struct EpiMerge2 {
    static constexpr bool PERM = true, AFTER_DRAIN = false;
    bf16_t* P; bf16_t* s0; int ld0; const bf16_t* s1; int ld1; bf16_t* mrg; int ldm;
    __device__ __forceinline__ void operator()(const f32x4 (&acc)[2][2][4][2], const Unit& u, int wr, int wc, int fr, int fq) const {
        const int row0 = u.pm * BM + wr * 64 + fr, col0 = u.pn * BM + wc * 32 + 8 * fq;
#pragma unroll
        for (int ai = 0; ai < 2; ++ai) {
            unsigned gb = (unsigned)((row0 + ai * HALF) * 12544 + 9216 + BR * 1024 + col0); asm volatile("" : "+v"(gb));
            unsigned b0 = (unsigned)((row0 + ai * HALF) * ld0 + col0); asm volatile("" : "+v"(b0));
            u32x4 gw[4][2];
#pragma unroll
            for (int m = 0; m < 4; ++m)
#pragma unroll
                for (int bj = 0; bj < 2; ++bj) gw[m][bj] = *(const u32x4*)(P + (gb + (unsigned)(m * 16 * 12544 + bj * HALF)));
            f32x4 v[4][2][2];
#pragma unroll
            for (int m = 0; m < 4; ++m)
#pragma unroll
                for (int bj = 0; bj < 2; ++bj) { const u32x4 g4 = gw[m][bj]; f32x4 v0 = acc[ai][bj][m][0], v1 = acc[ai][bj][m][1];
#pragma unroll
                    for (int i = 0; i < 2; ++i) { v0[2 * i] *= __builtin_amdgcn_rcpf(1.f + __expf(-__uint_as_float(g4[i] << 16))); v0[2 * i + 1] *= __builtin_amdgcn_rcpf(1.f + __expf(-__uint_as_float(g4[i] & 0xffff0000u)));
                        v1[2 * i] *= __builtin_amdgcn_rcpf(1.f + __expf(-__uint_as_float(g4[2 + i] << 16))); v1[2 * i + 1] *= __builtin_amdgcn_rcpf(1.f + __expf(-__uint_as_float(g4[2 + i] & 0xffff0000u))); }
                    v[m][bj][0] = v0; v[m][bj][1] = v1; }
            if (!FINAL) {
#pragma unroll
                for (int m = 0; m < 4; ++m)
#pragma unroll
                    for (int bj = 0; bj < 2; ++bj) { const f32x4 v0 = v[m][bj][0], v1 = v[m][bj][1]; u32x4 w; w.x = cvt_pk_bf16(v0[0], v0[1]); w.y = cvt_pk_bf16(v0[2], v0[3]); w.z = cvt_pk_bf16(v1[0], v1[1]); w.w = cvt_pk_bf16(v1[2], v1[3]);
                        *(u32x4*)(s0 + (b0 + (unsigned)(m * 16) * (unsigned)ld0 + (unsigned)(bj * HALF))) = w; }
            } else {
                asm volatile("" ::: "memory");
                unsigned b1 = (unsigned)((row0 + ai * HALF) * ld1 + col0); asm volatile("" : "+v"(b1));
                unsigned bm = (unsigned)((row0 + ai * HALF) * ldm + col0); asm volatile("" : "+v"(bm));
#pragma unroll
                for (int mp = 0; mp < 2; ++mp) { u32x4 a0[2][2], a1[2][2];
#pragma unroll
                    for (int mm = 0; mm < 2; ++mm)
#pragma unroll
                        for (int bj = 0; bj < 2; ++bj) { const unsigned rr = (unsigned)((2 * mp + mm) * 16);
                            a0[mm][bj] = *(const u32x4*)(s0 + (b0 + rr * (unsigned)ld0 + (unsigned)(bj * HALF))); a1[mm][bj] = *(const u32x4*)(s1 + (b1 + rr * (unsigned)ld1 + (unsigned)(bj * HALF))); }
#pragma unroll
                    for (int mm = 0; mm < 2; ++mm)
#pragma unroll
                        for (int bj = 0; bj < 2; ++bj) { const int m = 2 * mp + mm; const unsigned rr = (unsigned)(m * 16);
                            f32x4 v0 = v[m][bj][0], v1 = v[m][bj][1];
#pragma unroll
                            for (int i = 0; i < 2; ++i) { v0[2 * i] += __uint_as_float(a0[mm][bj][i] << 16) + __uint_as_float(a1[mm][bj][i] << 16); v0[2 * i + 1] += __uint_as_float(a0[mm][bj][i] & 0xffff0000u) + __uint_as_float(a1[mm][bj][i] & 0xffff0000u);
                                v1[2 * i] += __uint_as_float(a0[mm][bj][2 + i] << 16) + __uint_as_float(a1[mm][bj][2 + i] << 16); v1[2 * i + 1] += __uint_as_float(a0[mm][bj][2 + i] & 0xffff0000u) + __uint_as_float(a1[mm][bj][2 + i] & 0xffff0000u); }
                            u32x4 w; w.x = cvt_pk_bf16(v0[0], v0[1]); w.y = cvt_pk_bf16(v0[2], v0[3]); w.z = cvt_pk_bf16(v1[0], v1[1]); w.w = cvt_pk_bf16(v1[2], v1[3]);
                            *(u32x4*)(mrg + (bm + rr * (unsigned)ldm + (unsigned)(bj * HALF))) = w; }
                    asm volatile("" ::: "memory"); }
            }
            asm volatile("" ::: "memory");
        }
    }
};
struct EpiOutNorm {
    static constexpr bool PERM = false, AFTER_DRAIN = true;
    const float* xres; float* out; const float* fg; float* xbuf; unsigned* cnt;
    __device__ __forceinline__ void fused(f32x4 (&acc)[2][2][4][2], const Unit& u, int wr, int wc, int fr, int fq, PG8_LAS unsigned char* lds, int wid, int lane) const {
        PG8_LAS float* Pp = (PG8_LAS float*)lds; PG8_LAS float* Sr = (PG8_LAS float*)(lds + 4096);
        const int row0 = u.pm * BM + wr * 64 + fr, col0 = u.pn * BM + wc * 32 + 4 * fq;
#pragma unroll
        for (int ai = 0; ai < 2; ++ai)
#pragma unroll
            for (int m = 0; m < 4; ++m) { const size_t off = (size_t)(row0 + ai * HALF + m * 16) * 1024 + col0; float s = 0.f;
#pragma unroll
                for (int bj = 0; bj < 2; ++bj)
#pragma unroll
                    for (int n = 0; n < 2; ++n) { const f32x4 v = acc[ai][bj][m][n] + *(const f32x4*)(xres + off + bj * HALF + n * 16); acc[ai][bj][m][n] = v; s += (v[0] * v[0] + v[1] * v[1]) + (v[2] * v[2] + v[3] * v[3]); }
                s += __shfl_xor(s, 16); s += __shfl_xor(s, 32);
                if (fq == 0) Pp[(ai * HALF + wr * 64 + m * 16 + fr) * 4 + wc] = s;
                if (m == 3) asm volatile("" ::: "memory"); }
        asm volatile("s_waitcnt lgkmcnt(0)" ::: "memory"); __builtin_amdgcn_s_barrier(); asm volatile("" ::: "memory");
        const int tid = wid * 64 + lane;
        if (tid < 256) { const float s = (Pp[tid * 4 + 0] + Pp[tid * 4 + 1]) + (Pp[tid * 4 + 2] + Pp[tid * 4 + 3]);
            __hip_atomic_store(xbuf + (size_t)(u.pm * BM + tid) * 4 + u.pn, s, __ATOMIC_RELAXED, __HIP_MEMORY_SCOPE_AGENT); }
        asm volatile("s_waitcnt vmcnt(0)" ::: "memory");
        if (wid < 4 && lane == 0) __hip_atomic_fetch_add(cnt + 64 * u.pm, 1u, __ATOMIC_RELAXED, __HIP_MEMORY_SCOPE_AGENT);
        if (wid == 0) { unsigned spins = 0;
            while ((unsigned)__builtin_amdgcn_readfirstlane(__hip_atomic_load(cnt + 64 * u.pm, __ATOMIC_RELAXED, __HIP_MEMORY_SCOPE_AGENT)) < 16u && ++spins < (1u << 22)) __builtin_amdgcn_s_sleep(2);
            __builtin_amdgcn_fence(__ATOMIC_ACQUIRE, "agent"); }
        asm volatile("s_waitcnt vmcnt(0) lgkmcnt(0)" ::: "memory"); __builtin_amdgcn_s_barrier(); asm volatile("" ::: "memory");
        if (tid < 256) { const float* slot = xbuf + (size_t)(u.pm * BM + tid) * 4; float s = 0.f;
#pragma unroll
            for (int q = 0; q < 4; ++q) s += __hip_atomic_load(slot + q, __ATOMIC_RELAXED, __HIP_MEMORY_SCOPE_AGENT);
            Sr[tid] = 1.0f / sqrtf(s * (1.f / 1024.f) + 1e-6f); }
        asm volatile("s_waitcnt lgkmcnt(0)" ::: "memory"); __builtin_amdgcn_s_barrier(); asm volatile("" ::: "memory");
#pragma unroll
        for (int ai = 0; ai < 2; ++ai)
#pragma unroll
            for (int m = 0; m < 4; ++m) { const int r = ai * HALF + wr * 64 + m * 16 + fr; const float rs = Sr[r]; const size_t off = (size_t)(u.pm * BM + r) * 1024 + col0;
#pragma unroll
                for (int bj = 0; bj < 2; ++bj)
#pragma unroll
                    for (int n = 0; n < 2; ++n) { const f32x4 gg = *(const f32x4*)(fg + col0 + bj * HALF + n * 16); *(f32x4*)(out + off + bj * HALF + n * 16) = acc[ai][bj][m][n] * rs * gg; } }
    }
};
struct SkewOrder {
    StaticOrder base; int c;
    __device__ void init(int M, int N, int c_) { base.init(M, N, 256, 0); c = c_; }
    __device__ bool next(int i, Unit& u) const {
        int ii, cc = c;
        if (c < 128) { if (i >= 5) return false; ii = i + 1; }
        else { if (i > 6) return false; if (i == 0) ii = 0; else if (i == 1) { ii = 0; cc = c - 128; } else ii = i - 1; }
        StaticOrder b2 = base; b2.c = cc; return b2.next(ii, u);
    }
    __device__ __forceinline__ void a_ready(const Unit&) const {}
    __device__ __forceinline__ void done(const Unit&) const {}
};
}
#define PG8_SP2 true
#define PG8_ALIGN true

__device__ __forceinline__ bf16_t* merged_ptr(const Params& p, int b) { return b == 0 ? xn_ptr(p) : proj_ptr(p) + 4096; }
__device__ __forceinline__ int merged_ld(int b) { return b == 0 ? DM : LD; }
__device__ __forceinline__ void phase1_gemm(const Params& p, int b, LAS unsigned char* lds) {
    const int G = gridDim.x, c = opq_bid();
    { pg8::Gemm g{xn_ptr(p) + (size_t)b * SEQ * DM, (const bf16_t*)(wsb(p) + WS_WIN), SEQ, 12288, DM, DM, DM}; pg8::StaticOrder S; S.init(SEQ, 12288, G, c);
      pg8::EpiBf16<0> E{proj_ptr(p), LD, nullptr, 0, 0, 1.f};
      if (b == 1 && G == 256) { pg8::SkewOrder S2; S2.init(SEQ, 12288, c);
          pg8::gemm_phase<pg8::EpiBf16<0>, pg8::SkewOrder, PG8_ALIGN, PG8_SP2>(lds, g, S2, E); }
      else pg8::gemm_phase<pg8::EpiBf16<0>, pg8::StaticOrder, PG8_ALIGN, PG8_SP2>(lds, g, S, E); }
    { const int tid = opq_tid(), lane = tid & 63, wave = tid >> 6, fr = lane & 15, kg = lane >> 4;
      const bf16_t* XNb = xn_ptr(p) + (size_t)b * SEQ * DM; const bf16_t* Wd = (const bf16_t*)(wsb(p) + WS_WIN) + (size_t)C_DT * DM; bf16_t* Pq = proj_ptr(p);
      LAS float* sRed = (LAS float*)lds;
      for (int rb = c; rb < SEQ / 32; rb += G) {
          __syncthreads();
          f32x4 acc[2][2];
#pragma unroll
          for (int mt = 0; mt < 2; ++mt)
#pragma unroll
              for (int nt = 0; nt < 2; ++nt) acc[mt][nt] = (f32x4){0.f, 0.f, 0.f, 0.f};
          bf16x8 af[2][4], bfr[2][4];
#pragma unroll
          for (int ks = 0; ks < 4; ++ks)
#pragma unroll
              for (int q = 0; q < 2; ++q) { af[q][ks] = *(const bf16x8*)(XNb + (size_t)(32 * rb + 16 * q + fr) * DM + 128 * wave + 32 * ks + 8 * kg);
                  bfr[q][ks] = *(const bf16x8*)(Wd + (size_t)(16 * q + fr) * DM + 128 * wave + 32 * ks + 8 * kg); }
#pragma unroll
          for (int ks = 0; ks < 4; ++ks)
#pragma unroll
              for (int mt = 0; mt < 2; ++mt)
#pragma unroll
                  for (int nt = 0; nt < 2; ++nt) acc[mt][nt] = __builtin_amdgcn_mfma_f32_16x16x32_bf16(af[mt][ks], bfr[nt][ks], acc[mt][nt], 0, 0, 0);
#pragma unroll
          for (int mt = 0; mt < 2; ++mt)
#pragma unroll
              for (int nt = 0; nt < 2; ++nt)
#pragma unroll
                  for (int j = 0; j < 4; ++j) sRed[(wave * 32 + 16 * mt + 4 * kg + j) * 32 + 16 * nt + fr] = acc[mt][nt][j];
          __syncthreads();
#pragma unroll
          for (int q = 0; q < 2; ++q) { const int e = tid + 512 * q, row = e >> 5, col = e & 31; float s = 0.f;
#pragma unroll
              for (int w2 = 0; w2 < 8; ++w2) s += sRed[(w2 * 32 + row) * 32 + col];
              Pq[(size_t)(32 * rb + row) * LD + C_DT + col] = (bf16_t)f2bf(s); }
      } }
    if (b == 0 && G != 256) {
        { pg8::Gemm g{(const bf16_t*)(wsb(p) + WS_MEMN), (const bf16_t*)(wsb(p) + WS_WKV), 512, 1024, DM, DM, DM}; pg8::StaticOrder S; S.init(512, 1024, G, (c + 16) % G);
          pg8::EpiBf16<0> E{(bf16_t*)(wsb(p) + WS_KVK), 1024, nullptr, 0, 0, 1.f};
          pg8::gemm_phase<pg8::EpiBf16<0>, pg8::StaticOrder, PG8_ALIGN, PG8_SP2>(lds, g, S, E); }
        { pg8::Gemm g{(const bf16_t*)(wsb(p) + WS_WKV) + (size_t)1024 * DM, (const bf16_t*)(wsb(p) + WS_MEMN), 1024, 512, DM, DM, DM}; pg8::StaticOrder S; S.init(1024, 512, G, (c + 8) % G);
          pg8::EpiBf16<0> E{(bf16_t*)(wsb(p) + WS_KVVT), 512, nullptr, 0, 0, 1.f};
          pg8::gemm_phase<pg8::EpiBf16<0>, pg8::StaticOrder, PG8_ALIGN, PG8_SP2>(lds, g, S, E); }
    }
    if (b == 0 && G == 256) {
        const int tid = opq_tid(), lane = tid & 63, wave = tid >> 6, fr = lane & 15, kg = lane >> 4;
        const bf16_t* MN = (const bf16_t*)(wsb(p) + WS_MEMN); const bf16_t* WK = (const bf16_t*)(wsb(p) + WS_WKV);
        const bool jobK = c < 128; const int cb = jobK ? c : c - 128;
        const bf16_t* Ap = jobK ? MN + (size_t)(64 * (cb >> 4)) * DM : WK + (size_t)(1024 + 64 * (cb >> 3)) * DM;
        const bf16_t* Bp = jobK ? WK + (size_t)(64 * (cb & 15)) * DM : MN + (size_t)(64 * (cb & 7)) * DM;
        bf16_t* Cp = jobK ? (bf16_t*)(wsb(p) + WS_KVK) + (size_t)(64 * (cb >> 4)) * 1024 + 64 * (cb & 15) : (bf16_t*)(wsb(p) + WS_KVVT) + (size_t)(64 * (cb >> 3)) * 512 + 64 * (cb & 7);
        const int ldc = jobK ? 1024 : 512;
        LAS float* sRed = (LAS float*)lds;
        __syncthreads();
        f32x4 acc[4][4];
#pragma unroll
        for (int mt = 0; mt < 4; ++mt)
#pragma unroll
            for (int nt = 0; nt < 4; ++nt) acc[mt][nt] = (f32x4){0.f, 0.f, 0.f, 0.f};
#pragma unroll
        for (int ks = 0; ks < 4; ++ks) { bf16x8 af[4], bfr[4];
#pragma unroll
            for (int q = 0; q < 4; ++q) { af[q] = *(const bf16x8*)(Ap + (size_t)(16 * q + fr) * DM + 128 * wave + 32 * ks + 8 * kg); bfr[q] = *(const bf16x8*)(Bp + (size_t)(16 * q + fr) * DM + 128 * wave + 32 * ks + 8 * kg); }
#pragma unroll
            for (int mt = 0; mt < 4; ++mt)
#pragma unroll
                for (int nt = 0; nt < 4; ++nt) acc[mt][nt] = __builtin_amdgcn_mfma_f32_16x16x32_bf16(af[mt], bfr[nt], acc[mt][nt], 0, 0, 0); }
#pragma unroll
        for (int mt = 0; mt < 4; ++mt)
#pragma unroll
            for (int nt = 0; nt < 4; ++nt)
#pragma unroll
                for (int j = 0; j < 4; ++j) sRed[(wave * 64 + 16 * mt + 4 * kg + j) * 64 + 16 * nt + fr] = acc[mt][nt][j];
        __syncthreads();
#pragma unroll
        for (int q = 0; q < 8; ++q) { const int e2 = tid + 512 * q, row = e2 >> 6, col = e2 & 63; float s = 0.f;
#pragma unroll
            for (int w2 = 0; w2 < 8; ++w2) s += sRed[(w2 * 64 + row) * 64 + col];
            Cp[(size_t)row * ldc + col] = (bf16_t)f2bf(s); }
    }
}
__device__ __forceinline__ void phase5_gemm(const Params& p, int b, LAS unsigned char* lds) {
    const int G = gridDim.x, c = opq_bid(); bf16_t* P = proj_ptr(p); float* scr = scr_ptr(p, b);
    bf16_t* scrB = P + 2048;
    bf16_t* scrA = (bf16_t*)scr;
    unsigned* flag = (unsigned*)(wsb(p) + WS_CTL) + 4096 + (b * 128 + (c & 127)) * 16;
    if (c < 128) {
        pg8::Gemm g{P + C_Z, (const bf16_t*)(wsb(p) + WS_WSSD), SEQ, DM, 2048, LD, 2048}; pg8::StaticOrder S; S.init(SEQ, DM, 128, c); pg8::EpiMerge2<0, false> E{P, scrA, 1024, nullptr, 0, nullptr, 0};
        pg8::gemm_phase<pg8::EpiMerge2<0, false>, pg8::StaticOrder, false, PG8_SP2>(lds, g, S, E);
#ifdef PROBE_NOFENCE
        asm volatile("s_waitcnt vmcnt(0)" ::: "memory"); __syncthreads();
        if (threadIdx.x == 0) __hip_atomic_store(flag, 1u, __ATOMIC_RELAXED, __HIP_MEMORY_SCOPE_AGENT);
#else
        asm volatile("s_waitcnt vmcnt(0)" ::: "memory"); __syncthreads();
        if (threadIdx.x == 0) { __builtin_amdgcn_fence(__ATOMIC_RELEASE, "agent"); asm volatile("s_waitcnt vmcnt(0)" ::: "memory");
            __hip_atomic_store(flag, 1u, __ATOMIC_RELAXED, __HIP_MEMORY_SCOPE_AGENT); }
#endif
        if (b == 0 && G == 256) { const int tid2 = opq_tid(); xn_rows(p, SEQ, MTOK, c * 8 + (tid2 >> 6), 128 * 8, tid2 & 63); }
    } else {
        { pg8::Gemm g{P + C_LG, (const bf16_t*)(wsb(p) + WS_WLRU), SEQ, DM, 1536, LD, 1536}; pg8::StaticOrder S; S.init(SEQ, DM, 128, c - 128); pg8::EpiMerge2<1, false> E{P, scrB, LD, nullptr, 0, nullptr, 0};
          pg8::gemm_phase<pg8::EpiMerge2<1, false>, pg8::StaticOrder, false, PG8_SP2>(lds, g, S, E); }
        if (threadIdx.x == 0) { unsigned spins = 0; while (__hip_atomic_load(flag, __ATOMIC_RELAXED, __HIP_MEMORY_SCOPE_AGENT) == 0u && ++spins < (1u << 22)) __builtin_amdgcn_s_sleep(2);
#ifndef PROBE_NOFENCE
            __builtin_amdgcn_fence(__ATOMIC_ACQUIRE, "agent"); asm volatile("s_waitcnt vmcnt(0)" ::: "memory");
#endif
        }
        __syncthreads();
        { pg8::Gemm g{P + C_Q, (const bf16_t*)(wsb(p) + WS_WMEM), SEQ, DM, 1024, LD, 1024}; pg8::StaticOrder S; S.init(SEQ, DM, 128, c - 128); pg8::EpiMerge2<2, true> E{P, scrB, LD, scrA, 1024, merged_ptr(p, b), merged_ld(b)};
          pg8::gemm_phase<pg8::EpiMerge2<2, true>, pg8::StaticOrder, false, PG8_SP2>(lds, g, S, E); }
    }
}
__device__ __forceinline__ void phase6_gemm(const Params& p, int b, LAS unsigned char* lds) {
    const int G = gridDim.x, c = opq_bid(); bf16_t* P = proj_ptr(p);
    pg8::Gemm g{merged_ptr(p, b), (const bf16_t*)(wsb(p) + WS_WOUT), SEQ, DM, DM, merged_ld(b), DM}; pg8::StaticOrder S; S.init(SEQ, DM, G, c);
    pg8::EpiOutNorm E{opq(p.x) + (size_t)b * SEQ * DM, opq(p.out) + (size_t)b * SEQ * DM, opq(p.final_g), (float*)(wsb(p) + WS_XBUF) + (size_t)b * SEQ * 4, (unsigned*)(wsb(p) + WS_CTL) + 8192 + b * 2048};
    pg8::gemm_phase<pg8::EpiOutNorm, pg8::StaticOrder, false, PG8_SP2>(lds, g, S, E);
}
#define MFMA16(a, b, c) __builtin_amdgcn_mfma_f32_16x16x32_bf16((a), (b), (c), 0, 0, 0)
__device__ __forceinline__ bf16x8 pack8(const float (&v)[8]) {
    u32x4 w; w.x = pk2(v[0], v[1]); w.y = pk2(v[2], v[3]); w.z = pk2(v[4], v[5]); w.w = pk2(v[6], v[7]); return __builtin_bit_cast(bf16x8, w);
}
__device__ __forceinline__ void unpack8(u32x4 w, float (&v)[8]) {
#pragma unroll
    for (int i = 0; i < 4; ++i) { v[2 * i] = __uint_as_float(w[i] << 16); v[2 * i + 1] = __uint_as_float(w[i] & 0xffff0000u); }
}
__device__ __forceinline__ void attn_phase(const Params& p, int b, LAS unsigned char* lds, int dry = 0) {
    const int tid = opq_tid(), lane = tid & 63, wave = tid >> 6, fr = lane & 15, kg = lane >> 4;
    bf16_t* P = proj_ptr(p); const bf16_t* KK = (const bf16_t*)(wsb(p) + WS_KVK) + (size_t)b * 256 * 1024; const bf16_t* VT = (const bf16_t*)(wsb(p) + WS_KVVT) + b * 256;
    LAS bf16_t* sKV = (LAS bf16_t*)lds;
    for (int u = opq_bid(); u < 256; u += gridDim.x) {
        const int hd = u & 3, rt = u >> 2, q0 = rt * 128 + wave * 16;
        bf16_t* qrow = P + (size_t)(q0 + fr) * LD + C_Q + hd * 256;
        __syncthreads();
        { unsigned ko = (unsigned)((tid >> 5) * 1024 + hd * 256 + 8 * (tid & 31)); asm volatile("" : "+v"(ko));
          u32x4 st[16];
#pragma unroll
          for (int i = 0; i < 16; ++i) st[i] = *(const u32x4*)(KK + (ko + (unsigned)(i * 16 * 1024)));
#pragma unroll
          for (int i = 0; i < 16; ++i) *(LAS u32x4*)(sKV + ((tid >> 5) + 16 * i) * 264 + 8 * (tid & 31)) = st[i]; }
        bf16x8 qf[8];
#pragma unroll
        for (int s = 0; s < 8; ++s) qf[s] = *(const bf16x8*)(qrow + 32 * s + 8 * kg);
        __syncthreads();
        u32x4 vst[16];
        { unsigned vo = (unsigned)((hd * 256 + (tid >> 5)) * 512 + 8 * (tid & 31)); asm volatile("" : "+v"(vo));
#pragma unroll
          for (int i = 0; i < 16; ++i) vst[i] = *(const u32x4*)(VT + (vo + (unsigned)(i * 16 * 512))); }
        f32x4 sacc[16];
#pragma unroll
        for (int mt = 0; mt < 16; ++mt) { sacc[mt] = (f32x4){0.f, 0.f, 0.f, 0.f};
#pragma unroll
            for (int s = 0; s < 8; ++s) { const bf16x8 kf = *(const LAS bf16x8*)(sKV + (16 * mt + fr) * 264 + 32 * s + 8 * kg); sacc[mt] = MFMA16(kf, qf[s], sacc[mt]); } }
        float mx = -INFINITY;
#pragma unroll
        for (int mt = 0; mt < 16; ++mt)
#pragma unroll
            for (int j = 0; j < 4; ++j) mx = fmaxf(mx, sacc[mt][j]);
        mx = fmaxf(mx, __shfl_xor(mx, 16)); mx = fmaxf(mx, __shfl_xor(mx, 32));
        float sum = 0.f;
#pragma unroll
        for (int mt = 0; mt < 16; ++mt)
#pragma unroll
            for (int j = 0; j < 4; ++j) { const float e = __expf((sacc[mt][j] - mx) * 0.0625f); sacc[mt][j] = e; sum += e; }
        sum += __shfl_xor(sum, 16); sum += __shfl_xor(sum, 32);
        const float inv = 1.f / sum;
        bf16x8 pf[8];
#pragma unroll
        for (int s2 = 0; s2 < 8; ++s2) { u32x4 w; w.x = pk2(sacc[2 * s2][0], sacc[2 * s2][1]); w.y = pk2(sacc[2 * s2][2], sacc[2 * s2][3]);
            w.z = pk2(sacc[2 * s2 + 1][0], sacc[2 * s2 + 1][1]); w.w = pk2(sacc[2 * s2 + 1][2], sacc[2 * s2 + 1][3]); pf[s2] = __builtin_bit_cast(bf16x8, w); }
        __syncthreads();
#pragma unroll
        for (int i = 0; i < 16; ++i) *(LAS u32x4*)(sKV + ((tid >> 5) + 16 * i) * 264 + 8 * (tid & 31)) = vst[i];
        __syncthreads();
#pragma unroll 4
        for (int mt2 = 0; mt2 < 16; ++mt2) { f32x4 o = (f32x4){0.f, 0.f, 0.f, 0.f}; const LAS bf16_t* vr = sKV + (16 * mt2 + fr) * 264 + 4 * kg;
#pragma unroll
            for (int s2 = 0; s2 < 8; ++s2) { const u32x2 lo = *(const LAS u32x2*)(vr + 32 * s2), hi = *(const LAS u32x2*)(vr + 32 * s2 + 16);
                u32x4 w; w.x = lo.x; w.y = lo.y; w.z = hi.x; w.w = hi.y; o = MFMA16(__builtin_bit_cast(bf16x8, w), pf[s2], o); }
            u32x2 ow; ow.x = pk2(o[0] * inv, o[1] * inv); ow.y = pk2(o[2] * inv, o[3] * inv);
            if (!dry) *(u32x2*)(qrow + 16 * mt2 + 4 * kg) = ow; }
    }
}
template <bool FINAL> __device__ __forceinline__ void lru_phase(const Params& p, int b, LAS unsigned char* lds, int dry = 0) {
    const int tid = opq_tid(), lane = tid & 63, wave = tid >> 6, fr = lane & 15, kg = lane >> 4;
    bf16_t* P = proj_ptr(p);
    LAS bf16_t* sWA = (LAS bf16_t*)lds; LAS bf16_t* sWX = (LAS bf16_t*)(lds + 19968);
    LAS float* sCW = (LAS float*)(lds + 39936); LAS float* sCB = sCW + 384; LAS float* sBA = sCB + 96; LAS float* sBX = sBA + 96; LAS float* sSP = sBX + 96;
    LAS float* sXL = (LAS float*)(lds + 43008) + wave * 1600;
    LAS float* sAG = (LAS float*)(lds + 94208);
    float* agg = (float*)(wsb(p) + WS_LAGG) + (size_t)b * NBLK64 * LRUW * 2;
    const float* car = (const float*)(wsb(p) + WS_LCAR) + (size_t)b * NBLK64 * LRUW;
    const float* lcw = opq(p.lru_conv_w); const float* lcb = opq(p.lru_conv_b); const float* lba = opq(p.lru_b_a); const float* lbx = opq(p.lru_b_x); const float* lam = opq(p.lru_lambda);
    for (int u = opq_bid(); u < NLB * NSEG; u += gridDim.x) {
        const int n = u % NLB, sg = u / NLB;
        __syncthreads();
        { const bf16_t* gwa = (const bf16_t*)(wsb(p) + WS_LRUWA) + n * 9216; const bf16_t* gwx = (const bf16_t*)(wsb(p) + WS_LRUWX) + n * 9216;
          u32x4 wa3[3], wx3[3]; float cwv = 0.f, v4[4] = {0.f, 0.f, 0.f, 0.f};
#pragma unroll
          for (int i = 0; i < 3; ++i) { const int e = tid + 512 * i; if (e < 96 * 12) { const int j = e / 12, c8 = e % 12; wa3[i] = *(const u32x4*)(gwa + j * 96 + 8 * c8); wx3[i] = *(const u32x4*)(gwx + j * 96 + 8 * c8); } }
          if (tid < 384) cwv = lcw[(tid / 96) * 1536 + n * 96 + tid % 96];
          if (tid < 96) { v4[0] = lcb[n * 96 + tid]; v4[1] = lba[n * 96 + tid]; v4[2] = lbx[n * 96 + tid]; v4[3] = lam[n * 96 + tid]; }
#pragma unroll
          for (int i = 0; i < 3; ++i) { const int e = tid + 512 * i; if (e < 96 * 12) { const int j = e / 12, c8 = e % 12; *(LAS u32x4*)(sWA + j * 104 + 8 * c8) = wa3[i]; *(LAS u32x4*)(sWX + j * 104 + 8 * c8) = wx3[i]; } }
          if (tid < 384) sCW[tid] = cwv;
          if (tid < 96) { sCB[tid] = v4[0]; sBA[tid] = v4[1]; sBX[tid] = v4[2]; sSP[tid] = softplusf_(-v4[3]); } }
        __syncthreads();
        float runA[6], runH[6];
#pragma unroll
        for (int nt = 0; nt < 6; ++nt) { runA[nt] = 1.f; runH[nt] = FINAL ? car[(sg * 8 + wave) * LRUW + n * 96 + 16 * nt + fr] : 0.f; }
        for (int step = 0; step < 4; ++step) {
            const int tb = sg * LSEG + wave * 64 + step * 16;
            u32x4 rawC[3][4];
            { const int t0r = tb + fr - 3; unsigned ro = (unsigned)((t0r < 0 ? 0 : t0r) * LD + C_LX + n * 96 + 8 * kg); asm volatile("" : "+v"(ro));
              if (t0r >= 0) {
#pragma unroll
                  for (int ks = 0; ks < 3; ++ks)
#pragma unroll
                      for (int k = 0; k < 4; ++k) rawC[ks][k] = *(const u32x4*)(P + (ro + (unsigned)(k * LD + 32 * ks)));
              } else {
#pragma unroll
                  for (int ks = 0; ks < 3; ++ks)
#pragma unroll
                      for (int k = 0; k < 4; ++k) { const int t = t0r + k; rawC[ks][k] = *(const u32x4*)(P + (ro + (unsigned)((t < 0 ? 0 : t) * LD + 32 * ks))); if (t < 0) rawC[ks][k] = (u32x4){0u, 0u, 0u, 0u}; }
              } }
            bf16x8 af[3];
#pragma unroll
            for (int ks = 0; ks < 3; ++ks) { const int ch0 = 32 * ks + 8 * kg; float xl[8];
#pragma unroll
                for (int i = 0; i < 8; ++i) xl[i] = sCB[ch0 + i];
#pragma unroll
                for (int k = 0; k < 4; ++k) { const u32x4 raw = rawC[ks][k];
                    float rv[8]; unpack8(raw, rv);
#pragma unroll
                    for (int i = 0; i < 8; ++i) xl[i] += sCW[k * 96 + ch0 + i] * rv[i]; }
                *(LAS f32x4*)(sXL + fr * 100 + ch0) = (f32x4){xl[0], xl[1], xl[2], xl[3]}; *(LAS f32x4*)(sXL + fr * 100 + ch0 + 4) = (f32x4){xl[4], xl[5], xl[6], xl[7]};
                af[ks] = pack8(xl); }
            LAS bf16_t* sG = (LAS bf16_t*)((LAS unsigned char*)sWA + 106496) + wave * 1536;
            unsigned go3[3]; u32x4 graw[3];
            if (FINAL) {
#pragma unroll
                for (int i = 0; i < 3; ++i) { const int e = lane + 64 * i, row = e / 12, c12 = e % 12; go3[i] = (unsigned)((tb + row) * LD + C_LG + n * 96 + 8 * c12); }
                asm volatile("" : "+v"(go3[0]), "+v"(go3[1]), "+v"(go3[2]));
#pragma unroll
                for (int i = 0; i < 3; ++i) graw[i] = *(const u32x4*)(P + go3[i]); }
            f32x4 aR[6], aI[6];
#pragma unroll
            for (int nt = 0; nt < 6; ++nt) { aR[nt] = (f32x4){0.f, 0.f, 0.f, 0.f}; aI[nt] = (f32x4){0.f, 0.f, 0.f, 0.f};
#pragma unroll
                for (int ks = 0; ks < 3; ++ks) { const bf16x8 wa = *(const LAS bf16x8*)(sWA + (16 * nt + fr) * 104 + 32 * ks + 8 * kg), wx = *(const LAS bf16x8*)(sWX + (16 * nt + fr) * 104 + 32 * ks + 8 * kg);
                    aR[nt] = MFMA16(af[ks], wa, aR[nt]); aI[nt] = MFMA16(af[ks], wx, aI[nt]); } }
            float Ainc[6][4], Hinc[6][4];
#pragma unroll
            for (int nt = 0; nt < 6; ++nt) { const int j = 16 * nt + fr; const float ba2 = -1.44269504f * sBA[j], bx2 = -1.44269504f * sBX[j], spc = -8.f * 1.44269504f * sSP[j];
                float A = 1.f, H = 0.f;
#pragma unroll
                for (int r = 0; r < 4; ++r) { const float xlv = sXL[(4 * kg + r) * 100 + j];
                    const float rr = __builtin_amdgcn_rcpf(1.f + __builtin_amdgcn_exp2f(fmaf(aR[nt][r], -1.44269504f, ba2))), ii = __builtin_amdgcn_rcpf(1.f + __builtin_amdgcn_exp2f(fmaf(aI[nt][r], -1.44269504f, bx2)));
                    const float a = __builtin_amdgcn_exp2f(rr * spc), mult = __builtin_amdgcn_sqrtf(fmaxf(0.f, fmaf(-a, a, 1.f)));
                    H = a * H + mult * ii * xlv; A *= a; Ainc[nt][r] = A; Hinc[nt][r] = H; }
                float ap = 1.f, hp = 0.f, at = 1.f, ht = 0.f;
#pragma unroll
                for (int k = 0; k < 4; ++k) { const float ab = __shfl(A, fr + 16 * k), hb = __shfl(H, fr + 16 * k);
                    if (k < kg) { hp = ab * hp + hb; ap *= ab; } ht = ab * ht + hb; at *= ab; }
                if (FINAL) { const float hin = ap * runH[nt] + hp;
#pragma unroll
                    for (int r = 0; r < 4; ++r) Hinc[nt][r] = Ainc[nt][r] * hin + Hinc[nt][r]; }
                runH[nt] = at * runH[nt] + ht; runA[nt] *= at; }
            if (FINAL) {
#pragma unroll
                for (int i = 0; i < 3; ++i) { const int e = lane + 64 * i; *(LAS u32x4*)(sG + (e / 12) * 96 + 8 * (e % 12)) = graw[i]; }
                asm volatile("s_waitcnt lgkmcnt(0)" ::: "memory");
#pragma unroll
                for (int nt = 0; nt < 6; ++nt)
#pragma unroll
                    for (int r = 0; r < 4; ++r) { LAS bf16_t* gp = sG + (4 * kg + r) * 96 + 16 * nt + fr; const float yv = Hinc[nt][r] * siluf_(bf2f(*gp)); *gp = (bf16_t)f2bf(yv); }
                asm volatile("s_waitcnt lgkmcnt(0)" ::: "memory");
#pragma unroll
                for (int i = 0; i < 3; ++i) { const int e = lane + 64 * i; const u32x4 w = *(const LAS u32x4*)(sG + (e / 12) * 96 + 8 * (e % 12)); if (!dry) *(u32x4*)(P + go3[i]) = w; }
                asm volatile("s_waitcnt lgkmcnt(0)" ::: "memory"); }
        }
        if (!FINAL && kg == 0) {
#pragma unroll
            for (int nt = 0; nt < 6; ++nt) { const int ch = n * 96 + 16 * nt + fr; agg[((size_t)(sg * 8 + wave) * LRUW + ch) * 2] = runA[nt]; agg[((size_t)(sg * 8 + wave) * LRUW + ch) * 2 + 1] = runH[nt]; } }
    }
}
__device__ __forceinline__ void lru_carry_phase(const Params& p, int b) {
    const int gt = opq_bid() * 512 + opq_tid();
    const float* agg = (const float*)(wsb(p) + WS_LAGG) + (size_t)b * NBLK64 * LRUW * 2; float* car = (float*)(wsb(p) + WS_LCAR) + (size_t)b * NBLK64 * LRUW;
    for (int ch = gt; ch < LRUW; ch += gridDim.x * 512) { float h = 0.f;
        for (int k0 = 0; k0 < NBLK64; k0 += 16) { float a[16], hh[16];
#pragma unroll
            for (int i = 0; i < 16; ++i) { a[i] = agg[((size_t)(k0 + i) * LRUW + ch) * 2]; hh[i] = agg[((size_t)(k0 + i) * LRUW + ch) * 2 + 1]; }
#pragma unroll
            for (int i = 0; i < 16; ++i) { car[(k0 + i) * LRUW + ch] = h; h = a[i] * h + hh[i]; } } }
}
__device__ __forceinline__ void conv8_silu(const bf16_t* P, int t, int col, const float* cw, const float* cb, int ch, float (&o)[8]) {
    float r[11];
    unsigned off0 = (unsigned)((t < 3 ? 0 : t - 3) * LD + col); asm volatile("" : "+v"(off0));
    if (t >= 3) {
#pragma unroll
        for (int i = 0; i < 11; ++i) r[i] = bf2f(P[off0 + (unsigned)(i * LD)]);
    } else {
#pragma unroll
        for (int i = 0; i < 11; ++i) { const int tt = t - 3 + i; const float v = bf2f(P[off0 + (unsigned)((tt < 0 ? 0 : tt) * LD)]); r[i] = tt < 0 ? 0.f : v; }
    }
    const float w0 = cw[ch], w1 = cw[3072 + ch], w2 = cw[6144 + ch], w3 = cw[9216 + ch], bb = cb[ch];
#pragma unroll
    for (int j = 0; j < 8; ++j) o[j] = siluf_(bb + w0 * r[j] + w1 * r[j + 1] + w2 * r[j + 2] + w3 * r[j + 3]);
}
__device__ __forceinline__ float ssd_dt_setup(const Params& p, const bf16_t* P, int t0, int h, int lane, LAS float* sACS, LAS float* sDT) {
    const float dtb = opq(p.ssd_dt_bias)[h], an = -__expf(opq(p.ssd_a_log)[h]);
    const float dt0 = softplusf_(bf2f(P[(size_t)(t0 + 2 * lane) * LD + C_DT + h]) + dtb), dt1 = softplusf_(bf2f(P[(size_t)(t0 + 2 * lane + 1) * LD + C_DT + h]) + dtb);
    const float dA1 = dt1 * an; float s = dt0 * an + dA1;
#pragma unroll
    for (int o = 1; o < 64; o <<= 1) { const float t = __shfl_up(s, o); if (lane >= o) s += t; }
    sACS[2 * lane] = s - dA1; sACS[2 * lane + 1] = s; sDT[2 * lane] = dt0; sDT[2 * lane + 1] = dt1;
    return __shfl(s, 63);
}
template <int R> __device__ __forceinline__ void conv_rows(const bf16_t* P, int t, int col, const float* cw, const float* cb, int ch, float (&o)[R][8]) {
    unsigned off0 = (unsigned)((t < 3 ? 0 : t - 3) * LD + col); asm volatile("" : "+v"(off0));
    u32x4 raw[R + 3];
    if (t >= 3) {
#pragma unroll
        for (int i = 0; i < R + 3; ++i) raw[i] = *(const u32x4*)(P + (off0 + (unsigned)(i * LD)));
    } else {
#pragma unroll
        for (int i = 0; i < R + 3; ++i) { const int tt = t - 3 + i; raw[i] = *(const u32x4*)(P + (off0 + (unsigned)((tt < 0 ? 0 : tt) * LD))); if (tt < 0) raw[i] = (u32x4){0u, 0u, 0u, 0u}; }
    }
    float w[4][8], bb[8];
#pragma unroll
    for (int k = 0; k < 4; ++k) { const f32x4 w0 = *(const f32x4*)(cw + k * 3072 + ch), w1 = *(const f32x4*)(cw + k * 3072 + ch + 4);
        w[k][0] = w0[0]; w[k][1] = w0[1]; w[k][2] = w0[2]; w[k][3] = w0[3]; w[k][4] = w1[0]; w[k][5] = w1[1]; w[k][6] = w1[2]; w[k][7] = w1[3]; }
    { const f32x4 b0 = *(const f32x4*)(cb + ch), b1 = *(const f32x4*)(cb + ch + 4); bb[0] = b0[0]; bb[1] = b0[1]; bb[2] = b0[2]; bb[3] = b0[3]; bb[4] = b1[0]; bb[5] = b1[1]; bb[6] = b1[2]; bb[7] = b1[3]; }
#pragma unroll
    for (int r = 0; r < R; ++r)
#pragma unroll
        for (int q = 0; q < 8; ++q) o[r][q] = bb[q];
#pragma unroll
    for (int i = 0; i < R + 3; ++i) { float v[8]; unpack8(raw[i], v);
#pragma unroll
        for (int k = 0; k < 4; ++k) { const int r = i - k; if (r >= 0 && r < R) {
#pragma unroll
                for (int q = 0; q < 8; ++q) o[r][q] += w[k][q] * v[q]; } } }
#pragma unroll
    for (int r = 0; r < R; ++r)
#pragma unroll
        for (int q = 0; q < 8; ++q) o[r][q] = siluf_(o[r][q]);
}
__device__ __forceinline__ void ssd_states_phase(const Params& p, int b, LAS unsigned char* lds) {
    const int tid = opq_tid(), lane = tid & 63, wave = tid >> 6, fr = lane & 15, kg = lane >> 4;
    const bf16_t* P = proj_ptr(p); bf16_t* ST = states_ptr(p, b); float* dasum = (float*)(wsb(p) + WS_DASUM) + b * NCHUNK * NHEAD;
    const float* cw = opq(p.ssd_conv_w); const float* cb = opq(p.ssd_conv_b);
    LAS bf16_t* sBT = (LAS bf16_t*)lds; LAS bf16_t* sXT = (LAS bf16_t*)(lds + 34816 + wave * 8704);
    LAS float* sACS = (LAS float*)(lds + 104448) + wave * 128; LAS float* sW = (LAS float*)(lds + 108544) + wave * 128;
    for (int u = opq_bid(); u < NCHUNK * NGRP; u += gridDim.x) {
        const int c = u >> 2, g = u & 3, t0 = c * CHUNK, h = 8 * g + wave;
        __syncthreads();
        { const float tot = ssd_dt_setup(p, P, t0, h, lane, sACS, sW);
          if (lane == 0) dasum[c * NHEAD + h] = tot;
          sW[2 * lane] = sW[2 * lane] * __expf(tot - sACS[2 * lane]); sW[2 * lane + 1] = sW[2 * lane + 1] * __expf(tot - sACS[2 * lane + 1]); }
        { const int cg = tid & 15, rs = tid >> 4; float o[4][8];
          conv_rows<4>(P, t0 + 4 * rs, C_B + g * 128 + 8 * cg, cw, cb, 2048 + g * 128 + 8 * cg, o);
#pragma unroll
          for (int q = 0; q < 8; ++q) { u32x2 w; w.x = pk2(o[0][q], o[1][q]); w.y = pk2(o[2][q], o[3][q]); *(LAS u32x2*)(sBT + (8 * cg + q) * 136 + 4 * rs) = w; } }
        __syncthreads();
        for (int ph = 0; ph < 2; ++ph) {
            { const int cg = lane & 3, rs = lane >> 2; float o[8][8];
              conv_rows<8>(P, t0 + 8 * rs, C_X + h * 64 + 32 * ph + 8 * cg, cw, cb, h * 64 + 32 * ph + 8 * cg, o);
              const f32x4 w0 = *(const LAS f32x4*)(sW + 8 * rs), w1 = *(const LAS f32x4*)(sW + 8 * rs + 4);
#pragma unroll
              for (int q = 0; q < 8; ++q) { float v[8] = {o[0][q] * w0[0], o[1][q] * w0[1], o[2][q] * w0[2], o[3][q] * w0[3], o[4][q] * w1[0], o[5][q] * w1[1], o[6][q] * w1[2], o[7][q] * w1[3]};
                  *(LAS bf16x8*)(sXT + (8 * cg + q) * 136 + 8 * rs) = pack8(v); } }
            asm volatile("s_waitcnt lgkmcnt(0)" ::: "memory");
            f32x4 acc[8][2];
#pragma unroll
            for (int mt = 0; mt < 8; ++mt) { acc[mt][0] = (f32x4){0.f, 0.f, 0.f, 0.f}; acc[mt][1] = (f32x4){0.f, 0.f, 0.f, 0.f}; }
#pragma unroll
            for (int s = 0; s < 4; ++s) { const bf16x8 x0 = *(const LAS bf16x8*)(sXT + fr * 136 + 32 * s + 8 * kg), x1 = *(const LAS bf16x8*)(sXT + (16 + fr) * 136 + 32 * s + 8 * kg);
#pragma unroll
                for (int mt = 0; mt < 8; ++mt) { const bf16x8 a = *(const LAS bf16x8*)(sBT + (16 * mt + fr) * 136 + 32 * s + 8 * kg);
                    acc[mt][0] = MFMA16(a, x0, acc[mt][0]); acc[mt][1] = MFMA16(a, x1, acc[mt][1]); } }
            asm volatile("s_waitcnt lgkmcnt(0)" ::: "memory");
#pragma unroll
            for (int mt = 0; mt < 8; ++mt)
#pragma unroll
                for (int nt = 0; nt < 2; ++nt) { const int n0 = 16 * mt + 4 * kg, pp = 32 * ph + 16 * nt + fr;
                    u32x2 w; w.x = pk2(acc[mt][nt][0], acc[mt][nt][1]); w.y = pk2(acc[mt][nt][2], acc[mt][nt][3]);
                    *(u32x2*)(ST + ((size_t)(c * NHEAD + h) * 64 + pp) * 128 + n0) = w; }
        }
    }
}
__device__ __forceinline__ void ssd_scan_phase(const Params& p, int b, int dry = 0) {
    unsigned* st = (unsigned*)states_ptr(p, b); const float* dasum = (const float*)(wsb(p) + WS_DASUM) + b * NCHUNK * NHEAD;
    for (int e2 = opq_bid() * 512 + opq_tid(); e2 < 131072; e2 += gridDim.x * 512) {
        const int h = e2 >> 12; float r0 = 0.f, r1 = 0.f;
        for (int c0 = 0; c0 < NCHUNK; c0 += 16) { unsigned v[16]; float d[16];
#pragma unroll
            for (int i = 0; i < 16; ++i) { v[i] = st[(size_t)(c0 + i) * 131072 + e2]; d[i] = dasum[(c0 + i) * NHEAD + h]; }
#pragma unroll
            for (int i = 0; i < 16; ++i) { const unsigned w = pk2(r0, r1); const float dd = __expf(d[i]);
                r0 = r0 * dd + __uint_as_float(v[i] << 16); r1 = r1 * dd + __uint_as_float(v[i] & 0xffff0000u); v[i] = w; }
            if (!dry) {
#pragma unroll
                for (int i = 0; i < 16; ++i) st[(size_t)(c0 + i) * 131072 + e2] = v[i]; } }
    }
}
__device__ __forceinline__ void ssd_out_phase(const Params& p, int b, LAS unsigned char* lds, int dry = 0) {
    const int tid = opq_tid(), lane = tid & 63, wave = tid >> 6, fr = lane & 15, kg = lane >> 4;
    bf16_t* P = proj_ptr(p); const bf16_t* ST = states_ptr(p, b);
    const float* cw = opq(p.ssd_conv_w); const float* cb = opq(p.ssd_conv_b);
    LAS bf16_t* sC = (LAS bf16_t*)lds; LAS bf16_t* sCB = (LAS bf16_t*)(lds + 34816); LAS bf16_t* sB = (LAS bf16_t*)(lds + 69632); LAS bf16_t* sXT = (LAS bf16_t*)(lds + 69632 + wave * 8704);
    LAS float* sACS = (LAS float*)(lds + 139264) + wave * 128; LAS float* sDT = (LAS float*)(lds + 143360) + wave * 128; LAS float* sSSQ = (LAS float*)(lds + 147456);
    for (int u = opq_bid(); u < NCHUNK * NGRP; u += gridDim.x) {
        const int c = u >> 2, g = u & 3, t0 = c * CHUNK, h = 8 * g + wave;
        __syncthreads();
        MSTAMP(p, 0);
        (void)ssd_dt_setup(p, P, t0, h, lane, sACS, sDT);
        { const int cg = tid & 15, rs = (tid >> 4) & 15, isC = tid >> 8; float o[8][8];
          conv_rows<8>(P, t0 + 8 * rs, C_B + isC * 512 + g * 128 + 8 * cg, cw, cb, 2048 + isC * 512 + g * 128 + 8 * cg, o);
          LAS bf16_t* dst = (isC ? sC : sB) + (8 * rs) * 136 + 8 * cg;
#pragma unroll
          for (int r = 0; r < 8; ++r) *(LAS bf16x8*)(dst + r * 136) = pack8(o[r]); }
        __syncthreads();
#pragma unroll
        for (int ms = 0; ms < 8; ++ms) if (ms <= wave) { f32x4 a4 = (f32x4){0.f, 0.f, 0.f, 0.f};
#pragma unroll
            for (int kn = 0; kn < 4; ++kn) { const bf16x8 a = *(const LAS bf16x8*)(sB + (16 * ms + fr) * 136 + 32 * kn + 8 * kg), bb = *(const LAS bf16x8*)(sC + (16 * wave + fr) * 136 + 32 * kn + 8 * kg);
                a4 = MFMA16(a, bb, a4); }
            u32x2 w; w.x = pk2(a4[0], a4[1]); w.y = pk2(a4[2], a4[3]);
            *(LAS u32x2*)(sCB + (16 * wave + fr) * 136 + 16 * ms + 4 * kg) = w; }
        __syncthreads();
        MSTAMP(p, 1);
        const float Dh = opq(p.ssd_d)[h];
        const unsigned zbase0 = (unsigned)((t0 + fr) * LD + C_Z + h * 64 + 4 * kg);
        float ssq[8];
#pragma unroll
        for (int nt = 0; nt < 8; ++nt) ssq[nt] = 0.f;
        for (int ph = 0; ph < 2; ++ph) {
            unsigned zb = zbase0 + 32u * ph; asm volatile("" : "+v"(zb));
            unsigned pfo = (unsigned)(((c * NHEAD + h) * 64 + 32 * ph + fr) * 128 + 8 * kg); asm volatile("" : "+v"(pfo));
            bf16x8 pf[4][2];
#pragma unroll
            for (int sn = 0; sn < 4; ++sn) { pf[sn][0] = *(const bf16x8*)(ST + (pfo + (unsigned)(32 * sn))); pf[sn][1] = *(const bf16x8*)(ST + (pfo + (unsigned)(16 * 128 + 32 * sn))); }
            { const int cg = lane & 3, rs = lane >> 2; float o[8][8];
              conv_rows<8>(P, t0 + 8 * rs, C_X + h * 64 + 32 * ph + 8 * cg, cw, cb, h * 64 + 32 * ph + 8 * cg, o);
#pragma unroll
              for (int q = 0; q < 8; ++q) { float v[8] = {o[0][q], o[1][q], o[2][q], o[3][q], o[4][q], o[5][q], o[6][q], o[7][q]};
                  *(LAS bf16x8*)(sXT + (8 * cg + q) * 136 + 8 * rs) = pack8(v); } }
            asm volatile("s_waitcnt lgkmcnt(0)" ::: "memory");
            f32x4 acc[2][8];
#pragma unroll
            for (int nt = 0; nt < 8; ++nt) { acc[0][nt] = (f32x4){0.f, 0.f, 0.f, 0.f}; acc[1][nt] = (f32x4){0.f, 0.f, 0.f, 0.f}; }
#pragma unroll
            for (int nt = 0; nt < 8; ++nt) {
#pragma unroll
                for (int sn = 0; sn < 4; ++sn) { const bf16x8 cf = *(const LAS bf16x8*)(sC + (16 * nt + fr) * 136 + 32 * sn + 8 * kg);
                    acc[0][nt] = MFMA16(pf[sn][0], cf, acc[0][nt]); acc[1][nt] = MFMA16(pf[sn][1], cf, acc[1][nt]); }
                const float sc = __expf(sACS[16 * nt + fr]);
                acc[0][nt] *= sc; acc[1][nt] *= sc; }
#pragma unroll
            for (int sk = 0; sk < 4; ++sk) {
                const int s0 = 32 * sk + 8 * kg;
                const bf16x8 xa0 = *(const LAS bf16x8*)(sXT + fr * 136 + s0), xa1 = *(const LAS bf16x8*)(sXT + (16 + fr) * 136 + s0);
                const f32x4 as0 = *(const LAS f32x4*)(sACS + s0), as1 = *(const LAS f32x4*)(sACS + s0 + 4), d0 = *(const LAS f32x4*)(sDT + s0), d1 = *(const LAS f32x4*)(sDT + s0 + 4);
#pragma unroll
                for (int nt = 0; nt < 8; ++nt) if (nt >= 2 * sk) { const int l = 16 * nt + fr; const float acsl = sACS[l];
                    float cbv[8]; unpack8(*(const LAS u32x4*)(sCB + l * 136 + s0), cbv);
                    float m[8];
#pragma unroll
                    for (int i = 0; i < 8; ++i) { const int s = s0 + i; const float as = i < 4 ? as0[i & 3] : as1[i & 3], ds = i < 4 ? d0[i & 3] : d1[i & 3];
                        float mv = (s <= l) ? cbv[i] * __expf(acsl - as) * ds : 0.f; if (s == l) mv += Dh; m[i] = mv; }
                    const bf16x8 mb = pack8(m);
                    acc[0][nt] = MFMA16(xa0, mb, acc[0][nt]); acc[1][nt] = MFMA16(xa1, mb, acc[1][nt]);
                    asm volatile("" ::: "memory"); }
            }
            u32x2 zall[8][2];
#pragma unroll
            for (int nt = 0; nt < 8; ++nt)
#pragma unroll
                for (int mt = 0; mt < 2; ++mt) zall[nt][mt] = *(const u32x2*)(P + (zb + (unsigned)(16 * nt * LD + 16 * mt)));
#pragma unroll
            for (int nt = 0; nt < 8; ++nt)
#pragma unroll
                for (int mt = 0; mt < 2; ++mt) { u32x2* zp = (u32x2*)(P + (zb + (unsigned)(16 * nt * LD + 16 * mt)));
                    const u32x2 zw = zall[nt][mt]; float y[4];
                    y[0] = acc[mt][nt][0] * siluf_(__uint_as_float(zw.x << 16)); y[1] = acc[mt][nt][1] * siluf_(__uint_as_float(zw.x & 0xffff0000u));
                    y[2] = acc[mt][nt][2] * siluf_(__uint_as_float(zw.y << 16)); y[3] = acc[mt][nt][3] * siluf_(__uint_as_float(zw.y & 0xffff0000u));
                    ssq[nt] += (y[0] * y[0] + y[1] * y[1]) + (y[2] * y[2] + y[3] * y[3]);
                    u32x2 yw; yw.x = pk2(y[0], y[1]); yw.y = pk2(y[2], y[3]); (void)zp; *(LAS u32x2*)(sXT + (16 * nt + fr) * 32 + 16 * mt + 4 * kg) = yw; }
            asm volatile("s_waitcnt lgkmcnt(0)" ::: "memory");
            { const int rr = lane >> 2, cc = lane & 3;
              unsigned so = (unsigned)((t0 + rr) * LD + C_Z + h * 64 + 32 * ph + 8 * cc); asm volatile("" : "+v"(so));
              if (ph == 0) {
#pragma unroll
                  for (int i = 0; i < 8; ++i) { const u32x4 w = *(const LAS u32x4*)(sXT + (16 * i + rr) * 32 + 8 * cc); if (!dry) *(u32x4*)(P + (so + (unsigned)(16 * i * LD))) = w; } } }
            asm volatile("s_waitcnt lgkmcnt(0)" ::: "memory");
        }
        MSTAMP(p, 2);
#pragma unroll
        for (int nt = 0; nt < 8; ++nt) { float v = ssq[nt]; v += __shfl_xor(v, 16); v += __shfl_xor(v, 32); if (kg == 0) sSSQ[wave * 128 + 16 * nt + fr] = v; }
        __syncthreads();
        { const int rr = lane >> 2, cc = lane & 3;
          const float* ng = opq(p.ssd_norm_g) + g * 512 + wave * 64 + 8 * cc;
          f32x4 gg[2][2];
#pragma unroll
          for (int ph = 0; ph < 2; ++ph) { gg[ph][0] = *(const f32x4*)(ng + 32 * ph); gg[ph][1] = *(const f32x4*)(ng + 32 * ph + 4); }
          unsigned so = (unsigned)((t0 + rr) * LD + C_Z + h * 64 + 8 * cc); asm volatile("" : "+v"(so));
          u32x4 yv[8][2];
#pragma unroll
          for (int i = 0; i < 8; ++i)
#pragma unroll
              for (int ph = 0; ph < 2; ++ph) yv[i][ph] = ph == 0 ? *(const u32x4*)(P + (so + (unsigned)(16 * i * LD))) : *(const LAS u32x4*)(sXT + (16 * i + rr) * 32 + 8 * cc);
#pragma unroll
          for (int i = 0; i < 8; ++i) { const int l = 16 * i + rr; float tot = 0.f;
#pragma unroll
              for (int w2 = 0; w2 < 8; ++w2) tot += sSSQ[w2 * 128 + l];
              const float rs = 1.f / sqrtf(tot * (1.f / 512.f) + EPS);
#pragma unroll
              for (int ph = 0; ph < 2; ++ph) { float v[8]; unpack8(yv[i][ph], v);
                  v[0] *= rs * gg[ph][0][0]; v[1] *= rs * gg[ph][0][1]; v[2] *= rs * gg[ph][0][2]; v[3] *= rs * gg[ph][0][3];
                  v[4] *= rs * gg[ph][1][0]; v[5] *= rs * gg[ph][1][1]; v[6] *= rs * gg[ph][1][2]; v[7] *= rs * gg[ph][1][3];
                  if (!dry) *(bf16x8*)(P + (so + (unsigned)(16 * i * LD + 32 * ph))) = pack8(v); } } }
        MSTAMP(p, 3);
    }
}
#define XB_TMO      128
#define XB_XCNT(j)  (256  + 64 * (j))
#define XB_XSUB(j)  (1280 + 64 * (j))
#define XB_XGEN(j)  (2304 + 64 * (j))
#define XB_TOP      3328
#define XB_TOPGEN   3392
#define XCD_BAR_WORDS 3456
#define XB_SPIN_CAP (1u << 18)

__device__ __forceinline__ unsigned xb_ld(unsigned* p)              { return __hip_atomic_load(p, __ATOMIC_RELAXED, __HIP_MEMORY_SCOPE_AGENT); }
__device__ __forceinline__ unsigned xb_add(unsigned* p, unsigned v) { return __hip_atomic_fetch_add(p, v, __ATOMIC_RELAXED, __HIP_MEMORY_SCOPE_AGENT); }
__device__ __forceinline__ unsigned xb_xcc_id() { return (unsigned)__builtin_amdgcn_s_getreg((3 << 11) | 20) & 0xFu; }
#define XB_SPIN(cond, bar) do { unsigned _sp = 0; while (cond) { __builtin_amdgcn_s_sleep(1); \
    if ((++_sp & 255u) == 0u) { if (xb_ld(&(bar)[XB_TMO])) break; if (_sp > XB_SPIN_CAP) { atomicAdd(&(bar)[XB_TMO], 1u); break; } } } } while (0)

struct XcdBarrier {
    unsigned* bar; unsigned x;
    volatile LAS unsigned* st;
};

__device__ __forceinline__ XcdBarrier xcd_barrier_post(unsigned* bar, volatile LAS unsigned* st) {
    XcdBarrier b; b.bar = bar; b.x = xb_xcc_id(); b.st = st;
    if (threadIdx.x == 0) (void)xb_add(&bar[XB_XCNT(b.x)], 1u);
    return b;
}
__device__ __forceinline__ void xcd_barrier_complete(unsigned* bar, unsigned x, unsigned& nloc, unsigned& nx) {
    const unsigned G = gridDim.x * gridDim.y * gridDim.z;
    unsigned sum, cnt, mine, sp = 0u;
    for (;;) {
        sum = 0u; cnt = 0u; mine = 0u;
#pragma unroll
        for (unsigned j = 0; j < 16; ++j) { const unsigned c = xb_ld(&bar[XB_XCNT(j)]); sum += c; cnt += (c > 0u) ? 1u : 0u; mine = (j == x) ? c : mine; }
        if (sum == G) break;
        __builtin_amdgcn_s_sleep(1);
        if ((++sp & 255u) == 0u) { if (xb_ld(&bar[XB_TMO])) break; if (sp > XB_SPIN_CAP) { atomicAdd(&bar[XB_TMO], 1u); break; } }
    }
    nloc = mine > 0u ? mine : 1u; nx = cnt > 0u ? cnt : 1u;
}

__device__ __forceinline__ void xcd_barrier(const XcdBarrier& b) {
    asm volatile("s_waitcnt vmcnt(0)" ::: "memory");
    __syncthreads();
    if (threadIdx.x == 0) {
        unsigned* bar = b.bar; asm volatile("" : "+s"(bar));
        unsigned bx = b.x; asm volatile("" : "+s"(bx));
        __builtin_amdgcn_s_waitcnt(0);
        unsigned nloc = b.st[0], nx = b.st[1];
        if (nloc == 0u) { xcd_barrier_complete(bar, bx, nloc, nx); b.st[0] = nloc; b.st[1] = nx; }
        const unsigned old = xb_add(&bar[XB_XSUB(bx)], 1u);
        const unsigned gen = old / nloc;
        if (old + 1u == (gen + 1u) * nloc) {
            __builtin_amdgcn_fence(__ATOMIC_RELEASE, "agent");
            asm volatile("s_waitcnt vmcnt(0)" ::: "memory");
            const unsigned og = xb_add(&bar[XB_TOP], 1u);
            const unsigned tg = og / nx;
            if (og + 1u == (tg + 1u) * nx) xb_add(&bar[XB_TOPGEN], 1u);
            else XB_SPIN(xb_ld(&bar[XB_TOPGEN]) == tg, bar);
            __builtin_amdgcn_fence(__ATOMIC_ACQUIRE, "agent");
            xb_add(&bar[XB_XGEN(bx)], 1u);
            asm volatile("s_waitcnt vmcnt(0)" ::: "memory");
        } else {
            XB_SPIN(xb_ld(&bar[XB_XGEN(bx)]) == gen, bar);
            __builtin_amdgcn_fence(__ATOMIC_ACQUIRE, "agent");
            asm volatile("s_waitcnt vmcnt(0)" ::: "memory");
        }
    }
    __syncthreads();
}

#ifdef REP_COLD
#define REP_SEP() xcd_barrier(bar)
#else
#define REP_SEP() __syncthreads()
#endif
#define RUNP(n, ...) do { if ((n) > 1) { for (int r_ = nrep(n) - 1; r_ > 0; --r_) { const int dry_ = 1; (void)dry_; __VA_ARGS__; REP_SEP(); } } { const int dry_ = 0; (void)dry_; __VA_ARGS__; } } while (0)
#ifndef REP_SYNC
#define REP_SYNC 1
#endif
#ifndef REP_P0
#define REP_P0 1
#endif
#ifndef REP_P1
#define REP_P1 1
#endif
#ifndef REP_P5
#define REP_P5 1
#endif
#ifndef REP_P6
#define REP_P6 1
#endif
#ifndef REP_ST
#define REP_ST 1
#endif
#ifndef REP_LA
#define REP_LA 1
#endif
#ifndef REP_AT
#define REP_AT 1
#endif
#ifndef REP_SC
#define REP_SC 1
#endif
#ifndef REP_SO
#define REP_SO 1
#endif
#ifndef REP_LF
#define REP_LF 1
#endif
__device__ __forceinline__ int nrep(int n) { asm volatile("" : "+s"(n)); return n; }
__device__ __forceinline__ LAS unsigned char* opl(LAS unsigned char* q) { asm volatile("" : "+s"(q)); return q; }
__global__ void __launch_bounds__(512) mk(Params p) {
    extern __shared__ __attribute__((aligned(16))) unsigned char lds_raw[];
    LAS unsigned char* lds = (LAS unsigned char*)lds_raw;
    if (threadIdx.x < 4) ((volatile LAS unsigned*)(lds + LDS_BYTES - 16))[threadIdx.x] = 0u;
    __syncthreads();
    const XcdBarrier bar = xcd_barrier_post((unsigned*)(p.ws + WS_CTL), (volatile LAS unsigned*)(lds + LDS_BYTES - 16));
    if (p.hi > 1000) cg::this_grid().sync();
#ifdef PROBE_SPAN
    unsigned long long ts0 = 0, ts1 = 0;
#define STAMP(i) do { if ((i) == PROBE_SPAN) ts0 = __builtin_amdgcn_s_memrealtime(); if ((i) == PROBE_SPAN + PROBE_LEN) ts1 = __builtin_amdgcn_s_memrealtime(); } while (0)
#else
#define STAMP(i) do { } while (0)
#endif
    STAMP(0);
    RUNP(REP_P0, phase0(p, opl(lds)));
    xcd_barrier(bar); STAMP(1);
#define BATCH_PHASES(b) do { \
        RUNP(REP_P1, phase1_gemm(p, b, opl(lds))); \
        for (int r = 0; r < nrep(REP_SYNC); ++r) xcd_barrier(bar); \
        STAMP(2 + 6 * b); \
        RUNP(REP_ST, ssd_states_phase(p, b, opl(lds))); \
        __syncthreads(); STAMP(20 + 3 * b); \
        RUNP(REP_LA, lru_phase<false>(p, b, opl(lds), 0)); \
        __syncthreads(); STAMP(21 + 3 * b); \
        RUNP(REP_AT, attn_phase(p, b, opl(lds), dry_)); \
        xcd_barrier(bar); STAMP(3 + 6 * b); \
        RUNP(REP_SC, ssd_scan_phase(p, b, dry_)); \
        lru_carry_phase(p, b); \
        if (b == 0 && gridDim.x == 256) { __syncthreads(); transpose_items(p, opl(lds), TI_EARLY, TI_ALL); }     \
        xcd_barrier(bar); STAMP(4 + 6 * b); \
        RUNP(REP_SO, ssd_out_phase(p, b, opl(lds), dry_)); \
        __syncthreads(); STAMP(22 + 3 * b); \
        RUNP(REP_LF, lru_phase<true>(p, b, opl(lds), dry_)); \
        xcd_barrier(bar); STAMP(5 + 6 * b); \
        RUNP(REP_P5, phase5_gemm(p, b, opl(lds))); \
        xcd_barrier(bar); STAMP(6 + 6 * b); \
        RUNP(REP_P6, phase6_gemm(p, b, opl(lds))); \
        if (b + 1 < NBATCH && gridDim.x != 256) xcd_barrier(bar);     \
        STAMP(7 + 6 * b); \
    } while (0)
    BATCH_PHASES(0);
    BATCH_PHASES(1);
#ifdef PROBE_MA
    if (blockIdx.x == 0 && threadIdx.x == 0) { const unsigned long long* tsm = (const unsigned long long*)(p.ws + 255 * MiB); const unsigned long long t2 = __builtin_amdgcn_s_memrealtime(), want = 8ull * (tsm[PROBE_MB] - tsm[PROBE_MA]);
        while (__builtin_amdgcn_s_memrealtime() - t2 < want) __builtin_amdgcn_s_sleep(16); }
#endif
#ifdef PROBE_SPAN
    if (blockIdx.x == 0 && threadIdx.x == 0) { const unsigned long long t2 = __builtin_amdgcn_s_memrealtime(), want = 8ull * (ts1 - ts0);
        while (__builtin_amdgcn_s_memrealtime() - t2 < want) __builtin_amdgcn_s_sleep(16); }
#endif
}

static void launch_mk(Params& p, int lo, int hi, int grid, hipStream_t stream) {
    p.lo = lo; p.hi = hi; void* args[] = {&p};
    (void)hipMemsetAsync(p.ws + WS_CTL, 0, 65536, stream);
    hipError_t e = hipLaunchCooperativeKernel((const void*)mk, dim3(grid), dim3(512), args, LDS_BYTES, stream);
    if (e != hipSuccess) fprintf(stderr, "cooperative launch failed: %s (grid %d)\n", hipGetErrorString(e), grid);
}
extern "C" void kernel_launch(void* const* d_in, const int* in_sizes, int n_in, void* d_out, int out_size, void* d_ws, size_t ws_size, hipStream_t stream) {
    static int grid = 0;
    if (grid == 0) {
        if (n_in != 24 || out_size != MTOK * DM || ws_size < WS_END) { fprintf(stderr, "kernel_launch: unexpected shapes (n_in %d out %d ws %zu)\n", n_in, out_size, ws_size); grid = -1; return; }
        int dev = 0, cus = 0, per_cu = 0;
        hipGetDevice(&dev); hipDeviceGetAttribute(&cus, hipDeviceAttributeMultiprocessorCount, dev);
        hipFuncSetAttribute((const void*)mk, hipFuncAttributeMaxDynamicSharedMemorySize, LDS_BYTES);
        hipOccupancyMaxActiveBlocksPerMultiprocessor(&per_cu, (const void*)mk, 512, LDS_BYTES);
        if (per_cu < 1) { fprintf(stderr, "kernel_launch: occupancy query says %d blocks/CU\n", per_cu); per_cu = 1; }
        grid = cus * 1;
        (void)hipGetLastError();
    }
    if (grid < 0) return;
    Params p{};
    const float** f = (const float**)&p;
    for (int i = 0; i < 24; ++i) f[i] = (const float*)d_in[i];
    p.out = (float*)d_out; p.ws = (unsigned char*)d_ws;
    launch_mk(p, 0, 14, grid, stream);
}
```

```cpp
#define NAIVE_GEMM 0
#define NAIVE_ATT 0
#define NAIVE_LRU 0
#define NAIVE_SSD 0
#define ONE_LAUNCH 1

#include <hip/hip_runtime.h>
#include <hip/hip_cooperative_groups.h>
#include <cstdio>
#include <cstdint>
namespace cg = cooperative_groups;

#ifndef NAIVE_GEMM
#define NAIVE_GEMM 1
#endif
#ifndef NAIVE_SSD
#define NAIVE_SSD 1
#endif
#ifndef NAIVE_LRU
#define NAIVE_LRU 1
#endif
#ifndef NAIVE_ATT
#define NAIVE_ATT 1
#endif
#ifndef ONE_LAUNCH
#define ONE_LAUNCH 0
#endif

namespace pg8 {
#define PG8_LAS __attribute__((address_space(3)))
typedef unsigned short bf16_t;
typedef short bf16x8 __attribute__((ext_vector_type(8)));
typedef float f32x4 __attribute__((ext_vector_type(4)));
typedef unsigned u32x4 __attribute__((ext_vector_type(4)));
constexpr int BM = 256, BK = 64, HALF = 128, HTB = HALF * BK * 2  , STAGE_BYTES = 8 * HTB, NXCD = 8, WGM = 8;

__host__ __device__ __forceinline__ int lds_byte(int r, int c) { const int st = (r >> 4) * 2 + (c >> 5), rr = r & 15, cc = c & 31, ob = rr * 64 + cc * 2; return st * 1024 + (ob ^ (((ob >> 9) & 1) << 5)); }
__host__ __device__ __forceinline__ void stage_rc(int b, int& R, int& C) { const int st = b / 1024, sb = b % 1024, swz = sb ^ (((sb >> 9) & 1) << 5); R = (st >> 1) * 16 + swz / 64; C = (st & 1) * 32 + (swz % 64) / 2; }
__host__ __device__ __forceinline__ int perm32(int rho) { const int n = rho >> 4, i = rho & 15; return 8 * (i >> 2) + 4 * n + (i & 3); }

struct Unit { int pm, pn; };
struct Gemm { const bf16_t* A; const bf16_t* Bt; int M, N, K, lda, ldb; };

struct StaticOrder {
    int nM, nN, nwg, G, c;
    __host__ __device__ void init(int M, int N, int G_, int c_) { nM = M / BM; nN = N / BM; nwg = nM * nN; G = G_; c = c_; }
    __host__ __device__ bool next(int i, Unit& u) const {
        const long L = (long)i * G + c; if (L >= nwg) return false;
        int wgid = (int)L; { const int q = nwg / NXCD, r = nwg % NXCD, xcd = wgid % NXCD, off = wgid / NXCD; wgid = (xcd < r ? xcd * (q + 1) : r * (q + 1) + (xcd - r) * q) + off; }
        const int nig = WGM * nN, gid = wgid / nig, fm = gid * WGM, gsz = (nM - fm) < WGM ? (nM - fm) : WGM;
        u.pm = fm + ((wgid % nig) % gsz); u.pn = (wgid % nig) / gsz; return true;
    }
    __device__ __forceinline__ void a_ready(const Unit&) const {}
    __device__ __forceinline__ void done(const Unit&) const {}
};

__device__ __forceinline__ unsigned cvt_pk_bf16(float lo, float hi) { unsigned r; asm volatile("v_cvt_pk_bf16_f32 %0, %1, %2" : "=v"(r) : "v"(lo), "v"(hi)); return r; }
typedef float f32x2 __attribute__((ext_vector_type(2)));
__device__ __forceinline__ f32x2 gelu_pk(f32x2 v) {
    const f32x2 av = __builtin_elementwise_abs(v), d = av * 0.2316418882f + 1.0f;
    f32x2 t; t.x = __builtin_amdgcn_rcpf(d.x); t.y = __builtin_amdgcn_rcpf(d.y);
    f32x2 q = t * 0.5307027145f + (-0.7265760135f); q = q * t + 0.7107068705f; q = q * t + (-0.142248368f); q = q * t + 0.127414796f; q = q * t;
    const f32x2 s = (v * v) * (-0.72134752044f);
    f32x2 e; e.x = __builtin_amdgcn_exp2f(s.x); e.y = __builtin_amdgcn_exp2f(s.y);
    const f32x2 m = v * (q * e), r = v - m;
    f32x2 o; o.x = v.x < 0.f ? m.x : r.x; o.y = v.y < 0.f ? m.y : r.y; return o;
}

template <int ACT  > struct EpiBf16 {
    static constexpr bool PERM = true, AFTER_DRAIN = false; static_assert(ACT == 0 || ACT == 1, "EpiBf16: ACT is 0 (none) or 1 (gelu_pk)");
    bf16_t* O; int ldc; const float* bias; int split_cols; size_t split_stride; float scale0;
    __device__ __forceinline__ void operator()(const f32x4 (&acc)[2][2][4][2], const Unit& u, int wr, int wc, int fr, int fq) const {
        const int row0 = u.pm * BM + wr * 64 + fr; int colt = u.pn * BM; bf16_t* base = O;
        float sc = 1.f; if (split_cols) { const int t = colt / split_cols; base += (size_t)t * split_stride; colt -= t * split_cols; if (t == 0) sc = scale0; }
        const int col0 = colt + wc * 32 + 8 * fq, bcol0 = u.pn * BM + wc * 32 + 8 * fq;
        f32x4 bv[2][2];
#pragma unroll
        for (int bj = 0; bj < 2; ++bj)
#pragma unroll
            for (int n = 0; n < 2; ++n) bv[bj][n] = bias ? *(const f32x4*)(bias + bcol0 + bj * HALF + 4 * n) : (f32x4){0.f, 0.f, 0.f, 0.f};
#pragma unroll
        for (int ai = 0; ai < 2; ++ai)
#pragma unroll
            for (int m = 0; m < 4; ++m) { bf16_t* rowp = base + (size_t)(row0 + ai * HALF + m * 16) * ldc + col0;
#pragma unroll
                for (int bj = 0; bj < 2; ++bj) { f32x4 v0 = acc[ai][bj][m][0] + bv[bj][0], v1 = acc[ai][bj][m][1] + bv[bj][1];
                    if (ACT == 1) { f32x2 a = gelu_pk((f32x2){v0[0], v0[1]}), b = gelu_pk((f32x2){v0[2], v0[3]}), c = gelu_pk((f32x2){v1[0], v1[1]}), d = gelu_pk((f32x2){v1[2], v1[3]});
                        v0 = (f32x4){a.x, a.y, b.x, b.y}; v1 = (f32x4){c.x, c.y, d.x, d.y}; }
                    v0 = v0 * sc; v1 = v1 * sc; u32x4 w; w.x = cvt_pk_bf16(v0[0], v0[1]); w.y = cvt_pk_bf16(v0[2], v0[3]); w.z = cvt_pk_bf16(v1[0], v1[1]); w.w = cvt_pk_bf16(v1[2], v1[3]);
                    *(u32x4*)(rowp + bj * HALF) = w; } }
    }
};
template <class Epi, class Sched, bool ALIGN_EPI = false, bool SP2 = false>
__device__ __forceinline__ void gemm_phase(PG8_LAS unsigned char* lds, const Gemm g, const Sched& S, const Epi& E) {
    int tid_ = threadIdx.x; asm volatile("" : "+v"(tid_));
    const int tid = tid_, wid = __builtin_amdgcn_readfirstlane(tid >> 6), lane = tid & 63, wr = wid >> 2, wc = wid & 3, fr = lane & 15, fq = lane >> 4;
    const int K = g.K, nt = K / BK;
    unsigned voffA[2], voffB[2];
#pragma unroll
    for (int i = 0; i < 2; ++i) { int R, C; stage_rc(tid * 16 + i * 8192, R, C); const int Rb = Epi::PERM ? ((R & ~31) + perm32(R & 31)) : R;
        voffA[i] = (unsigned)(R * g.lda + C) * 2u; voffB[i] = (unsigned)(Rb * g.ldb + C) * 2u; }
    const size_t kstep = (size_t)(BK * 2);
    const size_t hstepA = (size_t)HALF * g.lda * 2, hstepB = (size_t)HALF * g.ldb * 2;
    const size_t tstepA = 2 * hstepA, tstepB = 2 * hstepB;
    const unsigned ldsw = (unsigned)wid * 1024u;
    const int aoff = lds_byte(wr * 64 + fr, fq * 8), boff = lds_byte(wc * 32 + fr, fq * 8);
#define PG8_SA(b, h) (((b) * 2 + (h)) * HTB)
#define PG8_SB(b, h) ((4 + (b) * 2 + (h)) * HTB)
#define PG8_STAGE(bufoff, gbase, voff) do { _Pragma("unroll") for (int _i = 0; _i < 2; ++_i) \
        __builtin_amdgcn_global_load_lds((const unsigned*)((const char*)(gbase) + (voff)[_i]), (PG8_LAS unsigned*)(lds + (bufoff) + ldsw + _i * 8192), 16, 0, 0); } while (0)
#define PG8_LDA(dst, b, h) do { _Pragma("unroll") for (int m = 0; m < 4; ++m) _Pragma("unroll") for (int k = 0; k < 2; ++k) dst[m][k] = *(const PG8_LAS bf16x8*)(lds + PG8_SA(b, h) + aoff + m * 2048 + k * 1024); } while (0)
#define PG8_LDB(dst, b, h) do { _Pragma("unroll") for (int n = 0; n < 2; ++n) _Pragma("unroll") for (int k = 0; k < 2; ++k) dst[n][k] = *(const PG8_LAS bf16x8*)(lds + PG8_SB(b, h) + boff + n * 2048 + k * 1024); } while (0)
#define PG8_MMA(ai, bj, At, Bt) do { __builtin_amdgcn_s_setprio(1); _Pragma("unroll") for (int m = 0; m < 4; ++m) _Pragma("unroll") for (int n = 0; n < 2; ++n) _Pragma("unroll") for (int k = 0; k < 2; ++k) \
        acc[ai][bj][m][n] = __builtin_amdgcn_mfma_f32_16x16x32_bf16(Bt[n][k], At[m][k], acc[ai][bj][m][n], 0, 0, 0); __builtin_amdgcn_s_setprio(0); } while (0)
#define PG8_WAIT_V(n) asm volatile("s_waitcnt vmcnt(" #n ")" ::: "memory")
#define PG8_WAIT_L(n) asm volatile("s_waitcnt lgkmcnt(" #n ")" ::: "memory")
#define PG8_BAR __builtin_amdgcn_s_barrier()
#define PG8_SCHED __builtin_amdgcn_sched_barrier(0)
    Unit cur, nxt; int ui = 0;
    if (!S.next(0, cur)) return;
    f32x4 acc[2][2][4][2];
#pragma unroll
    for (int a = 0; a < 2; ++a)
#pragma unroll
        for (int b = 0; b < 2; ++b)
#pragma unroll
            for (int m = 0; m < 4; ++m)
#pragma unroll
                for (int n = 0; n < 2; ++n) acc[a][b][m][n] = (f32x4){0.f, 0.f, 0.f, 0.f};
    bf16x8 At[4][2], B0[2][2], B1[2][2];
    const char* cA = (const char*)g.A + (size_t)cur.pm * tstepA; const char* cB = (const char*)g.Bt + (size_t)cur.pn * tstepB;
    S.a_ready(cur);
    if constexpr (SP2) {
        PG8_STAGE(PG8_SB(0, 0), cB, voffB); PG8_STAGE(PG8_SB(0, 1), cB + hstepB, voffB); PG8_STAGE(PG8_SA(0, 0), cA, voffA); PG8_STAGE(PG8_SA(0, 1), cA + hstepA, voffA);
        if (wr == 1) PG8_BAR;
        PG8_WAIT_V(2); PG8_BAR;
        PG8_STAGE(PG8_SB(1, 0), cB + kstep, voffB); PG8_STAGE(PG8_SA(1, 0), cA + kstep, voffA); PG8_STAGE(PG8_SB(1, 1), cB + hstepB + kstep, voffB);
        PG8_WAIT_V(6); PG8_BAR;
    } else {
        PG8_STAGE(PG8_SB(0, 0), cB, voffB); PG8_STAGE(PG8_SA(0, 0), cA, voffA); PG8_STAGE(PG8_SB(0, 1), cB + hstepB, voffB); PG8_STAGE(PG8_SA(0, 1), cA + hstepA, voffA);
        if (wr == 1) PG8_BAR;
        PG8_WAIT_V(4); PG8_BAR;
        PG8_STAGE(PG8_SB(1, 0), cB + kstep, voffB); PG8_STAGE(PG8_SA(1, 0), cA + kstep, voffA); PG8_STAGE(PG8_SB(1, 1), cB + hstepB + kstep, voffB);
        PG8_WAIT_V(6); PG8_BAR;
    }
    for (;;) {
        const bool has_next = S.next(ui + 1, nxt);
        const char* nA = has_next ? (const char*)g.A + (size_t)nxt.pm * tstepA : cA; const char* nB = has_next ? (const char*)g.Bt + (size_t)nxt.pn * tstepB : cB;
        for (int t = 0; t < nt; t += 2) {
            const bool last = (t == nt - 2);
            const char* a1 = cA + (size_t)(t + 1) * kstep;
            const char* a2 = last ? nA : cA + (size_t)(t + 2) * kstep; const char* b2 = last ? nB : cB + (size_t)(t + 2) * kstep;
            const char* a3 = a2 + kstep; const char* b3 = b2 + kstep;
            if (last && has_next) S.a_ready(nxt);
            if constexpr (SP2) {
            PG8_LDB(B0, 0, 0); PG8_LDB(B1, 0, 1); PG8_SCHED; PG8_LDA(At, 0, 0); PG8_STAGE(PG8_SA(1, 1), a1 + hstepA, voffA);
            PG8_WAIT_V(8); PG8_WAIT_L(0); PG8_BAR; PG8_MMA(0, 0, At, B0); PG8_MMA(0, 1, At, B1); PG8_BAR; PG8_SCHED;
            PG8_LDA(At, 0, 1); PG8_STAGE(PG8_SB(0, 0), b2, voffB); PG8_STAGE(PG8_SB(0, 1), b2 + hstepB, voffB); PG8_STAGE(PG8_SA(0, 0), a2, voffA);
            PG8_WAIT_V(8); PG8_WAIT_L(0); PG8_BAR; PG8_MMA(1, 0, At, B0); PG8_MMA(1, 1, At, B1); PG8_BAR; PG8_SCHED;
            PG8_LDB(B0, 1, 0); PG8_LDB(B1, 1, 1); PG8_SCHED; PG8_LDA(At, 1, 0); PG8_STAGE(PG8_SA(0, 1), a2 + hstepA, voffA);
            PG8_WAIT_V(8); PG8_WAIT_L(0); PG8_BAR; PG8_MMA(0, 0, At, B0); PG8_MMA(0, 1, At, B1); PG8_BAR; PG8_SCHED;
            PG8_LDA(At, 1, 1); PG8_STAGE(PG8_SB(1, 0), b3, voffB); PG8_STAGE(PG8_SB(1, 1), b3 + hstepB, voffB); PG8_STAGE(PG8_SA(1, 0), a3, voffA);
            PG8_WAIT_V(8); PG8_WAIT_L(0); PG8_BAR; PG8_MMA(1, 0, At, B0); PG8_MMA(1, 1, At, B1); PG8_BAR; PG8_SCHED;
            } else {
            PG8_LDB(B0, 0, 0); PG8_SCHED; PG8_LDA(At, 0, 0); PG8_STAGE(PG8_SA(1, 1), a1 + hstepA, voffA);
            PG8_WAIT_L(8); PG8_BAR; PG8_WAIT_L(0); PG8_MMA(0, 0, At, B0); PG8_BAR; PG8_SCHED;
            PG8_LDB(B1, 0, 1); PG8_STAGE(PG8_SB(0, 0), b2, voffB);
            PG8_BAR; PG8_WAIT_L(0); PG8_MMA(0, 1, At, B1); PG8_BAR;
            PG8_LDA(At, 0, 1); PG8_STAGE(PG8_SA(0, 0), a2, voffA);
            PG8_BAR; PG8_WAIT_L(0); PG8_MMA(1, 0, At, B0); PG8_BAR; PG8_SCHED;
            PG8_STAGE(PG8_SB(0, 1), b2 + hstepB, voffB);
            PG8_WAIT_V(6); PG8_BAR; PG8_MMA(1, 1, At, B1); PG8_BAR;
            PG8_LDB(B0, 1, 0); PG8_SCHED; PG8_LDA(At, 1, 0); PG8_STAGE(PG8_SA(0, 1), a2 + hstepA, voffA);
            PG8_WAIT_L(8); PG8_BAR; PG8_WAIT_L(0); PG8_MMA(0, 0, At, B0); PG8_BAR; PG8_SCHED;
            PG8_LDB(B1, 1, 1); PG8_STAGE(PG8_SB(1, 0), b3, voffB);
            PG8_BAR; PG8_WAIT_L(0); PG8_MMA(0, 1, At, B1); PG8_BAR;
            PG8_LDA(At, 1, 1); PG8_STAGE(PG8_SA(1, 0), a3, voffA);
            PG8_BAR; PG8_WAIT_L(0); PG8_MMA(1, 0, At, B0); PG8_BAR; PG8_SCHED;
            PG8_STAGE(PG8_SB(1, 1), b3 + hstepB, voffB);
            PG8_WAIT_V(6); PG8_BAR; PG8_MMA(1, 1, At, B1); PG8_BAR;
            }
        }
        if constexpr (ALIGN_EPI) { if (wr == 0) PG8_BAR; }
        if constexpr (!Epi::AFTER_DRAIN) { E(acc, cur, wr, wc, fr, fq); S.done(cur); }
        if (!has_next) break;
#pragma unroll
        for (int a = 0; a < 2; ++a)
#pragma unroll
            for (int b = 0; b < 2; ++b)
#pragma unroll
                for (int m = 0; m < 4; ++m)
#pragma unroll
                    for (int n = 0; n < 2; ++n) acc[a][b][m][n] = (f32x4){0.f, 0.f, 0.f, 0.f};
        cur = nxt; cA = nA; cB = nB; ++ui;
        if constexpr (ALIGN_EPI) { if (wr == 1) PG8_BAR; }
    }
    PG8_WAIT_V(0);
    if constexpr (!ALIGN_EPI) { if (wr == 0) PG8_BAR; }
    PG8_BAR;
    if constexpr (Epi::AFTER_DRAIN) { E.fused(acc, cur, wr, wc, fr, fq, lds, wid, lane); S.done(cur); }
#undef PG8_SA
#undef PG8_SB
#undef PG8_STAGE
#undef PG8_LDA
#undef PG8_LDB
#undef PG8_MMA
#undef PG8_WAIT_V
#undef PG8_WAIT_L
#undef PG8_BAR
#undef PG8_SCHED
}
}

#define GAS __attribute__((address_space(1)))
#define LAS __attribute__((address_space(3)))
typedef unsigned short bf16_t;
typedef short bf16x8 __attribute__((ext_vector_type(8)));
typedef float f32x4 __attribute__((ext_vector_type(4)));
typedef unsigned u32x4 __attribute__((ext_vector_type(4)));
typedef unsigned u32x2 __attribute__((ext_vector_type(2)));

constexpr int DM = 1024, NBATCH = 2, SEQ = 8192, MEML = 256, MTOK = NBATCH * SEQ;
constexpr int INW = 12320, LD = 12544;
constexpr int C_Z = 0, C_X = 2048, C_B = 4096, C_C = 4608, C_LG = 5120, C_LX = 6656, C_Q = 8192, C_G = 9216, C_DT = 12288;
constexpr int C_MRG = 2048;
constexpr int NHEAD = 32, HDIM = 64, NGRP = 4, NSTATE = 128, CHUNK = 128, NCHUNK = SEQ / CHUNK;
constexpr int LRUW = 1536, LRUB = 96, NLB = 16, LSEG = 512, NSEG = SEQ / LSEG, NBLK64 = SEQ / 64;
constexpr float EPS = 1e-6f;
constexpr size_t MiB = 1u << 20;
constexpr size_t WS_WIN = 0, WS_WKV = 25 * MiB, WS_WSSD = 29 * MiB, WS_WLRU = 33 * MiB, WS_WMEM = 36 * MiB, WS_WOUT = 38 * MiB;
constexpr size_t WS_PROJ = 40 * MiB;
constexpr size_t WS_MEMN = 236 * MiB, WS_KVK = 237 * MiB, WS_KVVT = 238 * MiB, WS_LRUWA = 239 * MiB, WS_LRUWX = 239 * MiB + 512 * 1024;
constexpr size_t WS_DASUM = 240 * MiB;
constexpr size_t WS_LAGG = 246 * MiB;
constexpr size_t WS_LCAR = 250 * MiB;
constexpr size_t WS_CTL = 244 * MiB;
constexpr size_t WS_XBUF = 245 * MiB;
constexpr size_t WS_END = 256 * MiB;
static_assert(WS_PROJ + (size_t)SEQ * LD * 2 <= WS_MEMN, "ws map");
constexpr int LDS_BYTES = 155648;

struct Params {
    const float *x, *mem, *norm_g, *w_in, *ssd_conv_w, *ssd_conv_b, *ssd_dt_bias, *ssd_a_log, *ssd_d, *ssd_norm_g,
        *lru_conv_w, *lru_conv_b, *lru_w_a, *lru_b_a, *lru_w_x, *lru_b_x, *lru_lambda, *mem_norm_g, *w_kv,
        *w_br_ssd, *w_br_lru, *w_br_mem, *w_out, *final_g;
    float* out; unsigned char* ws;
    int lo, hi;
};

__device__ __forceinline__ float bf2f(bf16_t v) { return __uint_as_float((unsigned)v << 16); }
__device__ __forceinline__ unsigned f2bf(float f) { unsigned u = __float_as_uint(f); return (u + 0x7fffu + ((u >> 16) & 1u)) >> 16; }
__device__ __forceinline__ unsigned pk2(float lo, float hi) { return f2bf(lo) | (f2bf(hi) << 16); }
__device__ __forceinline__ float sigmoidf_(float v) { return __builtin_amdgcn_rcpf(1.f + __expf(-v)); }
__device__ __forceinline__ float siluf_(float v) { return v * __builtin_amdgcn_rcpf(1.f + __expf(-v)); }
__device__ __forceinline__ float softplusf_(float v) { const float e = __expf(v); const float sm = e * (1.f - e * (0.5f - e * 0.33333334f)); return v > 20.f ? v : (e < 1e-3f ? sm : __logf(1.f + e)); }
__device__ __forceinline__ float wave_sum(float v) {
#pragma unroll
    for (int o = 1; o < 64; o <<= 1) v += __shfl_xor(v, o);
    return v;
}
template <class T> __device__ __forceinline__ T* opq(T* q) { asm volatile("" : "+s"(q)); return q; }
__device__ __forceinline__ int opq_tid() { int t = threadIdx.x; asm volatile("" : "+v"(t)); return t; }
__device__ __forceinline__ int opq_bid() { int t = blockIdx.x; asm volatile("" : "+s"(t)); return t; }
__device__ __forceinline__ unsigned char* wsb(const Params& p) { return opq(p.ws); }
__device__ __forceinline__ bf16_t* proj_ptr(const Params& p) { return (bf16_t*)(wsb(p) + WS_PROJ); }
__device__ __forceinline__ bf16_t* xn_ptr(const Params& p) { return (bf16_t*)((unsigned char*)opq(p.out) + 32 * MiB); }
__device__ __forceinline__ bf16_t* states_ptr(const Params& p, int b) { return (bf16_t*)((unsigned char*)opq(p.out) + (size_t)b * 32 * MiB); }
__device__ __forceinline__ float* scr_ptr(const Params& p, int b) { return (float*)((unsigned char*)opq(p.out) + (size_t)b * 32 * MiB); }

#ifdef PROBE_MA
#define MSTAMP(p, i) do { if (blockIdx.x == 0 && threadIdx.x == 0) ((unsigned long long*)(wsb(p) + 255 * MiB))[i] = __builtin_amdgcn_s_memrealtime(); } while (0)
#else
#define MSTAMP(p, i) do { } while (0)
#endif
__device__ __forceinline__ void transpose_item(const float* W, int K, int Ns, int srccol0, bf16_t* WT, int dstrow0, LAS float* scr, int k0, int lane) {
    float wv[32];
#pragma unroll
    for (int i = 0; i < 32; ++i) wv[i] = W[(size_t)(k0 + 2 * i + (lane >> 5)) * Ns + srccol0 + (lane & 31)];
#pragma unroll
    for (int i = 0; i < 32; ++i) scr[(2 * i + (lane >> 5)) * 33 + (lane & 31)] = wv[i];
    asm volatile("s_waitcnt lgkmcnt(0)" ::: "memory");
    const int c = lane & 7;
#pragma unroll
    for (int j = 0; j < 4; ++j) { const int n = (lane >> 3) + 8 * j; const LAS float* s = scr + (8 * c) * 33 + n;
        u32x4 o; o.x = pk2(s[0 * 33], s[1 * 33]); o.y = pk2(s[2 * 33], s[3 * 33]); o.z = pk2(s[4 * 33], s[5 * 33]); o.w = pk2(s[6 * 33], s[7 * 33]);
        *(u32x4*)(WT + (size_t)(dstrow0 + n) * K + k0 + 8 * c) = o; }
    asm volatile("s_waitcnt lgkmcnt(0)" ::: "memory");
}
__device__ __forceinline__ void rms_row_to_bf16(const float* xrow, const float* g, bf16_t* orow, int lane) {
    const f32x4* xr = (const f32x4*)xrow + lane; const f32x4* gr = (const f32x4*)g + lane;
    f32x4 v[4]; float s = 0.f;
#pragma unroll
    for (int j = 0; j < 4; ++j) { v[j] = xr[64 * j]; s += (v[j].x * v[j].x + v[j].y * v[j].y) + (v[j].z * v[j].z + v[j].w * v[j].w); }
    const float rs = 1.f / sqrtf(wave_sum(s) * (1.f / DM) + EPS);
    unsigned long long* o8 = (unsigned long long*)orow + lane;
#pragma unroll
    for (int j = 0; j < 4; ++j) { const f32x4 gg = gr[64 * j];
        o8[64 * j] = (unsigned long long)pk2(v[j].x * rs * gg.x, v[j].y * rs * gg.y) | ((unsigned long long)pk2(v[j].z * rs * gg.z, v[j].w * rs * gg.w) << 32); }
}
__device__ __forceinline__ void xn_rows(const Params& p, int row_lo, int row_hi, int gw, int NGW, int lane) {
    bf16_t* XN = xn_ptr(p);
    { const float* xb = opq(p.x); const f32x4* gr = (const f32x4*)opq(p.norm_g) + lane;
      for (int m0 = row_lo + gw * 4; m0 < row_hi; m0 += NGW * 4) {
          f32x4 v[4][4];
#pragma unroll
          for (int r = 0; r < 4; ++r)
#pragma unroll
              for (int j = 0; j < 4; ++j) v[r][j] = ((const f32x4*)(xb + (size_t)(m0 + r) * DM) + lane)[64 * j];
#pragma unroll
          for (int r = 0; r < 4; ++r) { float s = 0.f;
#pragma unroll
              for (int j = 0; j < 4; ++j) s += (v[r][j].x * v[r][j].x + v[r][j].y * v[r][j].y) + (v[r][j].z * v[r][j].z + v[r][j].w * v[r][j].w);
              const float rs = 1.f / sqrtf(wave_sum(s) * (1.f / DM) + EPS);
              unsigned long long* o8 = (unsigned long long*)(XN + (size_t)(m0 + r) * DM) + lane;
#pragma unroll
              for (int j = 0; j < 4; ++j) { const f32x4 gg = gr[64 * j];
                  o8[64 * j] = (unsigned long long)pk2(v[r][j].x * rs * gg.x, v[r][j].y * rs * gg.y) | ((unsigned long long)pk2(v[r][j].z * rs * gg.z, v[r][j].w * rs * gg.w) << 32); } } } }
}
__device__ __forceinline__ void transpose_items(const Params& p, LAS unsigned char* lds, int it_lo, int it_hi) {
    const int tid = opq_tid(), lane = tid & 63, wave = tid >> 6, bid = opq_bid();
    const int gw = bid * 8 + wave, NGW = gridDim.x * 8;
    LAS float* scr = (LAS float*)(lds + wave * 8704);
    bf16_t* Win = (bf16_t*)(wsb(p) + WS_WIN); bf16_t* Wkv = (bf16_t*)(wsb(p) + WS_WKV); bf16_t* Wssd = (bf16_t*)(wsb(p) + WS_WSSD);
    bf16_t* Wlru = (bf16_t*)(wsb(p) + WS_WLRU); bf16_t* Wmem = (bf16_t*)(wsb(p) + WS_WMEM); bf16_t* Wout = (bf16_t*)(wsb(p) + WS_WOUT);
    constexpr int I_IN = 16 * 385, I_KV = 16 * 64, I_SSD = 32 * 32, I_LRU = 24 * 32, I_MEM = 16 * 32, I_OUT = 16 * 32;
    constexpr int NITEMS = I_IN + I_KV + I_SSD + I_LRU + I_MEM + I_OUT;
    (void)NITEMS;
    for (int it = it_lo + gw; it < it_hi; it += NGW) {
        int r = it;
        if (r < I_IN) { const int nb = r % 385, kb = r / 385; const int sc = 32 * nb; int dr;
            if (sc < 5120) dr = sc; else if (sc < 5152) dr = sc - 5120 + C_DT; else dr = sc - 32;
            transpose_item(opq(p.w_in), 1024, INW, sc, Win, dr, scr, 64 * kb, lane); continue; } r -= I_IN;
        if (r < I_KV) { transpose_item(opq(p.w_kv), 1024, 2048, 32 * (r % 64), Wkv, 32 * (r % 64), scr, 64 * (r / 64), lane); continue; } r -= I_KV;
        if (r < I_SSD) { transpose_item(opq(p.w_br_ssd), 2048, 1024, 32 * (r % 32), Wssd, 32 * (r % 32), scr, 64 * (r / 32), lane); continue; } r -= I_SSD;
        if (r < I_LRU) { transpose_item(opq(p.w_br_lru), 1536, 1024, 32 * (r % 32), Wlru, 32 * (r % 32), scr, 64 * (r / 32), lane); continue; } r -= I_LRU;
        if (r < I_MEM) { transpose_item(opq(p.w_br_mem), 1024, 1024, 32 * (r % 32), Wmem, 32 * (r % 32), scr, 64 * (r / 32), lane); continue; } r -= I_MEM;
        transpose_item(opq(p.w_out), 1024, 1024, 32 * (r % 32), Wout, 32 * (r % 32), scr, 64 * (r / 32), lane);
    }
}
constexpr int TI_EARLY = 16 * 385 + 16 * 64, TI_ALL = TI_EARLY + 32 * 32 + 24 * 32 + 16 * 32 + 16 * 32;
__device__ __forceinline__ void phase0(const Params& p, LAS unsigned char* lds) {
    const int tid = opq_tid(), lane = tid & 63, wave = tid >> 6, bid = opq_bid();
    const int gw = bid * 8 + wave, NGW = gridDim.x * 8;
    bf16_t* Win = (bf16_t*)(wsb(p) + WS_WIN);
    transpose_items(p, lds, 0, gridDim.x == 256 ? TI_EARLY : TI_ALL);
    { const int gt = bid * 512 + tid, NT = gridDim.x * 512; u32x4* z = (u32x4*)(Win + (size_t)INW * 1024);
      for (int i = gt; i < (LD - INW) * 1024 / 8; i += NT) z[i] = (u32x4){0u, 0u, 0u, 0u}; }
    { const int gt = bid * 512 + tid, NT = gridDim.x * 512; bf16_t* wa = (bf16_t*)(wsb(p) + WS_LRUWA); bf16_t* wx = (bf16_t*)(wsb(p) + WS_LRUWX);
      for (int e = gt; e < NLB * LRUB * LRUB; e += NT) { const int n = e / (LRUB * LRUB), r2 = e % (LRUB * LRUB), j = r2 / LRUB, i = r2 % LRUB;
          wa[e] = (bf16_t)f2bf(opq(p.lru_w_a)[(n * LRUB + i) * LRUB + j]); wx[e] = (bf16_t)f2bf(opq(p.lru_w_x)[(n * LRUB + i) * LRUB + j]); } }
    bf16_t* XN = xn_ptr(p); bf16_t* MN = (bf16_t*)(wsb(p) + WS_MEMN);
    if (gridDim.x == 256) xn_rows(p, 0, SEQ, gw, NGW, lane); else xn_rows(p, 0, MTOK, gw, NGW, lane);
    for (int m = gw; m < NBATCH * MEML; m += NGW) rms_row_to_bf16(opq(p.mem) + (size_t)m * DM, opq(p.mem_norm_g), MN + (size_t)m * DM, lane);
}
__device__ __forceinline__ void phase7(const Params& p) {
    const int tid = opq_tid(), lane = tid & 63, wave = tid >> 6; const int gw = opq_bid() * 8 + wave, NGW = gridDim.x * 8; float* outb = opq(p.out); const float* fg = opq(p.final_g);
    for (int m = gw; m < MTOK; m += NGW) {
        f32x4* xr = (f32x4*)(outb + (size_t)m * DM) + lane; const f32x4* gr = (const f32x4*)fg + lane;
        f32x4 v[4]; float s = 0.f;
#pragma unroll
        for (int j = 0; j < 4; ++j) { v[j] = xr[64 * j]; s += (v[j].x * v[j].x + v[j].y * v[j].y) + (v[j].z * v[j].z + v[j].w * v[j].w); }
        const float rs = 1.f / sqrtf(wave_sum(s) * (1.f / DM) + EPS);
#pragma unroll
        for (int j = 0; j < 4; ++j) { const f32x4 gg = gr[64 * j]; xr[64 * j] = v[j] * rs * gg; }
    }
}

namespace pg8 {
template <int BR> struct EpiMerge {
    static constexpr bool PERM = true, AFTER_DRAIN = false;
    bf16_t* P; float* scr;
    __device__ __forceinline__ void operator()(const f32x4 (&acc)[2][2][4][2], const Unit& u, int wr, int wc, int fr, int fq) const {
        const int row0 = u.pm * BM + wr * 64 + fr, col0 = u.pn * BM + wc * 32 + 8 * fq;
#pragma unroll
        for (int ai = 0; ai < 2; ++ai)
#pragma unroll
            for (int m = 0; m < 4; ++m) { const size_t r = (size_t)(row0 + ai * HALF + m * 16);
#pragma unroll
                for (int bj = 0; bj < 2; ++bj) { const int c = col0 + bj * HALF;
                    const u32x4 gw = *(const u32x4*)(P + r * 12544 + 9216 + BR * 1024 + c);
                    float g[8];
#pragma unroll
                    for (int i = 0; i < 4; ++i) { g[2 * i] = __uint_as_float(gw[i] << 16); g[2 * i + 1] = __uint_as_float(gw[i] & 0xffff0000u); }
                    f32x4 v0 = acc[ai][bj][m][0], v1 = acc[ai][bj][m][1];
#pragma unroll
                    for (int i = 0; i < 4; ++i) { v0[i] *= 1.f / (1.f + __expf(-g[i])); v1[i] *= 1.f / (1.f + __expf(-g[4 + i])); }
                    float* sp = scr + r * 1024 + c;
                    if (BR > 0) { v0 += *(const f32x4*)sp; v1 += *(const f32x4*)(sp + 4); }
                    if (BR < 2) { *(f32x4*)sp = v0; *(f32x4*)(sp + 4) = v1; }
                    else { u32x4 w; w.x = cvt_pk_bf16(v0[0], v0[1]); w.y = cvt_pk_bf16(v0[2], v0[3]); w.z = cvt_pk_bf16(v1[0], v1[1]); w.w = cvt_pk_bf16(v1[2], v1[3]);
                        *(u32x4*)(P + r * 12544 + 2048 + c) = w; } } }
    }
};
template <int BR, bool FINAL> struct EpiMerge2 {
    static constexpr bool PERM = true, AFTER_DRAIN = false;
    bf16_t* P; bf16_t* s0; int ld0; const bf16_t* s1; int ld1; bf16_t* mrg; int ldm;
    __device__ __forceinline__ void operator()(const f32x4 (&acc)[2][2][4][2], const Unit& u, int wr, int wc, int fr, int fq) const {
        const int row0 = u.pm * BM + wr * 64 + fr, col0 = u.pn * BM + wc * 32 + 8 * fq;
#pragma unroll
        for (int ai = 0; ai < 2; ++ai) {
            unsigned gb = (unsigned)((row0 + ai * HALF) * 12544 + 9216 + BR * 1024 + col0); asm volatile("" : "+v"(gb));
            unsigned b0 = (unsigned)((row0 + ai * HALF) * ld0 + col0); asm volatile("" : "+v"(b0));
            u32x4 gw[4][2];
#pragma unroll
            for (int m = 0; m < 4; ++m)
#pragma unroll
                for (int bj = 0; bj < 2; ++bj) gw[m][bj] = *(const u32x4*)(P + (gb + (unsigned)(m * 16 * 12544 + bj * HALF)));
            f32x4 v[4][2][2];
#pragma unroll
            for (int m = 0; m < 4; ++m)
#pragma unroll
                for (int bj = 0; bj < 2; ++bj) { const u32x4 g4 = gw[m][bj]; f32x4 v0 = acc[ai][bj][m][0], v1 = acc[ai][bj][m][1];
#pragma unroll
                    for (int i = 0; i < 2; ++i) { v0[2 * i] *= __builtin_amdgcn_rcpf(1.f + __expf(-__uint_as_float(g4[i] << 16))); v0[2 * i + 1] *= __builtin_amdgcn_rcpf(1.f + __expf(-__uint_as_float(g4[i] & 0xffff0000u)));
                        v1[2 * i] *= __builtin_amdgcn_rcpf(1.f + __expf(-__uint_as_float(g4[2 + i] << 16))); v1[2 * i + 1] *= __builtin_amdgcn_rcpf(1.f + __expf(-__uint_as_float(g4[2 + i] & 0xffff0000u))); }
                    v[m][bj][0] = v0; v[m][bj][1] = v1; }
            if (!FINAL) {
#pragma unroll
                for (int m = 0; m < 4; ++m)
#pragma unroll
                    for (int bj = 0; bj < 2; ++bj) { const f32x4 v0 = v[m][bj][0], v1 = v[m][bj][1]; u32x4 w; w.x = cvt_pk_bf16(v0[0], v0[1]); w.y = cvt_pk_bf16(v0[2], v0[3]); w.z = cvt_pk_bf16(v1[0], v1[1]); w.w = cvt_pk_bf16(v1[2], v1[3]);
                        *(u32x4*)(s0 + (b0 + (unsigned)(m * 16) * (unsigned)ld0 + (unsigned)(bj * HALF))) = w; }
            } else {
                asm volatile("" ::: "memory");
                unsigned b1 = (unsigned)((row0 + ai * HALF) * ld1 + col0); asm volatile("" : "+v"(b1));
                unsigned bm = (unsigned)((row0 + ai * HALF) * ldm + col0); asm volatile("" : "+v"(bm));
#pragma unroll
                for (int mp = 0; mp < 2; ++mp) { u32x4 a0[2][2], a1[2][2];
#pragma unroll
                    for (int mm = 0; mm < 2; ++mm)
#pragma unroll
                        for (int bj = 0; bj < 2; ++bj) { const unsigned rr = (unsigned)((2 * mp + mm) * 16);
                            a0[mm][bj] = *(const u32x4*)(s0 + (b0 + rr * (unsigned)ld0 + (unsigned)(bj * HALF))); a1[mm][bj] = *(const u32x4*)(s1 + (b1 + rr * (unsigned)ld1 + (unsigned)(bj * HALF))); }
#pragma unroll
                    for (int mm = 0; mm < 2; ++mm)
#pragma unroll
                        for (int bj = 0; bj < 2; ++bj) { const int m = 2 * mp + mm; const unsigned rr = (unsigned)(m * 16);
                            f32x4 v0 = v[m][bj][0], v1 = v[m][bj][1];
#pragma unroll
                            for (int i = 0; i < 2; ++i) { v0[2 * i] += __uint_as_float(a0[mm][bj][i] << 16) + __uint_as_float(a1[mm][bj][i] << 16); v0[2 * i + 1] += __uint_as_float(a0[mm][bj][i] & 0xffff0000u) + __uint_as_float(a1[mm][bj][i] & 0xffff0000u);
                                v1[2 * i] += __uint_as_float(a0[mm][bj][2 + i] << 16) + __uint_as_float(a1[mm][bj][2 + i] << 16); v1[2 * i + 1] += __uint_as_float(a0[mm][bj][2 + i] & 0xffff0000u) + __uint_as_float(a1[mm][bj][2 + i] & 0xffff0000u); }
                            u32x4 w; w.x = cvt_pk_bf16(v0[0], v0[1]); w.y = cvt_pk_bf16(v0[2], v0[3]); w.z = cvt_pk_bf16(v1[0], v1[1]); w.w = cvt_pk_bf16(v1[2], v1[3]);
                            *(u32x4*)(mrg + (bm + rr * (unsigned)ldm + (unsigned)(bj * HALF))) = w; }
                    asm volatile("" ::: "memory"); }
            }
            asm volatile("" ::: "memory");
        }
    }
};
struct EpiOutNorm {
    static constexpr bool PERM = false, AFTER_DRAIN = true;
    const float* xres; float* out; const float* fg; float* xbuf; unsigned* cnt;
    __device__ __forceinline__ void fused(f32x4 (&acc)[2][2][4][2], const Unit& u, int wr, int wc, int fr, int fq, PG8_LAS unsigned char* lds, int wid, int lane) const {
        PG8_LAS float* Pp = (PG8_LAS float*)lds; PG8_LAS float* Sr = (PG8_LAS float*)(lds + 4096);
        const int row0 = u.pm * BM + wr * 64 + fr, col0 = u.pn * BM + wc * 32 + 4 * fq;
#pragma unroll
        for (int ai = 0; ai < 2; ++ai)
#pragma unroll
            for (int m = 0; m < 4; ++m) { const size_t off = (size_t)(row0 + ai * HALF + m * 16) * 1024 + col0; float s = 0.f;
#pragma unroll
                for (int bj = 0; bj < 2; ++bj)
#pragma unroll
                    for (int n = 0; n < 2; ++n) { const f32x4 v = acc[ai][bj][m][n] + *(const f32x4*)(xres + off + bj * HALF + n * 16); acc[ai][bj][m][n] = v; s += (v[0] * v[0] + v[1] * v[1]) + (v[2] * v[2] + v[3] * v[3]); }
                s += __shfl_xor(s, 16); s += __shfl_xor(s, 32);
                if (fq == 0) Pp[(ai * HALF + wr * 64 + m * 16 + fr) * 4 + wc] = s;
                if (m == 3) asm volatile("" ::: "memory"); }
        asm volatile("s_waitcnt lgkmcnt(0)" ::: "memory"); __builtin_amdgcn_s_barrier(); asm volatile("" ::: "memory");
        const int tid = wid * 64 + lane;
        if (tid < 256) { const float s = (Pp[tid * 4 + 0] + Pp[tid * 4 + 1]) + (Pp[tid * 4 + 2] + Pp[tid * 4 + 3]);
            __hip_atomic_store(xbuf + (size_t)(u.pm * BM + tid) * 4 + u.pn, s, __ATOMIC_RELAXED, __HIP_MEMORY_SCOPE_AGENT); }
        asm volatile("s_waitcnt vmcnt(0)" ::: "memory");
        if (wid < 4 && lane == 0) __hip_atomic_fetch_add(cnt + 64 * u.pm, 1u, __ATOMIC_RELAXED, __HIP_MEMORY_SCOPE_AGENT);
        if (wid == 0) { unsigned spins = 0;
            while ((unsigned)__builtin_amdgcn_readfirstlane(__hip_atomic_load(cnt + 64 * u.pm, __ATOMIC_RELAXED, __HIP_MEMORY_SCOPE_AGENT)) < 16u && ++spins < (1u << 22)) __builtin_amdgcn_s_sleep(2);
            __builtin_amdgcn_fence(__ATOMIC_ACQUIRE, "agent"); }
        asm volatile("s_waitcnt vmcnt(0) lgkmcnt(0)" ::: "memory"); __builtin_amdgcn_s_barrier(); asm volatile("" ::: "memory");
        if (tid < 256) { const float* slot = xbuf + (size_t)(u.pm * BM + tid) * 4; float s = 0.f;
#pragma unroll
            for (int q = 0; q < 4; ++q) s += __hip_atomic_load(slot + q, __ATOMIC_RELAXED, __HIP_MEMORY_SCOPE_AGENT);
            Sr[tid] = 1.0f / sqrtf(s * (1.f / 1024.f) + 1e-6f); }
        asm volatile("s_waitcnt lgkmcnt(0)" ::: "memory"); __builtin_amdgcn_s_barrier(); asm volatile("" ::: "memory");
#pragma unroll
        for (int ai = 0; ai < 2; ++ai)
#pragma unroll
            for (int m = 0; m < 4; ++m) { const int r = ai * HALF + wr * 64 + m * 16 + fr; const float rs = Sr[r]; const size_t off = (size_t)(u.pm * BM + r) * 1024 + col0;
#pragma unroll
                for (int bj = 0; bj < 2; ++bj)
#pragma unroll
                    for (int n = 0; n < 2; ++n) { const f32x4 gg = *(const f32x4*)(fg + col0 + bj * HALF + n * 16); *(f32x4*)(out + off + bj * HALF + n * 16) = acc[ai][bj][m][n] * rs * gg; } }
    }
};
struct SkewOrder {
    StaticOrder base; int c;
    __device__ void init(int M, int N, int c_) { base.init(M, N, 256, 0); c = c_; }
    __device__ bool next(int i, Unit& u) const {
        int ii, cc = c;
        if (c < 128) { if (i >= 5) return false; ii = i + 1; }
        else { if (i > 6) return false; if (i == 0) ii = 0; else if (i == 1) { ii = 0; cc = c - 128; } else ii = i - 1; }
        StaticOrder b2 = base; b2.c = cc; return b2.next(ii, u);
    }
    __device__ __forceinline__ void a_ready(const Unit&) const {}
    __device__ __forceinline__ void done(const Unit&) const {}
};
}
#define PG8_SP2 true
#define PG8_ALIGN true

__device__ __forceinline__ bf16_t* merged_ptr(const Params& p, int b) { return b == 0 ? xn_ptr(p) : proj_ptr(p) + 4096; }
__device__ __forceinline__ int merged_ld(int b) { return b == 0 ? DM : LD; }
__device__ __forceinline__ void phase1_gemm(const Params& p, int b, LAS unsigned char* lds) {
    const int G = gridDim.x, c = opq_bid();
    { pg8::Gemm g{xn_ptr(p) + (size_t)b * SEQ * DM, (const bf16_t*)(wsb(p) + WS_WIN), SEQ, 12288, DM, DM, DM}; pg8::StaticOrder S; S.init(SEQ, 12288, G, c);
      pg8::EpiBf16<0> E{proj_ptr(p), LD, nullptr, 0, 0, 1.f};
      if (b == 1 && G == 256) { pg8::SkewOrder S2; S2.init(SEQ, 12288, c);
          pg8::gemm_phase<pg8::EpiBf16<0>, pg8::SkewOrder, PG8_ALIGN, PG8_SP2>(lds, g, S2, E); }
      else pg8::gemm_phase<pg8::EpiBf16<0>, pg8::StaticOrder, PG8_ALIGN, PG8_SP2>(lds, g, S, E); }
    { const int tid = opq_tid(), lane = tid & 63, wave = tid >> 6, fr = lane & 15, kg = lane >> 4;
      const bf16_t* XNb = xn_ptr(p) + (size_t)b * SEQ * DM; const bf16_t* Wd = (const bf16_t*)(wsb(p) + WS_WIN) + (size_t)C_DT * DM; bf16_t* Pq = proj_ptr(p);
      LAS float* sRed = (LAS float*)lds;
      for (int rb = c; rb < SEQ / 32; rb += G) {
          __syncthreads();
          f32x4 acc[2][2];
#pragma unroll
          for (int mt = 0; mt < 2; ++mt)
#pragma unroll
              for (int nt = 0; nt < 2; ++nt) acc[mt][nt] = (f32x4){0.f, 0.f, 0.f, 0.f};
          bf16x8 af[2][4], bfr[2][4];
#pragma unroll
          for (int ks = 0; ks < 4; ++ks)
#pragma unroll
              for (int q = 0; q < 2; ++q) { af[q][ks] = *(const bf16x8*)(XNb + (size_t)(32 * rb + 16 * q + fr) * DM + 128 * wave + 32 * ks + 8 * kg);
                  bfr[q][ks] = *(const bf16x8*)(Wd + (size_t)(16 * q + fr) * DM + 128 * wave + 32 * ks + 8 * kg); }
#pragma unroll
          for (int ks = 0; ks < 4; ++ks)
#pragma unroll
              for (int mt = 0; mt < 2; ++mt)
#pragma unroll
                  for (int nt = 0; nt < 2; ++nt) acc[mt][nt] = __builtin_amdgcn_mfma_f32_16x16x32_bf16(af[mt][ks], bfr[nt][ks], acc[mt][nt], 0, 0, 0);
#pragma unroll
          for (int mt = 0; mt < 2; ++mt)
#pragma unroll
              for (int nt = 0; nt < 2; ++nt)
#pragma unroll
                  for (int j = 0; j < 4; ++j) sRed[(wave * 32 + 16 * mt + 4 * kg + j) * 32 + 16 * nt + fr] = acc[mt][nt][j];
          __syncthreads();
#pragma unroll
          for (int q = 0; q < 2; ++q) { const int e = tid + 512 * q, row = e >> 5, col = e & 31; float s = 0.f;
#pragma unroll
              for (int w2 = 0; w2 < 8; ++w2) s += sRed[(w2 * 32 + row) * 32 + col];
              Pq[(size_t)(32 * rb + row) * LD + C_DT + col] = (bf16_t)f2bf(s); }
      } }
    if (b == 0 && G != 256) {
        { pg8::Gemm g{(const bf16_t*)(wsb(p) + WS_MEMN), (const bf16_t*)(wsb(p) + WS_WKV), 512, 1024, DM, DM, DM}; pg8::StaticOrder S; S.init(512, 1024, G, (c + 16) % G);
          pg8::EpiBf16<0> E{(bf16_t*)(wsb(p) + WS_KVK), 1024, nullptr, 0, 0, 1.f};
          pg8::gemm_phase<pg8::EpiBf16<0>, pg8::StaticOrder, PG8_ALIGN, PG8_SP2>(lds, g, S, E); }
        { pg8::Gemm g{(const bf16_t*)(wsb(p) + WS_WKV) + (size_t)1024 * DM, (const bf16_t*)(wsb(p) + WS_MEMN), 1024, 512, DM, DM, DM}; pg8::StaticOrder S; S.init(1024, 512, G, (c + 8) % G);
          pg8::EpiBf16<0> E{(bf16_t*)(wsb(p) + WS_KVVT), 512, nullptr, 0, 0, 1.f};
          pg8::gemm_phase<pg8::EpiBf16<0>, pg8::StaticOrder, PG8_ALIGN, PG8_SP2>(lds, g, S, E); }
    }
    if (b == 0 && G == 256) {
        const int tid = opq_tid(), lane = tid & 63, wave = tid >> 6, fr = lane & 15, kg = lane >> 4;
        const bf16_t* MN = (const bf16_t*)(wsb(p) + WS_MEMN); const bf16_t* WK = (const bf16_t*)(wsb(p) + WS_WKV);
        const bool jobK = c < 128; const int cb = jobK ? c : c - 128;
        const bf16_t* Ap = jobK ? MN + (size_t)(64 * (cb >> 4)) * DM : WK + (size_t)(1024 + 64 * (cb >> 3)) * DM;
        const bf16_t* Bp = jobK ? WK + (size_t)(64 * (cb & 15)) * DM : MN + (size_t)(64 * (cb & 7)) * DM;
        bf16_t* Cp = jobK ? (bf16_t*)(wsb(p) + WS_KVK) + (size_t)(64 * (cb >> 4)) * 1024 + 64 * (cb & 15) : (bf16_t*)(wsb(p) + WS_KVVT) + (size_t)(64 * (cb >> 3)) * 512 + 64 * (cb & 7);
        const int ldc = jobK ? 1024 : 512;
        LAS float* sRed = (LAS float*)lds;
        __syncthreads();
        f32x4 acc[4][4];
#pragma unroll
        for (int mt = 0; mt < 4; ++mt)
#pragma unroll
            for (int nt = 0; nt < 4; ++nt) acc[mt][nt] = (f32x4){0.f, 0.f, 0.f, 0.f};
#pragma unroll
        for (int ks = 0; ks < 4; ++ks) { bf16x8 af[4], bfr[4];
#pragma unroll
            for (int q = 0; q < 4; ++q) { af[q] = *(const bf16x8*)(Ap + (size_t)(16 * q + fr) * DM + 128 * wave + 32 * ks + 8 * kg); bfr[q] = *(const bf16x8*)(Bp + (size_t)(16 * q + fr) * DM + 128 * wave + 32 * ks + 8 * kg); }
#pragma unroll
            for (int mt = 0; mt < 4; ++mt)
#pragma unroll
                for (int nt = 0; nt < 4; ++nt) acc[mt][nt] = __builtin_amdgcn_mfma_f32_16x16x32_bf16(af[mt], bfr[nt], acc[mt][nt], 0, 0, 0); }
#pragma unroll
        for (int mt = 0; mt < 4; ++mt)
#pragma unroll
            for (int nt = 0; nt < 4; ++nt)
#pragma unroll
                for (int j = 0; j < 4; ++j) sRed[(wave * 64 + 16 * mt + 4 * kg + j) * 64 + 16 * nt + fr] = acc[mt][nt][j];
        __syncthreads();
#pragma unroll
        for (int q = 0; q < 8; ++q) { const int e2 = tid + 512 * q, row = e2 >> 6, col = e2 & 63; float s = 0.f;
#pragma unroll
            for (int w2 = 0; w2 < 8; ++w2) s += sRed[(w2 * 64 + row) * 64 + col];
            Cp[(size_t)row * ldc + col] = (bf16_t)f2bf(s); }
    }
}
__device__ __forceinline__ void phase5_gemm(const Params& p, int b, LAS unsigned char* lds) {
    const int G = gridDim.x, c = opq_bid(); bf16_t* P = proj_ptr(p); float* scr = scr_ptr(p, b);
    bf16_t* scrB = P + 2048;
    bf16_t* scrA = (bf16_t*)scr;
    unsigned* flag = (unsigned*)(wsb(p) + WS_CTL) + 4096 + (b * 128 + (c & 127)) * 16;
    if (c < 128) {
        pg8::Gemm g{P + C_Z, (const bf16_t*)(wsb(p) + WS_WSSD), SEQ, DM, 2048, LD, 2048}; pg8::StaticOrder S; S.init(SEQ, DM, 128, c); pg8::EpiMerge2<0, false> E{P, scrA, 1024, nullptr, 0, nullptr, 0};
        pg8::gemm_phase<pg8::EpiMerge2<0, false>, pg8::StaticOrder, false, PG8_SP2>(lds, g, S, E);
#ifdef PROBE_NOFENCE
        asm volatile("s_waitcnt vmcnt(0)" ::: "memory"); __syncthreads();
        if (threadIdx.x == 0) __hip_atomic_store(flag, 1u, __ATOMIC_RELAXED, __HIP_MEMORY_SCOPE_AGENT);
#else
        asm volatile("s_waitcnt vmcnt(0)" ::: "memory"); __syncthreads();
        if (threadIdx.x == 0) { __builtin_amdgcn_fence(__ATOMIC_RELEASE, "agent"); asm volatile("s_waitcnt vmcnt(0)" ::: "memory");
            __hip_atomic_store(flag, 1u, __ATOMIC_RELAXED, __HIP_MEMORY_SCOPE_AGENT); }
#endif
        if (b == 0 && G == 256) { const int tid2 = opq_tid(); xn_rows(p, SEQ, MTOK, c * 8 + (tid2 >> 6), 128 * 8, tid2 & 63); }
    } else {
        { pg8::Gemm g{P + C_LG, (const bf16_t*)(wsb(p) + WS_WLRU), SEQ, DM, 1536, LD, 1536}; pg8::StaticOrder S; S.init(SEQ, DM, 128, c - 128); pg8::EpiMerge2<1, false> E{P, scrB, LD, nullptr, 0, nullptr, 0};
          pg8::gemm_phase<pg8::EpiMerge2<1, false>, pg8::StaticOrder, false, PG8_SP2>(lds, g, S, E); }
        if (threadIdx.x == 0) { unsigned spins = 0; while (__hip_atomic_load(flag, __ATOMIC_RELAXED, __HIP_MEMORY_SCOPE_AGENT) == 0u && ++spins < (1u << 22)) __builtin_amdgcn_s_sleep(2);
#ifndef PROBE_NOFENCE
            __builtin_amdgcn_fence(__ATOMIC_ACQUIRE, "agent"); asm volatile("s_waitcnt vmcnt(0)" ::: "memory");
#endif
        }
        __syncthreads();
        { pg8::Gemm g{P + C_Q, (const bf16_t*)(wsb(p) + WS_WMEM), SEQ, DM, 1024, LD, 1024}; pg8::StaticOrder S; S.init(SEQ, DM, 128, c - 128); pg8::EpiMerge2<2, true> E{P, scrB, LD, scrA, 1024, merged_ptr(p, b), merged_ld(b)};
          pg8::gemm_phase<pg8::EpiMerge2<2, true>, pg8::StaticOrder, false, PG8_SP2>(lds, g, S, E); }
    }
}
__device__ __forceinline__ void phase6_gemm(const Params& p, int b, LAS unsigned char* lds) {
    const int G = gridDim.x, c = opq_bid(); bf16_t* P = proj_ptr(p);
    pg8::Gemm g{merged_ptr(p, b), (const bf16_t*)(wsb(p) + WS_WOUT), SEQ, DM, DM, merged_ld(b), DM}; pg8::StaticOrder S; S.init(SEQ, DM, G, c);
    pg8::EpiOutNorm E{opq(p.x) + (size_t)b * SEQ * DM, opq(p.out) + (size_t)b * SEQ * DM, opq(p.final_g), (float*)(wsb(p) + WS_XBUF) + (size_t)b * SEQ * 4, (unsigned*)(wsb(p) + WS_CTL) + 8192 + b * 2048};
    pg8::gemm_phase<pg8::EpiOutNorm, pg8::StaticOrder, false, PG8_SP2>(lds, g, S, E);
}
#define MFMA16(a, b, c) __builtin_amdgcn_mfma_f32_16x16x32_bf16((a), (b), (c), 0, 0, 0)
__device__ __forceinline__ bf16x8 pack8(const float (&v)[8]) {
    u32x4 w; w.x = pk2(v[0], v[1]); w.y = pk2(v[2], v[3]); w.z = pk2(v[4], v[5]); w.w = pk2(v[6], v[7]); return __builtin_bit_cast(bf16x8, w);
}
__device__ __forceinline__ void unpack8(u32x4 w, float (&v)[8]) {
#pragma unroll
    for (int i = 0; i < 4; ++i) { v[2 * i] = __uint_as_float(w[i] << 16); v[2 * i + 1] = __uint_as_float(w[i] & 0xffff0000u); }
}
__device__ __forceinline__ void attn_phase(const Params& p, int b, LAS unsigned char* lds, int dry = 0) {
    const int tid = opq_tid(), lane = tid & 63, wave = tid >> 6, fr = lane & 15, kg = lane >> 4;
    bf16_t* P = proj_ptr(p); const bf16_t* KK = (const bf16_t*)(wsb(p) + WS_KVK) + (size_t)b * 256 * 1024; const bf16_t* VT = (const bf16_t*)(wsb(p) + WS_KVVT) + b * 256;
    LAS bf16_t* sKV = (LAS bf16_t*)lds;
    for (int u = opq_bid(); u < 256; u += gridDim.x) {
        const int hd = u & 3, rt = u >> 2, q0 = rt * 128 + wave * 16;
        bf16_t* qrow = P + (size_t)(q0 + fr) * LD + C_Q + hd * 256;
        __syncthreads();
        { unsigned ko = (unsigned)((tid >> 5) * 1024 + hd * 256 + 8 * (tid & 31)); asm volatile("" : "+v"(ko));
          u32x4 st[16];
#pragma unroll
          for (int i = 0; i < 16; ++i) st[i] = *(const u32x4*)(KK + (ko + (unsigned)(i * 16 * 1024)));
#pragma unroll
          for (int i = 0; i < 16; ++i) *(LAS u32x4*)(sKV + ((tid >> 5) + 16 * i) * 264 + 8 * (tid & 31)) = st[i]; }
        bf16x8 qf[8];
#pragma unroll
        for (int s = 0; s < 8; ++s) qf[s] = *(const bf16x8*)(qrow + 32 * s + 8 * kg);
        __syncthreads();
        u32x4 vst[16];
        { unsigned vo = (unsigned)((hd * 256 + (tid >> 5)) * 512 + 8 * (tid & 31)); asm volatile("" : "+v"(vo));
#pragma unroll
          for (int i = 0; i < 16; ++i) vst[i] = *(const u32x4*)(VT + (vo + (unsigned)(i * 16 * 512))); }
        f32x4 sacc[16];
#pragma unroll
        for (int mt = 0; mt < 16; ++mt) { sacc[mt] = (f32x4){0.f, 0.f, 0.f, 0.f};
#pragma unroll
            for (int s = 0; s < 8; ++s) { const bf16x8 kf = *(const LAS bf16x8*)(sKV + (16 * mt + fr) * 264 + 32 * s + 8 * kg); sacc[mt] = MFMA16(kf, qf[s], sacc[mt]); } }
        float mx = -INFINITY;
#pragma unroll
        for (int mt = 0; mt < 16; ++mt)
#pragma unroll
            for (int j = 0; j < 4; ++j) mx = fmaxf(mx, sacc[mt][j]);
        mx = fmaxf(mx, __shfl_xor(mx, 16)); mx = fmaxf(mx, __shfl_xor(mx, 32));
        float sum = 0.f;
#pragma unroll
        for (int mt = 0; mt < 16; ++mt)
#pragma unroll
            for (int j = 0; j < 4; ++j) { const float e = __expf((sacc[mt][j] - mx) * 0.0625f); sacc[mt][j] = e; sum += e; }
        sum += __shfl_xor(sum, 16); sum += __shfl_xor(sum, 32);
        const float inv = 1.f / sum;
        bf16x8 pf[8];
#pragma unroll
        for (int s2 = 0; s2 < 8; ++s2) { u32x4 w; w.x = pk2(sacc[2 * s2][0], sacc[2 * s2][1]); w.y = pk2(sacc[2 * s2][2], sacc[2 * s2][3]);
            w.z = pk2(sacc[2 * s2 + 1][0], sacc[2 * s2 + 1][1]); w.w = pk2(sacc[2 * s2 + 1][2], sacc[2 * s2 + 1][3]); pf[s2] = __builtin_bit_cast(bf16x8, w); }
        __syncthreads();
#pragma unroll
        for (int i = 0; i < 16; ++i) *(LAS u32x4*)(sKV + ((tid >> 5) + 16 * i) * 264 + 8 * (tid & 31)) = vst[i];
        __syncthreads();
#pragma unroll 4
        for (int mt2 = 0; mt2 < 16; ++mt2) { f32x4 o = (f32x4){0.f, 0.f, 0.f, 0.f}; const LAS bf16_t* vr = sKV + (16 * mt2 + fr) * 264 + 4 * kg;
#pragma unroll
            for (int s2 = 0; s2 < 8; ++s2) { const u32x2 lo = *(const LAS u32x2*)(vr + 32 * s2), hi = *(const LAS u32x2*)(vr + 32 * s2 + 16);
                u32x4 w; w.x = lo.x; w.y = lo.y; w.z = hi.x; w.w = hi.y; o = MFMA16(__builtin_bit_cast(bf16x8, w), pf[s2], o); }
            u32x2 ow; ow.x = pk2(o[0] * inv, o[1] * inv); ow.y = pk2(o[2] * inv, o[3] * inv);
            if (!dry) *(u32x2*)(qrow + 16 * mt2 + 4 * kg) = ow; }
    }
}
template <bool FINAL> __device__ __forceinline__ void lru_phase(const Params& p, int b, LAS unsigned char* lds, int dry = 0) {
    const int tid = opq_tid(), lane = tid & 63, wave = tid >> 6, fr = lane & 15, kg = lane >> 4;
    bf16_t* P = proj_ptr(p);
    LAS bf16_t* sWA = (LAS bf16_t*)lds; LAS bf16_t* sWX = (LAS bf16_t*)(lds + 19968);
    LAS float* sCW = (LAS float*)(lds + 39936); LAS float* sCB = sCW + 384; LAS float* sBA = sCB + 96; LAS float* sBX = sBA + 96; LAS float* sSP = sBX + 96;
    LAS float* sXL = (LAS float*)(lds + 43008) + wave * 1600;
    LAS float* sAG = (LAS float*)(lds + 94208);
    float* agg = (float*)(wsb(p) + WS_LAGG) + (size_t)b * NBLK64 * LRUW * 2;
    const float* car = (const float*)(wsb(p) + WS_LCAR) + (size_t)b * NBLK64 * LRUW;
    const float* lcw = opq(p.lru_conv_w); const float* lcb = opq(p.lru_conv_b); const float* lba = opq(p.lru_b_a); const float* lbx = opq(p.lru_b_x); const float* lam = opq(p.lru_lambda);
    for (int u = opq_bid(); u < NLB * NSEG; u += gridDim.x) {
        const int n = u % NLB, sg = u / NLB;
        __syncthreads();
        { const bf16_t* gwa = (const bf16_t*)(wsb(p) + WS_LRUWA) + n * 9216; const bf16_t* gwx = (const bf16_t*)(wsb(p) + WS_LRUWX) + n * 9216;
          u32x4 wa3[3], wx3[3]; float cwv = 0.f, v4[4] = {0.f, 0.f, 0.f, 0.f};
#pragma unroll
          for (int i = 0; i < 3; ++i) { const int e = tid + 512 * i; if (e < 96 * 12) { const int j = e / 12, c8 = e % 12; wa3[i] = *(const u32x4*)(gwa + j * 96 + 8 * c8); wx3[i] = *(const u32x4*)(gwx + j * 96 + 8 * c8); } }
          if (tid < 384) cwv = lcw[(tid / 96) * 1536 + n * 96 + tid % 96];
          if (tid < 96) { v4[0] = lcb[n * 96 + tid]; v4[1] = lba[n * 96 + tid]; v4[2] = lbx[n * 96 + tid]; v4[3] = lam[n * 96 + tid]; }
#pragma unroll
          for (int i = 0; i < 3; ++i) { const int e = tid + 512 * i; if (e < 96 * 12) { const int j = e / 12, c8 = e % 12; *(LAS u32x4*)(sWA + j * 104 + 8 * c8) = wa3[i]; *(LAS u32x4*)(sWX + j * 104 + 8 * c8) = wx3[i]; } }
          if (tid < 384) sCW[tid] = cwv;
          if (tid < 96) { sCB[tid] = v4[0]; sBA[tid] = v4[1]; sBX[tid] = v4[2]; sSP[tid] = softplusf_(-v4[3]); } }
        __syncthreads();
        float runA[6], runH[6];
#pragma unroll
        for (int nt = 0; nt < 6; ++nt) { runA[nt] = 1.f; runH[nt] = FINAL ? car[(sg * 8 + wave) * LRUW + n * 96 + 16 * nt + fr] : 0.f; }
        for (int step = 0; step < 4; ++step) {
            const int tb = sg * LSEG + wave * 64 + step * 16;
            u32x4 rawC[3][4];
            { const int t0r = tb + fr - 3; unsigned ro = (unsigned)((t0r < 0 ? 0 : t0r) * LD + C_LX + n * 96 + 8 * kg); asm volatile("" : "+v"(ro));
              if (t0r >= 0) {
#pragma unroll
                  for (int ks = 0; ks < 3; ++ks)
#pragma unroll
                      for (int k = 0; k < 4; ++k) rawC[ks][k] = *(const u32x4*)(P + (ro + (unsigned)(k * LD + 32 * ks)));
              } else {
#pragma unroll
                  for (int ks = 0; ks < 3; ++ks)
#pragma unroll
                      for (int k = 0; k < 4; ++k) { const int t = t0r + k; rawC[ks][k] = *(const u32x4*)(P + (ro + (unsigned)((t < 0 ? 0 : t) * LD + 32 * ks))); if (t < 0) rawC[ks][k] = (u32x4){0u, 0u, 0u, 0u}; }
              } }
            bf16x8 af[3];
#pragma unroll
            for (int ks = 0; ks < 3; ++ks) { const int ch0 = 32 * ks + 8 * kg; float xl[8];
#pragma unroll
                for (int i = 0; i < 8; ++i) xl[i] = sCB[ch0 + i];
#pragma unroll
                for (int k = 0; k < 4; ++k) { const u32x4 raw = rawC[ks][k];
                    float rv[8]; unpack8(raw, rv);
#pragma unroll
                    for (int i = 0; i < 8; ++i) xl[i] += sCW[k * 96 + ch0 + i] * rv[i]; }
                *(LAS f32x4*)(sXL + fr * 100 + ch0) = (f32x4){xl[0], xl[1], xl[2], xl[3]}; *(LAS f32x4*)(sXL + fr * 100 + ch0 + 4) = (f32x4){xl[4], xl[5], xl[6], xl[7]};
                af[ks] = pack8(xl); }
            LAS bf16_t* sG = (LAS bf16_t*)((LAS unsigned char*)sWA + 106496) + wave * 1536;
            unsigned go3[3]; u32x4 graw[3];
            if (FINAL) {
#pragma unroll
                for (int i = 0; i < 3; ++i) { const int e = lane + 64 * i, row = e / 12, c12 = e % 12; go3[i] = (unsigned)((tb + row) * LD + C_LG + n * 96 + 8 * c12); }
                asm volatile("" : "+v"(go3[0]), "+v"(go3[1]), "+v"(go3[2]));
#pragma unroll
                for (int i = 0; i < 3; ++i) graw[i] = *(const u32x4*)(P + go3[i]); }
            f32x4 aR[6], aI[6];
#pragma unroll
            for (int nt = 0; nt < 6; ++nt) { aR[nt] = (f32x4){0.f, 0.f, 0.f, 0.f}; aI[nt] = (f32x4){0.f, 0.f, 0.f, 0.f};
#pragma unroll
                for (int ks = 0; ks < 3; ++ks) { const bf16x8 wa = *(const LAS bf16x8*)(sWA + (16 * nt + fr) * 104 + 32 * ks + 8 * kg), wx = *(const LAS bf16x8*)(sWX + (16 * nt + fr) * 104 + 32 * ks + 8 * kg);
                    aR[nt] = MFMA16(af[ks], wa, aR[nt]); aI[nt] = MFMA16(af[ks], wx, aI[nt]); } }
            float Ainc[6][4], Hinc[6][4];
#pragma unroll
            for (int nt = 0; nt < 6; ++nt) { const int j = 16 * nt + fr; const float ba2 = -1.44269504f * sBA[j], bx2 = -1.44269504f * sBX[j], spc = -8.f * 1.44269504f * sSP[j];
                float A = 1.f, H = 0.f;
#pragma unroll
                for (int r = 0; r < 4; ++r) { const float xlv = sXL[(4 * kg + r) * 100 + j];
                    const float rr = __builtin_amdgcn_rcpf(1.f + __builtin_amdgcn_exp2f(fmaf(aR[nt][r], -1.44269504f, ba2))), ii = __builtin_amdgcn_rcpf(1.f + __builtin_amdgcn_exp2f(fmaf(aI[nt][r], -1.44269504f, bx2)));
                    const float a = __builtin_amdgcn_exp2f(rr * spc), mult = __builtin_amdgcn_sqrtf(fmaxf(0.f, fmaf(-a, a, 1.f)));
                    H = a * H + mult * ii * xlv; A *= a; Ainc[nt][r] = A; Hinc[nt][r] = H; }
                float ap = 1.f, hp = 0.f, at = 1.f, ht = 0.f;
#pragma unroll
                for (int k = 0; k < 4; ++k) { const float ab = __shfl(A, fr + 16 * k), hb = __shfl(H, fr + 16 * k);
                    if (k < kg) { hp = ab * hp + hb; ap *= ab; } ht = ab * ht + hb; at *= ab; }
                if (FINAL) { const float hin = ap * runH[nt] + hp;
#pragma unroll
                    for (int r = 0; r < 4; ++r) Hinc[nt][r] = Ainc[nt][r] * hin + Hinc[nt][r]; }
                runH[nt] = at * runH[nt] + ht; runA[nt] *= at; }
            if (FINAL) {
#pragma unroll
                for (int i = 0; i < 3; ++i) { const int e = lane + 64 * i; *(LAS u32x4*)(sG + (e / 12) * 96 + 8 * (e % 12)) = graw[i]; }
                asm volatile("s_waitcnt lgkmcnt(0)" ::: "memory");
#pragma unroll
                for (int nt = 0; nt < 6; ++nt)
#pragma unroll
                    for (int r = 0; r < 4; ++r) { LAS bf16_t* gp = sG + (4 * kg + r) * 96 + 16 * nt + fr; const float yv = Hinc[nt][r] * siluf_(bf2f(*gp)); *gp = (bf16_t)f2bf(yv); }
                asm volatile("s_waitcnt lgkmcnt(0)" ::: "memory");
#pragma unroll
                for (int i = 0; i < 3; ++i) { const int e = lane + 64 * i; const u32x4 w = *(const LAS u32x4*)(sG + (e / 12) * 96 + 8 * (e % 12)); if (!dry) *(u32x4*)(P + go3[i]) = w; }
                asm volatile("s_waitcnt lgkmcnt(0)" ::: "memory"); }
        }
        if (!FINAL && kg == 0) {
#pragma unroll
            for (int nt = 0; nt < 6; ++nt) { const int ch = n * 96 + 16 * nt + fr; agg[((size_t)(sg * 8 + wave) * LRUW + ch) * 2] = runA[nt]; agg[((size_t)(sg * 8 + wave) * LRUW + ch) * 2 + 1] = runH[nt]; } }
    }
}
__device__ __forceinline__ void lru_carry_phase(const Params& p, int b) {
    const int tid = opq_tid(), lane = tid & 63, wave = tid >> 6;
    const float* agg = (const float*)(wsb(p) + WS_LAGG) + (size_t)b * NBLK64 * LRUW * 2; float* car = (float*)(wsb(p) + WS_LCAR) + (size_t)b * NBLK64 * LRUW;
    for (int ch = opq_bid() * 8 + wave; ch < LRUW; ch += gridDim.x * 8) {
        const float a0 = agg[((size_t)(2 * lane) * LRUW + ch) * 2], h0 = agg[((size_t)(2 * lane) * LRUW + ch) * 2 + 1];
        const float a1 = agg[((size_t)(2 * lane + 1) * LRUW + ch) * 2], h1 = agg[((size_t)(2 * lane + 1) * LRUW + ch) * 2 + 1];
        float A = a1 * a0, H = a1 * h0 + h1;
#pragma unroll
        for (int o = 1; o < 64; o <<= 1) { const float Ap = __shfl_up(A, o), Hp = __shfl_up(H, o); if (lane >= o) { H = A * Hp + H; A = A * Ap; } }
        float hin = __shfl_up(H, 1); if (lane == 0) hin = 0.f;
        car[(2 * lane) * LRUW + ch] = hin; car[(2 * lane + 1) * LRUW + ch] = a0 * hin + h0;
    }
}
__device__ __forceinline__ void conv8_silu(const bf16_t* P, int t, int col, const float* cw, const float* cb, int ch, float (&o)[8]) {
    float r[11];
    unsigned off0 = (unsigned)((t < 3 ? 0 : t - 3) * LD + col); asm volatile("" : "+v"(off0));
    if (t >= 3) {
#pragma unroll
        for (int i = 0; i < 11; ++i) r[i] = bf2f(P[off0 + (unsigned)(i * LD)]);
    } else {
#pragma unroll
        for (int i = 0; i < 11; ++i) { const int tt = t - 3 + i; const float v = bf2f(P[off0 + (unsigned)((tt < 0 ? 0 : tt) * LD)]); r[i] = tt < 0 ? 0.f : v; }
    }
    const float w0 = cw[ch], w1 = cw[3072 + ch], w2 = cw[6144 + ch], w3 = cw[9216 + ch], bb = cb[ch];
#pragma unroll
    for (int j = 0; j < 8; ++j) o[j] = siluf_(bb + w0 * r[j] + w1 * r[j + 1] + w2 * r[j + 2] + w3 * r[j + 3]);
}
__device__ __forceinline__ float ssd_dt_setup(const Params& p, const bf16_t* P, int t0, int h, int lane, LAS float* sACS, LAS float* sDT) {
    const float dtb = opq(p.ssd_dt_bias)[h], an = -__expf(opq(p.ssd_a_log)[h]);
    const float dt0 = softplusf_(bf2f(P[(size_t)(t0 + 2 * lane) * LD + C_DT + h]) + dtb), dt1 = softplusf_(bf2f(P[(size_t)(t0 + 2 * lane + 1) * LD + C_DT + h]) + dtb);
    const float dA1 = dt1 * an; float s = dt0 * an + dA1;
#pragma unroll
    for (int o = 1; o < 64; o <<= 1) { const float t = __shfl_up(s, o); if (lane >= o) s += t; }
    sACS[2 * lane] = s - dA1; sACS[2 * lane + 1] = s; sDT[2 * lane] = dt0; sDT[2 * lane + 1] = dt1;
    return __shfl(s, 63);
}
template <int R> __device__ __forceinline__ void conv_rows(const bf16_t* P, int t, int col, const float* cw, const float* cb, int ch, float (&o)[R][8]) {
    unsigned off0 = (unsigned)((t < 3 ? 0 : t - 3) * LD + col); asm volatile("" : "+v"(off0));
    u32x4 raw[R + 3];
    if (t >= 3) {
#pragma unroll
        for (int i = 0; i < R + 3; ++i) raw[i] = *(const u32x4*)(P + (off0 + (unsigned)(i * LD)));
    } else {
#pragma unroll
        for (int i = 0; i < R + 3; ++i) { const int tt = t - 3 + i; raw[i] = *(const u32x4*)(P + (off0 + (unsigned)((tt < 0 ? 0 : tt) * LD))); if (tt < 0) raw[i] = (u32x4){0u, 0u, 0u, 0u}; }
    }
    float w[4][8], bb[8];
#pragma unroll
    for (int k = 0; k < 4; ++k) { const f32x4 w0 = *(const f32x4*)(cw + k * 3072 + ch), w1 = *(const f32x4*)(cw + k * 3072 + ch + 4);
        w[k][0] = w0[0]; w[k][1] = w0[1]; w[k][2] = w0[2]; w[k][3] = w0[3]; w[k][4] = w1[0]; w[k][5] = w1[1]; w[k][6] = w1[2]; w[k][7] = w1[3]; }
    { const f32x4 b0 = *(const f32x4*)(cb + ch), b1 = *(const f32x4*)(cb + ch + 4); bb[0] = b0[0]; bb[1] = b0[1]; bb[2] = b0[2]; bb[3] = b0[3]; bb[4] = b1[0]; bb[5] = b1[1]; bb[6] = b1[2]; bb[7] = b1[3]; }
#pragma unroll
    for (int r = 0; r < R; ++r)
#pragma unroll
        for (int q = 0; q < 8; ++q) o[r][q] = bb[q];
#pragma unroll
    for (int i = 0; i < R + 3; ++i) { float v[8]; unpack8(raw[i], v);
#pragma unroll
        for (int k = 0; k < 4; ++k) { const int r = i - k; if (r >= 0 && r < R) {
#pragma unroll
                for (int q = 0; q < 8; ++q) o[r][q] += w[k][q] * v[q]; } } }
#pragma unroll
    for (int r = 0; r < R; ++r)
#pragma unroll
        for (int q = 0; q < 8; ++q) o[r][q] = siluf_(o[r][q]);
}
__device__ __forceinline__ void ssd_states_phase(const Params& p, int b, LAS unsigned char* lds) {
    const int tid = opq_tid(), lane = tid & 63, wave = tid >> 6, fr = lane & 15, kg = lane >> 4;
    const bf16_t* P = proj_ptr(p); bf16_t* ST = states_ptr(p, b); float* dasum = (float*)(wsb(p) + WS_DASUM) + b * NCHUNK * NHEAD;
    const float* cw = opq(p.ssd_conv_w); const float* cb = opq(p.ssd_conv_b);
    LAS bf16_t* sBT = (LAS bf16_t*)lds; LAS bf16_t* sXT = (LAS bf16_t*)(lds + 34816 + wave * 8704);
    LAS float* sACS = (LAS float*)(lds + 104448) + wave * 128; LAS float* sW = (LAS float*)(lds + 108544) + wave * 128;
    for (int u = opq_bid(); u < NCHUNK * NGRP; u += gridDim.x) {
        const int c = u >> 2, g = u & 3, t0 = c * CHUNK, h = 8 * g + wave;
        __syncthreads();
        { const float tot = ssd_dt_setup(p, P, t0, h, lane, sACS, sW);
          if (lane == 0) dasum[c * NHEAD + h] = tot;
          sW[2 * lane] = sW[2 * lane] * __expf(tot - sACS[2 * lane]); sW[2 * lane + 1] = sW[2 * lane + 1] * __expf(tot - sACS[2 * lane + 1]); }
        { const int cg = tid & 15, rs = tid >> 4; float o[4][8];
          conv_rows<4>(P, t0 + 4 * rs, C_B + g * 128 + 8 * cg, cw, cb, 2048 + g * 128 + 8 * cg, o);
#pragma unroll
          for (int q = 0; q < 8; ++q) { u32x2 w; w.x = pk2(o[0][q], o[1][q]); w.y = pk2(o[2][q], o[3][q]); *(LAS u32x2*)(sBT + (8 * cg + q) * 136 + 4 * rs) = w; } }
        __syncthreads();
        for (int ph = 0; ph < 2; ++ph) {
            { const int cg = lane & 3, rs = lane >> 2; float o[8][8];
              conv_rows<8>(P, t0 + 8 * rs, C_X + h * 64 + 32 * ph + 8 * cg, cw, cb, h * 64 + 32 * ph + 8 * cg, o);
              const f32x4 w0 = *(const LAS f32x4*)(sW + 8 * rs), w1 = *(const LAS f32x4*)(sW + 8 * rs + 4);
#pragma unroll
              for (int q = 0; q < 8; ++q) { float v[8] = {o[0][q] * w0[0], o[1][q] * w0[1], o[2][q] * w0[2], o[3][q] * w0[3], o[4][q] * w1[0], o[5][q] * w1[1], o[6][q] * w1[2], o[7][q] * w1[3]};
                  *(LAS bf16x8*)(sXT + (8 * cg + q) * 136 + 8 * rs) = pack8(v); } }
            asm volatile("s_waitcnt lgkmcnt(0)" ::: "memory");
            f32x4 acc[8][2];
#pragma unroll
            for (int mt = 0; mt < 8; ++mt) { acc[mt][0] = (f32x4){0.f, 0.f, 0.f, 0.f}; acc[mt][1] = (f32x4){0.f, 0.f, 0.f, 0.f}; }
#pragma unroll
            for (int s = 0; s < 4; ++s) { const bf16x8 x0 = *(const LAS bf16x8*)(sXT + fr * 136 + 32 * s + 8 * kg), x1 = *(const LAS bf16x8*)(sXT + (16 + fr) * 136 + 32 * s + 8 * kg);
#pragma unroll
                for (int mt = 0; mt < 8; ++mt) { const bf16x8 a = *(const LAS bf16x8*)(sBT + (16 * mt + fr) * 136 + 32 * s + 8 * kg);
                    acc[mt][0] = MFMA16(a, x0, acc[mt][0]); acc[mt][1] = MFMA16(a, x1, acc[mt][1]); } }
            asm volatile("s_waitcnt lgkmcnt(0)" ::: "memory");
#pragma unroll
            for (int mt = 0; mt < 8; ++mt)
#pragma unroll
                for (int nt = 0; nt < 2; ++nt) { const int n0 = 16 * mt + 4 * kg, pp = 32 * ph + 16 * nt + fr;
                    u32x2 w; w.x = pk2(acc[mt][nt][0], acc[mt][nt][1]); w.y = pk2(acc[mt][nt][2], acc[mt][nt][3]);
                    *(u32x2*)(ST + ((size_t)(c * NHEAD + h) * 64 + pp) * 128 + n0) = w; }
        }
    }
}
__device__ __forceinline__ void ssd_scan_phase(const Params& p, int b, int dry = 0) {
    unsigned* st = (unsigned*)states_ptr(p, b); const float* dasum = (const float*)(wsb(p) + WS_DASUM) + b * NCHUNK * NHEAD;
    for (int e2 = opq_bid() * 512 + opq_tid(); e2 < 131072; e2 += gridDim.x * 512) {
        const int h = e2 >> 12; float r0 = 0.f, r1 = 0.f;
        for (int c0 = 0; c0 < NCHUNK; c0 += 16) { unsigned v[16]; float d[16];
#pragma unroll
            for (int i = 0; i < 16; ++i) { v[i] = st[(size_t)(c0 + i) * 131072 + e2]; d[i] = dasum[(c0 + i) * NHEAD + h]; }
#pragma unroll
            for (int i = 0; i < 16; ++i) { const unsigned w = pk2(r0, r1); const float dd = __expf(d[i]);
                r0 = r0 * dd + __uint_as_float(v[i] << 16); r1 = r1 * dd + __uint_as_float(v[i] & 0xffff0000u); v[i] = w; }
            if (!dry) {
#pragma unroll
                for (int i = 0; i < 16; ++i) st[(size_t)(c0 + i) * 131072 + e2] = v[i]; } }
    }
}
__device__ __forceinline__ void ssd_out_phase(const Params& p, int b, LAS unsigned char* lds, int dry = 0) {
    const int tid = opq_tid(), lane = tid & 63, wave = tid >> 6, fr = lane & 15, kg = lane >> 4;
    bf16_t* P = proj_ptr(p); const bf16_t* ST = states_ptr(p, b);
    const float* cw = opq(p.ssd_conv_w); const float* cb = opq(p.ssd_conv_b);
    LAS bf16_t* sC = (LAS bf16_t*)lds; LAS bf16_t* sCB = (LAS bf16_t*)(lds + 34816); LAS bf16_t* sB = (LAS bf16_t*)(lds + 69632); LAS bf16_t* sXT = (LAS bf16_t*)(lds + 69632 + wave * 8704);
    LAS float* sACS = (LAS float*)(lds + 139264) + wave * 128; LAS float* sDT = (LAS float*)(lds + 143360) + wave * 128; LAS float* sSSQ = (LAS float*)(lds + 147456);
    for (int u = opq_bid(); u < NCHUNK * NGRP; u += gridDim.x) {
        const int c = u >> 2, g = u & 3, t0 = c * CHUNK, h = 8 * g + wave;
        __syncthreads();
        MSTAMP(p, 0);
        (void)ssd_dt_setup(p, P, t0, h, lane, sACS, sDT);
        { const int cg = tid & 15, rs = (tid >> 4) & 15, isC = tid >> 8; float o[8][8];
          conv_rows<8>(P, t0 + 8 * rs, C_B + isC * 512 + g * 128 + 8 * cg, cw, cb, 2048 + isC * 512 + g * 128 + 8 * cg, o);
          LAS bf16_t* dst = (isC ? sC : sB) + (8 * rs) * 136 + 8 * cg;
#pragma unroll
          for (int r = 0; r < 8; ++r) *(LAS bf16x8*)(dst + r * 136) = pack8(o[r]); }
        __syncthreads();
#pragma unroll
        for (int ms = 0; ms < 8; ++ms) if (ms <= wave) { f32x4 a4 = (f32x4){0.f, 0.f, 0.f, 0.f};
#pragma unroll
            for (int kn = 0; kn < 4; ++kn) { const bf16x8 a = *(const LAS bf16x8*)(sB + (16 * ms + fr) * 136 + 32 * kn + 8 * kg), bb = *(const LAS bf16x8*)(sC + (16 * wave + fr) * 136 + 32 * kn + 8 * kg);
                a4 = MFMA16(a, bb, a4); }
            u32x2 w; w.x = pk2(a4[0], a4[1]); w.y = pk2(a4[2], a4[3]);
            *(LAS u32x2*)(sCB + (16 * wave + fr) * 136 + 16 * ms + 4 * kg) = w; }
        __syncthreads();
        MSTAMP(p, 1);
        const float Dh = opq(p.ssd_d)[h];
        const unsigned zbase0 = (unsigned)((t0 + fr) * LD + C_Z + h * 64 + 4 * kg);
        float ssq[8];
#pragma unroll
        for (int nt = 0; nt < 8; ++nt) ssq[nt] = 0.f;
        for (int ph = 0; ph < 2; ++ph) {
            unsigned zb = zbase0 + 32u * ph; asm volatile("" : "+v"(zb));
            unsigned pfo = (unsigned)(((c * NHEAD + h) * 64 + 32 * ph + fr) * 128 + 8 * kg); asm volatile("" : "+v"(pfo));
            bf16x8 pf[4][2];
#pragma unroll
            for (int sn = 0; sn < 4; ++sn) { pf[sn][0] = *(const bf16x8*)(ST + (pfo + (unsigned)(32 * sn))); pf[sn][1] = *(const bf16x8*)(ST + (pfo + (unsigned)(16 * 128 + 32 * sn))); }
            { const int cg = lane & 3, rs = lane >> 2; float o[8][8];
              conv_rows<8>(P, t0 + 8 * rs, C_X + h * 64 + 32 * ph + 8 * cg, cw, cb, h * 64 + 32 * ph + 8 * cg, o);
#pragma unroll
              for (int q = 0; q < 8; ++q) { float v[8] = {o[0][q], o[1][q], o[2][q], o[3][q], o[4][q], o[5][q], o[6][q], o[7][q]};
                  *(LAS bf16x8*)(sXT + (8 * cg + q) * 136 + 8 * rs) = pack8(v); } }
            asm volatile("s_waitcnt lgkmcnt(0)" ::: "memory");
            f32x4 acc[2][8];
#pragma unroll
            for (int nt = 0; nt < 8; ++nt) { acc[0][nt] = (f32x4){0.f, 0.f, 0.f, 0.f}; acc[1][nt] = (f32x4){0.f, 0.f, 0.f, 0.f}; }
#pragma unroll
            for (int nt = 0; nt < 8; ++nt) {
#pragma unroll
                for (int sn = 0; sn < 4; ++sn) { const bf16x8 cf = *(const LAS bf16x8*)(sC + (16 * nt + fr) * 136 + 32 * sn + 8 * kg);
                    acc[0][nt] = MFMA16(pf[sn][0], cf, acc[0][nt]); acc[1][nt] = MFMA16(pf[sn][1], cf, acc[1][nt]); }
                const float sc = __expf(sACS[16 * nt + fr]);
                acc[0][nt] *= sc; acc[1][nt] *= sc; }
#pragma unroll
            for (int sk = 0; sk < 4; ++sk) {
                const int s0 = 32 * sk + 8 * kg;
                const bf16x8 xa0 = *(const LAS bf16x8*)(sXT + fr * 136 + s0), xa1 = *(const LAS bf16x8*)(sXT + (16 + fr) * 136 + s0);
                const f32x4 as0 = *(const LAS f32x4*)(sACS + s0), as1 = *(const LAS f32x4*)(sACS + s0 + 4), d0 = *(const LAS f32x4*)(sDT + s0), d1 = *(const LAS f32x4*)(sDT + s0 + 4);
#pragma unroll
                for (int nt = 0; nt < 8; ++nt) if (nt >= 2 * sk) { const int l = 16 * nt + fr; const float acsl = sACS[l];
                    float cbv[8]; unpack8(*(const LAS u32x4*)(sCB + l * 136 + s0), cbv);
                    float m[8];
#pragma unroll
                    for (int i = 0; i < 8; ++i) { const int s = s0 + i; const float as = i < 4 ? as0[i & 3] : as1[i & 3], ds = i < 4 ? d0[i & 3] : d1[i & 3];
                        float mv = (s <= l) ? cbv[i] * __expf(acsl - as) * ds : 0.f; if (s == l) mv += Dh; m[i] = mv; }
                    const bf16x8 mb = pack8(m);
                    acc[0][nt] = MFMA16(xa0, mb, acc[0][nt]); acc[1][nt] = MFMA16(xa1, mb, acc[1][nt]);
                    asm volatile("" ::: "memory"); }
            }
            u32x2 zall[8][2];
#pragma unroll
            for (int nt = 0; nt < 8; ++nt)
#pragma unroll
                for (int mt = 0; mt < 2; ++mt) zall[nt][mt] = *(const u32x2*)(P + (zb + (unsigned)(16 * nt * LD + 16 * mt)));
#pragma unroll
            for (int nt = 0; nt < 8; ++nt)
#pragma unroll
                for (int mt = 0; mt < 2; ++mt) { u32x2* zp = (u32x2*)(P + (zb + (unsigned)(16 * nt * LD + 16 * mt)));
                    const u32x2 zw = zall[nt][mt]; float y[4];
                    y[0] = acc[mt][nt][0] * siluf_(__uint_as_float(zw.x << 16)); y[1] = acc[mt][nt][1] * siluf_(__uint_as_float(zw.x & 0xffff0000u));
                    y[2] = acc[mt][nt][2] * siluf_(__uint_as_float(zw.y << 16)); y[3] = acc[mt][nt][3] * siluf_(__uint_as_float(zw.y & 0xffff0000u));
                    ssq[nt] += (y[0] * y[0] + y[1] * y[1]) + (y[2] * y[2] + y[3] * y[3]);
                    u32x2 yw; yw.x = pk2(y[0], y[1]); yw.y = pk2(y[2], y[3]); (void)zp; *(LAS u32x2*)(sXT + (16 * nt + fr) * 32 + 16 * mt + 4 * kg) = yw; }
            asm volatile("s_waitcnt lgkmcnt(0)" ::: "memory");
            { const int rr = lane >> 2, cc = lane & 3;
              unsigned so = (unsigned)((t0 + rr) * LD + C_Z + h * 64 + 32 * ph + 8 * cc); asm volatile("" : "+v"(so));
              if (ph == 0) {
#pragma unroll
                  for (int i = 0; i < 8; ++i) { const u32x4 w = *(const LAS u32x4*)(sXT + (16 * i + rr) * 32 + 8 * cc); if (!dry) *(u32x4*)(P + (so + (unsigned)(16 * i * LD))) = w; } } }
            asm volatile("s_waitcnt lgkmcnt(0)" ::: "memory");
        }
        MSTAMP(p, 2);
#pragma unroll
        for (int nt = 0; nt < 8; ++nt) { float v = ssq[nt]; v += __shfl_xor(v, 16); v += __shfl_xor(v, 32); if (kg == 0) sSSQ[wave * 128 + 16 * nt + fr] = v; }
        __syncthreads();
        { const int rr = lane >> 2, cc = lane & 3;
          const float* ng = opq(p.ssd_norm_g) + g * 512 + wave * 64 + 8 * cc;
          f32x4 gg[2][2];
#pragma unroll
          for (int ph = 0; ph < 2; ++ph) { gg[ph][0] = *(const f32x4*)(ng + 32 * ph); gg[ph][1] = *(const f32x4*)(ng + 32 * ph + 4); }
          unsigned so = (unsigned)((t0 + rr) * LD + C_Z + h * 64 + 8 * cc); asm volatile("" : "+v"(so));
          u32x4 yv[8][2];
#pragma unroll
          for (int i = 0; i < 8; ++i)
#pragma unroll
              for (int ph = 0; ph < 2; ++ph) yv[i][ph] = ph == 0 ? *(const u32x4*)(P + (so + (unsigned)(16 * i * LD))) : *(const LAS u32x4*)(sXT + (16 * i + rr) * 32 + 8 * cc);
#pragma unroll
          for (int i = 0; i < 8; ++i) { const int l = 16 * i + rr; float tot = 0.f;
#pragma unroll
              for (int w2 = 0; w2 < 8; ++w2) tot += sSSQ[w2 * 128 + l];
              const float rs = 1.f / sqrtf(tot * (1.f / 512.f) + EPS);
#pragma unroll
              for (int ph = 0; ph < 2; ++ph) { float v[8]; unpack8(yv[i][ph], v);
                  v[0] *= rs * gg[ph][0][0]; v[1] *= rs * gg[ph][0][1]; v[2] *= rs * gg[ph][0][2]; v[3] *= rs * gg[ph][0][3];
                  v[4] *= rs * gg[ph][1][0]; v[5] *= rs * gg[ph][1][1]; v[6] *= rs * gg[ph][1][2]; v[7] *= rs * gg[ph][1][3];
                  if (!dry) *(bf16x8*)(P + (so + (unsigned)(16 * i * LD + 32 * ph))) = pack8(v); } } }
        MSTAMP(p, 3);
    }
}
#define XB_TMO      128
#define XB_XCNT(j)  (256  + 64 * (j))
#define XB_XSUB(j)  (1280 + 64 * (j))
#define XB_XGEN(j)  (2304 + 64 * (j))
#define XB_TOP      3328
#define XB_TOPGEN   3392
#define XCD_BAR_WORDS 3456
#define XB_SPIN_CAP (1u << 18)

__device__ __forceinline__ unsigned xb_ld(unsigned* p)              { return __hip_atomic_load(p, __ATOMIC_RELAXED, __HIP_MEMORY_SCOPE_AGENT); }
__device__ __forceinline__ unsigned xb_add(unsigned* p, unsigned v) { return __hip_atomic_fetch_add(p, v, __ATOMIC_RELAXED, __HIP_MEMORY_SCOPE_AGENT); }
__device__ __forceinline__ unsigned xb_xcc_id() { return (unsigned)__builtin_amdgcn_s_getreg((3 << 11) | 20) & 0xFu; }
#define XB_SPIN(cond, bar) do { unsigned _sp = 0; while (cond) { __builtin_amdgcn_s_sleep(1); \
    if ((++_sp & 255u) == 0u) { if (xb_ld(&(bar)[XB_TMO])) break; if (_sp > XB_SPIN_CAP) { atomicAdd(&(bar)[XB_TMO], 1u); break; } } } } while (0)

struct XcdBarrier {
    unsigned* bar; unsigned x;
    volatile LAS unsigned* st;
};

__device__ __forceinline__ XcdBarrier xcd_barrier_post(unsigned* bar, volatile LAS unsigned* st) {
    XcdBarrier b; b.bar = bar; b.x = xb_xcc_id(); b.st = st;
    if (threadIdx.x == 0) (void)xb_add(&bar[XB_XCNT(b.x)], 1u);
    return b;
}
__device__ __forceinline__ void xcd_barrier_complete(unsigned* bar, unsigned x, unsigned& nloc, unsigned& nx) {
    const unsigned G = gridDim.x * gridDim.y * gridDim.z;
    unsigned sum, cnt, mine, sp = 0u;
    for (;;) {
        sum = 0u; cnt = 0u; mine = 0u;
#pragma unroll
        for (unsigned j = 0; j < 16; ++j) { const unsigned c = xb_ld(&bar[XB_XCNT(j)]); sum += c; cnt += (c > 0u) ? 1u : 0u; mine = (j == x) ? c : mine; }
        if (sum == G) break;
        __builtin_amdgcn_s_sleep(1);
        if ((++sp & 255u) == 0u) { if (xb_ld(&bar[XB_TMO])) break; if (sp > XB_SPIN_CAP) { atomicAdd(&bar[XB_TMO], 1u); break; } }
    }
    nloc = mine > 0u ? mine : 1u; nx = cnt > 0u ? cnt : 1u;
}

__device__ __forceinline__ void xcd_barrier(const XcdBarrier& b) {
    asm volatile("s_waitcnt vmcnt(0)" ::: "memory");
    __syncthreads();
    if (threadIdx.x == 0) {
        unsigned* bar = b.bar; asm volatile("" : "+s"(bar));
        unsigned bx = b.x; asm volatile("" : "+s"(bx));
        __builtin_amdgcn_s_waitcnt(0);
        unsigned nloc = b.st[0], nx = b.st[1];
        if (nloc == 0u) { xcd_barrier_complete(bar, bx, nloc, nx); b.st[0] = nloc; b.st[1] = nx; }
        const unsigned old = xb_add(&bar[XB_XSUB(bx)], 1u);
        const unsigned gen = old / nloc;
        if (old + 1u == (gen + 1u) * nloc) {
            __builtin_amdgcn_fence(__ATOMIC_RELEASE, "agent");
            asm volatile("s_waitcnt vmcnt(0)" ::: "memory");
            const unsigned og = xb_add(&bar[XB_TOP], 1u);
            const unsigned tg = og / nx;
            if (og + 1u == (tg + 1u) * nx) xb_add(&bar[XB_TOPGEN], 1u);
            else XB_SPIN(xb_ld(&bar[XB_TOPGEN]) == tg, bar);
            __builtin_amdgcn_fence(__ATOMIC_ACQUIRE, "agent");
            xb_add(&bar[XB_XGEN(bx)], 1u);
            asm volatile("s_waitcnt vmcnt(0)" ::: "memory");
        } else {
            XB_SPIN(xb_ld(&bar[XB_XGEN(bx)]) == gen, bar);
            __builtin_amdgcn_fence(__ATOMIC_ACQUIRE, "agent");
            asm volatile("s_waitcnt vmcnt(0)" ::: "memory");
        }
    }
    __syncthreads();
}

#ifdef REP_COLD
#define REP_SEP() xcd_barrier(bar)
#else
#define REP_SEP() __syncthreads()
#endif
#define RUNP(n, ...) do { if ((n) > 1) { for (int r_ = nrep(n) - 1; r_ > 0; --r_) { const int dry_ = 1; (void)dry_; __VA_ARGS__; REP_SEP(); } } { const int dry_ = 0; (void)dry_; __VA_ARGS__; } } while (0)
#ifndef REP_SYNC
#define REP_SYNC 1
#endif
#ifndef REP_P0
#define REP_P0 1
#endif
#ifndef REP_P1
#define REP_P1 1
#endif
#ifndef REP_P5
#define REP_P5 1
#endif
#ifndef REP_P6
#define REP_P6 1
#endif
#ifndef REP_ST
#define REP_ST 1
#endif
#ifndef REP_LA
#define REP_LA 1
#endif
#ifndef REP_AT
#define REP_AT 1
#endif
#ifndef REP_SC
#define REP_SC 1
#endif
#ifndef REP_SO
#define REP_SO 1
#endif
#ifndef REP_LF
#define REP_LF 1
#endif
__device__ __forceinline__ int nrep(int n) { asm volatile("" : "+s"(n)); return n; }
__device__ __forceinline__ LAS unsigned char* opl(LAS unsigned char* q) { asm volatile("" : "+s"(q)); return q; }
__global__ void __launch_bounds__(512) mk(Params p) {
    extern __shared__ __attribute__((aligned(16))) unsigned char lds_raw[];
    LAS unsigned char* lds = (LAS unsigned char*)lds_raw;
    if (threadIdx.x < 4) ((volatile LAS unsigned*)(lds + LDS_BYTES - 16))[threadIdx.x] = 0u;
    __syncthreads();
    const XcdBarrier bar = xcd_barrier_post((unsigned*)(p.ws + WS_CTL), (volatile LAS unsigned*)(lds + LDS_BYTES - 16));
    if (p.hi > 1000) cg::this_grid().sync();
#ifdef PROBE_SPAN
    unsigned long long ts0 = 0, ts1 = 0;
#define STAMP(i) do { if ((i) == PROBE_SPAN) ts0 = __builtin_amdgcn_s_memrealtime(); if ((i) == PROBE_SPAN + PROBE_LEN) ts1 = __builtin_amdgcn_s_memrealtime(); } while (0)
#else
#define STAMP(i) do { } while (0)
#endif
    STAMP(0);
    RUNP(REP_P0, phase0(p, opl(lds)));
    xcd_barrier(bar); STAMP(1);
#define BATCH_PHASES(b) do { \
        RUNP(REP_P1, phase1_gemm(p, b, opl(lds))); \
        for (int r = 0; r < nrep(REP_SYNC); ++r) xcd_barrier(bar); \
        STAMP(2 + 6 * b); \
        RUNP(REP_ST, ssd_states_phase(p, b, opl(lds))); \
        __syncthreads(); STAMP(20 + 3 * b); \
        RUNP(REP_LA, lru_phase<false>(p, b, opl(lds), 0)); \
        __syncthreads(); STAMP(21 + 3 * b); \
        RUNP(REP_AT, attn_phase(p, b, opl(lds), dry_)); \
        xcd_barrier(bar); STAMP(3 + 6 * b); \
        RUNP(REP_SC, ssd_scan_phase(p, b, dry_)); \
        lru_carry_phase(p, b); \
        if (b == 0 && gridDim.x == 256) { __syncthreads(); transpose_items(p, opl(lds), TI_EARLY, TI_ALL); }     \
        xcd_barrier(bar); STAMP(4 + 6 * b); \
        RUNP(REP_SO, ssd_out_phase(p, b, opl(lds), dry_)); \
        __syncthreads(); STAMP(22 + 3 * b); \
        RUNP(REP_LF, lru_phase<true>(p, b, opl(lds), dry_)); \
        xcd_barrier(bar); STAMP(5 + 6 * b); \
        RUNP(REP_P5, phase5_gemm(p, b, opl(lds))); \
        xcd_barrier(bar); STAMP(6 + 6 * b); \
        RUNP(REP_P6, phase6_gemm(p, b, opl(lds))); \
        if (b + 1 < NBATCH && gridDim.x != 256) xcd_barrier(bar);     \
        STAMP(7 + 6 * b); \
    } while (0)
    BATCH_PHASES(0);
    BATCH_PHASES(1);
#ifdef PROBE_MA
    if (blockIdx.x == 0 && threadIdx.x == 0) { const unsigned long long* tsm = (const unsigned long long*)(p.ws + 255 * MiB); const unsigned long long t2 = __builtin_amdgcn_s_memrealtime(), want = 8ull * (tsm[PROBE_MB] - tsm[PROBE_MA]);
        while (__builtin_amdgcn_s_memrealtime() - t2 < want) __builtin_amdgcn_s_sleep(16); }
#endif
#ifdef PROBE_SPAN
    if (blockIdx.x == 0 && threadIdx.x == 0) { const unsigned long long t2 = __builtin_amdgcn_s_memrealtime(), want = 8ull * (ts1 - ts0);
        while (__builtin_amdgcn_s_memrealtime() - t2 < want) __builtin_amdgcn_s_sleep(16); }
#endif
}

static void launch_mk(Params& p, int lo, int hi, int grid, hipStream_t stream) {
    p.lo = lo; p.hi = hi; void* args[] = {&p};
    (void)hipMemsetAsync(p.ws + WS_CTL, 0, 65536, stream);
    hipError_t e = hipLaunchCooperativeKernel((const void*)mk, dim3(grid), dim3(512), args, LDS_BYTES, stream);
    if (e != hipSuccess) fprintf(stderr, "cooperative launch failed: %s (grid %d)\n", hipGetErrorString(e), grid);
}
extern "C" void kernel_launch(void* const* d_in, const int* in_sizes, int n_in, void* d_out, int out_size, void* d_ws, size_t ws_size, hipStream_t stream) {
    static int grid = 0;
    if (grid == 0) {
        if (n_in != 24 || out_size != MTOK * DM || ws_size < WS_END) { fprintf(stderr, "kernel_launch: unexpected shapes (n_in %d out %d ws %zu)\n", n_in, out_size, ws_size); grid = -1; return; }
        int dev = 0, cus = 0, per_cu = 0;
        hipGetDevice(&dev); hipDeviceGetAttribute(&cus, hipDeviceAttributeMultiprocessorCount, dev);
        hipFuncSetAttribute((const void*)mk, hipFuncAttributeMaxDynamicSharedMemorySize, LDS_BYTES);
        hipOccupancyMaxActiveBlocksPerMultiprocessor(&per_cu, (const void*)mk, 512, LDS_BYTES);
        if (per_cu < 1) { fprintf(stderr, "kernel_launch: occupancy query says %d blocks/CU\n", per_cu); per_cu = 1; }
        grid = cus * 1;
        (void)hipGetLastError();
    }
    if (grid < 0) return;
    Params p{};
    const float** f = (const float**)&p;
    for (int i = 0; i < 24; ++i) f[i] = (const float*)d_in[i];
    p.out = (float*)d_out; p.ws = (unsigned char*)d_ws;
    launch_mk(p, 0, 14, grid, stream);
}
```

```cpp
#define NAIVE_GEMM 0
#define NAIVE_ATT 0
#define NAIVE_LRU 0
#define NAIVE_SSD 0
#define ONE_LAUNCH 1

#include <hip/hip_runtime.h>
#include <hip/hip_cooperative_groups.h>
#include <cstdio>
#include <cstdint>
namespace cg = cooperative_groups;

#ifndef NAIVE_GEMM
#define NAIVE_GEMM 1
#endif
#ifndef NAIVE_SSD
#define NAIVE_SSD 1
#endif
#ifndef NAIVE_LRU
#define NAIVE_LRU 1
#endif
#ifndef NAIVE_ATT
#define NAIVE_ATT 1
#endif
#ifndef ONE_LAUNCH
#define ONE_LAUNCH 0
#endif

namespace pg8 {
#define PG8_LAS __attribute__((address_space(3)))
typedef unsigned short bf16_t;
typedef short bf16x8 __attribute__((ext_vector_type(8)));
typedef float f32x4 __attribute__((ext_vector_type(4)));
typedef unsigned u32x4 __attribute__((ext_vector_type(4)));
constexpr int BM = 256, BK = 64, HALF = 128, HTB = HALF * BK * 2  , STAGE_BYTES = 8 * HTB, NXCD = 8, WGM = 8;

__host__ __device__ __forceinline__ int lds_byte(int r, int c) { const int st = (r >> 4) * 2 + (c >> 5), rr = r & 15, cc = c & 31, ob = rr * 64 + cc * 2; return st * 1024 + (ob ^ (((ob >> 9) & 1) << 5)); }
__host__ __device__ __forceinline__ void stage_rc(int b, int& R, int& C) { const int st = b / 1024, sb = b % 1024, swz = sb ^ (((sb >> 9) & 1) << 5); R = (st >> 1) * 16 + swz / 64; C = (st & 1) * 32 + (swz % 64) / 2; }
__host__ __device__ __forceinline__ int perm32(int rho) { const int n = rho >> 4, i = rho & 15; return 8 * (i >> 2) + 4 * n + (i & 3); }

struct Unit { int pm, pn; };
struct Gemm { const bf16_t* A; const bf16_t* Bt; int M, N, K, lda, ldb; };

struct StaticOrder {
    int nM, nN, nwg, G, c;
    __host__ __device__ void init(int M, int N, int G_, int c_) { nM = M / BM; nN = N / BM; nwg = nM * nN; G = G_; c = c_; }
    __host__ __device__ bool next(int i, Unit& u) const {
        const long L = (long)i * G + c; if (L >= nwg) return false;
        int wgid = (int)L; { const int q = nwg / NXCD, r = nwg % NXCD, xcd = wgid % NXCD, off = wgid / NXCD; wgid = (xcd < r ? xcd * (q + 1) : r * (q + 1) + (xcd - r) * q) + off; }
        const int nig = WGM * nN, gid = wgid / nig, fm = gid * WGM, gsz = (nM - fm) < WGM ? (nM - fm) : WGM;
        u.pm = fm + ((wgid % nig) % gsz); u.pn = (wgid % nig) / gsz; return true;
    }
    __device__ __forceinline__ void a_ready(const Unit&) const {}
    __device__ __forceinline__ void done(const Unit&) const {}
};

__device__ __forceinline__ unsigned cvt_pk_bf16(float lo, float hi) { unsigned r; asm volatile("v_cvt_pk_bf16_f32 %0, %1, %2" : "=v"(r) : "v"(lo), "v"(hi)); return r; }
typedef float f32x2 __attribute__((ext_vector_type(2)));
__device__ __forceinline__ f32x2 gelu_pk(f32x2 v) {
    const f32x2 av = __builtin_elementwise_abs(v), d = av * 0.2316418882f + 1.0f;
    f32x2 t; t.x = __builtin_amdgcn_rcpf(d.x); t.y = __builtin_amdgcn_rcpf(d.y);
    f32x2 q = t * 0.5307027145f + (-0.7265760135f); q = q * t + 0.7107068705f; q = q * t + (-0.142248368f); q = q * t + 0.127414796f; q = q * t;
    const f32x2 s = (v * v) * (-0.72134752044f);
    f32x2 e; e.x = __builtin_amdgcn_exp2f(s.x); e.y = __builtin_amdgcn_exp2f(s.y);
    const f32x2 m = v * (q * e), r = v - m;
    f32x2 o; o.x = v.x < 0.f ? m.x : r.x; o.y = v.y < 0.f ? m.y : r.y; return o;
}

template <int ACT  > struct EpiBf16 {
    static constexpr bool PERM = true, AFTER_DRAIN = false; static_assert(ACT == 0 || ACT == 1, "EpiBf16: ACT is 0 (none) or 1 (gelu_pk)");
    bf16_t* O; int ldc; const float* bias; int split_cols; size_t split_stride; float scale0;
    __device__ __forceinline__ void operator()(const f32x4 (&acc)[2][2][4][2], const Unit& u, int wr, int wc, int fr, int fq) const {
        const int row0 = u.pm * BM + wr * 64 + fr; int colt = u.pn * BM; bf16_t* base = O;
        float sc = 1.f; if (split_cols) { const int t = colt / split_cols; base += (size_t)t * split_stride; colt -= t * split_cols; if (t == 0) sc = scale0; }
        const int col0 = colt + wc * 32 + 8 * fq, bcol0 = u.pn * BM + wc * 32 + 8 * fq;
        f32x4 bv[2][2];
#pragma unroll
        for (int bj = 0; bj < 2; ++bj)
#pragma unroll
            for (int n = 0; n < 2; ++n) bv[bj][n] = bias ? *(const f32x4*)(bias + bcol0 + bj * HALF + 4 * n) : (f32x4){0.f, 0.f, 0.f, 0.f};
#pragma unroll
        for (int ai = 0; ai < 2; ++ai)
#pragma unroll
            for (int m = 0; m < 4; ++m) { bf16_t* rowp = base + (size_t)(row0 + ai * HALF + m * 16) * ldc + col0;
#pragma unroll
                for (int bj = 0; bj < 2; ++bj) { f32x4 v0 = acc[ai][bj][m][0] + bv[bj][0], v1 = acc[ai][bj][m][1] + bv[bj][1];
                    if (ACT == 1) { f32x2 a = gelu_pk((f32x2){v0[0], v0[1]}), b = gelu_pk((f32x2){v0[2], v0[3]}), c = gelu_pk((f32x2){v1[0], v1[1]}), d = gelu_pk((f32x2){v1[2], v1[3]});
                        v0 = (f32x4){a.x, a.y, b.x, b.y}; v1 = (f32x4){c.x, c.y, d.x, d.y}; }
                    v0 = v0 * sc; v1 = v1 * sc; u32x4 w; w.x = cvt_pk_bf16(v0[0], v0[1]); w.y = cvt_pk_bf16(v0[2], v0[3]); w.z = cvt_pk_bf16(v1[0], v1[1]); w.w = cvt_pk_bf16(v1[2], v1[3]);
                    *(u32x4*)(rowp + bj * HALF) = w; } }
    }
};
template <class Epi, class Sched, bool ALIGN_EPI = false, bool SP2 = false>
__device__ __forceinline__ void gemm_phase(PG8_LAS unsigned char* lds, const Gemm g, const Sched& S, const Epi& E) {
    int tid_ = threadIdx.x; asm volatile("" : "+v"(tid_));
    const int tid = tid_, wid = __builtin_amdgcn_readfirstlane(tid >> 6), lane = tid & 63, wr = wid >> 2, wc = wid & 3, fr = lane & 15, fq = lane >> 4;
    const int K = g.K, nt = K / BK;
    unsigned voffA[2], voffB[2];
#pragma unroll
    for (int i = 0; i < 2; ++i) { int R, C; stage_rc(tid * 16 + i * 8192, R, C); const int Rb = Epi::PERM ? ((R & ~31) + perm32(R & 31)) : R;
        voffA[i] = (unsigned)(R * g.lda + C) * 2u; voffB[i] = (unsigned)(Rb * g.ldb + C) * 2u; }
    const size_t kstep = (size_t)(BK * 2);
    const size_t hstepA = (size_t)HALF * g.lda * 2, hstepB = (size_t)HALF * g.ldb * 2;
    const size_t tstepA = 2 * hstepA, tstepB = 2 * hstepB;
    const unsigned ldsw = (unsigned)wid * 1024u;
    const int aoff = lds_byte(wr * 64 + fr, fq * 8), boff = lds_byte(wc * 32 + fr, fq * 8);
#define PG8_SA(b, h) (((b) * 2 + (h)) * HTB)
#define PG8_SB(b, h) ((4 + (b) * 2 + (h)) * HTB)
#define PG8_STAGE(bufoff, gbase, voff) do { _Pragma("unroll") for (int _i = 0; _i < 2; ++_i) \
        __builtin_amdgcn_global_load_lds((const unsigned*)((const char*)(gbase) + (voff)[_i]), (PG8_LAS unsigned*)(lds + (bufoff) + ldsw + _i * 8192), 16, 0, 0); } while (0)
#define PG8_LDA(dst, b, h) do { _Pragma("unroll") for (int m = 0; m < 4; ++m) _Pragma("unroll") for (int k = 0; k < 2; ++k) dst[m][k] = *(const PG8_LAS bf16x8*)(lds + PG8_SA(b, h) + aoff + m * 2048 + k * 1024); } while (0)
#define PG8_LDB(dst, b, h) do { _Pragma("unroll") for (int n = 0; n < 2; ++n) _Pragma("unroll") for (int k = 0; k < 2; ++k) dst[n][k] = *(const PG8_LAS bf16x8*)(lds + PG8_SB(b, h) + boff + n * 2048 + k * 1024); } while (0)
#define PG8_MMA(ai, bj, At, Bt) do { __builtin_amdgcn_s_setprio(1); _Pragma("unroll") for (int m = 0; m < 4; ++m) _Pragma("unroll") for (int n = 0; n < 2; ++n) _Pragma("unroll") for (int k = 0; k < 2; ++k) \
        acc[ai][bj][m][n] = __builtin_amdgcn_mfma_f32_16x16x32_bf16(Bt[n][k], At[m][k], acc[ai][bj][m][n], 0, 0, 0); __builtin_amdgcn_s_setprio(0); } while (0)
#define PG8_WAIT_V(n) asm volatile("s_waitcnt vmcnt(" #n ")" ::: "memory")
#define PG8_WAIT_L(n) asm volatile("s_waitcnt lgkmcnt(" #n ")" ::: "memory")
#define PG8_BAR __builtin_amdgcn_s_barrier()
#define PG8_SCHED __builtin_amdgcn_sched_barrier(0)
    Unit cur, nxt; int ui = 0;
    if (!S.next(0, cur)) return;
    f32x4 acc[2][2][4][2];
#pragma unroll
    for (int a = 0; a < 2; ++a)
#pragma unroll
        for (int b = 0; b < 2; ++b)
#pragma unroll
            for (int m = 0; m < 4; ++m)
#pragma unroll
                for (int n = 0; n < 2; ++n) acc[a][b][m][n] = (f32x4){0.f, 0.f, 0.f, 0.f};
    bf16x8 At[4][2], B0[2][2], B1[2][2];
    const char* cA = (const char*)g.A + (size_t)cur.pm * tstepA; const char* cB = (const char*)g.Bt + (size_t)cur.pn * tstepB;
    S.a_ready(cur);
    if constexpr (SP2) {
        PG8_STAGE(PG8_SB(0, 0), cB, voffB); PG8_STAGE(PG8_SB(0, 1), cB + hstepB, voffB); PG8_STAGE(PG8_SA(0, 0), cA, voffA); PG8_STAGE(PG8_SA(0, 1), cA + hstepA, voffA);
        if (wr == 1) PG8_BAR;
        PG8_WAIT_V(2); PG8_BAR;
        PG8_STAGE(PG8_SB(1, 0), cB + kstep, voffB); PG8_STAGE(PG8_SA(1, 0), cA + kstep, voffA); PG8_STAGE(PG8_SB(1, 1), cB + hstepB + kstep, voffB);
        PG8_WAIT_V(6); PG8_BAR;
    } else {
        PG8_STAGE(PG8_SB(0, 0), cB, voffB); PG8_STAGE(PG8_SA(0, 0), cA, voffA); PG8_STAGE(PG8_SB(0, 1), cB + hstepB, voffB); PG8_STAGE(PG8_SA(0, 1), cA + hstepA, voffA);
        if (wr == 1) PG8_BAR;
        PG8_WAIT_V(4); PG8_BAR;
        PG8_STAGE(PG8_SB(1, 0), cB + kstep, voffB); PG8_STAGE(PG8_SA(1, 0), cA + kstep, voffA); PG8_STAGE(PG8_SB(1, 1), cB + hstepB + kstep, voffB);
        PG8_WAIT_V(6); PG8_BAR;
    }
    for (;;) {
        const bool has_next = S.next(ui + 1, nxt);
        const char* nA = has_next ? (const char*)g.A + (size_t)nxt.pm * tstepA : cA; const char* nB = has_next ? (const char*)g.Bt + (size_t)nxt.pn * tstepB : cB;
        for (int t = 0; t < nt; t += 2) {
            const bool last = (t == nt - 2);
            const char* a1 = cA + (size_t)(t + 1) * kstep;
            const char* a2 = last ? nA : cA + (size_t)(t + 2) * kstep; const char* b2 = last ? nB : cB + (size_t)(t + 2) * kstep;
            const char* a3 = a2 + kstep; const char* b3 = b2 + kstep;
            if (last && has_next) S.a_ready(nxt);
            if constexpr (SP2) {
            PG8_LDB(B0, 0, 0); PG8_LDB(B1, 0, 1); PG8_SCHED; PG8_LDA(At, 0, 0); PG8_STAGE(PG8_SA(1, 1), a1 + hstepA, voffA);
            PG8_WAIT_V(8); PG8_WAIT_L(0); PG8_BAR; PG8_MMA(0, 0, At, B0); PG8_MMA(0, 1, At, B1); PG8_BAR; PG8_SCHED;
            PG8_LDA(At, 0, 1); PG8_STAGE(PG8_SB(0, 0), b2, voffB); PG8_STAGE(PG8_SB(0, 1), b2 + hstepB, voffB); PG8_STAGE(PG8_SA(0, 0), a2, voffA);
            PG8_WAIT_V(8); PG8_WAIT_L(0); PG8_BAR; PG8_MMA(1, 0, At, B0); PG8_MMA(1, 1, At, B1); PG8_BAR; PG8_SCHED;
            PG8_LDB(B0, 1, 0); PG8_LDB(B1, 1, 1); PG8_SCHED; PG8_LDA(At, 1, 0); PG8_STAGE(PG8_SA(0, 1), a2 + hstepA, voffA);
            PG8_WAIT_V(8); PG8_WAIT_L(0); PG8_BAR; PG8_MMA(0, 0, At, B0); PG8_MMA(0, 1, At, B1); PG8_BAR; PG8_SCHED;
            PG8_LDA(At, 1, 1); PG8_STAGE(PG8_SB(1, 0), b3, voffB); PG8_STAGE(PG8_SB(1, 1), b3 + hstepB, voffB); PG8_STAGE(PG8_SA(1, 0), a3, voffA);
            PG8_WAIT_V(8); PG8_WAIT_L(0); PG8_BAR; PG8_MMA(1, 0, At, B0); PG8_MMA(1, 1, At, B1); PG8_BAR; PG8_SCHED;
            } else {
            PG8_LDB(B0, 0, 0); PG8_SCHED; PG8_LDA(At, 0, 0); PG8_STAGE(PG8_SA(1, 1), a1 + hstepA, voffA);
            PG8_WAIT_L(8); PG8_BAR; PG8_WAIT_L(0); PG8_MMA(0, 0, At, B0); PG8_BAR; PG8_SCHED;
            PG8_LDB(B1, 0, 1); PG8_STAGE(PG8_SB(0, 0), b2, voffB);
            PG8_BAR; PG8_WAIT_L(0); PG8_MMA(0, 1, At, B1); PG8_BAR;
            PG8_LDA(At, 0, 1); PG8_STAGE(PG8_SA(0, 0), a2, voffA);
            PG8_BAR; PG8_WAIT_L(0); PG8_MMA(1, 0, At, B0); PG8_BAR; PG8_SCHED;
            PG8_STAGE(PG8_SB(0, 1), b2 + hstepB, voffB);
            PG8_WAIT_V(6); PG8_BAR; PG8_MMA(1, 1, At, B1); PG8_BAR;
            PG8_LDB(B0, 1, 0); PG8_SCHED; PG8_LDA(At, 1, 0); PG8_STAGE(PG8_SA(0, 1), a2 + hstepA, voffA);
            PG8_WAIT_L(8); PG8_BAR; PG8_WAIT_L(0); PG8_MMA(0, 0, At, B0); PG8_BAR; PG8_SCHED;
            PG8_LDB(B1, 1, 1); PG8_STAGE(PG8_SB(1, 0), b3, voffB);
            PG8_BAR; PG8_WAIT_L(0); PG8_MMA(0, 1, At, B1); PG8_BAR;
            PG8_LDA(At, 1, 1); PG8_STAGE(PG8_SA(1, 0), a3, voffA);
            PG8_BAR; PG8_WAIT_L(0); PG8_MMA(1, 0, At, B0); PG8_BAR; PG8_SCHED;
            PG8_STAGE(PG8_SB(1, 1), b3 + hstepB, voffB);
            PG8_WAIT_V(6); PG8_BAR; PG8_MMA(1, 1, At, B1); PG8_BAR;
            }
        }
        if constexpr (ALIGN_EPI) { if (wr == 0) PG8_BAR; }
        if constexpr (!Epi::AFTER_DRAIN) { E(acc, cur, wr, wc, fr, fq); S.done(cur); }
        if (!has_next) break;
#pragma unroll
        for (int a = 0; a < 2; ++a)
#pragma unroll
            for (int b = 0; b < 2; ++b)
#pragma unroll
                for (int m = 0; m < 4; ++m)
#pragma unroll
                    for (int n = 0; n < 2; ++n) acc[a][b][m][n] = (f32x4){0.f, 0.f, 0.f, 0.f};
        cur = nxt; cA = nA; cB = nB; ++ui;
        if constexpr (ALIGN_EPI) { if (wr == 1) PG8_BAR; }
    }
    PG8_WAIT_V(0);
    if constexpr (!ALIGN_EPI) { if (wr == 0) PG8_BAR; }
    PG8_BAR;
    if constexpr (Epi::AFTER_DRAIN) { E.fused(acc, cur, wr, wc, fr, fq, lds, wid, lane); S.done(cur); }
#undef PG8_SA
#undef PG8_SB
#undef PG8_STAGE
#undef PG8_LDA
#undef PG8_LDB
#undef PG8_MMA
#undef PG8_WAIT_V
#undef PG8_WAIT_L
#undef PG8_BAR
#undef PG8_SCHED
}
}

#define GAS __attribute__((address_space(1)))
#define LAS __attribute__((address_space(3)))
typedef unsigned short bf16_t;
typedef short bf16x8 __attribute__((ext_vector_type(8)));
typedef float f32x4 __attribute__((ext_vector_type(4)));
typedef unsigned u32x4 __attribute__((ext_vector_type(4)));
typedef unsigned u32x2 __attribute__((ext_vector_type(2)));

constexpr int DM = 1024, NBATCH = 2, SEQ = 8192, MEML = 256, MTOK = NBATCH * SEQ;
constexpr int INW = 12320, LD = 12544;
constexpr int C_Z = 0, C_X = 2048, C_B = 4096, C_C = 4608, C_LG = 5120, C_LX = 6656, C_Q = 8192, C_G = 9216, C_DT = 12288;
constexpr int C_MRG = 2048;
constexpr int NHEAD = 32, HDIM = 64, NGRP = 4, NSTATE = 128, CHUNK = 128, NCHUNK = SEQ / CHUNK;
constexpr int LRUW = 1536, LRUB = 96, NLB = 16, LSEG = 512, NSEG = SEQ / LSEG, NBLK64 = SEQ / 64;
constexpr float EPS = 1e-6f;
constexpr size_t MiB = 1u << 20;
constexpr size_t WS_WIN = 0, WS_WKV = 25 * MiB, WS_WSSD = 29 * MiB, WS_WLRU = 33 * MiB, WS_WMEM = 36 * MiB, WS_WOUT = 38 * MiB;
constexpr size_t WS_PROJ = 40 * MiB;
constexpr size_t WS_MEMN = 236 * MiB, WS_KVK = 237 * MiB, WS_KVVT = 238 * MiB, WS_LRUWA = 239 * MiB, WS_LRUWX = 239 * MiB + 512 * 1024;
constexpr size_t WS_DASUM = 240 * MiB;
constexpr size_t WS_LAGG = 246 * MiB;
constexpr size_t WS_LCAR = 250 * MiB;
constexpr size_t WS_CTL = 244 * MiB;
constexpr size_t WS_XBUF = 245 * MiB;
constexpr size_t WS_END = 256 * MiB;
static_assert(WS_PROJ + (size_t)SEQ * LD * 2 <= WS_MEMN, "ws map");
constexpr int LDS_BYTES = 155648;

struct Params {
    const float *x, *mem, *norm_g, *w_in, *ssd_conv_w, *ssd_conv_b, *ssd_dt_bias, *ssd_a_log, *ssd_d, *ssd_norm_g,
        *lru_conv_w, *lru_conv_b, *lru_w_a, *lru_b_a, *lru_w_x, *lru_b_x, *lru_lambda, *mem_norm_g, *w_kv,
        *w_br_ssd, *w_br_lru, *w_br_mem, *w_out, *final_g;
    float* out; unsigned char* ws;
    int lo, hi;
};

__device__ __forceinline__ float bf2f(bf16_t v) { return __uint_as_float((unsigned)v << 16); }
__device__ __forceinline__ unsigned f2bf(float f) { unsigned u = __float_as_uint(f); return (u + 0x7fffu + ((u >> 16) & 1u)) >> 16; }
__device__ __forceinline__ unsigned pk2(float lo, float hi) { return f2bf(lo) | (f2bf(hi) << 16); }
__device__ __forceinline__ float sigmoidf_(float v) { return __builtin_amdgcn_rcpf(1.f + __expf(-v)); }
__device__ __forceinline__ float siluf_(float v) { return v * __builtin_amdgcn_rcpf(1.f + __expf(-v)); }
__device__ __forceinline__ float softplusf_(float v) { const float e = __expf(v); const float sm = e * (1.f - e * (0.5f - e * 0.33333334f)); return v > 20.f ? v : (e < 1e-3f ? sm : __logf(1.f + e)); }
__device__ __forceinline__ float wave_sum(float v) {
#pragma unroll
    for (int o = 1; o < 64; o <<= 1) v += __shfl_xor(v, o);
    return v;
}
template <class T> __device__ __forceinline__ T* opq(T* q) { asm volatile("" : "+s"(q)); return q; }
__device__ __forceinline__ int opq_tid() { int t = threadIdx.x; asm volatile("" : "+v"(t)); return t; }
__device__ __forceinline__ int opq_bid() { int t = blockIdx.x; asm volatile("" : "+s"(t)); return t; }
__device__ __forceinline__ unsigned char* wsb(const Params& p) { return opq(p.ws); }
__device__ __forceinline__ bf16_t* proj_ptr(const Params& p) { return (bf16_t*)(wsb(p) + WS_PROJ); }
__device__ __forceinline__ bf16_t* xn_ptr(const Params& p) { return (bf16_t*)((unsigned char*)opq(p.out) + 32 * MiB); }
__device__ __forceinline__ bf16_t* states_ptr(const Params& p, int b) { return (bf16_t*)((unsigned char*)opq(p.out) + (size_t)b * 32 * MiB); }
__device__ __forceinline__ float* scr_ptr(const Params& p, int b) { return (float*)((unsigned char*)opq(p.out) + (size_t)b * 32 * MiB); }

#ifdef PROBE_MA
#define MSTAMP(p, i) do { if (blockIdx.x == 0 && threadIdx.x == 0) ((unsigned long long*)(wsb(p) + 255 * MiB))[i] = __builtin_amdgcn_s_memrealtime(); } while (0)
#else
#define MSTAMP(p, i) do { } while (0)
#endif
__device__ __forceinline__ void transpose_item(const float* W, int K, int Ns, int srccol0, bf16_t* WT, int dstrow0, LAS float* scr, int k0, int lane) {
    float wv[32];
#pragma unroll
    for (int i = 0; i < 32; ++i) wv[i] = W[(size_t)(k0 + 2 * i + (lane >> 5)) * Ns + srccol0 + (lane & 31)];
#pragma unroll
    for (int i = 0; i < 32; ++i) scr[(2 * i + (lane >> 5)) * 33 + (lane & 31)] = wv[i];
    asm volatile("s_waitcnt lgkmcnt(0)" ::: "memory");
    const int c = lane & 7;
#pragma unroll
    for (int j = 0; j < 4; ++j) { const int n = (lane >> 3) + 8 * j; const LAS float* s = scr + (8 * c) * 33 + n;
        u32x4 o; o.x = pk2(s[0 * 33], s[1 * 33]); o.y = pk2(s[2 * 33], s[3 * 33]); o.z = pk2(s[4 * 33], s[5 * 33]); o.w = pk2(s[6 * 33], s[7 * 33]);
        *(u32x4*)(WT + (size_t)(dstrow0 + n) * K + k0 + 8 * c) = o; }
    asm volatile("s_waitcnt lgkmcnt(0)" ::: "memory");
}
__device__ __forceinline__ void rms_row_to_bf16(const float* xrow, const float* g, bf16_t* orow, int lane) {
    const f32x4* xr = (const f32x4*)xrow + lane; const f32x4* gr = (const f32x4*)g + lane;
    f32x4 v[4]; float s = 0.f;
#pragma unroll
    for (int j = 0; j < 4; ++j) { v[j] = xr[64 * j]; s += (v[j].x * v[j].x + v[j].y * v[j].y) + (v[j].z * v[j].z + v[j].w * v[j].w); }
    const float rs = 1.f / sqrtf(wave_sum(s) * (1.f / DM) + EPS);
    unsigned long long* o8 = (unsigned long long*)orow + lane;
#pragma unroll
    for (int j = 0; j < 4; ++j) { const f32x4 gg = gr[64 * j];
        o8[64 * j] = (unsigned long long)pk2(v[j].x * rs * gg.x, v[j].y * rs * gg.y) | ((unsigned long long)pk2(v[j].z * rs * gg.z, v[j].w * rs * gg.w) << 32); }
}
__device__ __forceinline__ void xn_rows(const Params& p, int row_lo, int row_hi, int gw, int NGW, int lane) {
    bf16_t* XN = xn_ptr(p);
    { const float* xb = opq(p.x); const f32x4* gr = (const f32x4*)opq(p.norm_g) + lane;
      for (int m0 = row_lo + gw * 4; m0 < row_hi; m0 += NGW * 4) {
          f32x4 v[4][4];
#pragma unroll
          for (int r = 0; r < 4; ++r)
#pragma unroll
              for (int j = 0; j < 4; ++j) v[r][j] = ((const f32x4*)(xb + (size_t)(m0 + r) * DM) + lane)[64 * j];
#pragma unroll
          for (int r = 0; r < 4; ++r) { float s = 0.f;
#pragma unroll
              for (int j = 0; j < 4; ++j) s += (v[r][j].x * v[r][j].x + v[r][j].y * v[r][j].y) + (v[r][j].z * v[r][j].z + v[r][j].w * v[r][j].w);
              const float rs = 1.f / sqrtf(wave_sum(s) * (1.f / DM) + EPS);
              unsigned long long* o8 = (unsigned long long*)(XN + (size_t)(m0 + r) * DM) + lane;
#pragma unroll
              for (int j = 0; j < 4; ++j) { const f32x4 gg = gr[64 * j];
                  o8[64 * j] = (unsigned long long)pk2(v[r][j].x * rs * gg.x, v[r][j].y * rs * gg.y) | ((unsigned long long)pk2(v[r][j].z * rs * gg.z, v[r][j].w * rs * gg.w) << 32); } } } }
}
__device__ __forceinline__ void transpose_items(const Params& p, LAS unsigned char* lds, int it_lo, int it_hi) {
    const int tid = opq_tid(), lane = tid & 63, wave = tid >> 6, bid = opq_bid();
    const int gw = bid * 8 + wave, NGW = gridDim.x * 8;
    LAS float* scr = (LAS float*)(lds + wave * 8704);
    bf16_t* Win = (bf16_t*)(wsb(p) + WS_WIN); bf16_t* Wkv = (bf16_t*)(wsb(p) + WS_WKV); bf16_t* Wssd = (bf16_t*)(wsb(p) + WS_WSSD);
    bf16_t* Wlru = (bf16_t*)(wsb(p) + WS_WLRU); bf16_t* Wmem = (bf16_t*)(wsb(p) + WS_WMEM); bf16_t* Wout = (bf16_t*)(wsb(p) + WS_WOUT);
    constexpr int I_IN = 16 * 385, I_KV = 16 * 64, I_SSD = 32 * 32, I_LRU = 24 * 32, I_MEM = 16 * 32, I_OUT = 16 * 32;
    constexpr int NITEMS = I_IN + I_KV + I_SSD + I_LRU + I_MEM + I_OUT;
    (void)NITEMS;
    for (int it = it_lo + gw; it < it_hi; it += NGW) {
        int r = it;
        if (r < I_IN) { const int nb = r % 385, kb = r / 385; const int sc = 32 * nb; int dr;
            if (sc < 5120) dr = sc; else if (sc < 5152) dr = sc - 5120 + C_DT; else dr = sc - 32;
            transpose_item(opq(p.w_in), 1024, INW, sc, Win, dr, scr, 64 * kb, lane); continue; } r -= I_IN;
        if (r < I_KV) { transpose_item(opq(p.w_kv), 1024, 2048, 32 * (r % 64), Wkv, 32 * (r % 64), scr, 64 * (r / 64), lane); continue; } r -= I_KV;
        if (r < I_SSD) { transpose_item(opq(p.w_br_ssd), 2048, 1024, 32 * (r % 32), Wssd, 32 * (r % 32), scr, 64 * (r / 32), lane); continue; } r -= I_SSD;
        if (r < I_LRU) { transpose_item(opq(p.w_br_lru), 1536, 1024, 32 * (r % 32), Wlru, 32 * (r % 32), scr, 64 * (r / 32), lane); continue; } r -= I_LRU;
        if (r < I_MEM) { transpose_item(opq(p.w_br_mem), 1024, 1024, 32 * (r % 32), Wmem, 32 * (r % 32), scr, 64 * (r / 32), lane); continue; } r -= I_MEM;
        transpose_item(opq(p.w_out), 1024, 1024, 32 * (r % 32), Wout, 32 * (r % 32), scr, 64 * (r / 32), lane);
    }
}
constexpr int TI_EARLY = 16 * 385 + 16 * 64, TI_ALL = TI_EARLY + 32 * 32 + 24 * 32 + 16 * 32 + 16 * 32;
__device__ __forceinline__ void phase0(const Params& p, LAS unsigned char* lds) {
    const int tid = opq_tid(), lane = tid & 63, wave = tid >> 6, bid = opq_bid();
    const int gw = bid * 8 + wave, NGW = gridDim.x * 8;
    bf16_t* Win = (bf16_t*)(wsb(p) + WS_WIN);
    transpose_items(p, lds, 0, gridDim.x == 256 ? TI_EARLY : TI_ALL);
    { const int gt = bid * 512 + tid, NT = gridDim.x * 512; u32x4* z = (u32x4*)(Win + (size_t)INW * 1024);
      for (int i = gt; i < (LD - INW) * 1024 / 8; i += NT) z[i] = (u32x4){0u, 0u, 0u, 0u}; }
    { const int gt = bid * 512 + tid, NT = gridDim.x * 512; bf16_t* wa = (bf16_t*)(wsb(p) + WS_LRUWA); bf16_t* wx = (bf16_t*)(wsb(p) + WS_LRUWX);
      for (int e = gt; e < NLB * LRUB * LRUB; e += NT) { const int n = e / (LRUB * LRUB), r2 = e % (LRUB * LRUB), j = r2 / LRUB, i = r2 % LRUB;
          wa[e] = (bf16_t)f2bf(opq(p.lru_w_a)[(n * LRUB + i) * LRUB + j]); wx[e] = (bf16_t)f2bf(opq(p.lru_w_x)[(n * LRUB + i) * LRUB + j]); } }
    bf16_t* XN = xn_ptr(p); bf16_t* MN = (bf16_t*)(wsb(p) + WS_MEMN);
    if (gridDim.x == 256) xn_rows(p, 0, SEQ, gw, NGW, lane); else xn_rows(p, 0, MTOK, gw, NGW, lane);
    for (int m = gw; m < NBATCH * MEML; m += NGW) rms_row_to_bf16(opq(p.mem) + (size_t)m * DM, opq(p.mem_norm_g), MN + (size_t)m * DM, lane);
}
__device__ __forceinline__ void phase7(const Params& p) {
    const int tid = opq_tid(), lane = tid & 63, wave = tid >> 6; const int gw = opq_bid() * 8 + wave, NGW = gridDim.x * 8; float* outb = opq(p.out); const float* fg = opq(p.final_g);
    for (int m = gw; m < MTOK; m += NGW) {
        f32x4* xr = (f32x4*)(outb + (size_t)m * DM) + lane; const f32x4* gr = (const f32x4*)fg + lane;
        f32x4 v[4]; float s = 0.f;
#pragma unroll
        for (int j = 0; j < 4; ++j) { v[j] = xr[64 * j]; s += (v[j].x * v[j].x + v[j].y * v[j].y) + (v[j].z * v[j].z + v[j].w * v[j].w); }
        const float rs = 1.f / sqrtf(wave_sum(s) * (1.f / DM) + EPS);
#pragma unroll
        for (int j = 0; j < 4; ++j) { const f32x4 gg = gr[64 * j]; xr[64 * j] = v[j] * rs * gg; }
    }
}

namespace pg8 {
template <int BR> struct EpiMerge {
    static constexpr bool PERM = true, AFTER_DRAIN = false;
    bf16_t* P; float* scr;
    __device__ __forceinline__ void operator()(const f32x4 (&acc)[2][2][4][2], const Unit& u, int wr, int wc, int fr, int fq) const {
        const int row0 = u.pm * BM + wr * 64 + fr, col0 = u.pn * BM + wc * 32 + 8 * fq;
#pragma unroll
        for (int ai = 0; ai < 2; ++ai)
#pragma unroll
            for (int m = 0; m < 4; ++m) { const size_t r = (size_t)(row0 + ai * HALF + m * 16);
#pragma unroll
                for (int bj = 0; bj < 2; ++bj) { const int c = col0 + bj * HALF;
                    const u32x4 gw = *(const u32x4*)(P + r * 12544 + 9216 + BR * 1024 + c);
                    float g[8];
#pragma unroll
                    for (int i = 0; i < 4; ++i) { g[2 * i] = __uint_as_float(gw[i] << 16); g[2 * i + 1] = __uint_as_float(gw[i] & 0xffff0000u); }
                    f32x4 v0 = acc[ai][bj][m][0], v1 = acc[ai][bj][m][1];
#pragma unroll
                    for (int i = 0; i < 4; ++i) { v0[i] *= 1.f / (1.f + __expf(-g[i])); v1[i] *= 1.f / (1.f + __expf(-g[4 + i])); }
                    float* sp = scr + r * 1024 + c;
                    if (BR > 0) { v0 += *(const f32x4*)sp; v1 += *(const f32x4*)(sp + 4); }
                    if (BR < 2) { *(f32x4*)sp = v0; *(f32x4*)(sp + 4) = v1; }
                    else { u32x4 w; w.x = cvt_pk_bf16(v0[0], v0[1]); w.y = cvt_pk_bf16(v0[2], v0[3]); w.z = cvt_pk_bf16(v1[0], v1[1]); w.w = cvt_pk_bf16(v1[2], v1[3]);
                        *(u32x4*)(P + r * 12544 + 2048 + c) = w; } } }
    }
};
template <int BR, bool FINAL> struct EpiMerge2 {
    static constexpr bool PERM = true, AFTER_DRAIN = false;
    bf16_t* P; bf16_t* s0; int ld0; const bf16_t* s1; int ld1; bf16_t* mrg; int ldm;
    __device__ __forceinline__ void operator()(const f32x4 (&acc)[2][2][4][2], const Unit& u, int wr, int wc, int fr, int fq) const {
        const int row0 = u.pm * BM + wr * 64 + fr, col0 = u.pn * BM + wc * 32 + 8 * fq;
#pragma unroll
        for (int ai = 0; ai < 2; ++ai) {
            unsigned gb = (unsigned)((row0 + ai * HALF) * 12544 + 9216 + BR * 1024 + col0); asm volatile("" : "+v"(gb));
            unsigned b0 = (unsigned)((row0 + ai * HALF) * ld0 + col0); asm volatile("" : "+v"(b0));
            u32x4 gw[4][2];
#pragma unroll
            for (int m = 0; m < 4; ++m)
#pragma unroll
                for (int bj = 0; bj < 2; ++bj) gw[m][bj] = *(const u32x4*)(P + (gb + (unsigned)(m * 16 * 12544 + bj * HALF)));
            f32x4 v[4][2][2];
#pragma unroll
            for (int m = 0; m < 4; ++m)
#pragma unroll
                for (int bj = 0; bj < 2; ++bj) { const u32x4 g4 = gw[m][bj]; f32x4 v0 = acc[ai][bj][m][0], v1 = acc[ai][bj][m][1];
#pragma unroll
                    for (int i = 0; i < 2; ++i) { v0[2 * i] *= __builtin_amdgcn_rcpf(1.f + __expf(-__uint_as_float(g4[i] << 16))); v0[2 * i + 1] *= __builtin_amdgcn_rcpf(1.f + __expf(-__uint_as_float(g4[i] & 0xffff0000u)));
                        v1[2 * i] *= __builtin_amdgcn_rcpf(1.f + __expf(-__uint_as_float(g4[2 + i] << 16))); v1[2 * i + 1] *= __builtin_amdgcn_rcpf(1.f + __expf(-__uint_as_float(g4[2 + i] & 0xffff0000u))); }
                    v[m][bj][0] = v0; v[m][bj][1] = v1; }
            if (!FINAL) {
#pragma unroll
                for (int m = 0; m < 4; ++m)
#pragma unroll
                    for (int bj = 0; bj < 2; ++bj) { const f32x4 v0 = v[m][bj][0], v1 = v[m][bj][1]; u32x4 w; w.x = cvt_pk_bf16(v0[0], v0[1]); w.y = cvt_pk_bf16(v0[2], v0[3]); w.z = cvt_pk_bf16(v1[0], v1[1]); w.w = cvt_pk_bf16(v1[2], v1[3]);
                        *(u32x4*)(s0 + (b0 + (unsigned)(m * 16) * (unsigned)ld0 + (unsigned)(bj * HALF))) = w; }
            } else {
                asm volatile("" ::: "memory");
                unsigned b1 = (unsigned)((row0 + ai * HALF) * ld1 + col0); asm volatile("" : "+v"(b1));
                unsigned bm = (unsigned)((row0 + ai * HALF) * ldm + col0); asm volatile("" : "+v"(bm));
#pragma unroll
                for (int mp = 0; mp < 2; ++mp) { u32x4 a0[2][2], a1[2][2];
#pragma unroll
                    for (int mm = 0; mm < 2; ++mm)
#pragma unroll
                        for (int bj = 0; bj < 2; ++bj) { const unsigned rr = (unsigned)((2 * mp + mm) * 16);
                            a0[mm][bj] = *(const u32x4*)(s0 + (b0 + rr * (unsigned)ld0 + (unsigned)(bj * HALF))); a1[mm][bj] = *(const u32x4*)(s1 + (b1 + rr * (unsigned)ld1 + (unsigned)(bj * HALF))); }
#pragma unroll
                    for (int mm = 0; mm < 2; ++mm)
#pragma unroll
                        for (int bj = 0; bj < 2; ++bj) { const int m = 2 * mp + mm; const unsigned rr = (unsigned)(m * 16);
                            f32x4 v0 = v[m][bj][0], v1 = v[m][bj][1];
#pragma unroll
                            for (int i = 0; i < 2; ++i) { v0[2 * i] += __uint_as_float(a0[mm][bj][i] << 16) + __uint_as_float(a1[mm][bj][i] << 16); v0[2 * i + 1] += __uint_as_float(a0[mm][bj][i] & 0xffff0000u) + __uint_as_float(a1[mm][bj][i] & 0xffff0000u);
                                v1[2 * i] += __uint_as_float(a0[mm][bj][2 + i] << 16) + __uint_as_float(a1[mm][bj][2 + i] << 16); v1[2 * i + 1] += __uint_as_float(a0[mm][bj][2 + i] & 0xffff0000u) + __uint_as_float(a1[mm][bj][2 + i] & 0xffff0000u); }
                            u32x4 w; w.x = cvt_pk_bf16(v0[0], v0[1]); w.y = cvt_pk_bf16(v0[2], v0[3]); w.z = cvt_pk_bf16(v1[0], v1[1]); w.w = cvt_pk_bf16(v1[2], v1[3]);
                            *(u32x4*)(mrg + (bm + rr * (unsigned)ldm + (unsigned)(bj * HALF))) = w; }
                    asm volatile("" ::: "memory"); }
            }
            asm volatile("" ::: "memory");
        }
    }
};
struct EpiOutNorm {
    static constexpr bool PERM = false, AFTER_DRAIN = true;
    const float* xres; float* out; const float* fg; float* xbuf; unsigned* cnt;
    __device__ __forceinline__ void fused(f32x4 (&acc)[2][2][4][2], const Unit& u, int wr, int wc, int fr, int fq, PG8_LAS unsigned char* lds, int wid, int lane) const {
        PG8_LAS float* Pp = (PG8_LAS float*)lds; PG8_LAS float* Sr = (PG8_LAS float*)(lds + 4096);
        const int row0 = u.pm * BM + wr * 64 + fr, col0 = u.pn * BM + wc * 32 + 4 * fq;
#pragma unroll
        for (int ai = 0; ai < 2; ++ai)
#pragma unroll
            for (int m = 0; m < 4; ++m) { const size_t off = (size_t)(row0 + ai * HALF + m * 16) * 1024 + col0; float s = 0.f;
#pragma unroll
                for (int bj = 0; bj < 2; ++bj)
#pragma unroll
                    for (int n = 0; n < 2; ++n) { const f32x4 v = acc[ai][bj][m][n] + *(const f32x4*)(xres + off + bj * HALF + n * 16); acc[ai][bj][m][n] = v; s += (v[0] * v[0] + v[1] * v[1]) + (v[2] * v[2] + v[3] * v[3]); }
                s += __shfl_xor(s, 16); s += __shfl_xor(s, 32);
                if (fq == 0) Pp[(ai * HALF + wr * 64 + m * 16 + fr) * 4 + wc] = s;
                if (m == 3) asm volatile("" ::: "memory"); }
        asm volatile("s_waitcnt lgkmcnt(0)" ::: "memory"); __builtin_amdgcn_s_barrier(); asm volatile("" ::: "memory");
        const int tid = wid * 64 + lane;
        if (tid < 256) { const float s = (Pp[tid * 4 + 0] + Pp[tid * 4 + 1]) + (Pp[tid * 4 + 2] + Pp[tid * 4 + 3]);
            __hip_atomic_store(xbuf + (size_t)(u.pm * BM + tid) * 4 + u.pn, s, __ATOMIC_RELAXED, __HIP_MEMORY_SCOPE_AGENT); }
        asm volatile("s_waitcnt vmcnt(0)" ::: "memory");
        if (wid < 4 && lane == 0) __hip_atomic_fetch_add(cnt + 64 * u.pm, 1u, __ATOMIC_RELAXED, __HIP_MEMORY_SCOPE_AGENT);
        if (wid == 0) { unsigned spins = 0;
            while ((unsigned)__builtin_amdgcn_readfirstlane(__hip_atomic_load(cnt + 64 * u.pm, __ATOMIC_RELAXED, __HIP_MEMORY_SCOPE_AGENT)) < 16u && ++spins < (1u << 22)) __builtin_amdgcn_s_sleep(2);
            __builtin_amdgcn_fence(__ATOMIC_ACQUIRE, "agent"); }
        asm volatile("s_waitcnt vmcnt(0) lgkmcnt(0)" ::: "memory"); __builtin_amdgcn_s_barrier(); asm volatile("" ::: "memory");
        if (tid < 256) { const float* slot = xbuf + (size_t)(u.pm * BM + tid) * 4; float s = 0.f;
#pragma unroll
            for (int q = 0; q < 4; ++q) s += __hip_atomic_load(slot + q, __ATOMIC_RELAXED, __HIP_MEMORY_SCOPE_AGENT);
            Sr[tid] = 1.0f / sqrtf(s * (1.f / 1024.f) + 1e-6f); }
        asm volatile("s_waitcnt lgkmcnt(0)" ::: "memory"); __builtin_amdgcn_s_barrier(); asm volatile("" ::: "memory");
#pragma unroll
        for (int ai = 0; ai < 2; ++ai)
#pragma unroll
            for (int m = 0; m < 4; ++m) { const int r = ai * HALF + wr * 64 + m * 16 + fr; const float rs = Sr[r]; const size_t off = (size_t)(u.pm * BM + r) * 1024 + col0;
#pragma unroll
                for (int bj = 0; bj < 2; ++bj)
#pragma unroll
                    for (int n = 0; n < 2; ++n) { const f32x4 gg = *(const f32x4*)(fg + col0 + bj * HALF + n * 16); *(f32x4*)(out + off + bj * HALF + n * 16) = acc[ai][bj][m][n] * rs * gg; } }
    }
};
struct SkewOrder {
    StaticOrder base; int c;
    __device__ void init(int M, int N, int c_) { base.init(M, N, 256, 0); c = c_; }
    __device__ bool next(int i, Unit& u) const {
        int ii, cc = c;
        if (c < 128) { if (i >= 5) return false; ii = i + 1; }
        else { if (i > 6) return false; if (i == 0) ii = 0; else if (i == 1) { ii = 0; cc = c - 128; } else ii = i - 1; }
        StaticOrder b2 = base; b2.c = cc; return b2.next(ii, u);
    }
    __device__ __forceinline__ void a_ready(const Unit&) const {}
    __device__ __forceinline__ void done(const Unit&) const {}
};
}
#define PG8_SP2 true
#define PG8_ALIGN true

__device__ __forceinline__ bf16_t* merged_ptr(const Params& p, int b) { return b == 0 ? xn_ptr(p) : proj_ptr(p) + 4096; }
__device__ __forceinline__ int merged_ld(int b) { return b == 0 ? DM : LD; }
__device__ __forceinline__ void phase1_gemm(const Params& p, int b, LAS unsigned char* lds) {
    const int G = gridDim.x, c = opq_bid();
    { pg8::Gemm g{xn_ptr(p) + (size_t)b * SEQ * DM, (const bf16_t*)(wsb(p) + WS_WIN), SEQ, 12288, DM, DM, DM}; pg8::StaticOrder S; S.init(SEQ, 12288, G, c);
      pg8::EpiBf16<0> E{proj_ptr(p), LD, nullptr, 0, 0, 1.f};
      if (b == 1 && G == 256) { pg8::SkewOrder S2; S2.init(SEQ, 12288, c);
          pg8::gemm_phase<pg8::EpiBf16<0>, pg8::SkewOrder, PG8_ALIGN, PG8_SP2>(lds, g, S2, E); }
      else pg8::gemm_phase<pg8::EpiBf16<0>, pg8::StaticOrder, PG8_ALIGN, PG8_SP2>(lds, g, S, E); }
    { const int tid = opq_tid(), lane = tid & 63, wave = tid >> 6, fr = lane & 15, kg = lane >> 4;
      const bf16_t* XNb = xn_ptr(p) + (size_t)b * SEQ * DM; const bf16_t* Wd = (const bf16_t*)(wsb(p) + WS_WIN) + (size_t)C_DT * DM; bf16_t* Pq = proj_ptr(p);
      LAS float* sRed = (LAS float*)lds;
      for (int rb = c; rb < SEQ / 32; rb += G) {
          __syncthreads();
          f32x4 acc[2][2];
#pragma unroll
          for (int mt = 0; mt < 2; ++mt)
#pragma unroll
              for (int nt = 0; nt < 2; ++nt) acc[mt][nt] = (f32x4){0.f, 0.f, 0.f, 0.f};
          bf16x8 af[2][4], bfr[2][4];
#pragma unroll
          for (int ks = 0; ks < 4; ++ks)
#pragma unroll
              for (int q = 0; q < 2; ++q) { af[q][ks] = *(const bf16x8*)(XNb + (size_t)(32 * rb + 16 * q + fr) * DM + 128 * wave + 32 * ks + 8 * kg);
                  bfr[q][ks] = *(const bf16x8*)(Wd + (size_t)(16 * q + fr) * DM + 128 * wave + 32 * ks + 8 * kg); }
#pragma unroll
          for (int ks = 0; ks < 4; ++ks)
#pragma unroll
              for (int mt = 0; mt < 2; ++mt)
#pragma unroll
                  for (int nt = 0; nt < 2; ++nt) acc[mt][nt] = __builtin_amdgcn_mfma_f32_16x16x32_bf16(af[mt][ks], bfr[nt][ks], acc[mt][nt], 0, 0, 0);
#pragma unroll
          for (int mt = 0; mt < 2; ++mt)
#pragma unroll
              for (int nt = 0; nt < 2; ++nt)
#pragma unroll
                  for (int j = 0; j < 4; ++j) sRed[(wave * 32 + 16 * mt + 4 * kg + j) * 32 + 16 * nt + fr] = acc[mt][nt][j];
          __syncthreads();
#pragma unroll
          for (int q = 0; q < 2; ++q) { const int e = tid + 512 * q, row = e >> 5, col = e & 31; float s = 0.f;
#pragma unroll
              for (int w2 = 0; w2 < 8; ++w2) s += sRed[(w2 * 32 + row) * 32 + col];
              Pq[(size_t)(32 * rb + row) * LD + C_DT + col] = (bf16_t)f2bf(s); }
      } }
    if (b == 0 && G != 256) {
        { pg8::Gemm g{(const bf16_t*)(wsb(p) + WS_MEMN), (const bf16_t*)(wsb(p) + WS_WKV), 512, 1024, DM, DM, DM}; pg8::StaticOrder S; S.init(512, 1024, G, (c + 16) % G);
          pg8::EpiBf16<0> E{(bf16_t*)(wsb(p) + WS_KVK), 1024, nullptr, 0, 0, 1.f};
          pg8::gemm_phase<pg8::EpiBf16<0>, pg8::StaticOrder, PG8_ALIGN, PG8_SP2>(lds, g, S, E); }
        { pg8::Gemm g{(const bf16_t*)(wsb(p) + WS_WKV) + (size_t)1024 * DM, (const bf16_t*)(wsb(p) + WS_MEMN), 1024, 512, DM, DM, DM}; pg8::StaticOrder S; S.init(1024, 512, G, (c + 8) % G);
          pg8::EpiBf16<0> E{(bf16_t*)(wsb(p) + WS_KVVT), 512, nullptr, 0, 0, 1.f};
          pg8::gemm_phase<pg8::EpiBf16<0>, pg8::StaticOrder, PG8_ALIGN, PG8_SP2>(lds, g, S, E); }
    }
    if (b == 0 && G == 256) {
        const int tid = opq_tid(), lane = tid & 63, wave = tid >> 6, fr = lane & 15, kg = lane >> 4;
        const bf16_t* MN = (const bf16_t*)(wsb(p) + WS_MEMN); const bf16_t* WK = (const bf16_t*)(wsb(p) + WS_WKV);
        const bool jobK = c < 128; const int cb = jobK ? c : c - 128;
        const bf16_t* Ap = jobK ? MN + (size_t)(64 * (cb >> 4)) * DM : WK + (size_t)(1024 + 64 * (cb >> 3)) * DM;
        const bf16_t* Bp = jobK ? WK + (size_t)(64 * (cb & 15)) * DM : MN + (size_t)(64 * (cb & 7)) * DM;
        bf16_t* Cp = jobK ? (bf16_t*)(wsb(p) + WS_KVK) + (size_t)(64 * (cb >> 4)) * 1024 + 64 * (cb & 15) : (bf16_t*)(wsb(p) + WS_KVVT) + (size_t)(64 * (cb >> 3)) * 512 + 64 * (cb & 7);
        const int ldc = jobK ? 1024 : 512;
        LAS float* sRed = (LAS float*)lds;
        __syncthreads();
        f32x4 acc[4][4];
#pragma unroll
        for (int mt = 0; mt < 4; ++mt)
#pragma unroll
            for (int nt = 0; nt < 4; ++nt) acc[mt][nt] = (f32x4){0.f, 0.f, 0.f, 0.f};
#pragma unroll
        for (int ks = 0; ks < 4; ++ks) { bf16x8 af[4], bfr[4];
#pragma unroll
            for (int q = 0; q < 4; ++q) { af[q] = *(const bf16x8*)(Ap + (size_t)(16 * q + fr) * DM + 128 * wave + 32 * ks + 8 * kg); bfr[q] = *(const bf16x8*)(Bp + (size_t)(16 * q + fr) * DM + 128 * wave + 32 * ks + 8 * kg); }
#pragma unroll
            for (int mt = 0; mt < 4; ++mt)
#pragma unroll
                for (int nt = 0; nt < 4; ++nt) acc[mt][nt] = __builtin_amdgcn_mfma_f32_16x16x32_bf16(af[mt], bfr[nt], acc[mt][nt], 0, 0, 0); }
#pragma unroll
        for (int mt = 0; mt < 4; ++mt)
#pragma unroll
            for (int nt = 0; nt < 4; ++nt)
#pragma unroll
                for (int j = 0; j < 4; ++j) sRed[(wave * 64 + 16 * mt + 4 * kg + j) * 64 + 16 * nt + fr] = acc[mt][nt][j];
        __syncthreads();
#pragma unroll
        for (int q = 0; q < 8; ++q) { const int e2 = tid + 512 * q, row = e2 >> 6, col = e2 & 63; float s = 0.f;
#pragma unroll
            for (int w2 = 0; w2 < 8; ++w2) s += sRed[(w2 * 64 + row) * 64 + col];
            Cp[(size_t)row * ldc + col] = (bf16_t)f2bf(s); }
    }
}
__device__ __forceinline__ void phase5_gemm(const Params& p, int b, LAS unsigned char* lds) {
    const int G = gridDim.x, c = opq_bid(); bf16_t* P = proj_ptr(p); float* scr = scr_ptr(p, b);
    bf16_t* scrB = P + 2048;
    bf16_t* scrA = (bf16_t*)scr;
    unsigned* flag = (unsigned*)(wsb(p) + WS_CTL) + 4096 + (b * 128 + (c & 127)) * 16;
    if (c < 128) {
        pg8::Gemm g{P + C_Z, (const bf16_t*)(wsb(p) + WS_WSSD), SEQ, DM, 2048, LD, 2048}; pg8::StaticOrder S; S.init(SEQ, DM, 128, c); pg8::EpiMerge2<0, false> E{P, scrA, 1024, nullptr, 0, nullptr, 0};
        pg8::gemm_phase<pg8::EpiMerge2<0, false>, pg8::StaticOrder, false, PG8_SP2>(lds, g, S, E);
#ifdef PROBE_NOFENCE
        asm volatile("s_waitcnt vmcnt(0)" ::: "memory"); __syncthreads();
        if (threadIdx.x == 0) __hip_atomic_store(flag, 1u, __ATOMIC_RELAXED, __HIP_MEMORY_SCOPE_AGENT);
#else
        asm volatile("s_waitcnt vmcnt(0)" ::: "memory"); __syncthreads();
        if (threadIdx.x == 0) { __builtin_amdgcn_fence(__ATOMIC_RELEASE, "agent"); asm volatile("s_waitcnt vmcnt(0)" ::: "memory");
            __hip_atomic_store(flag, 1u, __ATOMIC_RELAXED, __HIP_MEMORY_SCOPE_AGENT); }
#endif
        if (b == 0 && G == 256) { const int tid2 = opq_tid(); xn_rows(p, SEQ, MTOK, c * 8 + (tid2 >> 6), 128 * 8, tid2 & 63); }
    } else {
        { pg8::Gemm g{P + C_LG, (const bf16_t*)(wsb(p) + WS_WLRU), SEQ, DM, 1536, LD, 1536}; pg8::StaticOrder S; S.init(SEQ, DM, 128, c - 128); pg8::EpiMerge2<1, false> E{P, scrB, LD, nullptr, 0, nullptr, 0};
          pg8::gemm_phase<pg8::EpiMerge2<1, false>, pg8::StaticOrder, false, PG8_SP2>(lds, g, S, E); }
        if (threadIdx.x == 0) { unsigned spins = 0; while (__hip_atomic_load(flag, __ATOMIC_RELAXED, __HIP_MEMORY_SCOPE_AGENT) == 0u && ++spins < (1u << 22)) __builtin_amdgcn_s_sleep(2);
#ifndef PROBE_NOFENCE
            __builtin_amdgcn_fence(__ATOMIC_ACQUIRE, "agent"); asm volatile("s_waitcnt vmcnt(0)" ::: "memory");
#endif
        }
        __syncthreads();
        { pg8::Gemm g{P + C_Q, (const bf16_t*)(wsb(p) + WS_WMEM), SEQ, DM, 1024, LD, 1024}; pg8::StaticOrder S; S.init(SEQ, DM, 128, c - 128); pg8::EpiMerge2<2, true> E{P, scrB, LD, scrA, 1024, merged_ptr(p, b), merged_ld(b)};
          pg8::gemm_phase<pg8::EpiMerge2<2, true>, pg8::StaticOrder, false, PG8_SP2>(lds, g, S, E); }
    }
}
__device__ __forceinline__ void phase6_gemm(const Params& p, int b, LAS unsigned char* lds) {
    const int G = gridDim.x, c = opq_bid(); bf16_t* P = proj_ptr(p);
    pg8::Gemm g{merged_ptr(p, b), (const bf16_t*)(wsb(p) + WS_WOUT), SEQ, DM, DM, merged_ld(b), DM}; pg8::StaticOrder S; S.init(SEQ, DM, G, c);
    pg8::EpiOutNorm E{opq(p.x) + (size_t)b * SEQ * DM, opq(p.out) + (size_t)b * SEQ * DM, opq(p.final_g), (float*)(wsb(p) + WS_XBUF) + (size_t)b * SEQ * 4, (unsigned*)(wsb(p) + WS_CTL) + 8192 + b * 2048};
    pg8::gemm_phase<pg8::EpiOutNorm, pg8::StaticOrder, false, PG8_SP2>(lds, g, S, E);
}
#define MFMA16(a, b, c) __builtin_amdgcn_mfma_f32_16x16x32_bf16((a), (b), (c), 0, 0, 0)
__device__ __forceinline__ bf16x8 pack8(const float (&v)[8]) {
    u32x4 w; w.x = pk2(v[0], v[1]); w.y = pk2(v[2], v[3]); w.z = pk2(v[4], v[5]); w.w = pk2(v[6], v[7]); return __builtin_bit_cast(bf16x8, w);
}
__device__ __forceinline__ void unpack8(u32x4 w, float (&v)[8]) {
#pragma unroll
    for (int i = 0; i < 4; ++i) { v[2 * i] = __uint_as_float(w[i] << 16); v[2 * i + 1] = __uint_as_float(w[i] & 0xffff0000u); }
}
__device__ __forceinline__ void attn_phase(const Params& p, int b, LAS unsigned char* lds, int dry = 0) {
    const int tid = opq_tid(), lane = tid & 63, wave = tid >> 6, fr = lane & 15, kg = lane >> 4;
    bf16_t* P = proj_ptr(p); const bf16_t* KK = (const bf16_t*)(wsb(p) + WS_KVK) + (size_t)b * 256 * 1024; const bf16_t* VT = (const bf16_t*)(wsb(p) + WS_KVVT) + b * 256;
    LAS bf16_t* sKV = (LAS bf16_t*)lds;
    for (int u = opq_bid(); u < 256; u += gridDim.x) {
        const int hd = u & 3, rt = u >> 2, q0 = rt * 128 + wave * 16;
        bf16_t* qrow = P + (size_t)(q0 + fr) * LD + C_Q + hd * 256;
        __syncthreads();
        { unsigned ko = (unsigned)((tid >> 5) * 1024 + hd * 256 + 8 * (tid & 31)); asm volatile("" : "+v"(ko));
          u32x4 st[16];
#pragma unroll
          for (int i = 0; i < 16; ++i) st[i] = *(const u32x4*)(KK + (ko + (unsigned)(i * 16 * 1024)));
#pragma unroll
          for (int i = 0; i < 16; ++i) *(LAS u32x4*)(sKV + ((tid >> 5) + 16 * i) * 264 + 8 * (tid & 31)) = st[i]; }
        bf16x8 qf[8];
#pragma unroll
        for (int s = 0; s < 8; ++s) qf[s] = *(const bf16x8*)(qrow + 32 * s + 8 * kg);
        __syncthreads();
        u32x4 vst[16];
        { unsigned vo = (unsigned)((hd * 256 + (tid >> 5)) * 512 + 8 * (tid & 31)); asm volatile("" : "+v"(vo));
#pragma unroll
          for (int i = 0; i < 16; ++i) vst[i] = *(const u32x4*)(VT + (vo + (unsigned)(i * 16 * 512))); }
        f32x4 sacc[16];
#pragma unroll
        for (int mt = 0; mt < 16; ++mt) { sacc[mt] = (f32x4){0.f, 0.f, 0.f, 0.f};
#pragma unroll
            for (int s = 0; s < 8; ++s) { const bf16x8 kf = *(const LAS bf16x8*)(sKV + (16 * mt + fr) * 264 + 32 * s + 8 * kg); sacc[mt] = MFMA16(kf, qf[s], sacc[mt]); } }
        float mx = -INFINITY;
#pragma unroll
        for (int mt = 0; mt < 16; ++mt)
#pragma unroll
            for (int j = 0; j < 4; ++j) mx = fmaxf(mx, sacc[mt][j]);
        mx = fmaxf(mx, __shfl_xor(mx, 16)); mx = fmaxf(mx, __shfl_xor(mx, 32));
        float sum = 0.f;
#pragma unroll
        for (int mt = 0; mt < 16; ++mt)
#pragma unroll
            for (int j = 0; j < 4; ++j) { const float e = __expf((sacc[mt][j] - mx) * 0.0625f); sacc[mt][j] = e; sum += e; }
        sum += __shfl_xor(sum, 16); sum += __shfl_xor(sum, 32);
        const float inv = 1.f / sum;
        bf16x8 pf[8];
#pragma unroll
        for (int s2 = 0; s2 < 8; ++s2) { u32x4 w; w.x = pk2(sacc[2 * s2][0], sacc[2 * s2][1]); w.y = pk2(sacc[2 * s2][2], sacc[2 * s2][3]);
            w.z = pk2(sacc[2 * s2 + 1][0], sacc[2 * s2 + 1][1]); w.w = pk2(sacc[2 * s2 + 1][2], sacc[2 * s2 + 1][3]); pf[s2] = __builtin_bit_cast(bf16x8, w); }
        __syncthreads();
#pragma unroll
        for (int i = 0; i < 16; ++i) *(LAS u32x4*)(sKV + ((tid >> 5) + 16 * i) * 264 + 8 * (tid & 31)) = vst[i];
        __syncthreads();
#pragma unroll 4
        for (int mt2 = 0; mt2 < 16; ++mt2) { f32x4 o = (f32x4){0.f, 0.f, 0.f, 0.f}; const LAS bf16_t* vr = sKV + (16 * mt2 + fr) * 264 + 4 * kg;
#pragma unroll
            for (int s2 = 0; s2 < 8; ++s2) { const u32x2 lo = *(const LAS u32x2*)(vr + 32 * s2), hi = *(const LAS u32x2*)(vr + 32 * s2 + 16);
                u32x4 w; w.x = lo.x; w.y = lo.y; w.z = hi.x; w.w = hi.y; o = MFMA16(__builtin_bit_cast(bf16x8, w), pf[s2], o); }
            u32x2 ow; ow.x = pk2(o[0] * inv, o[1] * inv); ow.y = pk2(o[2] * inv, o[3] * inv);
            if (!dry) *(u32x2*)(qrow + 16 * mt2 + 4 * kg) = ow; }
    }
}
template <bool FINAL> __device__ __forceinline__ void lru_phase(const Params& p, int b, LAS unsigned char* lds, int dry = 0) {
    const int tid = opq_tid(), lane = tid & 63, wave = tid >> 6, fr = lane & 15, kg = lane >> 4;
    bf16_t* P = proj_ptr(p);
    LAS bf16_t* sWA = (LAS bf16_t*)lds; LAS bf16_t* sWX = (LAS bf16_t*)(lds + 19968);
    LAS float* sCW = (LAS float*)(lds + 39936); LAS float* sCB = sCW + 384; LAS float* sBA = sCB + 96; LAS float* sBX = sBA + 96; LAS float* sSP = sBX + 96;
    LAS float* sXL = (LAS float*)(lds + 43008) + wave * 1600;
    LAS float* sAG = (LAS float*)(lds + 94208);
    float* agg = (float*)(wsb(p) + WS_LAGG) + (size_t)b * NBLK64 * LRUW * 2;
    const float* car = (const float*)(wsb(p) + WS_LCAR) + (size_t)b * NBLK64 * LRUW;
    const float* lcw = opq(p.lru_conv_w); const float* lcb = opq(p.lru_conv_b); const float* lba = opq(p.lru_b_a); const float* lbx = opq(p.lru_b_x); const float* lam = opq(p.lru_lambda);
    for (int u = opq_bid(); u < NLB * NSEG; u += gridDim.x) {
        const int n = u % NLB, sg = u / NLB;
        __syncthreads();
        { const bf16_t* gwa = (const bf16_t*)(wsb(p) + WS_LRUWA) + n * 9216; const bf16_t* gwx = (const bf16_t*)(wsb(p) + WS_LRUWX) + n * 9216;
          u32x4 wa3[3], wx3[3]; float cwv = 0.f, v4[4] = {0.f, 0.f, 0.f, 0.f};
#pragma unroll
          for (int i = 0; i < 3; ++i) { const int e = tid + 512 * i; if (e < 96 * 12) { const int j = e / 12, c8 = e % 12; wa3[i] = *(const u32x4*)(gwa + j * 96 + 8 * c8); wx3[i] = *(const u32x4*)(gwx + j * 96 + 8 * c8); } }
          if (tid < 384) cwv = lcw[(tid / 96) * 1536 + n * 96 + tid % 96];
          if (tid < 96) { v4[0] = lcb[n * 96 + tid]; v4[1] = lba[n * 96 + tid]; v4[2] = lbx[n * 96 + tid]; v4[3] = lam[n * 96 + tid]; }
#pragma unroll
          for (int i = 0; i < 3; ++i) { const int e = tid + 512 * i; if (e < 96 * 12) { const int j = e / 12, c8 = e % 12; *(LAS u32x4*)(sWA + j * 104 + 8 * c8) = wa3[i]; *(LAS u32x4*)(sWX + j * 104 + 8 * c8) = wx3[i]; } }
          if (tid < 384) sCW[tid] = cwv;
          if (tid < 96) { sCB[tid] = v4[0]; sBA[tid] = v4[1]; sBX[tid] = v4[2]; sSP[tid] = softplusf_(-v4[3]); } }
        __syncthreads();
        float runA[6], runH[6];
#pragma unroll
        for (int nt = 0; nt < 6; ++nt) { runA[nt] = 1.f; runH[nt] = FINAL ? car[(sg * 8 + wave) * LRUW + n * 96 + 16 * nt + fr] : 0.f; }
        for (int step = 0; step < 4; ++step) {
            const int tb = sg * LSEG + wave * 64 + step * 16;
            u32x4 rawC[3][4];
            { const int t0r = tb + fr - 3; unsigned ro = (unsigned)((t0r < 0 ? 0 : t0r) * LD + C_LX + n * 96 + 8 * kg); asm volatile("" : "+v"(ro));
              if (t0r >= 0) {
#pragma unroll
                  for (int ks = 0; ks < 3; ++ks)
#pragma unroll
                      for (int k = 0; k < 4; ++k) rawC[ks][k] = *(const u32x4*)(P + (ro + (unsigned)(k * LD + 32 * ks)));
              } else {
#pragma unroll
                  for (int ks = 0; ks < 3; ++ks)
#pragma unroll
                      for (int k = 0; k < 4; ++k) { const int t = t0r + k; rawC[ks][k] = *(const u32x4*)(P + (ro + (unsigned)((t < 0 ? 0 : t) * LD + 32 * ks))); if (t < 0) rawC[ks][k] = (u32x4){0u, 0u, 0u, 0u}; }
              } }
            bf16x8 af[3];
#pragma unroll
            for (int ks = 0; ks < 3; ++ks) { const int ch0 = 32 * ks + 8 * kg; float xl[8];
#pragma unroll
                for (int i = 0; i < 8; ++i) xl[i] = sCB[ch0 + i];
#pragma unroll
                for (int k = 0; k < 4; ++k) { const u32x4 raw = rawC[ks][k];
                    float rv[8]; unpack8(raw, rv);
#pragma unroll
                    for (int i = 0; i < 8; ++i) xl[i] += sCW[k * 96 + ch0 + i] * rv[i]; }
                *(LAS f32x4*)(sXL + fr * 100 + ch0) = (f32x4){xl[0], xl[1], xl[2], xl[3]}; *(LAS f32x4*)(sXL + fr * 100 + ch0 + 4) = (f32x4){xl[4], xl[5], xl[6], xl[7]};
                af[ks] = pack8(xl); }
            LAS bf16_t* sG = (LAS bf16_t*)((LAS unsigned char*)sWA + 106496) + wave * 1536;
            unsigned go3[3]; u32x4 graw[3];
            if (FINAL) {
#pragma unroll
                for (int i = 0; i < 3; ++i) { const int e = lane + 64 * i, row = e / 12, c12 = e % 12; go3[i] = (unsigned)((tb + row) * LD + C_LG + n * 96 + 8 * c12); }
                asm volatile("" : "+v"(go3[0]), "+v"(go3[1]), "+v"(go3[2]));
#pragma unroll
                for (int i = 0; i < 3; ++i) graw[i] = *(const u32x4*)(P + go3[i]); }
            f32x4 aR[6], aI[6];
#pragma unroll
            for (int nt = 0; nt < 6; ++nt) { aR[nt] = (f32x4){0.f, 0.f, 0.f, 0.f}; aI[nt] = (f32x4){0.f, 0.f, 0.f, 0.f};
#pragma unroll
                for (int ks = 0; ks < 3; ++ks) { const bf16x8 wa = *(const LAS bf16x8*)(sWA + (16 * nt + fr) * 104 + 32 * ks + 8 * kg), wx = *(const LAS bf16x8*)(sWX + (16 * nt + fr) * 104 + 32 * ks + 8 * kg);
                    aR[nt] = MFMA16(af[ks], wa, aR[nt]); aI[nt] = MFMA16(af[ks], wx, aI[nt]); } }
            float Ainc[6][4], Hinc[6][4];
#pragma unroll
            for (int nt = 0; nt < 6; ++nt) { const int j = 16 * nt + fr; const float ba2 = -1.44269504f * sBA[j], bx2 = -1.44269504f * sBX[j], spc = -8.f * 1.44269504f * sSP[j];
                float A = 1.f, H = 0.f;
#pragma unroll
                for (int r = 0; r < 4; ++r) { const float xlv = sXL[(4 * kg + r) * 100 + j];
                    const float rr = __builtin_amdgcn_rcpf(1.f + __builtin_amdgcn_exp2f(fmaf(aR[nt][r], -1.44269504f, ba2))), ii = __builtin_amdgcn_rcpf(1.f + __builtin_amdgcn_exp2f(fmaf(aI[nt][r], -1.44269504f, bx2)));
                    const float a = __builtin_amdgcn_exp2f(rr * spc), mult = __builtin_amdgcn_sqrtf(fmaxf(0.f, fmaf(-a, a, 1.f)));
                    H = a * H + mult * ii * xlv; A *= a; Ainc[nt][r] = A; Hinc[nt][r] = H; }
                float ap = 1.f, hp = 0.f, at = 1.f, ht = 0.f;
#pragma unroll
                for (int k = 0; k < 4; ++k) { const float ab = __shfl(A, fr + 16 * k), hb = __shfl(H, fr + 16 * k);
                    if (k < kg) { hp = ab * hp + hb; ap *= ab; } ht = ab * ht + hb; at *= ab; }
                if (FINAL) { const float hin = ap * runH[nt] + hp;
#pragma unroll
                    for (int r = 0; r < 4; ++r) Hinc[nt][r] = Ainc[nt][r] * hin + Hinc[nt][r]; }
                runH[nt] = at * runH[nt] + ht; runA[nt] *= at; }
            if (FINAL) {
#pragma unroll
                for (int i = 0; i < 3; ++i) { const int e = lane + 64 * i; *(LAS u32x4*)(sG + (e / 12) * 96 + 8 * (e % 12)) = graw[i]; }
                asm volatile("s_waitcnt lgkmcnt(0)" ::: "memory");
#pragma unroll
                for (int nt = 0; nt < 6; ++nt)
#pragma unroll
                    for (int r = 0; r < 4; ++r) { LAS bf16_t* gp = sG + (4 * kg + r) * 96 + 16 * nt + fr; const float yv = Hinc[nt][r] * siluf_(bf2f(*gp)); *gp = (bf16_t)f2bf(yv); }
                asm volatile("s_waitcnt lgkmcnt(0)" ::: "memory");
#pragma unroll
                for (int i = 0; i < 3; ++i) { const int e = lane + 64 * i; const u32x4 w = *(const LAS u32x4*)(sG + (e / 12) * 96 + 8 * (e % 12)); if (!dry) *(u32x4*)(P + go3[i]) = w; }
                asm volatile("s_waitcnt lgkmcnt(0)" ::: "memory"); }
        }
        if (!FINAL && kg == 0) {
#pragma unroll
            for (int nt = 0; nt < 6; ++nt) { const int ch = n * 96 + 16 * nt + fr; agg[((size_t)(sg * 8 + wave) * LRUW + ch) * 2] = runA[nt]; agg[((size_t)(sg * 8 + wave) * LRUW + ch) * 2 + 1] = runH[nt]; } }
    }
}
__device__ __forceinline__ void lru_carry_phase(const Params& p, int b) {
    const int tid = opq_tid(), lane = tid & 63, wave = tid >> 6;
    const float* agg = (const float*)(wsb(p) + WS_LAGG) + (size_t)b * NBLK64 * LRUW * 2; float* car = (float*)(wsb(p) + WS_LCAR) + (size_t)b * NBLK64 * LRUW;
    for (int ch = opq_bid() * 8 + wave; ch < LRUW; ch += gridDim.x * 8) {
        const float a0 = agg[((size_t)(2 * lane) * LRUW + ch) * 2], h0 = agg[((size_t)(2 * lane) * LRUW + ch) * 2 + 1];
        const float a1 = agg[((size_t)(2 * lane + 1) * LRUW + ch) * 2], h1 = agg[((size_t)(2 * lane + 1) * LRUW + ch) * 2 + 1];
        float A = a1 * a0, H = a1 * h0 + h1;
#pragma unroll
        for (int o = 1; o < 64; o <<= 1) { const float Ap = __shfl_up(A, o), Hp = __shfl_up(H, o); if (lane >= o) { H = A * Hp + H; A = A * Ap; } }
        float hin = __shfl_up(H, 1); if (lane == 0) hin = 0.f;
        car[(2 * lane) * LRUW + ch] = hin; car[(2 * lane + 1) * LRUW + ch] = a0 * hin + h0;
    }
}
__device__ __forceinline__ void conv8_silu(const bf16_t* P, int t, int col, const float* cw, const float* cb, int ch, float (&o)[8]) {
    float r[11];
    unsigned off0 = (unsigned)((t < 3 ? 0 : t - 3) * LD + col); asm volatile("" : "+v"(off0));
    if (t >= 3) {
#pragma unroll
        for (int i = 0; i < 11; ++i) r[i] = bf2f(P[off0 + (unsigned)(i * LD)]);
    } else {
#pragma unroll
        for (int i = 0; i < 11; ++i) { const int tt = t - 3 + i; const float v = bf2f(P[off0 + (unsigned)((tt < 0 ? 0 : tt) * LD)]); r[i] = tt < 0 ? 0.f : v; }
    }
    const float w0 = cw[ch], w1 = cw[3072 + ch], w2 = cw[6144 + ch], w3 = cw[9216 + ch], bb = cb[ch];
#pragma unroll
    for (int j = 0; j < 8; ++j) o[j] = siluf_(bb + w0 * r[j] + w1 * r[j + 1] + w2 * r[j + 2] + w3 * r[j + 3]);
}
__device__ __forceinline__ float ssd_dt_setup(const Params& p, const bf16_t* P, int t0, int h, int lane, LAS float* sACS, LAS float* sDT) {
    const float dtb = opq(p.ssd_dt_bias)[h], an = -__expf(opq(p.ssd_a_log)[h]);
    const float dt0 = softplusf_(bf2f(P[(size_t)(t0 + 2 * lane) * LD + C_DT + h]) + dtb), dt1 = softplusf_(bf2f(P[(size_t)(t0 + 2 * lane + 1) * LD + C_DT + h]) + dtb);
    const float dA1 = dt1 * an; float s = dt0 * an + dA1;
#pragma unroll
    for (int o = 1; o < 64; o <<= 1) { const float t = __shfl_up(s, o); if (lane >= o) s += t; }
    sACS[2 * lane] = s - dA1; sACS[2 * lane + 1] = s; sDT[2 * lane] = dt0; sDT[2 * lane + 1] = dt1;
    return __shfl(s, 63);
}
template <int R> __device__ __forceinline__ void conv_rows(const bf16_t* P, int t, int col, const float* cw, const float* cb, int ch, float (&o)[R][8]) {
    unsigned off0 = (unsigned)((t < 3 ? 0 : t - 3) * LD + col); asm volatile("" : "+v"(off0));
    u32x4 raw[R + 3];
    if (t >= 3) {
#pragma unroll
        for (int i = 0; i < R + 3; ++i) raw[i] = *(const u32x4*)(P + (off0 + (unsigned)(i * LD)));
    } else {
#pragma unroll
        for (int i = 0; i < R + 3; ++i) { const int tt = t - 3 + i; raw[i] = *(const u32x4*)(P + (off0 + (unsigned)((tt < 0 ? 0 : tt) * LD))); if (tt < 0) raw[i] = (u32x4){0u, 0u, 0u, 0u}; }
    }
    float w[4][8], bb[8];
#pragma unroll
    for (int k = 0; k < 4; ++k) { const f32x4 w0 = *(const f32x4*)(cw + k * 3072 + ch), w1 = *(const f32x4*)(cw + k * 3072 + ch + 4);
        w[k][0] = w0[0]; w[k][1] = w0[1]; w[k][2] = w0[2]; w[k][3] = w0[3]; w[k][4] = w1[0]; w[k][5] = w1[1]; w[k][6] = w1[2]; w[k][7] = w1[3]; }
    { const f32x4 b0 = *(const f32x4*)(cb + ch), b1 = *(const f32x4*)(cb + ch + 4); bb[0] = b0[0]; bb[1] = b0[1]; bb[2] = b0[2]; bb[3] = b0[3]; bb[4] = b1[0]; bb[5] = b1[1]; bb[6] = b1[2]; bb[7] = b1[3]; }
#pragma unroll
    for (int r = 0; r < R; ++r)
#pragma unroll
        for (int q = 0; q < 8; ++q) o[r][q] = bb[q];
#pragma unroll
    for (int i = 0; i < R + 3; ++i) { float v[8]; unpack8(raw[i], v);
#pragma unroll
        for (int k = 0; k < 4; ++k) { const int r = i - k; if (r >= 0 && r < R) {
#pragma unroll
                for (int q = 0; q < 8; ++q) o[r][q] += w[k][q] * v[q]; } } }
#pragma unroll
    for (int r = 0; r < R; ++r)
#pragma unroll
        for (int q = 0; q < 8; ++q) o[r][q] = siluf_(o[r][q]);
}
__device__ __forceinline__ void ssd_states_phase(const Params& p, int b, LAS unsigned char* lds) {
    const int tid = opq_tid(), lane = tid & 63, wave = tid >> 6, fr = lane & 15, kg = lane >> 4;
    const bf16_t* P = proj_ptr(p); bf16_t* ST = states_ptr(p, b); float* dasum = (float*)(wsb(p) + WS_DASUM) + b * NCHUNK * NHEAD;
    const float* cw = opq(p.ssd_conv_w); const float* cb = opq(p.ssd_conv_b);
    LAS bf16_t* sBT = (LAS bf16_t*)lds; LAS bf16_t* sXT = (LAS bf16_t*)(lds + 34816 + wave * 8704);
    LAS float* sACS = (LAS float*)(lds + 104448) + wave * 128; LAS float* sW = (LAS float*)(lds + 108544) + wave * 128;
    for (int u = opq_bid(); u < NCHUNK * NGRP; u += gridDim.x) {
        const int c = u >> 2, g = u & 3, t0 = c * CHUNK, h = 8 * g + wave;
        __syncthreads();
        { const float tot = ssd_dt_setup(p, P, t0, h, lane, sACS, sW);
          if (lane == 0) dasum[c * NHEAD + h] = tot;
          sW[2 * lane] = sW[2 * lane] * __expf(tot - sACS[2 * lane]); sW[2 * lane + 1] = sW[2 * lane + 1] * __expf(tot - sACS[2 * lane + 1]); }
        { const int cg = tid & 15, rs = tid >> 4; float o[4][8];
          conv_rows<4>(P, t0 + 4 * rs, C_B + g * 128 + 8 * cg, cw, cb, 2048 + g * 128 + 8 * cg, o);
#pragma unroll
          for (int q = 0; q < 8; ++q) { u32x2 w; w.x = pk2(o[0][q], o[1][q]); w.y = pk2(o[2][q], o[3][q]); *(LAS u32x2*)(sBT + (8 * cg + q) * 136 + 4 * rs) = w; } }
        __syncthreads();
        for (int ph = 0; ph < 2; ++ph) {
            { const int cg = lane & 3, rs = lane >> 2; float o[8][8];
              conv_rows<8>(P, t0 + 8 * rs, C_X + h * 64 + 32 * ph + 8 * cg, cw, cb, h * 64 + 32 * ph + 8 * cg, o);
              const f32x4 w0 = *(const LAS f32x4*)(sW + 8 * rs), w1 = *(const LAS f32x4*)(sW + 8 * rs + 4);
#pragma unroll
              for (int q = 0; q < 8; ++q) { float v[8] = {o[0][q] * w0[0], o[1][q] * w0[1], o[2][q] * w0[2], o[3][q] * w0[3], o[4][q] * w1[0], o[5][q] * w1[1], o[6][q] * w1[2], o[7][q] * w1[3]};
                  *(LAS bf16x8*)(sXT + (8 * cg + q) * 136 + 8 * rs) = pack8(v); } }
            asm volatile("s_waitcnt lgkmcnt(0)" ::: "memory");
            f32x4 acc[8][2];
#pragma unroll
            for (int mt = 0; mt < 8; ++mt) { acc[mt][0] = (f32x4){0.f, 0.f, 0.f, 0.f}; acc[mt][1] = (f32x4){0.f, 0.f, 0.f, 0.f}; }
#pragma unroll
            for (int s = 0; s < 4; ++s) { const bf16x8 x0 = *(const LAS bf16x8*)(sXT + fr * 136 + 32 * s + 8 * kg), x1 = *(const LAS bf16x8*)(sXT + (16 + fr) * 136 + 32 * s + 8 * kg);
#pragma unroll
                for (int mt = 0; mt < 8; ++mt) { const bf16x8 a = *(const LAS bf16x8*)(sBT + (16 * mt + fr) * 136 + 32 * s + 8 * kg);
                    acc[mt][0] = MFMA16(a, x0, acc[mt][0]); acc[mt][1] = MFMA16(a, x1, acc[mt][1]); } }
            asm volatile("s_waitcnt lgkmcnt(0)" ::: "memory");
#pragma unroll
            for (int mt = 0; mt < 8; ++mt)
#pragma unroll
                for (int nt = 0; nt < 2; ++nt) { u32x2 w; w.x = pk2(acc[mt][nt][0], acc[mt][nt][1]); w.y = pk2(acc[mt][nt][2], acc[mt][nt][3]);
                    *(LAS u32x2*)(sXT + (16 * nt + fr) * 136 + 16 * mt + 4 * kg) = w; }
            asm volatile("s_waitcnt lgkmcnt(0)" ::: "memory");
            { const int rr = lane >> 4, cc = lane & 15; unsigned so = (unsigned)(((c * NHEAD + h) * 64 + 32 * ph + rr) * 128 + 8 * cc); asm volatile("" : "+v"(so));
#pragma unroll
              for (int i = 0; i < 8; ++i) { const u32x4 w4 = *(const LAS u32x4*)(sXT + (4 * i + rr) * 136 + 8 * cc); *(u32x4*)(ST + (so + (unsigned)(4 * i * 128))) = w4; } }
            asm volatile("s_waitcnt lgkmcnt(0)" ::: "memory");
        }
    }
}
__device__ __forceinline__ void ssd_scan_phase(const Params& p, int b, int dry = 0) {
    unsigned* st = (unsigned*)states_ptr(p, b); const float* dasum = (const float*)(wsb(p) + WS_DASUM) + b * NCHUNK * NHEAD;
    for (int e2 = opq_bid() * 512 + opq_tid(); e2 < 131072; e2 += gridDim.x * 512) {
        const int h = e2 >> 12; float r0 = 0.f, r1 = 0.f;
        for (int c0 = 0; c0 < NCHUNK; c0 += 16) { unsigned v[16]; float d[16];
#pragma unroll
            for (int i = 0; i < 16; ++i) { v[i] = st[(size_t)(c0 + i) * 131072 + e2]; d[i] = dasum[(c0 + i) * NHEAD + h]; }
#pragma unroll
            for (int i = 0; i < 16; ++i) { const unsigned w = pk2(r0, r1); const float dd = __expf(d[i]);
                r0 = r0 * dd + __uint_as_float(v[i] << 16); r1 = r1 * dd + __uint_as_float(v[i] & 0xffff0000u); v[i] = w; }
            if (!dry) {
#pragma unroll
                for (int i = 0; i < 16; ++i) st[(size_t)(c0 + i) * 131072 + e2] = v[i]; } }
    }
}
__device__ __forceinline__ void ssd_out_phase(const Params& p, int b, LAS unsigned char* lds, int dry = 0) {
    const int tid = opq_tid(), lane = tid & 63, wave = tid >> 6, fr = lane & 15, kg = lane >> 4;
    bf16_t* P = proj_ptr(p); const bf16_t* ST = states_ptr(p, b);
    const float* cw = opq(p.ssd_conv_w); const float* cb = opq(p.ssd_conv_b);
    LAS bf16_t* sC = (LAS bf16_t*)lds; LAS bf16_t* sCB = (LAS bf16_t*)(lds + 34816); LAS bf16_t* sB = (LAS bf16_t*)(lds + 69632); LAS bf16_t* sXT = (LAS bf16_t*)(lds + 69632 + wave * 8704);
    LAS float* sACS = (LAS float*)(lds + 139264) + wave * 128; LAS float* sDT = (LAS float*)(lds + 143360) + wave * 128; LAS float* sSSQ = (LAS float*)(lds + 147456);
    for (int u = opq_bid(); u < NCHUNK * NGRP; u += gridDim.x) {
        const int c = u >> 2, g = u & 3, t0 = c * CHUNK, h = 8 * g + wave;
        __syncthreads();
        MSTAMP(p, 0);
        (void)ssd_dt_setup(p, P, t0, h, lane, sACS, sDT);
        { const int cg = tid & 15, rs = (tid >> 4) & 15, isC = tid >> 8; float o[8][8];
          conv_rows<8>(P, t0 + 8 * rs, C_B + isC * 512 + g * 128 + 8 * cg, cw, cb, 2048 + isC * 512 + g * 128 + 8 * cg, o);
          LAS bf16_t* dst = (isC ? sC : sB) + (8 * rs) * 136 + 8 * cg;
#pragma unroll
          for (int r = 0; r < 8; ++r) *(LAS bf16x8*)(dst + r * 136) = pack8(o[r]); }
        __syncthreads();
#pragma unroll
        for (int ms = 0; ms < 8; ++ms) if (ms <= wave) { f32x4 a4 = (f32x4){0.f, 0.f, 0.f, 0.f};
#pragma unroll
            for (int kn = 0; kn < 4; ++kn) { const bf16x8 a = *(const LAS bf16x8*)(sB + (16 * ms + fr) * 136 + 32 * kn + 8 * kg), bb = *(const LAS bf16x8*)(sC + (16 * wave + fr) * 136 + 32 * kn + 8 * kg);
                a4 = MFMA16(a, bb, a4); }
            u32x2 w; w.x = pk2(a4[0], a4[1]); w.y = pk2(a4[2], a4[3]);
            *(LAS u32x2*)(sCB + (16 * wave + fr) * 136 + 16 * ms + 4 * kg) = w; }
        __syncthreads();
        MSTAMP(p, 1);
        const float Dh = opq(p.ssd_d)[h];
        const unsigned zbase0 = (unsigned)((t0 + fr) * LD + C_Z + h * 64 + 4 * kg);
        float ssq[8];
#pragma unroll
        for (int nt = 0; nt < 8; ++nt) ssq[nt] = 0.f;
        for (int ph = 0; ph < 2; ++ph) {
            unsigned zb = zbase0 + 32u * ph; asm volatile("" : "+v"(zb));
            unsigned pfo = (unsigned)(((c * NHEAD + h) * 64 + 32 * ph + fr) * 128 + 8 * kg); asm volatile("" : "+v"(pfo));
            bf16x8 pf[4][2];
#pragma unroll
            for (int sn = 0; sn < 4; ++sn) { pf[sn][0] = *(const bf16x8*)(ST + (pfo + (unsigned)(32 * sn))); pf[sn][1] = *(const bf16x8*)(ST + (pfo + (unsigned)(16 * 128 + 32 * sn))); }
            { const int cg = lane & 3, rs = lane >> 2; float o[8][8];
              conv_rows<8>(P, t0 + 8 * rs, C_X + h * 64 + 32 * ph + 8 * cg, cw, cb, h * 64 + 32 * ph + 8 * cg, o);
#pragma unroll
              for (int q = 0; q < 8; ++q) { float v[8] = {o[0][q], o[1][q], o[2][q], o[3][q], o[4][q], o[5][q], o[6][q], o[7][q]};
                  *(LAS bf16x8*)(sXT + (8 * cg + q) * 136 + 8 * rs) = pack8(v); } }
            asm volatile("s_waitcnt lgkmcnt(0)" ::: "memory");
            f32x4 acc[2][8];
#pragma unroll
            for (int nt = 0; nt < 8; ++nt) { acc[0][nt] = (f32x4){0.f, 0.f, 0.f, 0.f}; acc[1][nt] = (f32x4){0.f, 0.f, 0.f, 0.f}; }
#pragma unroll
            for (int nt = 0; nt < 8; ++nt) {
#pragma unroll
                for (int sn = 0; sn < 4; ++sn) { const bf16x8 cf = *(const LAS bf16x8*)(sC + (16 * nt + fr) * 136 + 32 * sn + 8 * kg);
                    acc[0][nt] = MFMA16(pf[sn][0], cf, acc[0][nt]); acc[1][nt] = MFMA16(pf[sn][1], cf, acc[1][nt]); }
                const float sc = __expf(sACS[16 * nt + fr]);
                acc[0][nt] *= sc; acc[1][nt] *= sc; }
#pragma unroll
            for (int sk = 0; sk < 4; ++sk) {
                const int s0 = 32 * sk + 8 * kg;
                const bf16x8 xa0 = *(const LAS bf16x8*)(sXT + fr * 136 + s0), xa1 = *(const LAS bf16x8*)(sXT + (16 + fr) * 136 + s0);
                const f32x4 as0 = *(const LAS f32x4*)(sACS + s0), as1 = *(const LAS f32x4*)(sACS + s0 + 4), d0 = *(const LAS f32x4*)(sDT + s0), d1 = *(const LAS f32x4*)(sDT + s0 + 4);
#pragma unroll
                for (int nt = 0; nt < 8; ++nt) if (nt >= 2 * sk) { const int l = 16 * nt + fr; const float acsl = sACS[l];
                    float cbv[8]; unpack8(*(const LAS u32x4*)(sCB + l * 136 + s0), cbv);
                    float m[8];
#pragma unroll
                    for (int i = 0; i < 8; ++i) { const int s = s0 + i; const float as = i < 4 ? as0[i & 3] : as1[i & 3], ds = i < 4 ? d0[i & 3] : d1[i & 3];
                        float mv = (s <= l) ? cbv[i] * __expf(acsl - as) * ds : 0.f; if (s == l) mv += Dh; m[i] = mv; }
                    const bf16x8 mb = pack8(m);
                    acc[0][nt] = MFMA16(xa0, mb, acc[0][nt]); acc[1][nt] = MFMA16(xa1, mb, acc[1][nt]);
                    asm volatile("" ::: "memory"); }
            }
            u32x2 zall[8][2];
#pragma unroll
            for (int nt = 0; nt < 8; ++nt)
#pragma unroll
                for (int mt = 0; mt < 2; ++mt) zall[nt][mt] = *(const u32x2*)(P + (zb + (unsigned)(16 * nt * LD + 16 * mt)));
#pragma unroll
            for (int nt = 0; nt < 8; ++nt)
#pragma unroll
                for (int mt = 0; mt < 2; ++mt) { u32x2* zp = (u32x2*)(P + (zb + (unsigned)(16 * nt * LD + 16 * mt)));
                    const u32x2 zw = zall[nt][mt]; float y[4];
                    y[0] = acc[mt][nt][0] * siluf_(__uint_as_float(zw.x << 16)); y[1] = acc[mt][nt][1] * siluf_(__uint_as_float(zw.x & 0xffff0000u));
                    y[2] = acc[mt][nt][2] * siluf_(__uint_as_float(zw.y << 16)); y[3] = acc[mt][nt][3] * siluf_(__uint_as_float(zw.y & 0xffff0000u));
                    ssq[nt] += (y[0] * y[0] + y[1] * y[1]) + (y[2] * y[2] + y[3] * y[3]);
                    u32x2 yw; yw.x = pk2(y[0], y[1]); yw.y = pk2(y[2], y[3]); (void)zp; *(LAS u32x2*)(sXT + (16 * nt + fr) * 32 + 16 * mt + 4 * kg) = yw; }
            asm volatile("s_waitcnt lgkmcnt(0)" ::: "memory");
            { const int rr = lane >> 2, cc = lane & 3;
              unsigned so = (unsigned)((t0 + rr) * LD + C_Z + h * 64 + 32 * ph + 8 * cc); asm volatile("" : "+v"(so));
              if (ph == 0) {
#pragma unroll
                  for (int i = 0; i < 8; ++i) { const u32x4 w = *(const LAS u32x4*)(sXT + (16 * i + rr) * 32 + 8 * cc); if (!dry) *(u32x4*)(P + (so + (unsigned)(16 * i * LD))) = w; } } }
            asm volatile("s_waitcnt lgkmcnt(0)" ::: "memory");
        }
        MSTAMP(p, 2);
#pragma unroll
        for (int nt = 0; nt < 8; ++nt) { float v = ssq[nt]; v += __shfl_xor(v, 16); v += __shfl_xor(v, 32); if (kg == 0) sSSQ[wave * 128 + 16 * nt + fr] = v; }
        __syncthreads();
        { const int rr = lane >> 2, cc = lane & 3;
          const float* ng = opq(p.ssd_norm_g) + g * 512 + wave * 64 + 8 * cc;
          f32x4 gg[2][2];
#pragma unroll
          for (int ph = 0; ph < 2; ++ph) { gg[ph][0] = *(const f32x4*)(ng + 32 * ph); gg[ph][1] = *(const f32x4*)(ng + 32 * ph + 4); }
          unsigned so = (unsigned)((t0 + rr) * LD + C_Z + h * 64 + 8 * cc); asm volatile("" : "+v"(so));
          u32x4 yv[8][2];
#pragma unroll
          for (int i = 0; i < 8; ++i)
#pragma unroll
              for (int ph = 0; ph < 2; ++ph) yv[i][ph] = ph == 0 ? *(const u32x4*)(P + (so + (unsigned)(16 * i * LD))) : *(const LAS u32x4*)(sXT + (16 * i + rr) * 32 + 8 * cc);
#pragma unroll
          for (int i = 0; i < 8; ++i) { const int l = 16 * i + rr; float tot = 0.f;
#pragma unroll
              for (int w2 = 0; w2 < 8; ++w2) tot += sSSQ[w2 * 128 + l];
              const float rs = 1.f / sqrtf(tot * (1.f / 512.f) + EPS);
#pragma unroll
              for (int ph = 0; ph < 2; ++ph) { float v[8]; unpack8(yv[i][ph], v);
                  v[0] *= rs * gg[ph][0][0]; v[1] *= rs * gg[ph][0][1]; v[2] *= rs * gg[ph][0][2]; v[3] *= rs * gg[ph][0][3];
                  v[4] *= rs * gg[ph][1][0]; v[5] *= rs * gg[ph][1][1]; v[6] *= rs * gg[ph][1][2]; v[7] *= rs * gg[ph][1][3];
                  if (!dry) *(bf16x8*)(P + (so + (unsigned)(16 * i * LD + 32 * ph))) = pack8(v); } } }
        MSTAMP(p, 3);
    }
}
#define XB_TMO      128
#define XB_XCNT(j)  (256  + 64 * (j))
#define XB_XSUB(j)  (1280 + 64 * (j))
#define XB_XGEN(j)  (2304 + 64 * (j))
#define XB_TOP      3328
#define XB_TOPGEN   3392
#define XCD_BAR_WORDS 3456
#define XB_SPIN_CAP (1u << 18)

__device__ __forceinline__ unsigned xb_ld(unsigned* p)              { return __hip_atomic_load(p, __ATOMIC_RELAXED, __HIP_MEMORY_SCOPE_AGENT); }
__device__ __forceinline__ unsigned xb_add(unsigned* p, unsigned v) { return __hip_atomic_fetch_add(p, v, __ATOMIC_RELAXED, __HIP_MEMORY_SCOPE_AGENT); }
__device__ __forceinline__ unsigned xb_xcc_id() { return (unsigned)__builtin_amdgcn_s_getreg((3 << 11) | 20) & 0xFu; }
#define XB_SPIN(cond, bar) do { unsigned _sp = 0; while (cond) { __builtin_amdgcn_s_sleep(1); \
    if ((++_sp & 255u) == 0u) { if (xb_ld(&(bar)[XB_TMO])) break; if (_sp > XB_SPIN_CAP) { atomicAdd(&(bar)[XB_TMO], 1u); break; } } } } while (0)

struct XcdBarrier {
    unsigned* bar; unsigned x;
    volatile LAS unsigned* st;
};

__device__ __forceinline__ XcdBarrier xcd_barrier_post(unsigned* bar, volatile LAS unsigned* st) {
    XcdBarrier b; b.bar = bar; b.x = xb_xcc_id(); b.st = st;
    if (threadIdx.x == 0) (void)xb_add(&bar[XB_XCNT(b.x)], 1u);
    return b;
}
__device__ __forceinline__ void xcd_barrier_complete(unsigned* bar, unsigned x, unsigned& nloc, unsigned& nx) {
    const unsigned G = gridDim.x * gridDim.y * gridDim.z;
    unsigned sum, cnt, mine, sp = 0u;
    for (;;) {
        sum = 0u; cnt = 0u; mine = 0u;
#pragma unroll
        for (unsigned j = 0; j < 16; ++j) { const unsigned c = xb_ld(&bar[XB_XCNT(j)]); sum += c; cnt += (c > 0u) ? 1u : 0u; mine = (j == x) ? c : mine; }
        if (sum == G) break;
        __builtin_amdgcn_s_sleep(1);
        if ((++sp & 255u) == 0u) { if (xb_ld(&bar[XB_TMO])) break; if (sp > XB_SPIN_CAP) { atomicAdd(&bar[XB_TMO], 1u); break; } }
    }
    nloc = mine > 0u ? mine : 1u; nx = cnt > 0u ? cnt : 1u;
}

__device__ __forceinline__ void xcd_barrier(const XcdBarrier& b) {
    asm volatile("s_waitcnt vmcnt(0)" ::: "memory");
    __syncthreads();
    if (threadIdx.x == 0) {
        unsigned* bar = b.bar; asm volatile("" : "+s"(bar));
        unsigned bx = b.x; asm volatile("" : "+s"(bx));
        __builtin_amdgcn_s_waitcnt(0);
        unsigned nloc = b.st[0], nx = b.st[1];
        if (nloc == 0u) { xcd_barrier_complete(bar, bx, nloc, nx); b.st[0] = nloc; b.st[1] = nx; }
        const unsigned old = xb_add(&bar[XB_XSUB(bx)], 1u);
        const unsigned gen = old / nloc;
        if (old + 1u == (gen + 1u) * nloc) {
            __builtin_amdgcn_fence(__ATOMIC_RELEASE, "agent");
            asm volatile("s_waitcnt vmcnt(0)" ::: "memory");
            const unsigned og = xb_add(&bar[XB_TOP], 1u);
            const unsigned tg = og / nx;
            if (og + 1u == (tg + 1u) * nx) xb_add(&bar[XB_TOPGEN], 1u);
            else XB_SPIN(xb_ld(&bar[XB_TOPGEN]) == tg, bar);
            __builtin_amdgcn_fence(__ATOMIC_ACQUIRE, "agent");
            xb_add(&bar[XB_XGEN(bx)], 1u);
            asm volatile("s_waitcnt vmcnt(0)" ::: "memory");
        } else {
            XB_SPIN(xb_ld(&bar[XB_XGEN(bx)]) == gen, bar);
            __builtin_amdgcn_fence(__ATOMIC_ACQUIRE, "agent");
            asm volatile("s_waitcnt vmcnt(0)" ::: "memory");
        }
    }
    __syncthreads();
}

#ifdef REP_COLD
#define REP_SEP() xcd_barrier(bar)
#else
#define REP_SEP() __syncthreads()
#endif
#define RUNP(n, ...) do { if ((n) > 1) { for (int r_ = nrep(n) - 1; r_ > 0; --r_) { const int dry_ = 1; (void)dry_; __VA_ARGS__; REP_SEP(); } } { const int dry_ = 0; (void)dry_; __VA_ARGS__; } } while (0)
#ifndef REP_SYNC
#define REP_SYNC 1
#endif
#ifndef REP_P0
#define REP_P0 1
#endif
#ifndef REP_P1
#define REP_P1 1
#endif
#ifndef REP_P5
#define REP_P5 1
#endif
#ifndef REP_P6
#define REP_P6 1
#endif
#ifndef REP_ST
#define REP_ST 1
#endif
#ifndef REP_LA
#define REP_LA 1
#endif
#ifndef REP_AT
#define REP_AT 1
#endif
#ifndef REP_SC
#define REP_SC 1
#endif
#ifndef REP_SO
#define REP_SO 1
#endif
#ifndef REP_LF
#define REP_LF 1
#endif
__device__ __forceinline__ int nrep(int n) { asm volatile("" : "+s"(n)); return n; }
__device__ __forceinline__ LAS unsigned char* opl(LAS unsigned char* q) { asm volatile("" : "+s"(q)); return q; }
__global__ void __launch_bounds__(512) mk(Params p) {
    extern __shared__ __attribute__((aligned(16))) unsigned char lds_raw[];
    LAS unsigned char* lds = (LAS unsigned char*)lds_raw;
    if (threadIdx.x < 4) ((volatile LAS unsigned*)(lds + LDS_BYTES - 16))[threadIdx.x] = 0u;
    __syncthreads();
    const XcdBarrier bar = xcd_barrier_post((unsigned*)(p.ws + WS_CTL), (volatile LAS unsigned*)(lds + LDS_BYTES - 16));
    if (p.hi > 1000) cg::this_grid().sync();
#ifdef PROBE_SPAN
    unsigned long long ts0 = 0, ts1 = 0;
#define STAMP(i) do { if ((i) == PROBE_SPAN) ts0 = __builtin_amdgcn_s_memrealtime(); if ((i) == PROBE_SPAN + PROBE_LEN) ts1 = __builtin_amdgcn_s_memrealtime(); } while (0)
#else
#define STAMP(i) do { } while (0)
#endif
    STAMP(0);
    RUNP(REP_P0, phase0(p, opl(lds)));
    xcd_barrier(bar); STAMP(1);
#define BATCH_PHASES(b) do { \
        RUNP(REP_P1, phase1_gemm(p, b, opl(lds))); \
        for (int r = 0; r < nrep(REP_SYNC); ++r) xcd_barrier(bar); \
        STAMP(2 + 6 * b); \
        RUNP(REP_ST, ssd_states_phase(p, b, opl(lds))); \
        __syncthreads(); STAMP(20 + 3 * b); \
        RUNP(REP_LA, lru_phase<false>(p, b, opl(lds), 0)); \
        __syncthreads(); STAMP(21 + 3 * b); \
        RUNP(REP_AT, attn_phase(p, b, opl(lds), dry_)); \
        xcd_barrier(bar); STAMP(3 + 6 * b); \
        RUNP(REP_SC, ssd_scan_phase(p, b, dry_)); \
        lru_carry_phase(p, b); \
        if (b == 0 && gridDim.x == 256) { __syncthreads(); transpose_items(p, opl(lds), TI_EARLY, TI_ALL); }     \
        xcd_barrier(bar); STAMP(4 + 6 * b); \
        RUNP(REP_SO, ssd_out_phase(p, b, opl(lds), dry_)); \
        __syncthreads(); STAMP(22 + 3 * b); \
        RUNP(REP_LF, lru_phase<true>(p, b, opl(lds), dry_)); \
        xcd_barrier(bar); STAMP(5 + 6 * b); \
        RUNP(REP_P5, phase5_gemm(p, b, opl(lds))); \
        xcd_barrier(bar); STAMP(6 + 6 * b); \
        RUNP(REP_P6, phase6_gemm(p, b, opl(lds))); \
        if (b + 1 < NBATCH && gridDim.x != 256) xcd_barrier(bar);     \
        STAMP(7 + 6 * b); \
    } while (0)
    BATCH_PHASES(0);
    BATCH_PHASES(1);
#ifdef PROBE_MA
    if (blockIdx.x == 0 && threadIdx.x == 0) { const unsigned long long* tsm = (const unsigned long long*)(p.ws + 255 * MiB); const unsigned long long t2 = __builtin_amdgcn_s_memrealtime(), want = 8ull * (tsm[PROBE_MB] - tsm[PROBE_MA]);
        while (__builtin_amdgcn_s_memrealtime() - t2 < want) __builtin_amdgcn_s_sleep(16); }
#endif
#ifdef PROBE_SPAN
    if (blockIdx.x == 0 && threadIdx.x == 0) { const unsigned long long t2 = __builtin_amdgcn_s_memrealtime(), want = 8ull * (ts1 - ts0);
        while (__builtin_amdgcn_s_memrealtime() - t2 < want) __builtin_amdgcn_s_sleep(16); }
#endif
}

static void launch_mk(Params& p, int lo, int hi, int grid, hipStream_t stream) {
    p.lo = lo; p.hi = hi; void* args[] = {&p};
    (void)hipMemsetAsync(p.ws + WS_CTL, 0, 65536, stream);
    hipError_t e = hipLaunchCooperativeKernel((const void*)mk, dim3(grid), dim3(512), args, LDS_BYTES, stream);
    if (e != hipSuccess) fprintf(stderr, "cooperative launch failed: %s (grid %d)\n", hipGetErrorString(e), grid);
}
extern "C" void kernel_launch(void* const* d_in, const int* in_sizes, int n_in, void* d_out, int out_size, void* d_ws, size_t ws_size, hipStream_t stream) {
    static int grid = 0;
    if (grid == 0) {
        if (n_in != 24 || out_size != MTOK * DM || ws_size < WS_END) { fprintf(stderr, "kernel_launch: unexpected shapes (n_in %d out %d ws %zu)\n", n_in, out_size, ws_size); grid = -1; return; }
        int dev = 0, cus = 0, per_cu = 0;
        hipGetDevice(&dev); hipDeviceGetAttribute(&cus, hipDeviceAttributeMultiprocessorCount, dev);
        hipFuncSetAttribute((const void*)mk, hipFuncAttributeMaxDynamicSharedMemorySize, LDS_BYTES);
        hipOccupancyMaxActiveBlocksPerMultiprocessor(&per_cu, (const void*)mk, 512, LDS_BYTES);
        if (per_cu < 1) { fprintf(stderr, "kernel_launch: occupancy query says %d blocks/CU\n", per_cu); per_cu = 1; }
        grid = cus * 1;
        (void)hipGetLastError();
    }
    if (grid < 0) return;
    Params p{};
    const float** f = (const float**)&p;
    for (int i = 0; i < 24; ++i) f[i] = (const float*)d_in[i];
    p.out = (float*)d_out; p.ws = (unsigned char*)d_ws;
    launch_mk(p, 0, 14, grid, stream);
}
```
